# Optimizing an MI355X kernel written in HIP

```python
import jax, jax.numpy as jnp
from jax import lax
import numpy as np

D_MODEL = 1024
BATCH = 8
SEQ = 4096
DEPTH = 2

MLA_HEADS = 8
QK_NOPE_DIM = 64
QK_ROPE_DIM = 32
QK_HEAD_DIM = QK_NOPE_DIM + QK_ROPE_DIM
V_HEAD_DIM = 64
Q_LORA_RANK = 256
KV_LORA_RANK = 128
ROPE_THETA = 10000.0
Q_BLOCK = 128
MLA_OUT = MLA_HEADS * V_HEAD_DIM
MLA_IN = Q_LORA_RANK + KV_LORA_RANK + QK_ROPE_DIM

RWKV_HEADS = 8
RWKV_HEAD_DIM = 64
RWKV_DIM = RWKV_HEADS * RWKV_HEAD_DIM
DECAY_LORA = 64
ICLR_LORA = 64
VRES_LORA = 32
GATE_LORA = 128
RWKV_GN_EPS = 64e-5
RWKV_IN = 3 * RWKV_DIM + DECAY_LORA + ICLR_LORA + GATE_LORA

N_IN = MLA_IN + RWKV_IN
MIX_DIM = MLA_OUT + RWKV_DIM

N_EXPERTS = 32
TOP_K = 4
D_FF_EXPERT = D_MODEL
SWIGLU_LIMIT = 7.0
SWIGLU_ALPHA = 1.702
EXPERT_BLOCK = 128

DEEPNORM_ALPHA = (2 * DEPTH) ** 0.25
DEEPNORM_BETA = (8 * DEPTH) ** -0.25
LN_EPS = 1e-5
RMS_EPS = 1e-6

kernel_name = 'hybrid_mla_rwkv7_moe_deepnorm_adaln'


def layer_norm(x, g, b):
    xf = x.astype(jnp.float32)
    mu = xf.mean(-1, keepdims=True)
    var = jnp.square(xf - mu).mean(-1, keepdims=True)
    return ((xf - mu) * lax.rsqrt(var + LN_EPS) * g + b).astype(x.dtype)


def rms_norm(x, g):
    xf = x.astype(jnp.float32)
    return (xf * lax.rsqrt(jnp.square(xf).mean(-1, keepdims=True) + RMS_EPS) * g).astype(x.dtype)


def rope(x, cos, sin):
    xp = x.astype(jnp.float32).reshape(x.shape[:-1] + (x.shape[-1] // 2, 2))
    x0, x1 = xp[..., 0], xp[..., 1]
    out = jnp.stack([x0 * cos - x1 * sin, x0 * sin + x1 * cos], axis=-1)
    return out.reshape(x.shape).astype(x.dtype)


def causal_attention(q, k, v):
    b, s, h, dq = q.shape
    nb = s // Q_BLOCK
    scale = QK_HEAD_DIM ** -0.5
    q_blocks = jnp.moveaxis(q.reshape(b, nb, Q_BLOCK, h, dq), 1, 0)
    k_pos = jnp.arange(s)

    def one_block(args):
        qb, bi = args
        scores = jnp.einsum('bqhd,bkhd->bhqk', qb, k, preferred_element_type=jnp.float32) * scale
        q_pos = bi * Q_BLOCK + jnp.arange(Q_BLOCK)
        scores = jnp.where(k_pos[None, :] <= q_pos[:, None], scores, -jnp.inf)
        probs = jax.nn.softmax(scores, axis=-1).astype(v.dtype)
        return jnp.einsum('bhqk,bkhd->bqhd', probs, v)

    out = lax.map(one_block, (q_blocks, jnp.arange(nb)))
    return jnp.moveaxis(out, 0, 1).reshape(b, s, h, v.shape[-1])


def mla_group(p, cos, sin, q_norm_g, w_uq, kv_norm_g, w_uk, w_uv, out_g):
    b, s, _ = p.shape
    q_lat = p[..., :Q_LORA_RANK]
    kv_lat = p[..., Q_LORA_RANK:Q_LORA_RANK + KV_LORA_RANK]
    k_rot = p[..., Q_LORA_RANK + KV_LORA_RANK:]
    q = (rms_norm(q_lat, q_norm_g) @ w_uq).reshape(b, s, MLA_HEADS, QK_HEAD_DIM)
    q = jnp.concatenate([q[..., :QK_NOPE_DIM],
                         rope(q[..., QK_NOPE_DIM:], cos[:, :, None, :], sin[:, :, None, :])], axis=-1)
    c_kv = rms_norm(kv_lat, kv_norm_g)
    k_nope = (c_kv @ w_uk).reshape(b, s, MLA_HEADS, QK_NOPE_DIM)
    v = (c_kv @ w_uv).reshape(b, s, MLA_HEADS, V_HEAD_DIM)
    k_rot = rope(k_rot, cos, sin)
    k = jnp.concatenate([k_nope, jnp.broadcast_to(k_rot[:, :, None, :], (b, s, MLA_HEADS, QK_ROPE_DIM))], axis=-1)
    o = causal_attention(q, k, v)
    return rms_norm(o.reshape(b, s, MLA_OUT), out_g)


def rwkv7_recurrence(r, decay, k, v, kk, a):
    b, s, h, n = r.shape

    def step(state, inp):
        r_t, w_t, k_t, v_t, kk_t, a_t = inp
        sa = jnp.einsum('bhij,bhj->bhi', state, -kk_t)
        state = (state * w_t[:, :, None, :]
                 + sa[..., :, None] * (kk_t * a_t)[..., None, :]
                 + v_t[..., :, None] * k_t[..., None, :])
        return state, jnp.einsum('bhij,bhj->bhi', state, r_t)

    xs = tuple(jnp.moveaxis(z, 1, 0) for z in (r, decay, k, v, kk, a))
    _, out = lax.scan(step, jnp.zeros((b, h, n, n), jnp.float32), xs)
    return jnp.moveaxis(out, 0, 1)


def rwkv7_group(p, mu, w0, w2, a0, a2, g2, k_k, k_a, r_k, gn_g, gn_b, v_first, vres):
    b, s, _ = p.shape
    h_, n_ = RWKV_HEADS, RWKV_HEAD_DIM
    p_prev = jnp.pad(p[:, :-1], ((0, 0), (1, 0), (0, 0)))
    p = p + mu * (p_prev - p)
    c3 = 3 * RWKV_DIM
    r = p[..., :RWKV_DIM]
    k = p[..., RWKV_DIM:2 * RWKV_DIM]
    v = p[..., 2 * RWKV_DIM:c3]
    wd = p[..., c3:c3 + DECAY_LORA]
    ad = p[..., c3 + DECAY_LORA:c3 + DECAY_LORA + ICLR_LORA]
    gd = p[..., c3 + DECAY_LORA + ICLR_LORA:]
    w = -jax.nn.softplus(-(w0 + jnp.tanh(wd) @ w2).astype(jnp.float32)) - 0.5
    decay = jnp.exp(-jnp.exp(w))
    a = jax.nn.sigmoid(a0 + ad @ a2)
    g = jax.nn.sigmoid(gd) @ g2
    if vres is not None:
        v0, v1, v2 = vres
        v = v + (v_first - v) * jax.nn.sigmoid(v0 + (v @ v1) @ v2)
    heads = lambda z: z.reshape(b, s, h_, n_).astype(jnp.float32)
    r_h, k_h, v_h, a_h, d_h = heads(r), heads(k), heads(v), heads(a), heads(decay)
    kk = k_h * k_k.reshape(h_, n_)
    kk = kk / jnp.maximum(jnp.linalg.norm(kk, axis=-1, keepdims=True), 1e-12)
    k_h = k_h * (1.0 + (a_h - 1.0) * k_a.reshape(h_, n_))
    o = rwkv7_recurrence(r_h, d_h, k_h, v_h, kk, a_h)
    mean = o.mean(-1, keepdims=True)
    var = jnp.square(o - mean).mean(-1, keepdims=True)
    o = ((o - mean) * lax.rsqrt(var + RWKV_GN_EPS)).reshape(b, s, RWKV_DIM) * gn_g + gn_b
    bonus = jnp.sum(r_h * k_h * r_k, axis=-1, keepdims=True) * v_h
    o = (o + bonus.reshape(b, s, RWKV_DIM)) * g
    return o.astype(p.dtype), v


def clamped_swiglu(hh):
    x_glu = jnp.minimum(hh[..., ::2], SWIGLU_LIMIT)
    x_lin = jnp.clip(hh[..., 1::2], -SWIGLU_LIMIT, SWIGLU_LIMIT)
    return x_glu * jax.nn.sigmoid(SWIGLU_ALPHA * x_glu) * (x_lin + 1.0)


def moe_ffn(h, router_w, router_b, w1, b1, w2, b2):
    b, s, d = h.shape
    t = b * s
    ht = h.reshape(t, d)
    logits = (ht @ router_w + router_b).astype(jnp.float32)
    top_val, top_idx = lax.top_k(logits, TOP_K)
    gates = jax.nn.softmax(top_val, axis=-1)
    n_assign = t * TOP_K
    e_flat = top_idx.reshape(n_assign)
    tok_flat = jnp.arange(n_assign, dtype=jnp.int32) // TOP_K
    order = jnp.argsort(e_flat)
    e_sorted = e_flat[order]
    counts = jnp.bincount(e_flat, length=N_EXPERTS)
    starts = jnp.cumsum(counts) - counts
    padded = (counts + EXPERT_BLOCK - 1) // EXPERT_BLOCK * EXPERT_BLOCK
    pad_ends = jnp.cumsum(padded)
    pad_starts = pad_ends - padded
    dest = pad_starts[e_sorted] + (jnp.arange(n_assign) - starts[e_sorted])
    n_blocks = -(-n_assign // EXPERT_BLOCK) + N_EXPERTS
    n_slots = n_blocks * EXPERT_BLOCK
    slot_tok = jnp.full((n_slots,), t, jnp.int32).at[dest].set(tok_flat[order])
    slot_gate = jnp.zeros((n_slots,), jnp.float32).at[dest].set(gates.reshape(n_assign)[order])
    block_expert = jnp.minimum(
        jnp.searchsorted(pad_ends, jnp.arange(n_blocks) * EXPERT_BLOCK, side='right'), N_EXPERTS - 1)
    h_pad = jnp.concatenate([ht, jnp.zeros((1, d), ht.dtype)], axis=0)

    def expert_block(args):
        idx, e = args
        u = clamped_swiglu(h_pad[idx] @ w1[e] + b1[e])
        return u @ w2[e] + b2[e]

    y_slots = lax.map(expert_block, (slot_tok.reshape(n_blocks, EXPERT_BLOCK), block_expert))
    y = jnp.zeros((t + 1, d), jnp.float32).at[slot_tok].add(
        y_slots.reshape(n_slots, d).astype(jnp.float32) * slot_gate[:, None])
    return y[:t].reshape(b, s, d).astype(h.dtype)


def setup_inputs(seed: int = 0) -> dict:
    key = jax.random.key(seed)
    keys = iter(jax.random.split(key, 64))

    def nrm(shape, scale):
        return jax.random.normal(next(keys), shape, jnp.float32) * scale

    L, D, C, E, F = DEPTH, D_MODEL, RWKV_DIM, N_EXPERTS, D_FF_EXPERT
    fan = D ** -0.5
    x = nrm((BATCH, SEQ, D), 1.0)
    c = nrm((BATCH, D), 1.0)
    positions = (jnp.arange(SEQ, dtype=jnp.int32)[None, :]
                 + jax.random.randint(next(keys), (BATCH, 1), 0, 2048, dtype=jnp.int32))
    emb_ln_g = 1.0 + nrm((D,), 0.02)
    emb_ln_b = nrm((D,), 0.02)
    ada_w = nrm((L, D, 6 * D), 0.1 * fan)
    ada_b = nrm((L, 6 * D), 0.02)
    w_in = jnp.concatenate([
        nrm((L, D, MLA_IN), fan),
        nrm((L, D, 2 * C), fan),
        nrm((L, D, C), fan * DEEPNORM_BETA),
        nrm((L, D, DECAY_LORA + ICLR_LORA + GATE_LORA), fan)], axis=-1)
    q_norm_g = 1.0 + nrm((L, Q_LORA_RANK), 0.02)
    w_uq = nrm((L, Q_LORA_RANK, MLA_HEADS * QK_HEAD_DIM), Q_LORA_RANK ** -0.5)
    kv_norm_g = 1.0 + nrm((L, KV_LORA_RANK), 0.02)
    w_uk = nrm((L, KV_LORA_RANK, MLA_HEADS * QK_NOPE_DIM), KV_LORA_RANK ** -0.5)
    w_uv = nrm((L, KV_LORA_RANK, MLA_HEADS * V_HEAD_DIM), KV_LORA_RANK ** -0.5 * DEEPNORM_BETA)
    mla_out_g = 1.0 + nrm((L, MLA_OUT), 0.02)
    rwkv_mu = jax.random.uniform(next(keys), (L, RWKV_IN), jnp.float32)
    ramp = jnp.linspace(0.0, 1.0, C) ** 0.85
    rwkv_w0 = -6.5 + 5.0 * ramp[None, :] + nrm((L, C), 0.1)
    rwkv_w2 = nrm((L, DECAY_LORA, C), 0.1 * DECAY_LORA ** -0.5)
    rwkv_a0 = nrm((L, C), 0.1)
    rwkv_a2 = nrm((L, ICLR_LORA, C), 0.1 * ICLR_LORA ** -0.5)
    rwkv_g2 = nrm((L, GATE_LORA, C), GATE_LORA ** -0.5)
    rwkv_k_k = 0.85 + nrm((L, C), 0.02)
    rwkv_k_a = 1.0 + nrm((L, C), 0.02)
    rwkv_r_k = nrm((L, RWKV_HEADS, RWKV_HEAD_DIM), 0.1)
    rwkv_gn_g = 1.0 + nrm((L, C), 0.02)
    rwkv_gn_b = nrm((L, C), 0.02)
    vres_v0 = 1.0 + nrm((L - 1, C), 0.1)
    vres_v1 = nrm((L - 1, C, VRES_LORA), C ** -0.5)
    vres_v2 = nrm((L - 1, VRES_LORA, C), 0.1 * VRES_LORA ** -0.5)
    w_o = nrm((L, MIX_DIM, D), MIX_DIM ** -0.5 * DEEPNORM_BETA)
    ln1_g = 1.0 + nrm((L, D), 0.02)
    ln1_b = nrm((L, D), 0.02)
    router_w = nrm((L, D, E), fan)
    router_b = nrm((L, E), 0.01)
    exp_w1 = nrm((L, E, D, 2 * F), fan)
    exp_b1 = nrm((L, E, 2 * F), 0.02)
    exp_w2 = nrm((L, E, F, D), F ** -0.5 * DEEPNORM_BETA)
    exp_b2 = nrm((L, E, D), 0.02)
    ln2_g = 1.0 + nrm((L, D), 0.02)
    ln2_b = nrm((L, D), 0.02)
    return {'x': x, 'c': c, 'positions': positions, 'emb_ln_g': emb_ln_g, 'emb_ln_b': emb_ln_b,
            'ada_w': ada_w, 'ada_b': ada_b, 'w_in': w_in,
            'q_norm_g': q_norm_g, 'w_uq': w_uq, 'kv_norm_g': kv_norm_g, 'w_uk': w_uk, 'w_uv': w_uv,
            'mla_out_g': mla_out_g, 'rwkv_mu': rwkv_mu, 'rwkv_w0': rwkv_w0, 'rwkv_w2': rwkv_w2,
            'rwkv_a0': rwkv_a0, 'rwkv_a2': rwkv_a2, 'rwkv_g2': rwkv_g2, 'rwkv_k_k': rwkv_k_k,
            'rwkv_k_a': rwkv_k_a, 'rwkv_r_k': rwkv_r_k, 'rwkv_gn_g': rwkv_gn_g, 'rwkv_gn_b': rwkv_gn_b,
            'vres_v0': vres_v0, 'vres_v1': vres_v1, 'vres_v2': vres_v2, 'w_o': w_o,
            'ln1_g': ln1_g, 'ln1_b': ln1_b, 'router_w': router_w, 'router_b': router_b,
            'exp_w1': exp_w1, 'exp_b1': exp_b1, 'exp_w2': exp_w2, 'exp_b2': exp_b2,
            'ln2_g': ln2_g, 'ln2_b': ln2_b}


def reference(x, c, positions, emb_ln_g, emb_ln_b, ada_w, ada_b, w_in,
              q_norm_g, w_uq, kv_norm_g, w_uk, w_uv, mla_out_g,
              rwkv_mu, rwkv_w0, rwkv_w2, rwkv_a0, rwkv_a2, rwkv_g2, rwkv_k_k, rwkv_k_a, rwkv_r_k,
              rwkv_gn_g, rwkv_gn_b, vres_v0, vres_v1, vres_v2, w_o, ln1_g, ln1_b,
              router_w, router_b, exp_w1, exp_b1, exp_w2, exp_b2, ln2_g, ln2_b):
    inv_freq = ROPE_THETA ** (-jnp.arange(0, QK_ROPE_DIM, 2, dtype=jnp.float32) / QK_ROPE_DIM)
    ang = positions.astype(jnp.float32)[..., None] * inv_freq
    cos, sin = jnp.cos(ang), jnp.sin(ang)
    c_act = jax.nn.silu(c)
    x = layer_norm(x, emb_ln_g, emb_ln_b)
    v_first = None
    for i in range(DEPTH):
        mod = c_act @ ada_w[i] + ada_b[i]
        sh1, sc1, gt1, sh2, sc2, gt2 = [m[:, None, :] for m in jnp.split(mod, 6, axis=-1)]
        h = x * (1.0 + sc1) + sh1
        p = h @ w_in[i]
        mla_o = mla_group(p[..., :MLA_IN], cos, sin, q_norm_g[i], w_uq[i], kv_norm_g[i],
                          w_uk[i], w_uv[i], mla_out_g[i])
        vres = None if i == 0 else (vres_v0[i - 1], vres_v1[i - 1], vres_v2[i - 1])
        rwkv_o, v_i = rwkv7_group(p[..., MLA_IN:], rwkv_mu[i], rwkv_w0[i], rwkv_w2[i], rwkv_a0[i],
                                  rwkv_a2[i], rwkv_g2[i], rwkv_k_k[i], rwkv_k_a[i], rwkv_r_k[i],
                                  rwkv_gn_g[i], rwkv_gn_b[i], v_first, vres)
        if i == 0:
            v_first = v_i
        mix = jnp.concatenate([mla_o, rwkv_o], axis=-1) @ w_o[i]
        x = layer_norm(DEEPNORM_ALPHA * x + (1.0 + gt1) * mix, ln1_g[i], ln1_b[i])
        h = x * (1.0 + sc2) + sh2
        ffn = moe_ffn(h, router_w[i], router_b[i], exp_w1[i], exp_b1[i], exp_w2[i], exp_b2[i])
        x = layer_norm(DEEPNORM_ALPHA * x + (1.0 + gt2) * ffn, ln2_g[i], ln2_b[i])
    return x
```

```cpp
#include <hip/hip_runtime.h>
#include <cstdio>
#include <cstdint>

#ifndef MK_ONE_LAUNCH
#define MK_ONE_LAUNCH 0
#endif

#define GAS __attribute__((address_space(1)))
#define LAS __attribute__((address_space(3)))
typedef unsigned short bf16;
typedef short bf16x8 __attribute__((ext_vector_type(8)));
typedef short s16x4 __attribute__((ext_vector_type(4)));
typedef float f32x2 __attribute__((ext_vector_type(2)));
typedef float f32x4 __attribute__((ext_vector_type(4)));
typedef float f32x16 __attribute__((ext_vector_type(16)));
typedef unsigned u32x2 __attribute__((ext_vector_type(2)));
typedef unsigned u32x4 __attribute__((ext_vector_type(4)));

constexpr int D = 1024, NBATCH = 8, SEQ = 4096, T = NBATCH * SEQ, DEPTH = 2;
constexpr int MLA_IN = 416, RWKV_IN = 1792, N_IN = 2208, N_INP = 2304;
constexpr int QLR = 256, KVLR = 128, ROPE = 32, NOPE = 64, QKD = 96, VD = 64, NH = 8;
constexpr int C5 = 512;
constexpr int NE = 32, TOPK = 4, FF = 1024, CAP = 32768;
constexpr int N_UP = 1792, K_UP = 384, N_SM = 1536, K_SM = 256;
constexpr int MAXSLOT = 139264;
constexpr float DN_ALPHA = 1.4142135623730951f;
constexpr float C2Q = 0.14724444602590306f;
constexpr float LN_EPS = 1e-5f, RMS_EPS = 1e-6f, GN_EPS = 64e-5f;
constexpr int NWAVES = 8, NTHREADS = 512;

enum { I_X = 0, I_C, I_POS, I_ELNG, I_ELNB, I_ADAW, I_ADAB, I_WIN, I_QNG, I_WUQ, I_KVNG, I_WUK, I_WUV, I_MOUTG, I_MU, I_W0, I_W2, I_A0, I_A2, I_G2,
       I_KK, I_KA, I_RK, I_GNG, I_GNB, I_V0, I_V1, I_V2, I_WO, I_LN1G, I_LN1B, I_RW, I_RB, I_EW1, I_EB1, I_EW2, I_EB2, I_LN2G, I_LN2B, N_INPUTS };

constexpr size_t MiB = 1u << 20;
constexpr size_t WS_CTL = 0, CTL_ZERO_BYTES = 4 * MiB;
constexpr size_t WS_MOD = 4 * MiB, WS_B1P = 5 * MiB, WS_CS = 6 * MiB, WS_LIST = 10 * MiB, WS_GATEL = 14 * MiB, WS_TOKSLOT = 18 * MiB;
constexpr size_t WS_WINT = 20 * MiB, WS_WUPT = 30 * MiB, WS_WSMT = 33 * MiB, WS_WV12T = 35 * MiB, WS_WOT = 36 * MiB, WS_W1T = 40 * MiB, WS_W2T = 296 * MiB;
constexpr size_t WS_X = 424 * MiB, WS_H = 552 * MiB, WS_VS0 = 616 * MiB, WS_VS1 = 648 * MiB;
constexpr size_t WS_P = 680 * MiB, WS_AN = 824 * MiB, WS_A2 = 848 * MiB, WS_RK = 864 * MiB, WS_Q = 928 * MiB, WS_KK = 976 * MiB, WS_V = 1024 * MiB, WS_O = 1056 * MiB;
constexpr size_t WS_WAG = 1088 * MiB, WS_RO = 1280 * MiB, WS_MIX = 1344 * MiB, WS_VR = 1408 * MiB;
constexpr size_t WS_H1 = 680 * MiB, WS_Y = 952 * MiB;
constexpr size_t WS_END = 1440 * MiB;
constexpr int CW_TMO = 0, CW_CODE = 1, CW_BAR = 4096, CW_CNT = 8192;

constexpr int RING_BYTES = 131072;
constexpr int LDSX_OFF = RING_BYTES;
constexpr int MISC_OFF = LDSX_OFF;
constexpr int TB_OFF = LDSX_OFF + 256;
constexpr int GT_OFF = LDSX_OFF + 1024;
constexpr int LDS_BYTES = 147456;

#define RLX_AGENT __ATOMIC_RELAXED, __HIP_MEMORY_SCOPE_AGENT
#define LDS_WAIT() asm volatile("s_waitcnt lgkmcnt(0)" ::: "memory")
#define VM_WAIT() asm volatile("s_waitcnt vmcnt(0)" ::: "memory")

__device__ __forceinline__ unsigned f2bf(float f) { unsigned u = __builtin_bit_cast(unsigned, f); return (u + 0x7fffu + ((u >> 16) & 1u)) >> 16; }
__device__ __forceinline__ unsigned pk2(float lo, float hi) { return f2bf(lo) | (f2bf(hi) << 16); }
__device__ __forceinline__ float bf2f(unsigned b) { return __builtin_bit_cast(float, b << 16); }
__device__ __forceinline__ float bflo(unsigned w) { return __builtin_bit_cast(float, w << 16); }
__device__ __forceinline__ float bfhi(unsigned w) { return __builtin_bit_cast(float, w & 0xffff0000u); }
__device__ __forceinline__ unsigned cvt_pk_bf16(float lo, float hi) { unsigned r; asm volatile("v_cvt_pk_bf16_f32 %0, %1, %2" : "=v"(r) : "v"(lo), "v"(hi)); return r; }
__device__ __forceinline__ float wave_sum(float v) {
#pragma unroll
    for (int o = 1; o < 64; o <<= 1) v += __shfl_xor(v, o);
    return v;
}
__device__ __forceinline__ float sigmoidf_(float x) { return 1.0f / (1.0f + __expf(-x)); }

#define XB_TMO      128
#define XB_XCNT(j)  (256  + 64 * (j))
#define XB_XSUB(j)  (1280 + 64 * (j))
#define XB_XGEN(j)  (2304 + 64 * (j))
#define XB_TOP      3328
#define XB_TOPGEN   3392
#define XCD_BAR_WORDS 3456
#define XB_SPIN_CAP (1u << 18)
__device__ __forceinline__ unsigned xb_ld(unsigned* p)              { return __hip_atomic_load(p, __ATOMIC_RELAXED, __HIP_MEMORY_SCOPE_AGENT); }
__device__ __forceinline__ unsigned xb_add(unsigned* p, unsigned v) { return __hip_atomic_fetch_add(p, v, __ATOMIC_RELAXED, __HIP_MEMORY_SCOPE_AGENT); }
__device__ __forceinline__ unsigned xb_xcc_id() { return (unsigned)__builtin_amdgcn_s_getreg((3 << 11) | 20) & 0xFu; }
#define XB_SPIN(cond, bar) do { unsigned _sp = 0; while (cond) { __builtin_amdgcn_s_sleep(1); \
    if ((++_sp & 255u) == 0u) { if (xb_ld(&(bar)[XB_TMO])) break; if (_sp > XB_SPIN_CAP) { atomicAdd(&(bar)[XB_TMO], 1u); break; } } } } while (0)
struct XcdBarrier { unsigned* bar; unsigned x; volatile LAS unsigned* st; };
__device__ __forceinline__ XcdBarrier xcd_barrier_post(unsigned* bar, volatile LAS unsigned* st) {
    XcdBarrier b; b.bar = bar; b.x = xb_xcc_id(); b.st = st;
    if (threadIdx.x == 0) (void)xb_add(&bar[XB_XCNT(b.x)], 1u);
    return b;
}
__device__ __forceinline__ void xcd_barrier_complete(unsigned* bar, unsigned x, unsigned& nloc, unsigned& nx) {
    const unsigned G = gridDim.x * gridDim.y * gridDim.z;
    unsigned sum, cnt, mine, sp = 0u;
    for (;;) {
        sum = 0u; cnt = 0u; mine = 0u;
#pragma unroll
        for (unsigned j = 0; j < 16; ++j) { const unsigned c = xb_ld(&bar[XB_XCNT(j)]); sum += c; cnt += (c > 0u) ? 1u : 0u; mine = (j == x) ? c : mine; }
        if (sum == G) break;
        __builtin_amdgcn_s_sleep(1);
        if ((++sp & 255u) == 0u) { if (xb_ld(&bar[XB_TMO])) break; if (sp > XB_SPIN_CAP) { atomicAdd(&bar[XB_TMO], 1u); break; } }
    }
    nloc = mine > 0u ? mine : 1u; nx = cnt > 0u ? cnt : 1u;
}
__device__ __forceinline__ void xcd_barrier(const XcdBarrier& b) {
    asm volatile("s_waitcnt vmcnt(0)" ::: "memory");
    __syncthreads();
    if (threadIdx.x == 0) {
        unsigned* bar = b.bar;
        __builtin_amdgcn_s_waitcnt(0);
        unsigned nloc = b.st[0], nx = b.st[1];
        if (nloc == 0u) { xcd_barrier_complete(bar, b.x, nloc, nx); b.st[0] = nloc; b.st[1] = nx; }
        const unsigned old = xb_add(&bar[XB_XSUB(b.x)], 1u);
        const unsigned gen = old / nloc;
        if (old + 1u == (gen + 1u) * nloc) {
            __builtin_amdgcn_fence(__ATOMIC_RELEASE, "agent");
            asm volatile("s_waitcnt vmcnt(0)" ::: "memory");
            const unsigned og = xb_add(&bar[XB_TOP], 1u);
            const unsigned tg = og / nx;
            if (og + 1u == (tg + 1u) * nx) xb_add(&bar[XB_TOPGEN], 1u);
            else XB_SPIN(xb_ld(&bar[XB_TOPGEN]) == tg, bar);
            __builtin_amdgcn_fence(__ATOMIC_ACQUIRE, "agent");
            xb_add(&bar[XB_XGEN(b.x)], 1u);
            asm volatile("s_waitcnt vmcnt(0)" ::: "memory");
        } else {
            XB_SPIN(xb_ld(&bar[XB_XGEN(b.x)]) == gen, bar);
            __builtin_amdgcn_fence(__ATOMIC_ACQUIRE, "agent");
            asm volatile("s_waitcnt vmcnt(0)" ::: "memory");
        }
    }
    __syncthreads();
}

namespace pg8 {
constexpr int BM = 256, BK = 64, HALF = 128, HTB = HALF * BK * 2, STAGE_BYTES = 8 * HTB, NXCD = 8, WGM = 8;
__device__ __forceinline__ int lds_byte(int r, int c) { const int st = (r >> 4) * 2 + (c >> 5), rr = r & 15, cc = c & 31, ob = rr * 64 + cc * 2; return st * 1024 + (ob ^ (((ob >> 9) & 1) << 5)); }
__device__ __forceinline__ void stage_rc(int b, int& R, int& C) { const int st = b / 1024, sb = b % 1024, swz = sb ^ (((sb >> 9) & 1) << 5); R = (st >> 1) * 16 + swz / 64; C = (st & 1) * 32 + (swz % 64) / 2; }
__device__ __forceinline__ int perm32(int rho) { const int n = rho >> 4, i = rho & 15; return 8 * (i >> 2) + 4 * n + (i & 3); }

struct Unit { int pm, pn, e; };
struct Gemm { const bf16* A; const bf16* Bt; int M, N, K; };

struct DenseOrder {
    int nM, nN, nwg, G, c;
    __device__ __forceinline__ void init(int M, int N, int G_, int c_) { nM = M / BM; nN = N / BM; nwg = nM * nN; G = G_; c = c_; }
    __device__ __forceinline__ bool next(int i, Unit& u) const {
        const long L = (long)i * G + c; if (L >= nwg) return false;
        int wgid = (int)L; { const int q = nwg / NXCD, r = nwg % NXCD, xcd = wgid % NXCD, off = wgid / NXCD; wgid = (xcd < r ? xcd * (q + 1) : r * (q + 1) + (xcd - r) * q) + off; }
        const int nig = WGM * nN, gid = wgid / nig, fm = gid * WGM, gsz = (nM - fm) < WGM ? (nM - fm) : WGM;
        u.pm = fm + ((wgid % nig) % gsz); u.pn = (wgid % nig) / gsz; u.e = 0; return true;
    }
    static constexpr bool GATHER = false;
    __device__ __forceinline__ size_t b_off(const Unit& u, int N, int K) const { return (size_t)u.pn * BM * K * 2; }
    __device__ __forceinline__ unsigned a_row_off(const Unit& u, int row, int K) const { return 0u; }
    __device__ __forceinline__ LAS unsigned* gtab() const { return nullptr; }
};
template <bool GATHER_> struct MoeOrder {
    static constexpr bool GATHER = GATHER_;
    const LAS int* tb; const LAS int* cnt; const int* list; int nN, G, c; LAS unsigned* gt_;
    __device__ __forceinline__ LAS unsigned* gtab() const { return gt_; }
    __device__ __forceinline__ bool next(int i, Unit& u) const {
        const int L = i * G + c; const int total = tb[NE] * nN; if (L >= total) return false;
        int e = 0;
#pragma unroll 1
        for (int j = 1; j < NE; ++j) if (tb[j] * nN <= L) e = j;
        const int Lr = L - tb[e] * nN, nte = tb[e + 1] - tb[e];
        u.e = e; u.pn = Lr / nte; u.pm = tb[e] + (Lr % nte); return true;
    }
    __device__ __forceinline__ size_t b_off(const Unit& u, int N, int K) const { return ((size_t)u.e * N + (size_t)u.pn * BM) * K * 2; }
    __device__ __forceinline__ unsigned a_row_off(const Unit& u, int row, int K) const {
        const int pos = (u.pm - tb[u.e]) * BM + row; const int tok = pos < cnt[u.e] ? list[u.e * CAP + pos] : 0; return (unsigned)tok * (unsigned)(K * 2);
    }
};

template <class Epi, class Sched, bool ALIGN_EPI>
__device__ __forceinline__ void gemm_phase(LAS unsigned char* lds, const Gemm g, const Sched& S, const Epi& E) {
    const int tid = threadIdx.x, wid = __builtin_amdgcn_readfirstlane(tid >> 6), lane = tid & 63, wr = wid >> 2, wc = wid & 3, fr = lane & 15, fq = lane >> 4;
    const int K = g.K, nt = K / BK;
    int RA[2]; unsigned CA[2], voffA[2], voffB[2];
#pragma unroll
    for (int i = 0; i < 2; ++i) { int R, C; stage_rc(tid * 16 + i * 8192, R, C); const int Rb = Epi::PERM ? ((R & ~31) + perm32(R & 31)) : R;
        RA[i] = R; CA[i] = (unsigned)C * 2u; voffA[i] = (unsigned)(R * K + C) * 2u; voffB[i] = (unsigned)(Rb * K + C) * 2u; }
    const size_t kstep = (size_t)(BK * 2);
    const size_t hstep = (size_t)HALF * K * 2;
    const size_t tstep = 2 * hstep;
    const unsigned ldsw = (unsigned)wid * 1024u;
    const int aoff = lds_byte(wr * 64 + fr, fq * 8), boff = lds_byte(wc * 32 + fr, fq * 8);
    const char* Abase = (const char*)g.A;
    LAS unsigned* gtb = S.gtab();
#define PG8_SA(b, h) (((b) * 2 + (h)) * HTB)
#define PG8_SB(b, h) ((4 + (b) * 2 + (h)) * HTB)
#define PG8_STAGE(bufoff, gbase, voff) do { _Pragma("unroll") for (int _i = 0; _i < 2; ++_i) \
        __builtin_amdgcn_global_load_lds((const unsigned*)((const char*)(gbase) + (voff)[_i]), (LAS unsigned*)(lds + (bufoff) + ldsw + _i * 8192), 16, 0, 0); } while (0)
#define PG8_STAGEA(bufoff, h, kb, nx) do { \
        if constexpr (Sched::GATHER) { const LAS unsigned* tp_ = gtb + ((nx) ? tnx : tcu) + (h) * HALF; const unsigned o0_ = tp_[RA[0]] + CA[0], o1_ = tp_[RA[1]] + CA[1]; \
            __builtin_amdgcn_global_load_lds((const unsigned*)(Abase + (size_t)(kb) + o0_), (LAS unsigned*)(lds + (bufoff) + ldsw), 16, 0, 0); \
            __builtin_amdgcn_global_load_lds((const unsigned*)(Abase + (size_t)(kb) + o1_), (LAS unsigned*)(lds + (bufoff) + ldsw + 8192), 16, 0, 0); } \
        else { const char* gb_ = ((nx) ? nA : cA) + (size_t)(h) * hstep + (size_t)(kb); PG8_STAGE(bufoff, gb_, voffA); } } while (0)
#define PG8_LDA(dst, b, h) do { _Pragma("unroll") for (int m = 0; m < 4; ++m) _Pragma("unroll") for (int k = 0; k < 2; ++k) dst[m][k] = *(const LAS bf16x8*)(lds + PG8_SA(b, h) + aoff + m * 2048 + k * 1024); } while (0)
#define PG8_LDB(dst, b, h) do { _Pragma("unroll") for (int n = 0; n < 2; ++n) _Pragma("unroll") for (int k = 0; k < 2; ++k) dst[n][k] = *(const LAS bf16x8*)(lds + PG8_SB(b, h) + boff + n * 2048 + k * 1024); } while (0)
#define PG8_MMA(ai, bj, At, Bt) do { __builtin_amdgcn_s_setprio(1); _Pragma("unroll") for (int m = 0; m < 4; ++m) _Pragma("unroll") for (int n = 0; n < 2; ++n) _Pragma("unroll") for (int k = 0; k < 2; ++k) \
        acc[ai][bj][m][n] = __builtin_amdgcn_mfma_f32_16x16x32_bf16(Bt[n][k], At[m][k], acc[ai][bj][m][n], 0, 0, 0); __builtin_amdgcn_s_setprio(0); } while (0)
#define PG8_WAIT_V(n) asm volatile("s_waitcnt vmcnt(" #n ")" ::: "memory")
#define PG8_WAIT_L(n) asm volatile("s_waitcnt lgkmcnt(" #n ")" ::: "memory")
#define PG8_BAR __builtin_amdgcn_s_barrier()
#define PG8_SCHED __builtin_amdgcn_sched_barrier(0)
    Unit cur, nxt; int ui = 0;
    if (!S.next(0, cur)) return;
    f32x4 acc[2][2][4][2];
#pragma unroll
    for (int a = 0; a < 2; ++a)
#pragma unroll
        for (int b = 0; b < 2; ++b)
#pragma unroll
            for (int m = 0; m < 4; ++m)
#pragma unroll
                for (int n = 0; n < 2; ++n) acc[a][b][m][n] = (f32x4){0.f, 0.f, 0.f, 0.f};
    bf16x8 At[4][2], B0[2][2], B1[2][2];
    const char* cA = Abase + (size_t)cur.pm * tstep; const char* cB = (const char*)g.Bt + S.b_off(cur, g.N, K);
    const char* nA = cA; const char* nB = cB;
    int tcu = 0, tnx = 0;
    if constexpr (Sched::GATHER) {
        if (tid < BM) gtb[tid] = S.a_row_off(cur, tid, K);
        asm volatile("s_waitcnt vmcnt(0) lgkmcnt(0)" ::: "memory"); PG8_BAR; asm volatile("" ::: "memory");
    }
    PG8_STAGE(PG8_SB(0, 0), cB, voffB); PG8_STAGE(PG8_SB(0, 1), cB + hstep, voffB); PG8_STAGEA(PG8_SA(0, 0), 0, 0, false); PG8_STAGEA(PG8_SA(0, 1), 1, 0, false);
    if (wr == 1) PG8_BAR;
    PG8_WAIT_V(2); PG8_BAR;
    PG8_STAGE(PG8_SB(1, 0), cB + kstep, voffB); PG8_STAGEA(PG8_SA(1, 0), 0, kstep, false); PG8_STAGE(PG8_SB(1, 1), cB + hstep + kstep, voffB);
    PG8_WAIT_V(6); PG8_BAR;
    for (;;) {
        const bool has_next = S.next(ui + 1, nxt);
        nA = cA; nB = cB; tnx = tcu;
        if (has_next) { nA = Abase + (size_t)nxt.pm * tstep; nB = (const char*)g.Bt + S.b_off(nxt, g.N, K);
            if constexpr (Sched::GATHER) { tnx = tcu ^ BM; if (tid < BM) gtb[tnx + tid] = S.a_row_off(nxt, tid, K); } }
#pragma unroll 1
        for (int t = 0; t < nt; t += 2) {
            const bool last = (t == nt - 2);
            const size_t k1 = (size_t)(t + 1) * kstep;
            const size_t k2 = last ? 0 : (size_t)(t + 2) * kstep, k3 = k2 + kstep;
            const char* b2 = last ? nB : cB + (size_t)(t + 2) * kstep; const char* b3 = b2 + kstep;
            PG8_LDB(B0, 0, 0); PG8_LDB(B1, 0, 1); PG8_SCHED; PG8_LDA(At, 0, 0); PG8_STAGEA(PG8_SA(1, 1), 1, k1, false);
            PG8_WAIT_V(8); PG8_WAIT_L(0); PG8_BAR; PG8_MMA(0, 0, At, B0); PG8_MMA(0, 1, At, B1); PG8_BAR; PG8_SCHED;
            PG8_LDA(At, 0, 1); PG8_STAGE(PG8_SB(0, 0), b2, voffB); PG8_STAGE(PG8_SB(0, 1), b2 + hstep, voffB); PG8_STAGEA(PG8_SA(0, 0), 0, k2, last);
            PG8_WAIT_V(8); PG8_WAIT_L(0); PG8_BAR; PG8_MMA(1, 0, At, B0); PG8_MMA(1, 1, At, B1); PG8_BAR; PG8_SCHED;
            PG8_LDB(B0, 1, 0); PG8_LDB(B1, 1, 1); PG8_SCHED; PG8_LDA(At, 1, 0); PG8_STAGEA(PG8_SA(0, 1), 1, k2, last);
            PG8_WAIT_V(8); PG8_WAIT_L(0); PG8_BAR; PG8_MMA(0, 0, At, B0); PG8_MMA(0, 1, At, B1); PG8_BAR; PG8_SCHED;
            PG8_LDA(At, 1, 1); PG8_STAGE(PG8_SB(1, 0), b3, voffB); PG8_STAGE(PG8_SB(1, 1), b3 + hstep, voffB); PG8_STAGEA(PG8_SA(1, 0), 0, k3, last);
            PG8_WAIT_V(8); PG8_WAIT_L(0); PG8_BAR; PG8_MMA(1, 0, At, B0); PG8_MMA(1, 1, At, B1); PG8_BAR; PG8_SCHED;
        }
        if constexpr (ALIGN_EPI) { if (wr == 0) PG8_BAR; }
        E(acc, cur, wr, wc, fr, fq);
        if (!has_next) break;
#pragma unroll
        for (int a = 0; a < 2; ++a)
#pragma unroll
            for (int b = 0; b < 2; ++b)
#pragma unroll
                for (int m = 0; m < 4; ++m)
#pragma unroll
                    for (int n = 0; n < 2; ++n) acc[a][b][m][n] = (f32x4){0.f, 0.f, 0.f, 0.f};
        cur = nxt; cA = nA; cB = nB; tcu = tnx; ++ui;
        if constexpr (ALIGN_EPI) { if (wr == 1) PG8_BAR; }
    }
    PG8_WAIT_V(0);
    if constexpr (!ALIGN_EPI) { if (wr == 0) PG8_BAR; }
    PG8_BAR;
#undef PG8_SA
#undef PG8_SB
#undef PG8_STAGE
#undef PG8_STAGEA
#undef PG8_LDA
#undef PG8_LDB
#undef PG8_MMA
#undef PG8_WAIT_V
#undef PG8_WAIT_L
#undef PG8_BAR
#undef PG8_SCHED
}

struct EpiBf16Plain {
    static constexpr bool PERM = true;
    bf16* O; int ldc;
    __device__ __forceinline__ void operator()(const f32x4 (&acc)[2][2][4][2], const Unit& u, int wr, int wc, int fr, int fq) const {
        const int row0 = u.pm * BM + wr * 64 + fr, col0 = u.pn * BM + wc * 32 + 8 * fq;
#pragma unroll
        for (int ai = 0; ai < 2; ++ai)
#pragma unroll
            for (int m = 0; m < 4; ++m) { bf16* rowp = O + (size_t)(row0 + ai * HALF + m * 16) * ldc + col0;
#pragma unroll
                for (int bj = 0; bj < 2; ++bj) { const f32x4 v0 = acc[ai][bj][m][0], v1 = acc[ai][bj][m][1];
                    u32x4 w; w.x = cvt_pk_bf16(v0[0], v0[1]); w.y = cvt_pk_bf16(v0[2], v0[3]); w.z = cvt_pk_bf16(v1[0], v1[1]); w.w = cvt_pk_bf16(v1[2], v1[3]);
                    *(u32x4*)(rowp + bj * HALF) = w; } }
    }
};
struct EpiMlaUp {
    static constexpr bool PERM = true;
    bf16* Q; bf16* KK; bf16* V; const float* cs;
    __device__ __forceinline__ void operator()(const f32x4 (&acc)[2][2][4][2], const Unit& u, int wr, int wc, int fr, int fq) const {
        const int row0 = u.pm * BM + wr * 64 + fr;
#pragma unroll
        for (int bj = 0; bj < 2; ++bj) {
            const int c0 = u.pn * BM + bj * HALF + wc * 32 + 8 * fq;
            if (u.pn < 3) {
                const int h = c0 / QKD, d = c0 - h * QKD;
                const bool rope = d >= NOPE; const int i0 = rope ? (d - NOPE) >> 1 : 0;
#pragma unroll
                for (int ai = 0; ai < 2; ++ai)
#pragma unroll
                    for (int m = 0; m < 4; ++m) { const int row = row0 + ai * HALF + m * 16;
                        f32x4 v0 = acc[ai][bj][m][0], v1 = acc[ai][bj][m][1];
                        if (rope) { const f32x4 cA = *(const f32x4*)(cs + (size_t)row * 32 + i0 * 2), cB = *(const f32x4*)(cs + (size_t)row * 32 + i0 * 2 + 4);
                            const f32x4 a = v0, b = v1;
                            v0[0] = a[0] * cA[0] - a[1] * cA[1]; v0[1] = a[0] * cA[1] + a[1] * cA[0]; v0[2] = a[2] * cA[2] - a[3] * cA[3]; v0[3] = a[2] * cA[3] + a[3] * cA[2];
                            v1[0] = b[0] * cB[0] - b[1] * cB[1]; v1[1] = b[0] * cB[1] + b[1] * cB[0]; v1[2] = b[2] * cB[2] - b[3] * cB[3]; v1[3] = b[2] * cB[3] + b[3] * cB[2]; }
                        v0 = v0 * C2Q; v1 = v1 * C2Q;
                        u32x4 w; w.x = cvt_pk_bf16(v0[0], v0[1]); w.y = cvt_pk_bf16(v0[2], v0[3]); w.z = cvt_pk_bf16(v1[0], v1[1]); w.w = cvt_pk_bf16(v1[2], v1[3]);
                        *(u32x4*)(Q + (size_t)row * 768 + c0) = w; asm volatile("" ::: "memory"); }
            } else {
                bf16* base; int ld, cc;
                if (u.pn < 5) { const int c1 = c0 - 768; const int h = c1 >> 6, d = c1 & 63; base = KK; ld = 768; cc = h * QKD + d; }
                else { base = V; ld = 512; cc = c0 - 1280; }
#pragma unroll
                for (int ai = 0; ai < 2; ++ai)
#pragma unroll
                    for (int m = 0; m < 4; ++m) { const int row = row0 + ai * HALF + m * 16; const f32x4 v0 = acc[ai][bj][m][0], v1 = acc[ai][bj][m][1];
                        u32x4 w; w.x = cvt_pk_bf16(v0[0], v0[1]); w.y = cvt_pk_bf16(v0[2], v0[3]); w.z = cvt_pk_bf16(v1[0], v1[1]); w.w = cvt_pk_bf16(v1[2], v1[3]);
                        *(u32x4*)(base + (size_t)row * ld + cc) = w; asm volatile("" ::: "memory"); }
            }
        }
    }
};
struct EpiRwkvSmall {
    static constexpr bool PERM = false;
    float* O; const float* w0; const float* a0;
    __device__ __forceinline__ void operator()(const f32x4 (&acc)[2][2][4][2], const Unit& u, int wr, int wc, int fr, int fq) const {
        const int row0 = u.pm * BM + wr * 64 + fr, col0 = u.pn * BM + wc * 32 + 4 * fq;
        const int kind = u.pn >> 1;
#pragma unroll
        for (int bj = 0; bj < 2; ++bj)
#pragma unroll
            for (int n = 0; n < 2; ++n) { const int c = col0 + bj * HALF + n * 16;
                f32x4 bv = (f32x4){0.f, 0.f, 0.f, 0.f};
                if (kind == 0) bv = *(const f32x4*)(w0 + c); else if (kind == 1) bv = *(const f32x4*)(a0 + (c - 512));
#pragma unroll
                for (int ai = 0; ai < 2; ++ai)
#pragma unroll
                    for (int m = 0; m < 4; ++m) { f32x4 v = acc[ai][bj][m][n] + bv;
                        if (kind == 0) {
#pragma unroll
                            for (int j = 0; j < 4; ++j) { const float z = -v[j]; const float sp = fmaxf(z, 0.f) + __logf(1.0f + __expf(-fabsf(z))); const float w = -sp - 0.5f; v[j] = __expf(-__expf(w)); }
                        } else if (kind == 1) {
#pragma unroll
                            for (int j = 0; j < 4; ++j) v[j] = sigmoidf_(v[j]);
                        }
                        *(f32x4*)(O + (size_t)(row0 + ai * HALF + m * 16) * N_SM + c) = v; asm volatile("" ::: "memory"); } }
    }
};
struct EpiVres {
    static constexpr bool PERM = true;
    const bf16* vs; const bf16* vf; bf16* vr; const float* v0;
    __device__ __forceinline__ void operator()(const f32x4 (&acc)[2][2][4][2], const Unit& u, int wr, int wc, int fr, int fq) const {
        const int row0 = u.pm * BM + wr * 64 + fr, col0 = u.pn * BM + wc * 32 + 8 * fq;
#pragma unroll
        for (int bj = 0; bj < 2; ++bj) { const int c = col0 + bj * HALF;
            const f32x4 b0 = *(const f32x4*)(v0 + c), b1 = *(const f32x4*)(v0 + c + 4);
#pragma unroll
            for (int ai = 0; ai < 2; ++ai)
#pragma unroll
                for (int m = 0; m < 4; ++m) { const size_t off = (size_t)(row0 + ai * HALF + m * 16) * C5 + c;
                    const u32x4 s = *(const u32x4*)(vs + off), f = *(const u32x4*)(vf + off);
                    const f32x4 g0 = acc[ai][bj][m][0] + b0, g1 = acc[ai][bj][m][1] + b1;
                    float o[8];
#pragma unroll
                    for (int j = 0; j < 4; ++j) { const float sl = bflo(s[j]), sh = bfhi(s[j]), fl = bflo(f[j]), fh = bfhi(f[j]);
                        const float ga = (j < 2) ? g0[2 * j] : g1[2 * j - 4], gb = (j < 2) ? g0[2 * j + 1] : g1[2 * j - 3];
                        o[2 * j] = sl + (fl - sl) * sigmoidf_(ga); o[2 * j + 1] = sh + (fh - sh) * sigmoidf_(gb); }
                    u32x4 w; w.x = cvt_pk_bf16(o[0], o[1]); w.y = cvt_pk_bf16(o[2], o[3]); w.z = cvt_pk_bf16(o[4], o[5]); w.w = cvt_pk_bf16(o[6], o[7]);
                    *(u32x4*)(vr + off) = w; } }
    }
};
struct EpiWo {
    static constexpr bool PERM = false;
    float* X; const float* gt;
    __device__ __forceinline__ void operator()(const f32x4 (&acc)[2][2][4][2], const Unit& u, int wr, int wc, int fr, int fq) const {
        const int row0 = u.pm * BM + wr * 64 + fr, col0 = u.pn * BM + wc * 32 + 4 * fq;
        const int b = (u.pm * BM) / SEQ;
#pragma unroll
        for (int bj = 0; bj < 2; ++bj)
#pragma unroll
            for (int n = 0; n < 2; ++n) { const int c = col0 + bj * HALF + n * 16; const f32x4 g = *(const f32x4*)(gt + (size_t)b * 6144 + c) + 1.0f;
#pragma unroll
                for (int ai = 0; ai < 2; ++ai)
#pragma unroll
                    for (int m = 0; m < 4; ++m) { float* p = X + (size_t)(row0 + ai * HALF + m * 16) * D + c; const f32x4 x = *(const f32x4*)p; *(f32x4*)p = x * DN_ALPHA + g * acc[ai][bj][m][n]; } }
    }
};
struct EpiSwiglu {
    static constexpr bool PERM = true;
    bf16* O; const float* b1p;
    __device__ __forceinline__ void operator()(const f32x4 (&acc)[2][2][4][2], const Unit& u, int wr, int wc, int fr, int fq) const {
        const int row0 = u.pm * BM + wr * 64 + fr; const int cin = u.pn * BM + wc * 32 + 8 * fq, cout = u.pn * HALF + wc * 32 + 8 * fq;
        const float* bp = b1p + (size_t)u.e * 2048 + cin;
        const f32x4 bg0 = *(const f32x4*)(bp), bg1 = *(const f32x4*)(bp + 4), bl0 = *(const f32x4*)(bp + HALF), bl1 = *(const f32x4*)(bp + HALF + 4);
#pragma unroll
        for (int ai = 0; ai < 2; ++ai)
#pragma unroll
            for (int m = 0; m < 4; ++m) {
                const f32x4 g0 = acc[ai][0][m][0] + bg0, g1 = acc[ai][0][m][1] + bg1, l0 = acc[ai][1][m][0] + bl0, l1 = acc[ai][1][m][1] + bl1;
                float o[8];
#pragma unroll
                for (int j = 0; j < 8; ++j) { const float gv = fminf(j < 4 ? g0[j & 3] : g1[j & 3], 7.0f); const float lv = fminf(fmaxf(j < 4 ? l0[j & 3] : l1[j & 3], -7.0f), 7.0f);
                    o[j] = gv * sigmoidf_(1.702f * gv) * (lv + 1.0f); }
                u32x4 w; w.x = cvt_pk_bf16(o[0], o[1]); w.y = cvt_pk_bf16(o[2], o[3]); w.z = cvt_pk_bf16(o[4], o[5]); w.w = cvt_pk_bf16(o[6], o[7]);
                *(u32x4*)(O + (size_t)(row0 + ai * HALF + m * 16) * FF + cout) = w; }
    }
};
struct EpiMoeOut {
    static constexpr bool PERM = true;
    bf16* O; const float* b2; const float* gatel; const LAS int* tb;
    __device__ __forceinline__ void operator()(const f32x4 (&acc)[2][2][4][2], const Unit& u, int wr, int wc, int fr, int fq) const {
        const int row0 = u.pm * BM + wr * 64 + fr, col0 = u.pn * BM + wc * 32 + 8 * fq;
        const int pos0 = (u.pm - tb[u.e]) * BM + wr * 64 + fr;
        const float* bp = b2 + (size_t)u.e * D + col0;
        f32x4 bv[2][2];
#pragma unroll
        for (int bj = 0; bj < 2; ++bj) { bv[bj][0] = *(const f32x4*)(bp + bj * HALF); bv[bj][1] = *(const f32x4*)(bp + bj * HALF + 4); }
#pragma unroll
        for (int ai = 0; ai < 2; ++ai)
#pragma unroll
            for (int m = 0; m < 4; ++m) { const float gt = gatel[(size_t)u.e * CAP + pos0 + ai * HALF + m * 16];
                bf16* rowp = O + (size_t)(row0 + ai * HALF + m * 16) * D + col0;
#pragma unroll
                for (int bj = 0; bj < 2; ++bj) { const f32x4 v0 = (acc[ai][bj][m][0] + bv[bj][0]) * gt, v1 = (acc[ai][bj][m][1] + bv[bj][1]) * gt;
                    u32x4 w; w.x = cvt_pk_bf16(v0[0], v0[1]); w.y = cvt_pk_bf16(v0[2], v0[3]); w.z = cvt_pk_bf16(v1[0], v1[1]); w.w = cvt_pk_bf16(v1[2], v1[3]);
                    *(u32x4*)(rowp + bj * HALF) = w; } }
    }
};
}

struct Params { const void* in[N_INPUTS]; float* out; unsigned char* ws; int ph_lo, ph_hi; };

struct Frame {
    LAS unsigned char* lds;
    int tid, lane, wave, G, vcu;
    unsigned char* ws;
};
#define WSP(type, off) ((type*)(F.ws + (off)))
#define INP(i) ((const float*)p.in[i])

__device__ const double INV_FREQ[16] = {1.00000000000000000e+00, 5.62341325190349073e-01, 3.16227766016837941e-01, 1.77827941003892293e-01, 1.00000000000000006e-01, 5.62341325190349114e-02,
    3.16227766016837913e-02, 1.77827941003892293e-02, 1.00000000000000002e-02, 5.62341325190349097e-03, 3.16227766016837939e-03, 1.77827941003892275e-03, 1.00000000000000002e-03,
    5.62341325190349097e-04, 3.16227766016837939e-04, 1.77827941003892270e-04};

template <int MODE>
__device__ __forceinline__ void tr_item(const float* W, int ldn, bf16* WT, int ldk, int kofs, int rofs, int k0, int n0, LAS float* scr, int lane) {
#pragma unroll 8
    for (int i = 0; i < 32; ++i) { const int kk = 2 * i + (lane >> 5); scr[kk * 33 + (lane & 31)] = W[(size_t)(k0 + kk) * ldn + n0 + (lane & 31)]; }
    LDS_WAIT(); asm volatile("" ::: "memory");
    const int c = lane & 7;
#pragma unroll
    for (int j = 0; j < 4; ++j) { const int n = (lane >> 3) + 8 * j; const LAS float* s = scr + (8 * c) * 33 + n;
        u32x4 o; o.x = pk2(s[0 * 33], s[1 * 33]); o.y = pk2(s[2 * 33], s[3 * 33]); o.z = pk2(s[4 * 33], s[5 * 33]); o.w = pk2(s[6 * 33], s[7 * 33]);
        const int ng = n0 + n; int row;
        if (MODE == 0) row = rofs + ng; else { const int jo = ng >> 1, bj = ng & 1; row = rofs + (jo >> 7) * 256 + bj * 128 + (jo & 127); }
        *(GAS u32x4*)(WT + (size_t)row * ldk + kofs + k0 + 8 * c) = o; }
    LDS_WAIT(); asm volatile("" ::: "memory");
}
__device__ __forceinline__ void zero_rect(const Frame& F, bf16* M, int ld, int r0, int nrows, int c0, int ncols) {
    const int gw = F.vcu * NWAVES + F.wave, NGW = F.G * NWAVES; const int nch = ncols / 8;
    for (int r = gw; r < nrows; r += NGW)
        for (int ch = F.lane; ch < nch; ch += 64) *(GAS u32x4*)(M + (size_t)(r0 + r) * ld + c0 + ch * 8) = (u32x4){0u, 0u, 0u, 0u};
}
__device__ __forceinline__ void phase_prologue(const Params& p, const Frame& F) {
    LAS float* scr = (LAS float*)(F.lds + F.wave * 16384);
    const int gw = F.vcu * NWAVES + F.wave, NGW = F.G * NWAVES;
    constexpr int I_IN = 16 * 69, I_UQ = 4 * 24, I_UK = 2 * 16, I_W2s = 16, I_G2s = 2 * 16, I_WO_ = 16 * 32, I_E1 = 16 * 64, I_E2 = 16 * 32;
    constexpr int PER_L = I_IN + I_UQ + 2 * I_UK + 2 * I_W2s + I_G2s + I_WO_;
    constexpr int NSMALL = DEPTH * PER_L, NE1 = DEPTH * NE * I_E1, NE2 = DEPTH * NE * I_E2;
    for (int it = gw; it < NSMALL + NE1 + NE2; it += NGW) {
        int r = it;
        if (r < NSMALL) {
            const int l = r / PER_L; r -= l * PER_L;
            if (r < I_IN) { tr_item<0>(INP(I_WIN) + (size_t)l * D * N_IN, N_IN, WSP(bf16, WS_WINT) + (size_t)l * N_INP * D, D, 0, 0, 64 * (r / 69), 32 * (r % 69), scr, F.lane); continue; } r -= I_IN;
            bf16* up = WSP(bf16, WS_WUPT) + (size_t)l * N_UP * K_UP;
            if (r < I_UQ) { tr_item<0>(INP(I_WUQ) + (size_t)l * QLR * 768, 768, up, K_UP, 0, 0, 64 * (r / 24), 32 * (r % 24), scr, F.lane); continue; } r -= I_UQ;
            if (r < I_UK) { tr_item<0>(INP(I_WUK) + (size_t)l * KVLR * 512, 512, up, K_UP, 256, 768, 64 * (r / 16), 32 * (r % 16), scr, F.lane); continue; } r -= I_UK;
            if (r < I_UK) { tr_item<0>(INP(I_WUV) + (size_t)l * KVLR * 512, 512, up, K_UP, 256, 1280, 64 * (r / 16), 32 * (r % 16), scr, F.lane); continue; } r -= I_UK;
            bf16* sm = WSP(bf16, WS_WSMT) + (size_t)l * N_SM * K_SM;
            if (r < I_W2s) { tr_item<0>(INP(I_W2) + (size_t)l * 64 * 512, 512, sm, K_SM, 0, 0, 0, 32 * r, scr, F.lane); continue; } r -= I_W2s;
            if (r < I_W2s) { tr_item<0>(INP(I_A2) + (size_t)l * 64 * 512, 512, sm, K_SM, 64, 512, 0, 32 * r, scr, F.lane); continue; } r -= I_W2s;
            if (r < I_G2s) { tr_item<0>(INP(I_G2) + (size_t)l * 128 * 512, 512, sm, K_SM, 128, 1024, 64 * (r / 16), 32 * (r % 16), scr, F.lane); continue; } r -= I_G2s;
            tr_item<0>(INP(I_WO) + (size_t)l * D * D, D, WSP(bf16, WS_WOT) + (size_t)l * D * D, D, 0, 0, 64 * (r / 32), 32 * (r % 32), scr, F.lane); continue;
        }
        r -= NSMALL;
        if (r < NE1) { const int le = r / I_E1; r -= le * I_E1;
            tr_item<1>(INP(I_EW1) + (size_t)le * D * 2048, 2048, WSP(bf16, WS_W1T) + (size_t)le * 2048 * D, D, 0, 0, 64 * (r / 64), 32 * (r % 64), scr, F.lane); continue; }
        r -= NE1;
        { const int le = r / I_E2; r -= le * I_E2;
            tr_item<0>(INP(I_EW2) + (size_t)le * FF * D, D, WSP(bf16, WS_W2T) + (size_t)le * D * FF, FF, 0, 0, 64 * (r / 32), 32 * (r % 32), scr, F.lane); }
    }
    for (int l = 0; l < DEPTH; ++l) {
        zero_rect(F, WSP(bf16, WS_WINT) + (size_t)l * N_INP * D, D, N_IN, N_INP - N_IN, 0, D);
        bf16* up = WSP(bf16, WS_WUPT) + (size_t)l * N_UP * K_UP;
        zero_rect(F, up, K_UP, 0, 768, 256, 128); zero_rect(F, up, K_UP, 768, 1024, 0, 256);
        bf16* sm = WSP(bf16, WS_WSMT) + (size_t)l * N_SM * K_SM;
        zero_rect(F, sm, K_SM, 0, 512, 64, 192); zero_rect(F, sm, K_SM, 512, 512, 0, 64); zero_rect(F, sm, K_SM, 512, 512, 128, 128); zero_rect(F, sm, K_SM, 1024, 512, 0, 128);
    }
    const int gt = (F.vcu * NTHREADS) + F.tid, NGT = F.G * NTHREADS;
    { const float* v1 = INP(I_V1); const float* v2 = INP(I_V2); bf16* o = WSP(bf16, WS_WV12T);
      for (int i = gt; i < 512 * 512; i += NGT) { const int n = i >> 9, k = i & 511; float s = 0.f;
#pragma unroll 8
          for (int j = 0; j < 32; ++j) s += v1[k * 32 + j] * v2[j * 512 + n];
          o[i] = (bf16)f2bf(s); } }
    { const float* b1 = INP(I_EB1); float* o = WSP(float, WS_B1P);
      for (int i = gt; i < DEPTH * NE * 2048; i += NGT) { const int q = i & 2047, le = i >> 11; const int pn = q >> 8, bj = (q >> 7) & 1, jj = q & 127; o[i] = b1[(size_t)le * 2048 + 2 * (pn * 128 + jj) + bj]; } }
    { const int* pos = (const int*)p.in[I_POS]; float* cs = WSP(float, WS_CS);
      for (int i = gt; i < T * 16; i += NGT) { const int t = i >> 4, k = i & 15; const double a = (double)pos[t] * INV_FREQ[k];
          const double q = __builtin_rint(a * 0.63661977236758134308); const int qi = (int)((long long)q & 3);
          double r = __builtin_fma(-q, 1.57079632679489655800e+00, a); r = __builtin_fma(-q, 6.12323399573676603587e-17, r);
          const double r2 = r * r;
          double sn = -2.50521083854417187751e-08; sn = sn * r2 + 2.75573192239858906526e-06; sn = sn * r2 - 1.98412698412698412698e-04; sn = sn * r2 + 8.33333333333333333333e-03; sn = sn * r2 - 1.66666666666666666667e-01; sn = r + r * r2 * sn;
          double cn = 2.08767569878680989792e-09; cn = cn * r2 - 2.75573192239858906526e-07; cn = cn * r2 + 2.48015873015873015873e-05; cn = cn * r2 - 1.38888888888888888889e-03; cn = cn * r2 + 4.16666666666666666667e-02; cn = cn * r2 - 0.5; cn = 1.0 + r2 * cn;
          double sv, cv;
          if (qi == 0) { sv = sn; cv = cn; } else if (qi == 1) { sv = cn; cv = -sn; } else if (qi == 2) { sv = -sn; cv = -cn; } else { sv = -cn; cv = sn; }
          cs[2 * i] = (float)cv; cs[2 * i + 1] = (float)sv; } }
    { LAS float* cact = (LAS float*)(F.lds);
      LAS float* part = (LAS float*)(F.lds + 32768);
      __syncthreads();
      const float* c = INP(I_C);
      for (int i = F.tid; i < NBATCH * D; i += NTHREADS) { const float v = c[i]; cact[i] = v / (1.0f + __expf(-v)); }
      __syncthreads();
      for (int item = F.vcu; item < DEPTH * 96; item += F.G) { const int l = item / 96, n0 = (item % 96) * 64;
          const float* aw = INP(I_ADAW) + (size_t)l * D * 6144 + n0 + F.lane;
          float a8[8];
#pragma unroll
          for (int b = 0; b < 8; ++b) a8[b] = 0.f;
          const int kb = F.wave * 128;
#pragma unroll 4
          for (int k = 0; k < 128; ++k) { const float wv = aw[(size_t)(kb + k) * 6144];
#pragma unroll
              for (int b = 0; b < 8; ++b) a8[b] += cact[b * D + kb + k] * wv; }
#pragma unroll
          for (int b = 0; b < 8; ++b) part[(F.wave * 8 + b) * 64 + F.lane] = a8[b];
          __syncthreads();
          { const int b = F.wave; float s = 0.f;
#pragma unroll
            for (int w = 0; w < 8; ++w) s += part[(w * 8 + b) * 64 + F.lane];
            WSP(float, WS_MOD)[((size_t)l * NBATCH + b) * 6144 + n0 + F.lane] = s + INP(I_ADAB)[(size_t)l * 6144 + n0 + F.lane]; }
          __syncthreads(); }
    }
}

__device__ __forceinline__ void phase_ln0(const Params& p, const Frame& F) {
    const int gw = F.vcu * NWAVES + F.wave, NGW = F.G * NWAVES;
    const float* mod = WSP(float, WS_MOD);
    for (int m = gw; m < T; m += NGW) {
        const int b = m / SEQ;
        const GAS f32x4* xr = (const GAS f32x4*)(INP(I_X) + (size_t)m * D) + F.lane;
        f32x4 v[4]; float s = 0.f;
#pragma unroll
        for (int j = 0; j < 4; ++j) { v[j] = xr[64 * j]; s += (v[j].x + v[j].y) + (v[j].z + v[j].w); }
        const float mean = wave_sum(s) * (1.f / D); float s2 = 0.f;
#pragma unroll
        for (int j = 0; j < 4; ++j) { v[j] = v[j] - mean; s2 += (v[j].x * v[j].x + v[j].y * v[j].y) + (v[j].z * v[j].z + v[j].w * v[j].w); }
        const float rstd = 1.f / sqrtf(wave_sum(s2) * (1.f / D) + LN_EPS);
        GAS f32x4* xo = (GAS f32x4*)(WSP(float, WS_X) + (size_t)m * D) + F.lane;
        GAS u32x2* ho = (GAS u32x2*)(WSP(bf16, WS_H) + (size_t)m * D) + F.lane;
#pragma unroll
        for (int j = 0; j < 4; ++j) { const int c = 4 * F.lane + 256 * j;
            const f32x4 g = *(const f32x4*)(INP(I_ELNG) + c), be = *(const f32x4*)(INP(I_ELNB) + c);
            const f32x4 x0 = v[j] * rstd * g + be; xo[64 * j] = x0;
            const f32x4 sh = *(const f32x4*)(mod + (size_t)b * 6144 + c), sc = *(const f32x4*)(mod + (size_t)b * 6144 + 1024 + c);
            const f32x4 h = x0 * (sc + 1.0f) + sh; u32x2 w; w.x = pk2(h.x, h.y); w.y = pk2(h.z, h.w); ho[64 * j] = w; }
    }
}

__device__ __forceinline__ void phase_prep(const Params& p, const Frame& F, int l) {
    const int gw = F.vcu * NWAVES + F.wave, NGW = F.G * NWAVES; const int lane = F.lane;
    const bf16* P = WSP(bf16, WS_P); const float* mu = INP(I_MU) + (size_t)l * RWKV_IN;
    const float* qg = INP(I_QNG) + (size_t)l * QLR; const float* kvg = INP(I_KVNG) + (size_t)l * KVLR;
    bf16* AN = WSP(bf16, WS_AN); bf16* A2 = WSP(bf16, WS_A2); bf16* RK = WSP(bf16, WS_RK); bf16* KKb = WSP(bf16, WS_KK);
    bf16* VS = l == 0 ? WSP(bf16, WS_VS0) : WSP(bf16, WS_VS1);
    const float* cs = WSP(float, WS_CS);
    for (int t = gw; t < T; t += NGW) {
        const bf16* pr = P + (size_t)t * N_INP; const bool first = (t % SEQ) == 0; const bf16* pp = pr - N_INP;
        { const u32x2 qw = *(const u32x2*)(pr + 4 * lane); float q0 = bflo(qw.x), q1 = bfhi(qw.x), q2 = bflo(qw.y), q3 = bfhi(qw.y);
          const float rq = 1.f / sqrtf(wave_sum(q0 * q0 + q1 * q1 + q2 * q2 + q3 * q3) * (1.f / QLR) + RMS_EPS);
          const f32x4 g = *(const f32x4*)(qg + 4 * lane);
          u32x2 w; w.x = pk2(q0 * rq * g.x, q1 * rq * g.y); w.y = pk2(q2 * rq * g.z, q3 * rq * g.w); *(u32x2*)(AN + (size_t)t * K_UP + 4 * lane) = w;
          const unsigned kw = *(const unsigned*)(pr + QLR + 2 * lane); const float k0 = bflo(kw), k1 = bfhi(kw);
          const float rk = 1.f / sqrtf(wave_sum(k0 * k0 + k1 * k1) * (1.f / KVLR) + RMS_EPS);
          const f32x2 g2 = *(const f32x2*)(kvg + 2 * lane);
          *(unsigned*)(AN + (size_t)t * K_UP + QLR + 2 * lane) = pk2(k0 * rk * g2.x, k1 * rk * g2.y);
          const int i = lane & 15; const unsigned rw = *(const unsigned*)(pr + QLR + KVLR + 2 * i); const float x0 = bflo(rw), x1 = bfhi(rw);
          const f32x2 csv = *(const f32x2*)(cs + (size_t)t * 32 + 2 * i); const unsigned ro = pk2(x0 * csv.x - x1 * csv.y, x0 * csv.y + x1 * csv.x);
          const int h0 = (lane >> 4) * 2;
          *(unsigned*)(KKb + (size_t)t * 768 + h0 * QKD + NOPE + 2 * i) = ro; *(unsigned*)(KKb + (size_t)t * 768 + (h0 + 1) * QKD + NOPE + 2 * i) = ro; }
        const bf16* rr = pr + MLA_IN; const bf16* rp = pp + MLA_IN;
#pragma unroll
        for (int part = 0; part < 3; ++part) {
            const int c = part * 512 + 8 * lane; const u32x4 cw = *(const u32x4*)(rr + c); u32x4 pw = (u32x4){0u, 0u, 0u, 0u}; if (!first) pw = *(const u32x4*)(rp + c);
            const f32x4 m0 = *(const f32x4*)(mu + c), m1 = *(const f32x4*)(mu + c + 4);
            float o[8];
#pragma unroll
            for (int j = 0; j < 4; ++j) { const float a = bflo(cw[j]), b = bfhi(cw[j]), pa = bflo(pw[j]), pb = bfhi(pw[j]); const float ma = j < 2 ? m0[2 * j] : m1[2 * j - 4], mb = j < 2 ? m0[2 * j + 1] : m1[2 * j - 3];
                o[2 * j] = a + ma * (pa - a); o[2 * j + 1] = b + mb * (pb - b); }
            u32x4 w; w.x = pk2(o[0], o[1]); w.y = pk2(o[2], o[3]); w.z = pk2(o[4], o[5]); w.w = pk2(o[6], o[7]);
            if (part < 2) *(u32x4*)(RK + (size_t)t * 1024 + part * 512 + 8 * lane) = w; else *(u32x4*)(VS + (size_t)t * C5 + 8 * lane) = w;
        }
        { const int c = 1536 + lane; const float a = bf2f(rr[c]), pa = first ? 0.f : bf2f(rp[c]); const float v = a + mu[c] * (pa - a); A2[(size_t)t * K_SM + lane] = (bf16)f2bf(tanhf(v)); }
        { const int c = 1600 + lane; const float a = bf2f(rr[c]), pa = first ? 0.f : bf2f(rp[c]); const float v = a + mu[c] * (pa - a); A2[(size_t)t * K_SM + 64 + lane] = (bf16)f2bf(v); }
        { const int c = 1664 + 2 * lane; const unsigned cw = *(const unsigned*)(rr + c); const unsigned pw = first ? 0u : *(const unsigned*)(rp + c);
          const f32x2 m = *(const f32x2*)(mu + c); const float a = bflo(cw), b = bfhi(cw); const float va = a + m.x * (bflo(pw) - a), vb = b + m.y * (bfhi(pw) - b);
          *(unsigned*)(A2 + (size_t)t * K_SM + 128 + 2 * lane) = pk2(sigmoidf_(va), sigmoidf_(vb)); }
    }
}

namespace att {
__device__ __forceinline__ int crow(int r, int hi) { return (r & 3) + 8 * (r >> 2) + 4 * hi; }
constexpr int KSLOT = 12288, VSLOT = 8192;
constexpr int LDS_K = 0, LDS_V = 2 * KSLOT, LDS_WS = LDS_V + 2 * VSLOT, LDS_OST = LDS_WS + NWAVES * 64 * 4, LDS_TOTAL = LDS_OST + NWAVES * 4096;
__device__ __forceinline__ void glds16(const void* gsrc, unsigned lds_dst) { unsigned keep;
    asm volatile("s_mov_b32 %0, m0\n\ts_mov_b32 m0, %2\n\ts_nop 0\n\tglobal_load_lds_dwordx4 %1, off\n\ts_mov_b32 m0, %0" : "=&s"(keep) : "v"(gsrc), "s"(lds_dst) : "memory"); }
__device__ __forceinline__ float max3f(float a, float b, float c) { return fmaxf(fmaxf(a, b), c); }
#define ATT_WAIT_BAR() asm volatile("s_waitcnt vmcnt(0) lgkmcnt(0)\n\ts_barrier" ::: "memory")
__device__ __forceinline__ float rowmax(const f32x16& p0, const f32x16& p1) {
    float a = max3f(p0[0], p0[1], p1[0]), b = max3f(p0[2], p0[3], p1[1]); a = max3f(a, p1[2], p1[3]);
#pragma unroll
    for (int r = 4; r < 16; r += 4) { a = max3f(a, p0[r], p0[r + 1]); b = max3f(b, p0[r + 2], p0[r + 3]); a = max3f(a, p1[r], p1[r + 1]); b = max3f(b, p1[r + 2], p1[r + 3]); }
    const float m = fmaxf(a, b);
    auto rr = __builtin_amdgcn_permlane32_swap(__float_as_uint(m), __float_as_uint(m), false, false);
    return fmaxf(__uint_as_float(rr[0]), __uint_as_float(rr[1]));
}
__device__ __forceinline__ void pv(f32x16* o, int vb, bf16x8 pa0, bf16x8 pa1, bf16x8 pa2, bf16x8 pa3) {
#pragma unroll
    for (int d0 = 0; d0 < 2; ++d0) { s16x4 lo[4], hi[4];
#pragma unroll
        for (int ks = 0; ks < 4; ++ks) {
            asm volatile("ds_read_b64_tr_b16 %0,%1 offset:%c2" : "=&v"(lo[ks]) : "v"(vb), "i"(d0 * 4096 + ks * 1024) : "memory");
            asm volatile("ds_read_b64_tr_b16 %0,%1 offset:%c2" : "=&v"(hi[ks]) : "v"(vb), "i"(d0 * 4096 + ks * 1024 + 512) : "memory"); }
        asm volatile("s_waitcnt lgkmcnt(0)" ::: "memory"); __builtin_amdgcn_sched_barrier(0);
#define PK(k) (bf16x8){lo[k][0], lo[k][1], lo[k][2], lo[k][3], hi[k][0], hi[k][1], hi[k][2], hi[k][3]}
        o[d0] = __builtin_amdgcn_mfma_f32_32x32x16_bf16(pa0, PK(0), o[d0], 0, 0, 0);
        o[d0] = __builtin_amdgcn_mfma_f32_32x32x16_bf16(pa1, PK(1), o[d0], 0, 0, 0);
        o[d0] = __builtin_amdgcn_mfma_f32_32x32x16_bf16(pa2, PK(2), o[d0], 0, 0, 0);
        o[d0] = __builtin_amdgcn_mfma_f32_32x32x16_bf16(pa3, PK(3), o[d0], 0, 0, 0);
#undef PK
    }
}
__device__ __forceinline__ void attn_unit(int b, int h, int qb, const bf16* Q, const bf16* __restrict__ KKp, const bf16* __restrict__ Vp, bf16* O, char* shm) {
    const int tid = threadIdx.x, lane = tid & 63, r32 = lane & 31, hi = lane >> 5; const int wid = __builtin_amdgcn_readfirstlane(tid >> 6);
    const long rowbase = (long)b * SEQ; const int q0 = qb * 256;
    const bf16* Qw = Q + (rowbase + q0 + wid * 32) * 768 + h * QKD;
    const bf16* Kh = KKp + rowbase * 768 + h * QKD; const bf16* Vh = Vp + rowbase * 512 + h * VD;
    const unsigned lds0 = (unsigned)(uintptr_t)shm;
    float* wsf = (float*)(shm + LDS_WS) + wid * 64;
    const bf16* ksrc0 = Kh + (long)lane * 768 + wid * 8;
    const bf16* ksrc1 = Kh + (long)lane * 768 + (8 + (wid & 3)) * 8;
    const bf16* vsrc = Vh + (long)(16 * (wid & 3) + (lane >> 2)) * 512 + (wid >> 2) * 32 + (lane & 3) * 8;
    const unsigned kdst0 = lds0 + LDS_K + wid * 1024, kdst1 = lds0 + LDS_K + (8 + (wid & 3)) * 1024, vdst = lds0 + LDS_V + wid * 1024;
#define DMA_KV(t, s) do { glds16(ksrc0 + (long)(t) * 64 * 768, (unsigned)__builtin_amdgcn_readfirstlane(kdst0 + (s) * KSLOT)); \
        if (wid < 4) glds16(ksrc1 + (long)(t) * 64 * 768, (unsigned)__builtin_amdgcn_readfirstlane(kdst1 + (s) * KSLOT)); \
        glds16(vsrc + (long)(t) * 64 * 512, (unsigned)__builtin_amdgcn_readfirstlane(vdst + (s) * VSLOT)); } while (0)
    const int vb0 = (int)(lds0 + LDS_V) + ((lane >> 4) & 1) * 32 + (lane & 3) * 8 + (4 * hi + ((lane & 15) >> 2)) * 64;
    const int NT = (q0 + 256) / 64;
    DMA_KV(0, 0);
    bf16x8 qr[6];
#pragma unroll
    for (int d0 = 0; d0 < 6; ++d0) qr[d0] = *reinterpret_cast<const bf16x8*>(&Qw[(long)r32 * 768 + d0 * 16 + hi * 8]);
    float mrun = -INFINITY, l_reg = 0.f; f32x16 o[2]; o[0] = f32x16{}; o[1] = f32x16{};
    const int qrel = wid * 32 + r32;
    for (int t = 0; t < NT; ++t) {
        ATT_WAIT_BAR();
        if (t + 1 < NT) DMA_KV(t + 1, (t + 1) & 1);
        const char* Kslot = shm + LDS_K + (t & 1) * KSLOT;
        f32x16 p0 = f32x16{}, p1 = f32x16{};
        { const char* kb = Kslot + hi * 1024 + r32 * 16;
#pragma unroll
          for (int d0 = 0; d0 < 6; ++d0) { const bf16x8 b0 = *reinterpret_cast<const bf16x8*>(kb + d0 * 2048); const bf16x8 b1 = *reinterpret_cast<const bf16x8*>(kb + d0 * 2048 + 512);
              p0 = __builtin_amdgcn_mfma_f32_32x32x16_bf16(b0, qr[d0], p0, 0, 0, 0); p1 = __builtin_amdgcn_mfma_f32_32x32x16_bf16(b1, qr[d0], p1, 0, 0, 0); } }
        const int jb = t - (NT - 4);
        if (jb >= 0) { const int kbase = 64 * jb + 4 * hi;
#pragma unroll
            for (int r = 0; r < 16; ++r) { const int kv = kbase + (r & 3) + 8 * (r >> 2); if (kv > qrel) p0[r] = -INFINITY; if (kv + 32 > qrel) p1[r] = -INFINITY; } }
        const float rm = rowmax(p0, p1); const float mnew = fmaxf(mrun, rm); const float f = exp2f(mrun - mnew); mrun = mnew;
        float sacc = 0.f;
#pragma unroll
        for (int r = 0; r < 16; ++r) { p0[r] = exp2f(p0[r] - mnew); p1[r] = exp2f(p1[r] - mnew); sacc += p0[r] + p1[r]; }
        l_reg = l_reg * f + sacc;
        if (hi == 0) wsf[r32] = f;
        asm volatile("s_waitcnt lgkmcnt(0)" ::: "memory");
#pragma unroll
        for (int r = 0; r < 16; ++r) { const float fr_ = wsf[crow(r, hi)]; o[0][r] *= fr_; o[1][r] *= fr_; }
        u32x4 pw0, pw1, pw2, pw3;
        pw0 = (u32x4){cvt_pk_bf16(p0[0], p0[1]), cvt_pk_bf16(p0[2], p0[3]), cvt_pk_bf16(p0[4], p0[5]), cvt_pk_bf16(p0[6], p0[7])};
        pw1 = (u32x4){cvt_pk_bf16(p0[8], p0[9]), cvt_pk_bf16(p0[10], p0[11]), cvt_pk_bf16(p0[12], p0[13]), cvt_pk_bf16(p0[14], p0[15])};
        pw2 = (u32x4){cvt_pk_bf16(p1[0], p1[1]), cvt_pk_bf16(p1[2], p1[3]), cvt_pk_bf16(p1[4], p1[5]), cvt_pk_bf16(p1[6], p1[7])};
        pw3 = (u32x4){cvt_pk_bf16(p1[8], p1[9]), cvt_pk_bf16(p1[10], p1[11]), cvt_pk_bf16(p1[12], p1[13]), cvt_pk_bf16(p1[14], p1[15])};
        asm volatile("s_waitcnt lgkmcnt(0)" ::: "memory");
        pv(o, vb0 + (t & 1) * VSLOT, __builtin_bit_cast(bf16x8, pw0), __builtin_bit_cast(bf16x8, pw1), __builtin_bit_cast(bf16x8, pw2), __builtin_bit_cast(bf16x8, pw3));
    }
    { auto rr = __builtin_amdgcn_permlane32_swap(__float_as_uint(l_reg), __float_as_uint(l_reg), false, false); l_reg = __uint_as_float(rr[0]) + __uint_as_float(rr[1]); }
    if (hi == 0) wsf[32 + r32] = l_reg; asm volatile("s_waitcnt lgkmcnt(0)" ::: "memory");
    float rli[16];
#pragma unroll
    for (int r = 0; r < 16; ++r) rli[r] = 1.0f / wsf[32 + crow(r, hi)];
    bf16* Ow = O + (rowbase + q0 + wid * 32) * 512 + h * VD;
    { bf16* stg = (bf16*)(shm + LDS_OST) + wid * 2048;
#pragma unroll
      for (int r = 0; r < 16; ++r) { const int orow = crow(r, hi);
#pragma unroll
          for (int d0 = 0; d0 < 2; ++d0) stg[orow * 64 + d0 * 32 + r32] = (bf16)f2bf(o[d0][r] * rli[r]); }
      asm volatile("s_waitcnt lgkmcnt(0)" ::: "memory");
#pragma unroll
      for (int i = 0; i < 4; ++i) { const int row = i * 8 + (lane >> 3), ch = lane & 7; const u32x4 v = *(const u32x4*)(stg + row * 64 + ch * 8); *(u32x4*)(Ow + (long)row * 512 + ch * 8) = v; } }
    asm volatile("s_waitcnt vmcnt(0) lgkmcnt(0)\n\ts_barrier" ::: "memory");
#undef DMA_KV
}
}

__device__ __forceinline__ void phase_attn(const Params& p, const Frame& F, char* lds_generic) {
    const bf16* Q = WSP(bf16, WS_Q); const bf16* KKp = WSP(bf16, WS_KK); const bf16* Vp = WSP(bf16, WS_V); bf16* O = WSP(bf16, WS_O);
    for (int u = F.vcu; u < 256; u += F.G) { const int bh = u >> 2, s = u & 3;
#pragma unroll 1
        for (int i = 0; i < 4; ++i) { const int qb = (i == 0) ? s : (i == 1) ? 7 - s : (i == 2) ? 8 + s : 15 - s;
            att::attn_unit(bh >> 3, bh & 7, qb, Q, KKp, Vp, O, lds_generic); } }
}

__device__ __forceinline__ float dpp_add(float x, const int ctrl_sel) { return x; }
#define DPP_F(x, ctrl) __builtin_bit_cast(float, __builtin_amdgcn_update_dpp(0, __builtin_bit_cast(int, (x)), (ctrl), 0xF, 0xF, true))
__device__ __forceinline__ float row16_sum(float x) {
    x += DPP_F(x, 0xB1);
    x += DPP_F(x, 0x4E);
    x += DPP_F(x, 0x141);
    x += DPP_F(x, 0x140);
    return x;
}
__device__ __forceinline__ void phase_rwkv(const Params& p, const Frame& F, int l) {
    constexpr int TC = 64;
    LAS float* sK = (LAS float*)(F.lds);
    LAS float* sB = sK + TC * 64;
    LAS float* sKp = sB + TC * 64;
    LAS float* sWR = sKp + TC * 64;
    LAS float* sW = sWR + TC * 64;
    LAS float* sV = sW + TC * 64;
    LAS float* sC = sV + TC * 32;
    LAS float* sO = sC + TC * 2;
    const bf16* RK = WSP(bf16, WS_RK); const float* WAG = WSP(float, WS_WAG);
    const bf16* Vv = l == 0 ? WSP(bf16, WS_VS0) : WSP(bf16, WS_VR);
    float* RO = WSP(float, WS_RO);
    const float* kkw = INP(I_KK) + (size_t)l * C5; const float* kaw = INP(I_KA) + (size_t)l * C5;
    const int tid = F.tid, lane = F.lane, wave = F.wave;
    for (int u = F.vcu; u < 128; u += F.G) {
        const int bh = u >> 1, half = u & 1, b = bh >> 3, h = bh & 7;
        const size_t row0 = (size_t)b * SEQ;
        float s0 = 0.f, s1 = 0.f, s2 = 0.f, s3 = 0.f;
        const int rsub = lane >> 4, jg = lane & 15, myrow = wave * 4 + rsub;
        for (int ch = 0; ch < SEQ / TC; ++ch) {
            __syncthreads();
            { const int t = tid >> 3, j8 = tid & 7; const size_t tok = row0 + ch * TC + t; const int c = h * 64 + 8 * j8;
              const u32x4 rw = *(const u32x4*)(RK + tok * 1024 + c), kw = *(const u32x4*)(RK + tok * 1024 + 512 + c);
              const f32x4 d0 = *(const f32x4*)(WAG + tok * N_SM + c), d1 = *(const f32x4*)(WAG + tok * N_SM + c + 4);
              const f32x4 a0 = *(const f32x4*)(WAG + tok * N_SM + 512 + c), a1 = *(const f32x4*)(WAG + tok * N_SM + 512 + c + 4);
              const f32x4 kk0 = *(const f32x4*)(kkw + c), kk1 = *(const f32x4*)(kkw + c + 4), ka0 = *(const f32x4*)(kaw + c), ka1 = *(const f32x4*)(kaw + c + 4);
              float r[8], k[8], a[8], d[8], kk[8]; float ss = 0.f;
#pragma unroll
              for (int j = 0; j < 4; ++j) { r[2 * j] = bflo(rw[j]); r[2 * j + 1] = bfhi(rw[j]); k[2 * j] = bflo(kw[j]); k[2 * j + 1] = bfhi(kw[j]); }
#pragma unroll
              for (int j = 0; j < 8; ++j) { a[j] = j < 4 ? a0[j & 3] : a1[j & 3]; d[j] = j < 4 ? d0[j & 3] : d1[j & 3]; kk[j] = k[j] * (j < 4 ? kk0[j & 3] : kk1[j & 3]); ss += kk[j] * kk[j]; }
              ss += __shfl_xor(ss, 1); ss += __shfl_xor(ss, 2); ss += __shfl_xor(ss, 4);
              const float inv = 1.0f / fmaxf(sqrtf(ss), 1e-12f);
              float c1 = 0.f, c2 = 0.f;
#pragma unroll
              for (int j = 0; j < 8; ++j) { const float kap = kk[j] * inv, be = kap * a[j], kp = k[j] * (1.0f + (a[j] - 1.0f) * (j < 4 ? ka0[j & 3] : ka1[j & 3]));
                  const int o = t * 64 + 8 * j8 + j; sK[o] = kap; sB[o] = be; sKp[o] = kp; sWR[o] = d[j] * r[j]; sW[o] = d[j]; c1 += be * r[j]; c2 += kp * r[j]; }
              c1 += __shfl_xor(c1, 1); c1 += __shfl_xor(c1, 2); c1 += __shfl_xor(c1, 4); c2 += __shfl_xor(c2, 1); c2 += __shfl_xor(c2, 2); c2 += __shfl_xor(c2, 4);
              if (j8 == 0) { sC[2 * t] = c1; sC[2 * t + 1] = c2; }
              const u32x2 vw = *(const u32x2*)(Vv + tok * C5 + h * 64 + half * 32 + 4 * j8);
              sV[t * 32 + 4 * j8] = bflo(vw.x); sV[t * 32 + 4 * j8 + 1] = bfhi(vw.x); sV[t * 32 + 4 * j8 + 2] = bflo(vw.y); sV[t * 32 + 4 * j8 + 3] = bfhi(vw.y); }
            __syncthreads();
#pragma unroll 4
            for (int t = 0; t < TC; ++t) {
                const f32x4 ka = *(const LAS f32x4*)(sK + t * 64 + 4 * jg), wr4 = *(const LAS f32x4*)(sWR + t * 64 + 4 * jg), w4 = *(const LAS f32x4*)(sW + t * 64 + 4 * jg);
                const f32x4 be = *(const LAS f32x4*)(sB + t * 64 + 4 * jg), kp = *(const LAS f32x4*)(sKp + t * 64 + 4 * jg);
                const float vi = sV[t * 32 + myrow]; const f32x2 cc = *(const LAS f32x2*)(sC + 2 * t);
                float d1 = (s0 * ka.x + s1 * ka.y) + (s2 * ka.z + s3 * ka.w), d2 = (s0 * wr4.x + s1 * wr4.y) + (s2 * wr4.z + s3 * wr4.w);
                d1 = row16_sum(d1); d2 = row16_sum(d2);
                const float sa = -d1; const float ov = d2 + sa * cc.x + vi * cc.y;
                s0 = s0 * w4.x + sa * be.x + vi * kp.x; s1 = s1 * w4.y + sa * be.y + vi * kp.y; s2 = s2 * w4.z + sa * be.z + vi * kp.z; s3 = s3 * w4.w + sa * be.w + vi * kp.w;
                if (jg == 0) sO[t * 32 + myrow] = ov;
            }
            __syncthreads();
            for (int i = tid; i < TC * 32; i += NTHREADS) { const int t = i >> 5, r = i & 31; RO[(row0 + ch * TC + t) * C5 + h * 64 + half * 32 + r] = sO[i]; }
        }
    }
    __syncthreads();
}

__device__ __forceinline__ void phase_mix(const Params& p, const Frame& F, int l) {
    const int gw = F.vcu * NWAVES + F.wave, NGW = F.G * NWAVES; const int lane = F.lane;
    const bf16* O = WSP(bf16, WS_O); const float* RO = WSP(float, WS_RO); const bf16* RK = WSP(bf16, WS_RK); const float* WAG = WSP(float, WS_WAG);
    const bf16* Vv = l == 0 ? WSP(bf16, WS_VS0) : WSP(bf16, WS_VR); bf16* MIX = WSP(bf16, WS_MIX);
    const float* og = INP(I_MOUTG) + (size_t)l * C5; const float* gng = INP(I_GNG) + (size_t)l * C5; const float* gnb = INP(I_GNB) + (size_t)l * C5;
    const float* kaw = INP(I_KA) + (size_t)l * C5; const float* rkw = INP(I_RK) + (size_t)l * C5;
    for (int t = gw; t < T; t += NGW) {
        const int c = 8 * lane;
        { const u32x4 ow = *(const u32x4*)(O + (size_t)t * C5 + c); float o[8]; float ss = 0.f;
#pragma unroll
          for (int j = 0; j < 4; ++j) { o[2 * j] = bflo(ow[j]); o[2 * j + 1] = bfhi(ow[j]); ss += o[2 * j] * o[2 * j] + o[2 * j + 1] * o[2 * j + 1]; }
          const float rs = 1.f / sqrtf(wave_sum(ss) * (1.f / C5) + RMS_EPS);
          const f32x4 g0 = *(const f32x4*)(og + c), g1 = *(const f32x4*)(og + c + 4);
          u32x4 w; w.x = pk2(o[0] * rs * g0.x, o[1] * rs * g0.y); w.y = pk2(o[2] * rs * g0.z, o[3] * rs * g0.w); w.z = pk2(o[4] * rs * g1.x, o[5] * rs * g1.y); w.w = pk2(o[6] * rs * g1.z, o[7] * rs * g1.w);
          *(u32x4*)(MIX + (size_t)t * D + c) = w; }
        { const f32x4 r0 = *(const f32x4*)(RO + (size_t)t * C5 + c), r1 = *(const f32x4*)(RO + (size_t)t * C5 + c + 4);
          float o[8]; float s = 0.f;
#pragma unroll
          for (int j = 0; j < 8; ++j) { o[j] = j < 4 ? r0[j & 3] : r1[j & 3]; s += o[j]; }
          s += __shfl_xor(s, 1); s += __shfl_xor(s, 2); s += __shfl_xor(s, 4); const float mean = s * (1.f / 64.f); float q = 0.f;
#pragma unroll
          for (int j = 0; j < 8; ++j) { o[j] -= mean; q += o[j] * o[j]; }
          q += __shfl_xor(q, 1); q += __shfl_xor(q, 2); q += __shfl_xor(q, 4); const float rstd = 1.f / sqrtf(q * (1.f / 64.f) + GN_EPS);
          const u32x4 rw = *(const u32x4*)(RK + (size_t)t * 1024 + c), kw = *(const u32x4*)(RK + (size_t)t * 1024 + 512 + c), vw = *(const u32x4*)(Vv + (size_t)t * C5 + c);
          const f32x4 a0 = *(const f32x4*)(WAG + (size_t)t * N_SM + 512 + c), a1 = *(const f32x4*)(WAG + (size_t)t * N_SM + 512 + c + 4);
          const f32x4 g0 = *(const f32x4*)(WAG + (size_t)t * N_SM + 1024 + c), g1 = *(const f32x4*)(WAG + (size_t)t * N_SM + 1024 + c + 4);
          const f32x4 ka0 = *(const f32x4*)(kaw + c), ka1 = *(const f32x4*)(kaw + c + 4), rk0 = *(const f32x4*)(rkw + c), rk1 = *(const f32x4*)(rkw + c + 4);
          const f32x4 gg0 = *(const f32x4*)(gng + c), gg1 = *(const f32x4*)(gng + c + 4), gb0 = *(const f32x4*)(gnb + c), gb1 = *(const f32x4*)(gnb + c + 4);
          float r[8], k[8], v[8]; float bon = 0.f;
#pragma unroll
          for (int j = 0; j < 4; ++j) { r[2 * j] = bflo(rw[j]); r[2 * j + 1] = bfhi(rw[j]); k[2 * j] = bflo(kw[j]); k[2 * j + 1] = bfhi(kw[j]); v[2 * j] = bflo(vw[j]); v[2 * j + 1] = bfhi(vw[j]); }
#pragma unroll
          for (int j = 0; j < 8; ++j) { const float a = j < 4 ? a0[j & 3] : a1[j & 3]; const float kp = k[j] * (1.0f + (a - 1.0f) * (j < 4 ? ka0[j & 3] : ka1[j & 3])); bon += r[j] * kp * (j < 4 ? rk0[j & 3] : rk1[j & 3]); }
          bon += __shfl_xor(bon, 1); bon += __shfl_xor(bon, 2); bon += __shfl_xor(bon, 4);
          float y[8];
#pragma unroll
          for (int j = 0; j < 8; ++j) { const float gn = o[j] * rstd * (j < 4 ? gg0[j & 3] : gg1[j & 3]) + (j < 4 ? gb0[j & 3] : gb1[j & 3]); y[j] = (gn + bon * v[j]) * (j < 4 ? g0[j & 3] : g1[j & 3]); }
          u32x4 w; w.x = pk2(y[0], y[1]); w.y = pk2(y[2], y[3]); w.z = pk2(y[4], y[5]); w.w = pk2(y[6], y[7]);
          *(u32x4*)(MIX + (size_t)t * D + C5 + c) = w; }
    }
}

__device__ __forceinline__ void phase_ln1_route(const Params& p, const Frame& F, int l) {
    LAS float* hrow = (LAS float*)(F.lds) + F.wave * D;
    LAS int* hist = (LAS int*)(F.lds + 65536);
    LAS int* basep = hist + 32;
    LAS int* rinfo = hist + 64;
    LAS float* rgate = (LAS float*)(rinfo + 512);
    const float* mod = WSP(float, WS_MOD) + (size_t)l * NBATCH * 6144;
    const float* g1 = INP(I_LN1G) + (size_t)l * D; const float* b1 = INP(I_LN1B) + (size_t)l * D;
    const float* rwt = INP(I_RW) + (size_t)l * D * NE; const float* rb = INP(I_RB) + (size_t)l * NE;
    unsigned* cnt = (unsigned*)(F.ws + WS_CTL) + CW_CNT + l * 64;
    int* LIST = WSP(int, WS_LIST); float* GATEL = WSP(float, WS_GATEL); int* TOKSLOT = WSP(int, WS_TOKSLOT);
    const int lane = F.lane;
    for (int chunk = F.vcu; chunk < T / 128; chunk += F.G) {
        __syncthreads();
        if (F.tid < 32) hist[F.tid] = 0;
        __syncthreads();
        for (int rr = 0; rr < 16; ++rr) {
            const int lr = F.wave * 16 + rr; const int m = chunk * 128 + lr; const int b = m / SEQ;
            GAS f32x4* xr = (GAS f32x4*)(WSP(float, WS_X) + (size_t)m * D) + lane;
            f32x4 v[4]; float s = 0.f;
#pragma unroll
            for (int j = 0; j < 4; ++j) { v[j] = xr[64 * j]; s += (v[j].x + v[j].y) + (v[j].z + v[j].w); }
            const float mean = wave_sum(s) * (1.f / D); float s2 = 0.f;
#pragma unroll
            for (int j = 0; j < 4; ++j) { v[j] = v[j] - mean; s2 += (v[j].x * v[j].x + v[j].y * v[j].y) + (v[j].z * v[j].z + v[j].w * v[j].w); }
            const float rstd = 1.f / sqrtf(wave_sum(s2) * (1.f / D) + LN_EPS);
            GAS u32x2* ho = (GAS u32x2*)(WSP(bf16, WS_H) + (size_t)m * D) + lane;
#pragma unroll
            for (int j = 0; j < 4; ++j) { const int c = 4 * lane + 256 * j;
                const f32x4 g = *(const f32x4*)(g1 + c), be = *(const f32x4*)(b1 + c);
                const f32x4 x1 = v[j] * rstd * g + be; xr[64 * j] = x1;
                const f32x4 sh = *(const f32x4*)(mod + (size_t)b * 6144 + 3072 + c), sc = *(const f32x4*)(mod + (size_t)b * 6144 + 4096 + c);
                const f32x4 h = x1 * (sc + 1.0f) + sh; u32x2 w; w.x = pk2(h.x, h.y); w.y = pk2(h.z, h.w); ho[64 * j] = w;
                *(LAS f32x4*)(hrow + c) = h; }
            LDS_WAIT(); asm volatile("" ::: "memory");
            const int e = lane & 31, kh = lane >> 5; float acc0 = 0.f, acc1 = 0.f;
            const float* rwp = rwt + (size_t)(kh * 512) * NE + e; const LAS float* hp = hrow + kh * 512;
#pragma unroll 4
            for (int k = 0; k < 512; k += 4) { const f32x4 hv = *(const LAS f32x4*)(hp + k);
                acc0 += hv.x * rwp[(size_t)(k + 0) * NE]; acc1 += hv.y * rwp[(size_t)(k + 1) * NE]; acc0 += hv.z * rwp[(size_t)(k + 2) * NE]; acc1 += hv.w * rwp[(size_t)(k + 3) * NE]; }
            float logit = acc0 + acc1; logit += __shfl_xor(logit, 32); logit += rb[e];
            float val = logit; float tv0 = 0.f, tv1 = 0.f, tv2 = 0.f, tv3 = 0.f; int te0 = 0, te1 = 0, te2 = 0, te3 = 0;
#pragma unroll
            for (int k = 0; k < 4; ++k) { float mx = val;
#pragma unroll
                for (int o = 1; o < 32; o <<= 1) mx = fmaxf(mx, __shfl_xor(mx, o));
                const unsigned long long bal = __ballot(val == mx && lane < 32); const int ek = __builtin_ctzll(bal);
                if (k == 0) { tv0 = mx; te0 = ek; } else if (k == 1) { tv1 = mx; te1 = ek; } else if (k == 2) { tv2 = mx; te2 = ek; } else { tv3 = mx; te3 = ek; }
                if (e == ek) val = -INFINITY; }
            const float e0 = 1.0f, e1 = __expf(tv1 - tv0), e2 = __expf(tv2 - tv0), e3 = __expf(tv3 - tv0); const float inv = 1.0f / (e0 + e1 + e2 + e3);
            if (lane < 4) { const int ek = lane == 0 ? te0 : lane == 1 ? te1 : lane == 2 ? te2 : te3; const float gk = (lane == 0 ? e0 : lane == 1 ? e1 : lane == 2 ? e2 : e3) * inv;
                const int lp = __hip_atomic_fetch_add(&hist[ek], 1, __ATOMIC_RELAXED, __HIP_MEMORY_SCOPE_WORKGROUP); rinfo[lr * 4 + lane] = (ek << 16) | lp; rgate[lr * 4 + lane] = gk; }
            LDS_WAIT(); asm volatile("" ::: "memory");
        }
        __syncthreads();
        if (F.tid < 32) basep[F.tid] = (int)__hip_atomic_fetch_add(cnt + F.tid, (unsigned)hist[F.tid], RLX_AGENT);
        __syncthreads();
        { const int lr = F.tid >> 2, k = F.tid & 3; const int m = chunk * 128 + lr; const int info = rinfo[F.tid]; const int ek = info >> 16; const int pos = basep[ek] + (info & 0xffff);
          LIST[ek * CAP + pos] = m; GATEL[ek * CAP + pos] = rgate[F.tid]; TOKSLOT[m * 4 + k] = (ek << 16) | pos; }
    }
    __syncthreads();
}

__device__ __forceinline__ void moe_tables(const Frame& F, int l) {
    LAS int* tb = (LAS int*)(F.lds + TB_OFF); LAS int* cn = tb + 40;
    const unsigned* cnt = (const unsigned*)(F.ws + WS_CTL) + CW_CNT + l * 64;
    __syncthreads();
    if (F.tid == 0) { int acc = 0;
        for (int e = 0; e < NE; ++e) { const int c = (int)__hip_atomic_load(cnt + e, RLX_AGENT); cn[e] = c; tb[e] = acc; acc += (c + 255) >> 8; }
        tb[NE] = acc; }
    __syncthreads();
}

__device__ __forceinline__ void phase_combine(const Params& p, const Frame& F, int l) {
    const LAS int* tb = (const LAS int*)(F.lds + TB_OFF);
    const int gw = F.vcu * NWAVES + F.wave, NGW = F.G * NWAVES; const int lane = F.lane;
    const float* mod = WSP(float, WS_MOD) + (size_t)l * NBATCH * 6144; const float* modn = WSP(float, WS_MOD) + (size_t)(l + 1) * NBATCH * 6144;
    const float* g2 = INP(I_LN2G) + (size_t)l * D; const float* b2 = INP(I_LN2B) + (size_t)l * D;
    const bf16* Y = WSP(bf16, WS_Y); const int* TOKSLOT = WSP(int, WS_TOKSLOT);
    const bool lastl = (l == DEPTH - 1);
    for (int m = gw; m < T; m += NGW) {
        const int b = m / SEQ;
        int srow[4];
#pragma unroll
        for (int k = 0; k < 4; ++k) { const int ts = TOKSLOT[m * 4 + k]; const int e = ts >> 16, pos = ts & 0xffff; srow[k] = tb[e] * 256 + pos; }
        GAS f32x4* xr = (GAS f32x4*)(WSP(float, WS_X) + (size_t)m * D) + lane;
        f32x4 v[4]; float s = 0.f;
#pragma unroll
        for (int j = 0; j < 4; ++j) { const int c = 4 * lane + 256 * j; f32x4 y = (f32x4){0.f, 0.f, 0.f, 0.f};
#pragma unroll
            for (int k = 0; k < 4; ++k) { const u32x2 yw = *(const u32x2*)(Y + (size_t)srow[k] * D + c); y.x += bflo(yw.x); y.y += bfhi(yw.x); y.z += bflo(yw.y); y.w += bfhi(yw.y); }
            const f32x4 gt = *(const f32x4*)(mod + (size_t)b * 6144 + 5120 + c) + 1.0f;
            v[j] = xr[64 * j] * DN_ALPHA + gt * y; s += (v[j].x + v[j].y) + (v[j].z + v[j].w); }
        const float mean = wave_sum(s) * (1.f / D); float s2 = 0.f;
#pragma unroll
        for (int j = 0; j < 4; ++j) { v[j] = v[j] - mean; s2 += (v[j].x * v[j].x + v[j].y * v[j].y) + (v[j].z * v[j].z + v[j].w * v[j].w); }
        const float rstd = 1.f / sqrtf(wave_sum(s2) * (1.f / D) + LN_EPS);
        GAS f32x4* oo = (GAS f32x4*)(p.out + (size_t)m * D) + lane;
        GAS u32x2* ho = (GAS u32x2*)(WSP(bf16, WS_H) + (size_t)m * D) + lane;
#pragma unroll
        for (int j = 0; j < 4; ++j) { const int c = 4 * lane + 256 * j;
            const f32x4 g = *(const f32x4*)(g2 + c), be = *(const f32x4*)(b2 + c);
            const f32x4 x2 = v[j] * rstd * g + be;
            if (lastl) oo[64 * j] = x2;
            else { xr[64 * j] = x2;
                const f32x4 sh = *(const f32x4*)(modn + (size_t)b * 6144 + c), sc = *(const f32x4*)(modn + (size_t)b * 6144 + 1024 + c);
                const f32x4 h = x2 * (sc + 1.0f) + sh; u32x2 w; w.x = pk2(h.x, h.y); w.y = pk2(h.z, h.w); ho[64 * j] = w; } }
    }
}

constexpr int PH_PER_LAYER = 11, N_PHASES = 2 + DEPTH * PH_PER_LAYER;
__global__ void __launch_bounds__(NTHREADS, 2) fwd(Params p) {
    extern __shared__ __attribute__((aligned(16))) unsigned char lds[];
    Frame F;
    F.lds = (LAS unsigned char*)lds; F.tid = threadIdx.x; F.lane = F.tid & 63; F.wave = __builtin_amdgcn_readfirstlane(F.tid >> 6);
    F.G = gridDim.x; { const int bx = blockIdx.x; F.vcu = (F.G % 8 == 0) ? (bx % 8) * (F.G / 8) + bx / 8 : bx; }
    F.ws = p.ws;
    volatile LAS unsigned* MISC = (volatile LAS unsigned*)(F.lds + MISC_OFF);
    if (F.tid < 64) MISC[F.tid] = 0u;
    __syncthreads();
    unsigned* ctl = (unsigned*)(p.ws + WS_CTL);
#if MK_ONE_LAUNCH
    XcdBarrier bar = xcd_barrier_post(ctl + CW_BAR, MISC + 8);
#define GRID_BAR() xcd_barrier(bar)
#else
#define GRID_BAR() do {} while (0)
#endif
    const int lo = p.ph_lo, hi = p.ph_hi;
#ifndef PH_MASK
#define PH_MASK 0xFFFFFFFFu
#endif
#define IN(k) (lo <= (k) && (k) < hi)
#define EN(j) ((PH_MASK >> (j)) & 1u)
#define SEAM(k) do { if (IN(k) && IN((k) + 1)) GRID_BAR(); } while (0)
    LAS unsigned char* ring = F.lds;

    if (EN(0) && IN(0)) { phase_prologue(p, F); } SEAM(0);
    if (EN(1) && IN(1)) { phase_ln0(p, F); } SEAM(1);
#define LAYER_BODY \
        constexpr int pb = 2 + l * PH_PER_LAYER; \
        const float* mod = WSP(float, WS_MOD) + (size_t)l * NBATCH * 6144; \
        if (EN(2) && IN(pb + 0)) { \
            pg8::Gemm g{WSP(bf16, WS_H), WSP(bf16, WS_WINT) + (size_t)l * N_INP * D, T, N_INP, D}; pg8::DenseOrder S; S.init(T, N_INP, F.G, (int)blockIdx.x); \
            pg8::EpiBf16Plain E{WSP(bf16, WS_P), N_INP}; \
            pg8::gemm_phase<pg8::EpiBf16Plain, pg8::DenseOrder, true>(ring, g, S, E); \
        } SEAM(pb + 0); \
        if (EN(3) && IN(pb + 1)) { phase_prep(p, F, l); } SEAM(pb + 1); \
        if (EN(4) && IN(pb + 2)) { \
            if (EN(13)) { pg8::Gemm g{WSP(bf16, WS_AN), WSP(bf16, WS_WUPT) + (size_t)l * N_UP * K_UP, T, N_UP, K_UP}; pg8::DenseOrder S; S.init(T, N_UP, F.G, (int)blockIdx.x); \
              pg8::EpiMlaUp E{WSP(bf16, WS_Q), WSP(bf16, WS_KK), WSP(bf16, WS_V), WSP(float, WS_CS)}; \
              pg8::gemm_phase<pg8::EpiMlaUp, pg8::DenseOrder, true>(ring, g, S, E); } \
            if (EN(14)) { pg8::Gemm g{WSP(bf16, WS_A2), WSP(bf16, WS_WSMT) + (size_t)l * N_SM * K_SM, T, N_SM, K_SM}; pg8::DenseOrder S; S.init(T, N_SM, F.G, (int)blockIdx.x); \
              pg8::EpiRwkvSmall E{WSP(float, WS_WAG), INP(I_W0) + (size_t)l * C5, INP(I_A0) + (size_t)l * C5}; \
              pg8::gemm_phase<pg8::EpiRwkvSmall, pg8::DenseOrder, true>(ring, g, S, E); } \
            if (EN(15) && l > 0) { pg8::Gemm g{WSP(bf16, WS_VS1), WSP(bf16, WS_WV12T), T, C5, C5}; pg8::DenseOrder S; S.init(T, C5, F.G, (int)blockIdx.x); \
              pg8::EpiVres E{WSP(bf16, WS_VS1), WSP(bf16, WS_VS0), WSP(bf16, WS_VR), INP(I_V0)}; \
              pg8::gemm_phase<pg8::EpiVres, pg8::DenseOrder, true>(ring, g, S, E); } \
        } SEAM(pb + 2); \
        if (EN(5) && IN(pb + 3)) { phase_attn(p, F, (char*)lds); } SEAM(pb + 3); \
        if (EN(6) && IN(pb + 4)) { phase_rwkv(p, F, l); } SEAM(pb + 4); \
        if (EN(7) && IN(pb + 5)) { phase_mix(p, F, l); } SEAM(pb + 5); \
        if (EN(8) && IN(pb + 6)) { \
            pg8::Gemm g{WSP(bf16, WS_MIX), WSP(bf16, WS_WOT) + (size_t)l * D * D, T, D, D}; pg8::DenseOrder S; S.init(T, D, F.G, (int)blockIdx.x); \
            pg8::EpiWo E{WSP(float, WS_X), mod + 2048}; \
            pg8::gemm_phase<pg8::EpiWo, pg8::DenseOrder, true>(ring, g, S, E); \
        } SEAM(pb + 6); \
        if (EN(9) && IN(pb + 7)) { phase_ln1_route(p, F, l); } SEAM(pb + 7); \
        if (EN(10) && IN(pb + 8)) { \
            moe_tables(F, l); \
            const LAS int* tb = (const LAS int*)(F.lds + TB_OFF); \
            pg8::Gemm g{WSP(bf16, WS_H), WSP(bf16, WS_W1T) + (size_t)l * NE * 2048 * D, T, 2048, D}; \
            pg8::MoeOrder<true> S{tb, tb + 40, WSP(int, WS_LIST), 8, F.G, (int)blockIdx.x, (LAS unsigned*)(F.lds + GT_OFF)}; \
            pg8::EpiSwiglu E{WSP(bf16, WS_H1), WSP(float, WS_B1P) + (size_t)l * NE * 2048}; \
            pg8::gemm_phase<pg8::EpiSwiglu, pg8::MoeOrder<true>, true>(ring, g, S, E); \
        } SEAM(pb + 8); \
        if (EN(11) && IN(pb + 9)) { \
            moe_tables(F, l); \
            const LAS int* tb = (const LAS int*)(F.lds + TB_OFF); \
            pg8::Gemm g{WSP(bf16, WS_H1), WSP(bf16, WS_W2T) + (size_t)l * NE * D * FF, MAXSLOT, D, FF}; \
            pg8::MoeOrder<false> S{tb, tb + 40, nullptr, 4, F.G, (int)blockIdx.x, nullptr}; \
            pg8::EpiMoeOut E{WSP(bf16, WS_Y), INP(I_EB2) + (size_t)l * NE * D, WSP(float, WS_GATEL), tb}; \
            pg8::gemm_phase<pg8::EpiMoeOut, pg8::MoeOrder<false>, true>(ring, g, S, E); \
        } SEAM(pb + 9); \
        if (EN(12) && IN(pb + 10)) { moe_tables(F, l); phase_combine(p, F, l); } SEAM(pb + 10);
    { constexpr int l = 0; LAYER_BODY }
    { constexpr int l = 1; LAYER_BODY }
#undef LAYER_BODY
#undef IN
#undef SEAM
}

extern "C" void kernel_launch(void* const* d_in, const int* in_sizes, int n_in, void* d_out, int out_size, void* d_ws, size_t ws_size, hipStream_t stream) {
    static int grid = 0;
    if (grid == 0) {
        if (n_in != N_INPUTS || out_size != T * D || ws_size < WS_END) { fprintf(stderr, "kernel_launch: unexpected problem: n_in %d out %d ws %zu\n", n_in, out_size, ws_size); grid = -1; return; }
        int dev = 0, cus = 0, per_cu = 0;
        if (hipGetDevice(&dev) != hipSuccess || hipDeviceGetAttribute(&cus, hipDeviceAttributeMultiprocessorCount, dev) != hipSuccess) { grid = -1; return; }
        if (hipFuncSetAttribute((const void*)fwd, hipFuncAttributeMaxDynamicSharedMemorySize, LDS_BYTES) != hipSuccess) { fprintf(stderr, "kernel_launch: hipFuncSetAttribute failed\n"); grid = -1; return; }
        if (hipOccupancyMaxActiveBlocksPerMultiprocessor(&per_cu, (const void*)fwd, NTHREADS, LDS_BYTES) != hipSuccess || per_cu < 1) fprintf(stderr, "kernel_launch: occupancy query reports %d\n", per_cu);
        (void)hipGetLastError();
        grid = cus;
    }
    if (grid < 0) return;
    if (hipMemsetAsync((char*)d_ws + WS_CTL, 0, CTL_ZERO_BYTES, stream) != hipSuccess) return;
    Params p{};
    for (int i = 0; i < N_INPUTS; ++i) p.in[i] = d_in[i];
    p.out = (float*)d_out; p.ws = (unsigned char*)d_ws;
#if MK_ONE_LAUNCH
    p.ph_lo = 0; p.ph_hi = N_PHASES;
    hipLaunchKernelGGL(fwd, dim3(grid), dim3(NTHREADS), LDS_BYTES, stream, p);
#else
    for (int ph = 0; ph < N_PHASES; ++ph) { p.ph_lo = ph; p.ph_hi = ph + 1; hipLaunchKernelGGL(fwd, dim3(grid), dim3(NTHREADS), LDS_BYTES, stream, p); }
#endif
}
```

```cpp
#include <hip/hip_runtime.h>
#include <cstdio>
#include <cstdint>

#ifndef MK_ONE_LAUNCH
#define MK_ONE_LAUNCH 1
#endif

#define GAS __attribute__((address_space(1)))
#define LAS __attribute__((address_space(3)))
typedef unsigned short bf16;
typedef short bf16x8 __attribute__((ext_vector_type(8)));
typedef short s16x4 __attribute__((ext_vector_type(4)));
typedef float f32x2 __attribute__((ext_vector_type(2)));
typedef float f32x4 __attribute__((ext_vector_type(4)));
typedef float f32x16 __attribute__((ext_vector_type(16)));
typedef unsigned u32x2 __attribute__((ext_vector_type(2)));
typedef unsigned u32x4 __attribute__((ext_vector_type(4)));

constexpr int D = 1024, NBATCH = 8, SEQ = 4096, T = NBATCH * SEQ, DEPTH = 2;
constexpr int MLA_IN = 416, RWKV_IN = 1792, N_IN = 2208, N_INP = 2304;
constexpr int QLR = 256, KVLR = 128, ROPE = 32, NOPE = 64, QKD = 96, VD = 64, NH = 8;
constexpr int C5 = 512;
constexpr int NE = 32, TOPK = 4, FF = 1024, CAP = 32768;
constexpr int N_UP = 1792, K_UP = 384, N_SM = 1536, K_SM = 256;
constexpr int MAXSLOT = 139264;
constexpr float DN_ALPHA = 1.4142135623730951f;
constexpr float C2Q = 0.14724444602590306f;
constexpr float LN_EPS = 1e-5f, RMS_EPS = 1e-6f, GN_EPS = 64e-5f;
constexpr int NWAVES = 8, NTHREADS = 512;

enum { I_X = 0, I_C, I_POS, I_ELNG, I_ELNB, I_ADAW, I_ADAB, I_WIN, I_QNG, I_WUQ, I_KVNG, I_WUK, I_WUV, I_MOUTG, I_MU, I_W0, I_W2, I_A0, I_A2, I_G2,
       I_KK, I_KA, I_RK, I_GNG, I_GNB, I_V0, I_V1, I_V2, I_WO, I_LN1G, I_LN1B, I_RW, I_RB, I_EW1, I_EB1, I_EW2, I_EB2, I_LN2G, I_LN2B, N_INPUTS };

constexpr size_t MiB = 1u << 20;
constexpr size_t WS_CTL = 0, CTL_ZERO_BYTES = 4 * MiB;
constexpr size_t WS_MOD = 4 * MiB, WS_B1P = 5 * MiB, WS_CS = 6 * MiB, WS_LIST = 10 * MiB, WS_GATEL = 14 * MiB, WS_TOKSLOT = 18 * MiB;
constexpr size_t WS_WINT = 20 * MiB, WS_WUPT = 30 * MiB, WS_WSMT = 33 * MiB, WS_WV12T = 35 * MiB, WS_WOT = 36 * MiB, WS_W1T = 40 * MiB, WS_W2T = 296 * MiB;
constexpr size_t WS_X = 424 * MiB, WS_H = 552 * MiB, WS_VS0 = 616 * MiB, WS_VS1 = 648 * MiB;
constexpr size_t WS_P = 680 * MiB, WS_AN = 824 * MiB, WS_A2 = 848 * MiB, WS_RK = 864 * MiB, WS_Q = 928 * MiB, WS_KK = 976 * MiB, WS_V = 1024 * MiB, WS_O = 1056 * MiB;
constexpr size_t WS_WAG = 1088 * MiB, WS_RO = 1280 * MiB, WS_MIX = 1344 * MiB, WS_VR = 1408 * MiB;
constexpr size_t WS_H1 = 680 * MiB, WS_Y = 952 * MiB;
constexpr size_t WS_END = 1440 * MiB;
constexpr int CW_TMO = 0, CW_CODE = 1, CW_BAR = 4096, CW_CNT = 8192;

constexpr int RING_BYTES = 131072;
constexpr int LDSX_OFF = RING_BYTES;
constexpr int MISC_OFF = LDSX_OFF;
constexpr int TB_OFF = LDSX_OFF + 256;
constexpr int GT_OFF = LDSX_OFF + 1024;
constexpr int LDS_BYTES = 147456;

#define RLX_AGENT __ATOMIC_RELAXED, __HIP_MEMORY_SCOPE_AGENT
#define LDS_WAIT() asm volatile("s_waitcnt lgkmcnt(0)" ::: "memory")
#define VM_WAIT() asm volatile("s_waitcnt vmcnt(0)" ::: "memory")

__device__ __forceinline__ unsigned f2bf(float f) { unsigned u = __builtin_bit_cast(unsigned, f); return (u + 0x7fffu + ((u >> 16) & 1u)) >> 16; }
__device__ __forceinline__ unsigned pk2(float lo, float hi) { return f2bf(lo) | (f2bf(hi) << 16); }
__device__ __forceinline__ float bf2f(unsigned b) { return __builtin_bit_cast(float, b << 16); }
__device__ __forceinline__ float bflo(unsigned w) { return __builtin_bit_cast(float, w << 16); }
__device__ __forceinline__ float bfhi(unsigned w) { return __builtin_bit_cast(float, w & 0xffff0000u); }
__device__ __forceinline__ unsigned cvt_pk_bf16(float lo, float hi) { unsigned r; asm volatile("v_cvt_pk_bf16_f32 %0, %1, %2" : "=v"(r) : "v"(lo), "v"(hi)); return r; }
__device__ __forceinline__ float wave_sum(float v) {
#pragma unroll
    for (int o = 1; o < 64; o <<= 1) v += __shfl_xor(v, o);
    return v;
}
__device__ __forceinline__ float sigmoidf_(float x) { return 1.0f / (1.0f + __expf(-x)); }

#define XB_TMO      128
#define XB_XCNT(j)  (256  + 64 * (j))
#define XB_XSUB(j)  (1280 + 64 * (j))
#define XB_XGEN(j)  (2304 + 64 * (j))
#define XB_TOP      3328
#define XB_TOPGEN   3392
#define XCD_BAR_WORDS 3456
#define XB_SPIN_CAP (1u << 18)
__device__ __forceinline__ unsigned xb_ld(unsigned* p)              { return __hip_atomic_load(p, __ATOMIC_RELAXED, __HIP_MEMORY_SCOPE_AGENT); }
__device__ __forceinline__ unsigned xb_add(unsigned* p, unsigned v) { return __hip_atomic_fetch_add(p, v, __ATOMIC_RELAXED, __HIP_MEMORY_SCOPE_AGENT); }
__device__ __forceinline__ unsigned xb_xcc_id() { return (unsigned)__builtin_amdgcn_s_getreg((3 << 11) | 20) & 0xFu; }
#define XB_SPIN(cond, bar) do { unsigned _sp = 0; while (cond) { __builtin_amdgcn_s_sleep(1); \
    if ((++_sp & 255u) == 0u) { if (xb_ld(&(bar)[XB_TMO])) break; if (_sp > XB_SPIN_CAP) { atomicAdd(&(bar)[XB_TMO], 1u); break; } } } } while (0)
struct XcdBarrier { unsigned* bar; unsigned x; volatile LAS unsigned* st; };
__device__ __forceinline__ XcdBarrier xcd_barrier_post(unsigned* bar, volatile LAS unsigned* st) {
    XcdBarrier b; b.bar = bar; b.x = xb_xcc_id(); b.st = st;
    if (threadIdx.x == 0) (void)xb_add(&bar[XB_XCNT(b.x)], 1u);
    return b;
}
__device__ __forceinline__ void xcd_barrier_complete(unsigned* bar, unsigned x, unsigned& nloc, unsigned& nx) {
    const unsigned G = gridDim.x * gridDim.y * gridDim.z;
    unsigned sum, cnt, mine, sp = 0u;
    for (;;) {
        sum = 0u; cnt = 0u; mine = 0u;
#pragma unroll
        for (unsigned j = 0; j < 16; ++j) { const unsigned c = xb_ld(&bar[XB_XCNT(j)]); sum += c; cnt += (c > 0u) ? 1u : 0u; mine = (j == x) ? c : mine; }
        if (sum == G) break;
        __builtin_amdgcn_s_sleep(1);
        if ((++sp & 255u) == 0u) { if (xb_ld(&bar[XB_TMO])) break; if (sp > XB_SPIN_CAP) { atomicAdd(&bar[XB_TMO], 1u); break; } }
    }
    nloc = mine > 0u ? mine : 1u; nx = cnt > 0u ? cnt : 1u;
}
__device__ __forceinline__ void xcd_barrier(const XcdBarrier& b) {
    asm volatile("s_waitcnt vmcnt(0)" ::: "memory");
    __syncthreads();
    if (threadIdx.x == 0) {
        unsigned* bar = b.bar;
        __builtin_amdgcn_s_waitcnt(0);
        unsigned nloc = b.st[0], nx = b.st[1];
        if (nloc == 0u) { xcd_barrier_complete(bar, b.x, nloc, nx); b.st[0] = nloc; b.st[1] = nx; }
        const unsigned old = xb_add(&bar[XB_XSUB(b.x)], 1u);
        const unsigned gen = old / nloc;
        if (old + 1u == (gen + 1u) * nloc) {
            __builtin_amdgcn_fence(__ATOMIC_RELEASE, "agent");
            asm volatile("s_waitcnt vmcnt(0)" ::: "memory");
            const unsigned og = xb_add(&bar[XB_TOP], 1u);
            const unsigned tg = og / nx;
            if (og + 1u == (tg + 1u) * nx) xb_add(&bar[XB_TOPGEN], 1u);
            else XB_SPIN(xb_ld(&bar[XB_TOPGEN]) == tg, bar);
            __builtin_amdgcn_fence(__ATOMIC_ACQUIRE, "agent");
            xb_add(&bar[XB_XGEN(b.x)], 1u);
            asm volatile("s_waitcnt vmcnt(0)" ::: "memory");
        } else {
            XB_SPIN(xb_ld(&bar[XB_XGEN(b.x)]) == gen, bar);
            __builtin_amdgcn_fence(__ATOMIC_ACQUIRE, "agent");
            asm volatile("s_waitcnt vmcnt(0)" ::: "memory");
        }
    }
    __syncthreads();
}

namespace pg8 {
constexpr int BM = 256, BK = 64, HALF = 128, HTB = HALF * BK * 2, STAGE_BYTES = 8 * HTB, NXCD = 8, WGM = 8;
__device__ __forceinline__ int lds_byte(int r, int c) { const int st = (r >> 4) * 2 + (c >> 5), rr = r & 15, cc = c & 31, ob = rr * 64 + cc * 2; return st * 1024 + (ob ^ (((ob >> 9) & 1) << 5)); }
__device__ __forceinline__ void stage_rc(int b, int& R, int& C) { const int st = b / 1024, sb = b % 1024, swz = sb ^ (((sb >> 9) & 1) << 5); R = (st >> 1) * 16 + swz / 64; C = (st & 1) * 32 + (swz % 64) / 2; }
__device__ __forceinline__ int perm32(int rho) { const int n = rho >> 4, i = rho & 15; return 8 * (i >> 2) + 4 * n + (i & 3); }

struct Unit { int pm, pn, e; };
struct Gemm { const bf16* A; const bf16* Bt; int M, N, K; };

struct DenseOrder {
    int nM, nN, nwg, G, c;
    __device__ __forceinline__ void init(int M, int N, int G_, int c_) { nM = M / BM; nN = N / BM; nwg = nM * nN; G = G_; c = c_; }
    __device__ __forceinline__ bool next(int i, Unit& u) const {
        const long L = (long)i * G + c; if (L >= nwg) return false;
        int wgid = (int)L; { const int q = nwg / NXCD, r = nwg % NXCD, xcd = wgid % NXCD, off = wgid / NXCD; wgid = (xcd < r ? xcd * (q + 1) : r * (q + 1) + (xcd - r) * q) + off; }
        const int nig = WGM * nN, gid = wgid / nig, fm = gid * WGM, gsz = (nM - fm) < WGM ? (nM - fm) : WGM;
        u.pm = fm + ((wgid % nig) % gsz); u.pn = (wgid % nig) / gsz; u.e = 0; return true;
    }
    static constexpr bool GATHER = false;
    __device__ __forceinline__ size_t b_off(const Unit& u, int N, int K) const { return (size_t)u.pn * BM * K * 2; }
    __device__ __forceinline__ unsigned a_row_off(const Unit& u, int row, int K) const { return 0u; }
    __device__ __forceinline__ LAS unsigned* gtab() const { return nullptr; }
};
template <bool GATHER_> struct MoeOrder {
    static constexpr bool GATHER = GATHER_;
    const LAS int* tb; const LAS int* cnt; const int* list; int nN, G, c; LAS unsigned* gt_;
    __device__ __forceinline__ LAS unsigned* gtab() const { return gt_; }
    __device__ __forceinline__ bool next(int i, Unit& u) const {
        const int L = i * G + c; const int total = tb[NE] * nN; if (L >= total) return false;
        int e = 0;
#pragma unroll 1
        for (int j = 1; j < NE; ++j) if (tb[j] * nN <= L) e = j;
        const int Lr = L - tb[e] * nN, nte = tb[e + 1] - tb[e];
        u.e = e; u.pn = Lr / nte; u.pm = tb[e] + (Lr % nte); return true;
    }
    __device__ __forceinline__ size_t b_off(const Unit& u, int N, int K) const { return ((size_t)u.e * N + (size_t)u.pn * BM) * K * 2; }
    __device__ __forceinline__ unsigned a_row_off(const Unit& u, int row, int K) const {
        const int pos = (u.pm - tb[u.e]) * BM + row; const int tok = pos < cnt[u.e] ? list[u.e * CAP + pos] : 0; return (unsigned)tok * (unsigned)(K * 2);
    }
};

template <class Epi, class Sched, bool ALIGN_EPI>
__device__ __forceinline__ void gemm_phase(LAS unsigned char* lds, const Gemm g, const Sched& S, const Epi& E) {
    const int tid = threadIdx.x, wid = __builtin_amdgcn_readfirstlane(tid >> 6), lane = tid & 63, wr = wid >> 2, wc = wid & 3, fr = lane & 15, fq = lane >> 4;
    const int K = g.K, nt = K / BK;
    int RA[2]; unsigned CA[2], voffA[2], voffB[2];
#pragma unroll
    for (int i = 0; i < 2; ++i) { int R, C; stage_rc(tid * 16 + i * 8192, R, C); const int Rb = Epi::PERM ? ((R & ~31) + perm32(R & 31)) : R;
        RA[i] = R; CA[i] = (unsigned)C * 2u; voffA[i] = (unsigned)(R * K + C) * 2u; voffB[i] = (unsigned)(Rb * K + C) * 2u; }
    const size_t kstep = (size_t)(BK * 2);
    const size_t hstep = (size_t)HALF * K * 2;
    const size_t tstep = 2 * hstep;
    const unsigned ldsw = (unsigned)wid * 1024u;
    const int aoff = lds_byte(wr * 64 + fr, fq * 8), boff = lds_byte(wc * 32 + fr, fq * 8);
    const char* Abase = (const char*)g.A;
    LAS unsigned* gtb = S.gtab();
#define PG8_SA(b, h) (((b) * 2 + (h)) * HTB)
#define PG8_SB(b, h) ((4 + (b) * 2 + (h)) * HTB)
#define PG8_STAGE(bufoff, gbase, voff) do { _Pragma("unroll") for (int _i = 0; _i < 2; ++_i) \
        __builtin_amdgcn_global_load_lds((const unsigned*)((const char*)(gbase) + (voff)[_i]), (LAS unsigned*)(lds + (bufoff) + ldsw + _i * 8192), 16, 0, 0); } while (0)
#define PG8_STAGEA(bufoff, h, kb, nx) do { \
        if constexpr (Sched::GATHER) { const LAS unsigned* tp_ = gtb + ((nx) ? tnx : tcu) + (h) * HALF; const unsigned o0_ = tp_[RA[0]] + CA[0], o1_ = tp_[RA[1]] + CA[1]; \
            __builtin_amdgcn_global_load_lds((const unsigned*)(Abase + (size_t)(kb) + o0_), (LAS unsigned*)(lds + (bufoff) + ldsw), 16, 0, 0); \
            __builtin_amdgcn_global_load_lds((const unsigned*)(Abase + (size_t)(kb) + o1_), (LAS unsigned*)(lds + (bufoff) + ldsw + 8192), 16, 0, 0); } \
        else { const char* gb_ = ((nx) ? nA : cA) + (size_t)(h) * hstep + (size_t)(kb); PG8_STAGE(bufoff, gb_, voffA); } } while (0)
#define PG8_LDA(dst, b, h) do { _Pragma("unroll") for (int m = 0; m < 4; ++m) _Pragma("unroll") for (int k = 0; k < 2; ++k) dst[m][k] = *(const LAS bf16x8*)(lds + PG8_SA(b, h) + aoff + m * 2048 + k * 1024); } while (0)
#define PG8_LDB(dst, b, h) do { _Pragma("unroll") for (int n = 0; n < 2; ++n) _Pragma("unroll") for (int k = 0; k < 2; ++k) dst[n][k] = *(const LAS bf16x8*)(lds + PG8_SB(b, h) + boff + n * 2048 + k * 1024); } while (0)
#define PG8_MMA(ai, bj, At, Bt) do { __builtin_amdgcn_s_setprio(1); _Pragma("unroll") for (int m = 0; m < 4; ++m) _Pragma("unroll") for (int n = 0; n < 2; ++n) _Pragma("unroll") for (int k = 0; k < 2; ++k) \
        acc[ai][bj][m][n] = __builtin_amdgcn_mfma_f32_16x16x32_bf16(Bt[n][k], At[m][k], acc[ai][bj][m][n], 0, 0, 0); __builtin_amdgcn_s_setprio(0); } while (0)
#define PG8_WAIT_V(n) asm volatile("s_waitcnt vmcnt(" #n ")" ::: "memory")
#define PG8_WAIT_L(n) asm volatile("s_waitcnt lgkmcnt(" #n ")" ::: "memory")
#define PG8_BAR __builtin_amdgcn_s_barrier()
#define PG8_SCHED __builtin_amdgcn_sched_barrier(0)
    Unit cur, nxt; int ui = 0;
    if (!S.next(0, cur)) return;
    f32x4 acc[2][2][4][2];
#pragma unroll
    for (int a = 0; a < 2; ++a)
#pragma unroll
        for (int b = 0; b < 2; ++b)
#pragma unroll
            for (int m = 0; m < 4; ++m)
#pragma unroll
                for (int n = 0; n < 2; ++n) acc[a][b][m][n] = (f32x4){0.f, 0.f, 0.f, 0.f};
    bf16x8 At[4][2], B0[2][2], B1[2][2];
    const char* cA = Abase + (size_t)cur.pm * tstep; const char* cB = (const char*)g.Bt + S.b_off(cur, g.N, K);
    const char* nA = cA; const char* nB = cB;
    int tcu = 0, tnx = 0;
    if constexpr (Sched::GATHER) {
        if (tid < BM) gtb[tid] = S.a_row_off(cur, tid, K);
        asm volatile("s_waitcnt vmcnt(0) lgkmcnt(0)" ::: "memory"); PG8_BAR; asm volatile("" ::: "memory");
    }
    PG8_STAGE(PG8_SB(0, 0), cB, voffB); PG8_STAGE(PG8_SB(0, 1), cB + hstep, voffB); PG8_STAGEA(PG8_SA(0, 0), 0, 0, false); PG8_STAGEA(PG8_SA(0, 1), 1, 0, false);
    if (wr == 1) PG8_BAR;
    PG8_WAIT_V(2); PG8_BAR;
    PG8_STAGE(PG8_SB(1, 0), cB + kstep, voffB); PG8_STAGEA(PG8_SA(1, 0), 0, kstep, false); PG8_STAGE(PG8_SB(1, 1), cB + hstep + kstep, voffB);
    PG8_WAIT_V(6); PG8_BAR;
    for (;;) {
        const bool has_next = S.next(ui + 1, nxt);
        nA = cA; nB = cB; tnx = tcu;
        if (has_next) { nA = Abase + (size_t)nxt.pm * tstep; nB = (const char*)g.Bt + S.b_off(nxt, g.N, K);
            if constexpr (Sched::GATHER) { tnx = tcu ^ BM; if (tid < BM) gtb[tnx + tid] = S.a_row_off(nxt, tid, K); } }
#pragma unroll 1
        for (int t = 0; t < nt; t += 2) {
            const bool last = (t == nt - 2);
            const size_t k1 = (size_t)(t + 1) * kstep;
            const size_t k2 = last ? 0 : (size_t)(t + 2) * kstep, k3 = k2 + kstep;
            const char* b2 = last ? nB : cB + (size_t)(t + 2) * kstep; const char* b3 = b2 + kstep;
            PG8_LDB(B0, 0, 0); PG8_LDB(B1, 0, 1); PG8_SCHED; PG8_LDA(At, 0, 0); PG8_STAGEA(PG8_SA(1, 1), 1, k1, false);
            PG8_WAIT_V(8); PG8_WAIT_L(0); PG8_BAR; PG8_MMA(0, 0, At, B0); PG8_MMA(0, 1, At, B1); PG8_BAR; PG8_SCHED;
            PG8_LDA(At, 0, 1); PG8_STAGE(PG8_SB(0, 0), b2, voffB); PG8_STAGE(PG8_SB(0, 1), b2 + hstep, voffB); PG8_STAGEA(PG8_SA(0, 0), 0, k2, last);
            PG8_WAIT_V(8); PG8_WAIT_L(0); PG8_BAR; PG8_MMA(1, 0, At, B0); PG8_MMA(1, 1, At, B1); PG8_BAR; PG8_SCHED;
            PG8_LDB(B0, 1, 0); PG8_LDB(B1, 1, 1); PG8_SCHED; PG8_LDA(At, 1, 0); PG8_STAGEA(PG8_SA(0, 1), 1, k2, last);
            PG8_WAIT_V(8); PG8_WAIT_L(0); PG8_BAR; PG8_MMA(0, 0, At, B0); PG8_MMA(0, 1, At, B1); PG8_BAR; PG8_SCHED;
            PG8_LDA(At, 1, 1); PG8_STAGE(PG8_SB(1, 0), b3, voffB); PG8_STAGE(PG8_SB(1, 1), b3 + hstep, voffB); PG8_STAGEA(PG8_SA(1, 0), 0, k3, last);
            PG8_WAIT_V(8); PG8_WAIT_L(0); PG8_BAR; PG8_MMA(1, 0, At, B0); PG8_MMA(1, 1, At, B1); PG8_BAR; PG8_SCHED;
        }
        if constexpr (ALIGN_EPI) { if (wr == 0) PG8_BAR; }
        E(acc, cur, wr, wc, fr, fq);
        if (!has_next) break;
#pragma unroll
        for (int a = 0; a < 2; ++a)
#pragma unroll
            for (int b = 0; b < 2; ++b)
#pragma unroll
                for (int m = 0; m < 4; ++m)
#pragma unroll
                    for (int n = 0; n < 2; ++n) acc[a][b][m][n] = (f32x4){0.f, 0.f, 0.f, 0.f};
        cur = nxt; cA = nA; cB = nB; tcu = tnx; ++ui;
        if constexpr (ALIGN_EPI) { if (wr == 1) PG8_BAR; }
    }
    PG8_WAIT_V(0);
    if constexpr (!ALIGN_EPI) { if (wr == 0) PG8_BAR; }
    PG8_BAR;
#undef PG8_SA
#undef PG8_SB
#undef PG8_STAGE
#undef PG8_STAGEA
#undef PG8_LDA
#undef PG8_LDB
#undef PG8_MMA
#undef PG8_WAIT_V
#undef PG8_WAIT_L
#undef PG8_BAR
#undef PG8_SCHED
}

struct EpiBf16Plain {
    static constexpr bool PERM = true;
    bf16* O; int ldc;
    __device__ __forceinline__ void operator()(const f32x4 (&acc)[2][2][4][2], const Unit& u, int wr, int wc, int fr, int fq) const {
        const int row0 = u.pm * BM + wr * 64 + fr, col0 = u.pn * BM + wc * 32 + 8 * fq;
#pragma unroll
        for (int ai = 0; ai < 2; ++ai)
#pragma unroll
            for (int m = 0; m < 4; ++m) { bf16* rowp = O + (size_t)(row0 + ai * HALF + m * 16) * ldc + col0;
#pragma unroll
                for (int bj = 0; bj < 2; ++bj) { const f32x4 v0 = acc[ai][bj][m][0], v1 = acc[ai][bj][m][1];
                    u32x4 w; w.x = cvt_pk_bf16(v0[0], v0[1]); w.y = cvt_pk_bf16(v0[2], v0[3]); w.z = cvt_pk_bf16(v1[0], v1[1]); w.w = cvt_pk_bf16(v1[2], v1[3]);
                    *(u32x4*)(rowp + bj * HALF) = w; } }
    }
};
struct EpiMlaUp {
    static constexpr bool PERM = true;
    bf16* Q; bf16* KK; bf16* V; const float* cs;
    __device__ __forceinline__ void operator()(const f32x4 (&acc)[2][2][4][2], const Unit& u, int wr, int wc, int fr, int fq) const {
        const int row0 = u.pm * BM + wr * 64 + fr;
#pragma unroll
        for (int bj = 0; bj < 2; ++bj) {
            const int c0 = u.pn * BM + bj * HALF + wc * 32 + 8 * fq;
            if (u.pn < 3) {
                const int h = c0 / QKD, d = c0 - h * QKD;
                const bool rope = d >= NOPE; const int i0 = rope ? (d - NOPE) >> 1 : 0;
#pragma unroll
                for (int ai = 0; ai < 2; ++ai)
#pragma unroll
                    for (int m = 0; m < 4; ++m) { const int row = row0 + ai * HALF + m * 16;
                        f32x4 v0 = acc[ai][bj][m][0], v1 = acc[ai][bj][m][1];
                        if (rope) { const f32x4 cA = *(const f32x4*)(cs + (size_t)row * 32 + i0 * 2), cB = *(const f32x4*)(cs + (size_t)row * 32 + i0 * 2 + 4);
                            const f32x4 a = v0, b = v1;
                            v0[0] = a[0] * cA[0] - a[1] * cA[1]; v0[1] = a[0] * cA[1] + a[1] * cA[0]; v0[2] = a[2] * cA[2] - a[3] * cA[3]; v0[3] = a[2] * cA[3] + a[3] * cA[2];
                            v1[0] = b[0] * cB[0] - b[1] * cB[1]; v1[1] = b[0] * cB[1] + b[1] * cB[0]; v1[2] = b[2] * cB[2] - b[3] * cB[3]; v1[3] = b[2] * cB[3] + b[3] * cB[2]; }
                        v0 = v0 * C2Q; v1 = v1 * C2Q;
                        u32x4 w; w.x = cvt_pk_bf16(v0[0], v0[1]); w.y = cvt_pk_bf16(v0[2], v0[3]); w.z = cvt_pk_bf16(v1[0], v1[1]); w.w = cvt_pk_bf16(v1[2], v1[3]);
                        *(u32x4*)(Q + (size_t)row * 768 + c0) = w; asm volatile("" ::: "memory"); }
            } else {
                bf16* base; int ld, cc;
                if (u.pn < 5) { const int c1 = c0 - 768; const int h = c1 >> 6, d = c1 & 63; base = KK; ld = 768; cc = h * QKD + d; }
                else { base = V; ld = 512; cc = c0 - 1280; }
#pragma unroll
                for (int ai = 0; ai < 2; ++ai)
#pragma unroll
                    for (int m = 0; m < 4; ++m) { const int row = row0 + ai * HALF + m * 16; const f32x4 v0 = acc[ai][bj][m][0], v1 = acc[ai][bj][m][1];
                        u32x4 w; w.x = cvt_pk_bf16(v0[0], v0[1]); w.y = cvt_pk_bf16(v0[2], v0[3]); w.z = cvt_pk_bf16(v1[0], v1[1]); w.w = cvt_pk_bf16(v1[2], v1[3]);
                        *(u32x4*)(base + (size_t)row * ld + cc) = w; asm volatile("" ::: "memory"); }
            }
        }
    }
};
struct EpiRwkvSmall {
    static constexpr bool PERM = false;
    float* O; const float* w0; const float* a0;
    __device__ __forceinline__ void operator()(const f32x4 (&acc)[2][2][4][2], const Unit& u, int wr, int wc, int fr, int fq) const {
        const int row0 = u.pm * BM + wr * 64 + fr, col0 = u.pn * BM + wc * 32 + 4 * fq;
        const int kind = u.pn >> 1;
#pragma unroll
        for (int bj = 0; bj < 2; ++bj)
#pragma unroll
            for (int n = 0; n < 2; ++n) { const int c = col0 + bj * HALF + n * 16;
                f32x4 bv = (f32x4){0.f, 0.f, 0.f, 0.f};
                if (kind == 0) bv = *(const f32x4*)(w0 + c); else if (kind == 1) bv = *(const f32x4*)(a0 + (c - 512));
#pragma unroll
                for (int ai = 0; ai < 2; ++ai)
#pragma unroll
                    for (int m = 0; m < 4; ++m) { f32x4 v = acc[ai][bj][m][n] + bv;
                        if (kind == 0) {
#pragma unroll
                            for (int j = 0; j < 4; ++j) { const float z = -v[j]; const float sp = fmaxf(z, 0.f) + __logf(1.0f + __expf(-fabsf(z))); const float w = -sp - 0.5f; v[j] = __expf(-__expf(w)); }
                        } else if (kind == 1) {
#pragma unroll
                            for (int j = 0; j < 4; ++j) v[j] = sigmoidf_(v[j]);
                        }
                        *(f32x4*)(O + (size_t)(row0 + ai * HALF + m * 16) * N_SM + c) = v; asm volatile("" ::: "memory"); } }
    }
};
struct EpiVres {
    static constexpr bool PERM = true;
    const bf16* vs; const bf16* vf; bf16* vr; const float* v0;
    __device__ __forceinline__ void operator()(const f32x4 (&acc)[2][2][4][2], const Unit& u, int wr, int wc, int fr, int fq) const {
        const int row0 = u.pm * BM + wr * 64 + fr, col0 = u.pn * BM + wc * 32 + 8 * fq;
#pragma unroll
        for (int bj = 0; bj < 2; ++bj) { const int c = col0 + bj * HALF;
            const f32x4 b0 = *(const f32x4*)(v0 + c), b1 = *(const f32x4*)(v0 + c + 4);
#pragma unroll
            for (int ai = 0; ai < 2; ++ai)
#pragma unroll
                for (int m = 0; m < 4; ++m) { const size_t off = (size_t)(row0 + ai * HALF + m * 16) * C5 + c;
                    const u32x4 s = *(const u32x4*)(vs + off), f = *(const u32x4*)(vf + off);
                    const f32x4 g0 = acc[ai][bj][m][0] + b0, g1 = acc[ai][bj][m][1] + b1;
                    float o[8];
#pragma unroll
                    for (int j = 0; j < 4; ++j) { const float sl = bflo(s[j]), sh = bfhi(s[j]), fl = bflo(f[j]), fh = bfhi(f[j]);
                        const float ga = (j < 2) ? g0[2 * j] : g1[2 * j - 4], gb = (j < 2) ? g0[2 * j + 1] : g1[2 * j - 3];
                        o[2 * j] = sl + (fl - sl) * sigmoidf_(ga); o[2 * j + 1] = sh + (fh - sh) * sigmoidf_(gb); }
                    u32x4 w; w.x = cvt_pk_bf16(o[0], o[1]); w.y = cvt_pk_bf16(o[2], o[3]); w.z = cvt_pk_bf16(o[4], o[5]); w.w = cvt_pk_bf16(o[6], o[7]);
                    *(u32x4*)(vr + off) = w; } }
    }
};
struct EpiWo {
    static constexpr bool PERM = false;
    float* X; const float* gt;
    __device__ __forceinline__ void operator()(const f32x4 (&acc)[2][2][4][2], const Unit& u, int wr, int wc, int fr, int fq) const {
        const int row0 = u.pm * BM + wr * 64 + fr, col0 = u.pn * BM + wc * 32 + 4 * fq;
        const int b = (u.pm * BM) / SEQ;
#pragma unroll
        for (int bj = 0; bj < 2; ++bj)
#pragma unroll
            for (int n = 0; n < 2; ++n) { const int c = col0 + bj * HALF + n * 16; const f32x4 g = *(const f32x4*)(gt + (size_t)b * 6144 + c) + 1.0f;
#pragma unroll
                for (int ai = 0; ai < 2; ++ai)
#pragma unroll
                    for (int m = 0; m < 4; ++m) { float* p = X + (size_t)(row0 + ai * HALF + m * 16) * D + c; const f32x4 x = *(const f32x4*)p; *(f32x4*)p = x * DN_ALPHA + g * acc[ai][bj][m][n]; } }
    }
};
struct EpiSwiglu {
    static constexpr bool PERM = true;
    bf16* O; const float* b1p;
    __device__ __forceinline__ void operator()(const f32x4 (&acc)[2][2][4][2], const Unit& u, int wr, int wc, int fr, int fq) const {
        const int row0 = u.pm * BM + wr * 64 + fr; const int cin = u.pn * BM + wc * 32 + 8 * fq, cout = u.pn * HALF + wc * 32 + 8 * fq;
        const float* bp = b1p + (size_t)u.e * 2048 + cin;
        const f32x4 bg0 = *(const f32x4*)(bp), bg1 = *(const f32x4*)(bp + 4), bl0 = *(const f32x4*)(bp + HALF), bl1 = *(const f32x4*)(bp + HALF + 4);
#pragma unroll
        for (int ai = 0; ai < 2; ++ai)
#pragma unroll
            for (int m = 0; m < 4; ++m) {
                const f32x4 g0 = acc[ai][0][m][0] + bg0, g1 = acc[ai][0][m][1] + bg1, l0 = acc[ai][1][m][0] + bl0, l1 = acc[ai][1][m][1] + bl1;
                float o[8];
#pragma unroll
                for (int j = 0; j < 8; ++j) { const float gv = fminf(j < 4 ? g0[j & 3] : g1[j & 3], 7.0f); const float lv = fminf(fmaxf(j < 4 ? l0[j & 3] : l1[j & 3], -7.0f), 7.0f);
                    o[j] = gv * sigmoidf_(1.702f * gv) * (lv + 1.0f); }
                u32x4 w; w.x = cvt_pk_bf16(o[0], o[1]); w.y = cvt_pk_bf16(o[2], o[3]); w.z = cvt_pk_bf16(o[4], o[5]); w.w = cvt_pk_bf16(o[6], o[7]);
                *(u32x4*)(O + (size_t)(row0 + ai * HALF + m * 16) * FF + cout) = w; }
    }
};
struct EpiMoeOut {
    static constexpr bool PERM = true;
    bf16* O; const float* b2; const float* gatel; const LAS int* tb;
    __device__ __forceinline__ void operator()(const f32x4 (&acc)[2][2][4][2], const Unit& u, int wr, int wc, int fr, int fq) const {
        const int row0 = u.pm * BM + wr * 64 + fr, col0 = u.pn * BM + wc * 32 + 8 * fq;
        const int pos0 = (u.pm - tb[u.e]) * BM + wr * 64 + fr;
        const float* bp = b2 + (size_t)u.e * D + col0;
        f32x4 bv[2][2];
#pragma unroll
        for (int bj = 0; bj < 2; ++bj) { bv[bj][0] = *(const f32x4*)(bp + bj * HALF); bv[bj][1] = *(const f32x4*)(bp + bj * HALF + 4); }
#pragma unroll
        for (int ai = 0; ai < 2; ++ai)
#pragma unroll
            for (int m = 0; m < 4; ++m) { const float gt = gatel[(size_t)u.e * CAP + pos0 + ai * HALF + m * 16];
                bf16* rowp = O + (size_t)(row0 + ai * HALF + m * 16) * D + col0;
#pragma unroll
                for (int bj = 0; bj < 2; ++bj) { const f32x4 v0 = (acc[ai][bj][m][0] + bv[bj][0]) * gt, v1 = (acc[ai][bj][m][1] + bv[bj][1]) * gt;
                    u32x4 w; w.x = cvt_pk_bf16(v0[0], v0[1]); w.y = cvt_pk_bf16(v0[2], v0[3]); w.z = cvt_pk_bf16(v1[0], v1[1]); w.w = cvt_pk_bf16(v1[2], v1[3]);
                    *(u32x4*)(rowp + bj * HALF) = w; } }
    }
};
}

struct Params { const void* in[N_INPUTS]; float* out; unsigned char* ws; int ph_lo, ph_hi; };

struct Frame {
    LAS unsigned char* lds;
    int tid, lane, wave, G, vcu;
    unsigned char* ws;
};
#define WSP(type, off) ((type*)(F.ws + (off)))
#define INP(i) ((const float*)p.in[i])

__device__ const double INV_FREQ[16] = {1.00000000000000000e+00, 5.62341325190349073e-01, 3.16227766016837941e-01, 1.77827941003892293e-01, 1.00000000000000006e-01, 5.62341325190349114e-02,
    3.16227766016837913e-02, 1.77827941003892293e-02, 1.00000000000000002e-02, 5.62341325190349097e-03, 3.16227766016837939e-03, 1.77827941003892275e-03, 1.00000000000000002e-03,
    5.62341325190349097e-04, 3.16227766016837939e-04, 1.77827941003892270e-04};

template <int MODE>
__device__ __forceinline__ void tr_item(const float* W, int ldn, bf16* WT, int ldk, int kofs, int rofs, int k0, int n0, LAS float* scr, int lane) {
#pragma unroll 8
    for (int i = 0; i < 32; ++i) { const int kk = 2 * i + (lane >> 5); scr[kk * 33 + (lane & 31)] = W[(size_t)(k0 + kk) * ldn + n0 + (lane & 31)]; }
    LDS_WAIT(); asm volatile("" ::: "memory");
    const int c = lane & 7;
#pragma unroll
    for (int j = 0; j < 4; ++j) { const int n = (lane >> 3) + 8 * j; const LAS float* s = scr + (8 * c) * 33 + n;
        u32x4 o; o.x = pk2(s[0 * 33], s[1 * 33]); o.y = pk2(s[2 * 33], s[3 * 33]); o.z = pk2(s[4 * 33], s[5 * 33]); o.w = pk2(s[6 * 33], s[7 * 33]);
        const int ng = n0 + n; int row;
        if (MODE == 0) row = rofs + ng; else { const int jo = ng >> 1, bj = ng & 1; row = rofs + (jo >> 7) * 256 + bj * 128 + (jo & 127); }
        *(GAS u32x4*)(WT + (size_t)row * ldk + kofs + k0 + 8 * c) = o; }
    LDS_WAIT(); asm volatile("" ::: "memory");
}
__device__ __forceinline__ void zero_rect(const Frame& F, bf16* M, int ld, int r0, int nrows, int c0, int ncols) {
    const int gw = F.vcu * NWAVES + F.wave, NGW = F.G * NWAVES; const int nch = ncols / 8;
    for (int r = gw; r < nrows; r += NGW)
        for (int ch = F.lane; ch < nch; ch += 64) *(GAS u32x4*)(M + (size_t)(r0 + r) * ld + c0 + ch * 8) = (u32x4){0u, 0u, 0u, 0u};
}
__device__ __forceinline__ void phase_prologue(const Params& p, const Frame& F) {
    LAS float* scr = (LAS float*)(F.lds + F.wave * 16384);
    const int gw = F.vcu * NWAVES + F.wave, NGW = F.G * NWAVES;
    constexpr int I_IN = 16 * 69, I_UQ = 4 * 24, I_UK = 2 * 16, I_W2s = 16, I_G2s = 2 * 16, I_WO_ = 16 * 32, I_E1 = 16 * 64, I_E2 = 16 * 32;
    constexpr int PER_L = I_IN + I_UQ + 2 * I_UK + 2 * I_W2s + I_G2s + I_WO_;
    constexpr int NSMALL = DEPTH * PER_L, NE1 = DEPTH * NE * I_E1, NE2 = DEPTH * NE * I_E2;
    for (int it = gw; it < NSMALL + NE1 + NE2; it += NGW) {
        int r = it;
        if (r < NSMALL) {
            const int l = r / PER_L; r -= l * PER_L;
            if (r < I_IN) { tr_item<0>(INP(I_WIN) + (size_t)l * D * N_IN, N_IN, WSP(bf16, WS_WINT) + (size_t)l * N_INP * D, D, 0, 0, 64 * (r / 69), 32 * (r % 69), scr, F.lane); continue; } r -= I_IN;
            bf16* up = WSP(bf16, WS_WUPT) + (size_t)l * N_UP * K_UP;
            if (r < I_UQ) { tr_item<0>(INP(I_WUQ) + (size_t)l * QLR * 768, 768, up, K_UP, 0, 0, 64 * (r / 24), 32 * (r % 24), scr, F.lane); continue; } r -= I_UQ;
            if (r < I_UK) { tr_item<0>(INP(I_WUK) + (size_t)l * KVLR * 512, 512, up, K_UP, 256, 768, 64 * (r / 16), 32 * (r % 16), scr, F.lane); continue; } r -= I_UK;
            if (r < I_UK) { tr_item<0>(INP(I_WUV) + (size_t)l * KVLR * 512, 512, up, K_UP, 256, 1280, 64 * (r / 16), 32 * (r % 16), scr, F.lane); continue; } r -= I_UK;
            bf16* sm = WSP(bf16, WS_WSMT) + (size_t)l * N_SM * K_SM;
            if (r < I_W2s) { tr_item<0>(INP(I_W2) + (size_t)l * 64 * 512, 512, sm, K_SM, 0, 0, 0, 32 * r, scr, F.lane); continue; } r -= I_W2s;
            if (r < I_W2s) { tr_item<0>(INP(I_A2) + (size_t)l * 64 * 512, 512, sm, K_SM, 64, 512, 0, 32 * r, scr, F.lane); continue; } r -= I_W2s;
            if (r < I_G2s) { tr_item<0>(INP(I_G2) + (size_t)l * 128 * 512, 512, sm, K_SM, 128, 1024, 64 * (r / 16), 32 * (r % 16), scr, F.lane); continue; } r -= I_G2s;
            tr_item<0>(INP(I_WO) + (size_t)l * D * D, D, WSP(bf16, WS_WOT) + (size_t)l * D * D, D, 0, 0, 64 * (r / 32), 32 * (r % 32), scr, F.lane); continue;
        }
        r -= NSMALL;
        if (r < NE1) { const int le = r / I_E1; r -= le * I_E1;
            tr_item<1>(INP(I_EW1) + (size_t)le * D * 2048, 2048, WSP(bf16, WS_W1T) + (size_t)le * 2048 * D, D, 0, 0, 64 * (r / 64), 32 * (r % 64), scr, F.lane); continue; }
        r -= NE1;
        { const int le = r / I_E2; r -= le * I_E2;
            tr_item<0>(INP(I_EW2) + (size_t)le * FF * D, D, WSP(bf16, WS_W2T) + (size_t)le * D * FF, FF, 0, 0, 64 * (r / 32), 32 * (r % 32), scr, F.lane); }
    }
    for (int l = 0; l < DEPTH; ++l) {
        zero_rect(F, WSP(bf16, WS_WINT) + (size_t)l * N_INP * D, D, N_IN, N_INP - N_IN, 0, D);
        bf16* up = WSP(bf16, WS_WUPT) + (size_t)l * N_UP * K_UP;
        zero_rect(F, up, K_UP, 0, 768, 256, 128); zero_rect(F, up, K_UP, 768, 1024, 0, 256);
        bf16* sm = WSP(bf16, WS_WSMT) + (size_t)l * N_SM * K_SM;
        zero_rect(F, sm, K_SM, 0, 512, 64, 192); zero_rect(F, sm, K_SM, 512, 512, 0, 64); zero_rect(F, sm, K_SM, 512, 512, 128, 128); zero_rect(F, sm, K_SM, 1024, 512, 0, 128);
    }
    const int gt = (F.vcu * NTHREADS) + F.tid, NGT = F.G * NTHREADS;
    { const float* v1 = INP(I_V1); const float* v2 = INP(I_V2); bf16* o = WSP(bf16, WS_WV12T);
      for (int i = gt; i < 512 * 512; i += NGT) { const int n = i >> 9, k = i & 511; float s = 0.f;
#pragma unroll 8
          for (int j = 0; j < 32; ++j) s += v1[k * 32 + j] * v2[j * 512 + n];
          o[i] = (bf16)f2bf(s); } }
    { const float* b1 = INP(I_EB1); float* o = WSP(float, WS_B1P);
      for (int i = gt; i < DEPTH * NE * 2048; i += NGT) { const int q = i & 2047, le = i >> 11; const int pn = q >> 8, bj = (q >> 7) & 1, jj = q & 127; o[i] = b1[(size_t)le * 2048 + 2 * (pn * 128 + jj) + bj]; } }
    { const int* pos = (const int*)p.in[I_POS]; float* cs = WSP(float, WS_CS);
      for (int i = gt; i < T * 16; i += NGT) { const int t = i >> 4, k = i & 15; const double a = (double)pos[t] * INV_FREQ[k];
          const double q = __builtin_rint(a * 0.63661977236758134308); const int qi = (int)((long long)q & 3);
          double r = __builtin_fma(-q, 1.57079632679489655800e+00, a); r = __builtin_fma(-q, 6.12323399573676603587e-17, r);
          const double r2 = r * r;
          double sn = -2.50521083854417187751e-08; sn = sn * r2 + 2.75573192239858906526e-06; sn = sn * r2 - 1.98412698412698412698e-04; sn = sn * r2 + 8.33333333333333333333e-03; sn = sn * r2 - 1.66666666666666666667e-01; sn = r + r * r2 * sn;
          double cn = 2.08767569878680989792e-09; cn = cn * r2 - 2.75573192239858906526e-07; cn = cn * r2 + 2.48015873015873015873e-05; cn = cn * r2 - 1.38888888888888888889e-03; cn = cn * r2 + 4.16666666666666666667e-02; cn = cn * r2 - 0.5; cn = 1.0 + r2 * cn;
          double sv, cv;
          if (qi == 0) { sv = sn; cv = cn; } else if (qi == 1) { sv = cn; cv = -sn; } else if (qi == 2) { sv = -sn; cv = -cn; } else { sv = -cn; cv = sn; }
          cs[2 * i] = (float)cv; cs[2 * i + 1] = (float)sv; } }
    { LAS float* cact = (LAS float*)(F.lds);
      LAS float* part = (LAS float*)(F.lds + 32768);
      __syncthreads();
      const float* c = INP(I_C);
      for (int i = F.tid; i < NBATCH * D; i += NTHREADS) { const float v = c[i]; cact[i] = v / (1.0f + __expf(-v)); }
      __syncthreads();
      for (int item = F.vcu; item < DEPTH * 96; item += F.G) { const int l = item / 96, n0 = (item % 96) * 64;
          const float* aw = INP(I_ADAW) + (size_t)l * D * 6144 + n0 + F.lane;
          float a8[8];
#pragma unroll
          for (int b = 0; b < 8; ++b) a8[b] = 0.f;
          const int kb = F.wave * 128;
#pragma unroll 4
          for (int k = 0; k < 128; ++k) { const float wv = aw[(size_t)(kb + k) * 6144];
#pragma unroll
              for (int b = 0; b < 8; ++b) a8[b] += cact[b * D + kb + k] * wv; }
#pragma unroll
          for (int b = 0; b < 8; ++b) part[(F.wave * 8 + b) * 64 + F.lane] = a8[b];
          __syncthreads();
          { const int b = F.wave; float s = 0.f;
#pragma unroll
            for (int w = 0; w < 8; ++w) s += part[(w * 8 + b) * 64 + F.lane];
            WSP(float, WS_MOD)[((size_t)l * NBATCH + b) * 6144 + n0 + F.lane] = s + INP(I_ADAB)[(size_t)l * 6144 + n0 + F.lane]; }
          __syncthreads(); }
    }
}

__device__ __forceinline__ void phase_ln0(const Params& p, const Frame& F) {
    const int gw = F.vcu * NWAVES + F.wave, NGW = F.G * NWAVES;
    const float* mod = WSP(float, WS_MOD);
    for (int m = gw; m < T; m += NGW) {
        const int b = m / SEQ;
        const GAS f32x4* xr = (const GAS f32x4*)(INP(I_X) + (size_t)m * D) + F.lane;
        f32x4 v[4]; float s = 0.f;
#pragma unroll
        for (int j = 0; j < 4; ++j) { v[j] = xr[64 * j]; s += (v[j].x + v[j].y) + (v[j].z + v[j].w); }
        const float mean = wave_sum(s) * (1.f / D); float s2 = 0.f;
#pragma unroll
        for (int j = 0; j < 4; ++j) { v[j] = v[j] - mean; s2 += (v[j].x * v[j].x + v[j].y * v[j].y) + (v[j].z * v[j].z + v[j].w * v[j].w); }
        const float rstd = 1.f / sqrtf(wave_sum(s2) * (1.f / D) + LN_EPS);
        GAS f32x4* xo = (GAS f32x4*)(WSP(float, WS_X) + (size_t)m * D) + F.lane;
        GAS u32x2* ho = (GAS u32x2*)(WSP(bf16, WS_H) + (size_t)m * D) + F.lane;
#pragma unroll
        for (int j = 0; j < 4; ++j) { const int c = 4 * F.lane + 256 * j;
            const f32x4 g = *(const f32x4*)(INP(I_ELNG) + c), be = *(const f32x4*)(INP(I_ELNB) + c);
            const f32x4 x0 = v[j] * rstd * g + be; xo[64 * j] = x0;
            const f32x4 sh = *(const f32x4*)(mod + (size_t)b * 6144 + c), sc = *(const f32x4*)(mod + (size_t)b * 6144 + 1024 + c);
            const f32x4 h = x0 * (sc + 1.0f) + sh; u32x2 w; w.x = pk2(h.x, h.y); w.y = pk2(h.z, h.w); ho[64 * j] = w; }
    }
}

__device__ __forceinline__ void phase_prep(const Params& p, const Frame& F, int l) {
    const int gw = F.vcu * NWAVES + F.wave, NGW = F.G * NWAVES; const int lane = F.lane;
    const bf16* P = WSP(bf16, WS_P); const float* mu = INP(I_MU) + (size_t)l * RWKV_IN;
    const float* qg = INP(I_QNG) + (size_t)l * QLR; const float* kvg = INP(I_KVNG) + (size_t)l * KVLR;
    bf16* AN = WSP(bf16, WS_AN); bf16* A2 = WSP(bf16, WS_A2); bf16* RK = WSP(bf16, WS_RK); bf16* KKb = WSP(bf16, WS_KK);
    bf16* VS = l == 0 ? WSP(bf16, WS_VS0) : WSP(bf16, WS_VS1);
    const float* cs = WSP(float, WS_CS);
    for (int t = gw; t < T; t += NGW) {
        const bf16* pr = P + (size_t)t * N_INP; const bool first = (t % SEQ) == 0; const bf16* pp = pr - N_INP;
        { const u32x2 qw = *(const u32x2*)(pr + 4 * lane); float q0 = bflo(qw.x), q1 = bfhi(qw.x), q2 = bflo(qw.y), q3 = bfhi(qw.y);
          const float rq = 1.f / sqrtf(wave_sum(q0 * q0 + q1 * q1 + q2 * q2 + q3 * q3) * (1.f / QLR) + RMS_EPS);
          const f32x4 g = *(const f32x4*)(qg + 4 * lane);
          u32x2 w; w.x = pk2(q0 * rq * g.x, q1 * rq * g.y); w.y = pk2(q2 * rq * g.z, q3 * rq * g.w); *(u32x2*)(AN + (size_t)t * K_UP + 4 * lane) = w;
          const unsigned kw = *(const unsigned*)(pr + QLR + 2 * lane); const float k0 = bflo(kw), k1 = bfhi(kw);
          const float rk = 1.f / sqrtf(wave_sum(k0 * k0 + k1 * k1) * (1.f / KVLR) + RMS_EPS);
          const f32x2 g2 = *(const f32x2*)(kvg + 2 * lane);
          *(unsigned*)(AN + (size_t)t * K_UP + QLR + 2 * lane) = pk2(k0 * rk * g2.x, k1 * rk * g2.y);
          const int i = lane & 15; const unsigned rw = *(const unsigned*)(pr + QLR + KVLR + 2 * i); const float x0 = bflo(rw), x1 = bfhi(rw);
          const f32x2 csv = *(const f32x2*)(cs + (size_t)t * 32 + 2 * i); const unsigned ro = pk2(x0 * csv.x - x1 * csv.y, x0 * csv.y + x1 * csv.x);
          const int h0 = (lane >> 4) * 2;
          *(unsigned*)(KKb + (size_t)t * 768 + h0 * QKD + NOPE + 2 * i) = ro; *(unsigned*)(KKb + (size_t)t * 768 + (h0 + 1) * QKD + NOPE + 2 * i) = ro; }
        const bf16* rr = pr + MLA_IN; const bf16* rp = pp + MLA_IN;
#pragma unroll
        for (int part = 0; part < 3; ++part) {
            const int c = part * 512 + 8 * lane; const u32x4 cw = *(const u32x4*)(rr + c); u32x4 pw = (u32x4){0u, 0u, 0u, 0u}; if (!first) pw = *(const u32x4*)(rp + c);
            const f32x4 m0 = *(const f32x4*)(mu + c), m1 = *(const f32x4*)(mu + c + 4);
            float o[8];
#pragma unroll
            for (int j = 0; j < 4; ++j) { const float a = bflo(cw[j]), b = bfhi(cw[j]), pa = bflo(pw[j]), pb = bfhi(pw[j]); const float ma = j < 2 ? m0[2 * j] : m1[2 * j - 4], mb = j < 2 ? m0[2 * j + 1] : m1[2 * j - 3];
                o[2 * j] = a + ma * (pa - a); o[2 * j + 1] = b + mb * (pb - b); }
            u32x4 w; w.x = pk2(o[0], o[1]); w.y = pk2(o[2], o[3]); w.z = pk2(o[4], o[5]); w.w = pk2(o[6], o[7]);
            if (part < 2) *(u32x4*)(RK + (size_t)t * 1024 + part * 512 + 8 * lane) = w; else *(u32x4*)(VS + (size_t)t * C5 + 8 * lane) = w;
        }
        { const int c = 1536 + lane; const float a = bf2f(rr[c]), pa = first ? 0.f : bf2f(rp[c]); const float v = a + mu[c] * (pa - a); A2[(size_t)t * K_SM + lane] = (bf16)f2bf(tanhf(v)); }
        { const int c = 1600 + lane; const float a = bf2f(rr[c]), pa = first ? 0.f : bf2f(rp[c]); const float v = a + mu[c] * (pa - a); A2[(size_t)t * K_SM + 64 + lane] = (bf16)f2bf(v); }
        { const int c = 1664 + 2 * lane; const unsigned cw = *(const unsigned*)(rr + c); const unsigned pw = first ? 0u : *(const unsigned*)(rp + c);
          const f32x2 m = *(const f32x2*)(mu + c); const float a = bflo(cw), b = bfhi(cw); const float va = a + m.x * (bflo(pw) - a), vb = b + m.y * (bfhi(pw) - b);
          *(unsigned*)(A2 + (size_t)t * K_SM + 128 + 2 * lane) = pk2(sigmoidf_(va), sigmoidf_(vb)); }
    }
}

namespace att {
__device__ __forceinline__ int crow(int r, int hi) { return (r & 3) + 8 * (r >> 2) + 4 * hi; }
constexpr int KSLOT = 12288, VSLOT = 8192;
constexpr int LDS_K = 0, LDS_V = 2 * KSLOT, LDS_WS = LDS_V + 2 * VSLOT, LDS_OST = LDS_WS + NWAVES * 64 * 4, LDS_TOTAL = LDS_OST + NWAVES * 4096;
__device__ __forceinline__ void glds16(const void* gsrc, unsigned lds_dst) { unsigned keep;
    asm volatile("s_mov_b32 %0, m0\n\ts_mov_b32 m0, %2\n\ts_nop 0\n\tglobal_load_lds_dwordx4 %1, off\n\ts_mov_b32 m0, %0" : "=&s"(keep) : "v"(gsrc), "s"(lds_dst) : "memory"); }
__device__ __forceinline__ float max3f(float a, float b, float c) { return fmaxf(fmaxf(a, b), c); }
#define ATT_WAIT_BAR() asm volatile("s_waitcnt vmcnt(0) lgkmcnt(0)\n\ts_barrier" ::: "memory")
__device__ __forceinline__ float rowmax(const f32x16& p0, const f32x16& p1) {
    float a = max3f(p0[0], p0[1], p1[0]), b = max3f(p0[2], p0[3], p1[1]); a = max3f(a, p1[2], p1[3]);
#pragma unroll
    for (int r = 4; r < 16; r += 4) { a = max3f(a, p0[r], p0[r + 1]); b = max3f(b, p0[r + 2], p0[r + 3]); a = max3f(a, p1[r], p1[r + 1]); b = max3f(b, p1[r + 2], p1[r + 3]); }
    const float m = fmaxf(a, b);
    auto rr = __builtin_amdgcn_permlane32_swap(__float_as_uint(m), __float_as_uint(m), false, false);
    return fmaxf(__uint_as_float(rr[0]), __uint_as_float(rr[1]));
}
__device__ __forceinline__ void pv(f32x16* o, int vb, bf16x8 pa0, bf16x8 pa1, bf16x8 pa2, bf16x8 pa3) {
#pragma unroll
    for (int d0 = 0; d0 < 2; ++d0) { s16x4 lo[4], hi[4];
#pragma unroll
        for (int ks = 0; ks < 4; ++ks) {
            asm volatile("ds_read_b64_tr_b16 %0,%1 offset:%c2" : "=&v"(lo[ks]) : "v"(vb), "i"(d0 * 4096 + ks * 1024) : "memory");
            asm volatile("ds_read_b64_tr_b16 %0,%1 offset:%c2" : "=&v"(hi[ks]) : "v"(vb), "i"(d0 * 4096 + ks * 1024 + 512) : "memory"); }
        asm volatile("s_waitcnt lgkmcnt(0)" ::: "memory"); __builtin_amdgcn_sched_barrier(0);
#define PK(k) (bf16x8){lo[k][0], lo[k][1], lo[k][2], lo[k][3], hi[k][0], hi[k][1], hi[k][2], hi[k][3]}
        o[d0] = __builtin_amdgcn_mfma_f32_32x32x16_bf16(pa0, PK(0), o[d0], 0, 0, 0);
        o[d0] = __builtin_amdgcn_mfma_f32_32x32x16_bf16(pa1, PK(1), o[d0], 0, 0, 0);
        o[d0] = __builtin_amdgcn_mfma_f32_32x32x16_bf16(pa2, PK(2), o[d0], 0, 0, 0);
        o[d0] = __builtin_amdgcn_mfma_f32_32x32x16_bf16(pa3, PK(3), o[d0], 0, 0, 0);
#undef PK
    }
}
__device__ __forceinline__ void attn_unit(int b, int h, int qb, const bf16* Q, const bf16* __restrict__ KKp, const bf16* __restrict__ Vp, bf16* O, char* shm) {
    const int tid = threadIdx.x, lane = tid & 63, r32 = lane & 31, hi = lane >> 5; const int wid = __builtin_amdgcn_readfirstlane(tid >> 6);
    const long rowbase = (long)b * SEQ; const int q0 = qb * 256;
    const bf16* Qw = Q + (rowbase + q0 + wid * 32) * 768 + h * QKD;
    const bf16* Kh = KKp + rowbase * 768 + h * QKD; const bf16* Vh = Vp + rowbase * 512 + h * VD;
    const unsigned lds0 = (unsigned)(uintptr_t)shm;
    float* wsf = (float*)(shm + LDS_WS) + wid * 64;
    const bf16* ksrc0 = Kh + (long)lane * 768 + wid * 8;
    const bf16* ksrc1 = Kh + (long)lane * 768 + (8 + (wid & 3)) * 8;
    const bf16* vsrc = Vh + (long)(16 * (wid & 3) + (lane >> 2)) * 512 + (wid >> 2) * 32 + (lane & 3) * 8;
    const unsigned kdst0 = lds0 + LDS_K + wid * 1024, kdst1 = lds0 + LDS_K + (8 + (wid & 3)) * 1024, vdst = lds0 + LDS_V + wid * 1024;
#define DMA_KV(t, s) do { glds16(ksrc0 + (long)(t) * 64 * 768, (unsigned)__builtin_amdgcn_readfirstlane(kdst0 + (s) * KSLOT)); \
        if (wid < 4) glds16(ksrc1 + (long)(t) * 64 * 768, (unsigned)__builtin_amdgcn_readfirstlane(kdst1 + (s) * KSLOT)); \
        glds16(vsrc + (long)(t) * 64 * 512, (unsigned)__builtin_amdgcn_readfirstlane(vdst + (s) * VSLOT)); } while (0)
    const int vb0 = (int)(lds0 + LDS_V) + ((lane >> 4) & 1) * 32 + (lane & 3) * 8 + (4 * hi + ((lane & 15) >> 2)) * 64;
    const int NT = (q0 + 256) / 64;
    DMA_KV(0, 0);
    bf16x8 qr[6];
#pragma unroll
    for (int d0 = 0; d0 < 6; ++d0) qr[d0] = *reinterpret_cast<const bf16x8*>(&Qw[(long)r32 * 768 + d0 * 16 + hi * 8]);
    float mrun = -INFINITY, l_reg = 0.f; f32x16 o[2]; o[0] = f32x16{}; o[1] = f32x16{};
    const int qrel = wid * 32 + r32;
    for (int t = 0; t < NT; ++t) {
        ATT_WAIT_BAR();
        if (t + 1 < NT) DMA_KV(t + 1, (t + 1) & 1);
        const char* Kslot = shm + LDS_K + (t & 1) * KSLOT;
        f32x16 p0 = f32x16{}, p1 = f32x16{};
        { const char* kb = Kslot + hi * 1024 + r32 * 16;
#pragma unroll
          for (int d0 = 0; d0 < 6; ++d0) { const bf16x8 b0 = *reinterpret_cast<const bf16x8*>(kb + d0 * 2048); const bf16x8 b1 = *reinterpret_cast<const bf16x8*>(kb + d0 * 2048 + 512);
              p0 = __builtin_amdgcn_mfma_f32_32x32x16_bf16(b0, qr[d0], p0, 0, 0, 0); p1 = __builtin_amdgcn_mfma_f32_32x32x16_bf16(b1, qr[d0], p1, 0, 0, 0); } }
        const int jb = t - (NT - 4);
        if (jb >= 0) { const int kbase = 64 * jb + 4 * hi;
#pragma unroll
            for (int r = 0; r < 16; ++r) { const int kv = kbase + (r & 3) + 8 * (r >> 2); if (kv > qrel) p0[r] = -INFINITY; if (kv + 32 > qrel) p1[r] = -INFINITY; } }
        const float rm = rowmax(p0, p1); const float mnew = fmaxf(mrun, rm); const float f = exp2f(mrun - mnew); mrun = mnew;
        float sacc = 0.f;
#pragma unroll
        for (int r = 0; r < 16; ++r) { p0[r] = exp2f(p0[r] - mnew); p1[r] = exp2f(p1[r] - mnew); sacc += p0[r] + p1[r]; }
        l_reg = l_reg * f + sacc;
        if (hi == 0) wsf[r32] = f;
        asm volatile("s_waitcnt lgkmcnt(0)" ::: "memory");
#pragma unroll
        for (int r = 0; r < 16; ++r) { const float fr_ = wsf[crow(r, hi)]; o[0][r] *= fr_; o[1][r] *= fr_; }
        u32x4 pw0, pw1, pw2, pw3;
        pw0 = (u32x4){cvt_pk_bf16(p0[0], p0[1]), cvt_pk_bf16(p0[2], p0[3]), cvt_pk_bf16(p0[4], p0[5]), cvt_pk_bf16(p0[6], p0[7])};
        pw1 = (u32x4){cvt_pk_bf16(p0[8], p0[9]), cvt_pk_bf16(p0[10], p0[11]), cvt_pk_bf16(p0[12], p0[13]), cvt_pk_bf16(p0[14], p0[15])};
        pw2 = (u32x4){cvt_pk_bf16(p1[0], p1[1]), cvt_pk_bf16(p1[2], p1[3]), cvt_pk_bf16(p1[4], p1[5]), cvt_pk_bf16(p1[6], p1[7])};
        pw3 = (u32x4){cvt_pk_bf16(p1[8], p1[9]), cvt_pk_bf16(p1[10], p1[11]), cvt_pk_bf16(p1[12], p1[13]), cvt_pk_bf16(p1[14], p1[15])};
        asm volatile("s_waitcnt lgkmcnt(0)" ::: "memory");
        pv(o, vb0 + (t & 1) * VSLOT, __builtin_bit_cast(bf16x8, pw0), __builtin_bit_cast(bf16x8, pw1), __builtin_bit_cast(bf16x8, pw2), __builtin_bit_cast(bf16x8, pw3));
    }
    { auto rr = __builtin_amdgcn_permlane32_swap(__float_as_uint(l_reg), __float_as_uint(l_reg), false, false); l_reg = __uint_as_float(rr[0]) + __uint_as_float(rr[1]); }
    if (hi == 0) wsf[32 + r32] = l_reg; asm volatile("s_waitcnt lgkmcnt(0)" ::: "memory");
    float rli[16];
#pragma unroll
    for (int r = 0; r < 16; ++r) rli[r] = 1.0f / wsf[32 + crow(r, hi)];
    bf16* Ow = O + (rowbase + q0 + wid * 32) * 512 + h * VD;
    { bf16* stg = (bf16*)(shm + LDS_OST) + wid * 2048;
#pragma unroll
      for (int r = 0; r < 16; ++r) { const int orow = crow(r, hi);
#pragma unroll
          for (int d0 = 0; d0 < 2; ++d0) stg[orow * 64 + d0 * 32 + r32] = (bf16)f2bf(o[d0][r] * rli[r]); }
      asm volatile("s_waitcnt lgkmcnt(0)" ::: "memory");
#pragma unroll
      for (int i = 0; i < 4; ++i) { const int row = i * 8 + (lane >> 3), ch = lane & 7; const u32x4 v = *(const u32x4*)(stg + row * 64 + ch * 8); *(u32x4*)(Ow + (long)row * 512 + ch * 8) = v; } }
    asm volatile("s_waitcnt vmcnt(0) lgkmcnt(0)\n\ts_barrier" ::: "memory");
#undef DMA_KV
}
}

__device__ __forceinline__ void phase_attn(const Params& p, const Frame& F, char* lds_generic) {
    const bf16* Q = WSP(bf16, WS_Q); const bf16* KKp = WSP(bf16, WS_KK); const bf16* Vp = WSP(bf16, WS_V); bf16* O = WSP(bf16, WS_O);
    for (int u = F.vcu; u < 256; u += F.G) { const int bh = u >> 2, s = u & 3;
#pragma unroll 1
        for (int i = 0; i < 4; ++i) { const int qb = (i == 0) ? s : (i == 1) ? 7 - s : (i == 2) ? 8 + s : 15 - s;
            att::attn_unit(bh >> 3, bh & 7, qb, Q, KKp, Vp, O, lds_generic); } }
}

__device__ __forceinline__ float dpp_add(float x, const int ctrl_sel) { return x; }
#define DPP_F(x, ctrl) __builtin_bit_cast(float, __builtin_amdgcn_update_dpp(0, __builtin_bit_cast(int, (x)), (ctrl), 0xF, 0xF, true))
__device__ __forceinline__ float row16_sum(float x) {
    x += DPP_F(x, 0xB1);
    x += DPP_F(x, 0x4E);
    x += DPP_F(x, 0x141);
    x += DPP_F(x, 0x140);
    return x;
}
__device__ __forceinline__ void phase_rwkv(const Params& p, const Frame& F, int l) {
    constexpr int TC = 64;
    LAS float* sK = (LAS float*)(F.lds);
    LAS float* sB = sK + TC * 64;
    LAS float* sKp = sB + TC * 64;
    LAS float* sWR = sKp + TC * 64;
    LAS float* sW = sWR + TC * 64;
    LAS float* sV = sW + TC * 64;
    LAS float* sC = sV + TC * 32;
    LAS float* sO = sC + TC * 2;
    const bf16* RK = WSP(bf16, WS_RK); const float* WAG = WSP(float, WS_WAG);
    const bf16* Vv = l == 0 ? WSP(bf16, WS_VS0) : WSP(bf16, WS_VR);
    float* RO = WSP(float, WS_RO);
    const float* kkw = INP(I_KK) + (size_t)l * C5; const float* kaw = INP(I_KA) + (size_t)l * C5;
    const int tid = F.tid, lane = F.lane, wave = F.wave;
    for (int u = F.vcu; u < 128; u += F.G) {
        const int bh = u >> 1, half = u & 1, b = bh >> 3, h = bh & 7;
        const size_t row0 = (size_t)b * SEQ;
        float s0 = 0.f, s1 = 0.f, s2 = 0.f, s3 = 0.f;
        const int rsub = lane >> 4, jg = lane & 15, myrow = wave * 4 + rsub;
        for (int ch = 0; ch < SEQ / TC; ++ch) {
            __syncthreads();
            { const int t = tid >> 3, j8 = tid & 7; const size_t tok = row0 + ch * TC + t; const int c = h * 64 + 8 * j8;
              const u32x4 rw = *(const u32x4*)(RK + tok * 1024 + c), kw = *(const u32x4*)(RK + tok * 1024 + 512 + c);
              const f32x4 d0 = *(const f32x4*)(WAG + tok * N_SM + c), d1 = *(const f32x4*)(WAG + tok * N_SM + c + 4);
              const f32x4 a0 = *(const f32x4*)(WAG + tok * N_SM + 512 + c), a1 = *(const f32x4*)(WAG + tok * N_SM + 512 + c + 4);
              const f32x4 kk0 = *(const f32x4*)(kkw + c), kk1 = *(const f32x4*)(kkw + c + 4), ka0 = *(const f32x4*)(kaw + c), ka1 = *(const f32x4*)(kaw + c + 4);
              float r[8], k[8], a[8], d[8], kk[8]; float ss = 0.f;
#pragma unroll
              for (int j = 0; j < 4; ++j) { r[2 * j] = bflo(rw[j]); r[2 * j + 1] = bfhi(rw[j]); k[2 * j] = bflo(kw[j]); k[2 * j + 1] = bfhi(kw[j]); }
#pragma unroll
              for (int j = 0; j < 8; ++j) { a[j] = j < 4 ? a0[j & 3] : a1[j & 3]; d[j] = j < 4 ? d0[j & 3] : d1[j & 3]; kk[j] = k[j] * (j < 4 ? kk0[j & 3] : kk1[j & 3]); ss += kk[j] * kk[j]; }
              ss += __shfl_xor(ss, 1); ss += __shfl_xor(ss, 2); ss += __shfl_xor(ss, 4);
              const float inv = 1.0f / fmaxf(sqrtf(ss), 1e-12f);
              float c1 = 0.f, c2 = 0.f;
#pragma unroll
              for (int j = 0; j < 8; ++j) { const float kap = kk[j] * inv, be = kap * a[j], kp = k[j] * (1.0f + (a[j] - 1.0f) * (j < 4 ? ka0[j & 3] : ka1[j & 3]));
                  const int o = t * 64 + 8 * j8 + j; sK[o] = kap; sB[o] = be; sKp[o] = kp; sWR[o] = d[j] * r[j]; sW[o] = d[j]; c1 += be * r[j]; c2 += kp * r[j]; }
              c1 += __shfl_xor(c1, 1); c1 += __shfl_xor(c1, 2); c1 += __shfl_xor(c1, 4); c2 += __shfl_xor(c2, 1); c2 += __shfl_xor(c2, 2); c2 += __shfl_xor(c2, 4);
              if (j8 == 0) { sC[2 * t] = c1; sC[2 * t + 1] = c2; }
              const u32x2 vw = *(const u32x2*)(Vv + tok * C5 + h * 64 + half * 32 + 4 * j8);
              sV[t * 32 + 4 * j8] = bflo(vw.x); sV[t * 32 + 4 * j8 + 1] = bfhi(vw.x); sV[t * 32 + 4 * j8 + 2] = bflo(vw.y); sV[t * 32 + 4 * j8 + 3] = bfhi(vw.y); }
            __syncthreads();
#pragma unroll 4
            for (int t = 0; t < TC; ++t) {
                const f32x4 ka = *(const LAS f32x4*)(sK + t * 64 + 4 * jg), wr4 = *(const LAS f32x4*)(sWR + t * 64 + 4 * jg), w4 = *(const LAS f32x4*)(sW + t * 64 + 4 * jg);
                const f32x4 be = *(const LAS f32x4*)(sB + t * 64 + 4 * jg), kp = *(const LAS f32x4*)(sKp + t * 64 + 4 * jg);
                const float vi = sV[t * 32 + myrow]; const f32x2 cc = *(const LAS f32x2*)(sC + 2 * t);
                float d1 = (s0 * ka.x + s1 * ka.y) + (s2 * ka.z + s3 * ka.w), d2 = (s0 * wr4.x + s1 * wr4.y) + (s2 * wr4.z + s3 * wr4.w);
                d1 = row16_sum(d1); d2 = row16_sum(d2);
                const float sa = -d1; const float ov = d2 + sa * cc.x + vi * cc.y;
                s0 = s0 * w4.x + sa * be.x + vi * kp.x; s1 = s1 * w4.y + sa * be.y + vi * kp.y; s2 = s2 * w4.z + sa * be.z + vi * kp.z; s3 = s3 * w4.w + sa * be.w + vi * kp.w;
                if (jg == 0) sO[t * 32 + myrow] = ov;
            }
            __syncthreads();
            for (int i = tid; i < TC * 32; i += NTHREADS) { const int t = i >> 5, r = i & 31; RO[(row0 + ch * TC + t) * C5 + h * 64 + half * 32 + r] = sO[i]; }
        }
    }
    __syncthreads();
}

__device__ __forceinline__ void phase_mix(const Params& p, const Frame& F, int l) {
    const int gw = F.vcu * NWAVES + F.wave, NGW = F.G * NWAVES; const int lane = F.lane;
    const bf16* O = WSP(bf16, WS_O); const float* RO = WSP(float, WS_RO); const bf16* RK = WSP(bf16, WS_RK); const float* WAG = WSP(float, WS_WAG);
    const bf16* Vv = l == 0 ? WSP(bf16, WS_VS0) : WSP(bf16, WS_VR); bf16* MIX = WSP(bf16, WS_MIX);
    const float* og = INP(I_MOUTG) + (size_t)l * C5; const float* gng = INP(I_GNG) + (size_t)l * C5; const float* gnb = INP(I_GNB) + (size_t)l * C5;
    const float* kaw = INP(I_KA) + (size_t)l * C5; const float* rkw = INP(I_RK) + (size_t)l * C5;
    for (int t = gw; t < T; t += NGW) {
        const int c = 8 * lane;
        { const u32x4 ow = *(const u32x4*)(O + (size_t)t * C5 + c); float o[8]; float ss = 0.f;
#pragma unroll
          for (int j = 0; j < 4; ++j) { o[2 * j] = bflo(ow[j]); o[2 * j + 1] = bfhi(ow[j]); ss += o[2 * j] * o[2 * j] + o[2 * j + 1] * o[2 * j + 1]; }
          const float rs = 1.f / sqrtf(wave_sum(ss) * (1.f / C5) + RMS_EPS);
          const f32x4 g0 = *(const f32x4*)(og + c), g1 = *(const f32x4*)(og + c + 4);
          u32x4 w; w.x = pk2(o[0] * rs * g0.x, o[1] * rs * g0.y); w.y = pk2(o[2] * rs * g0.z, o[3] * rs * g0.w); w.z = pk2(o[4] * rs * g1.x, o[5] * rs * g1.y); w.w = pk2(o[6] * rs * g1.z, o[7] * rs * g1.w);
          *(u32x4*)(MIX + (size_t)t * D + c) = w; }
        { const f32x4 r0 = *(const f32x4*)(RO + (size_t)t * C5 + c), r1 = *(const f32x4*)(RO + (size_t)t * C5 + c + 4);
          float o[8]; float s = 0.f;
#pragma unroll
          for (int j = 0; j < 8; ++j) { o[j] = j < 4 ? r0[j & 3] : r1[j & 3]; s += o[j]; }
          s += __shfl_xor(s, 1); s += __shfl_xor(s, 2); s += __shfl_xor(s, 4); const float mean = s * (1.f / 64.f); float q = 0.f;
#pragma unroll
          for (int j = 0; j < 8; ++j) { o[j] -= mean; q += o[j] * o[j]; }
          q += __shfl_xor(q, 1); q += __shfl_xor(q, 2); q += __shfl_xor(q, 4); const float rstd = 1.f / sqrtf(q * (1.f / 64.f) + GN_EPS);
          const u32x4 rw = *(const u32x4*)(RK + (size_t)t * 1024 + c), kw = *(const u32x4*)(RK + (size_t)t * 1024 + 512 + c), vw = *(const u32x4*)(Vv + (size_t)t * C5 + c);
          const f32x4 a0 = *(const f32x4*)(WAG + (size_t)t * N_SM + 512 + c), a1 = *(const f32x4*)(WAG + (size_t)t * N_SM + 512 + c + 4);
          const f32x4 g0 = *(const f32x4*)(WAG + (size_t)t * N_SM + 1024 + c), g1 = *(const f32x4*)(WAG + (size_t)t * N_SM + 1024 + c + 4);
          const f32x4 ka0 = *(const f32x4*)(kaw + c), ka1 = *(const f32x4*)(kaw + c + 4), rk0 = *(const f32x4*)(rkw + c), rk1 = *(const f32x4*)(rkw + c + 4);
          const f32x4 gg0 = *(const f32x4*)(gng + c), gg1 = *(const f32x4*)(gng + c + 4), gb0 = *(const f32x4*)(gnb + c), gb1 = *(const f32x4*)(gnb + c + 4);
          float r[8], k[8], v[8]; float bon = 0.f;
#pragma unroll
          for (int j = 0; j < 4; ++j) { r[2 * j] = bflo(rw[j]); r[2 * j + 1] = bfhi(rw[j]); k[2 * j] = bflo(kw[j]); k[2 * j + 1] = bfhi(kw[j]); v[2 * j] = bflo(vw[j]); v[2 * j + 1] = bfhi(vw[j]); }
#pragma unroll
          for (int j = 0; j < 8; ++j) { const float a = j < 4 ? a0[j & 3] : a1[j & 3]; const float kp = k[j] * (1.0f + (a - 1.0f) * (j < 4 ? ka0[j & 3] : ka1[j & 3])); bon += r[j] * kp * (j < 4 ? rk0[j & 3] : rk1[j & 3]); }
          bon += __shfl_xor(bon, 1); bon += __shfl_xor(bon, 2); bon += __shfl_xor(bon, 4);
          float y[8];
#pragma unroll
          for (int j = 0; j < 8; ++j) { const float gn = o[j] * rstd * (j < 4 ? gg0[j & 3] : gg1[j & 3]) + (j < 4 ? gb0[j & 3] : gb1[j & 3]); y[j] = (gn + bon * v[j]) * (j < 4 ? g0[j & 3] : g1[j & 3]); }
          u32x4 w; w.x = pk2(y[0], y[1]); w.y = pk2(y[2], y[3]); w.z = pk2(y[4], y[5]); w.w = pk2(y[6], y[7]);
          *(u32x4*)(MIX + (size_t)t * D + C5 + c) = w; }
    }
}

__device__ __forceinline__ void phase_ln1_route(const Params& p, const Frame& F, int l) {
    LAS float* hrow = (LAS float*)(F.lds) + F.wave * D;
    LAS int* hist = (LAS int*)(F.lds + 65536);
    LAS int* basep = hist + 32;
    LAS int* rinfo = hist + 64;
    LAS float* rgate = (LAS float*)(rinfo + 512);
    const float* mod = WSP(float, WS_MOD) + (size_t)l * NBATCH * 6144;
    const float* g1 = INP(I_LN1G) + (size_t)l * D; const float* b1 = INP(I_LN1B) + (size_t)l * D;
    const float* rwt = INP(I_RW) + (size_t)l * D * NE; const float* rb = INP(I_RB) + (size_t)l * NE;
    unsigned* cnt = (unsigned*)(F.ws + WS_CTL) + CW_CNT + l * 64;
    int* LIST = WSP(int, WS_LIST); float* GATEL = WSP(float, WS_GATEL); int* TOKSLOT = WSP(int, WS_TOKSLOT);
    const int lane = F.lane;
    for (int chunk = F.vcu; chunk < T / 128; chunk += F.G) {
        __syncthreads();
        if (F.tid < 32) hist[F.tid] = 0;
        __syncthreads();
        for (int rr = 0; rr < 16; ++rr) {
            const int lr = F.wave * 16 + rr; const int m = chunk * 128 + lr; const int b = m / SEQ;
            GAS f32x4* xr = (GAS f32x4*)(WSP(float, WS_X) + (size_t)m * D) + lane;
            f32x4 v[4]; float s = 0.f;
#pragma unroll
            for (int j = 0; j < 4; ++j) { v[j] = xr[64 * j]; s += (v[j].x + v[j].y) + (v[j].z + v[j].w); }
            const float mean = wave_sum(s) * (1.f / D); float s2 = 0.f;
#pragma unroll
            for (int j = 0; j < 4; ++j) { v[j] = v[j] - mean; s2 += (v[j].x * v[j].x + v[j].y * v[j].y) + (v[j].z * v[j].z + v[j].w * v[j].w); }
            const float rstd = 1.f / sqrtf(wave_sum(s2) * (1.f / D) + LN_EPS);
            GAS u32x2* ho = (GAS u32x2*)(WSP(bf16, WS_H) + (size_t)m * D) + lane;
#pragma unroll
            for (int j = 0; j < 4; ++j) { const int c = 4 * lane + 256 * j;
                const f32x4 g = *(const f32x4*)(g1 + c), be = *(const f32x4*)(b1 + c);
                const f32x4 x1 = v[j] * rstd * g + be; xr[64 * j] = x1;
                const f32x4 sh = *(const f32x4*)(mod + (size_t)b * 6144 + 3072 + c), sc = *(const f32x4*)(mod + (size_t)b * 6144 + 4096 + c);
                const f32x4 h = x1 * (sc + 1.0f) + sh; u32x2 w; w.x = pk2(h.x, h.y); w.y = pk2(h.z, h.w); ho[64 * j] = w;
                *(LAS f32x4*)(hrow + c) = h; }
            LDS_WAIT(); asm volatile("" ::: "memory");
            const int e = lane & 31, kh = lane >> 5; float acc0 = 0.f, acc1 = 0.f;
            const float* rwp = rwt + (size_t)(kh * 512) * NE + e; const LAS float* hp = hrow + kh * 512;
#pragma unroll 4
            for (int k = 0; k < 512; k += 4) { const f32x4 hv = *(const LAS f32x4*)(hp + k);
                acc0 += hv.x * rwp[(size_t)(k + 0) * NE]; acc1 += hv.y * rwp[(size_t)(k + 1) * NE]; acc0 += hv.z * rwp[(size_t)(k + 2) * NE]; acc1 += hv.w * rwp[(size_t)(k + 3) * NE]; }
            float logit = acc0 + acc1; logit += __shfl_xor(logit, 32); logit += rb[e];
            float val = logit; float tv0 = 0.f, tv1 = 0.f, tv2 = 0.f, tv3 = 0.f; int te0 = 0, te1 = 0, te2 = 0, te3 = 0;
#pragma unroll
            for (int k = 0; k < 4; ++k) { float mx = val;
#pragma unroll
                for (int o = 1; o < 32; o <<= 1) mx = fmaxf(mx, __shfl_xor(mx, o));
                const unsigned long long bal = __ballot(val == mx && lane < 32); const int ek = __builtin_ctzll(bal);
                if (k == 0) { tv0 = mx; te0 = ek; } else if (k == 1) { tv1 = mx; te1 = ek; } else if (k == 2) { tv2 = mx; te2 = ek; } else { tv3 = mx; te3 = ek; }
                if (e == ek) val = -INFINITY; }
            const float e0 = 1.0f, e1 = __expf(tv1 - tv0), e2 = __expf(tv2 - tv0), e3 = __expf(tv3 - tv0); const float inv = 1.0f / (e0 + e1 + e2 + e3);
            if (lane < 4) { const int ek = lane == 0 ? te0 : lane == 1 ? te1 : lane == 2 ? te2 : te3; const float gk = (lane == 0 ? e0 : lane == 1 ? e1 : lane == 2 ? e2 : e3) * inv;
                const int lp = __hip_atomic_fetch_add(&hist[ek], 1, __ATOMIC_RELAXED, __HIP_MEMORY_SCOPE_WORKGROUP); rinfo[lr * 4 + lane] = (ek << 16) | lp; rgate[lr * 4 + lane] = gk; }
            LDS_WAIT(); asm volatile("" ::: "memory");
        }
        __syncthreads();
        if (F.tid < 32) basep[F.tid] = (int)__hip_atomic_fetch_add(cnt + F.tid, (unsigned)hist[F.tid], RLX_AGENT);
        __syncthreads();
        { const int lr = F.tid >> 2, k = F.tid & 3; const int m = chunk * 128 + lr; const int info = rinfo[F.tid]; const int ek = info >> 16; const int pos = basep[ek] + (info & 0xffff);
          LIST[ek * CAP + pos] = m; GATEL[ek * CAP + pos] = rgate[F.tid]; TOKSLOT[m * 4 + k] = (ek << 16) | pos; }
    }
    __syncthreads();
}

__device__ __forceinline__ void moe_tables(const Frame& F, int l) {
    LAS int* tb = (LAS int*)(F.lds + TB_OFF); LAS int* cn = tb + 40;
    const unsigned* cnt = (const unsigned*)(F.ws + WS_CTL) + CW_CNT + l * 64;
    __syncthreads();
    if (F.tid == 0) { int acc = 0;
        for (int e = 0; e < NE; ++e) { const int c = (int)__hip_atomic_load(cnt + e, RLX_AGENT); cn[e] = c; tb[e] = acc; acc += (c + 255) >> 8; }
        tb[NE] = acc; }
    __syncthreads();
}

__device__ __forceinline__ void phase_combine(const Params& p, const Frame& F, int l) {
    const LAS int* tb = (const LAS int*)(F.lds + TB_OFF);
    const int gw = F.vcu * NWAVES + F.wave, NGW = F.G * NWAVES; const int lane = F.lane;
    const float* mod = WSP(float, WS_MOD) + (size_t)l * NBATCH * 6144; const float* modn = WSP(float, WS_MOD) + (size_t)(l + 1) * NBATCH * 6144;
    const float* g2 = INP(I_LN2G) + (size_t)l * D; const float* b2 = INP(I_LN2B) + (size_t)l * D;
    const bf16* Y = WSP(bf16, WS_Y); const int* TOKSLOT = WSP(int, WS_TOKSLOT);
    const bool lastl = (l == DEPTH - 1);
    for (int m = gw; m < T; m += NGW) {
        const int b = m / SEQ;
        int srow[4];
#pragma unroll
        for (int k = 0; k < 4; ++k) { const int ts = TOKSLOT[m * 4 + k]; const int e = ts >> 16, pos = ts & 0xffff; srow[k] = tb[e] * 256 + pos; }
        GAS f32x4* xr = (GAS f32x4*)(WSP(float, WS_X) + (size_t)m * D) + lane;
        f32x4 v[4]; float s = 0.f;
#pragma unroll
        for (int j = 0; j < 4; ++j) { const int c = 4 * lane + 256 * j; f32x4 y = (f32x4){0.f, 0.f, 0.f, 0.f};
#pragma unroll
            for (int k = 0; k < 4; ++k) { const u32x2 yw = *(const u32x2*)(Y + (size_t)srow[k] * D + c); y.x += bflo(yw.x); y.y += bfhi(yw.x); y.z += bflo(yw.y); y.w += bfhi(yw.y); }
            const f32x4 gt = *(const f32x4*)(mod + (size_t)b * 6144 + 5120 + c) + 1.0f;
            v[j] = xr[64 * j] * DN_ALPHA + gt * y; s += (v[j].x + v[j].y) + (v[j].z + v[j].w); }
        const float mean = wave_sum(s) * (1.f / D); float s2 = 0.f;
#pragma unroll
        for (int j = 0; j < 4; ++j) { v[j] = v[j] - mean; s2 += (v[j].x * v[j].x + v[j].y * v[j].y) + (v[j].z * v[j].z + v[j].w * v[j].w); }
        const float rstd = 1.f / sqrtf(wave_sum(s2) * (1.f / D) + LN_EPS);
        GAS f32x4* oo = (GAS f32x4*)(p.out + (size_t)m * D) + lane;
        GAS u32x2* ho = (GAS u32x2*)(WSP(bf16, WS_H) + (size_t)m * D) + lane;
#pragma unroll
        for (int j = 0; j < 4; ++j) { const int c = 4 * lane + 256 * j;
            const f32x4 g = *(const f32x4*)(g2 + c), be = *(const f32x4*)(b2 + c);
            const f32x4 x2 = v[j] * rstd * g + be;
            if (lastl) oo[64 * j] = x2;
            else { xr[64 * j] = x2;
                const f32x4 sh = *(const f32x4*)(modn + (size_t)b * 6144 + c), sc = *(const f32x4*)(modn + (size_t)b * 6144 + 1024 + c);
                const f32x4 h = x2 * (sc + 1.0f) + sh; u32x2 w; w.x = pk2(h.x, h.y); w.y = pk2(h.z, h.w); ho[64 * j] = w; } }
    }
}

constexpr int PH_PER_LAYER = 11, N_PHASES = 2 + DEPTH * PH_PER_LAYER;
__global__ void __launch_bounds__(NTHREADS, 2) fwd(Params p) {
    extern __shared__ __attribute__((aligned(16))) unsigned char lds[];
    Frame F;
    F.lds = (LAS unsigned char*)lds; F.tid = threadIdx.x; F.lane = F.tid & 63; F.wave = __builtin_amdgcn_readfirstlane(F.tid >> 6);
    F.G = gridDim.x; { const int bx = blockIdx.x; F.vcu = (F.G % 8 == 0) ? (bx % 8) * (F.G / 8) + bx / 8 : bx; }
    F.ws = p.ws;
    volatile LAS unsigned* MISC = (volatile LAS unsigned*)(F.lds + MISC_OFF);
    if (F.tid < 64) MISC[F.tid] = 0u;
    __syncthreads();
    unsigned* ctl = (unsigned*)(p.ws + WS_CTL);
#if MK_ONE_LAUNCH
    XcdBarrier bar = xcd_barrier_post(ctl + CW_BAR, MISC + 8);
#define GRID_BAR() xcd_barrier(bar)
#else
#define GRID_BAR() do {} while (0)
#endif
    const int lo = p.ph_lo, hi = p.ph_hi;
#ifndef PH_MASK
#define PH_MASK 0xFFFFFFFFu
#endif
#define IN(k) (lo <= (k) && (k) < hi)
#define EN(j) ((PH_MASK >> (j)) & 1u)
#define SEAM(k) do { if (IN(k) && IN((k) + 1)) GRID_BAR(); } while (0)
    LAS unsigned char* ring = F.lds;

    if (EN(0) && IN(0)) { phase_prologue(p, F); } SEAM(0);
    if (EN(1) && IN(1)) { phase_ln0(p, F); } SEAM(1);
#define LAYER_BODY \
        constexpr int pb = 2 + l * PH_PER_LAYER; \
        const float* mod = WSP(float, WS_MOD) + (size_t)l * NBATCH * 6144; \
        if (EN(2) && IN(pb + 0)) { \
            pg8::Gemm g{WSP(bf16, WS_H), WSP(bf16, WS_WINT) + (size_t)l * N_INP * D, T, N_INP, D}; pg8::DenseOrder S; S.init(T, N_INP, F.G, (int)blockIdx.x); \
            pg8::EpiBf16Plain E{WSP(bf16, WS_P), N_INP}; \
            pg8::gemm_phase<pg8::EpiBf16Plain, pg8::DenseOrder, true>(ring, g, S, E); \
        } SEAM(pb + 0); \
        if (EN(3) && IN(pb + 1)) { phase_prep(p, F, l); } SEAM(pb + 1); \
        if (EN(4) && IN(pb + 2)) { \
            if (EN(13)) { pg8::Gemm g{WSP(bf16, WS_AN), WSP(bf16, WS_WUPT) + (size_t)l * N_UP * K_UP, T, N_UP, K_UP}; pg8::DenseOrder S; S.init(T, N_UP, F.G, (int)blockIdx.x); \
              pg8::EpiMlaUp E{WSP(bf16, WS_Q), WSP(bf16, WS_KK), WSP(bf16, WS_V), WSP(float, WS_CS)}; \
              pg8::gemm_phase<pg8::EpiMlaUp, pg8::DenseOrder, true>(ring, g, S, E); } \
            if (EN(14)) { pg8::Gemm g{WSP(bf16, WS_A2), WSP(bf16, WS_WSMT) + (size_t)l * N_SM * K_SM, T, N_SM, K_SM}; pg8::DenseOrder S; S.init(T, N_SM, F.G, (int)blockIdx.x); \
              pg8::EpiRwkvSmall E{WSP(float, WS_WAG), INP(I_W0) + (size_t)l * C5, INP(I_A0) + (size_t)l * C5}; \
              pg8::gemm_phase<pg8::EpiRwkvSmall, pg8::DenseOrder, true>(ring, g, S, E); } \
            if (EN(15) && l > 0) { pg8::Gemm g{WSP(bf16, WS_VS1), WSP(bf16, WS_WV12T), T, C5, C5}; pg8::DenseOrder S; S.init(T, C5, F.G, (int)blockIdx.x); \
              pg8::EpiVres E{WSP(bf16, WS_VS1), WSP(bf16, WS_VS0), WSP(bf16, WS_VR), INP(I_V0)}; \
              pg8::gemm_phase<pg8::EpiVres, pg8::DenseOrder, true>(ring, g, S, E); } \
        } SEAM(pb + 2); \
        if (EN(5) && IN(pb + 3)) { phase_attn(p, F, (char*)lds); } SEAM(pb + 3); \
        if (EN(6) && IN(pb + 4)) { phase_rwkv(p, F, l); } SEAM(pb + 4); \
        if (EN(7) && IN(pb + 5)) { phase_mix(p, F, l); } SEAM(pb + 5); \
        if (EN(8) && IN(pb + 6)) { \
            pg8::Gemm g{WSP(bf16, WS_MIX), WSP(bf16, WS_WOT) + (size_t)l * D * D, T, D, D}; pg8::DenseOrder S; S.init(T, D, F.G, (int)blockIdx.x); \
            pg8::EpiWo E{WSP(float, WS_X), mod + 2048}; \
            pg8::gemm_phase<pg8::EpiWo, pg8::DenseOrder, true>(ring, g, S, E); \
        } SEAM(pb + 6); \
        if (EN(9) && IN(pb + 7)) { phase_ln1_route(p, F, l); } SEAM(pb + 7); \
        if (EN(10) && IN(pb + 8)) { \
            moe_tables(F, l); \
            const LAS int* tb = (const LAS int*)(F.lds + TB_OFF); \
            pg8::Gemm g{WSP(bf16, WS_H), WSP(bf16, WS_W1T) + (size_t)l * NE * 2048 * D, T, 2048, D}; \
            pg8::MoeOrder<true> S{tb, tb + 40, WSP(int, WS_LIST), 8, F.G, (int)blockIdx.x, (LAS unsigned*)(F.lds + GT_OFF)}; \
            pg8::EpiSwiglu E{WSP(bf16, WS_H1), WSP(float, WS_B1P) + (size_t)l * NE * 2048}; \
            pg8::gemm_phase<pg8::EpiSwiglu, pg8::MoeOrder<true>, true>(ring, g, S, E); \
        } SEAM(pb + 8); \
        if (EN(11) && IN(pb + 9)) { \
            moe_tables(F, l); \
            const LAS int* tb = (const LAS int*)(F.lds + TB_OFF); \
            pg8::Gemm g{WSP(bf16, WS_H1), WSP(bf16, WS_W2T) + (size_t)l * NE * D * FF, MAXSLOT, D, FF}; \
            pg8::MoeOrder<false> S{tb, tb + 40, nullptr, 4, F.G, (int)blockIdx.x, nullptr}; \
            pg8::EpiMoeOut E{WSP(bf16, WS_Y), INP(I_EB2) + (size_t)l * NE * D, WSP(float, WS_GATEL), tb}; \
            pg8::gemm_phase<pg8::EpiMoeOut, pg8::MoeOrder<false>, true>(ring, g, S, E); \
        } SEAM(pb + 9); \
        if (EN(12) && IN(pb + 10)) { moe_tables(F, l); phase_combine(p, F, l); } SEAM(pb + 10);
    { constexpr int l = 0; LAYER_BODY }
    { constexpr int l = 1; LAYER_BODY }
#undef LAYER_BODY
#undef IN
#undef SEAM
}

extern "C" void kernel_launch(void* const* d_in, const int* in_sizes, int n_in, void* d_out, int out_size, void* d_ws, size_t ws_size, hipStream_t stream) {
    static int grid = 0;
    if (grid == 0) {
        if (n_in != N_INPUTS || out_size != T * D || ws_size < WS_END) { fprintf(stderr, "kernel_launch: unexpected problem: n_in %d out %d ws %zu\n", n_in, out_size, ws_size); grid = -1; return; }
        int dev = 0, cus = 0, per_cu = 0;
        if (hipGetDevice(&dev) != hipSuccess || hipDeviceGetAttribute(&cus, hipDeviceAttributeMultiprocessorCount, dev) != hipSuccess) { grid = -1; return; }
        if (hipFuncSetAttribute((const void*)fwd, hipFuncAttributeMaxDynamicSharedMemorySize, LDS_BYTES) != hipSuccess) { fprintf(stderr, "kernel_launch: hipFuncSetAttribute failed\n"); grid = -1; return; }
        if (hipOccupancyMaxActiveBlocksPerMultiprocessor(&per_cu, (const void*)fwd, NTHREADS, LDS_BYTES) != hipSuccess || per_cu < 1) fprintf(stderr, "kernel_launch: occupancy query reports %d\n", per_cu);
        (void)hipGetLastError();
        grid = cus;
    }
    if (grid < 0) return;
    if (hipMemsetAsync((char*)d_ws + WS_CTL, 0, CTL_ZERO_BYTES, stream) != hipSuccess) return;
    Params p{};
    for (int i = 0; i < N_INPUTS; ++i) p.in[i] = d_in[i];
    p.out = (float*)d_out; p.ws = (unsigned char*)d_ws;
#if MK_ONE_LAUNCH
    p.ph_lo = 0; p.ph_hi = N_PHASES;
    hipLaunchKernelGGL(fwd, dim3(grid), dim3(NTHREADS), LDS_BYTES, stream, p);
#else
    for (int ph = 0; ph < N_PHASES; ++ph) { p.ph_lo = ph; p.ph_hi = ph + 1; hipLaunchKernelGGL(fwd, dim3(grid), dim3(NTHREADS), LDS_BYTES, stream, p); }
#endif
}
```

```cpp
#include <hip/hip_runtime.h>
#include <cstdio>
#include <cstdint>

#define REP_PRO 1
#define REP_ATTN 1
#define REP_RWKV 1
#define REP_MOE1 1
#define REP_MOE2 1
#define REP_WIN 1
#define REP_PREP 1
#define REP_MIX 1
#ifndef MK_ONE_LAUNCH
#define MK_ONE_LAUNCH 1
#endif

#define GAS __attribute__((address_space(1)))
#define LAS __attribute__((address_space(3)))
typedef unsigned short bf16;
typedef short bf16x8 __attribute__((ext_vector_type(8)));
typedef short s16x4 __attribute__((ext_vector_type(4)));
typedef float f32x2 __attribute__((ext_vector_type(2)));
typedef float f32x4 __attribute__((ext_vector_type(4)));
typedef float f32x16 __attribute__((ext_vector_type(16)));
typedef unsigned u32x2 __attribute__((ext_vector_type(2)));
typedef unsigned u32x4 __attribute__((ext_vector_type(4)));

constexpr int D = 1024, NBATCH = 8, SEQ = 4096, T = NBATCH * SEQ, DEPTH = 2;
constexpr int MLA_IN = 416, RWKV_IN = 1792, N_IN = 2208, N_INP = 2304;
constexpr int QLR = 256, KVLR = 128, ROPE = 32, NOPE = 64, QKD = 96, VD = 64, NH = 8;
constexpr int C5 = 512;
constexpr int NE = 32, TOPK = 4, FF = 1024, CAP = 32768;
constexpr int N_UP = 1792, K_UP = 384, N_SM = 1536, K_SM = 256;
constexpr int MAXSLOT = 139264;
constexpr float DN_ALPHA = 1.4142135623730951f;
constexpr float C2Q = 0.14724444602590306f;
constexpr float LN_EPS = 1e-5f, RMS_EPS = 1e-6f, GN_EPS = 64e-5f;
constexpr int NWAVES = 8, NTHREADS = 512;

enum { I_X = 0, I_C, I_POS, I_ELNG, I_ELNB, I_ADAW, I_ADAB, I_WIN, I_QNG, I_WUQ, I_KVNG, I_WUK, I_WUV, I_MOUTG, I_MU, I_W0, I_W2, I_A0, I_A2, I_G2,
       I_KK, I_KA, I_RK, I_GNG, I_GNB, I_V0, I_V1, I_V2, I_WO, I_LN1G, I_LN1B, I_RW, I_RB, I_EW1, I_EB1, I_EW2, I_EB2, I_LN2G, I_LN2B, N_INPUTS };

constexpr size_t MiB = 1u << 20;
constexpr size_t WS_CTL = 0, CTL_ZERO_BYTES = 4 * MiB;
constexpr size_t WS_MOD = 4 * MiB, WS_B1P = 5 * MiB, WS_CS = 6 * MiB, WS_LIST = 10 * MiB, WS_GATEL = 14 * MiB, WS_TOKSLOT = 18 * MiB;
constexpr size_t WS_WINT = 20 * MiB, WS_WUPT = 30 * MiB, WS_WSMT = 33 * MiB, WS_WV12T = 35 * MiB, WS_WOT = 36 * MiB, WS_W1T = 40 * MiB, WS_W2T = 296 * MiB;
constexpr size_t WS_X = 424 * MiB, WS_H = 552 * MiB, WS_VS0 = 616 * MiB, WS_VS1 = 648 * MiB;
constexpr size_t WS_P = 680 * MiB, WS_AN = 824 * MiB, WS_A2 = 848 * MiB, WS_RK = 864 * MiB, WS_Q = 928 * MiB, WS_KK = 976 * MiB, WS_V = 1024 * MiB, WS_O = 1056 * MiB;
constexpr size_t WS_WAG = 1088 * MiB, WS_RO = 1280 * MiB, WS_MIX = 1344 * MiB, WS_VR = 1408 * MiB;
constexpr size_t WS_H1 = 680 * MiB, WS_Y = 952 * MiB;
constexpr size_t WS_END = 1440 * MiB;
constexpr int CW_TMO = 0, CW_CODE = 1, CW_BAR = 4096, CW_CNT = 8192;

constexpr int RING_BYTES = 131072;
constexpr int LDSX_OFF = RING_BYTES;
constexpr int MISC_OFF = LDSX_OFF;
constexpr int TB_OFF = LDSX_OFF + 256;
constexpr int GT_OFF = LDSX_OFF + 1024;
constexpr int LDS_BYTES = 147456;

#define RLX_AGENT __ATOMIC_RELAXED, __HIP_MEMORY_SCOPE_AGENT
#define LDS_WAIT() asm volatile("s_waitcnt lgkmcnt(0)" ::: "memory")
#define VM_WAIT() asm volatile("s_waitcnt vmcnt(0)" ::: "memory")

__device__ __forceinline__ unsigned f2bf(float f) { unsigned u = __builtin_bit_cast(unsigned, f); return (u + 0x7fffu + ((u >> 16) & 1u)) >> 16; }
__device__ __forceinline__ unsigned pk2(float lo, float hi) { return f2bf(lo) | (f2bf(hi) << 16); }
__device__ __forceinline__ float bf2f(unsigned b) { return __builtin_bit_cast(float, b << 16); }
__device__ __forceinline__ float bflo(unsigned w) { return __builtin_bit_cast(float, w << 16); }
__device__ __forceinline__ float bfhi(unsigned w) { return __builtin_bit_cast(float, w & 0xffff0000u); }
__device__ __forceinline__ unsigned cvt_pk_bf16(float lo, float hi) { unsigned r; asm volatile("v_cvt_pk_bf16_f32 %0, %1, %2" : "=v"(r) : "v"(lo), "v"(hi)); return r; }
__device__ __forceinline__ float wave_sum(float v) {
#pragma unroll
    for (int o = 1; o < 64; o <<= 1) v += __shfl_xor(v, o);
    return v;
}
__device__ __forceinline__ float sigmoidf_(float x) { return 1.0f / (1.0f + __expf(-x)); }

#define XB_TMO      128
#define XB_XCNT(j)  (256  + 64 * (j))
#define XB_XSUB(j)  (1280 + 64 * (j))
#define XB_XGEN(j)  (2304 + 64 * (j))
#define XB_TOP      3328
#define XB_TOPGEN   3392
#define XCD_BAR_WORDS 3456
#define XB_SPIN_CAP (1u << 18)
__device__ __forceinline__ unsigned xb_ld(unsigned* p)              { return __hip_atomic_load(p, __ATOMIC_RELAXED, __HIP_MEMORY_SCOPE_AGENT); }
__device__ __forceinline__ unsigned xb_add(unsigned* p, unsigned v) { return __hip_atomic_fetch_add(p, v, __ATOMIC_RELAXED, __HIP_MEMORY_SCOPE_AGENT); }
__device__ __forceinline__ unsigned xb_xcc_id() { return (unsigned)__builtin_amdgcn_s_getreg((3 << 11) | 20) & 0xFu; }
#define XB_SPIN(cond, bar) do { unsigned _sp = 0; while (cond) { __builtin_amdgcn_s_sleep(1); \
    if ((++_sp & 255u) == 0u) { if (xb_ld(&(bar)[XB_TMO])) break; if (_sp > XB_SPIN_CAP) { atomicAdd(&(bar)[XB_TMO], 1u); break; } } } } while (0)
struct XcdBarrier { unsigned* bar; unsigned x; volatile LAS unsigned* st; };
__device__ __forceinline__ XcdBarrier xcd_barrier_post(unsigned* bar, volatile LAS unsigned* st) {
    XcdBarrier b; b.bar = bar; b.x = xb_xcc_id(); b.st = st;
    if (threadIdx.x == 0) (void)xb_add(&bar[XB_XCNT(b.x)], 1u);
    return b;
}
__device__ __forceinline__ void xcd_barrier_complete(unsigned* bar, unsigned x, unsigned& nloc, unsigned& nx) {
    const unsigned G = gridDim.x * gridDim.y * gridDim.z;
    unsigned sum, cnt, mine, sp = 0u;
    for (;;) {
        sum = 0u; cnt = 0u; mine = 0u;
#pragma unroll
        for (unsigned j = 0; j < 16; ++j) { const unsigned c = xb_ld(&bar[XB_XCNT(j)]); sum += c; cnt += (c > 0u) ? 1u : 0u; mine = (j == x) ? c : mine; }
        if (sum == G) break;
        __builtin_amdgcn_s_sleep(1);
        if ((++sp & 255u) == 0u) { if (xb_ld(&bar[XB_TMO])) break; if (sp > XB_SPIN_CAP) { atomicAdd(&bar[XB_TMO], 1u); break; } }
    }
    nloc = mine > 0u ? mine : 1u; nx = cnt > 0u ? cnt : 1u;
}
__device__ __forceinline__ void xcd_barrier(const XcdBarrier& b) {
    asm volatile("s_waitcnt vmcnt(0)" ::: "memory");
    __syncthreads();
    if (threadIdx.x == 0) {
        unsigned* bar = b.bar;
        __builtin_amdgcn_s_waitcnt(0);
        unsigned nloc = b.st[0], nx = b.st[1];
        if (nloc == 0u) { xcd_barrier_complete(bar, b.x, nloc, nx); b.st[0] = nloc; b.st[1] = nx; }
        const unsigned old = xb_add(&bar[XB_XSUB(b.x)], 1u);
        const unsigned gen = old / nloc;
        if (old + 1u == (gen + 1u) * nloc) {
            __builtin_amdgcn_fence(__ATOMIC_RELEASE, "agent");
            asm volatile("s_waitcnt vmcnt(0)" ::: "memory");
            const unsigned og = xb_add(&bar[XB_TOP], 1u);
            const unsigned tg = og / nx;
            if (og + 1u == (tg + 1u) * nx) xb_add(&bar[XB_TOPGEN], 1u);
            else XB_SPIN(xb_ld(&bar[XB_TOPGEN]) == tg, bar);
            __builtin_amdgcn_fence(__ATOMIC_ACQUIRE, "agent");
            xb_add(&bar[XB_XGEN(b.x)], 1u);
            asm volatile("s_waitcnt vmcnt(0)" ::: "memory");
        } else {
            XB_SPIN(xb_ld(&bar[XB_XGEN(b.x)]) == gen, bar);
            __builtin_amdgcn_fence(__ATOMIC_ACQUIRE, "agent");
            asm volatile("s_waitcnt vmcnt(0)" ::: "memory");
        }
    }
    __syncthreads();
}

namespace pg8 {
constexpr int BM = 256, BK = 64, HALF = 128, HTB = HALF * BK * 2, STAGE_BYTES = 8 * HTB, NXCD = 8, WGM = 8;
__device__ __forceinline__ int lds_byte(int r, int c) { const int st = (r >> 4) * 2 + (c >> 5), rr = r & 15, cc = c & 31, ob = rr * 64 + cc * 2; return st * 1024 + (ob ^ (((ob >> 9) & 1) << 5)); }
__device__ __forceinline__ void stage_rc(int b, int& R, int& C) { const int st = b / 1024, sb = b % 1024, swz = sb ^ (((sb >> 9) & 1) << 5); R = (st >> 1) * 16 + swz / 64; C = (st & 1) * 32 + (swz % 64) / 2; }
__device__ __forceinline__ int perm32(int rho) { const int n = rho >> 4, i = rho & 15; return 8 * (i >> 2) + 4 * n + (i & 3); }

struct Unit { int pm, pn, e; };
struct Gemm { const bf16* A; const bf16* Bt; int M, N, K; };

struct DenseOrder {
    int nM, nN, nwg, G, c;
    __device__ __forceinline__ void init(int M, int N, int G_, int c_) { nM = M / BM; nN = N / BM; nwg = nM * nN; G = G_; c = c_; }
    __device__ __forceinline__ bool next(int i, Unit& u) const {
        const long L = (long)i * G + c; if (L >= nwg) return false;
        int wgid = (int)L; { const int q = nwg / NXCD, r = nwg % NXCD, xcd = wgid % NXCD, off = wgid / NXCD; wgid = (xcd < r ? xcd * (q + 1) : r * (q + 1) + (xcd - r) * q) + off; }
        const int nig = WGM * nN, gid = wgid / nig, fm = gid * WGM, gsz = (nM - fm) < WGM ? (nM - fm) : WGM;
        u.pm = fm + ((wgid % nig) % gsz); u.pn = (wgid % nig) / gsz; u.e = 0; return true;
    }
    static constexpr bool GATHER = false;
    __device__ __forceinline__ size_t b_off(const Unit& u, int N, int K) const { return (size_t)u.pn * BM * K * 2; }
    __device__ __forceinline__ unsigned a_row_off(const Unit& u, int row, int K) const { return 0u; }
    __device__ __forceinline__ LAS unsigned* gtab() const { return nullptr; }
};
template <bool GATHER_> struct MoeOrder {
    static constexpr bool GATHER = GATHER_;
    const LAS int* tb; const LAS int* cnt; const int* list; int nN, G, c; LAS unsigned* gt_;
    __device__ __forceinline__ LAS unsigned* gtab() const { return gt_; }
    __device__ __forceinline__ bool next(int i, Unit& u) const {
        const int L = i * G + c; const int total = tb[NE] * nN; if (L >= total) return false;
        int e = 0;
#pragma unroll 1
        for (int j = 1; j < NE; ++j) if (tb[j] * nN <= L) e = j;
        const int Lr = L - tb[e] * nN, nte = tb[e + 1] - tb[e];
        const int mblk = Lr / (4 * nN), m0 = mblk * 4, gsz = (nte - m0) < 4 ? (nte - m0) : 4, rem = Lr - mblk * 4 * nN;
        u.e = e; u.pn = rem / gsz; u.pm = tb[e] + m0 + (rem % gsz); return true;
    }
    __device__ __forceinline__ size_t b_off(const Unit& u, int N, int K) const { return ((size_t)u.e * N + (size_t)u.pn * BM) * K * 2; }
    __device__ __forceinline__ unsigned a_row_off(const Unit& u, int row, int K) const {
        const int pos = (u.pm - tb[u.e]) * BM + row; const int tok = pos < cnt[u.e] ? list[u.e * CAP + pos] : 0; return (unsigned)tok * (unsigned)(K * 2);
    }
};

template <class Epi, class Sched, bool ALIGN_EPI>
__device__ __forceinline__ void gemm_phase(LAS unsigned char* lds, const Gemm g, const Sched& S, const Epi& E) {
    const int tid = threadIdx.x, wid = __builtin_amdgcn_readfirstlane(tid >> 6), lane = tid & 63, wr = wid >> 2, wc = wid & 3, fr = lane & 15, fq = lane >> 4;
    const int K = g.K, nt = K / BK;
    int RA[2]; unsigned CA[2], voffA[2], voffB[2];
#pragma unroll
    for (int i = 0; i < 2; ++i) { int R, C; stage_rc(tid * 16 + i * 8192, R, C); const int Rb = Epi::PERM ? ((R & ~31) + perm32(R & 31)) : R;
        RA[i] = R; CA[i] = (unsigned)C * 2u; voffA[i] = (unsigned)(R * K + C) * 2u; voffB[i] = (unsigned)(Rb * K + C) * 2u; }
    const size_t kstep = (size_t)(BK * 2);
    const size_t hstep = (size_t)HALF * K * 2;
    const size_t tstep = 2 * hstep;
    const unsigned ldsw = (unsigned)wid * 1024u;
    const int aoff = lds_byte(wr * 64 + fr, fq * 8), boff = lds_byte(wc * 32 + fr, fq * 8);
    const char* Abase = (const char*)g.A;
    LAS unsigned* gtb = S.gtab();
#define PG8_SA(b, h) (((b) * 2 + (h)) * HTB)
#define PG8_SB(b, h) ((4 + (b) * 2 + (h)) * HTB)
#define PG8_STAGE(bufoff, gbase, voff) do { _Pragma("unroll") for (int _i = 0; _i < 2; ++_i) \
        __builtin_amdgcn_global_load_lds((const unsigned*)((const char*)(gbase) + (voff)[_i]), (LAS unsigned*)(lds + (bufoff) + ldsw + _i * 8192), 16, 0, 0); } while (0)
#define PG8_STAGEA(bufoff, h, kb, nx) do { \
        if constexpr (Sched::GATHER) { const LAS unsigned* tp_ = gtb + ((nx) ? tnx : tcu) + (h) * HALF; const unsigned o0_ = tp_[RA[0]] + CA[0], o1_ = tp_[RA[1]] + CA[1]; \
            __builtin_amdgcn_global_load_lds((const unsigned*)(Abase + (size_t)(kb) + o0_), (LAS unsigned*)(lds + (bufoff) + ldsw), 16, 0, 0); \
            __builtin_amdgcn_global_load_lds((const unsigned*)(Abase + (size_t)(kb) + o1_), (LAS unsigned*)(lds + (bufoff) + ldsw + 8192), 16, 0, 0); } \
        else { const char* gb_ = ((nx) ? nA : cA) + (size_t)(h) * hstep + (size_t)(kb); PG8_STAGE(bufoff, gb_, voffA); } } while (0)
#define PG8_LDA(dst, b, h) do { _Pragma("unroll") for (int m = 0; m < 4; ++m) _Pragma("unroll") for (int k = 0; k < 2; ++k) dst[m][k] = *(const LAS bf16x8*)(lds + PG8_SA(b, h) + aoff + m * 2048 + k * 1024); } while (0)
#define PG8_LDB(dst, b, h) do { _Pragma("unroll") for (int n = 0; n < 2; ++n) _Pragma("unroll") for (int k = 0; k < 2; ++k) dst[n][k] = *(const LAS bf16x8*)(lds + PG8_SB(b, h) + boff + n * 2048 + k * 1024); } while (0)
#define PG8_MMA(ai, bj, At, Bt) do { __builtin_amdgcn_s_setprio(1); _Pragma("unroll") for (int m = 0; m < 4; ++m) _Pragma("unroll") for (int n = 0; n < 2; ++n) _Pragma("unroll") for (int k = 0; k < 2; ++k) \
        acc[ai][bj][m][n] = __builtin_amdgcn_mfma_f32_16x16x32_bf16(Bt[n][k], At[m][k], acc[ai][bj][m][n], 0, 0, 0); __builtin_amdgcn_s_setprio(0); } while (0)
#define PG8_WAIT_V(n) asm volatile("s_waitcnt vmcnt(" #n ")" ::: "memory")
#define PG8_WAIT_L(n) asm volatile("s_waitcnt lgkmcnt(" #n ")" ::: "memory")
#define PG8_BAR __builtin_amdgcn_s_barrier()
#define PG8_SCHED __builtin_amdgcn_sched_barrier(0)
    Unit cur, nxt; int ui = 0;
    if (!S.next(0, cur)) return;
    f32x4 acc[2][2][4][2];
#pragma unroll
    for (int a = 0; a < 2; ++a)
#pragma unroll
        for (int b = 0; b < 2; ++b)
#pragma unroll
            for (int m = 0; m < 4; ++m)
#pragma unroll
                for (int n = 0; n < 2; ++n) acc[a][b][m][n] = (f32x4){0.f, 0.f, 0.f, 0.f};
    bf16x8 At[4][2], B0[2][2], B1[2][2];
    const char* cA = Abase + (size_t)cur.pm * tstep; const char* cB = (const char*)g.Bt + S.b_off(cur, g.N, K);
    const char* nA = cA; const char* nB = cB;
    int tcu = 0, tnx = 0;
    if constexpr (Sched::GATHER) {
        if (tid < BM) gtb[tid] = S.a_row_off(cur, tid, K);
        asm volatile("s_waitcnt vmcnt(0) lgkmcnt(0)" ::: "memory"); PG8_BAR; asm volatile("" ::: "memory");
    }
    PG8_STAGE(PG8_SB(0, 0), cB, voffB); PG8_STAGE(PG8_SB(0, 1), cB + hstep, voffB); PG8_STAGEA(PG8_SA(0, 0), 0, 0, false); PG8_STAGEA(PG8_SA(0, 1), 1, 0, false);
    if (wr == 1) PG8_BAR;
    PG8_WAIT_V(2); PG8_BAR;
    PG8_STAGE(PG8_SB(1, 0), cB + kstep, voffB); PG8_STAGEA(PG8_SA(1, 0), 0, kstep, false); PG8_STAGE(PG8_SB(1, 1), cB + hstep + kstep, voffB);
    PG8_WAIT_V(6); PG8_BAR;
    for (;;) {
        const bool has_next = S.next(ui + 1, nxt);
        nA = cA; nB = cB; tnx = tcu;
        if (has_next) { nA = Abase + (size_t)nxt.pm * tstep; nB = (const char*)g.Bt + S.b_off(nxt, g.N, K);
            if constexpr (Sched::GATHER) { tnx = tcu ^ BM; if (tid < BM) gtb[tnx + tid] = S.a_row_off(nxt, tid, K); } }
#pragma unroll 1
        for (int t = 0; t < nt; t += 2) {
            const bool last = (t == nt - 2);
            const size_t k1 = (size_t)(t + 1) * kstep;
            const size_t k2 = last ? 0 : (size_t)(t + 2) * kstep, k3 = k2 + kstep;
            const char* b2 = last ? nB : cB + (size_t)(t + 2) * kstep; const char* b3 = b2 + kstep;
            PG8_LDB(B0, 0, 0); PG8_LDB(B1, 0, 1); PG8_SCHED; PG8_LDA(At, 0, 0); PG8_STAGEA(PG8_SA(1, 1), 1, k1, false);
            PG8_WAIT_V(8); PG8_WAIT_L(0); PG8_BAR; PG8_MMA(0, 0, At, B0); PG8_MMA(0, 1, At, B1); PG8_BAR; PG8_SCHED;
            PG8_LDA(At, 0, 1); PG8_STAGE(PG8_SB(0, 0), b2, voffB); PG8_STAGE(PG8_SB(0, 1), b2 + hstep, voffB); PG8_STAGEA(PG8_SA(0, 0), 0, k2, last);
            PG8_WAIT_V(8); PG8_WAIT_L(0); PG8_BAR; PG8_MMA(1, 0, At, B0); PG8_MMA(1, 1, At, B1); PG8_BAR; PG8_SCHED;
            PG8_LDB(B0, 1, 0); PG8_LDB(B1, 1, 1); PG8_SCHED; PG8_LDA(At, 1, 0); PG8_STAGEA(PG8_SA(0, 1), 1, k2, last);
            PG8_WAIT_V(8); PG8_WAIT_L(0); PG8_BAR; PG8_MMA(0, 0, At, B0); PG8_MMA(0, 1, At, B1); PG8_BAR; PG8_SCHED;
            PG8_LDA(At, 1, 1); PG8_STAGE(PG8_SB(1, 0), b3, voffB); PG8_STAGE(PG8_SB(1, 1), b3 + hstep, voffB); PG8_STAGEA(PG8_SA(1, 0), 0, k3, last);
            PG8_WAIT_V(8); PG8_WAIT_L(0); PG8_BAR; PG8_MMA(1, 0, At, B0); PG8_MMA(1, 1, At, B1); PG8_BAR; PG8_SCHED;
        }
        if constexpr (ALIGN_EPI) { if (wr == 0) PG8_BAR; }
        E(acc, cur, wr, wc, fr, fq);
        if (!has_next) break;
#pragma unroll
        for (int a = 0; a < 2; ++a)
#pragma unroll
            for (int b = 0; b < 2; ++b)
#pragma unroll
                for (int m = 0; m < 4; ++m)
#pragma unroll
                    for (int n = 0; n < 2; ++n) acc[a][b][m][n] = (f32x4){0.f, 0.f, 0.f, 0.f};
        cur = nxt; cA = nA; cB = nB; tcu = tnx; ++ui;
        if constexpr (ALIGN_EPI) { if (wr == 1) PG8_BAR; }
    }
    PG8_WAIT_V(0);
    if constexpr (!ALIGN_EPI) { if (wr == 0) PG8_BAR; }
    PG8_BAR;
#undef PG8_SA
#undef PG8_SB
#undef PG8_STAGE
#undef PG8_STAGEA
#undef PG8_LDA
#undef PG8_LDB
#undef PG8_MMA
#undef PG8_WAIT_V
#undef PG8_WAIT_L
#undef PG8_BAR
#undef PG8_SCHED
}

struct EpiBf16Plain {
    static constexpr bool PERM = true;
    bf16* O; int ldc;
    __device__ __forceinline__ void operator()(const f32x4 (&acc)[2][2][4][2], const Unit& u, int wr, int wc, int fr, int fq) const {
        const int row0 = u.pm * BM + wr * 64 + fr, col0 = u.pn * BM + wc * 32 + 8 * fq;
#pragma unroll
        for (int ai = 0; ai < 2; ++ai)
#pragma unroll
            for (int m = 0; m < 4; ++m) { bf16* rowp = O + (size_t)(row0 + ai * HALF + m * 16) * ldc + col0;
#pragma unroll
                for (int bj = 0; bj < 2; ++bj) { const f32x4 v0 = acc[ai][bj][m][0], v1 = acc[ai][bj][m][1];
                    u32x4 w; w.x = cvt_pk_bf16(v0[0], v0[1]); w.y = cvt_pk_bf16(v0[2], v0[3]); w.z = cvt_pk_bf16(v1[0], v1[1]); w.w = cvt_pk_bf16(v1[2], v1[3]);
                    *(u32x4*)(rowp + bj * HALF) = w; } }
    }
};
struct EpiMlaUp {
    static constexpr bool PERM = true;
    bf16* Q; bf16* KK; bf16* V; const float* cs;
    __device__ __forceinline__ void operator()(const f32x4 (&acc)[2][2][4][2], const Unit& u, int wr, int wc, int fr, int fq) const {
        const int row0 = u.pm * BM + wr * 64 + fr;
#pragma unroll
        for (int bj = 0; bj < 2; ++bj) {
            const int c0 = u.pn * BM + bj * HALF + wc * 32 + 8 * fq;
            if (u.pn < 3) {
                const int h = c0 / QKD, d = c0 - h * QKD;
                const bool rope = d >= NOPE; const int i0 = rope ? (d - NOPE) >> 1 : 0;
#pragma unroll
                for (int ai = 0; ai < 2; ++ai)
#pragma unroll
                    for (int m = 0; m < 4; ++m) { const int row = row0 + ai * HALF + m * 16;
                        f32x4 v0 = acc[ai][bj][m][0], v1 = acc[ai][bj][m][1];
                        if (rope) { const f32x4 cA = *(const f32x4*)(cs + (size_t)row * 32 + i0 * 2), cB = *(const f32x4*)(cs + (size_t)row * 32 + i0 * 2 + 4);
                            const f32x4 a = v0, b = v1;
                            v0[0] = a[0] * cA[0] - a[1] * cA[1]; v0[1] = a[0] * cA[1] + a[1] * cA[0]; v0[2] = a[2] * cA[2] - a[3] * cA[3]; v0[3] = a[2] * cA[3] + a[3] * cA[2];
                            v1[0] = b[0] * cB[0] - b[1] * cB[1]; v1[1] = b[0] * cB[1] + b[1] * cB[0]; v1[2] = b[2] * cB[2] - b[3] * cB[3]; v1[3] = b[2] * cB[3] + b[3] * cB[2]; }
                        v0 = v0 * C2Q; v1 = v1 * C2Q;
                        u32x4 w; w.x = cvt_pk_bf16(v0[0], v0[1]); w.y = cvt_pk_bf16(v0[2], v0[3]); w.z = cvt_pk_bf16(v1[0], v1[1]); w.w = cvt_pk_bf16(v1[2], v1[3]);
                        *(u32x4*)(Q + (size_t)row * 768 + c0) = w; asm volatile("" ::: "memory"); }
            } else {
                bf16* base; int ld, cc;
                if (u.pn < 5) { const int c1 = c0 - 768; const int h = c1 >> 6, d = c1 & 63; base = KK; ld = 768; cc = h * QKD + d; }
                else { base = V; ld = 512; cc = c0 - 1280; }
#pragma unroll
                for (int ai = 0; ai < 2; ++ai)
#pragma unroll
                    for (int m = 0; m < 4; ++m) { const int row = row0 + ai * HALF + m * 16; const f32x4 v0 = acc[ai][bj][m][0], v1 = acc[ai][bj][m][1];
                        u32x4 w; w.x = cvt_pk_bf16(v0[0], v0[1]); w.y = cvt_pk_bf16(v0[2], v0[3]); w.z = cvt_pk_bf16(v1[0], v1[1]); w.w = cvt_pk_bf16(v1[2], v1[3]);
                        *(u32x4*)(base + (size_t)row * ld + cc) = w; asm volatile("" ::: "memory"); }
            }
        }
    }
};
struct EpiRwkvSmall {
    static constexpr bool PERM = false;
    float* O; const float* w0; const float* a0;
    __device__ __forceinline__ void operator()(const f32x4 (&acc)[2][2][4][2], const Unit& u, int wr, int wc, int fr, int fq) const {
        const int row0 = u.pm * BM + wr * 64 + fr, col0 = u.pn * BM + wc * 32 + 4 * fq;
        const int kind = u.pn >> 1;
#pragma unroll
        for (int bj = 0; bj < 2; ++bj)
#pragma unroll
            for (int n = 0; n < 2; ++n) { const int c = col0 + bj * HALF + n * 16;
                f32x4 bv = (f32x4){0.f, 0.f, 0.f, 0.f};
                if (kind == 0) bv = *(const f32x4*)(w0 + c); else if (kind == 1) bv = *(const f32x4*)(a0 + (c - 512));
#pragma unroll
                for (int ai = 0; ai < 2; ++ai)
#pragma unroll
                    for (int m = 0; m < 4; ++m) { f32x4 v = acc[ai][bj][m][n] + bv;
                        if (kind == 0) {
#pragma unroll
                            for (int j = 0; j < 4; ++j) { const float z = -v[j]; const float sp = fmaxf(z, 0.f) + __logf(1.0f + __expf(-fabsf(z))); const float w = -sp - 0.5f; v[j] = __expf(-__expf(w)); }
                        } else if (kind == 1) {
#pragma unroll
                            for (int j = 0; j < 4; ++j) v[j] = sigmoidf_(v[j]);
                        }
                        *(f32x4*)(O + (size_t)(row0 + ai * HALF + m * 16) * N_SM + c) = v; asm volatile("" ::: "memory"); } }
    }
};
struct EpiVres {
    static constexpr bool PERM = true;
    const bf16* vs; const bf16* vf; bf16* vr; const float* v0;
    __device__ __forceinline__ void operator()(const f32x4 (&acc)[2][2][4][2], const Unit& u, int wr, int wc, int fr, int fq) const {
        const int row0 = u.pm * BM + wr * 64 + fr, col0 = u.pn * BM + wc * 32 + 8 * fq;
#pragma unroll
        for (int bj = 0; bj < 2; ++bj) { const int c = col0 + bj * HALF;
            const f32x4 b0 = *(const f32x4*)(v0 + c), b1 = *(const f32x4*)(v0 + c + 4);
#pragma unroll
            for (int ai = 0; ai < 2; ++ai)
#pragma unroll
                for (int m = 0; m < 4; ++m) { const size_t off = (size_t)(row0 + ai * HALF + m * 16) * C5 + c;
                    const u32x4 s = *(const u32x4*)(vs + off), f = *(const u32x4*)(vf + off);
                    const f32x4 g0 = acc[ai][bj][m][0] + b0, g1 = acc[ai][bj][m][1] + b1;
                    float o[8];
#pragma unroll
                    for (int j = 0; j < 4; ++j) { const float sl = bflo(s[j]), sh = bfhi(s[j]), fl = bflo(f[j]), fh = bfhi(f[j]);
                        const float ga = (j < 2) ? g0[2 * j] : g1[2 * j - 4], gb = (j < 2) ? g0[2 * j + 1] : g1[2 * j - 3];
                        o[2 * j] = sl + (fl - sl) * sigmoidf_(ga); o[2 * j + 1] = sh + (fh - sh) * sigmoidf_(gb); }
                    u32x4 w; w.x = cvt_pk_bf16(o[0], o[1]); w.y = cvt_pk_bf16(o[2], o[3]); w.z = cvt_pk_bf16(o[4], o[5]); w.w = cvt_pk_bf16(o[6], o[7]);
                    *(u32x4*)(vr + off) = w; } }
    }
};
struct EpiWo {
    static constexpr bool PERM = false;
    float* X; const float* gt;
    __device__ __forceinline__ void operator()(const f32x4 (&acc)[2][2][4][2], const Unit& u, int wr, int wc, int fr, int fq) const {
        const int row0 = u.pm * BM + wr * 64 + fr, col0 = u.pn * BM + wc * 32 + 4 * fq;
        const int b = (u.pm * BM) / SEQ;
#pragma unroll
        for (int bj = 0; bj < 2; ++bj)
#pragma unroll
            for (int n = 0; n < 2; ++n) { const int c = col0 + bj * HALF + n * 16; const f32x4 g = *(const f32x4*)(gt + (size_t)b * 6144 + c) + 1.0f;
#pragma unroll
                for (int ai = 0; ai < 2; ++ai)
#pragma unroll
                    for (int m = 0; m < 4; ++m) { float* p = X + (size_t)(row0 + ai * HALF + m * 16) * D + c; const f32x4 x = *(const f32x4*)p; *(f32x4*)p = x * DN_ALPHA + g * acc[ai][bj][m][n]; } }
    }
};
struct EpiSwiglu {
    static constexpr bool PERM = true;
    bf16* O; const float* b1p;
    __device__ __forceinline__ void operator()(const f32x4 (&acc)[2][2][4][2], const Unit& u, int wr, int wc, int fr, int fq) const {
        const int row0 = u.pm * BM + wr * 64 + fr; const int cin = u.pn * BM + wc * 32 + 8 * fq, cout = u.pn * HALF + wc * 32 + 8 * fq;
        const float* bp = b1p + (size_t)u.e * 2048 + cin;
        const f32x4 bg0 = *(const f32x4*)(bp), bg1 = *(const f32x4*)(bp + 4), bl0 = *(const f32x4*)(bp + HALF), bl1 = *(const f32x4*)(bp + HALF + 4);
#pragma unroll
        for (int ai = 0; ai < 2; ++ai)
#pragma unroll
            for (int m = 0; m < 4; ++m) {
                const f32x4 g0 = acc[ai][0][m][0] + bg0, g1 = acc[ai][0][m][1] + bg1, l0 = acc[ai][1][m][0] + bl0, l1 = acc[ai][1][m][1] + bl1;
                float o[8];
#pragma unroll
                for (int j = 0; j < 8; ++j) { const float gv = fminf(j < 4 ? g0[j & 3] : g1[j & 3], 7.0f); const float lv = fminf(fmaxf(j < 4 ? l0[j & 3] : l1[j & 3], -7.0f), 7.0f);
                    o[j] = gv * sigmoidf_(1.702f * gv) * (lv + 1.0f); }
                u32x4 w; w.x = cvt_pk_bf16(o[0], o[1]); w.y = cvt_pk_bf16(o[2], o[3]); w.z = cvt_pk_bf16(o[4], o[5]); w.w = cvt_pk_bf16(o[6], o[7]);
                *(u32x4*)(O + (size_t)(row0 + ai * HALF + m * 16) * FF + cout) = w; }
    }
};
struct EpiMoeOut {
    static constexpr bool PERM = true;
    bf16* O; const float* b2; const float* gatel; const LAS int* tb;
    __device__ __forceinline__ void operator()(const f32x4 (&acc)[2][2][4][2], const Unit& u, int wr, int wc, int fr, int fq) const {
        const int row0 = u.pm * BM + wr * 64 + fr, col0 = u.pn * BM + wc * 32 + 8 * fq;
        const int pos0 = (u.pm - tb[u.e]) * BM + wr * 64 + fr;
        const float* bp = b2 + (size_t)u.e * D + col0;
        f32x4 bv[2][2];
#pragma unroll
        for (int bj = 0; bj < 2; ++bj) { bv[bj][0] = *(const f32x4*)(bp + bj * HALF); bv[bj][1] = *(const f32x4*)(bp + bj * HALF + 4); }
#pragma unroll
        for (int ai = 0; ai < 2; ++ai)
#pragma unroll
            for (int m = 0; m < 4; ++m) { const float gt = gatel[(size_t)u.e * CAP + pos0 + ai * HALF + m * 16];
                bf16* rowp = O + (size_t)(row0 + ai * HALF + m * 16) * D + col0;
#pragma unroll
                for (int bj = 0; bj < 2; ++bj) { const f32x4 v0 = (acc[ai][bj][m][0] + bv[bj][0]) * gt, v1 = (acc[ai][bj][m][1] + bv[bj][1]) * gt;
                    u32x4 w; w.x = cvt_pk_bf16(v0[0], v0[1]); w.y = cvt_pk_bf16(v0[2], v0[3]); w.z = cvt_pk_bf16(v1[0], v1[1]); w.w = cvt_pk_bf16(v1[2], v1[3]);
                    *(u32x4*)(rowp + bj * HALF) = w; } }
    }
};
}

struct Params { const void* in[N_INPUTS]; float* out; unsigned char* ws; int ph_lo, ph_hi; };

struct Frame {
    LAS unsigned char* lds;
    int tid, lane, wave, G, vcu;
    unsigned char* ws;
};
#define WSP(type, off) ((type*)(F.ws + (off)))
#define INP(i) ((const float*)p.in[i])

__device__ const double INV_FREQ[16] = {1.00000000000000000e+00, 5.62341325190349073e-01, 3.16227766016837941e-01, 1.77827941003892293e-01, 1.00000000000000006e-01, 5.62341325190349114e-02,
    3.16227766016837913e-02, 1.77827941003892293e-02, 1.00000000000000002e-02, 5.62341325190349097e-03, 3.16227766016837939e-03, 1.77827941003892275e-03, 1.00000000000000002e-03,
    5.62341325190349097e-04, 3.16227766016837939e-04, 1.77827941003892270e-04};

template <int MODE>
__device__ __forceinline__ void tr_item(const float* W, int ldn, bf16* WT, int ldk, int kofs, int rofs, int k0, int n0, LAS float* scr, int lane) {
#pragma unroll 8
    for (int i = 0; i < 32; ++i) { const int kk = 2 * i + (lane >> 5); scr[kk * 33 + (lane & 31)] = W[(size_t)(k0 + kk) * ldn + n0 + (lane & 31)]; }
    LDS_WAIT(); asm volatile("" ::: "memory");
    const int c = lane & 7;
#pragma unroll
    for (int j = 0; j < 4; ++j) { const int n = (lane >> 3) + 8 * j; const LAS float* s = scr + (8 * c) * 33 + n;
        u32x4 o; o.x = pk2(s[0 * 33], s[1 * 33]); o.y = pk2(s[2 * 33], s[3 * 33]); o.z = pk2(s[4 * 33], s[5 * 33]); o.w = pk2(s[6 * 33], s[7 * 33]);
        const int ng = n0 + n; int row;
        if (MODE == 0) row = rofs + ng; else { const int jo = ng >> 1, bj = ng & 1; row = rofs + (jo >> 7) * 256 + bj * 128 + (jo & 127); }
        *(GAS u32x4*)(WT + (size_t)row * ldk + kofs + k0 + 8 * c) = o; }
    LDS_WAIT(); asm volatile("" ::: "memory");
}
__device__ __forceinline__ void zero_rect(const Frame& F, bf16* M, int ld, int r0, int nrows, int c0, int ncols) {
    const int gw = F.vcu * NWAVES + F.wave, NGW = F.G * NWAVES; const int nch = ncols / 8;
    for (int r = gw; r < nrows; r += NGW)
        for (int ch = F.lane; ch < nch; ch += 64) *(GAS u32x4*)(M + (size_t)(r0 + r) * ld + c0 + ch * 8) = (u32x4){0u, 0u, 0u, 0u};
}
__device__ __forceinline__ void phase_prologue(const Params& p, const Frame& F) {
    LAS float* scr = (LAS float*)(F.lds + F.wave * 16384);
    const int gw = F.vcu * NWAVES + F.wave, NGW = F.G * NWAVES;
    constexpr int I_IN = 16 * 69, I_UQ = 4 * 24, I_UK = 2 * 16, I_W2s = 16, I_G2s = 2 * 16, I_WO_ = 16 * 32, I_E1 = 16 * 64, I_E2 = 16 * 32;
    constexpr int PER_L = I_IN + I_UQ + 2 * I_UK + 2 * I_W2s + I_G2s + I_WO_;
    constexpr int NSMALL = DEPTH * PER_L, NE1 = DEPTH * NE * I_E1, NE2 = DEPTH * NE * I_E2;
    for (int it = gw; it < NSMALL + NE1 + NE2; it += NGW) {
        int r = it;
        if (r < NSMALL) {
            const int l = r / PER_L; r -= l * PER_L;
            if (r < I_IN) { tr_item<0>(INP(I_WIN) + (size_t)l * D * N_IN, N_IN, WSP(bf16, WS_WINT) + (size_t)l * N_INP * D, D, 0, 0, 64 * (r / 69), 32 * (r % 69), scr, F.lane); continue; } r -= I_IN;
            bf16* up = WSP(bf16, WS_WUPT) + (size_t)l * N_UP * K_UP;
            if (r < I_UQ) { tr_item<0>(INP(I_WUQ) + (size_t)l * QLR * 768, 768, up, K_UP, 0, 0, 64 * (r / 24), 32 * (r % 24), scr, F.lane); continue; } r -= I_UQ;
            if (r < I_UK) { tr_item<0>(INP(I_WUK) + (size_t)l * KVLR * 512, 512, up, K_UP, 256, 768, 64 * (r / 16), 32 * (r % 16), scr, F.lane); continue; } r -= I_UK;
            if (r < I_UK) { tr_item<0>(INP(I_WUV) + (size_t)l * KVLR * 512, 512, up, K_UP, 256, 1280, 64 * (r / 16), 32 * (r % 16), scr, F.lane); continue; } r -= I_UK;
            bf16* sm = WSP(bf16, WS_WSMT) + (size_t)l * N_SM * K_SM;
            if (r < I_W2s) { tr_item<0>(INP(I_W2) + (size_t)l * 64 * 512, 512, sm, K_SM, 0, 0, 0, 32 * r, scr, F.lane); continue; } r -= I_W2s;
            if (r < I_W2s) { tr_item<0>(INP(I_A2) + (size_t)l * 64 * 512, 512, sm, K_SM, 64, 512, 0, 32 * r, scr, F.lane); continue; } r -= I_W2s;
            if (r < I_G2s) { tr_item<0>(INP(I_G2) + (size_t)l * 128 * 512, 512, sm, K_SM, 128, 1024, 64 * (r / 16), 32 * (r % 16), scr, F.lane); continue; } r -= I_G2s;
            tr_item<0>(INP(I_WO) + (size_t)l * D * D, D, WSP(bf16, WS_WOT) + (size_t)l * D * D, D, 0, 0, 64 * (r / 32), 32 * (r % 32), scr, F.lane); continue;
        }
        r -= NSMALL;
        if (r < NE1) { const int le = r / I_E1; r -= le * I_E1;
            tr_item<1>(INP(I_EW1) + (size_t)le * D * 2048, 2048, WSP(bf16, WS_W1T) + (size_t)le * 2048 * D, D, 0, 0, 64 * (r / 64), 32 * (r % 64), scr, F.lane); continue; }
        r -= NE1;
        { const int le = r / I_E2; r -= le * I_E2;
            tr_item<0>(INP(I_EW2) + (size_t)le * FF * D, D, WSP(bf16, WS_W2T) + (size_t)le * D * FF, FF, 0, 0, 64 * (r / 32), 32 * (r % 32), scr, F.lane); }
    }
    for (int l = 0; l < DEPTH; ++l) {
        zero_rect(F, WSP(bf16, WS_WINT) + (size_t)l * N_INP * D, D, N_IN, N_INP - N_IN, 0, D);
        bf16* up = WSP(bf16, WS_WUPT) + (size_t)l * N_UP * K_UP;
        zero_rect(F, up, K_UP, 0, 768, 256, 128); zero_rect(F, up, K_UP, 768, 1024, 0, 256);
        bf16* sm = WSP(bf16, WS_WSMT) + (size_t)l * N_SM * K_SM;
        zero_rect(F, sm, K_SM, 0, 512, 64, 192); zero_rect(F, sm, K_SM, 512, 512, 0, 64); zero_rect(F, sm, K_SM, 512, 512, 128, 128); zero_rect(F, sm, K_SM, 1024, 512, 0, 128);
    }
    const int gt = (F.vcu * NTHREADS) + F.tid, NGT = F.G * NTHREADS;
    { const float* v1 = INP(I_V1); const float* v2 = INP(I_V2); bf16* o = WSP(bf16, WS_WV12T);
      for (int i = gt; i < 512 * 512; i += NGT) { const int n = i >> 9, k = i & 511; float s = 0.f;
#pragma unroll 8
          for (int j = 0; j < 32; ++j) s += v1[k * 32 + j] * v2[j * 512 + n];
          o[i] = (bf16)f2bf(s); } }
    { const float* b1 = INP(I_EB1); float* o = WSP(float, WS_B1P);
      for (int i = gt; i < DEPTH * NE * 2048; i += NGT) { const int q = i & 2047, le = i >> 11; const int pn = q >> 8, bj = (q >> 7) & 1, jj = q & 127; o[i] = b1[(size_t)le * 2048 + 2 * (pn * 128 + jj) + bj]; } }
    { const int* pos = (const int*)p.in[I_POS]; float* cs = WSP(float, WS_CS);
      for (int i = gt; i < T * 16; i += NGT) { const int t = i >> 4, k = i & 15; const double a = (double)pos[t] * INV_FREQ[k];
          const double q = __builtin_rint(a * 0.63661977236758134308); const int qi = (int)((long long)q & 3);
          double r = __builtin_fma(-q, 1.57079632679489655800e+00, a); r = __builtin_fma(-q, 6.12323399573676603587e-17, r);
          const double r2 = r * r;
          double sn = -2.50521083854417187751e-08; sn = sn * r2 + 2.75573192239858906526e-06; sn = sn * r2 - 1.98412698412698412698e-04; sn = sn * r2 + 8.33333333333333333333e-03; sn = sn * r2 - 1.66666666666666666667e-01; sn = r + r * r2 * sn;
          double cn = 2.08767569878680989792e-09; cn = cn * r2 - 2.75573192239858906526e-07; cn = cn * r2 + 2.48015873015873015873e-05; cn = cn * r2 - 1.38888888888888888889e-03; cn = cn * r2 + 4.16666666666666666667e-02; cn = cn * r2 - 0.5; cn = 1.0 + r2 * cn;
          double sv, cv;
          if (qi == 0) { sv = sn; cv = cn; } else if (qi == 1) { sv = cn; cv = -sn; } else if (qi == 2) { sv = -sn; cv = -cn; } else { sv = -cn; cv = sn; }
          cs[2 * i] = (float)cv; cs[2 * i + 1] = (float)sv; } }
    { LAS float* cact = (LAS float*)(F.lds);
      LAS float* part = (LAS float*)(F.lds + 32768);
      __syncthreads();
      const float* c = INP(I_C);
      for (int i = F.tid; i < NBATCH * D; i += NTHREADS) { const float v = c[i]; cact[i] = v / (1.0f + __expf(-v)); }
      __syncthreads();
      for (int item = F.vcu; item < DEPTH * 96; item += F.G) { const int l = item / 96, n0 = (item % 96) * 64;
          const float* aw = INP(I_ADAW) + (size_t)l * D * 6144 + n0 + F.lane;
          float a8[8];
#pragma unroll
          for (int b = 0; b < 8; ++b) a8[b] = 0.f;
          const int kb = F.wave * 128;
#pragma unroll 4
          for (int k = 0; k < 128; ++k) { const float wv = aw[(size_t)(kb + k) * 6144];
#pragma unroll
              for (int b = 0; b < 8; ++b) a8[b] += cact[b * D + kb + k] * wv; }
#pragma unroll
          for (int b = 0; b < 8; ++b) part[(F.wave * 8 + b) * 64 + F.lane] = a8[b];
          __syncthreads();
          { const int b = F.wave; float s = 0.f;
#pragma unroll
            for (int w = 0; w < 8; ++w) s += part[(w * 8 + b) * 64 + F.lane];
            WSP(float, WS_MOD)[((size_t)l * NBATCH + b) * 6144 + n0 + F.lane] = s + INP(I_ADAB)[(size_t)l * 6144 + n0 + F.lane]; }
          __syncthreads(); }
    }
}

__device__ __forceinline__ void phase_ln0(const Params& p, const Frame& F) {
    const int gw = F.vcu * NWAVES + F.wave, NGW = F.G * NWAVES;
    const float* mod = WSP(float, WS_MOD);
    for (int m = gw; m < T; m += NGW) {
        const int b = m / SEQ;
        const GAS f32x4* xr = (const GAS f32x4*)(INP(I_X) + (size_t)m * D) + F.lane;
        f32x4 v[4]; float s = 0.f;
#pragma unroll
        for (int j = 0; j < 4; ++j) { v[j] = xr[64 * j]; s += (v[j].x + v[j].y) + (v[j].z + v[j].w); }
        const float mean = wave_sum(s) * (1.f / D); float s2 = 0.f;
#pragma unroll
        for (int j = 0; j < 4; ++j) { v[j] = v[j] - mean; s2 += (v[j].x * v[j].x + v[j].y * v[j].y) + (v[j].z * v[j].z + v[j].w * v[j].w); }
        const float rstd = 1.f / sqrtf(wave_sum(s2) * (1.f / D) + LN_EPS);
        GAS f32x4* xo = (GAS f32x4*)(WSP(float, WS_X) + (size_t)m * D) + F.lane;
        GAS u32x2* ho = (GAS u32x2*)(WSP(bf16, WS_H) + (size_t)m * D) + F.lane;
#pragma unroll
        for (int j = 0; j < 4; ++j) { const int c = 4 * F.lane + 256 * j;
            const f32x4 g = *(const f32x4*)(INP(I_ELNG) + c), be = *(const f32x4*)(INP(I_ELNB) + c);
            const f32x4 x0 = v[j] * rstd * g + be; xo[64 * j] = x0;
            const f32x4 sh = *(const f32x4*)(mod + (size_t)b * 6144 + c), sc = *(const f32x4*)(mod + (size_t)b * 6144 + 1024 + c);
            const f32x4 h = x0 * (sc + 1.0f) + sh; u32x2 w; w.x = pk2(h.x, h.y); w.y = pk2(h.z, h.w); ho[64 * j] = w; }
    }
}

__device__ __forceinline__ void phase_prep(const Params& p, const Frame& F, int l) {
    const int gw = F.vcu * NWAVES + F.wave, NGW = F.G * NWAVES; const int lane = F.lane;
    const bf16* P = WSP(bf16, WS_P); const float* mu = INP(I_MU) + (size_t)l * RWKV_IN;
    const float* qg = INP(I_QNG) + (size_t)l * QLR; const float* kvg = INP(I_KVNG) + (size_t)l * KVLR;
    bf16* AN = WSP(bf16, WS_AN); bf16* A2 = WSP(bf16, WS_A2); bf16* RK = WSP(bf16, WS_RK); bf16* KKb = WSP(bf16, WS_KK);
    bf16* VS = l == 0 ? WSP(bf16, WS_VS0) : WSP(bf16, WS_VS1);
    const float* cs = WSP(float, WS_CS);
    for (int t = gw; t < T; t += NGW) {
        const bf16* pr = P + (size_t)t * N_INP; const bool first = (t % SEQ) == 0; const bf16* pp = pr - N_INP;
        { const u32x2 qw = *(const u32x2*)(pr + 4 * lane); float q0 = bflo(qw.x), q1 = bfhi(qw.x), q2 = bflo(qw.y), q3 = bfhi(qw.y);
          const float rq = 1.f / sqrtf(wave_sum(q0 * q0 + q1 * q1 + q2 * q2 + q3 * q3) * (1.f / QLR) + RMS_EPS);
          const f32x4 g = *(const f32x4*)(qg + 4 * lane);
          u32x2 w; w.x = pk2(q0 * rq * g.x, q1 * rq * g.y); w.y = pk2(q2 * rq * g.z, q3 * rq * g.w); *(u32x2*)(AN + (size_t)t * K_UP + 4 * lane) = w;
          const unsigned kw = *(const unsigned*)(pr + QLR + 2 * lane); const float k0 = bflo(kw), k1 = bfhi(kw);
          const float rk = 1.f / sqrtf(wave_sum(k0 * k0 + k1 * k1) * (1.f / KVLR) + RMS_EPS);
          const f32x2 g2 = *(const f32x2*)(kvg + 2 * lane);
          *(unsigned*)(AN + (size_t)t * K_UP + QLR + 2 * lane) = pk2(k0 * rk * g2.x, k1 * rk * g2.y);
          const int i = lane & 15; const unsigned rw = *(const unsigned*)(pr + QLR + KVLR + 2 * i); const float x0 = bflo(rw), x1 = bfhi(rw);
          const f32x2 csv = *(const f32x2*)(cs + (size_t)t * 32 + 2 * i); const unsigned ro = pk2(x0 * csv.x - x1 * csv.y, x0 * csv.y + x1 * csv.x);
          const int h0 = (lane >> 4) * 2;
          *(unsigned*)(KKb + (size_t)t * 768 + h0 * QKD + NOPE + 2 * i) = ro; *(unsigned*)(KKb + (size_t)t * 768 + (h0 + 1) * QKD + NOPE + 2 * i) = ro; }
        const bf16* rr = pr + MLA_IN; const bf16* rp = pp + MLA_IN;
#pragma unroll
        for (int part = 0; part < 3; ++part) {
            const int c = part * 512 + 8 * lane; const u32x4 cw = *(const u32x4*)(rr + c); u32x4 pw = (u32x4){0u, 0u, 0u, 0u}; if (!first) pw = *(const u32x4*)(rp + c);
            const f32x4 m0 = *(const f32x4*)(mu + c), m1 = *(const f32x4*)(mu + c + 4);
            float o[8];
#pragma unroll
            for (int j = 0; j < 4; ++j) { const float a = bflo(cw[j]), b = bfhi(cw[j]), pa = bflo(pw[j]), pb = bfhi(pw[j]); const float ma = j < 2 ? m0[2 * j] : m1[2 * j - 4], mb = j < 2 ? m0[2 * j + 1] : m1[2 * j - 3];
                o[2 * j] = a + ma * (pa - a); o[2 * j + 1] = b + mb * (pb - b); }
            u32x4 w; w.x = pk2(o[0], o[1]); w.y = pk2(o[2], o[3]); w.z = pk2(o[4], o[5]); w.w = pk2(o[6], o[7]);
            if (part < 2) *(u32x4*)(RK + (size_t)t * 1024 + part * 512 + 8 * lane) = w; else *(u32x4*)(VS + (size_t)t * C5 + 8 * lane) = w;
        }
        { const int c = 1536 + lane; const float a = bf2f(rr[c]), pa = first ? 0.f : bf2f(rp[c]); const float v = a + mu[c] * (pa - a); A2[(size_t)t * K_SM + lane] = (bf16)f2bf(tanhf(v)); }
        { const int c = 1600 + lane; const float a = bf2f(rr[c]), pa = first ? 0.f : bf2f(rp[c]); const float v = a + mu[c] * (pa - a); A2[(size_t)t * K_SM + 64 + lane] = (bf16)f2bf(v); }
        { const int c = 1664 + 2 * lane; const unsigned cw = *(const unsigned*)(rr + c); const unsigned pw = first ? 0u : *(const unsigned*)(rp + c);
          const f32x2 m = *(const f32x2*)(mu + c); const float a = bflo(cw), b = bfhi(cw); const float va = a + m.x * (bflo(pw) - a), vb = b + m.y * (bfhi(pw) - b);
          *(unsigned*)(A2 + (size_t)t * K_SM + 128 + 2 * lane) = pk2(sigmoidf_(va), sigmoidf_(vb)); }
    }
}

namespace att {
__device__ __forceinline__ int crow(int r, int hi) { return (r & 3) + 8 * (r >> 2) + 4 * hi; }
constexpr int KSLOT = 12288, VSLOT = 8192;
constexpr int LDS_K = 0, LDS_V = 2 * KSLOT, LDS_WS = LDS_V + 2 * VSLOT, LDS_OST = LDS_WS + NWAVES * 64 * 4, LDS_TOTAL = LDS_OST + NWAVES * 4096;
__device__ __forceinline__ void glds16(const void* gsrc, unsigned lds_dst) { unsigned keep;
    asm volatile("s_mov_b32 %0, m0\n\ts_mov_b32 m0, %2\n\ts_nop 0\n\tglobal_load_lds_dwordx4 %1, off\n\ts_mov_b32 m0, %0" : "=&s"(keep) : "v"(gsrc), "s"(lds_dst) : "memory"); }
__device__ __forceinline__ float max3f(float a, float b, float c) { return fmaxf(fmaxf(a, b), c); }
#define ATT_WAIT_BAR() asm volatile("s_waitcnt vmcnt(0) lgkmcnt(0)\n\ts_barrier" ::: "memory")
__device__ __forceinline__ float rowmax(const f32x16& p0, const f32x16& p1) {
    float a = max3f(p0[0], p0[1], p1[0]), b = max3f(p0[2], p0[3], p1[1]); a = max3f(a, p1[2], p1[3]);
#pragma unroll
    for (int r = 4; r < 16; r += 4) { a = max3f(a, p0[r], p0[r + 1]); b = max3f(b, p0[r + 2], p0[r + 3]); a = max3f(a, p1[r], p1[r + 1]); b = max3f(b, p1[r + 2], p1[r + 3]); }
    const float m = fmaxf(a, b);
    auto rr = __builtin_amdgcn_permlane32_swap(__float_as_uint(m), __float_as_uint(m), false, false);
    return fmaxf(__uint_as_float(rr[0]), __uint_as_float(rr[1]));
}
__device__ __forceinline__ void pv(f32x16* o, int vb, bf16x8 pa0, bf16x8 pa1, bf16x8 pa2, bf16x8 pa3) {
#pragma unroll
    for (int d0 = 0; d0 < 2; ++d0) { s16x4 lo[4], hi[4];
#pragma unroll
        for (int ks = 0; ks < 4; ++ks) {
            asm volatile("ds_read_b64_tr_b16 %0,%1 offset:%c2" : "=&v"(lo[ks]) : "v"(vb), "i"(d0 * 4096 + ks * 1024) : "memory");
            asm volatile("ds_read_b64_tr_b16 %0,%1 offset:%c2" : "=&v"(hi[ks]) : "v"(vb), "i"(d0 * 4096 + ks * 1024 + 512) : "memory"); }
        asm volatile("s_waitcnt lgkmcnt(0)" ::: "memory"); __builtin_amdgcn_sched_barrier(0);
#define PK(k) (bf16x8){lo[k][0], lo[k][1], lo[k][2], lo[k][3], hi[k][0], hi[k][1], hi[k][2], hi[k][3]}
        o[d0] = __builtin_amdgcn_mfma_f32_32x32x16_bf16(pa0, PK(0), o[d0], 0, 0, 0);
        o[d0] = __builtin_amdgcn_mfma_f32_32x32x16_bf16(pa1, PK(1), o[d0], 0, 0, 0);
        o[d0] = __builtin_amdgcn_mfma_f32_32x32x16_bf16(pa2, PK(2), o[d0], 0, 0, 0);
        o[d0] = __builtin_amdgcn_mfma_f32_32x32x16_bf16(pa3, PK(3), o[d0], 0, 0, 0);
#undef PK
    }
}
__device__ __forceinline__ void attn_unit(int b, int h, int qb, const bf16* Q, const bf16* __restrict__ KKp, const bf16* __restrict__ Vp, bf16* O, char* shm) {
    const int tid = threadIdx.x, lane = tid & 63, r32 = lane & 31, hi = lane >> 5; const int wid = __builtin_amdgcn_readfirstlane(tid >> 6);
    const long rowbase = (long)b * SEQ; const int q0 = qb * 256;
    const bf16* Qw = Q + (rowbase + q0 + wid * 32) * 768 + h * QKD;
    const bf16* Kh = KKp + rowbase * 768 + h * QKD; const bf16* Vh = Vp + rowbase * 512 + h * VD;
    const unsigned lds0 = (unsigned)(uintptr_t)shm;
    float* wsf = (float*)(shm + LDS_WS) + wid * 64;
    const bf16* ksrc0 = Kh + (long)lane * 768 + wid * 8;
    const bf16* ksrc1 = Kh + (long)lane * 768 + (8 + (wid & 3)) * 8;
    const bf16* vsrc = Vh + (long)(16 * (wid & 3) + (lane >> 2)) * 512 + (wid >> 2) * 32 + (lane & 3) * 8;
    const unsigned kdst0 = lds0 + LDS_K + wid * 1024, kdst1 = lds0 + LDS_K + (8 + (wid & 3)) * 1024, vdst = lds0 + LDS_V + wid * 1024;
#define DMA_KV(t, s) do { glds16(ksrc0 + (long)(t) * 64 * 768, (unsigned)__builtin_amdgcn_readfirstlane(kdst0 + (s) * KSLOT)); \
        if (wid < 4) glds16(ksrc1 + (long)(t) * 64 * 768, (unsigned)__builtin_amdgcn_readfirstlane(kdst1 + (s) * KSLOT)); \
        glds16(vsrc + (long)(t) * 64 * 512, (unsigned)__builtin_amdgcn_readfirstlane(vdst + (s) * VSLOT)); } while (0)
    const int vb0 = (int)(lds0 + LDS_V) + ((lane >> 4) & 1) * 32 + (lane & 3) * 8 + (4 * hi + ((lane & 15) >> 2)) * 64;
    const int NT = (q0 + 256) / 64;
    DMA_KV(0, 0);
    bf16x8 qr[6];
#pragma unroll
    for (int d0 = 0; d0 < 6; ++d0) qr[d0] = *reinterpret_cast<const bf16x8*>(&Qw[(long)r32 * 768 + d0 * 16 + hi * 8]);
    float mrun = -INFINITY, l_reg = 0.f; f32x16 o[2]; o[0] = f32x16{}; o[1] = f32x16{};
    const int qrel = wid * 32 + r32;
    for (int t = 0; t < NT; ++t) {
        ATT_WAIT_BAR();
        if (t + 1 < NT) DMA_KV(t + 1, (t + 1) & 1);
        const char* Kslot = shm + LDS_K + (t & 1) * KSLOT;
        f32x16 p0 = f32x16{}, p1 = f32x16{};
        { const char* kb = Kslot + hi * 1024 + r32 * 16;
#pragma unroll
          for (int d0 = 0; d0 < 6; ++d0) { const bf16x8 b0 = *reinterpret_cast<const bf16x8*>(kb + d0 * 2048); const bf16x8 b1 = *reinterpret_cast<const bf16x8*>(kb + d0 * 2048 + 512);
              p0 = __builtin_amdgcn_mfma_f32_32x32x16_bf16(b0, qr[d0], p0, 0, 0, 0); p1 = __builtin_amdgcn_mfma_f32_32x32x16_bf16(b1, qr[d0], p1, 0, 0, 0); } }
        const int jb = t - (NT - 4);
        if (jb >= 0) { const int kbase = 64 * jb + 4 * hi;
#pragma unroll
            for (int r = 0; r < 16; ++r) { const int kv = kbase + (r & 3) + 8 * (r >> 2); if (kv > qrel) p0[r] = -INFINITY; if (kv + 32 > qrel) p1[r] = -INFINITY; } }
        const float rm = rowmax(p0, p1); const float mnew = fmaxf(mrun, rm); const float f = exp2f(mrun - mnew); mrun = mnew;
        float sacc = 0.f;
#pragma unroll
        for (int r = 0; r < 16; ++r) { p0[r] = exp2f(p0[r] - mnew); p1[r] = exp2f(p1[r] - mnew); sacc += p0[r] + p1[r]; }
        l_reg = l_reg * f + sacc;
        if (hi == 0) wsf[r32] = f;
        asm volatile("s_waitcnt lgkmcnt(0)" ::: "memory");
#pragma unroll
        for (int r = 0; r < 16; ++r) { const float fr_ = wsf[crow(r, hi)]; o[0][r] *= fr_; o[1][r] *= fr_; }
        u32x4 pw0, pw1, pw2, pw3;
        pw0 = (u32x4){cvt_pk_bf16(p0[0], p0[1]), cvt_pk_bf16(p0[2], p0[3]), cvt_pk_bf16(p0[4], p0[5]), cvt_pk_bf16(p0[6], p0[7])};
        pw1 = (u32x4){cvt_pk_bf16(p0[8], p0[9]), cvt_pk_bf16(p0[10], p0[11]), cvt_pk_bf16(p0[12], p0[13]), cvt_pk_bf16(p0[14], p0[15])};
        pw2 = (u32x4){cvt_pk_bf16(p1[0], p1[1]), cvt_pk_bf16(p1[2], p1[3]), cvt_pk_bf16(p1[4], p1[5]), cvt_pk_bf16(p1[6], p1[7])};
        pw3 = (u32x4){cvt_pk_bf16(p1[8], p1[9]), cvt_pk_bf16(p1[10], p1[11]), cvt_pk_bf16(p1[12], p1[13]), cvt_pk_bf16(p1[14], p1[15])};
        asm volatile("s_waitcnt lgkmcnt(0)" ::: "memory");
        pv(o, vb0 + (t & 1) * VSLOT, __builtin_bit_cast(bf16x8, pw0), __builtin_bit_cast(bf16x8, pw1), __builtin_bit_cast(bf16x8, pw2), __builtin_bit_cast(bf16x8, pw3));
    }
    { auto rr = __builtin_amdgcn_permlane32_swap(__float_as_uint(l_reg), __float_as_uint(l_reg), false, false); l_reg = __uint_as_float(rr[0]) + __uint_as_float(rr[1]); }
    if (hi == 0) wsf[32 + r32] = l_reg; asm volatile("s_waitcnt lgkmcnt(0)" ::: "memory");
    float rli[16];
#pragma unroll
    for (int r = 0; r < 16; ++r) rli[r] = 1.0f / wsf[32 + crow(r, hi)];
    bf16* Ow = O + (rowbase + q0 + wid * 32) * 512 + h * VD;
    { bf16* stg = (bf16*)(shm + LDS_OST) + wid * 2048;
#pragma unroll
      for (int r = 0; r < 16; ++r) { const int orow = crow(r, hi);
#pragma unroll
          for (int d0 = 0; d0 < 2; ++d0) stg[orow * 64 + d0 * 32 + r32] = (bf16)f2bf(o[d0][r] * rli[r]); }
      asm volatile("s_waitcnt lgkmcnt(0)" ::: "memory");
#pragma unroll
      for (int i = 0; i < 4; ++i) { const int row = i * 8 + (lane >> 3), ch = lane & 7; const u32x4 v = *(const u32x4*)(stg + row * 64 + ch * 8); *(u32x4*)(Ow + (long)row * 512 + ch * 8) = v; } }
    asm volatile("s_waitcnt vmcnt(0) lgkmcnt(0)\n\ts_barrier" ::: "memory");
#undef DMA_KV
}
}

__device__ __forceinline__ void phase_attn(const Params& p, const Frame& F, char* lds_generic, int a0, int na) {
    const bf16* Q = WSP(bf16, WS_Q); const bf16* KKp = WSP(bf16, WS_KK); const bf16* Vp = WSP(bf16, WS_V); bf16* O = WSP(bf16, WS_O);
    for (int u = a0; u < 128; u += na) { const int bh = u >> 1, sub = u & 1;
#pragma unroll 1
        for (int i = 0; i < 8; ++i) { const int pi = sub + 2 * (i >> 1); const int qb = (i & 1) ? 15 - pi : pi;
            att::attn_unit(bh >> 3, bh & 7, qb, Q, KKp, Vp, O, lds_generic); } }
}

#define DPP_F(x, ctrl) __builtin_bit_cast(float, __builtin_amdgcn_update_dpp(0, __builtin_bit_cast(int, (x)), (ctrl), 0xF, 0xF, true))
__device__ __forceinline__ float row16_sum(float x) {
    x += DPP_F(x, 0xB1);
    x += DPP_F(x, 0x4E);
    x += DPP_F(x, 0x141);
    x += DPP_F(x, 0x140);
    return x;
}
__device__ __forceinline__ float mul_s(float a, float b) { float d; asm("v_mul_f32 %0, %1, %2" : "=v"(d) : "v"(a), "v"(b)); return d; }
__device__ __forceinline__ float fma_s(float a, float b, float c) { float d; asm("v_fma_f32 %0, %1, %2, %3" : "=v"(d) : "v"(a), "v"(b), "v"(c)); return d; }
__device__ __forceinline__ float fnma_s(float a, float b, float c) { float d; asm("v_fma_f32 %0, -%1, %2, %3" : "=v"(d) : "v"(a), "v"(b), "v"(c)); return d; }
__device__ __forceinline__ float add_nop_s(float a, float b) { float d; asm("v_add_f32 %0, %1, %2\n\ts_nop 1" : "=v"(d) : "v"(a), "v"(b)); return d; }
__device__ __forceinline__ void phase_rwkv(const Params& p, const Frame& F, int l, int r0, int nr) {
    constexpr int TC = 32, NCH = SEQ / TC;
    constexpr int BUF_F = 5 * TC * 64 + TC * 32 + TC * 2;
    LAS float* base = (LAS float*)(F.lds);
    const bf16* RK = WSP(bf16, WS_RK); const float* WAG = WSP(float, WS_WAG);
    const bf16* Vv = l == 0 ? WSP(bf16, WS_VS0) : WSP(bf16, WS_VR);
    float* RO = WSP(float, WS_RO);
    const float* kkw = INP(I_KK) + (size_t)l * C5; const float* kaw = INP(I_KA) + (size_t)l * C5;
    const int tid = F.tid, lane = F.lane, wave = F.wave;
    for (int u = r0; u < 128; u += nr) {
        const int bh = u >> 1, half = u & 1, b = bh >> 3, h = bh & 7;
        const size_t row0 = (size_t)b * SEQ;
        const int pt = tid >> 4, j4 = tid & 15; const int c = h * 64 + 4 * j4;
        const f32x4 kkp = *(const f32x4*)(kkw + c), kap = *(const f32x4*)(kaw + c);
        const int rsub = lane >> 4, jg = lane & 15, myrow = wave * 4 + rsub;
        u32x2 g_r, g_k; f32x4 g_d, g_a; unsigned g_v;
#define RW_FETCH(chn) do { const size_t tok = row0 + (size_t)(chn) * TC + pt; g_r = *(const u32x2*)(RK + tok * 1024 + c); g_k = *(const u32x2*)(RK + tok * 1024 + 512 + c); \
            g_d = *(const f32x4*)(WAG + tok * N_SM + c); g_a = *(const f32x4*)(WAG + tok * N_SM + 512 + c); g_v = *(const unsigned*)(Vv + tok * C5 + h * 64 + half * 32 + 2 * j4); } while (0)
#define RW_STORE(chn) do { LAS float* bb = base + ((chn) & 1) * BUF_F; \
            const float r0 = bflo(g_r.x), r1 = bfhi(g_r.x), r2 = bflo(g_r.y), r3 = bfhi(g_r.y), k0 = bflo(g_k.x), k1 = bfhi(g_k.x), k2 = bflo(g_k.y), k3 = bfhi(g_k.y); \
            const float q0 = k0 * kkp.x, q1 = k1 * kkp.y, q2 = k2 * kkp.z, q3 = k3 * kkp.w; \
            const float ss = row16_sum((q0 * q0 + q1 * q1) + (q2 * q2 + q3 * q3)); const float inv = 1.0f / fmaxf(sqrtf(ss), 1e-12f); \
            const f32x4 kap4 = (f32x4){q0 * inv, q1 * inv, q2 * inv, q3 * inv}; const f32x4 be4 = kap4 * g_a; \
            const f32x4 kp4 = (f32x4){k0 * (1.0f + (g_a.x - 1.0f) * kap.x), k1 * (1.0f + (g_a.y - 1.0f) * kap.y), k2 * (1.0f + (g_a.z - 1.0f) * kap.z), k3 * (1.0f + (g_a.w - 1.0f) * kap.w)}; \
            const f32x4 r4 = (f32x4){r0, r1, r2, r3}; const f32x4 wr4 = g_d * r4; \
            const float c1 = row16_sum((be4.x * r0 + be4.y * r1) + (be4.z * r2 + be4.w * r3)), c2 = row16_sum((kp4.x * r0 + kp4.y * r1) + (kp4.z * r2 + kp4.w * r3)); \
            const int o_ = pt * 64 + 4 * j4; \
            *(LAS f32x4*)(bb + o_) = kap4; *(LAS f32x4*)(bb + TC * 64 + o_) = wr4; *(LAS f32x4*)(bb + 2 * TC * 64 + o_) = g_d; *(LAS f32x4*)(bb + 3 * TC * 64 + o_) = be4; *(LAS f32x4*)(bb + 4 * TC * 64 + o_) = kp4; \
            *(LAS f32x2*)(bb + 5 * TC * 64 + pt * 32 + 2 * j4) = (f32x2){bflo(g_v), bfhi(g_v)}; \
            if (j4 == 0) *(LAS f32x2*)(bb + 5 * TC * 64 + TC * 32 + 2 * pt) = (f32x2){c1, c2}; } while (0)
        __syncthreads();
        RW_FETCH(0); RW_STORE(0);
        __syncthreads();
        float s0 = 0.f, s1 = 0.f, s2 = 0.f, s3 = 0.f;
        float* rout = RO + (row0 + jg) * C5 + h * 64 + half * 32 + myrow;
#pragma unroll 1
        for (int ch = 0; ch < NCH; ++ch) {
            if (ch + 1 < NCH) RW_FETCH(ch + 1);
            const LAS float* bb = base + (ch & 1) * BUF_F + 4 * jg;
            const LAS float* sV = base + (ch & 1) * BUF_F + 5 * TC * 64 + myrow; const LAS float* sC = base + (ch & 1) * BUF_F + 5 * TC * 64 + TC * 32;
#define RW_LOAD(t) do { kan = *(const LAS f32x4*)(bb + (t) * 64); wrn = *(const LAS f32x4*)(bb + TC * 64 + (t) * 64); w4n = *(const LAS f32x4*)(bb + 2 * TC * 64 + (t) * 64); ben = *(const LAS f32x4*)(bb + 3 * TC * 64 + (t) * 64); \
                kpn = *(const LAS f32x4*)(bb + 4 * TC * 64 + (t) * 64); vin = sV[(t) * 32]; ccn = *(const LAS f32x2*)(sC + 2 * (t)); } while (0)
            f32x4 kan, wrn, w4n, ben, kpn; float vin; f32x2 ccn;
            RW_LOAD(0);
#pragma unroll
            for (int t0 = 0; t0 < TC; t0 += 16) {
                float keep = 0.f;
#pragma unroll
                for (int tt = 0; tt < 16; ++tt) { const int t = t0 + tt;
                    const f32x4 ka = kan, wr = wrn, w4 = w4n, be = ben, kp = kpn; const float vi = vin; const f32x2 cc = ccn;
                    { const int tn = (t + 1 < TC) ? t + 1 : t; RW_LOAD(tn); }
                    __builtin_amdgcn_sched_barrier(0);
                    float a1 = mul_s(s0, ka.x), b1 = mul_s(s2, ka.z), a2 = mul_s(s0, wr.x), b2 = mul_s(s2, wr.z);
                    a1 = fma_s(s1, ka.y, a1); b1 = fma_s(s3, ka.w, b1); a2 = fma_s(s1, wr.y, a2); b2 = fma_s(s3, wr.w, b2);
                    float d1 = add_nop_s(a1, b1), d2 = add_nop_s(a2, b2);
                    d1 = row16_sum(d1); d2 = row16_sum(d2);
                    const float ov = fnma_s(d1, cc.x, fma_s(vi, cc.y, d2));
                    s0 = fma_s(vi, kp.x, fnma_s(d1, be.x, mul_s(s0, w4.x))); s1 = fma_s(vi, kp.y, fnma_s(d1, be.y, mul_s(s1, w4.y)));
                    s2 = fma_s(vi, kp.z, fnma_s(d1, be.z, mul_s(s2, w4.z))); s3 = fma_s(vi, kp.w, fnma_s(d1, be.w, mul_s(s3, w4.w)));
                    keep = (jg == tt) ? ov : keep;
                    __builtin_amdgcn_sched_barrier(0); }
                rout[(size_t)(ch * TC + t0) * C5] = keep;
            }
#undef RW_LOAD
            if (ch + 1 < NCH) RW_STORE(ch + 1);
            __syncthreads();
        }
#undef RW_FETCH
#undef RW_STORE
    }
    __syncthreads();
}

__device__ __forceinline__ void phase_mix(const Params& p, const Frame& F, int l) {
    const int gw = F.vcu * NWAVES + F.wave, NGW = F.G * NWAVES; const int lane = F.lane;
    const bf16* O = WSP(bf16, WS_O); const float* RO = WSP(float, WS_RO); const bf16* RK = WSP(bf16, WS_RK); const float* WAG = WSP(float, WS_WAG);
    const bf16* Vv = l == 0 ? WSP(bf16, WS_VS0) : WSP(bf16, WS_VR); bf16* MIX = WSP(bf16, WS_MIX);
    const float* og = INP(I_MOUTG) + (size_t)l * C5; const float* gng = INP(I_GNG) + (size_t)l * C5; const float* gnb = INP(I_GNB) + (size_t)l * C5;
    const float* kaw = INP(I_KA) + (size_t)l * C5; const float* rkw = INP(I_RK) + (size_t)l * C5;
    for (int t = gw; t < T; t += NGW) {
        const int c = 8 * lane;
        { const u32x4 ow = *(const u32x4*)(O + (size_t)t * C5 + c); float o[8]; float ss = 0.f;
#pragma unroll
          for (int j = 0; j < 4; ++j) { o[2 * j] = bflo(ow[j]); o[2 * j + 1] = bfhi(ow[j]); ss += o[2 * j] * o[2 * j] + o[2 * j + 1] * o[2 * j + 1]; }
          const float rs = 1.f / sqrtf(wave_sum(ss) * (1.f / C5) + RMS_EPS);
          const f32x4 g0 = *(const f32x4*)(og + c), g1 = *(const f32x4*)(og + c + 4);
          u32x4 w; w.x = pk2(o[0] * rs * g0.x, o[1] * rs * g0.y); w.y = pk2(o[2] * rs * g0.z, o[3] * rs * g0.w); w.z = pk2(o[4] * rs * g1.x, o[5] * rs * g1.y); w.w = pk2(o[6] * rs * g1.z, o[7] * rs * g1.w);
          *(u32x4*)(MIX + (size_t)t * D + c) = w; }
        { const f32x4 r0 = *(const f32x4*)(RO + (size_t)t * C5 + c), r1 = *(const f32x4*)(RO + (size_t)t * C5 + c + 4);
          float o[8]; float s = 0.f;
#pragma unroll
          for (int j = 0; j < 8; ++j) { o[j] = j < 4 ? r0[j & 3] : r1[j & 3]; s += o[j]; }
          s += __shfl_xor(s, 1); s += __shfl_xor(s, 2); s += __shfl_xor(s, 4); const float mean = s * (1.f / 64.f); float q = 0.f;
#pragma unroll
          for (int j = 0; j < 8; ++j) { o[j] -= mean; q += o[j] * o[j]; }
          q += __shfl_xor(q, 1); q += __shfl_xor(q, 2); q += __shfl_xor(q, 4); const float rstd = 1.f / sqrtf(q * (1.f / 64.f) + GN_EPS);
          const u32x4 rw = *(const u32x4*)(RK + (size_t)t * 1024 + c), kw = *(const u32x4*)(RK + (size_t)t * 1024 + 512 + c), vw = *(const u32x4*)(Vv + (size_t)t * C5 + c);
          const f32x4 a0 = *(const f32x4*)(WAG + (size_t)t * N_SM + 512 + c), a1 = *(const f32x4*)(WAG + (size_t)t * N_SM + 512 + c + 4);
          const f32x4 g0 = *(const f32x4*)(WAG + (size_t)t * N_SM + 1024 + c), g1 = *(const f32x4*)(WAG + (size_t)t * N_SM + 1024 + c + 4);
          const f32x4 ka0 = *(const f32x4*)(kaw + c), ka1 = *(const f32x4*)(kaw + c + 4), rk0 = *(const f32x4*)(rkw + c), rk1 = *(const f32x4*)(rkw + c + 4);
          const f32x4 gg0 = *(const f32x4*)(gng + c), gg1 = *(const f32x4*)(gng + c + 4), gb0 = *(const f32x4*)(gnb + c), gb1 = *(const f32x4*)(gnb + c + 4);
          float r[8], k[8], v[8]; float bon = 0.f;
#pragma unroll
          for (int j = 0; j < 4; ++j) { r[2 * j] = bflo(rw[j]); r[2 * j + 1] = bfhi(rw[j]); k[2 * j] = bflo(kw[j]); k[2 * j + 1] = bfhi(kw[j]); v[2 * j] = bflo(vw[j]); v[2 * j + 1] = bfhi(vw[j]); }
#pragma unroll
          for (int j = 0; j < 8; ++j) { const float a = j < 4 ? a0[j & 3] : a1[j & 3]; const float kp = k[j] * (1.0f + (a - 1.0f) * (j < 4 ? ka0[j & 3] : ka1[j & 3])); bon += r[j] * kp * (j < 4 ? rk0[j & 3] : rk1[j & 3]); }
          bon += __shfl_xor(bon, 1); bon += __shfl_xor(bon, 2); bon += __shfl_xor(bon, 4);
          float y[8];
#pragma unroll
          for (int j = 0; j < 8; ++j) { const float gn = o[j] * rstd * (j < 4 ? gg0[j & 3] : gg1[j & 3]) + (j < 4 ? gb0[j & 3] : gb1[j & 3]); y[j] = (gn + bon * v[j]) * (j < 4 ? g0[j & 3] : g1[j & 3]); }
          u32x4 w; w.x = pk2(y[0], y[1]); w.y = pk2(y[2], y[3]); w.z = pk2(y[4], y[5]); w.w = pk2(y[6], y[7]);
          *(u32x4*)(MIX + (size_t)t * D + C5 + c) = w; }
    }
}

__device__ __forceinline__ void phase_ln1_route(const Params& p, const Frame& F, int l) {
    LAS float* hrow = (LAS float*)(F.lds) + F.wave * D;
    LAS int* hist = (LAS int*)(F.lds + 65536);
    LAS int* basep = hist + 32;
    LAS int* rinfo = hist + 64;
    LAS float* rgate = (LAS float*)(rinfo + 512);
    const float* mod = WSP(float, WS_MOD) + (size_t)l * NBATCH * 6144;
    const float* g1 = INP(I_LN1G) + (size_t)l * D; const float* b1 = INP(I_LN1B) + (size_t)l * D;
    const float* rwt = INP(I_RW) + (size_t)l * D * NE; const float* rb = INP(I_RB) + (size_t)l * NE;
    unsigned* cnt = (unsigned*)(F.ws + WS_CTL) + CW_CNT + l * 64;
    int* LIST = WSP(int, WS_LIST); float* GATEL = WSP(float, WS_GATEL); int* TOKSLOT = WSP(int, WS_TOKSLOT);
    const int lane = F.lane;
    for (int chunk = F.vcu; chunk < T / 128; chunk += F.G) {
        __syncthreads();
        if (F.tid < 32) hist[F.tid] = 0;
        __syncthreads();
        for (int rr = 0; rr < 16; ++rr) {
            const int lr = F.wave * 16 + rr; const int m = chunk * 128 + lr; const int b = m / SEQ;
            GAS f32x4* xr = (GAS f32x4*)(WSP(float, WS_X) + (size_t)m * D) + lane;
            f32x4 v[4]; float s = 0.f;
#pragma unroll
            for (int j = 0; j < 4; ++j) { v[j] = xr[64 * j]; s += (v[j].x + v[j].y) + (v[j].z + v[j].w); }
            const float mean = wave_sum(s) * (1.f / D); float s2 = 0.f;
#pragma unroll
            for (int j = 0; j < 4; ++j) { v[j] = v[j] - mean; s2 += (v[j].x * v[j].x + v[j].y * v[j].y) + (v[j].z * v[j].z + v[j].w * v[j].w); }
            const float rstd = 1.f / sqrtf(wave_sum(s2) * (1.f / D) + LN_EPS);
            GAS u32x2* ho = (GAS u32x2*)(WSP(bf16, WS_H) + (size_t)m * D) + lane;
#pragma unroll
            for (int j = 0; j < 4; ++j) { const int c = 4 * lane + 256 * j;
                const f32x4 g = *(const f32x4*)(g1 + c), be = *(const f32x4*)(b1 + c);
                const f32x4 x1 = v[j] * rstd * g + be; xr[64 * j] = x1;
                const f32x4 sh = *(const f32x4*)(mod + (size_t)b * 6144 + 3072 + c), sc = *(const f32x4*)(mod + (size_t)b * 6144 + 4096 + c);
                const f32x4 h = x1 * (sc + 1.0f) + sh; u32x2 w; w.x = pk2(h.x, h.y); w.y = pk2(h.z, h.w); ho[64 * j] = w;
                *(LAS f32x4*)(hrow + c) = h; }
            LDS_WAIT(); asm volatile("" ::: "memory");
            const int e = lane & 31, kh = lane >> 5; float acc0 = 0.f, acc1 = 0.f;
            const float* rwp = rwt + (size_t)(kh * 512) * NE + e; const LAS float* hp = hrow + kh * 512;
#pragma unroll 4
            for (int k = 0; k < 512; k += 4) { const f32x4 hv = *(const LAS f32x4*)(hp + k);
                acc0 += hv.x * rwp[(size_t)(k + 0) * NE]; acc1 += hv.y * rwp[(size_t)(k + 1) * NE]; acc0 += hv.z * rwp[(size_t)(k + 2) * NE]; acc1 += hv.w * rwp[(size_t)(k + 3) * NE]; }
            float logit = acc0 + acc1; logit += __shfl_xor(logit, 32); logit += rb[e];
            float val = logit; float tv0 = 0.f, tv1 = 0.f, tv2 = 0.f, tv3 = 0.f; int te0 = 0, te1 = 0, te2 = 0, te3 = 0;
#pragma unroll
            for (int k = 0; k < 4; ++k) { float mx = val;
#pragma unroll
                for (int o = 1; o < 32; o <<= 1) mx = fmaxf(mx, __shfl_xor(mx, o));
                const unsigned long long bal = __ballot(val == mx && lane < 32); const int ek = __builtin_ctzll(bal);
                if (k == 0) { tv0 = mx; te0 = ek; } else if (k == 1) { tv1 = mx; te1 = ek; } else if (k == 2) { tv2 = mx; te2 = ek; } else { tv3 = mx; te3 = ek; }
                if (e == ek) val = -INFINITY; }
            const float e0 = 1.0f, e1 = __expf(tv1 - tv0), e2 = __expf(tv2 - tv0), e3 = __expf(tv3 - tv0); const float inv = 1.0f / (e0 + e1 + e2 + e3);
            if (lane < 4) { const int ek = lane == 0 ? te0 : lane == 1 ? te1 : lane == 2 ? te2 : te3; const float gk = (lane == 0 ? e0 : lane == 1 ? e1 : lane == 2 ? e2 : e3) * inv;
                const int lp = __hip_atomic_fetch_add(&hist[ek], 1, __ATOMIC_RELAXED, __HIP_MEMORY_SCOPE_WORKGROUP); rinfo[lr * 4 + lane] = (ek << 16) | lp; rgate[lr * 4 + lane] = gk; }
            LDS_WAIT(); asm volatile("" ::: "memory");
        }
        __syncthreads();
        if (F.tid < 32) basep[F.tid] = (int)__hip_atomic_fetch_add(cnt + F.tid, (unsigned)hist[F.tid], RLX_AGENT);
        __syncthreads();
        { const int lr = F.tid >> 2, k = F.tid & 3; const int m = chunk * 128 + lr; const int info = rinfo[F.tid]; const int ek = info >> 16; const int pos = basep[ek] + (info & 0xffff);
          LIST[ek * CAP + pos] = m; GATEL[ek * CAP + pos] = rgate[F.tid]; TOKSLOT[m * 4 + k] = (ek << 16) | pos; }
    }
    __syncthreads();
}

__device__ __forceinline__ void moe_tables(const Frame& F, int l) {
    LAS int* tb = (LAS int*)(F.lds + TB_OFF); LAS int* cn = tb + 40;
    const unsigned* cnt = (const unsigned*)(F.ws + WS_CTL) + CW_CNT + l * 64;
    __syncthreads();
    if (F.tid == 0) { int acc = 0;
        for (int e = 0; e < NE; ++e) { const int c = (int)__hip_atomic_load(cnt + e, RLX_AGENT); cn[e] = c; tb[e] = acc; acc += (c + 255) >> 8; }
        tb[NE] = acc; }
    __syncthreads();
}

__device__ __forceinline__ void phase_combine(const Params& p, const Frame& F, int l) {
    const LAS int* tb = (const LAS int*)(F.lds + TB_OFF);
    const int gw = F.vcu * NWAVES + F.wave, NGW = F.G * NWAVES; const int lane = F.lane;
    const float* mod = WSP(float, WS_MOD) + (size_t)l * NBATCH * 6144; const float* modn = WSP(float, WS_MOD) + (size_t)(l + 1) * NBATCH * 6144;
    const float* g2 = INP(I_LN2G) + (size_t)l * D; const float* b2 = INP(I_LN2B) + (size_t)l * D;
    const bf16* Y = WSP(bf16, WS_Y); const int* TOKSLOT = WSP(int, WS_TOKSLOT);
    const bool lastl = (l == DEPTH - 1);
    for (int m = gw; m < T; m += NGW) {
        const int b = m / SEQ;
        int srow[4];
#pragma unroll
        for (int k = 0; k < 4; ++k) { const int ts = TOKSLOT[m * 4 + k]; const int e = ts >> 16, pos = ts & 0xffff; srow[k] = tb[e] * 256 + pos; }
        GAS f32x4* xr = (GAS f32x4*)(WSP(float, WS_X) + (size_t)m * D) + lane;
        f32x4 v[4]; float s = 0.f;
#pragma unroll
        for (int j = 0; j < 4; ++j) { const int c = 4 * lane + 256 * j; f32x4 y = (f32x4){0.f, 0.f, 0.f, 0.f};
#pragma unroll
            for (int k = 0; k < 4; ++k) { const u32x2 yw = *(const u32x2*)(Y + (size_t)srow[k] * D + c); y.x += bflo(yw.x); y.y += bfhi(yw.x); y.z += bflo(yw.y); y.w += bfhi(yw.y); }
            const f32x4 gt = *(const f32x4*)(mod + (size_t)b * 6144 + 5120 + c) + 1.0f;
            v[j] = xr[64 * j] * DN_ALPHA + gt * y; s += (v[j].x + v[j].y) + (v[j].z + v[j].w); }
        const float mean = wave_sum(s) * (1.f / D); float s2 = 0.f;
#pragma unroll
        for (int j = 0; j < 4; ++j) { v[j] = v[j] - mean; s2 += (v[j].x * v[j].x + v[j].y * v[j].y) + (v[j].z * v[j].z + v[j].w * v[j].w); }
        const float rstd = 1.f / sqrtf(wave_sum(s2) * (1.f / D) + LN_EPS);
        GAS f32x4* oo = (GAS f32x4*)(p.out + (size_t)m * D) + lane;
        GAS u32x2* ho = (GAS u32x2*)(WSP(bf16, WS_H) + (size_t)m * D) + lane;
#pragma unroll
        for (int j = 0; j < 4; ++j) { const int c = 4 * lane + 256 * j;
            const f32x4 g = *(const f32x4*)(g2 + c), be = *(const f32x4*)(b2 + c);
            const f32x4 x2 = v[j] * rstd * g + be;
            if (lastl) oo[64 * j] = x2;
            else { xr[64 * j] = x2;
                const f32x4 sh = *(const f32x4*)(modn + (size_t)b * 6144 + c), sc = *(const f32x4*)(modn + (size_t)b * 6144 + 1024 + c);
                const f32x4 h = x2 * (sc + 1.0f) + sh; u32x2 w; w.x = pk2(h.x, h.y); w.y = pk2(h.z, h.w); ho[64 * j] = w; } }
    }
}

constexpr int PH_PER_LAYER = 11, N_PHASES = 2 + DEPTH * PH_PER_LAYER;
__global__ void __launch_bounds__(NTHREADS, 2) fwd(Params p) {
    extern __shared__ __attribute__((aligned(16))) unsigned char lds[];
    Frame F;
    F.lds = (LAS unsigned char*)lds; F.tid = threadIdx.x; F.lane = F.tid & 63; F.wave = __builtin_amdgcn_readfirstlane(F.tid >> 6);
    F.G = gridDim.x; { const int bx = blockIdx.x; F.vcu = (F.G % 8 == 0) ? (bx % 8) * (F.G / 8) + bx / 8 : bx; }
    F.ws = p.ws;
    volatile LAS unsigned* MISC = (volatile LAS unsigned*)(F.lds + MISC_OFF);
    if (F.tid < 64) MISC[F.tid] = 0u;
    __syncthreads();
    unsigned* ctl = (unsigned*)(p.ws + WS_CTL);
#if MK_ONE_LAUNCH
    XcdBarrier bar = xcd_barrier_post(ctl + CW_BAR, MISC + 8);
#define GRID_BAR() xcd_barrier(bar)
#else
#define GRID_BAR() do {} while (0)
#endif
    const int lo = p.ph_lo, hi = p.ph_hi;
#ifndef PH_MASK
#define PH_MASK 0xFFFFFFFFu
#endif
#define IN(k) (lo <= (k) && (k) < hi)
#define EN(j) ((PH_MASK >> (j)) & 1u)
#define SEAM(k) do { if (IN(k) && IN((k) + 1)) GRID_BAR(); } while (0)
    LAS unsigned char* ring = F.lds;

    if (EN(0) && IN(0)) { for (int rep = 0; rep < REP_PRO; ++rep) phase_prologue(p, F); } SEAM(0);
    if (EN(1) && IN(1)) { phase_ln0(p, F); } SEAM(1);
#define LAYER_BODY \
        constexpr int pb = 2 + l * PH_PER_LAYER; \
        const float* mod = WSP(float, WS_MOD) + (size_t)l * NBATCH * 6144; \
        if (EN(2) && IN(pb + 0)) { \
            pg8::Gemm g{WSP(bf16, WS_H), WSP(bf16, WS_WINT) + (size_t)l * N_INP * D, T, N_INP, D}; pg8::DenseOrder S; S.init(T, N_INP, F.G, (int)blockIdx.x); \
            pg8::EpiBf16Plain E{WSP(bf16, WS_P), N_INP}; \
            for (int rep = 0; rep < REP_WIN; ++rep) pg8::gemm_phase<pg8::EpiBf16Plain, pg8::DenseOrder, true>(ring, g, S, E); \
        } SEAM(pb + 0); \
        if (EN(3) && IN(pb + 1)) { for (int rep = 0; rep < REP_PREP; ++rep) phase_prep(p, F, l); } SEAM(pb + 1); \
        if (EN(4) && IN(pb + 2)) { \
            if (EN(13)) { pg8::Gemm g{WSP(bf16, WS_AN), WSP(bf16, WS_WUPT) + (size_t)l * N_UP * K_UP, T, N_UP, K_UP}; pg8::DenseOrder S; S.init(T, N_UP, F.G, (int)blockIdx.x); \
              pg8::EpiMlaUp E{WSP(bf16, WS_Q), WSP(bf16, WS_KK), WSP(bf16, WS_V), WSP(float, WS_CS)}; \
              pg8::gemm_phase<pg8::EpiMlaUp, pg8::DenseOrder, true>(ring, g, S, E); } \
            if (EN(14)) { pg8::Gemm g{WSP(bf16, WS_A2), WSP(bf16, WS_WSMT) + (size_t)l * N_SM * K_SM, T, N_SM, K_SM}; pg8::DenseOrder S; S.init(T, N_SM, F.G, (int)blockIdx.x); \
              pg8::EpiRwkvSmall E{WSP(float, WS_WAG), INP(I_W0) + (size_t)l * C5, INP(I_A0) + (size_t)l * C5}; \
              pg8::gemm_phase<pg8::EpiRwkvSmall, pg8::DenseOrder, true>(ring, g, S, E); } \
            if (EN(15) && l > 0) { pg8::Gemm g{WSP(bf16, WS_VS1), WSP(bf16, WS_WV12T), T, C5, C5}; pg8::DenseOrder S; S.init(T, C5, F.G, (int)blockIdx.x); \
              pg8::EpiVres E{WSP(bf16, WS_VS1), WSP(bf16, WS_VS0), WSP(bf16, WS_VR), INP(I_V0)}; \
              pg8::gemm_phase<pg8::EpiVres, pg8::DenseOrder, true>(ring, g, S, E); } \
        } SEAM(pb + 2); \
        if (EN(5) && IN(pb + 3)) { const int nr = F.G / 2; if (F.vcu < nr) phase_rwkv(p, F, l, F.vcu, nr); else phase_attn(p, F, (char*)lds, F.vcu - nr, F.G - nr); } SEAM(pb + 3); \
        if (EN(7) && IN(pb + 5)) { for (int rep = 0; rep < REP_MIX; ++rep) phase_mix(p, F, l); } SEAM(pb + 5); \
        if (EN(8) && IN(pb + 6)) { \
            pg8::Gemm g{WSP(bf16, WS_MIX), WSP(bf16, WS_WOT) + (size_t)l * D * D, T, D, D}; pg8::DenseOrder S; S.init(T, D, F.G, (int)blockIdx.x); \
            pg8::EpiWo E{WSP(float, WS_X), mod + 2048}; \
            pg8::gemm_phase<pg8::EpiWo, pg8::DenseOrder, true>(ring, g, S, E); \
        } SEAM(pb + 6); \
        if (EN(9) && IN(pb + 7)) { phase_ln1_route(p, F, l); } SEAM(pb + 7); \
        if (EN(10) && IN(pb + 8)) { \
            moe_tables(F, l); \
            const LAS int* tb = (const LAS int*)(F.lds + TB_OFF); \
            pg8::Gemm g{WSP(bf16, WS_H), WSP(bf16, WS_W1T) + (size_t)l * NE * 2048 * D, T, 2048, D}; \
            pg8::MoeOrder<true> S{tb, tb + 40, WSP(int, WS_LIST), 8, F.G, F.vcu, (LAS unsigned*)(F.lds + GT_OFF)}; \
            pg8::EpiSwiglu E{WSP(bf16, WS_H1), WSP(float, WS_B1P) + (size_t)l * NE * 2048}; \
            for (int rep = 0; rep < REP_MOE1; ++rep) pg8::gemm_phase<pg8::EpiSwiglu, pg8::MoeOrder<true>, true>(ring, g, S, E); \
        } SEAM(pb + 8); \
        if (EN(11) && IN(pb + 9)) { \
            moe_tables(F, l); \
            const LAS int* tb = (const LAS int*)(F.lds + TB_OFF); \
            pg8::Gemm g{WSP(bf16, WS_H1), WSP(bf16, WS_W2T) + (size_t)l * NE * D * FF, MAXSLOT, D, FF}; \
            pg8::MoeOrder<false> S{tb, tb + 40, nullptr, 4, F.G, F.vcu, nullptr}; \
            pg8::EpiMoeOut E{WSP(bf16, WS_Y), INP(I_EB2) + (size_t)l * NE * D, WSP(float, WS_GATEL), tb}; \
            for (int rep = 0; rep < REP_MOE2; ++rep) pg8::gemm_phase<pg8::EpiMoeOut, pg8::MoeOrder<false>, true>(ring, g, S, E); \
        } SEAM(pb + 9); \
        if (EN(12) && IN(pb + 10)) { moe_tables(F, l); phase_combine(p, F, l); } SEAM(pb + 10);
    { constexpr int l = 0; LAYER_BODY }
    { constexpr int l = 1; LAYER_BODY }
#undef LAYER_BODY
#undef IN
#undef SEAM
}

extern "C" void kernel_launch(void* const* d_in, const int* in_sizes, int n_in, void* d_out, int out_size, void* d_ws, size_t ws_size, hipStream_t stream) {
    static int grid = 0;
    if (grid == 0) {
        if (n_in != N_INPUTS || out_size != T * D || ws_size < WS_END) { fprintf(stderr, "kernel_launch: unexpected problem: n_in %d out %d ws %zu\n", n_in, out_size, ws_size); grid = -1; return; }
        int dev = 0, cus = 0, per_cu = 0;
        if (hipGetDevice(&dev) != hipSuccess || hipDeviceGetAttribute(&cus, hipDeviceAttributeMultiprocessorCount, dev) != hipSuccess) { grid = -1; return; }
        if (hipFuncSetAttribute((const void*)fwd, hipFuncAttributeMaxDynamicSharedMemorySize, LDS_BYTES) != hipSuccess) { fprintf(stderr, "kernel_launch: hipFuncSetAttribute failed\n"); grid = -1; return; }
        if (hipOccupancyMaxActiveBlocksPerMultiprocessor(&per_cu, (const void*)fwd, NTHREADS, LDS_BYTES) != hipSuccess || per_cu < 1) fprintf(stderr, "kernel_launch: occupancy query reports %d\n", per_cu);
        (void)hipGetLastError();
        grid = cus;
    }
    if (grid < 0) return;
    if (hipMemsetAsync((char*)d_ws + WS_CTL, 0, CTL_ZERO_BYTES, stream) != hipSuccess) return;
    Params p{};
    for (int i = 0; i < N_INPUTS; ++i) p.in[i] = d_in[i];
    p.out = (float*)d_out; p.ws = (unsigned char*)d_ws;
#if MK_ONE_LAUNCH
    p.ph_lo = 0; p.ph_hi = N_PHASES;
    hipLaunchKernelGGL(fwd, dim3(grid), dim3(NTHREADS), LDS_BYTES, stream, p);
#else
    for (int ph = 0; ph < N_PHASES; ++ph) { p.ph_lo = ph; p.ph_hi = ph + 1; hipLaunchKernelGGL(fwd, dim3(grid), dim3(NTHREADS), LDS_BYTES, stream, p); }
#endif
}
```

```cpp
#include <hip/hip_runtime.h>
#include <cstdio>
#include <cstdint>

#define REP_PRO 1
#define REP_ATTN 1
#define REP_RWKV 1
#define REP_MOE1 1
#define REP_MOE2 1
#define REP_WIN 1
#define REP_PREP 1
#define REP_MIX 1
#ifndef MK_ONE_LAUNCH
#define MK_ONE_LAUNCH 1
#endif

#define GAS __attribute__((address_space(1)))
#define LAS __attribute__((address_space(3)))
typedef unsigned short bf16;
typedef short bf16x8 __attribute__((ext_vector_type(8)));
typedef short s16x4 __attribute__((ext_vector_type(4)));
typedef float f32x2 __attribute__((ext_vector_type(2)));
typedef float f32x4 __attribute__((ext_vector_type(4)));
typedef float f32x16 __attribute__((ext_vector_type(16)));
typedef unsigned u32x2 __attribute__((ext_vector_type(2)));
typedef unsigned u32x4 __attribute__((ext_vector_type(4)));

constexpr int D = 1024, NBATCH = 8, SEQ = 4096, T = NBATCH * SEQ, DEPTH = 2;
constexpr int MLA_IN = 416, RWKV_IN = 1792, N_IN = 2208, N_INP = 2304;
constexpr int QLR = 256, KVLR = 128, ROPE = 32, NOPE = 64, QKD = 96, VD = 64, NH = 8;
constexpr int C5 = 512;
constexpr int NE = 32, TOPK = 4, FF = 1024, CAP = 32768;
constexpr int N_UP = 1792, K_UP = 384, N_SM = 1536, K_SM = 256;
constexpr int MAXSLOT = 139264;
constexpr float DN_ALPHA = 1.4142135623730951f;
constexpr float C2Q = 0.14724444602590306f;
constexpr float LN_EPS = 1e-5f, RMS_EPS = 1e-6f, GN_EPS = 64e-5f;
constexpr int NWAVES = 8, NTHREADS = 512;

enum { I_X = 0, I_C, I_POS, I_ELNG, I_ELNB, I_ADAW, I_ADAB, I_WIN, I_QNG, I_WUQ, I_KVNG, I_WUK, I_WUV, I_MOUTG, I_MU, I_W0, I_W2, I_A0, I_A2, I_G2,
       I_KK, I_KA, I_RK, I_GNG, I_GNB, I_V0, I_V1, I_V2, I_WO, I_LN1G, I_LN1B, I_RW, I_RB, I_EW1, I_EB1, I_EW2, I_EB2, I_LN2G, I_LN2B, N_INPUTS };

constexpr size_t MiB = 1u << 20;
constexpr size_t WS_CTL = 0, CTL_ZERO_BYTES = 4 * MiB;
constexpr size_t WS_MOD = 4 * MiB, WS_B1P = 5 * MiB, WS_CS = 6 * MiB, WS_LIST = 10 * MiB, WS_GATEL = 14 * MiB, WS_TOKSLOT = 18 * MiB;
constexpr size_t WS_WINT = 20 * MiB, WS_WUPT = 30 * MiB, WS_WSMT = 33 * MiB, WS_WV12T = 35 * MiB, WS_WOT = 36 * MiB, WS_W1T = 40 * MiB, WS_W2T = 296 * MiB;
constexpr size_t WS_X = 424 * MiB, WS_H = 552 * MiB, WS_VS0 = 616 * MiB, WS_VS1 = 648 * MiB;
constexpr size_t WS_P = 680 * MiB, WS_AN = 824 * MiB, WS_A2 = 848 * MiB, WS_RK = 864 * MiB, WS_Q = 928 * MiB, WS_KK = 976 * MiB, WS_V = 1024 * MiB, WS_O = 1056 * MiB;
constexpr size_t WS_WAG = 1088 * MiB, WS_RO = 1280 * MiB, WS_MIX = 1344 * MiB, WS_VR = 1408 * MiB;
constexpr size_t WS_H1 = 680 * MiB, WS_Y = 952 * MiB;
constexpr size_t WS_CH = 1440 * MiB;
constexpr size_t WS_END = 1696 * MiB;
constexpr int CW_TMO = 0, CW_CODE = 1, CW_BAR = 4096, CW_CNT = 8192, CW_ATTQ = 8448;

constexpr int RING_BYTES = 131072;
constexpr int LDSX_OFF = RING_BYTES;
constexpr int MISC_OFF = LDSX_OFF;
constexpr int TB_OFF = LDSX_OFF + 256;
constexpr int GT_OFF = LDSX_OFF + 1024;
constexpr int LDS_BYTES = 147456;

#define RLX_AGENT __ATOMIC_RELAXED, __HIP_MEMORY_SCOPE_AGENT
#define LDS_WAIT() asm volatile("s_waitcnt lgkmcnt(0)" ::: "memory")
#define VM_WAIT() asm volatile("s_waitcnt vmcnt(0)" ::: "memory")

__device__ __forceinline__ unsigned f2bf(float f) { unsigned u = __builtin_bit_cast(unsigned, f); return (u + 0x7fffu + ((u >> 16) & 1u)) >> 16; }
__device__ __forceinline__ unsigned pk2(float lo, float hi) { return f2bf(lo) | (f2bf(hi) << 16); }
__device__ __forceinline__ float bf2f(unsigned b) { return __builtin_bit_cast(float, b << 16); }
__device__ __forceinline__ float bflo(unsigned w) { return __builtin_bit_cast(float, w << 16); }
__device__ __forceinline__ float bfhi(unsigned w) { return __builtin_bit_cast(float, w & 0xffff0000u); }
__device__ __forceinline__ unsigned cvt_pk_bf16(float lo, float hi) { unsigned r; asm volatile("v_cvt_pk_bf16_f32 %0, %1, %2" : "=v"(r) : "v"(lo), "v"(hi)); return r; }
typedef __bf16 bf16x2_t __attribute__((ext_vector_type(2)));
__device__ __forceinline__ unsigned cvtpk_c(float lo, float hi) { f32x2 v = {lo, hi}; bf16x2_t b = __builtin_convertvector(v, bf16x2_t); return __builtin_bit_cast(unsigned, b); }
__device__ __forceinline__ float wave_sum(float v) {
#pragma unroll
    for (int o = 1; o < 64; o <<= 1) v += __shfl_xor(v, o);
    return v;
}
__device__ __forceinline__ float sigmoidf_(float x) { return 1.0f / (1.0f + __expf(-x)); }

#define XB_TMO      128
#define XB_XCNT(j)  (256  + 64 * (j))
#define XB_XSUB(j)  (1280 + 64 * (j))
#define XB_XGEN(j)  (2304 + 64 * (j))
#define XB_TOP      3328
#define XB_TOPGEN   3392
#define XCD_BAR_WORDS 3456
#define XB_SPIN_CAP (1u << 18)
__device__ __forceinline__ unsigned xb_ld(unsigned* p)              { return __hip_atomic_load(p, __ATOMIC_RELAXED, __HIP_MEMORY_SCOPE_AGENT); }
__device__ __forceinline__ unsigned xb_add(unsigned* p, unsigned v) { return __hip_atomic_fetch_add(p, v, __ATOMIC_RELAXED, __HIP_MEMORY_SCOPE_AGENT); }
__device__ __forceinline__ unsigned xb_xcc_id() { return (unsigned)__builtin_amdgcn_s_getreg((3 << 11) | 20) & 0xFu; }
#define XB_SPIN(cond, bar) do { unsigned _sp = 0; while (cond) { __builtin_amdgcn_s_sleep(1); \
    if ((++_sp & 255u) == 0u) { if (xb_ld(&(bar)[XB_TMO])) break; if (_sp > XB_SPIN_CAP) { atomicAdd(&(bar)[XB_TMO], 1u); break; } } } } while (0)
struct XcdBarrier { unsigned* bar; unsigned x; volatile LAS unsigned* st; };
__device__ __forceinline__ XcdBarrier xcd_barrier_post(unsigned* bar, volatile LAS unsigned* st) {
    XcdBarrier b; b.bar = bar; b.x = xb_xcc_id(); b.st = st;
    if (threadIdx.x == 0) (void)xb_add(&bar[XB_XCNT(b.x)], 1u);
    return b;
}
__device__ __forceinline__ void xcd_barrier_complete(unsigned* bar, unsigned x, unsigned& nloc, unsigned& nx) {
    const unsigned G = gridDim.x * gridDim.y * gridDim.z;
    unsigned sum, cnt, mine, sp = 0u;
    for (;;) {
        sum = 0u; cnt = 0u; mine = 0u;
#pragma unroll
        for (unsigned j = 0; j < 16; ++j) { const unsigned c = xb_ld(&bar[XB_XCNT(j)]); sum += c; cnt += (c > 0u) ? 1u : 0u; mine = (j == x) ? c : mine; }
        if (sum == G) break;
        __builtin_amdgcn_s_sleep(1);
        if ((++sp & 255u) == 0u) { if (xb_ld(&bar[XB_TMO])) break; if (sp > XB_SPIN_CAP) { atomicAdd(&bar[XB_TMO], 1u); break; } }
    }
    nloc = mine > 0u ? mine : 1u; nx = cnt > 0u ? cnt : 1u;
}
__device__ __forceinline__ void xcd_barrier(const XcdBarrier& b) {
    asm volatile("s_waitcnt vmcnt(0)" ::: "memory");
    __syncthreads();
    if (threadIdx.x == 0) {
        unsigned* bar = b.bar;
        __builtin_amdgcn_s_waitcnt(0);
        unsigned nloc = b.st[0], nx = b.st[1];
        if (nloc == 0u) { xcd_barrier_complete(bar, b.x, nloc, nx); b.st[0] = nloc; b.st[1] = nx; }
        const unsigned old = xb_add(&bar[XB_XSUB(b.x)], 1u);
        const unsigned gen = old / nloc;
        if (old + 1u == (gen + 1u) * nloc) {
            __builtin_amdgcn_fence(__ATOMIC_RELEASE, "agent");
            asm volatile("s_waitcnt vmcnt(0)" ::: "memory");
            const unsigned og = xb_add(&bar[XB_TOP], 1u);
            const unsigned tg = og / nx;
            if (og + 1u == (tg + 1u) * nx) xb_add(&bar[XB_TOPGEN], 1u);
            else XB_SPIN(xb_ld(&bar[XB_TOPGEN]) == tg, bar);
            __builtin_amdgcn_fence(__ATOMIC_ACQUIRE, "agent");
            xb_add(&bar[XB_XGEN(b.x)], 1u);
            asm volatile("s_waitcnt vmcnt(0)" ::: "memory");
        } else {
            XB_SPIN(xb_ld(&bar[XB_XGEN(b.x)]) == gen, bar);
            __builtin_amdgcn_fence(__ATOMIC_ACQUIRE, "agent");
            asm volatile("s_waitcnt vmcnt(0)" ::: "memory");
        }
    }
    __syncthreads();
}

namespace pg8 {
constexpr int BM = 256, BK = 64, HALF = 128, HTB = HALF * BK * 2, STAGE_BYTES = 8 * HTB, NXCD = 8, WGM = 8;
__device__ __forceinline__ int lds_byte(int r, int c) { const int st = (r >> 4) * 2 + (c >> 5), rr = r & 15, cc = c & 31, ob = rr * 64 + cc * 2; return st * 1024 + (ob ^ (((ob >> 9) & 1) << 5)); }
__device__ __forceinline__ void stage_rc(int b, int& R, int& C) { const int st = b / 1024, sb = b % 1024, swz = sb ^ (((sb >> 9) & 1) << 5); R = (st >> 1) * 16 + swz / 64; C = (st & 1) * 32 + (swz % 64) / 2; }
__device__ __forceinline__ int perm32(int rho) { const int n = rho >> 4, i = rho & 15; return 8 * (i >> 2) + 4 * n + (i & 3); }

struct Unit { int pm, pn, e; };
struct Gemm { const bf16* A; const bf16* Bt; int M, N, K; };

struct DenseOrder {
    int nM, nN, nwg, G, c;
    __device__ __forceinline__ void init(int M, int N, int G_, int c_) { nM = M / BM; nN = N / BM; nwg = nM * nN; G = G_; c = c_; }
    __device__ __forceinline__ bool next(int i, Unit& u) const {
        const long L = (long)i * G + c; if (L >= nwg) return false;
        int wgid = (int)L; { const int q = nwg / NXCD, r = nwg % NXCD, xcd = wgid % NXCD, off = wgid / NXCD; wgid = (xcd < r ? xcd * (q + 1) : r * (q + 1) + (xcd - r) * q) + off; }
        const int nig = WGM * nN, gid = wgid / nig, fm = gid * WGM, gsz = (nM - fm) < WGM ? (nM - fm) : WGM;
        u.pm = fm + ((wgid % nig) % gsz); u.pn = (wgid % nig) / gsz; u.e = 0; return true;
    }
    static constexpr bool GATHER = false;
    __device__ __forceinline__ size_t b_off(const Unit& u, int N, int K) const { return (size_t)u.pn * BM * K * 2; }
    __device__ __forceinline__ unsigned a_row_off(const Unit& u, int row, int K) const { return 0u; }
    __device__ __forceinline__ LAS unsigned* gtab() const { return nullptr; }
};
template <bool GATHER_> struct MoeOrder {
    static constexpr bool GATHER = GATHER_;
    const LAS int* tb; const LAS int* cnt; const int* list; int nN, G, c; LAS unsigned* gt_;
    __device__ __forceinline__ LAS unsigned* gtab() const { return gt_; }
    __device__ __forceinline__ bool next(int i, Unit& u) const {
        const int L = i * G + c; const int total = tb[NE] * nN; if (L >= total) return false;
        int e = 0;
#pragma unroll 1
        for (int j = 1; j < NE; ++j) if (tb[j] * nN <= L) e = j;
        const int Lr = L - tb[e] * nN, nte = tb[e + 1] - tb[e];
        const int mblk = Lr / (4 * nN), m0 = mblk * 4, gsz = (nte - m0) < 4 ? (nte - m0) : 4, rem = Lr - mblk * 4 * nN;
        u.e = e; u.pn = rem / gsz; u.pm = tb[e] + m0 + (rem % gsz); return true;
    }
    __device__ __forceinline__ size_t b_off(const Unit& u, int N, int K) const { return ((size_t)u.e * N + (size_t)u.pn * BM) * K * 2; }
    __device__ __forceinline__ unsigned a_row_off(const Unit& u, int row, int K) const {
        const int pos = (u.pm - tb[u.e]) * BM + row; const int tok = pos < cnt[u.e] ? list[u.e * CAP + pos] : 0; return (unsigned)tok * (unsigned)(K * 2);
    }
};

template <class Epi, class Sched, bool ALIGN_EPI>
__device__ __forceinline__ void gemm_phase(LAS unsigned char* lds, const Gemm g, const Sched& S, const Epi& E) {
    const int tid = threadIdx.x, wid = __builtin_amdgcn_readfirstlane(tid >> 6), lane = tid & 63, wr = wid >> 2, wc = wid & 3, fr = lane & 15, fq = lane >> 4;
    const int K = g.K, nt = K / BK;
    int RA[2]; unsigned CA[2], voffA[2], voffB[2];
#pragma unroll
    for (int i = 0; i < 2; ++i) { int R, C; stage_rc(tid * 16 + i * 8192, R, C); const int Rb = Epi::PERM ? ((R & ~31) + perm32(R & 31)) : R;
        RA[i] = R; CA[i] = (unsigned)C * 2u; voffA[i] = (unsigned)(R * K + C) * 2u; voffB[i] = (unsigned)(Rb * K + C) * 2u; }
    const size_t kstep = (size_t)(BK * 2);
    const size_t hstep = (size_t)HALF * K * 2;
    const size_t tstep = 2 * hstep;
    const unsigned ldsw = (unsigned)wid * 1024u;
    const int aoff = lds_byte(wr * 64 + fr, fq * 8), boff = lds_byte(wc * 32 + fr, fq * 8);
    const char* Abase = (const char*)g.A;
    LAS unsigned* gtb = S.gtab();
#define PG8_SA(b, h) (((b) * 2 + (h)) * HTB)
#define PG8_SB(b, h) ((4 + (b) * 2 + (h)) * HTB)
#define PG8_STAGE(bufoff, gbase, voff) do { _Pragma("unroll") for (int _i = 0; _i < 2; ++_i) \
        __builtin_amdgcn_global_load_lds((const unsigned*)((const char*)(gbase) + (voff)[_i]), (LAS unsigned*)(lds + (bufoff) + ldsw + _i * 8192), 16, 0, 0); } while (0)
#define PG8_STAGEA(bufoff, h, kb, nx) do { \
        if constexpr (Sched::GATHER) { const LAS unsigned* tp_ = gtb + ((nx) ? tnx : tcu) + (h) * HALF; const unsigned o0_ = tp_[RA[0]] + CA[0], o1_ = tp_[RA[1]] + CA[1]; \
            __builtin_amdgcn_global_load_lds((const unsigned*)(Abase + (size_t)(kb) + o0_), (LAS unsigned*)(lds + (bufoff) + ldsw), 16, 0, 0); \
            __builtin_amdgcn_global_load_lds((const unsigned*)(Abase + (size_t)(kb) + o1_), (LAS unsigned*)(lds + (bufoff) + ldsw + 8192), 16, 0, 0); } \
        else { const char* gb_ = ((nx) ? nA : cA) + (size_t)(h) * hstep + (size_t)(kb); PG8_STAGE(bufoff, gb_, voffA); } } while (0)
#define PG8_LDA(dst, b, h) do { _Pragma("unroll") for (int m = 0; m < 4; ++m) _Pragma("unroll") for (int k = 0; k < 2; ++k) dst[m][k] = *(const LAS bf16x8*)(lds + PG8_SA(b, h) + aoff + m * 2048 + k * 1024); } while (0)
#define PG8_LDB(dst, b, h) do { _Pragma("unroll") for (int n = 0; n < 2; ++n) _Pragma("unroll") for (int k = 0; k < 2; ++k) dst[n][k] = *(const LAS bf16x8*)(lds + PG8_SB(b, h) + boff + n * 2048 + k * 1024); } while (0)
#define PG8_MMA(ai, bj, At, Bt) do { __builtin_amdgcn_s_setprio(1); _Pragma("unroll") for (int m = 0; m < 4; ++m) _Pragma("unroll") for (int n = 0; n < 2; ++n) _Pragma("unroll") for (int k = 0; k < 2; ++k) \
        acc[ai][bj][m][n] = __builtin_amdgcn_mfma_f32_16x16x32_bf16(Bt[n][k], At[m][k], acc[ai][bj][m][n], 0, 0, 0); __builtin_amdgcn_s_setprio(0); } while (0)
#define PG8_WAIT_V(n) asm volatile("s_waitcnt vmcnt(" #n ")" ::: "memory")
#define PG8_WAIT_L(n) asm volatile("s_waitcnt lgkmcnt(" #n ")" ::: "memory")
#define PG8_BAR __builtin_amdgcn_s_barrier()
#define PG8_SCHED __builtin_amdgcn_sched_barrier(0)
    Unit cur, nxt; int ui = 0;
    if (!S.next(0, cur)) return;
    f32x4 acc[2][2][4][2];
#pragma unroll
    for (int a = 0; a < 2; ++a)
#pragma unroll
        for (int b = 0; b < 2; ++b)
#pragma unroll
            for (int m = 0; m < 4; ++m)
#pragma unroll
                for (int n = 0; n < 2; ++n) acc[a][b][m][n] = (f32x4){0.f, 0.f, 0.f, 0.f};
    bf16x8 At[4][2], B0[2][2], B1[2][2];
    const char* cA = Abase + (size_t)cur.pm * tstep; const char* cB = (const char*)g.Bt + S.b_off(cur, g.N, K);
    const char* nA = cA; const char* nB = cB;
    int tcu = 0, tnx = 0;
    if constexpr (Sched::GATHER) {
        if (tid < BM) gtb[tid] = S.a_row_off(cur, tid, K);
        asm volatile("s_waitcnt vmcnt(0) lgkmcnt(0)" ::: "memory"); PG8_BAR; asm volatile("" ::: "memory");
    }
    PG8_STAGE(PG8_SB(0, 0), cB, voffB); PG8_STAGE(PG8_SB(0, 1), cB + hstep, voffB); PG8_STAGEA(PG8_SA(0, 0), 0, 0, false); PG8_STAGEA(PG8_SA(0, 1), 1, 0, false);
    if (wr == 1) PG8_BAR;
    PG8_WAIT_V(2); PG8_BAR;
    PG8_STAGE(PG8_SB(1, 0), cB + kstep, voffB); PG8_STAGEA(PG8_SA(1, 0), 0, kstep, false); PG8_STAGE(PG8_SB(1, 1), cB + hstep + kstep, voffB);
    PG8_WAIT_V(6); PG8_BAR;
    for (;;) {
        const bool has_next = S.next(ui + 1, nxt);
        nA = cA; nB = cB; tnx = tcu;
        if (has_next) { nA = Abase + (size_t)nxt.pm * tstep; nB = (const char*)g.Bt + S.b_off(nxt, g.N, K);
            if constexpr (Sched::GATHER) { tnx = tcu ^ BM; if (tid < BM) gtb[tnx + tid] = S.a_row_off(nxt, tid, K); } }
#pragma unroll 1
        for (int t = 0; t < nt; t += 2) {
            const bool last = (t == nt - 2);
            const size_t k1 = (size_t)(t + 1) * kstep;
            const size_t k2 = last ? 0 : (size_t)(t + 2) * kstep, k3 = k2 + kstep;
            const char* b2 = last ? nB : cB + (size_t)(t + 2) * kstep; const char* b3 = b2 + kstep;
            PG8_LDB(B0, 0, 0); PG8_LDB(B1, 0, 1); PG8_SCHED; PG8_LDA(At, 0, 0); PG8_STAGEA(PG8_SA(1, 1), 1, k1, false);
            PG8_WAIT_V(8); PG8_WAIT_L(0); PG8_BAR; PG8_MMA(0, 0, At, B0); PG8_MMA(0, 1, At, B1); PG8_BAR; PG8_SCHED;
            PG8_LDA(At, 0, 1); PG8_STAGE(PG8_SB(0, 0), b2, voffB); PG8_STAGE(PG8_SB(0, 1), b2 + hstep, voffB); PG8_STAGEA(PG8_SA(0, 0), 0, k2, last);
            PG8_WAIT_V(8); PG8_WAIT_L(0); PG8_BAR; PG8_MMA(1, 0, At, B0); PG8_MMA(1, 1, At, B1); PG8_BAR; PG8_SCHED;
            PG8_LDB(B0, 1, 0); PG8_LDB(B1, 1, 1); PG8_SCHED; PG8_LDA(At, 1, 0); PG8_STAGEA(PG8_SA(0, 1), 1, k2, last);
            PG8_WAIT_V(8); PG8_WAIT_L(0); PG8_BAR; PG8_MMA(0, 0, At, B0); PG8_MMA(0, 1, At, B1); PG8_BAR; PG8_SCHED;
            PG8_LDA(At, 1, 1); PG8_STAGE(PG8_SB(1, 0), b3, voffB); PG8_STAGE(PG8_SB(1, 1), b3 + hstep, voffB); PG8_STAGEA(PG8_SA(1, 0), 0, k3, last);
            PG8_WAIT_V(8); PG8_WAIT_L(0); PG8_BAR; PG8_MMA(1, 0, At, B0); PG8_MMA(1, 1, At, B1); PG8_BAR; PG8_SCHED;
        }
        if constexpr (ALIGN_EPI) { if (wr == 0) PG8_BAR; }
        E(acc, cur, wr, wc, fr, fq);
        if (!has_next) break;
#pragma unroll
        for (int a = 0; a < 2; ++a)
#pragma unroll
            for (int b = 0; b < 2; ++b)
#pragma unroll
                for (int m = 0; m < 4; ++m)
#pragma unroll
                    for (int n = 0; n < 2; ++n) acc[a][b][m][n] = (f32x4){0.f, 0.f, 0.f, 0.f};
        cur = nxt; cA = nA; cB = nB; tcu = tnx; ++ui;
        if constexpr (ALIGN_EPI) { if (wr == 1) PG8_BAR; }
    }
    PG8_WAIT_V(0);
    if constexpr (!ALIGN_EPI) { if (wr == 0) PG8_BAR; }
    PG8_BAR;
#undef PG8_SA
#undef PG8_SB
#undef PG8_STAGE
#undef PG8_STAGEA
#undef PG8_LDA
#undef PG8_LDB
#undef PG8_MMA
#undef PG8_WAIT_V
#undef PG8_WAIT_L
#undef PG8_BAR
#undef PG8_SCHED
}

struct EpiBf16Plain {
    static constexpr bool PERM = true;
    bf16* O; int ldc;
    __device__ __forceinline__ void operator()(const f32x4 (&acc)[2][2][4][2], const Unit& u, int wr, int wc, int fr, int fq) const {
        const int row0 = u.pm * BM + wr * 64 + fr, col0 = u.pn * BM + wc * 32 + 8 * fq;
#pragma unroll
        for (int ai = 0; ai < 2; ++ai)
#pragma unroll
            for (int m = 0; m < 4; ++m) { bf16* rowp = O + (size_t)(row0 + ai * HALF + m * 16) * ldc + col0;
#pragma unroll
                for (int bj = 0; bj < 2; ++bj) { const f32x4 v0 = acc[ai][bj][m][0], v1 = acc[ai][bj][m][1];
                    u32x4 w; w.x = cvt_pk_bf16(v0[0], v0[1]); w.y = cvt_pk_bf16(v0[2], v0[3]); w.z = cvt_pk_bf16(v1[0], v1[1]); w.w = cvt_pk_bf16(v1[2], v1[3]);
                    *(u32x4*)(rowp + bj * HALF) = w; } }
    }
};
struct EpiMlaUp {
    static constexpr bool PERM = true;
    bf16* Q; bf16* KK; bf16* V; const float* cs;
    __device__ __forceinline__ void operator()(const f32x4 (&acc)[2][2][4][2], const Unit& u, int wr, int wc, int fr, int fq) const {
        const int row0 = u.pm * BM + wr * 64 + fr;
#pragma unroll
        for (int bj = 0; bj < 2; ++bj) {
            const int c0 = u.pn * BM + bj * HALF + wc * 32 + 8 * fq;
            if (u.pn < 3) {
                const int h = c0 / QKD, d = c0 - h * QKD;
                const bool rope = d >= NOPE; const int i0 = rope ? (d - NOPE) >> 1 : 0;
#pragma unroll
                for (int ai = 0; ai < 2; ++ai)
#pragma unroll
                    for (int m = 0; m < 4; ++m) { const int row = row0 + ai * HALF + m * 16;
                        f32x4 v0 = acc[ai][bj][m][0], v1 = acc[ai][bj][m][1];
                        if (rope) { const f32x4 cA = *(const f32x4*)(cs + (size_t)row * 32 + i0 * 2), cB = *(const f32x4*)(cs + (size_t)row * 32 + i0 * 2 + 4);
                            const f32x4 a = v0, b = v1;
                            v0[0] = a[0] * cA[0] - a[1] * cA[1]; v0[1] = a[0] * cA[1] + a[1] * cA[0]; v0[2] = a[2] * cA[2] - a[3] * cA[3]; v0[3] = a[2] * cA[3] + a[3] * cA[2];
                            v1[0] = b[0] * cB[0] - b[1] * cB[1]; v1[1] = b[0] * cB[1] + b[1] * cB[0]; v1[2] = b[2] * cB[2] - b[3] * cB[3]; v1[3] = b[2] * cB[3] + b[3] * cB[2]; }
                        v0 = v0 * C2Q; v1 = v1 * C2Q;
                        u32x4 w; w.x = cvt_pk_bf16(v0[0], v0[1]); w.y = cvt_pk_bf16(v0[2], v0[3]); w.z = cvt_pk_bf16(v1[0], v1[1]); w.w = cvt_pk_bf16(v1[2], v1[3]);
                        *(u32x4*)(Q + (size_t)row * 768 + c0) = w; asm volatile("" ::: "memory"); }
            } else {
                bf16* base; int ld, cc;
                if (u.pn < 5) { const int c1 = c0 - 768; const int h = c1 >> 6, d = c1 & 63; base = KK; ld = 768; cc = h * QKD + d; }
                else { base = V; ld = 512; cc = c0 - 1280; }
#pragma unroll
                for (int ai = 0; ai < 2; ++ai)
#pragma unroll
                    for (int m = 0; m < 4; ++m) { const int row = row0 + ai * HALF + m * 16; const f32x4 v0 = acc[ai][bj][m][0], v1 = acc[ai][bj][m][1];
                        u32x4 w; w.x = cvt_pk_bf16(v0[0], v0[1]); w.y = cvt_pk_bf16(v0[2], v0[3]); w.z = cvt_pk_bf16(v1[0], v1[1]); w.w = cvt_pk_bf16(v1[2], v1[3]);
                        *(u32x4*)(base + (size_t)row * ld + cc) = w; asm volatile("" ::: "memory"); }
            }
        }
    }
};
struct EpiRwkvSmall {
    static constexpr bool PERM = false;
    float* O; const float* w0; const float* a0;
    __device__ __forceinline__ void operator()(const f32x4 (&acc)[2][2][4][2], const Unit& u, int wr, int wc, int fr, int fq) const {
        const int row0 = u.pm * BM + wr * 64 + fr, col0 = u.pn * BM + wc * 32 + 4 * fq;
        const int kind = u.pn >> 1;
#pragma unroll
        for (int bj = 0; bj < 2; ++bj)
#pragma unroll
            for (int n = 0; n < 2; ++n) { const int c = col0 + bj * HALF + n * 16;
                f32x4 bv = (f32x4){0.f, 0.f, 0.f, 0.f};
                if (kind == 0) bv = *(const f32x4*)(w0 + c); else if (kind == 1) bv = *(const f32x4*)(a0 + (c - 512));
#pragma unroll
                for (int ai = 0; ai < 2; ++ai)
#pragma unroll
                    for (int m = 0; m < 4; ++m) { f32x4 v = acc[ai][bj][m][n] + bv;
                        if (kind == 0) {
#pragma unroll
                            for (int j = 0; j < 4; ++j) { const float z = -v[j]; const float sp = fmaxf(z, 0.f) + __logf(1.0f + __expf(-fabsf(z))); const float w = -sp - 0.5f; v[j] = -__expf(w); }
                        } else if (kind == 1) {
#pragma unroll
                            for (int j = 0; j < 4; ++j) v[j] = sigmoidf_(v[j]);
                        }
                        *(f32x4*)(O + (size_t)(row0 + ai * HALF + m * 16) * N_SM + c) = v; asm volatile("" ::: "memory"); } }
    }
};
struct EpiVres {
    static constexpr bool PERM = true;
    const bf16* vs; const bf16* vf; bf16* vr; const float* v0;
    __device__ __forceinline__ void operator()(const f32x4 (&acc)[2][2][4][2], const Unit& u, int wr, int wc, int fr, int fq) const {
        const int row0 = u.pm * BM + wr * 64 + fr, col0 = u.pn * BM + wc * 32 + 8 * fq;
#pragma unroll
        for (int bj = 0; bj < 2; ++bj) { const int c = col0 + bj * HALF;
            const f32x4 b0 = *(const f32x4*)(v0 + c), b1 = *(const f32x4*)(v0 + c + 4);
#pragma unroll
            for (int ai = 0; ai < 2; ++ai)
#pragma unroll
                for (int m = 0; m < 4; ++m) { const size_t off = (size_t)(row0 + ai * HALF + m * 16) * C5 + c;
                    const u32x4 s = *(const u32x4*)(vs + off), f = *(const u32x4*)(vf + off);
                    const f32x4 g0 = acc[ai][bj][m][0] + b0, g1 = acc[ai][bj][m][1] + b1;
                    float o[8];
#pragma unroll
                    for (int j = 0; j < 4; ++j) { const float sl = bflo(s[j]), sh = bfhi(s[j]), fl = bflo(f[j]), fh = bfhi(f[j]);
                        const float ga = (j < 2) ? g0[2 * j] : g1[2 * j - 4], gb = (j < 2) ? g0[2 * j + 1] : g1[2 * j - 3];
                        o[2 * j] = sl + (fl - sl) * sigmoidf_(ga); o[2 * j + 1] = sh + (fh - sh) * sigmoidf_(gb); }
                    u32x4 w; w.x = cvt_pk_bf16(o[0], o[1]); w.y = cvt_pk_bf16(o[2], o[3]); w.z = cvt_pk_bf16(o[4], o[5]); w.w = cvt_pk_bf16(o[6], o[7]);
                    *(u32x4*)(vr + off) = w; } }
    }
};
struct EpiWo {
    static constexpr bool PERM = false;
    float* X; const float* gt;
    __device__ __forceinline__ void operator()(const f32x4 (&acc)[2][2][4][2], const Unit& u, int wr, int wc, int fr, int fq) const {
        const int row0 = u.pm * BM + wr * 64 + fr, col0 = u.pn * BM + wc * 32 + 4 * fq;
        const int b = (u.pm * BM) / SEQ;
#pragma unroll
        for (int bj = 0; bj < 2; ++bj)
#pragma unroll
            for (int n = 0; n < 2; ++n) { const int c = col0 + bj * HALF + n * 16; const f32x4 g = *(const f32x4*)(gt + (size_t)b * 6144 + c) + 1.0f;
#pragma unroll
                for (int ai = 0; ai < 2; ++ai)
#pragma unroll
                    for (int m = 0; m < 4; ++m) { float* p = X + (size_t)(row0 + ai * HALF + m * 16) * D + c; const f32x4 x = *(const f32x4*)p; *(f32x4*)p = x * DN_ALPHA + g * acc[ai][bj][m][n]; } }
    }
};
struct EpiSwiglu {
    static constexpr bool PERM = true;
    bf16* O; const float* b1p;
    __device__ __forceinline__ void operator()(const f32x4 (&acc)[2][2][4][2], const Unit& u, int wr, int wc, int fr, int fq) const {
        const int row0 = u.pm * BM + wr * 64 + fr; const int cin = u.pn * BM + wc * 32 + 8 * fq, cout = u.pn * HALF + wc * 32 + 8 * fq;
        const float* bp = b1p + (size_t)u.e * 2048 + cin;
        const f32x4 bg0 = *(const f32x4*)(bp), bg1 = *(const f32x4*)(bp + 4), bl0 = *(const f32x4*)(bp + HALF), bl1 = *(const f32x4*)(bp + HALF + 4);
#pragma unroll
        for (int ai = 0; ai < 2; ++ai)
#pragma unroll
            for (int m = 0; m < 4; ++m) {
                const f32x4 g0 = acc[ai][0][m][0] + bg0, g1 = acc[ai][0][m][1] + bg1, l0 = acc[ai][1][m][0] + bl0, l1 = acc[ai][1][m][1] + bl1;
                float o[8];
#pragma unroll
                for (int j = 0; j < 8; ++j) { const float gv = fminf(j < 4 ? g0[j & 3] : g1[j & 3], 7.0f); const float lv = fminf(fmaxf(j < 4 ? l0[j & 3] : l1[j & 3], -7.0f), 7.0f);
                    o[j] = gv * sigmoidf_(1.702f * gv) * (lv + 1.0f); }
                u32x4 w; w.x = cvt_pk_bf16(o[0], o[1]); w.y = cvt_pk_bf16(o[2], o[3]); w.z = cvt_pk_bf16(o[4], o[5]); w.w = cvt_pk_bf16(o[6], o[7]);
                *(u32x4*)(O + (size_t)(row0 + ai * HALF + m * 16) * FF + cout) = w; }
    }
};
struct EpiMoeOut {
    static constexpr bool PERM = true;
    bf16* O; const float* b2; const float* gatel; const LAS int* tb;
    __device__ __forceinline__ void operator()(const f32x4 (&acc)[2][2][4][2], const Unit& u, int wr, int wc, int fr, int fq) const {
        const int row0 = u.pm * BM + wr * 64 + fr, col0 = u.pn * BM + wc * 32 + 8 * fq;
        const int pos0 = (u.pm - tb[u.e]) * BM + wr * 64 + fr;
        const float* bp = b2 + (size_t)u.e * D + col0;
        f32x4 bv[2][2];
#pragma unroll
        for (int bj = 0; bj < 2; ++bj) { bv[bj][0] = *(const f32x4*)(bp + bj * HALF); bv[bj][1] = *(const f32x4*)(bp + bj * HALF + 4); }
#pragma unroll
        for (int ai = 0; ai < 2; ++ai)
#pragma unroll
            for (int m = 0; m < 4; ++m) { const float gt = gatel[(size_t)u.e * CAP + pos0 + ai * HALF + m * 16];
                bf16* rowp = O + (size_t)(row0 + ai * HALF + m * 16) * D + col0;
#pragma unroll
                for (int bj = 0; bj < 2; ++bj) { const f32x4 v0 = (acc[ai][bj][m][0] + bv[bj][0]) * gt, v1 = (acc[ai][bj][m][1] + bv[bj][1]) * gt;
                    u32x4 w; w.x = cvt_pk_bf16(v0[0], v0[1]); w.y = cvt_pk_bf16(v0[2], v0[3]); w.z = cvt_pk_bf16(v1[0], v1[1]); w.w = cvt_pk_bf16(v1[2], v1[3]);
                    *(u32x4*)(rowp + bj * HALF) = w; } }
    }
};
}

struct Params { const void* in[N_INPUTS]; float* out; unsigned char* ws; int ph_lo, ph_hi; };

struct Frame {
    LAS unsigned char* lds;
    int tid, lane, wave, G, vcu;
    unsigned char* ws;
};
#define WSP(type, off) ((type*)(F.ws + (off)))
#define INP(i) ((const float*)p.in[i])

__device__ const double INV_FREQ[16] = {1.00000000000000000e+00, 5.62341325190349073e-01, 3.16227766016837941e-01, 1.77827941003892293e-01, 1.00000000000000006e-01, 5.62341325190349114e-02,
    3.16227766016837913e-02, 1.77827941003892293e-02, 1.00000000000000002e-02, 5.62341325190349097e-03, 3.16227766016837939e-03, 1.77827941003892275e-03, 1.00000000000000002e-03,
    5.62341325190349097e-04, 3.16227766016837939e-04, 1.77827941003892270e-04};

template <int MODE>
__device__ __forceinline__ void tr_item(const float* W, int ldn, bf16* WT, int ldk, int kofs, int rofs, int k0, int n0, LAS float* scr, int lane) {
    f32x4 ld[8];
#pragma unroll
    for (int i = 0; i < 8; ++i) ld[i] = *(const f32x4*)(W + (size_t)(k0 + 8 * i + (lane >> 3)) * ldn + n0 + 4 * (lane & 7));
#pragma unroll
    for (int i = 0; i < 8; ++i) { LAS float* d = scr + (8 * i + (lane >> 3)) * 33 + 4 * (lane & 7); d[0] = ld[i].x; d[1] = ld[i].y; d[2] = ld[i].z; d[3] = ld[i].w; }
    LDS_WAIT(); asm volatile("" ::: "memory");
    const int c = lane & 7;
#pragma unroll
    for (int j = 0; j < 4; ++j) { const int n = (lane >> 3) + 8 * j; const LAS float* s = scr + (8 * c) * 33 + n;
        u32x4 o; o.x = pk2(s[0 * 33], s[1 * 33]); o.y = pk2(s[2 * 33], s[3 * 33]); o.z = pk2(s[4 * 33], s[5 * 33]); o.w = pk2(s[6 * 33], s[7 * 33]);
        const int ng = n0 + n; int row;
        if (MODE == 0) row = rofs + ng; else { const int jo = ng >> 1, bj = ng & 1; row = rofs + (jo >> 7) * 256 + bj * 128 + (jo & 127); }
        *(GAS u32x4*)(WT + (size_t)row * ldk + kofs + k0 + 8 * c) = o; }
    LDS_WAIT(); asm volatile("" ::: "memory");
}
__device__ __forceinline__ void zero_rect(const Frame& F, bf16* M, int ld, int r0, int nrows, int c0, int ncols) {
    const int gw = F.vcu * NWAVES + F.wave, NGW = F.G * NWAVES; const int nch = ncols / 8;
    for (int r = gw; r < nrows; r += NGW)
        for (int ch = F.lane; ch < nch; ch += 64) *(GAS u32x4*)(M + (size_t)(r0 + r) * ld + c0 + ch * 8) = (u32x4){0u, 0u, 0u, 0u};
}
__device__ __forceinline__ void phase_prologue(const Params& p, const Frame& F) {
    LAS float* scr = (LAS float*)(F.lds + F.wave * 16384);
    const int gw = F.vcu * NWAVES + F.wave, NGW = F.G * NWAVES;
    constexpr int I_IN = 16 * 69, I_UQ = 4 * 24, I_UK = 2 * 16, I_W2s = 16, I_G2s = 2 * 16, I_WO_ = 16 * 32, I_E1 = 16 * 64, I_E2 = 16 * 32;
    constexpr int PER_L = I_IN + I_UQ + 2 * I_UK + 2 * I_W2s + I_G2s + I_WO_;
    constexpr int NSMALL = DEPTH * PER_L, NE1 = DEPTH * NE * I_E1, NE2 = DEPTH * NE * I_E2;
    for (int it = gw; it < NSMALL + NE1 + NE2; it += NGW) {
        int r = it;
        if (r < NSMALL) {
            const int l = r / PER_L; r -= l * PER_L;
            if (r < I_IN) { tr_item<0>(INP(I_WIN) + (size_t)l * D * N_IN, N_IN, WSP(bf16, WS_WINT) + (size_t)l * N_INP * D, D, 0, 0, 64 * (r / 69), 32 * (r % 69), scr, F.lane); continue; } r -= I_IN;
            bf16* up = WSP(bf16, WS_WUPT) + (size_t)l * N_UP * K_UP;
            if (r < I_UQ) { tr_item<0>(INP(I_WUQ) + (size_t)l * QLR * 768, 768, up, K_UP, 0, 0, 64 * (r / 24), 32 * (r % 24), scr, F.lane); continue; } r -= I_UQ;
            if (r < I_UK) { tr_item<0>(INP(I_WUK) + (size_t)l * KVLR * 512, 512, up, K_UP, 256, 768, 64 * (r / 16), 32 * (r % 16), scr, F.lane); continue; } r -= I_UK;
            if (r < I_UK) { tr_item<0>(INP(I_WUV) + (size_t)l * KVLR * 512, 512, up, K_UP, 256, 1280, 64 * (r / 16), 32 * (r % 16), scr, F.lane); continue; } r -= I_UK;
            bf16* sm = WSP(bf16, WS_WSMT) + (size_t)l * N_SM * K_SM;
            if (r < I_W2s) { tr_item<0>(INP(I_W2) + (size_t)l * 64 * 512, 512, sm, K_SM, 0, 0, 0, 32 * r, scr, F.lane); continue; } r -= I_W2s;
            if (r < I_W2s) { tr_item<0>(INP(I_A2) + (size_t)l * 64 * 512, 512, sm, K_SM, 64, 512, 0, 32 * r, scr, F.lane); continue; } r -= I_W2s;
            if (r < I_G2s) { tr_item<0>(INP(I_G2) + (size_t)l * 128 * 512, 512, sm, K_SM, 128, 1024, 64 * (r / 16), 32 * (r % 16), scr, F.lane); continue; } r -= I_G2s;
            tr_item<0>(INP(I_WO) + (size_t)l * D * D, D, WSP(bf16, WS_WOT) + (size_t)l * D * D, D, 0, 0, 64 * (r / 32), 32 * (r % 32), scr, F.lane); continue;
        }
        r -= NSMALL;
        if (r < NE1) { const int le = r / I_E1; r -= le * I_E1;
            tr_item<1>(INP(I_EW1) + (size_t)le * D * 2048, 2048, WSP(bf16, WS_W1T) + (size_t)le * 2048 * D, D, 0, 0, 64 * (r / 64), 32 * (r % 64), scr, F.lane); continue; }
        r -= NE1;
        { const int le = r / I_E2; r -= le * I_E2;
            tr_item<0>(INP(I_EW2) + (size_t)le * FF * D, D, WSP(bf16, WS_W2T) + (size_t)le * D * FF, FF, 0, 0, 64 * (r / 32), 32 * (r % 32), scr, F.lane); }
    }
    for (int l = 0; l < DEPTH; ++l) {
        zero_rect(F, WSP(bf16, WS_WINT) + (size_t)l * N_INP * D, D, N_IN, N_INP - N_IN, 0, D);
        bf16* up = WSP(bf16, WS_WUPT) + (size_t)l * N_UP * K_UP;
        zero_rect(F, up, K_UP, 0, 768, 256, 128); zero_rect(F, up, K_UP, 768, 1024, 0, 256);
        bf16* sm = WSP(bf16, WS_WSMT) + (size_t)l * N_SM * K_SM;
        zero_rect(F, sm, K_SM, 0, 512, 64, 192); zero_rect(F, sm, K_SM, 512, 512, 0, 64); zero_rect(F, sm, K_SM, 512, 512, 128, 128); zero_rect(F, sm, K_SM, 1024, 512, 0, 128);
    }
    const int gt = (F.vcu * NTHREADS) + F.tid, NGT = F.G * NTHREADS;
    { const float* v1 = INP(I_V1); const float* v2 = INP(I_V2); bf16* o = WSP(bf16, WS_WV12T);
      for (int i = gt; i < 512 * 512; i += NGT) { const int n = i >> 9, k = i & 511; float s = 0.f;
#pragma unroll 8
          for (int j = 0; j < 32; ++j) s += v1[k * 32 + j] * v2[j * 512 + n];
          o[i] = (bf16)f2bf(s); } }
    { const float* b1 = INP(I_EB1); float* o = WSP(float, WS_B1P);
      for (int i = gt; i < DEPTH * NE * 2048; i += NGT) { const int q = i & 2047, le = i >> 11; const int pn = q >> 8, bj = (q >> 7) & 1, jj = q & 127; o[i] = b1[(size_t)le * 2048 + 2 * (pn * 128 + jj) + bj]; } }
    { const int* pos = (const int*)p.in[I_POS]; float* cs = WSP(float, WS_CS);
      for (int i = gt; i < T * 16; i += NGT) { const int t = i >> 4, k = i & 15; const double a = (double)pos[t] * INV_FREQ[k];
          const double q = __builtin_rint(a * 0.63661977236758134308); const int qi = (int)((long long)q & 3);
          double r = __builtin_fma(-q, 1.57079632679489655800e+00, a); r = __builtin_fma(-q, 6.12323399573676603587e-17, r);
          const double r2 = r * r;
          double sn = -2.50521083854417187751e-08; sn = sn * r2 + 2.75573192239858906526e-06; sn = sn * r2 - 1.98412698412698412698e-04; sn = sn * r2 + 8.33333333333333333333e-03; sn = sn * r2 - 1.66666666666666666667e-01; sn = r + r * r2 * sn;
          double cn = 2.08767569878680989792e-09; cn = cn * r2 - 2.75573192239858906526e-07; cn = cn * r2 + 2.48015873015873015873e-05; cn = cn * r2 - 1.38888888888888888889e-03; cn = cn * r2 + 4.16666666666666666667e-02; cn = cn * r2 - 0.5; cn = 1.0 + r2 * cn;
          double sv, cv;
          if (qi == 0) { sv = sn; cv = cn; } else if (qi == 1) { sv = cn; cv = -sn; } else if (qi == 2) { sv = -sn; cv = -cn; } else { sv = -cn; cv = sn; }
          cs[2 * i] = (float)cv; cs[2 * i + 1] = (float)sv; } }
    { LAS float* cact = (LAS float*)(F.lds);
      LAS float* part = (LAS float*)(F.lds + 32768);
      __syncthreads();
      const float* c = INP(I_C);
      for (int i = F.tid; i < NBATCH * D; i += NTHREADS) { const float v = c[i]; cact[i] = v / (1.0f + __expf(-v)); }
      __syncthreads();
      for (int item = F.vcu; item < DEPTH * 96; item += F.G) { const int l = item / 96, n0 = (item % 96) * 64;
          const float* aw = INP(I_ADAW) + (size_t)l * D * 6144 + n0 + F.lane;
          float a8[8];
#pragma unroll
          for (int b = 0; b < 8; ++b) a8[b] = 0.f;
          const int kb = F.wave * 128;
#pragma unroll 4
          for (int k = 0; k < 128; ++k) { const float wv = aw[(size_t)(kb + k) * 6144];
#pragma unroll
              for (int b = 0; b < 8; ++b) a8[b] += cact[b * D + kb + k] * wv; }
#pragma unroll
          for (int b = 0; b < 8; ++b) part[(F.wave * 8 + b) * 64 + F.lane] = a8[b];
          __syncthreads();
          { const int b = F.wave; float s = 0.f;
#pragma unroll
            for (int w = 0; w < 8; ++w) s += part[(w * 8 + b) * 64 + F.lane];
            WSP(float, WS_MOD)[((size_t)l * NBATCH + b) * 6144 + n0 + F.lane] = s + INP(I_ADAB)[(size_t)l * 6144 + n0 + F.lane]; }
          __syncthreads(); }
    }
}

__device__ __forceinline__ void phase_ln0(const Params& p, const Frame& F) {
    const int gw = F.vcu * NWAVES + F.wave, NGW = F.G * NWAVES;
    const float* mod = WSP(float, WS_MOD);
    for (int m = gw; m < T; m += NGW) {
        const int b = m / SEQ;
        const GAS f32x4* xr = (const GAS f32x4*)(INP(I_X) + (size_t)m * D) + F.lane;
        f32x4 v[4]; float s = 0.f;
#pragma unroll
        for (int j = 0; j < 4; ++j) { v[j] = xr[64 * j]; s += (v[j].x + v[j].y) + (v[j].z + v[j].w); }
        const float mean = wave_sum(s) * (1.f / D); float s2 = 0.f;
#pragma unroll
        for (int j = 0; j < 4; ++j) { v[j] = v[j] - mean; s2 += (v[j].x * v[j].x + v[j].y * v[j].y) + (v[j].z * v[j].z + v[j].w * v[j].w); }
        const float rstd = 1.f / sqrtf(wave_sum(s2) * (1.f / D) + LN_EPS);
        GAS f32x4* xo = (GAS f32x4*)(WSP(float, WS_X) + (size_t)m * D) + F.lane;
        GAS u32x2* ho = (GAS u32x2*)(WSP(bf16, WS_H) + (size_t)m * D) + F.lane;
#pragma unroll
        for (int j = 0; j < 4; ++j) { const int c = 4 * F.lane + 256 * j;
            const f32x4 g = *(const f32x4*)(INP(I_ELNG) + c), be = *(const f32x4*)(INP(I_ELNB) + c);
            const f32x4 x0 = v[j] * rstd * g + be; xo[64 * j] = x0;
            const f32x4 sh = *(const f32x4*)(mod + (size_t)b * 6144 + c), sc = *(const f32x4*)(mod + (size_t)b * 6144 + 1024 + c);
            const f32x4 h = x0 * (sc + 1.0f) + sh; u32x2 w; w.x = pk2(h.x, h.y); w.y = pk2(h.z, h.w); ho[64 * j] = w; }
    }
}

__device__ __forceinline__ void phase_prep(const Params& p, const Frame& F, int l) {
    const int gw = F.vcu * NWAVES + F.wave, NGW = F.G * NWAVES; const int lane = F.lane;
    const bf16* P = WSP(bf16, WS_P); const float* mu = INP(I_MU) + (size_t)l * RWKV_IN;
    const float* qg = INP(I_QNG) + (size_t)l * QLR; const float* kvg = INP(I_KVNG) + (size_t)l * KVLR;
    bf16* AN = WSP(bf16, WS_AN); bf16* A2 = WSP(bf16, WS_A2); bf16* RK = WSP(bf16, WS_RK); bf16* KKb = WSP(bf16, WS_KK);
    bf16* VS = l == 0 ? WSP(bf16, WS_VS0) : WSP(bf16, WS_VS1);
    const float* cs = WSP(float, WS_CS);
    for (int t = gw; t < T; t += NGW) {
        const bf16* pr = P + (size_t)t * N_INP; const bool first = (t % SEQ) == 0; const bf16* pp = pr - N_INP;
        { const u32x2 qw = *(const u32x2*)(pr + 4 * lane); float q0 = bflo(qw.x), q1 = bfhi(qw.x), q2 = bflo(qw.y), q3 = bfhi(qw.y);
          const float rq = 1.f / sqrtf(wave_sum(q0 * q0 + q1 * q1 + q2 * q2 + q3 * q3) * (1.f / QLR) + RMS_EPS);
          const f32x4 g = *(const f32x4*)(qg + 4 * lane);
          u32x2 w; w.x = pk2(q0 * rq * g.x, q1 * rq * g.y); w.y = pk2(q2 * rq * g.z, q3 * rq * g.w); *(u32x2*)(AN + (size_t)t * K_UP + 4 * lane) = w;
          const unsigned kw = *(const unsigned*)(pr + QLR + 2 * lane); const float k0 = bflo(kw), k1 = bfhi(kw);
          const float rk = 1.f / sqrtf(wave_sum(k0 * k0 + k1 * k1) * (1.f / KVLR) + RMS_EPS);
          const f32x2 g2 = *(const f32x2*)(kvg + 2 * lane);
          *(unsigned*)(AN + (size_t)t * K_UP + QLR + 2 * lane) = pk2(k0 * rk * g2.x, k1 * rk * g2.y);
          const int i = lane & 15; const unsigned rw = *(const unsigned*)(pr + QLR + KVLR + 2 * i); const float x0 = bflo(rw), x1 = bfhi(rw);
          const f32x2 csv = *(const f32x2*)(cs + (size_t)t * 32 + 2 * i); const unsigned ro = pk2(x0 * csv.x - x1 * csv.y, x0 * csv.y + x1 * csv.x);
          const int h0 = (lane >> 4) * 2;
          *(unsigned*)(KKb + (size_t)t * 768 + h0 * QKD + NOPE + 2 * i) = ro; *(unsigned*)(KKb + (size_t)t * 768 + (h0 + 1) * QKD + NOPE + 2 * i) = ro; }
        const bf16* rr = pr + MLA_IN; const bf16* rp = pp + MLA_IN;
#pragma unroll
        for (int part = 0; part < 3; ++part) {
            const int c = part * 512 + 8 * lane; const u32x4 cw = *(const u32x4*)(rr + c); u32x4 pw = (u32x4){0u, 0u, 0u, 0u}; if (!first) pw = *(const u32x4*)(rp + c);
            const f32x4 m0 = *(const f32x4*)(mu + c), m1 = *(const f32x4*)(mu + c + 4);
            float o[8];
#pragma unroll
            for (int j = 0; j < 4; ++j) { const float a = bflo(cw[j]), b = bfhi(cw[j]), pa = bflo(pw[j]), pb = bfhi(pw[j]); const float ma = j < 2 ? m0[2 * j] : m1[2 * j - 4], mb = j < 2 ? m0[2 * j + 1] : m1[2 * j - 3];
                o[2 * j] = a + ma * (pa - a); o[2 * j + 1] = b + mb * (pb - b); }
            u32x4 w; w.x = pk2(o[0], o[1]); w.y = pk2(o[2], o[3]); w.z = pk2(o[4], o[5]); w.w = pk2(o[6], o[7]);
            if (part < 2) *(u32x4*)(RK + (size_t)t * 1024 + part * 512 + 8 * lane) = w; else *(u32x4*)(VS + (size_t)t * C5 + 8 * lane) = w;
        }
        { const int c = 1536 + lane; const float a = bf2f(rr[c]), pa = first ? 0.f : bf2f(rp[c]); const float v = a + mu[c] * (pa - a); A2[(size_t)t * K_SM + lane] = (bf16)f2bf(tanhf(v)); }
        { const int c = 1600 + lane; const float a = bf2f(rr[c]), pa = first ? 0.f : bf2f(rp[c]); const float v = a + mu[c] * (pa - a); A2[(size_t)t * K_SM + 64 + lane] = (bf16)f2bf(v); }
        { const int c = 1664 + 2 * lane; const unsigned cw = *(const unsigned*)(rr + c); const unsigned pw = first ? 0u : *(const unsigned*)(rp + c);
          const f32x2 m = *(const f32x2*)(mu + c); const float a = bflo(cw), b = bfhi(cw); const float va = a + m.x * (bflo(pw) - a), vb = b + m.y * (bfhi(pw) - b);
          *(unsigned*)(A2 + (size_t)t * K_SM + 128 + 2 * lane) = pk2(sigmoidf_(va), sigmoidf_(vb)); }
    }
}

namespace att {
__device__ __forceinline__ int crow(int r, int hi) { return (r & 3) + 8 * (r >> 2) + 4 * hi; }
constexpr int KSLOT = 12288, VSLOT = 8192;
constexpr int LDS_K = 0, LDS_V = 2 * KSLOT, LDS_WS = LDS_V + 2 * VSLOT, LDS_OST = LDS_WS + NWAVES * 64 * 4, LDS_TOTAL = LDS_OST + NWAVES * 4096;
__device__ __forceinline__ void glds16(const void* gsrc, unsigned lds_dst) { unsigned keep;
    asm volatile("s_mov_b32 %0, m0\n\ts_mov_b32 m0, %2\n\ts_nop 0\n\tglobal_load_lds_dwordx4 %1, off\n\ts_mov_b32 m0, %0" : "=&s"(keep) : "v"(gsrc), "s"(lds_dst) : "memory"); }
__device__ __forceinline__ float max3f(float a, float b, float c) { return fmaxf(fmaxf(a, b), c); }
#define ATT_WAIT_BAR() asm volatile("s_waitcnt vmcnt(0) lgkmcnt(0)\n\ts_barrier" ::: "memory")
__device__ __forceinline__ float rowmax(const f32x16& p0, const f32x16& p1) {
    float a = max3f(p0[0], p0[1], p1[0]), b = max3f(p0[2], p0[3], p1[1]); a = max3f(a, p1[2], p1[3]);
#pragma unroll
    for (int r = 4; r < 16; r += 4) { a = max3f(a, p0[r], p0[r + 1]); b = max3f(b, p0[r + 2], p0[r + 3]); a = max3f(a, p1[r], p1[r + 1]); b = max3f(b, p1[r + 2], p1[r + 3]); }
    const float m = fmaxf(a, b);
    auto rr = __builtin_amdgcn_permlane32_swap(__float_as_uint(m), __float_as_uint(m), false, false);
    return fmaxf(__uint_as_float(rr[0]), __uint_as_float(rr[1]));
}
__device__ __forceinline__ void pv(f32x16* o, int vb, bf16x8 pa0, bf16x8 pa1, bf16x8 pa2, bf16x8 pa3) {
#pragma unroll
    for (int d0 = 0; d0 < 2; ++d0) { s16x4 lo[4], hi[4];
#pragma unroll
        for (int ks = 0; ks < 4; ++ks) {
            asm volatile("ds_read_b64_tr_b16 %0,%1 offset:%c2" : "=&v"(lo[ks]) : "v"(vb), "i"(d0 * 4096 + ks * 1024) : "memory");
            asm volatile("ds_read_b64_tr_b16 %0,%1 offset:%c2" : "=&v"(hi[ks]) : "v"(vb), "i"(d0 * 4096 + ks * 1024 + 512) : "memory"); }
        asm volatile("s_waitcnt lgkmcnt(0)" ::: "memory"); __builtin_amdgcn_sched_barrier(0);
#define PK(k) (bf16x8){lo[k][0], lo[k][1], lo[k][2], lo[k][3], hi[k][0], hi[k][1], hi[k][2], hi[k][3]}
        o[d0] = __builtin_amdgcn_mfma_f32_32x32x16_bf16(pa0, PK(0), o[d0], 0, 0, 0);
        o[d0] = __builtin_amdgcn_mfma_f32_32x32x16_bf16(pa1, PK(1), o[d0], 0, 0, 0);
        o[d0] = __builtin_amdgcn_mfma_f32_32x32x16_bf16(pa2, PK(2), o[d0], 0, 0, 0);
        o[d0] = __builtin_amdgcn_mfma_f32_32x32x16_bf16(pa3, PK(3), o[d0], 0, 0, 0);
#undef PK
    }
}
__device__ __forceinline__ void attn_unit(int b, int h, int qb, const bf16* Q, const bf16* __restrict__ KKp, const bf16* __restrict__ Vp, bf16* O, char* shm) {
    const int tid = threadIdx.x, lane = tid & 63, r32 = lane & 31, hi = lane >> 5; const int wid = __builtin_amdgcn_readfirstlane(tid >> 6);
    const long rowbase = (long)b * SEQ; const int q0 = qb * 256;
    const bf16* Qw = Q + (rowbase + q0 + wid * 32) * 768 + h * QKD;
    const bf16* Kh = KKp + rowbase * 768 + h * QKD; const bf16* Vh = Vp + rowbase * 512 + h * VD;
    const unsigned lds0 = (unsigned)(uintptr_t)shm;
    float* wsf = (float*)(shm + LDS_WS) + wid * 64;
    const bf16* ksrc0 = Kh + (long)lane * 768 + wid * 8;
    const bf16* ksrc1 = Kh + (long)lane * 768 + (8 + (wid & 3)) * 8;
    const bf16* vsrc = Vh + (long)(16 * (wid & 3) + (lane >> 2)) * 512 + (wid >> 2) * 32 + (lane & 3) * 8;
    const unsigned kdst0 = lds0 + LDS_K + wid * 1024, kdst1 = lds0 + LDS_K + (8 + (wid & 3)) * 1024, vdst = lds0 + LDS_V + wid * 1024;
#define DMA_KV(t, s) do { glds16(ksrc0 + (long)(t) * 64 * 768, (unsigned)__builtin_amdgcn_readfirstlane(kdst0 + (s) * KSLOT)); \
        if (wid < 4) glds16(ksrc1 + (long)(t) * 64 * 768, (unsigned)__builtin_amdgcn_readfirstlane(kdst1 + (s) * KSLOT)); \
        glds16(vsrc + (long)(t) * 64 * 512, (unsigned)__builtin_amdgcn_readfirstlane(vdst + (s) * VSLOT)); } while (0)
    const int vb0 = (int)(lds0 + LDS_V) + ((lane >> 4) & 1) * 32 + (lane & 3) * 8 + (4 * hi + ((lane & 15) >> 2)) * 64;
    const int NT = (q0 + 256) / 64;
    DMA_KV(0, 0);
    bf16x8 qr[6];
#pragma unroll
    for (int d0 = 0; d0 < 6; ++d0) qr[d0] = *reinterpret_cast<const bf16x8*>(&Qw[(long)r32 * 768 + d0 * 16 + hi * 8]);
    float mrun = -INFINITY, l_reg = 0.f; f32x16 o[2]; o[0] = f32x16{}; o[1] = f32x16{};
    const int qrel = wid * 32 + r32;
    for (int t = 0; t < NT; ++t) {
        ATT_WAIT_BAR();
        if (t + 1 < NT) DMA_KV(t + 1, (t + 1) & 1);
        const char* Kslot = shm + LDS_K + (t & 1) * KSLOT;
        f32x16 p0 = f32x16{}, p1 = f32x16{};
        { const char* kb = Kslot + hi * 1024 + r32 * 16;
#pragma unroll
          for (int d0 = 0; d0 < 6; ++d0) { const bf16x8 b0 = *reinterpret_cast<const bf16x8*>(kb + d0 * 2048); const bf16x8 b1 = *reinterpret_cast<const bf16x8*>(kb + d0 * 2048 + 512);
              p0 = __builtin_amdgcn_mfma_f32_32x32x16_bf16(b0, qr[d0], p0, 0, 0, 0); p1 = __builtin_amdgcn_mfma_f32_32x32x16_bf16(b1, qr[d0], p1, 0, 0, 0); } }
        const int jb = t - (NT - 4);
        if (jb >= 0) { const int kbase = 64 * jb + 4 * hi;
#pragma unroll
            for (int r = 0; r < 16; ++r) { const int kv = kbase + (r & 3) + 8 * (r >> 2); if (kv > qrel) p0[r] = -INFINITY; if (kv + 32 > qrel) p1[r] = -INFINITY; } }
        const float rm = rowmax(p0, p1); const float mnew = fmaxf(mrun, rm); const float f = exp2f(mrun - mnew); mrun = mnew;
        float sacc = 0.f;
#pragma unroll
        for (int r = 0; r < 16; ++r) { p0[r] = exp2f(p0[r] - mnew); p1[r] = exp2f(p1[r] - mnew); sacc += p0[r] + p1[r]; }
        l_reg = l_reg * f + sacc;
        if (hi == 0) wsf[r32] = f;
        asm volatile("s_waitcnt lgkmcnt(0)" ::: "memory");
#pragma unroll
        for (int r = 0; r < 16; ++r) { const float fr_ = wsf[crow(r, hi)]; o[0][r] *= fr_; o[1][r] *= fr_; }
        u32x4 pw0, pw1, pw2, pw3;
        pw0 = (u32x4){cvt_pk_bf16(p0[0], p0[1]), cvt_pk_bf16(p0[2], p0[3]), cvt_pk_bf16(p0[4], p0[5]), cvt_pk_bf16(p0[6], p0[7])};
        pw1 = (u32x4){cvt_pk_bf16(p0[8], p0[9]), cvt_pk_bf16(p0[10], p0[11]), cvt_pk_bf16(p0[12], p0[13]), cvt_pk_bf16(p0[14], p0[15])};
        pw2 = (u32x4){cvt_pk_bf16(p1[0], p1[1]), cvt_pk_bf16(p1[2], p1[3]), cvt_pk_bf16(p1[4], p1[5]), cvt_pk_bf16(p1[6], p1[7])};
        pw3 = (u32x4){cvt_pk_bf16(p1[8], p1[9]), cvt_pk_bf16(p1[10], p1[11]), cvt_pk_bf16(p1[12], p1[13]), cvt_pk_bf16(p1[14], p1[15])};
        asm volatile("s_waitcnt lgkmcnt(0)" ::: "memory");
        pv(o, vb0 + (t & 1) * VSLOT, __builtin_bit_cast(bf16x8, pw0), __builtin_bit_cast(bf16x8, pw1), __builtin_bit_cast(bf16x8, pw2), __builtin_bit_cast(bf16x8, pw3));
    }
    { auto rr = __builtin_amdgcn_permlane32_swap(__float_as_uint(l_reg), __float_as_uint(l_reg), false, false); l_reg = __uint_as_float(rr[0]) + __uint_as_float(rr[1]); }
    if (hi == 0) wsf[32 + r32] = l_reg; asm volatile("s_waitcnt lgkmcnt(0)" ::: "memory");
    float rli[16];
#pragma unroll
    for (int r = 0; r < 16; ++r) rli[r] = 1.0f / wsf[32 + crow(r, hi)];
    bf16* Ow = O + (rowbase + q0 + wid * 32) * 512 + h * VD;
    { bf16* stg = (bf16*)(shm + LDS_OST) + wid * 2048;
#pragma unroll
      for (int r = 0; r < 16; ++r) { const int orow = crow(r, hi);
#pragma unroll
          for (int d0 = 0; d0 < 2; ++d0) stg[orow * 64 + d0 * 32 + r32] = (bf16)f2bf(o[d0][r] * rli[r]); }
      asm volatile("s_waitcnt lgkmcnt(0)" ::: "memory");
#pragma unroll
      for (int i = 0; i < 4; ++i) { const int row = i * 8 + (lane >> 3), ch = lane & 7; const u32x4 v = *(const u32x4*)(stg + row * 64 + ch * 8); *(u32x4*)(Ow + (long)row * 512 + ch * 8) = v; } }
    asm volatile("s_waitcnt vmcnt(0) lgkmcnt(0)\n\ts_barrier" ::: "memory");
#undef DMA_KV
}
}

__device__ __forceinline__ void phase_attn(const Params& p, const Frame& F, char* lds_generic, int l) {
    const bf16* Q = WSP(bf16, WS_Q); const bf16* KKp = WSP(bf16, WS_KK); const bf16* Vp = WSP(bf16, WS_V); bf16* O = WSP(bf16, WS_O);
    unsigned* head = (unsigned*)(F.ws + WS_CTL) + CW_ATTQ + l * 64;
    volatile LAS unsigned* MISC = (volatile LAS unsigned*)(F.lds + MISC_OFF);
    for (;;) {
        if (F.tid == 0) MISC[16] = __hip_atomic_fetch_add(head, 1u, RLX_AGENT);
        __syncthreads();
        const unsigned k = MISC[16];
        __syncthreads();
        if (k >= 1024u) break;
        const int qb = 15 - (int)(k >> 6), bh = (int)(k & 63u);
        att::attn_unit(bh >> 3, bh & 7, qb, Q, KKp, Vp, O, lds_generic);
    }
}

namespace rw {
constexpr int RS = 144;
constexpr int SLOT = 64 * RS;
constexpr int S_KT = 0, S_RT = 1, S_BC = 2, S_KC = 3, S_V = 4, S_BH = 5, S_KH = 6, S_GT = 7, S_ABK = 8, S_AKK = 9, S_AKR = 10, S_ABR = 11, S_ABKF = 12;
constexpr int S_TT = S_BC, S_ZT = S_KC, S_NW1T = S_AKK, S_NW2T = S_ABK;
constexpr int TOT_OFF = 13 * SLOT, PL_OFF = TOT_OFF + 8 * 64 * 4;
typedef short v4i16_t __attribute__((ext_vector_type(4)));
__device__ __forceinline__ int crow(int r, int hi) { return (r & 3) + 8 * (r >> 2) + 4 * hi; }
__device__ __forceinline__ bf16x8 frag_d(const LAS unsigned char* M, int row0, int k0, int r, int h) { return *(const LAS bf16x8*)(M + (row0 + r) * RS + (k0 + 8 * h) * 2); }
__device__ __forceinline__ bf16x8 frag_t(const LAS unsigned char* M, int k0, int col0, int lane) {
    const int h = lane >> 5, blk = (lane >> 4) & 1, q = (lane & 15) >> 2, pp = lane & 3;
    const LAS unsigned char* a = M + (k0 + 8 * h + q) * RS + (col0 + 16 * blk + 4 * pp) * 2;
    const v4i16_t lo = __builtin_amdgcn_ds_read_tr16_b64_v4i16((LAS v4i16_t*)a), hi = __builtin_amdgcn_ds_read_tr16_b64_v4i16((LAS v4i16_t*)(a + 4 * RS));
    return (bf16x8){lo[0], lo[1], lo[2], lo[3], hi[0], hi[1], hi[2], hi[3]};
}
__device__ __forceinline__ void store_T(LAS unsigned char* D, int m0, int n0, const f32x16& acc, float sgn, int r, int h) {
#pragma unroll
    for (int g = 0; g < 4; ++g) { u32x2 w; w.x = cvtpk_c(acc[4 * g] * sgn, acc[4 * g + 1] * sgn); w.y = cvtpk_c(acc[4 * g + 2] * sgn, acc[4 * g + 3] * sgn);
        *(LAS u32x2*)(D + (n0 + r) * RS + (m0 + 8 * g + 4 * h) * 2) = w; }
}
#define RW_MMA(acc, A, B) acc = __builtin_amdgcn_mfma_f32_32x32x16_bf16((A), (B), acc, 0, 0, 0)
}

#define LBAR() asm volatile("s_waitcnt lgkmcnt(0)\n\ts_barrier" ::: "memory")
__device__ __forceinline__ void phase_rwkv_r1(const Params& p, const Frame& F, int l) {
    using namespace rw;
    LAS unsigned char* L0 = F.lds;
#define SL(i) (L0 + (i) * SLOT)
    const bf16* RK = WSP(bf16, WS_RK); const float* WAG = WSP(float, WS_WAG);
    const bf16* Vv = l == 0 ? WSP(bf16, WS_VS0) : WSP(bf16, WS_VR);
    float* CH = WSP(float, WS_CH);
    const float* kkw = INP(I_KK) + (size_t)l * C5; const float* kaw = INP(I_KA) + (size_t)l * C5;
    const int tid0 = F.tid, wave = F.wave;
    const int pt0 = tid0 >> 3, j80 = tid0 & 7;
    LAS float* tot = (LAS float*)(L0 + TOT_OFF); LAS float* PLv = (LAS float*)(L0 + PL_OFF);
    u32x4 g_r, g_k, g_v; f32x4 g_l0, g_l1, g_a0, g_a1;
#define R1_FETCH(uu) do { const int bh_ = (uu) >> 6, cc_ = (uu) & 63; const size_t tok = (size_t)(bh_ >> 3) * SEQ + (size_t)cc_ * 64 + pt0; const int c_ = (bh_ & 7) * 64 + 8 * j80; \
        g_r = *(const u32x4*)(RK + tok * 1024 + c_); g_k = *(const u32x4*)(RK + tok * 1024 + 512 + c_); g_v = *(const u32x4*)(Vv + tok * C5 + c_); \
        g_l0 = *(const f32x4*)(WAG + tok * N_SM + c_); g_l1 = *(const f32x4*)(WAG + tok * N_SM + c_ + 4); g_a0 = *(const f32x4*)(WAG + tok * N_SM + 512 + c_); g_a1 = *(const f32x4*)(WAG + tok * N_SM + 512 + c_ + 4); } while (0)
    int u = F.vcu;
    if (u < 4096) R1_FETCH(u);
    for (; u < 4096; u += F.G) {
        const int hh = (u >> 6) & 7;
        int tid = tid0; asm volatile("" : "+v"(tid)); const int lane = tid & 63, r = lane & 31, h = lane >> 5, pt = tid >> 3, j8 = tid & 7;
        {
            const int c = hh * 64 + 8 * j8;
            const f32x4 kk0 = *(const f32x4*)(kkw + c), kk1 = *(const f32x4*)(kkw + c + 4), ka0 = *(const f32x4*)(kaw + c), ka1 = *(const f32x4*)(kaw + c + 4);
            float rr[8], k[8], a[8], x[8], lw[8], kap[8], be[8], kp[8]; float ss = 0.f;
#pragma unroll
            for (int j = 0; j < 4; ++j) { rr[2 * j] = bflo(g_r[j]); rr[2 * j + 1] = bfhi(g_r[j]); k[2 * j] = bflo(g_k[j]); k[2 * j + 1] = bfhi(g_k[j]); }
            *(LAS u32x4*)(SL(S_V) + pt * RS + j8 * 16) = g_v;
#pragma unroll
            for (int j = 0; j < 8; ++j) { a[j] = j < 4 ? g_a0[j & 3] : g_a1[j & 3]; lw[j] = j < 4 ? g_l0[j & 3] : g_l1[j & 3]; x[j] = lw[j]; const float q = k[j] * (j < 4 ? kk0[j & 3] : kk1[j & 3]); kap[j] = q; ss += q * q; }
            ss += __shfl_xor(ss, 1); ss += __shfl_xor(ss, 2); ss += __shfl_xor(ss, 4);
            const float inv = 1.0f / fmaxf(sqrtf(ss), 1e-12f);
#pragma unroll
            for (int j = 0; j < 8; ++j) { kap[j] *= inv; be[j] = kap[j] * a[j]; kp[j] = k[j] * (1.0f + (a[j] - 1.0f) * (j < 4 ? ka0[j & 3] : ka1[j & 3])); }
#pragma unroll
            for (int off = 8; off < 64; off <<= 1) {
#pragma unroll
                for (int j = 0; j < 8; ++j) { const float y = __shfl_up(x[j], off); if (lane >= off) x[j] += y; } }
            if (lane >= 56) { *(LAS f32x4*)(tot + wave * 64 + 8 * j8) = (f32x4){x[0], x[1], x[2], x[3]}; *(LAS f32x4*)(tot + wave * 64 + 8 * j8 + 4) = (f32x4){x[4], x[5], x[6], x[7]}; }
            LBAR();
            float csL[8];
#pragma unroll
            for (int j = 0; j < 8; ++j) csL[j] = 0.f;
#pragma unroll
            for (int w2 = 0; w2 < 8; ++w2) { const f32x4 t0 = *(const LAS f32x4*)(tot + w2 * 64 + 8 * j8), t1 = *(const LAS f32x4*)(tot + w2 * 64 + 8 * j8 + 4);
#pragma unroll
                for (int j = 0; j < 8; ++j) { const float tv = j < 4 ? t0[j & 3] : t1[j & 3]; csL[j] += tv; if (w2 < wave) x[j] += tv; } }
            if (pt == 0) {
#pragma unroll
                for (int j = 0; j < 8; ++j) PLv[8 * j8 + j] = __expf(csL[j]); }
            float kt[8], rt[8], bc[8], kc[8], bh[8], kh[8];
#pragma unroll
            for (int j = 0; j < 8; ++j) { const float eP = __expf(x[j]), ePm1 = __expf(x[j] - lw[j]), eInv = __expf(-x[j]), eL = __expf(csL[j] - x[j]);
                kt[j] = kap[j] * ePm1; rt[j] = rr[j] * eP; bc[j] = be[j] * eInv; kc[j] = kp[j] * eInv; bh[j] = be[j] * eL; kh[j] = kp[j] * eL; }
#define PK8(v) (u32x4){cvtpk_c(v[0], v[1]), cvtpk_c(v[2], v[3]), cvtpk_c(v[4], v[5]), cvtpk_c(v[6], v[7])}
            *(LAS u32x4*)(SL(S_KT) + pt * RS + j8 * 16) = PK8(kt); *(LAS u32x4*)(SL(S_RT) + pt * RS + j8 * 16) = PK8(rt);
            *(LAS u32x4*)(SL(S_BC) + pt * RS + j8 * 16) = PK8(bc); *(LAS u32x4*)(SL(S_KC) + pt * RS + j8 * 16) = PK8(kc);
            *(LAS u32x4*)(SL(S_BH) + pt * RS + j8 * 16) = PK8(bh); *(LAS u32x4*)(SL(S_KH) + pt * RS + j8 * 16) = PK8(kh);
#undef PK8
        }
        LBAR();
        {
            const int mat = wave >> 1, ti = wave & 1;
            const LAS unsigned char* X = (mat < 2) ? SL(S_KT) : SL(S_RT); const LAS unsigned char* Y = (mat == 0 || mat == 3) ? SL(S_BC) : SL(S_KC);
            LAS unsigned char* Dm = SL(S_ABK + mat);
            const int t = 32 * ti + r;
            bf16x8 xb[4];
#pragma unroll
            for (int kk = 0; kk < 4; ++kk) xb[kk] = frag_d(X, 32 * ti, 16 * kk, r, h);
#pragma unroll
            for (int si = 0; si < 2; ++si) {
                f32x16 acc = f32x16{};
                if (!(ti == 0 && si == 1)) {
#pragma unroll
                    for (int kk = 0; kk < 4; ++kk) RW_MMA(acc, frag_d(Y, 32 * si, 16 * kk, r, h), xb[kk]); }
#pragma unroll
                for (int g = 0; g < 4; ++g) { float v[4];
#pragma unroll
                    for (int e = 0; e < 4; ++e) { const int sidx = 32 * si + 8 * g + 4 * h + e; const bool keep = (mat < 2) ? (sidx < t) : (sidx <= t); v[e] = keep ? acc[4 * g + e] : 0.f; }
                    u32x2 w; w.x = cvtpk_c(v[0], v[1]); w.y = cvtpk_c(v[2], v[3]);
                    *(LAS u32x2*)(Dm + t * RS + (32 * si + 8 * g + 4 * h) * 2) = w;
                    if (mat == 0 && ti == si) *(LAS f32x4*)(SL(S_ABKF) + ti * 4608 + r * 144 + (8 * g + 4 * h) * 4) = (f32x4){v[0], v[1], v[2], v[3]}; }
            }
        }
        LBAR();
        if (wave == 0) {
            const int hb = lane >> 5, c = lane & 31; const LAS unsigned char* Ab = SL(S_ABKF) + hb * 4608;
            float Tc[32];
#pragma unroll
            for (int t = 0; t < 32; ++t) Tc[t] = 0.f;
#pragma unroll
            for (int t = 0; t < 32; ++t) { float acc0 = (t == c) ? 1.0f : 0.0f, acc1 = 0.f;
#pragma unroll
                for (int s4 = 0; s4 < (t + 3) / 4; ++s4) { const f32x4 a4 = *(const LAS f32x4*)(Ab + t * 144 + s4 * 16);
                    acc0 -= a4.x * Tc[4 * s4]; acc1 -= a4.y * Tc[4 * s4 + 1]; acc0 -= a4.z * Tc[4 * s4 + 2]; acc1 -= a4.w * Tc[4 * s4 + 3]; }
                float acc = acc0 + acc1;
                asm volatile("" : "+v"(acc) :: "memory");
                Tc[t] = acc; }
#pragma unroll
            for (int q = 0; q < 4; ++q) *(LAS u32x4*)(SL(S_TT) + (32 * hb + c) * RS + (32 * hb) * 2 + q * 16) =
                (u32x4){cvtpk_c(Tc[8 * q], Tc[8 * q + 1]), cvtpk_c(Tc[8 * q + 2], Tc[8 * q + 3]), cvtpk_c(Tc[8 * q + 4], Tc[8 * q + 5]), cvtpk_c(Tc[8 * q + 6], Tc[8 * q + 7])};
        } else if (wave == 1) {
            const int row = 32 + (lane >> 1), hf = lane & 1;
            *(LAS u32x4*)(SL(S_TT) + row * RS + hf * 32) = (u32x4){0u, 0u, 0u, 0u}; *(LAS u32x4*)(SL(S_TT) + row * RS + hf * 32 + 16) = (u32x4){0u, 0u, 0u, 0u};
        } else if (wave >= 4) {
            const int ti = (wave - 4) >> 1, ii = (wave - 4) & 1; f32x16 acc = f32x16{};
#pragma unroll
            for (int kk = 0; kk < 4; ++kk) RW_MMA(acc, frag_d(SL(S_AKK), 32 * ti, 16 * kk, r, h), frag_t(SL(S_V), 16 * kk, 32 * ii, lane));
            store_T(SL(S_GT), 32 * ti, 32 * ii, acc, 1.0f, r, h);
        }
        LBAR();
        if (wave == 0) { f32x16 acc = f32x16{};
#pragma unroll
            for (int kk = 0; kk < 2; ++kk) RW_MMA(acc, frag_d(SL(S_ABK), 32, 16 * kk, r, h), frag_d(SL(S_TT), 0, 16 * kk, r, h));
            store_T(SL(S_ZT), 0, 0, acc, 1.0f, r, h); }
        LBAR();
        if (wave == 0) { f32x16 acc = f32x16{};
#pragma unroll
            for (int kk = 0; kk < 2; ++kk) RW_MMA(acc, frag_t(SL(S_TT), 32 + 16 * kk, 32, lane), frag_d(SL(S_ZT), 0, 16 * kk, r, h));
            store_T(SL(S_TT), 32, 0, acc, -1.0f, r, h); }
        LBAR();
        if (u + F.G < 4096) R1_FETCH(u + F.G);
        { const int w4 = wave & 3, ti = w4 >> 1, ci = w4 & 1; f32x16 acc = f32x16{};
          if (wave < 4) {
#pragma unroll
              for (int kk = 0; kk < 4; ++kk) RW_MMA(acc, frag_t(SL(S_TT), 16 * kk, 32 * ti, lane), frag_t(SL(S_KT), 16 * kk, 32 * ci, lane));
              store_T(SL(S_NW1T), 32 * ti, 32 * ci, acc, -1.0f, r, h); }
          else {
#pragma unroll
              for (int kk = 0; kk < 4; ++kk) RW_MMA(acc, frag_t(SL(S_TT), 16 * kk, 32 * ti, lane), frag_d(SL(S_GT), 32 * ci, 16 * kk, r, h));
              store_T(SL(S_NW2T), 32 * ti, 32 * ci, acc, -1.0f, r, h); } }
        LBAR();
        { const int which = wave >> 1, mi = wave & 1; float* dst = CH + ((size_t)u * 4 + which) * 4096;
#pragma unroll
          for (int ni = 0; ni < 2; ++ni) { f32x16 acc = f32x16{};
#pragma unroll
              for (int kk = 0; kk < 4; ++kk) {
                  if (which == 0) RW_MMA(acc, frag_d(SL(S_ABR), 32 * mi, 16 * kk, r, h), frag_d(SL(S_NW1T), 32 * ni, 16 * kk, r, h));
                  else if (which == 1) { RW_MMA(acc, frag_d(SL(S_AKR), 32 * mi, 16 * kk, r, h), frag_t(SL(S_V), 16 * kk, 32 * ni, lane)); RW_MMA(acc, frag_d(SL(S_ABR), 32 * mi, 16 * kk, r, h), frag_d(SL(S_NW2T), 32 * ni, 16 * kk, r, h)); }
                  else if (which == 2) RW_MMA(acc, frag_t(SL(S_BH), 16 * kk, 32 * mi, lane), frag_d(SL(S_NW1T), 32 * ni, 16 * kk, r, h));
                  else { RW_MMA(acc, frag_t(SL(S_KH), 16 * kk, 32 * mi, lane), frag_t(SL(S_V), 16 * kk, 32 * ni, lane)); RW_MMA(acc, frag_t(SL(S_BH), 16 * kk, 32 * mi, lane), frag_d(SL(S_NW2T), 32 * ni, 16 * kk, r, h)); } }
              const int n = 32 * ni + r;
#pragma unroll
              for (int rg = 0; rg < 16; ++rg) { const int m = 32 * mi + crow(rg, h); float v = acc[rg];
                  if (which == 0) v += bf2f(*(const LAS bf16*)(SL(S_RT) + m * RS + n * 2));
                  if (which == 2 && m == n) v += PLv[n];
                  dst[m * 64 + n] = v; } } }
        LBAR();
    }
#undef R1_FETCH
#undef SL
}

__device__ __forceinline__ void phase_rwkv_r2(const Params& p, const Frame& F) {
    const float* CH = WSP(float, WS_CH); float* RO = WSP(float, WS_RO);
    LAS float* stb = (LAS float*)(F.lds);
    constexpr int STB = 4 * 1280;
    const int lane = F.lane, wave = F.wave, q = lane >> 4, li = lane & 15, w4 = wave & 3;
    const int nr2 = F.G >= 4 ? F.G / 4 : 1;
    if (F.vcu >= nr2) return;
    for (int bh = F.vcu; bh < 64; bh += nr2) {
        const int b = bh >> 3, hh = bh & 7;
        __syncthreads();
        for (int i = F.tid; i < 2 * STB; i += NTHREADS) stb[i] = 0.f;
        __syncthreads();
        const int mA = (wave < 4) ? 2 : 0, mC = (wave < 4) ? 3 : 1;
        const float* basec = CH + (size_t)bh * 64 * 4 * 4096;
        f32x4 fa[2][4], fc[2][4];
#define R2_FETCH(cc, st) do { const float* pa = basec + ((size_t)(cc) * 4 + mA) * 4096 + (16 * w4 + li) * 64 + 16 * q; fa[st][0] = *(const f32x4*)(pa); fa[st][1] = *(const f32x4*)(pa + 4); fa[st][2] = *(const f32x4*)(pa + 8); fa[st][3] = *(const f32x4*)(pa + 12); \
            const float* pc = basec + ((size_t)(cc) * 4 + mC) * 4096 + (16 * w4 + 4 * q) * 64 + li; \
            _Pragma("unroll") for (int ct = 0; ct < 4; ++ct) fc[st][ct] = (f32x4){pc[16 * ct], pc[64 + 16 * ct], pc[128 + 16 * ct], pc[192 + 16 * ct]}; } while (0)
        R2_FETCH(0, 0); R2_FETCH(1, 1);
#pragma unroll 1
        for (int c0 = 0; c0 < 64; c0 += 2) {
#pragma unroll
            for (int st = 0; st < 2; ++st) { const int c = c0 + st;
                const f32x4 A0 = fa[st][0], A1 = fa[st][1], A2 = fa[st][2], A3 = fa[st][3];
                f32x4 acc[4];
#pragma unroll
                for (int ct = 0; ct < 4; ++ct) acc[ct] = fc[st][ct];
                if (c + 2 < 64) R2_FETCH(c + 2, st);
#pragma unroll
                for (int ct = 0; ct < 4; ++ct) { const LAS float* sb = stb + (c & 1) * STB + ct * 1280 + lane * 20;
                    const f32x4 b0 = *(const LAS f32x4*)(sb), b1 = *(const LAS f32x4*)(sb + 4), b2 = *(const LAS f32x4*)(sb + 8), b3 = *(const LAS f32x4*)(sb + 12);
#pragma unroll
                    for (int k = 0; k < 4; ++k) acc[ct] = __builtin_amdgcn_mfma_f32_16x16x4f32(A0[k], b0[k], acc[ct], 0, 0, 0);
#pragma unroll
                    for (int k = 0; k < 4; ++k) acc[ct] = __builtin_amdgcn_mfma_f32_16x16x4f32(A1[k], b1[k], acc[ct], 0, 0, 0);
#pragma unroll
                    for (int k = 0; k < 4; ++k) acc[ct] = __builtin_amdgcn_mfma_f32_16x16x4f32(A2[k], b2[k], acc[ct], 0, 0, 0);
#pragma unroll
                    for (int k = 0; k < 4; ++k) acc[ct] = __builtin_amdgcn_mfma_f32_16x16x4f32(A3[k], b3[k], acc[ct], 0, 0, 0); }
                if (wave < 4) {
#pragma unroll
                    for (int ct = 0; ct < 4; ++ct) *(LAS f32x4*)(stb + ((c + 1) & 1) * STB + ct * 1280 + (w4 * 16 + li) * 20 + 4 * q) = acc[ct]; }
                else { float* ro = RO + ((size_t)b * SEQ + (size_t)c * 64 + 16 * w4 + 4 * q) * C5 + hh * 64 + li;
#pragma unroll
                    for (int ct = 0; ct < 4; ++ct) { ro[16 * ct] = acc[ct][0]; ro[C5 + 16 * ct] = acc[ct][1]; ro[2 * C5 + 16 * ct] = acc[ct][2]; ro[3 * C5 + 16 * ct] = acc[ct][3]; } }
                LBAR();
            }
        }
#undef R2_FETCH
    }
    __syncthreads();
}
#undef LBAR

__device__ __forceinline__ void phase_mix(const Params& p, const Frame& F, int l) {
    const int gw = F.vcu * NWAVES + F.wave, NGW = F.G * NWAVES; const int lane = F.lane;
    const bf16* O = WSP(bf16, WS_O); const float* RO = WSP(float, WS_RO); const bf16* RK = WSP(bf16, WS_RK); const float* WAG = WSP(float, WS_WAG);
    const bf16* Vv = l == 0 ? WSP(bf16, WS_VS0) : WSP(bf16, WS_VR); bf16* MIX = WSP(bf16, WS_MIX);
    const float* og = INP(I_MOUTG) + (size_t)l * C5; const float* gng = INP(I_GNG) + (size_t)l * C5; const float* gnb = INP(I_GNB) + (size_t)l * C5;
    const float* kaw = INP(I_KA) + (size_t)l * C5; const float* rkw = INP(I_RK) + (size_t)l * C5;
    for (int t = gw; t < T; t += NGW) {
        const int c = 8 * lane;
        { const u32x4 ow = *(const u32x4*)(O + (size_t)t * C5 + c); float o[8]; float ss = 0.f;
#pragma unroll
          for (int j = 0; j < 4; ++j) { o[2 * j] = bflo(ow[j]); o[2 * j + 1] = bfhi(ow[j]); ss += o[2 * j] * o[2 * j] + o[2 * j + 1] * o[2 * j + 1]; }
          const float rs = 1.f / sqrtf(wave_sum(ss) * (1.f / C5) + RMS_EPS);
          const f32x4 g0 = *(const f32x4*)(og + c), g1 = *(const f32x4*)(og + c + 4);
          u32x4 w; w.x = pk2(o[0] * rs * g0.x, o[1] * rs * g0.y); w.y = pk2(o[2] * rs * g0.z, o[3] * rs * g0.w); w.z = pk2(o[4] * rs * g1.x, o[5] * rs * g1.y); w.w = pk2(o[6] * rs * g1.z, o[7] * rs * g1.w);
          *(u32x4*)(MIX + (size_t)t * D + c) = w; }
        { const f32x4 r0 = *(const f32x4*)(RO + (size_t)t * C5 + c), r1 = *(const f32x4*)(RO + (size_t)t * C5 + c + 4);
          float o[8]; float s = 0.f;
#pragma unroll
          for (int j = 0; j < 8; ++j) { o[j] = j < 4 ? r0[j & 3] : r1[j & 3]; s += o[j]; }
          s += __shfl_xor(s, 1); s += __shfl_xor(s, 2); s += __shfl_xor(s, 4); const float mean = s * (1.f / 64.f); float q = 0.f;
#pragma unroll
          for (int j = 0; j < 8; ++j) { o[j] -= mean; q += o[j] * o[j]; }
          q += __shfl_xor(q, 1); q += __shfl_xor(q, 2); q += __shfl_xor(q, 4); const float rstd = 1.f / sqrtf(q * (1.f / 64.f) + GN_EPS);
          const u32x4 rw = *(const u32x4*)(RK + (size_t)t * 1024 + c), kw = *(const u32x4*)(RK + (size_t)t * 1024 + 512 + c), vw = *(const u32x4*)(Vv + (size_t)t * C5 + c);
          const f32x4 a0 = *(const f32x4*)(WAG + (size_t)t * N_SM + 512 + c), a1 = *(const f32x4*)(WAG + (size_t)t * N_SM + 512 + c + 4);
          const f32x4 g0 = *(const f32x4*)(WAG + (size_t)t * N_SM + 1024 + c), g1 = *(const f32x4*)(WAG + (size_t)t * N_SM + 1024 + c + 4);
          const f32x4 ka0 = *(const f32x4*)(kaw + c), ka1 = *(const f32x4*)(kaw + c + 4), rk0 = *(const f32x4*)(rkw + c), rk1 = *(const f32x4*)(rkw + c + 4);
          const f32x4 gg0 = *(const f32x4*)(gng + c), gg1 = *(const f32x4*)(gng + c + 4), gb0 = *(const f32x4*)(gnb + c), gb1 = *(const f32x4*)(gnb + c + 4);
          float r[8], k[8], v[8]; float bon = 0.f;
#pragma unroll
          for (int j = 0; j < 4; ++j) { r[2 * j] = bflo(rw[j]); r[2 * j + 1] = bfhi(rw[j]); k[2 * j] = bflo(kw[j]); k[2 * j + 1] = bfhi(kw[j]); v[2 * j] = bflo(vw[j]); v[2 * j + 1] = bfhi(vw[j]); }
#pragma unroll
          for (int j = 0; j < 8; ++j) { const float a = j < 4 ? a0[j & 3] : a1[j & 3]; const float kp = k[j] * (1.0f + (a - 1.0f) * (j < 4 ? ka0[j & 3] : ka1[j & 3])); bon += r[j] * kp * (j < 4 ? rk0[j & 3] : rk1[j & 3]); }
          bon += __shfl_xor(bon, 1); bon += __shfl_xor(bon, 2); bon += __shfl_xor(bon, 4);
          float y[8];
#pragma unroll
          for (int j = 0; j < 8; ++j) { const float gn = o[j] * rstd * (j < 4 ? gg0[j & 3] : gg1[j & 3]) + (j < 4 ? gb0[j & 3] : gb1[j & 3]); y[j] = (gn + bon * v[j]) * (j < 4 ? g0[j & 3] : g1[j & 3]); }
          u32x4 w; w.x = pk2(y[0], y[1]); w.y = pk2(y[2], y[3]); w.z = pk2(y[4], y[5]); w.w = pk2(y[6], y[7]);
          *(u32x4*)(MIX + (size_t)t * D + C5 + c) = w; }
    }
}

__device__ __forceinline__ void phase_ln1_route(const Params& p, const Frame& F, int l) {
    LAS float* hrow = (LAS float*)(F.lds) + F.wave * D;
    LAS int* hist = (LAS int*)(F.lds + 65536);
    LAS int* basep = hist + 32;
    LAS int* rinfo = hist + 64;
    LAS float* rgate = (LAS float*)(rinfo + 512);
    const float* mod = WSP(float, WS_MOD) + (size_t)l * NBATCH * 6144;
    const float* g1 = INP(I_LN1G) + (size_t)l * D; const float* b1 = INP(I_LN1B) + (size_t)l * D;
    const float* rwt = INP(I_RW) + (size_t)l * D * NE; const float* rb = INP(I_RB) + (size_t)l * NE;
    unsigned* cnt = (unsigned*)(F.ws + WS_CTL) + CW_CNT + l * 64;
    int* LIST = WSP(int, WS_LIST); float* GATEL = WSP(float, WS_GATEL); int* TOKSLOT = WSP(int, WS_TOKSLOT);
    const int lane = F.lane;
    for (int chunk = F.vcu; chunk < T / 128; chunk += F.G) {
        __syncthreads();
        if (F.tid < 32) hist[F.tid] = 0;
        __syncthreads();
        for (int rr = 0; rr < 16; ++rr) {
            const int lr = F.wave * 16 + rr; const int m = chunk * 128 + lr; const int b = m / SEQ;
            GAS f32x4* xr = (GAS f32x4*)(WSP(float, WS_X) + (size_t)m * D) + lane;
            f32x4 v[4]; float s = 0.f;
#pragma unroll
            for (int j = 0; j < 4; ++j) { v[j] = xr[64 * j]; s += (v[j].x + v[j].y) + (v[j].z + v[j].w); }
            const float mean = wave_sum(s) * (1.f / D); float s2 = 0.f;
#pragma unroll
            for (int j = 0; j < 4; ++j) { v[j] = v[j] - mean; s2 += (v[j].x * v[j].x + v[j].y * v[j].y) + (v[j].z * v[j].z + v[j].w * v[j].w); }
            const float rstd = 1.f / sqrtf(wave_sum(s2) * (1.f / D) + LN_EPS);
            GAS u32x2* ho = (GAS u32x2*)(WSP(bf16, WS_H) + (size_t)m * D) + lane;
#pragma unroll
            for (int j = 0; j < 4; ++j) { const int c = 4 * lane + 256 * j;
                const f32x4 g = *(const f32x4*)(g1 + c), be = *(const f32x4*)(b1 + c);
                const f32x4 x1 = v[j] * rstd * g + be; xr[64 * j] = x1;
                const f32x4 sh = *(const f32x4*)(mod + (size_t)b * 6144 + 3072 + c), sc = *(const f32x4*)(mod + (size_t)b * 6144 + 4096 + c);
                const f32x4 h = x1 * (sc + 1.0f) + sh; u32x2 w; w.x = pk2(h.x, h.y); w.y = pk2(h.z, h.w); ho[64 * j] = w;
                *(LAS f32x4*)(hrow + c) = h; }
            LDS_WAIT(); asm volatile("" ::: "memory");
            const int e = lane & 31, kh = lane >> 5; float acc0 = 0.f, acc1 = 0.f;
            const float* rwp = rwt + (size_t)(kh * 512) * NE + e; const LAS float* hp = hrow + kh * 512;
#pragma unroll 4
            for (int k = 0; k < 512; k += 4) { const f32x4 hv = *(const LAS f32x4*)(hp + k);
                acc0 += hv.x * rwp[(size_t)(k + 0) * NE]; acc1 += hv.y * rwp[(size_t)(k + 1) * NE]; acc0 += hv.z * rwp[(size_t)(k + 2) * NE]; acc1 += hv.w * rwp[(size_t)(k + 3) * NE]; }
            float logit = acc0 + acc1; logit += __shfl_xor(logit, 32); logit += rb[e];
            float val = logit; float tv0 = 0.f, tv1 = 0.f, tv2 = 0.f, tv3 = 0.f; int te0 = 0, te1 = 0, te2 = 0, te3 = 0;
#pragma unroll
            for (int k = 0; k < 4; ++k) { float mx = val;
#pragma unroll
                for (int o = 1; o < 32; o <<= 1) mx = fmaxf(mx, __shfl_xor(mx, o));
                const unsigned long long bal = __ballot(val == mx && lane < 32); const int ek = __builtin_ctzll(bal);
                if (k == 0) { tv0 = mx; te0 = ek; } else if (k == 1) { tv1 = mx; te1 = ek; } else if (k == 2) { tv2 = mx; te2 = ek; } else { tv3 = mx; te3 = ek; }
                if (e == ek) val = -INFINITY; }
            const float e0 = 1.0f, e1 = __expf(tv1 - tv0), e2 = __expf(tv2 - tv0), e3 = __expf(tv3 - tv0); const float inv = 1.0f / (e0 + e1 + e2 + e3);
            if (lane < 4) { const int ek = lane == 0 ? te0 : lane == 1 ? te1 : lane == 2 ? te2 : te3; const float gk = (lane == 0 ? e0 : lane == 1 ? e1 : lane == 2 ? e2 : e3) * inv;
                const int lp = __hip_atomic_fetch_add(&hist[ek], 1, __ATOMIC_RELAXED, __HIP_MEMORY_SCOPE_WORKGROUP); rinfo[lr * 4 + lane] = (ek << 16) | lp; rgate[lr * 4 + lane] = gk; }
            LDS_WAIT(); asm volatile("" ::: "memory");
        }
        __syncthreads();
        if (F.tid < 32) basep[F.tid] = (int)__hip_atomic_fetch_add(cnt + F.tid, (unsigned)hist[F.tid], RLX_AGENT);
        __syncthreads();
        { const int lr = F.tid >> 2, k = F.tid & 3; const int m = chunk * 128 + lr; const int info = rinfo[F.tid]; const int ek = info >> 16; const int pos = basep[ek] + (info & 0xffff);
          LIST[ek * CAP + pos] = m; GATEL[ek * CAP + pos] = rgate[F.tid]; TOKSLOT[m * 4 + k] = (ek << 16) | pos; }
    }
    __syncthreads();
}

__device__ __forceinline__ void moe_tables(const Frame& F, int l) {
    LAS int* tb = (LAS int*)(F.lds + TB_OFF); LAS int* cn = tb + 40;
    const unsigned* cnt = (const unsigned*)(F.ws + WS_CTL) + CW_CNT + l * 64;
    __syncthreads();
    if (F.tid == 0) { int acc = 0;
        for (int e = 0; e < NE; ++e) { const int c = (int)__hip_atomic_load(cnt + e, RLX_AGENT); cn[e] = c; tb[e] = acc; acc += (c + 255) >> 8; }
        tb[NE] = acc; }
    __syncthreads();
}

__device__ __forceinline__ void phase_combine(const Params& p, const Frame& F, int l) {
    const LAS int* tb = (const LAS int*)(F.lds + TB_OFF);
    const int gw = F.vcu * NWAVES + F.wave, NGW = F.G * NWAVES; const int lane = F.lane;
    const float* mod = WSP(float, WS_MOD) + (size_t)l * NBATCH * 6144; const float* modn = WSP(float, WS_MOD) + (size_t)(l + 1) * NBATCH * 6144;
    const float* g2 = INP(I_LN2G) + (size_t)l * D; const float* b2 = INP(I_LN2B) + (size_t)l * D;
    const bf16* Y = WSP(bf16, WS_Y); const int* TOKSLOT = WSP(int, WS_TOKSLOT);
    const bool lastl = (l == DEPTH - 1);
    for (int m = gw; m < T; m += NGW) {
        const int b = m / SEQ;
        int srow[4];
#pragma unroll
        for (int k = 0; k < 4; ++k) { const int ts = TOKSLOT[m * 4 + k]; const int e = ts >> 16, pos = ts & 0xffff; srow[k] = tb[e] * 256 + pos; }
        GAS f32x4* xr = (GAS f32x4*)(WSP(float, WS_X) + (size_t)m * D) + lane;
        f32x4 v[4]; float s = 0.f;
#pragma unroll
        for (int j = 0; j < 4; ++j) { const int c = 4 * lane + 256 * j; f32x4 y = (f32x4){0.f, 0.f, 0.f, 0.f};
#pragma unroll
            for (int k = 0; k < 4; ++k) { const u32x2 yw = *(const u32x2*)(Y + (size_t)srow[k] * D + c); y.x += bflo(yw.x); y.y += bfhi(yw.x); y.z += bflo(yw.y); y.w += bfhi(yw.y); }
            const f32x4 gt = *(const f32x4*)(mod + (size_t)b * 6144 + 5120 + c) + 1.0f;
            v[j] = xr[64 * j] * DN_ALPHA + gt * y; s += (v[j].x + v[j].y) + (v[j].z + v[j].w); }
        const float mean = wave_sum(s) * (1.f / D); float s2 = 0.f;
#pragma unroll
        for (int j = 0; j < 4; ++j) { v[j] = v[j] - mean; s2 += (v[j].x * v[j].x + v[j].y * v[j].y) + (v[j].z * v[j].z + v[j].w * v[j].w); }
        const float rstd = 1.f / sqrtf(wave_sum(s2) * (1.f / D) + LN_EPS);
        GAS f32x4* oo = (GAS f32x4*)(p.out + (size_t)m * D) + lane;
        GAS u32x2* ho = (GAS u32x2*)(WSP(bf16, WS_H) + (size_t)m * D) + lane;
#pragma unroll
        for (int j = 0; j < 4; ++j) { const int c = 4 * lane + 256 * j;
            const f32x4 g = *(const f32x4*)(g2 + c), be = *(const f32x4*)(b2 + c);
            const f32x4 x2 = v[j] * rstd * g + be;
            if (lastl) oo[64 * j] = x2;
            else { xr[64 * j] = x2;
                const f32x4 sh = *(const f32x4*)(modn + (size_t)b * 6144 + c), sc = *(const f32x4*)(modn + (size_t)b * 6144 + 1024 + c);
                const f32x4 h = x2 * (sc + 1.0f) + sh; u32x2 w; w.x = pk2(h.x, h.y); w.y = pk2(h.z, h.w); ho[64 * j] = w; } }
    }
}

constexpr int PH_PER_LAYER = 11, N_PHASES = 2 + DEPTH * PH_PER_LAYER;
__global__ void __launch_bounds__(NTHREADS, 2) fwd(Params p) {
    extern __shared__ __attribute__((aligned(16))) unsigned char lds[];
    Frame F;
    F.lds = (LAS unsigned char*)lds; F.tid = threadIdx.x; F.lane = F.tid & 63; F.wave = __builtin_amdgcn_readfirstlane(F.tid >> 6);
    F.G = gridDim.x; { const int bx = blockIdx.x; F.vcu = (F.G % 8 == 0) ? (bx % 8) * (F.G / 8) + bx / 8 : bx; }
    F.ws = p.ws;
    volatile LAS unsigned* MISC = (volatile LAS unsigned*)(F.lds + MISC_OFF);
    if (F.tid < 64) MISC[F.tid] = 0u;
    __syncthreads();
    unsigned* ctl = (unsigned*)(p.ws + WS_CTL);
#if MK_ONE_LAUNCH
    XcdBarrier bar = xcd_barrier_post(ctl + CW_BAR, MISC + 8);
#define GRID_BAR() xcd_barrier(bar)
#else
#define GRID_BAR() do {} while (0)
#endif
    const int lo = p.ph_lo, hi = p.ph_hi;
#ifndef PH_MASK
#define PH_MASK 0xFFFFFFFFu
#endif
#define IN(k) (lo <= (k) && (k) < hi)
#define EN(j) ((PH_MASK >> (j)) & 1u)
#define SEAM(k) do { if (IN(k) && IN((k) + 1)) GRID_BAR(); } while (0)
    LAS unsigned char* ring = F.lds;

    if (EN(0) && IN(0)) { for (int rep = 0; rep < REP_PRO; ++rep) phase_prologue(p, F); } SEAM(0);
    if (EN(1) && IN(1)) { phase_ln0(p, F); } SEAM(1);
#define LAYER_BODY \
        constexpr int pb = 2 + l * PH_PER_LAYER; \
        const float* mod = WSP(float, WS_MOD) + (size_t)l * NBATCH * 6144; \
        if (EN(2) && IN(pb + 0)) { \
            pg8::Gemm g{WSP(bf16, WS_H), WSP(bf16, WS_WINT) + (size_t)l * N_INP * D, T, N_INP, D}; pg8::DenseOrder S; S.init(T, N_INP, F.G, (int)blockIdx.x); \
            pg8::EpiBf16Plain E{WSP(bf16, WS_P), N_INP}; \
            for (int rep = 0; rep < REP_WIN; ++rep) pg8::gemm_phase<pg8::EpiBf16Plain, pg8::DenseOrder, true>(ring, g, S, E); \
        } SEAM(pb + 0); \
        if (EN(3) && IN(pb + 1)) { for (int rep = 0; rep < REP_PREP; ++rep) phase_prep(p, F, l); } SEAM(pb + 1); \
        if (EN(4) && IN(pb + 2)) { \
            if (EN(13)) { pg8::Gemm g{WSP(bf16, WS_AN), WSP(bf16, WS_WUPT) + (size_t)l * N_UP * K_UP, T, N_UP, K_UP}; pg8::DenseOrder S; S.init(T, N_UP, F.G, (int)blockIdx.x); \
              pg8::EpiMlaUp E{WSP(bf16, WS_Q), WSP(bf16, WS_KK), WSP(bf16, WS_V), WSP(float, WS_CS)}; \
              pg8::gemm_phase<pg8::EpiMlaUp, pg8::DenseOrder, true>(ring, g, S, E); } \
            if (EN(14)) { pg8::Gemm g{WSP(bf16, WS_A2), WSP(bf16, WS_WSMT) + (size_t)l * N_SM * K_SM, T, N_SM, K_SM}; pg8::DenseOrder S; S.init(T, N_SM, F.G, (int)blockIdx.x); \
              pg8::EpiRwkvSmall E{WSP(float, WS_WAG), INP(I_W0) + (size_t)l * C5, INP(I_A0) + (size_t)l * C5}; \
              pg8::gemm_phase<pg8::EpiRwkvSmall, pg8::DenseOrder, true>(ring, g, S, E); } \
            if (EN(15) && l > 0) { pg8::Gemm g{WSP(bf16, WS_VS1), WSP(bf16, WS_WV12T), T, C5, C5}; pg8::DenseOrder S; S.init(T, C5, F.G, (int)blockIdx.x); \
              pg8::EpiVres E{WSP(bf16, WS_VS1), WSP(bf16, WS_VS0), WSP(bf16, WS_VR), INP(I_V0)}; \
              pg8::gemm_phase<pg8::EpiVres, pg8::DenseOrder, true>(ring, g, S, E); } \
        } SEAM(pb + 2); \
        if (EN(5) && IN(pb + 3)) { phase_rwkv_r1(p, F, l); } SEAM(pb + 3); \
        if (EN(6) && IN(pb + 4)) { phase_rwkv_r2(p, F); phase_attn(p, F, (char*)lds, l); } SEAM(pb + 4); \
        if (EN(7) && IN(pb + 5)) { for (int rep = 0; rep < REP_MIX; ++rep) phase_mix(p, F, l); } SEAM(pb + 5); \
        if (EN(8) && IN(pb + 6)) { \
            pg8::Gemm g{WSP(bf16, WS_MIX), WSP(bf16, WS_WOT) + (size_t)l * D * D, T, D, D}; pg8::DenseOrder S; S.init(T, D, F.G, (int)blockIdx.x); \
            pg8::EpiWo E{WSP(float, WS_X), mod + 2048}; \
            pg8::gemm_phase<pg8::EpiWo, pg8::DenseOrder, true>(ring, g, S, E); \
        } SEAM(pb + 6); \
        if (EN(9) && IN(pb + 7)) { phase_ln1_route(p, F, l); } SEAM(pb + 7); \
        if (EN(10) && IN(pb + 8)) { \
            moe_tables(F, l); \
            const LAS int* tb = (const LAS int*)(F.lds + TB_OFF); \
            pg8::Gemm g{WSP(bf16, WS_H), WSP(bf16, WS_W1T) + (size_t)l * NE * 2048 * D, T, 2048, D}; \
            pg8::MoeOrder<true> S{tb, tb + 40, WSP(int, WS_LIST), 8, F.G, F.vcu, (LAS unsigned*)(F.lds + GT_OFF)}; \
            pg8::EpiSwiglu E{WSP(bf16, WS_H1), WSP(float, WS_B1P) + (size_t)l * NE * 2048}; \
            for (int rep = 0; rep < REP_MOE1; ++rep) pg8::gemm_phase<pg8::EpiSwiglu, pg8::MoeOrder<true>, true>(ring, g, S, E); \
        } SEAM(pb + 8); \
        if (EN(11) && IN(pb + 9)) { \
            moe_tables(F, l); \
            const LAS int* tb = (const LAS int*)(F.lds + TB_OFF); \
            pg8::Gemm g{WSP(bf16, WS_H1), WSP(bf16, WS_W2T) + (size_t)l * NE * D * FF, MAXSLOT, D, FF}; \
            pg8::MoeOrder<false> S{tb, tb + 40, nullptr, 4, F.G, F.vcu, nullptr}; \
            pg8::EpiMoeOut E{WSP(bf16, WS_Y), INP(I_EB2) + (size_t)l * NE * D, WSP(float, WS_GATEL), tb}; \
            for (int rep = 0; rep < REP_MOE2; ++rep) pg8::gemm_phase<pg8::EpiMoeOut, pg8::MoeOrder<false>, true>(ring, g, S, E); \
        } SEAM(pb + 9); \
        if (EN(12) && IN(pb + 10)) { moe_tables(F, l); phase_combine(p, F, l); } SEAM(pb + 10);
    { constexpr int l = 0; LAYER_BODY }
    { constexpr int l = 1; LAYER_BODY }
#undef LAYER_BODY
#undef IN
#undef SEAM
}

extern "C" void kernel_launch(void* const* d_in, const int* in_sizes, int n_in, void* d_out, int out_size, void* d_ws, size_t ws_size, hipStream_t stream) {
    static int grid = 0;
    if (grid == 0) {
        if (n_in != N_INPUTS || out_size != T * D || ws_size < WS_END) { fprintf(stderr, "kernel_launch: unexpected problem: n_in %d out %d ws %zu\n", n_in, out_size, ws_size); grid = -1; return; }
        int dev = 0, cus = 0, per_cu = 0;
        if (hipGetDevice(&dev) != hipSuccess || hipDeviceGetAttribute(&cus, hipDeviceAttributeMultiprocessorCount, dev) != hipSuccess) { grid = -1; return; }
        if (hipFuncSetAttribute((const void*)fwd, hipFuncAttributeMaxDynamicSharedMemorySize, LDS_BYTES) != hipSuccess) { fprintf(stderr, "kernel_launch: hipFuncSetAttribute failed\n"); grid = -1; return; }
        if (hipOccupancyMaxActiveBlocksPerMultiprocessor(&per_cu, (const void*)fwd, NTHREADS, LDS_BYTES) != hipSuccess || per_cu < 1) fprintf(stderr, "kernel_launch: occupancy query reports %d\n", per_cu);
        (void)hipGetLastError();
        grid = cus;
    }
    if (grid < 0) return;
    if (hipMemsetAsync((char*)d_ws + WS_CTL, 0, CTL_ZERO_BYTES, stream) != hipSuccess) return;
    Params p{};
    for (int i = 0; i < N_INPUTS; ++i) p.in[i] = d_in[i];
    p.out = (float*)d_out; p.ws = (unsigned char*)d_ws;
#if MK_ONE_LAUNCH
    p.ph_lo = 0; p.ph_hi = N_PHASES;
    hipLaunchKernelGGL(fwd, dim3(grid), dim3(NTHREADS), LDS_BYTES, stream, p);
#else
    for (int ph = 0; ph < N_PHASES; ++ph) { p.ph_lo = ph; p.ph_hi = ph + 1; hipLaunchKernelGGL(fwd, dim3(grid), dim3(NTHREADS), LDS_BYTES, stream, p); }
#endif
}
```

```cpp
#include <hip/hip_runtime.h>
#include <cstdio>
#include <cstdint>

#define REP_PRO 1
#define REP_ATTN 1
#define REP_RWKV 1
#define REP_MOE1 1
#define REP_MOE2 1
#define REP_WIN 1
#define REP_PREP 1
#define REP_MIX 1
#ifndef MK_ONE_LAUNCH
#define MK_ONE_LAUNCH 1
#endif

#define GAS __attribute__((address_space(1)))
#define LAS __attribute__((address_space(3)))
typedef unsigned short bf16;
typedef short bf16x8 __attribute__((ext_vector_type(8)));
typedef short s16x4 __attribute__((ext_vector_type(4)));
typedef float f32x2 __attribute__((ext_vector_type(2)));
typedef float f32x4 __attribute__((ext_vector_type(4)));
typedef float f32x16 __attribute__((ext_vector_type(16)));
typedef unsigned u32x2 __attribute__((ext_vector_type(2)));
typedef unsigned u32x4 __attribute__((ext_vector_type(4)));

constexpr int D = 1024, NBATCH = 8, SEQ = 4096, T = NBATCH * SEQ, DEPTH = 2;
constexpr int MLA_IN = 416, RWKV_IN = 1792, N_IN = 2208, N_INP = 2304;
constexpr int QLR = 256, KVLR = 128, ROPE = 32, NOPE = 64, QKD = 96, VD = 64, NH = 8;
constexpr int C5 = 512;
constexpr int NE = 32, TOPK = 4, FF = 1024, CAP = 32768;
constexpr int N_UP = 1792, K_UP = 384, N_SM = 1536, K_SM = 256;
constexpr int MAXSLOT = 139264;
constexpr float DN_ALPHA = 1.4142135623730951f;
constexpr float C2Q = 0.14724444602590306f;
constexpr float LN_EPS = 1e-5f, RMS_EPS = 1e-6f, GN_EPS = 64e-5f;
constexpr int NWAVES = 8, NTHREADS = 512;

enum { I_X = 0, I_C, I_POS, I_ELNG, I_ELNB, I_ADAW, I_ADAB, I_WIN, I_QNG, I_WUQ, I_KVNG, I_WUK, I_WUV, I_MOUTG, I_MU, I_W0, I_W2, I_A0, I_A2, I_G2,
       I_KK, I_KA, I_RK, I_GNG, I_GNB, I_V0, I_V1, I_V2, I_WO, I_LN1G, I_LN1B, I_RW, I_RB, I_EW1, I_EB1, I_EW2, I_EB2, I_LN2G, I_LN2B, N_INPUTS };

constexpr size_t MiB = 1u << 20;
constexpr size_t WS_CTL = 0, CTL_ZERO_BYTES = 4 * MiB;
constexpr size_t WS_MOD = 4 * MiB, WS_B1P = 5 * MiB, WS_CS = 6 * MiB, WS_LIST = 10 * MiB, WS_GATEL = 14 * MiB, WS_TOKSLOT = 18 * MiB;
constexpr size_t WS_RWT = 19 * MiB;
constexpr size_t WS_WINT = 20 * MiB, WS_WUPT = 30 * MiB, WS_WSMT = 33 * MiB, WS_WV12T = 35 * MiB, WS_WOT = 36 * MiB, WS_W1T = 40 * MiB, WS_W2T = 296 * MiB;
constexpr size_t WS_X = 424 * MiB, WS_H = 552 * MiB, WS_VS0 = 616 * MiB, WS_VS1 = 648 * MiB;
constexpr size_t WS_P = 680 * MiB, WS_AN = 824 * MiB, WS_A2 = 848 * MiB, WS_RK = 864 * MiB, WS_Q = 928 * MiB, WS_KK = 976 * MiB, WS_V = 1024 * MiB, WS_O = 1056 * MiB;
constexpr size_t WS_WAG = 1088 * MiB, WS_RO = 1280 * MiB, WS_MIX = 1344 * MiB, WS_VR = 1408 * MiB;
constexpr size_t WS_H1 = 680 * MiB, WS_Y = 952 * MiB;
constexpr size_t WS_CH = 1440 * MiB;
constexpr size_t WS_END = 1696 * MiB;
constexpr int CW_TMO = 0, CW_CODE = 1, CW_BAR = 4096, CW_CNT = 8192, CW_ATTQ = 8448;

constexpr int RING_BYTES = 131072;
constexpr int LDSX_OFF = RING_BYTES;
constexpr int MISC_OFF = LDSX_OFF;
constexpr int TB_OFF = LDSX_OFF + 256;
constexpr int GT_OFF = LDSX_OFF + 1024;
constexpr int LDS_BYTES = 147456;

#define RLX_AGENT __ATOMIC_RELAXED, __HIP_MEMORY_SCOPE_AGENT
#define LDS_WAIT() asm volatile("s_waitcnt lgkmcnt(0)" ::: "memory")
#define VM_WAIT() asm volatile("s_waitcnt vmcnt(0)" ::: "memory")

__device__ __forceinline__ unsigned f2bf(float f) { unsigned u = __builtin_bit_cast(unsigned, f); return (u + 0x7fffu + ((u >> 16) & 1u)) >> 16; }
__device__ __forceinline__ unsigned pk2(float lo, float hi) { return f2bf(lo) | (f2bf(hi) << 16); }
__device__ __forceinline__ float bf2f(unsigned b) { return __builtin_bit_cast(float, b << 16); }
__device__ __forceinline__ float bflo(unsigned w) { return __builtin_bit_cast(float, w << 16); }
__device__ __forceinline__ float bfhi(unsigned w) { return __builtin_bit_cast(float, w & 0xffff0000u); }
__device__ __forceinline__ unsigned cvt_pk_bf16(float lo, float hi) { unsigned r; asm volatile("v_cvt_pk_bf16_f32 %0, %1, %2" : "=v"(r) : "v"(lo), "v"(hi)); return r; }
typedef __bf16 bf16x2_t __attribute__((ext_vector_type(2)));
__device__ __forceinline__ unsigned cvtpk_c(float lo, float hi) { f32x2 v = {lo, hi}; bf16x2_t b = __builtin_convertvector(v, bf16x2_t); return __builtin_bit_cast(unsigned, b); }
__device__ __forceinline__ float wave_sum(float v) {
#pragma unroll
    for (int o = 1; o < 64; o <<= 1) v += __shfl_xor(v, o);
    return v;
}
__device__ __forceinline__ float sigmoidf_(float x) { return __builtin_amdgcn_rcpf(1.0f + __expf(-x)); }
__device__ __forceinline__ float tanhf_(float x) { return 1.0f - 2.0f * __builtin_amdgcn_rcpf(1.0f + __expf(2.0f * x)); }

#define XB_TMO      128
#define XB_XCNT(j)  (256  + 64 * (j))
#define XB_XSUB(j)  (1280 + 64 * (j))
#define XB_XGEN(j)  (2304 + 64 * (j))
#define XB_TOP      3328
#define XB_TOPGEN   3392
#define XCD_BAR_WORDS 3456
#define XB_SPIN_CAP (1u << 18)
__device__ __forceinline__ unsigned xb_ld(unsigned* p)              { return __hip_atomic_load(p, __ATOMIC_RELAXED, __HIP_MEMORY_SCOPE_AGENT); }
__device__ __forceinline__ unsigned xb_add(unsigned* p, unsigned v) { return __hip_atomic_fetch_add(p, v, __ATOMIC_RELAXED, __HIP_MEMORY_SCOPE_AGENT); }
__device__ __forceinline__ unsigned xb_xcc_id() { return (unsigned)__builtin_amdgcn_s_getreg((3 << 11) | 20) & 0xFu; }
#define XB_SPIN(cond, bar) do { unsigned _sp = 0; while (cond) { __builtin_amdgcn_s_sleep(1); \
    if ((++_sp & 255u) == 0u) { if (xb_ld(&(bar)[XB_TMO])) break; if (_sp > XB_SPIN_CAP) { atomicAdd(&(bar)[XB_TMO], 1u); break; } } } } while (0)
struct XcdBarrier { unsigned* bar; unsigned x; volatile LAS unsigned* st; };
__device__ __forceinline__ XcdBarrier xcd_barrier_post(unsigned* bar, volatile LAS unsigned* st) {
    XcdBarrier b; b.bar = bar; b.x = xb_xcc_id(); b.st = st;
    if (threadIdx.x == 0) (void)xb_add(&bar[XB_XCNT(b.x)], 1u);
    return b;
}
__device__ __forceinline__ void xcd_barrier_complete(unsigned* bar, unsigned x, unsigned& nloc, unsigned& nx) {
    const unsigned G = gridDim.x * gridDim.y * gridDim.z;
    unsigned sum, cnt, mine, sp = 0u;
    for (;;) {
        sum = 0u; cnt = 0u; mine = 0u;
#pragma unroll
        for (unsigned j = 0; j < 16; ++j) { const unsigned c = xb_ld(&bar[XB_XCNT(j)]); sum += c; cnt += (c > 0u) ? 1u : 0u; mine = (j == x) ? c : mine; }
        if (sum == G) break;
        __builtin_amdgcn_s_sleep(1);
        if ((++sp & 255u) == 0u) { if (xb_ld(&bar[XB_TMO])) break; if (sp > XB_SPIN_CAP) { atomicAdd(&bar[XB_TMO], 1u); break; } }
    }
    nloc = mine > 0u ? mine : 1u; nx = cnt > 0u ? cnt : 1u;
}
__device__ __forceinline__ void xcd_barrier(const XcdBarrier& b) {
    asm volatile("s_waitcnt vmcnt(0)" ::: "memory");
    __syncthreads();
    if (threadIdx.x == 0) {
        unsigned* bar = b.bar;
        __builtin_amdgcn_s_waitcnt(0);
        unsigned nloc = b.st[0], nx = b.st[1];
        if (nloc == 0u) { xcd_barrier_complete(bar, b.x, nloc, nx); b.st[0] = nloc; b.st[1] = nx; }
        const unsigned old = xb_add(&bar[XB_XSUB(b.x)], 1u);
        const unsigned gen = old / nloc;
        if (old + 1u == (gen + 1u) * nloc) {
            __builtin_amdgcn_fence(__ATOMIC_RELEASE, "agent");
            asm volatile("s_waitcnt vmcnt(0)" ::: "memory");
            const unsigned og = xb_add(&bar[XB_TOP], 1u);
            const unsigned tg = og / nx;
            if (og + 1u == (tg + 1u) * nx) xb_add(&bar[XB_TOPGEN], 1u);
            else XB_SPIN(xb_ld(&bar[XB_TOPGEN]) == tg, bar);
            __builtin_amdgcn_fence(__ATOMIC_ACQUIRE, "agent");
            xb_add(&bar[XB_XGEN(b.x)], 1u);
            asm volatile("s_waitcnt vmcnt(0)" ::: "memory");
        } else {
            XB_SPIN(xb_ld(&bar[XB_XGEN(b.x)]) == gen, bar);
            __builtin_amdgcn_fence(__ATOMIC_ACQUIRE, "agent");
            asm volatile("s_waitcnt vmcnt(0)" ::: "memory");
        }
    }
    __syncthreads();
}

namespace pg8 {
constexpr int BM = 256, BK = 64, HALF = 128, HTB = HALF * BK * 2, STAGE_BYTES = 8 * HTB, NXCD = 8, WGM = 8;
__device__ __forceinline__ int lds_byte(int r, int c) { const int st = (r >> 4) * 2 + (c >> 5), rr = r & 15, cc = c & 31, ob = rr * 64 + cc * 2; return st * 1024 + (ob ^ (((ob >> 9) & 1) << 5)); }
__device__ __forceinline__ void stage_rc(int b, int& R, int& C) { const int st = b / 1024, sb = b % 1024, swz = sb ^ (((sb >> 9) & 1) << 5); R = (st >> 1) * 16 + swz / 64; C = (st & 1) * 32 + (swz % 64) / 2; }
__device__ __forceinline__ int perm32(int rho) { const int n = rho >> 4, i = rho & 15; return 8 * (i >> 2) + 4 * n + (i & 3); }

struct Unit { int pm, pn, e; };
struct Gemm { const bf16* A; const bf16* Bt; int M, N, K; };

struct DenseOrder {
    int nM, nN, nwg, G, c;
    __device__ __forceinline__ void init(int M, int N, int G_, int c_) { nM = M / BM; nN = N / BM; nwg = nM * nN; G = G_; c = c_; }
    __device__ __forceinline__ bool next(int i, Unit& u) const {
        const long L = (long)i * G + c; if (L >= nwg) return false;
        int wgid = (int)L; { const int q = nwg / NXCD, r = nwg % NXCD, xcd = wgid % NXCD, off = wgid / NXCD; wgid = (xcd < r ? xcd * (q + 1) : r * (q + 1) + (xcd - r) * q) + off; }
        const int nig = WGM * nN, gid = wgid / nig, fm = gid * WGM, gsz = (nM - fm) < WGM ? (nM - fm) : WGM;
        u.pm = fm + ((wgid % nig) % gsz); u.pn = (wgid % nig) / gsz; u.e = 0; return true;
    }
    static constexpr bool GATHER = false;
    __device__ __forceinline__ size_t b_off(const Unit& u, int N, int K) const { return (size_t)u.pn * BM * K * 2; }
    __device__ __forceinline__ unsigned a_row_off(const Unit& u, int row, int K) const { return 0u; }
    __device__ __forceinline__ LAS unsigned* gtab() const { return nullptr; }
};
template <bool GATHER_> struct MoeOrder {
    static constexpr bool GATHER = GATHER_;
    const LAS int* tb; const LAS int* cnt; const int* list; int nN, G, c; LAS unsigned* gt_;
    __device__ __forceinline__ LAS unsigned* gtab() const { return gt_; }
    __device__ __forceinline__ bool next(int i, Unit& u) const {
        const int L = i * G + c; const int total = tb[NE] * nN; if (L >= total) return false;
        int e = 0;
#pragma unroll 1
        for (int j = 1; j < NE; ++j) if (tb[j] * nN <= L) e = j;
        const int Lr = L - tb[e] * nN, nte = tb[e + 1] - tb[e];
        const int mblk = Lr / (4 * nN), m0 = mblk * 4, gsz = (nte - m0) < 4 ? (nte - m0) : 4, rem = Lr - mblk * 4 * nN;
        u.e = e; u.pn = rem / gsz; u.pm = tb[e] + m0 + (rem % gsz); return true;
    }
    __device__ __forceinline__ size_t b_off(const Unit& u, int N, int K) const { return ((size_t)u.e * N + (size_t)u.pn * BM) * K * 2; }
    __device__ __forceinline__ unsigned a_row_off(const Unit& u, int row, int K) const {
        const int pos = (u.pm - tb[u.e]) * BM + row; const int tok = pos < cnt[u.e] ? list[u.e * CAP + pos] : 0; return (unsigned)tok * (unsigned)(K * 2);
    }
};

template <class Epi, class Sched, bool ALIGN_EPI>
__device__ __forceinline__ void gemm_phase(LAS unsigned char* lds, const Gemm g, const Sched& S, const Epi& E) {
    const int tid = threadIdx.x, wid = __builtin_amdgcn_readfirstlane(tid >> 6), lane = tid & 63, wr = wid >> 2, wc = wid & 3, fr = lane & 15, fq = lane >> 4;
    const int K = g.K, nt = K / BK;
    int RA[2]; unsigned CA[2], voffA[2], voffB[2];
#pragma unroll
    for (int i = 0; i < 2; ++i) { int R, C; stage_rc(tid * 16 + i * 8192, R, C); const int Rb = Epi::PERM ? ((R & ~31) + perm32(R & 31)) : R;
        RA[i] = R; CA[i] = (unsigned)C * 2u; voffA[i] = (unsigned)(R * K + C) * 2u; voffB[i] = (unsigned)(Rb * K + C) * 2u; }
    const size_t kstep = (size_t)(BK * 2);
    const size_t hstep = (size_t)HALF * K * 2;
    const size_t tstep = 2 * hstep;
    const unsigned ldsw = (unsigned)wid * 1024u;
    const int aoff = lds_byte(wr * 64 + fr, fq * 8), boff = lds_byte(wc * 32 + fr, fq * 8);
    const char* Abase = (const char*)g.A;
    LAS unsigned* gtb = S.gtab();
#define PG8_SA(b, h) (((b) * 2 + (h)) * HTB)
#define PG8_SB(b, h) ((4 + (b) * 2 + (h)) * HTB)
#define PG8_STAGE(bufoff, gbase, voff) do { _Pragma("unroll") for (int _i = 0; _i < 2; ++_i) \
        __builtin_amdgcn_global_load_lds((const unsigned*)((const char*)(gbase) + (voff)[_i]), (LAS unsigned*)(lds + (bufoff) + ldsw + _i * 8192), 16, 0, 0); } while (0)
#define PG8_STAGEA(bufoff, h, kb, nx) do { \
        if constexpr (Sched::GATHER) { const LAS unsigned* tp_ = gtb + ((nx) ? tnx : tcu) + (h) * HALF; const unsigned o0_ = tp_[RA[0]] + CA[0], o1_ = tp_[RA[1]] + CA[1]; \
            __builtin_amdgcn_global_load_lds((const unsigned*)(Abase + (size_t)(kb) + o0_), (LAS unsigned*)(lds + (bufoff) + ldsw), 16, 0, 0); \
            __builtin_amdgcn_global_load_lds((const unsigned*)(Abase + (size_t)(kb) + o1_), (LAS unsigned*)(lds + (bufoff) + ldsw + 8192), 16, 0, 0); } \
        else { const char* gb_ = ((nx) ? nA : cA) + (size_t)(h) * hstep + (size_t)(kb); PG8_STAGE(bufoff, gb_, voffA); } } while (0)
#define PG8_LDA(dst, b, h) do { _Pragma("unroll") for (int m = 0; m < 4; ++m) _Pragma("unroll") for (int k = 0; k < 2; ++k) dst[m][k] = *(const LAS bf16x8*)(lds + PG8_SA(b, h) + aoff + m * 2048 + k * 1024); } while (0)
#define PG8_LDB(dst, b, h) do { _Pragma("unroll") for (int n = 0; n < 2; ++n) _Pragma("unroll") for (int k = 0; k < 2; ++k) dst[n][k] = *(const LAS bf16x8*)(lds + PG8_SB(b, h) + boff + n * 2048 + k * 1024); } while (0)
#define PG8_MMA(ai, bj, At, Bt) do { __builtin_amdgcn_s_setprio(1); _Pragma("unroll") for (int m = 0; m < 4; ++m) _Pragma("unroll") for (int n = 0; n < 2; ++n) _Pragma("unroll") for (int k = 0; k < 2; ++k) \
        acc[ai][bj][m][n] = __builtin_amdgcn_mfma_f32_16x16x32_bf16(Bt[n][k], At[m][k], acc[ai][bj][m][n], 0, 0, 0); __builtin_amdgcn_s_setprio(0); } while (0)
#define PG8_WAIT_V(n) asm volatile("s_waitcnt vmcnt(" #n ")" ::: "memory")
#define PG8_WAIT_L(n) asm volatile("s_waitcnt lgkmcnt(" #n ")" ::: "memory")
#define PG8_BAR __builtin_amdgcn_s_barrier()
#define PG8_SCHED __builtin_amdgcn_sched_barrier(0)
    Unit cur, nxt; int ui = 0;
    if (!S.next(0, cur)) return;
    f32x4 acc[2][2][4][2];
#pragma unroll
    for (int a = 0; a < 2; ++a)
#pragma unroll
        for (int b = 0; b < 2; ++b)
#pragma unroll
            for (int m = 0; m < 4; ++m)
#pragma unroll
                for (int n = 0; n < 2; ++n) acc[a][b][m][n] = (f32x4){0.f, 0.f, 0.f, 0.f};
    bf16x8 At[4][2], B0[2][2], B1[2][2];
    const char* cA = Abase + (size_t)cur.pm * tstep; const char* cB = (const char*)g.Bt + S.b_off(cur, g.N, K);
    const char* nA = cA; const char* nB = cB;
    int tcu = 0, tnx = 0;
    if constexpr (Sched::GATHER) {
        if (tid < BM) gtb[tid] = S.a_row_off(cur, tid, K);
        asm volatile("s_waitcnt vmcnt(0) lgkmcnt(0)" ::: "memory"); PG8_BAR; asm volatile("" ::: "memory");
    }
    PG8_STAGE(PG8_SB(0, 0), cB, voffB); PG8_STAGE(PG8_SB(0, 1), cB + hstep, voffB); PG8_STAGEA(PG8_SA(0, 0), 0, 0, false); PG8_STAGEA(PG8_SA(0, 1), 1, 0, false);
    if (wr == 1) PG8_BAR;
    PG8_WAIT_V(2); PG8_BAR;
    PG8_STAGE(PG8_SB(1, 0), cB + kstep, voffB); PG8_STAGEA(PG8_SA(1, 0), 0, kstep, false); PG8_STAGE(PG8_SB(1, 1), cB + hstep + kstep, voffB);
    PG8_WAIT_V(6); PG8_BAR;
    for (;;) {
        const bool has_next = S.next(ui + 1, nxt);
        nA = cA; nB = cB; tnx = tcu;
        if (has_next) { nA = Abase + (size_t)nxt.pm * tstep; nB = (const char*)g.Bt + S.b_off(nxt, g.N, K);
            if constexpr (Sched::GATHER) { tnx = tcu ^ BM; if (tid < BM) gtb[tnx + tid] = S.a_row_off(nxt, tid, K); } }
#pragma unroll 1
        for (int t = 0; t < nt; t += 2) {
            const bool last = (t == nt - 2);
            const size_t k1 = (size_t)(t + 1) * kstep;
            const size_t k2 = last ? 0 : (size_t)(t + 2) * kstep, k3 = k2 + kstep;
            const char* b2 = last ? nB : cB + (size_t)(t + 2) * kstep; const char* b3 = b2 + kstep;
            PG8_LDB(B0, 0, 0); PG8_LDB(B1, 0, 1); PG8_SCHED; PG8_LDA(At, 0, 0); PG8_STAGEA(PG8_SA(1, 1), 1, k1, false);
            PG8_WAIT_V(8); PG8_WAIT_L(0); PG8_BAR; PG8_MMA(0, 0, At, B0); PG8_MMA(0, 1, At, B1); PG8_BAR; PG8_SCHED;
            PG8_LDA(At, 0, 1); PG8_STAGE(PG8_SB(0, 0), b2, voffB); PG8_STAGE(PG8_SB(0, 1), b2 + hstep, voffB); PG8_STAGEA(PG8_SA(0, 0), 0, k2, last);
            PG8_WAIT_V(8); PG8_WAIT_L(0); PG8_BAR; PG8_MMA(1, 0, At, B0); PG8_MMA(1, 1, At, B1); PG8_BAR; PG8_SCHED;
            PG8_LDB(B0, 1, 0); PG8_LDB(B1, 1, 1); PG8_SCHED; PG8_LDA(At, 1, 0); PG8_STAGEA(PG8_SA(0, 1), 1, k2, last);
            PG8_WAIT_V(8); PG8_WAIT_L(0); PG8_BAR; PG8_MMA(0, 0, At, B0); PG8_MMA(0, 1, At, B1); PG8_BAR; PG8_SCHED;
            PG8_LDA(At, 1, 1); PG8_STAGE(PG8_SB(1, 0), b3, voffB); PG8_STAGE(PG8_SB(1, 1), b3 + hstep, voffB); PG8_STAGEA(PG8_SA(1, 0), 0, k3, last);
            PG8_WAIT_V(8); PG8_WAIT_L(0); PG8_BAR; PG8_MMA(1, 0, At, B0); PG8_MMA(1, 1, At, B1); PG8_BAR; PG8_SCHED;
        }
        if constexpr (ALIGN_EPI) { if (wr == 0) PG8_BAR; }
        E(acc, cur, wr, wc, fr, fq);
        if (!has_next) break;
#pragma unroll
        for (int a = 0; a < 2; ++a)
#pragma unroll
            for (int b = 0; b < 2; ++b)
#pragma unroll
                for (int m = 0; m < 4; ++m)
#pragma unroll
                    for (int n = 0; n < 2; ++n) acc[a][b][m][n] = (f32x4){0.f, 0.f, 0.f, 0.f};
        cur = nxt; cA = nA; cB = nB; tcu = tnx; ++ui;
        if constexpr (ALIGN_EPI) { if (wr == 1) PG8_BAR; }
    }
    PG8_WAIT_V(0);
    if constexpr (!ALIGN_EPI) { if (wr == 0) PG8_BAR; }
    PG8_BAR;
#undef PG8_SA
#undef PG8_SB
#undef PG8_STAGE
#undef PG8_STAGEA
#undef PG8_LDA
#undef PG8_LDB
#undef PG8_MMA
#undef PG8_WAIT_V
#undef PG8_WAIT_L
#undef PG8_BAR
#undef PG8_SCHED
}

struct EpiBf16Plain {
    static constexpr bool PERM = true;
    bf16* O; int ldc;
    __device__ __forceinline__ void operator()(const f32x4 (&acc)[2][2][4][2], const Unit& u, int wr, int wc, int fr, int fq) const {
        const int row0 = u.pm * BM + wr * 64 + fr, col0 = u.pn * BM + wc * 32 + 8 * fq;
#pragma unroll
        for (int ai = 0; ai < 2; ++ai)
#pragma unroll
            for (int m = 0; m < 4; ++m) { bf16* rowp = O + (size_t)(row0 + ai * HALF + m * 16) * ldc + col0;
#pragma unroll
                for (int bj = 0; bj < 2; ++bj) { const f32x4 v0 = acc[ai][bj][m][0], v1 = acc[ai][bj][m][1];
                    u32x4 w; w.x = cvt_pk_bf16(v0[0], v0[1]); w.y = cvt_pk_bf16(v0[2], v0[3]); w.z = cvt_pk_bf16(v1[0], v1[1]); w.w = cvt_pk_bf16(v1[2], v1[3]);
                    *(u32x4*)(rowp + bj * HALF) = w; } }
    }
};
struct EpiMlaUp {
    static constexpr bool PERM = true;
    bf16* Q; bf16* KK; bf16* V; const float* cs;
    __device__ __forceinline__ void operator()(const f32x4 (&acc)[2][2][4][2], const Unit& u, int wr, int wc, int fr, int fq) const {
        const int row0 = u.pm * BM + wr * 64 + fr;
#pragma unroll
        for (int bj = 0; bj < 2; ++bj) {
            const int c0 = u.pn * BM + bj * HALF + wc * 32 + 8 * fq;
            if (u.pn < 3) {
                const int h = c0 / QKD, d = c0 - h * QKD;
                const bool rope = d >= NOPE; const int i0 = rope ? (d - NOPE) >> 1 : 0;
#pragma unroll
                for (int ai = 0; ai < 2; ++ai)
#pragma unroll
                    for (int m = 0; m < 4; ++m) { const int row = row0 + ai * HALF + m * 16;
                        f32x4 v0 = acc[ai][bj][m][0], v1 = acc[ai][bj][m][1];
                        if (rope) { const f32x4 cA = *(const f32x4*)(cs + (size_t)row * 32 + i0 * 2), cB = *(const f32x4*)(cs + (size_t)row * 32 + i0 * 2 + 4);
                            const f32x4 a = v0, b = v1;
                            v0[0] = a[0] * cA[0] - a[1] * cA[1]; v0[1] = a[0] * cA[1] + a[1] * cA[0]; v0[2] = a[2] * cA[2] - a[3] * cA[3]; v0[3] = a[2] * cA[3] + a[3] * cA[2];
                            v1[0] = b[0] * cB[0] - b[1] * cB[1]; v1[1] = b[0] * cB[1] + b[1] * cB[0]; v1[2] = b[2] * cB[2] - b[3] * cB[3]; v1[3] = b[2] * cB[3] + b[3] * cB[2]; }
                        v0 = v0 * C2Q; v1 = v1 * C2Q;
                        u32x4 w; w.x = cvt_pk_bf16(v0[0], v0[1]); w.y = cvt_pk_bf16(v0[2], v0[3]); w.z = cvt_pk_bf16(v1[0], v1[1]); w.w = cvt_pk_bf16(v1[2], v1[3]);
                        *(u32x4*)(Q + (size_t)row * 768 + c0) = w; asm volatile("" ::: "memory"); }
            } else {
                bf16* base; int ld, cc;
                if (u.pn < 5) { const int c1 = c0 - 768; const int h = c1 >> 6, d = c1 & 63; base = KK; ld = 768; cc = h * QKD + d; }
                else { base = V; ld = 512; cc = c0 - 1280; }
#pragma unroll
                for (int ai = 0; ai < 2; ++ai)
#pragma unroll
                    for (int m = 0; m < 4; ++m) { const int row = row0 + ai * HALF + m * 16; const f32x4 v0 = acc[ai][bj][m][0], v1 = acc[ai][bj][m][1];
                        u32x4 w; w.x = cvt_pk_bf16(v0[0], v0[1]); w.y = cvt_pk_bf16(v0[2], v0[3]); w.z = cvt_pk_bf16(v1[0], v1[1]); w.w = cvt_pk_bf16(v1[2], v1[3]);
                        *(u32x4*)(base + (size_t)row * ld + cc) = w; asm volatile("" ::: "memory"); }
            }
        }
    }
};
struct EpiRwkvSmall {
    static constexpr bool PERM = false;
    float* O; const float* w0; const float* a0;
    __device__ __forceinline__ void operator()(const f32x4 (&acc)[2][2][4][2], const Unit& u, int wr, int wc, int fr, int fq) const {
        const int row0 = u.pm * BM + wr * 64 + fr, col0 = u.pn * BM + wc * 32 + 4 * fq;
        const int kind = u.pn >> 1;
#pragma unroll
        for (int bj = 0; bj < 2; ++bj)
#pragma unroll
            for (int n = 0; n < 2; ++n) { const int c = col0 + bj * HALF + n * 16;
                f32x4 bv = (f32x4){0.f, 0.f, 0.f, 0.f};
                if (kind == 0) bv = *(const f32x4*)(w0 + c); else if (kind == 1) bv = *(const f32x4*)(a0 + (c - 512));
#pragma unroll
                for (int ai = 0; ai < 2; ++ai)
#pragma unroll
                    for (int m = 0; m < 4; ++m) { f32x4 v = acc[ai][bj][m][n] + bv;
                        if (kind == 0) {
#pragma unroll
                            for (int j = 0; j < 4; ++j) { const float z = -v[j]; const float sp = fmaxf(z, 0.f) + __logf(1.0f + __expf(-fabsf(z))); const float w = -sp - 0.5f; v[j] = -__expf(w); }
                        } else if (kind == 1) {
#pragma unroll
                            for (int j = 0; j < 4; ++j) v[j] = sigmoidf_(v[j]);
                        }
                        *(f32x4*)(O + (size_t)(row0 + ai * HALF + m * 16) * N_SM + c) = v; asm volatile("" ::: "memory"); } }
    }
};
struct EpiVres {
    static constexpr bool PERM = true;
    const bf16* vs; const bf16* vf; bf16* vr; const float* v0;
    __device__ __forceinline__ void operator()(const f32x4 (&acc)[2][2][4][2], const Unit& u, int wr, int wc, int fr, int fq) const {
        const int row0 = u.pm * BM + wr * 64 + fr, col0 = u.pn * BM + wc * 32 + 8 * fq;
#pragma unroll
        for (int bj = 0; bj < 2; ++bj) { const int c = col0 + bj * HALF;
            const f32x4 b0 = *(const f32x4*)(v0 + c), b1 = *(const f32x4*)(v0 + c + 4);
#pragma unroll
            for (int ai = 0; ai < 2; ++ai)
#pragma unroll
                for (int m = 0; m < 4; ++m) { const size_t off = (size_t)(row0 + ai * HALF + m * 16) * C5 + c;
                    const u32x4 s = *(const u32x4*)(vs + off), f = *(const u32x4*)(vf + off);
                    const f32x4 g0 = acc[ai][bj][m][0] + b0, g1 = acc[ai][bj][m][1] + b1;
                    float o[8];
#pragma unroll
                    for (int j = 0; j < 4; ++j) { const float sl = bflo(s[j]), sh = bfhi(s[j]), fl = bflo(f[j]), fh = bfhi(f[j]);
                        const float ga = (j < 2) ? g0[2 * j] : g1[2 * j - 4], gb = (j < 2) ? g0[2 * j + 1] : g1[2 * j - 3];
                        o[2 * j] = sl + (fl - sl) * sigmoidf_(ga); o[2 * j + 1] = sh + (fh - sh) * sigmoidf_(gb); }
                    u32x4 w; w.x = cvt_pk_bf16(o[0], o[1]); w.y = cvt_pk_bf16(o[2], o[3]); w.z = cvt_pk_bf16(o[4], o[5]); w.w = cvt_pk_bf16(o[6], o[7]);
                    *(u32x4*)(vr + off) = w; } }
    }
};
struct EpiWo {
    static constexpr bool PERM = false;
    float* X; const float* gt;
    __device__ __forceinline__ void operator()(const f32x4 (&acc)[2][2][4][2], const Unit& u, int wr, int wc, int fr, int fq) const {
        const int row0 = u.pm * BM + wr * 64 + fr, col0 = u.pn * BM + wc * 32 + 4 * fq;
        const int b = (u.pm * BM) / SEQ;
#pragma unroll
        for (int bj = 0; bj < 2; ++bj)
#pragma unroll
            for (int n = 0; n < 2; ++n) { const int c = col0 + bj * HALF + n * 16; const f32x4 g = *(const f32x4*)(gt + (size_t)b * 6144 + c) + 1.0f;
#pragma unroll
                for (int ai = 0; ai < 2; ++ai)
#pragma unroll
                    for (int m = 0; m < 4; ++m) { float* p = X + (size_t)(row0 + ai * HALF + m * 16) * D + c; const f32x4 x = *(const f32x4*)p; *(f32x4*)p = x * DN_ALPHA + g * acc[ai][bj][m][n]; } }
    }
};
struct EpiSwiglu {
    static constexpr bool PERM = true;
    bf16* O; const float* b1p;
    __device__ __forceinline__ void operator()(const f32x4 (&acc)[2][2][4][2], const Unit& u, int wr, int wc, int fr, int fq) const {
        const int row0 = u.pm * BM + wr * 64 + fr; const int cin = u.pn * BM + wc * 32 + 8 * fq, cout = u.pn * HALF + wc * 32 + 8 * fq;
        const float* bp = b1p + (size_t)u.e * 2048 + cin;
        const f32x4 bg0 = *(const f32x4*)(bp), bg1 = *(const f32x4*)(bp + 4), bl0 = *(const f32x4*)(bp + HALF), bl1 = *(const f32x4*)(bp + HALF + 4);
#pragma unroll
        for (int ai = 0; ai < 2; ++ai)
#pragma unroll
            for (int m = 0; m < 4; ++m) {
                const f32x4 g0 = acc[ai][0][m][0] + bg0, g1 = acc[ai][0][m][1] + bg1, l0 = acc[ai][1][m][0] + bl0, l1 = acc[ai][1][m][1] + bl1;
                float o[8];
#pragma unroll
                for (int j = 0; j < 8; ++j) { const float gv = fminf(j < 4 ? g0[j & 3] : g1[j & 3], 7.0f); const float lv = fminf(fmaxf(j < 4 ? l0[j & 3] : l1[j & 3], -7.0f), 7.0f);
                    o[j] = gv * sigmoidf_(1.702f * gv) * (lv + 1.0f); }
                u32x4 w; w.x = cvt_pk_bf16(o[0], o[1]); w.y = cvt_pk_bf16(o[2], o[3]); w.z = cvt_pk_bf16(o[4], o[5]); w.w = cvt_pk_bf16(o[6], o[7]);
                *(u32x4*)(O + (size_t)(row0 + ai * HALF + m * 16) * FF + cout) = w; }
    }
};
struct EpiMoeOut {
    static constexpr bool PERM = true;
    bf16* O; const float* b2; const float* gatel; const LAS int* tb;
    __device__ __forceinline__ void operator()(const f32x4 (&acc)[2][2][4][2], const Unit& u, int wr, int wc, int fr, int fq) const {
        const int row0 = u.pm * BM + wr * 64 + fr, col0 = u.pn * BM + wc * 32 + 8 * fq;
        const int pos0 = (u.pm - tb[u.e]) * BM + wr * 64 + fr;
        const float* bp = b2 + (size_t)u.e * D + col0;
        f32x4 bv[2][2];
#pragma unroll
        for (int bj = 0; bj < 2; ++bj) { bv[bj][0] = *(const f32x4*)(bp + bj * HALF); bv[bj][1] = *(const f32x4*)(bp + bj * HALF + 4); }
#pragma unroll
        for (int ai = 0; ai < 2; ++ai)
#pragma unroll
            for (int m = 0; m < 4; ++m) { const float gt = gatel[(size_t)u.e * CAP + pos0 + ai * HALF + m * 16];
                bf16* rowp = O + (size_t)(row0 + ai * HALF + m * 16) * D + col0;
#pragma unroll
                for (int bj = 0; bj < 2; ++bj) { const f32x4 v0 = (acc[ai][bj][m][0] + bv[bj][0]) * gt, v1 = (acc[ai][bj][m][1] + bv[bj][1]) * gt;
                    u32x4 w; w.x = cvt_pk_bf16(v0[0], v0[1]); w.y = cvt_pk_bf16(v0[2], v0[3]); w.z = cvt_pk_bf16(v1[0], v1[1]); w.w = cvt_pk_bf16(v1[2], v1[3]);
                    *(u32x4*)(rowp + bj * HALF) = w; } }
    }
};
}

struct Params { const void* in[N_INPUTS]; float* out; unsigned char* ws; int ph_lo, ph_hi; };

struct Frame {
    LAS unsigned char* lds;
    int tid, lane, wave, G, vcu;
    unsigned char* ws;
};
#define WSP(type, off) ((type*)(F.ws + (off)))
#define INP(i) ((const float*)p.in[i])

__device__ const double INV_FREQ[16] = {1.00000000000000000e+00, 5.62341325190349073e-01, 3.16227766016837941e-01, 1.77827941003892293e-01, 1.00000000000000006e-01, 5.62341325190349114e-02,
    3.16227766016837913e-02, 1.77827941003892293e-02, 1.00000000000000002e-02, 5.62341325190349097e-03, 3.16227766016837939e-03, 1.77827941003892275e-03, 1.00000000000000002e-03,
    5.62341325190349097e-04, 3.16227766016837939e-04, 1.77827941003892270e-04};

template <int MODE>
__device__ __forceinline__ void tr_item(const float* W, int ldn, bf16* WT, int ldk, int kofs, int rofs, int k0, int n0, LAS float* scr, int lane) {
    f32x4 ld[8];
#pragma unroll
    for (int i = 0; i < 8; ++i) ld[i] = *(const f32x4*)(W + (size_t)(k0 + 8 * i + (lane >> 3)) * ldn + n0 + 4 * (lane & 7));
#pragma unroll
    for (int i = 0; i < 8; ++i) { LAS float* d = scr + (8 * i + (lane >> 3)) * 33 + 4 * (lane & 7); d[0] = ld[i].x; d[1] = ld[i].y; d[2] = ld[i].z; d[3] = ld[i].w; }
    LDS_WAIT(); asm volatile("" ::: "memory");
    const int c = lane & 7;
#pragma unroll
    for (int j = 0; j < 4; ++j) { const int n = (lane >> 3) + 8 * j; const LAS float* s = scr + (8 * c) * 33 + n;
        u32x4 o; o.x = pk2(s[0 * 33], s[1 * 33]); o.y = pk2(s[2 * 33], s[3 * 33]); o.z = pk2(s[4 * 33], s[5 * 33]); o.w = pk2(s[6 * 33], s[7 * 33]);
        const int ng = n0 + n; int row;
        if (MODE == 0) row = rofs + ng; else { const int jo = ng >> 1, bj = ng & 1; row = rofs + (jo >> 7) * 256 + bj * 128 + (jo & 127); }
        *(GAS u32x4*)(WT + (size_t)row * ldk + kofs + k0 + 8 * c) = o; }
    LDS_WAIT(); asm volatile("" ::: "memory");
}
__device__ __forceinline__ void zero_rect(const Frame& F, bf16* M, int ld, int r0, int nrows, int c0, int ncols) {
    const int gw = F.vcu * NWAVES + F.wave, NGW = F.G * NWAVES; const int nch = ncols / 8;
    for (int r = gw; r < nrows; r += NGW)
        for (int ch = F.lane; ch < nch; ch += 64) *(GAS u32x4*)(M + (size_t)(r0 + r) * ld + c0 + ch * 8) = (u32x4){0u, 0u, 0u, 0u};
}
__device__ __forceinline__ void phase_prologue(const Params& p, const Frame& F) {
    LAS float* scr = (LAS float*)(F.lds + F.wave * 16384);
    const int gw = F.vcu * NWAVES + F.wave, NGW = F.G * NWAVES;
    constexpr int I_IN = 16 * 69, I_UQ = 4 * 24, I_UK = 2 * 16, I_W2s = 16, I_G2s = 2 * 16, I_WO_ = 16 * 32, I_E1 = 16 * 64, I_E2 = 16 * 32;
    constexpr int PER_L = I_IN + I_UQ + 2 * I_UK + 2 * I_W2s + I_G2s + I_WO_;
    constexpr int NSMALL = DEPTH * PER_L, NE1 = DEPTH * NE * I_E1, NE2 = DEPTH * NE * I_E2;
    for (int it = gw; it < NSMALL + NE1 + NE2; it += NGW) {
        int r = it;
        if (r < NSMALL) {
            const int l = r / PER_L; r -= l * PER_L;
            if (r < I_IN) { tr_item<0>(INP(I_WIN) + (size_t)l * D * N_IN, N_IN, WSP(bf16, WS_WINT) + (size_t)l * N_INP * D, D, 0, 0, 64 * (r / 69), 32 * (r % 69), scr, F.lane); continue; } r -= I_IN;
            bf16* up = WSP(bf16, WS_WUPT) + (size_t)l * N_UP * K_UP;
            if (r < I_UQ) { tr_item<0>(INP(I_WUQ) + (size_t)l * QLR * 768, 768, up, K_UP, 0, 0, 64 * (r / 24), 32 * (r % 24), scr, F.lane); continue; } r -= I_UQ;
            if (r < I_UK) { tr_item<0>(INP(I_WUK) + (size_t)l * KVLR * 512, 512, up, K_UP, 256, 768, 64 * (r / 16), 32 * (r % 16), scr, F.lane); continue; } r -= I_UK;
            if (r < I_UK) { tr_item<0>(INP(I_WUV) + (size_t)l * KVLR * 512, 512, up, K_UP, 256, 1280, 64 * (r / 16), 32 * (r % 16), scr, F.lane); continue; } r -= I_UK;
            bf16* sm = WSP(bf16, WS_WSMT) + (size_t)l * N_SM * K_SM;
            if (r < I_W2s) { tr_item<0>(INP(I_W2) + (size_t)l * 64 * 512, 512, sm, K_SM, 0, 0, 0, 32 * r, scr, F.lane); continue; } r -= I_W2s;
            if (r < I_W2s) { tr_item<0>(INP(I_A2) + (size_t)l * 64 * 512, 512, sm, K_SM, 64, 512, 0, 32 * r, scr, F.lane); continue; } r -= I_W2s;
            if (r < I_G2s) { tr_item<0>(INP(I_G2) + (size_t)l * 128 * 512, 512, sm, K_SM, 128, 1024, 64 * (r / 16), 32 * (r % 16), scr, F.lane); continue; } r -= I_G2s;
            tr_item<0>(INP(I_WO) + (size_t)l * D * D, D, WSP(bf16, WS_WOT) + (size_t)l * D * D, D, 0, 0, 64 * (r / 32), 32 * (r % 32), scr, F.lane); continue;
        }
        r -= NSMALL;
        if (r < NE1) { const int le = r / I_E1; r -= le * I_E1;
            tr_item<1>(INP(I_EW1) + (size_t)le * D * 2048, 2048, WSP(bf16, WS_W1T) + (size_t)le * 2048 * D, D, 0, 0, 64 * (r / 64), 32 * (r % 64), scr, F.lane); continue; }
        r -= NE1;
        { const int le = r / I_E2; r -= le * I_E2;
            tr_item<0>(INP(I_EW2) + (size_t)le * FF * D, D, WSP(bf16, WS_W2T) + (size_t)le * D * FF, FF, 0, 0, 64 * (r / 32), 32 * (r % 32), scr, F.lane); }
    }
    for (int l = 0; l < DEPTH; ++l) {
        zero_rect(F, WSP(bf16, WS_WINT) + (size_t)l * N_INP * D, D, N_IN, N_INP - N_IN, 0, D);
        bf16* up = WSP(bf16, WS_WUPT) + (size_t)l * N_UP * K_UP;
        zero_rect(F, up, K_UP, 0, 768, 256, 128); zero_rect(F, up, K_UP, 768, 1024, 0, 256);
        bf16* sm = WSP(bf16, WS_WSMT) + (size_t)l * N_SM * K_SM;
        zero_rect(F, sm, K_SM, 0, 512, 64, 192); zero_rect(F, sm, K_SM, 512, 512, 0, 64); zero_rect(F, sm, K_SM, 512, 512, 128, 128); zero_rect(F, sm, K_SM, 1024, 512, 0, 128);
    }
    const int gt = (F.vcu * NTHREADS) + F.tid, NGT = F.G * NTHREADS;
    { const float* v1 = INP(I_V1); const float* v2 = INP(I_V2); bf16* o = WSP(bf16, WS_WV12T);
      for (int i = gt; i < 512 * 512; i += NGT) { const int n = i >> 9, k = i & 511; float s = 0.f;
#pragma unroll 8
          for (int j = 0; j < 32; ++j) s += v1[k * 32 + j] * v2[j * 512 + n];
          o[i] = (bf16)f2bf(s); } }
    { const float* b1 = INP(I_EB1); float* o = WSP(float, WS_B1P);
      for (int i = gt; i < DEPTH * NE * 2048; i += NGT) { const int q = i & 2047, le = i >> 11; const int pn = q >> 8, bj = (q >> 7) & 1, jj = q & 127; o[i] = b1[(size_t)le * 2048 + 2 * (pn * 128 + jj) + bj]; } }
    { const float* rw = INP(I_RW); bf16* o = WSP(bf16, WS_RWT);
      for (int i = gt; i < DEPTH * NE * D; i += NGT) { const int k = i & 1023, e = (i >> 10) & 31, l2 = i >> 15; const float v = rw[((size_t)l2 * D + k) * NE + e]; const unsigned hi = f2bf(v); const float lo = v - bf2f(hi);
          o[i] = (bf16)hi; o[DEPTH * NE * D + i] = (bf16)f2bf(lo); } }
    { const int* pos = (const int*)p.in[I_POS]; float* cs = WSP(float, WS_CS);
      for (int i = gt; i < T * 16; i += NGT) { const int t = i >> 4, k = i & 15; const double a = (double)pos[t] * INV_FREQ[k];
          const double q = __builtin_rint(a * 0.63661977236758134308); const int qi = (int)((long long)q & 3);
          double r = __builtin_fma(-q, 1.57079632679489655800e+00, a); r = __builtin_fma(-q, 6.12323399573676603587e-17, r);
          const double r2 = r * r;
          double sn = -2.50521083854417187751e-08; sn = sn * r2 + 2.75573192239858906526e-06; sn = sn * r2 - 1.98412698412698412698e-04; sn = sn * r2 + 8.33333333333333333333e-03; sn = sn * r2 - 1.66666666666666666667e-01; sn = r + r * r2 * sn;
          double cn = 2.08767569878680989792e-09; cn = cn * r2 - 2.75573192239858906526e-07; cn = cn * r2 + 2.48015873015873015873e-05; cn = cn * r2 - 1.38888888888888888889e-03; cn = cn * r2 + 4.16666666666666666667e-02; cn = cn * r2 - 0.5; cn = 1.0 + r2 * cn;
          double sv, cv;
          if (qi == 0) { sv = sn; cv = cn; } else if (qi == 1) { sv = cn; cv = -sn; } else if (qi == 2) { sv = -sn; cv = -cn; } else { sv = -cn; cv = sn; }
          cs[2 * i] = (float)cv; cs[2 * i + 1] = (float)sv; } }
    { LAS float* cact = (LAS float*)(F.lds);
      LAS float* part = (LAS float*)(F.lds + 32768);
      __syncthreads();
      const float* c = INP(I_C);
      for (int i = F.tid; i < NBATCH * D; i += NTHREADS) { const float v = c[i]; cact[i] = v / (1.0f + __expf(-v)); }
      __syncthreads();
      for (int item = F.vcu; item < DEPTH * 96; item += F.G) { const int l = item / 96, n0 = (item % 96) * 64;
          const float* aw = INP(I_ADAW) + (size_t)l * D * 6144 + n0 + F.lane;
          float a8[8];
#pragma unroll
          for (int b = 0; b < 8; ++b) a8[b] = 0.f;
          const int kb = F.wave * 128;
#pragma unroll 4
          for (int k = 0; k < 128; ++k) { const float wv = aw[(size_t)(kb + k) * 6144];
#pragma unroll
              for (int b = 0; b < 8; ++b) a8[b] += cact[b * D + kb + k] * wv; }
#pragma unroll
          for (int b = 0; b < 8; ++b) part[(F.wave * 8 + b) * 64 + F.lane] = a8[b];
          __syncthreads();
          { const int b = F.wave; float s = 0.f;
#pragma unroll
            for (int w = 0; w < 8; ++w) s += part[(w * 8 + b) * 64 + F.lane];
            WSP(float, WS_MOD)[((size_t)l * NBATCH + b) * 6144 + n0 + F.lane] = s + INP(I_ADAB)[(size_t)l * 6144 + n0 + F.lane]; }
          __syncthreads(); }
    }
}

__device__ __forceinline__ void phase_ln0(const Params& p, const Frame& F) {
    const int gw = F.vcu * NWAVES + F.wave, NGW = F.G * NWAVES;
    const float* mod = WSP(float, WS_MOD);
    for (int m = gw; m < T; m += NGW) {
        const int b = m / SEQ;
        const GAS f32x4* xr = (const GAS f32x4*)(INP(I_X) + (size_t)m * D) + F.lane;
        f32x4 v[4]; float s = 0.f;
#pragma unroll
        for (int j = 0; j < 4; ++j) { v[j] = xr[64 * j]; s += (v[j].x + v[j].y) + (v[j].z + v[j].w); }
        const float mean = wave_sum(s) * (1.f / D); float s2 = 0.f;
#pragma unroll
        for (int j = 0; j < 4; ++j) { v[j] = v[j] - mean; s2 += (v[j].x * v[j].x + v[j].y * v[j].y) + (v[j].z * v[j].z + v[j].w * v[j].w); }
        const float rstd = 1.f / sqrtf(wave_sum(s2) * (1.f / D) + LN_EPS);
        GAS f32x4* xo = (GAS f32x4*)(WSP(float, WS_X) + (size_t)m * D) + F.lane;
        GAS u32x2* ho = (GAS u32x2*)(WSP(bf16, WS_H) + (size_t)m * D) + F.lane;
#pragma unroll
        for (int j = 0; j < 4; ++j) { const int c = 4 * F.lane + 256 * j;
            const f32x4 g = *(const f32x4*)(INP(I_ELNG) + c), be = *(const f32x4*)(INP(I_ELNB) + c);
            const f32x4 x0 = v[j] * rstd * g + be; xo[64 * j] = x0;
            const f32x4 sh = *(const f32x4*)(mod + (size_t)b * 6144 + c), sc = *(const f32x4*)(mod + (size_t)b * 6144 + 1024 + c);
            const f32x4 h = x0 * (sc + 1.0f) + sh; u32x2 w; w.x = pk2(h.x, h.y); w.y = pk2(h.z, h.w); ho[64 * j] = w; }
    }
}

__device__ __forceinline__ void phase_prep(const Params& p, const Frame& F, int l) {
    const int gw = F.vcu * NWAVES + F.wave, NGW = F.G * NWAVES; const int lane = F.lane;
    const bf16* P = WSP(bf16, WS_P); const float* mu = INP(I_MU) + (size_t)l * RWKV_IN;
    const float* qg = INP(I_QNG) + (size_t)l * QLR; const float* kvg = INP(I_KVNG) + (size_t)l * KVLR;
    bf16* AN = WSP(bf16, WS_AN); bf16* A2 = WSP(bf16, WS_A2); bf16* RK = WSP(bf16, WS_RK); bf16* KKb = WSP(bf16, WS_KK);
    bf16* VS = l == 0 ? WSP(bf16, WS_VS0) : WSP(bf16, WS_VS1);
    const float* cs = WSP(float, WS_CS);
    for (int t = gw; t < T; t += NGW) {
        const bf16* pr = P + (size_t)t * N_INP; const bool first = (t % SEQ) == 0; const bf16* pp = pr - N_INP;
        { const u32x2 qw = *(const u32x2*)(pr + 4 * lane); float q0 = bflo(qw.x), q1 = bfhi(qw.x), q2 = bflo(qw.y), q3 = bfhi(qw.y);
          const float rq = 1.f / sqrtf(wave_sum(q0 * q0 + q1 * q1 + q2 * q2 + q3 * q3) * (1.f / QLR) + RMS_EPS);
          const f32x4 g = *(const f32x4*)(qg + 4 * lane);
          u32x2 w; w.x = pk2(q0 * rq * g.x, q1 * rq * g.y); w.y = pk2(q2 * rq * g.z, q3 * rq * g.w); *(u32x2*)(AN + (size_t)t * K_UP + 4 * lane) = w;
          const unsigned kw = *(const unsigned*)(pr + QLR + 2 * lane); const float k0 = bflo(kw), k1 = bfhi(kw);
          const float rk = 1.f / sqrtf(wave_sum(k0 * k0 + k1 * k1) * (1.f / KVLR) + RMS_EPS);
          const f32x2 g2 = *(const f32x2*)(kvg + 2 * lane);
          *(unsigned*)(AN + (size_t)t * K_UP + QLR + 2 * lane) = pk2(k0 * rk * g2.x, k1 * rk * g2.y);
          const int i = lane & 15; const unsigned rw = *(const unsigned*)(pr + QLR + KVLR + 2 * i); const float x0 = bflo(rw), x1 = bfhi(rw);
          const f32x2 csv = *(const f32x2*)(cs + (size_t)t * 32 + 2 * i); const unsigned ro = pk2(x0 * csv.x - x1 * csv.y, x0 * csv.y + x1 * csv.x);
          const int h0 = (lane >> 4) * 2;
          *(unsigned*)(KKb + (size_t)t * 768 + h0 * QKD + NOPE + 2 * i) = ro; *(unsigned*)(KKb + (size_t)t * 768 + (h0 + 1) * QKD + NOPE + 2 * i) = ro; }
        const bf16* rr = pr + MLA_IN; const bf16* rp = pp + MLA_IN;
#pragma unroll
        for (int part = 0; part < 3; ++part) {
            const int c = part * 512 + 8 * lane; const u32x4 cw = *(const u32x4*)(rr + c); u32x4 pw = (u32x4){0u, 0u, 0u, 0u}; if (!first) pw = *(const u32x4*)(rp + c);
            const f32x4 m0 = *(const f32x4*)(mu + c), m1 = *(const f32x4*)(mu + c + 4);
            float o[8];
#pragma unroll
            for (int j = 0; j < 4; ++j) { const float a = bflo(cw[j]), b = bfhi(cw[j]), pa = bflo(pw[j]), pb = bfhi(pw[j]); const float ma = j < 2 ? m0[2 * j] : m1[2 * j - 4], mb = j < 2 ? m0[2 * j + 1] : m1[2 * j - 3];
                o[2 * j] = a + ma * (pa - a); o[2 * j + 1] = b + mb * (pb - b); }
            u32x4 w; w.x = pk2(o[0], o[1]); w.y = pk2(o[2], o[3]); w.z = pk2(o[4], o[5]); w.w = pk2(o[6], o[7]);
            if (part < 2) *(u32x4*)(RK + (size_t)t * 1024 + part * 512 + 8 * lane) = w; else *(u32x4*)(VS + (size_t)t * C5 + 8 * lane) = w;
        }
        { const int c = 1536 + lane; const float a = bf2f(rr[c]), pa = first ? 0.f : bf2f(rp[c]); const float v = a + mu[c] * (pa - a); A2[(size_t)t * K_SM + lane] = (bf16)f2bf(tanhf_(v)); }
        { const int c = 1600 + lane; const float a = bf2f(rr[c]), pa = first ? 0.f : bf2f(rp[c]); const float v = a + mu[c] * (pa - a); A2[(size_t)t * K_SM + 64 + lane] = (bf16)f2bf(v); }
        { const int c = 1664 + 2 * lane; const unsigned cw = *(const unsigned*)(rr + c); const unsigned pw = first ? 0u : *(const unsigned*)(rp + c);
          const f32x2 m = *(const f32x2*)(mu + c); const float a = bflo(cw), b = bfhi(cw); const float va = a + m.x * (bflo(pw) - a), vb = b + m.y * (bfhi(pw) - b);
          *(unsigned*)(A2 + (size_t)t * K_SM + 128 + 2 * lane) = pk2(sigmoidf_(va), sigmoidf_(vb)); }
    }
}

namespace att {
__device__ __forceinline__ int crow(int r, int hi) { return (r & 3) + 8 * (r >> 2) + 4 * hi; }
constexpr int KSLOT = 12288, VSLOT = 8192;
constexpr int LDS_K = 0, LDS_V = 2 * KSLOT, LDS_WS = LDS_V + 2 * VSLOT, LDS_OST = LDS_WS + NWAVES * 64 * 4, LDS_TOTAL = LDS_OST + NWAVES * 4096;
__device__ __forceinline__ void glds16(const void* gsrc, unsigned lds_dst) { unsigned keep;
    asm volatile("s_mov_b32 %0, m0\n\ts_mov_b32 m0, %2\n\ts_nop 0\n\tglobal_load_lds_dwordx4 %1, off\n\ts_mov_b32 m0, %0" : "=&s"(keep) : "v"(gsrc), "s"(lds_dst) : "memory"); }
__device__ __forceinline__ float max3f(float a, float b, float c) { return fmaxf(fmaxf(a, b), c); }
#define ATT_WAIT_BAR() asm volatile("s_waitcnt vmcnt(0) lgkmcnt(0)\n\ts_barrier" ::: "memory")
__device__ __forceinline__ float rowmax(const f32x16& p0, const f32x16& p1) {
    float a = max3f(p0[0], p0[1], p1[0]), b = max3f(p0[2], p0[3], p1[1]); a = max3f(a, p1[2], p1[3]);
#pragma unroll
    for (int r = 4; r < 16; r += 4) { a = max3f(a, p0[r], p0[r + 1]); b = max3f(b, p0[r + 2], p0[r + 3]); a = max3f(a, p1[r], p1[r + 1]); b = max3f(b, p1[r + 2], p1[r + 3]); }
    const float m = fmaxf(a, b);
    auto rr = __builtin_amdgcn_permlane32_swap(__float_as_uint(m), __float_as_uint(m), false, false);
    return fmaxf(__uint_as_float(rr[0]), __uint_as_float(rr[1]));
}
__device__ __forceinline__ void pv(f32x16* o, int vb, bf16x8 pa0, bf16x8 pa1, bf16x8 pa2, bf16x8 pa3) {
#pragma unroll
    for (int d0 = 0; d0 < 2; ++d0) { s16x4 lo[4], hi[4];
#pragma unroll
        for (int ks = 0; ks < 4; ++ks) {
            asm volatile("ds_read_b64_tr_b16 %0,%1 offset:%c2" : "=&v"(lo[ks]) : "v"(vb), "i"(d0 * 4096 + ks * 1024) : "memory");
            asm volatile("ds_read_b64_tr_b16 %0,%1 offset:%c2" : "=&v"(hi[ks]) : "v"(vb), "i"(d0 * 4096 + ks * 1024 + 512) : "memory"); }
        asm volatile("s_waitcnt lgkmcnt(0)" ::: "memory"); __builtin_amdgcn_sched_barrier(0);
#define PK(k) (bf16x8){lo[k][0], lo[k][1], lo[k][2], lo[k][3], hi[k][0], hi[k][1], hi[k][2], hi[k][3]}
        o[d0] = __builtin_amdgcn_mfma_f32_32x32x16_bf16(pa0, PK(0), o[d0], 0, 0, 0);
        o[d0] = __builtin_amdgcn_mfma_f32_32x32x16_bf16(pa1, PK(1), o[d0], 0, 0, 0);
        o[d0] = __builtin_amdgcn_mfma_f32_32x32x16_bf16(pa2, PK(2), o[d0], 0, 0, 0);
        o[d0] = __builtin_amdgcn_mfma_f32_32x32x16_bf16(pa3, PK(3), o[d0], 0, 0, 0);
#undef PK
    }
}
__device__ __forceinline__ void attn_unit(int b, int h, int qb, const bf16* Q, const bf16* __restrict__ KKp, const bf16* __restrict__ Vp, bf16* O, char* shm) {
    const int tid = threadIdx.x, lane = tid & 63, r32 = lane & 31, hi = lane >> 5; const int wid = __builtin_amdgcn_readfirstlane(tid >> 6);
    const long rowbase = (long)b * SEQ; const int q0 = qb * 256;
    const bf16* Qw = Q + (rowbase + q0 + wid * 32) * 768 + h * QKD;
    const bf16* Kh = KKp + rowbase * 768 + h * QKD; const bf16* Vh = Vp + rowbase * 512 + h * VD;
    const unsigned lds0 = (unsigned)(uintptr_t)shm;
    float* wsf = (float*)(shm + LDS_WS) + wid * 64;
    const bf16* ksrc0 = Kh + (long)lane * 768 + wid * 8;
    const bf16* ksrc1 = Kh + (long)lane * 768 + (8 + (wid & 3)) * 8;
    const bf16* vsrc = Vh + (long)(16 * (wid & 3) + (lane >> 2)) * 512 + (wid >> 2) * 32 + (lane & 3) * 8;
    const unsigned kdst0 = lds0 + LDS_K + wid * 1024, kdst1 = lds0 + LDS_K + (8 + (wid & 3)) * 1024, vdst = lds0 + LDS_V + wid * 1024;
#define DMA_KV(t, s) do { glds16(ksrc0 + (long)(t) * 64 * 768, (unsigned)__builtin_amdgcn_readfirstlane(kdst0 + (s) * KSLOT)); \
        if (wid < 4) glds16(ksrc1 + (long)(t) * 64 * 768, (unsigned)__builtin_amdgcn_readfirstlane(kdst1 + (s) * KSLOT)); \
        glds16(vsrc + (long)(t) * 64 * 512, (unsigned)__builtin_amdgcn_readfirstlane(vdst + (s) * VSLOT)); } while (0)
    const int vb0 = (int)(lds0 + LDS_V) + ((lane >> 4) & 1) * 32 + (lane & 3) * 8 + (4 * hi + ((lane & 15) >> 2)) * 64;
    const int NT = (q0 + 256) / 64;
    DMA_KV(0, 0);
    bf16x8 qr[6];
#pragma unroll
    for (int d0 = 0; d0 < 6; ++d0) qr[d0] = *reinterpret_cast<const bf16x8*>(&Qw[(long)r32 * 768 + d0 * 16 + hi * 8]);
    float mrun = -INFINITY, l_reg = 0.f; f32x16 o[2]; o[0] = f32x16{}; o[1] = f32x16{};
    const int qrel = wid * 32 + r32;
    for (int t = 0; t < NT; ++t) {
        ATT_WAIT_BAR();
        if (t + 1 < NT) DMA_KV(t + 1, (t + 1) & 1);
        const char* Kslot = shm + LDS_K + (t & 1) * KSLOT;
        f32x16 p0 = f32x16{}, p1 = f32x16{};
        { const char* kb = Kslot + hi * 1024 + r32 * 16;
#pragma unroll
          for (int d0 = 0; d0 < 6; ++d0) { const bf16x8 b0 = *reinterpret_cast<const bf16x8*>(kb + d0 * 2048); const bf16x8 b1 = *reinterpret_cast<const bf16x8*>(kb + d0 * 2048 + 512);
              p0 = __builtin_amdgcn_mfma_f32_32x32x16_bf16(b0, qr[d0], p0, 0, 0, 0); p1 = __builtin_amdgcn_mfma_f32_32x32x16_bf16(b1, qr[d0], p1, 0, 0, 0); } }
        const int jb = t - (NT - 4);
        if (jb >= 0) { const int kbase = 64 * jb + 4 * hi;
#pragma unroll
            for (int r = 0; r < 16; ++r) { const int kv = kbase + (r & 3) + 8 * (r >> 2); if (kv > qrel) p0[r] = -INFINITY; if (kv + 32 > qrel) p1[r] = -INFINITY; } }
        const float rm = rowmax(p0, p1); const float mnew = fmaxf(mrun, rm); const float f = exp2f(mrun - mnew); mrun = mnew;
        float sacc = 0.f;
#pragma unroll
        for (int r = 0; r < 16; ++r) { p0[r] = exp2f(p0[r] - mnew); p1[r] = exp2f(p1[r] - mnew); sacc += p0[r] + p1[r]; }
        l_reg = l_reg * f + sacc;
        if (hi == 0) wsf[r32] = f;
        asm volatile("s_waitcnt lgkmcnt(0)" ::: "memory");
#pragma unroll
        for (int r = 0; r < 16; ++r) { const float fr_ = wsf[crow(r, hi)]; o[0][r] *= fr_; o[1][r] *= fr_; }
        u32x4 pw0, pw1, pw2, pw3;
        pw0 = (u32x4){cvt_pk_bf16(p0[0], p0[1]), cvt_pk_bf16(p0[2], p0[3]), cvt_pk_bf16(p0[4], p0[5]), cvt_pk_bf16(p0[6], p0[7])};
        pw1 = (u32x4){cvt_pk_bf16(p0[8], p0[9]), cvt_pk_bf16(p0[10], p0[11]), cvt_pk_bf16(p0[12], p0[13]), cvt_pk_bf16(p0[14], p0[15])};
        pw2 = (u32x4){cvt_pk_bf16(p1[0], p1[1]), cvt_pk_bf16(p1[2], p1[3]), cvt_pk_bf16(p1[4], p1[5]), cvt_pk_bf16(p1[6], p1[7])};
        pw3 = (u32x4){cvt_pk_bf16(p1[8], p1[9]), cvt_pk_bf16(p1[10], p1[11]), cvt_pk_bf16(p1[12], p1[13]), cvt_pk_bf16(p1[14], p1[15])};
        asm volatile("s_waitcnt lgkmcnt(0)" ::: "memory");
        pv(o, vb0 + (t & 1) * VSLOT, __builtin_bit_cast(bf16x8, pw0), __builtin_bit_cast(bf16x8, pw1), __builtin_bit_cast(bf16x8, pw2), __builtin_bit_cast(bf16x8, pw3));
    }
    { auto rr = __builtin_amdgcn_permlane32_swap(__float_as_uint(l_reg), __float_as_uint(l_reg), false, false); l_reg = __uint_as_float(rr[0]) + __uint_as_float(rr[1]); }
    if (hi == 0) wsf[32 + r32] = l_reg; asm volatile("s_waitcnt lgkmcnt(0)" ::: "memory");
    float rli[16];
#pragma unroll
    for (int r = 0; r < 16; ++r) rli[r] = __builtin_amdgcn_rcpf(wsf[32 + crow(r, hi)]);
    bf16* Ow = O + (rowbase + q0 + wid * 32) * 512 + h * VD;
    { bf16* stg = (bf16*)(shm + LDS_OST) + wid * 2048;
#pragma unroll
      for (int r = 0; r < 16; ++r) { const int orow = crow(r, hi);
#pragma unroll
          for (int d0 = 0; d0 < 2; ++d0) stg[orow * 64 + d0 * 32 + r32] = (bf16)f2bf(o[d0][r] * rli[r]); }
      asm volatile("s_waitcnt lgkmcnt(0)" ::: "memory");
#pragma unroll
      for (int i = 0; i < 4; ++i) { const int row = i * 8 + (lane >> 3), ch = lane & 7; const u32x4 v = *(const u32x4*)(stg + row * 64 + ch * 8); *(u32x4*)(Ow + (long)row * 512 + ch * 8) = v; } }
    asm volatile("s_waitcnt vmcnt(0) lgkmcnt(0)\n\ts_barrier" ::: "memory");
#undef DMA_KV
}
}

__device__ __forceinline__ void phase_attn(const Params& p, const Frame& F, char* lds_generic, int l) {
    const bf16* Q = WSP(bf16, WS_Q); const bf16* KKp = WSP(bf16, WS_KK); const bf16* Vp = WSP(bf16, WS_V); bf16* O = WSP(bf16, WS_O);
    unsigned* head = (unsigned*)(F.ws + WS_CTL) + CW_ATTQ + l * 64;
    volatile LAS unsigned* MISC = (volatile LAS unsigned*)(F.lds + MISC_OFF);
    for (;;) {
        if (F.tid == 0) MISC[16] = __hip_atomic_fetch_add(head, 1u, RLX_AGENT);
        __syncthreads();
        const unsigned k = MISC[16];
        __syncthreads();
        if (k >= 1024u) break;
        const int qb = 15 - (int)(k >> 6), bh = (int)(k & 63u);
        att::attn_unit(bh >> 3, bh & 7, qb, Q, KKp, Vp, O, lds_generic);
    }
}

namespace rw {
constexpr int RS = 144;
constexpr int SLOT = 64 * RS;
constexpr int S_KT = 0, S_RT = 1, S_BC = 2, S_KC = 3, S_V = 4, S_BH = 5, S_KH = 6, S_GT = 7, S_ABK = 8, S_AKK = 9, S_AKR = 10, S_ABR = 11, S_ABKF = 12;
constexpr int S_TT = S_BC, S_ZT = S_KC, S_NW1T = S_AKK, S_NW2T = S_ABK;
constexpr int TOT_OFF = 13 * SLOT, PL_OFF = TOT_OFF + 8 * 64 * 4;
typedef short v4i16_t __attribute__((ext_vector_type(4)));
__device__ __forceinline__ int crow(int r, int hi) { return (r & 3) + 8 * (r >> 2) + 4 * hi; }
__device__ __forceinline__ bf16x8 frag_d(const LAS unsigned char* M, int row0, int k0, int r, int h) { return *(const LAS bf16x8*)(M + (row0 + r) * RS + (k0 + 8 * h) * 2); }
__device__ __forceinline__ bf16x8 frag_t(const LAS unsigned char* M, int k0, int col0, int lane) {
    const int h = lane >> 5, blk = (lane >> 4) & 1, q = (lane & 15) >> 2, pp = lane & 3;
    const LAS unsigned char* a = M + (k0 + 8 * h + q) * RS + (col0 + 16 * blk + 4 * pp) * 2;
    const v4i16_t lo = __builtin_amdgcn_ds_read_tr16_b64_v4i16((LAS v4i16_t*)a), hi = __builtin_amdgcn_ds_read_tr16_b64_v4i16((LAS v4i16_t*)(a + 4 * RS));
    return (bf16x8){lo[0], lo[1], lo[2], lo[3], hi[0], hi[1], hi[2], hi[3]};
}
__device__ __forceinline__ void store_T(LAS unsigned char* D, int m0, int n0, const f32x16& acc, float sgn, int r, int h) {
#pragma unroll
    for (int g = 0; g < 4; ++g) { u32x2 w; w.x = cvtpk_c(acc[4 * g] * sgn, acc[4 * g + 1] * sgn); w.y = cvtpk_c(acc[4 * g + 2] * sgn, acc[4 * g + 3] * sgn);
        *(LAS u32x2*)(D + (n0 + r) * RS + (m0 + 8 * g + 4 * h) * 2) = w; }
}
#define RW_MMA(acc, A, B) acc = __builtin_amdgcn_mfma_f32_32x32x16_bf16((A), (B), acc, 0, 0, 0)
}

#define LBAR() asm volatile("s_waitcnt lgkmcnt(0)\n\ts_barrier" ::: "memory")
__device__ __forceinline__ void phase_rwkv_r1(const Params& p, const Frame& F, int l) {
    using namespace rw;
    LAS unsigned char* L0 = F.lds;
#define SL(i) (L0 + (i) * SLOT)
    const bf16* RK = WSP(bf16, WS_RK); const float* WAG = WSP(float, WS_WAG);
    const bf16* Vv = l == 0 ? WSP(bf16, WS_VS0) : WSP(bf16, WS_VR);
    float* CH = WSP(float, WS_CH);
    const float* kkw = INP(I_KK) + (size_t)l * C5; const float* kaw = INP(I_KA) + (size_t)l * C5;
    const int tid0 = F.tid, wave = F.wave;
    const int pt0 = tid0 >> 3, j80 = tid0 & 7;
    LAS float* tot = (LAS float*)(L0 + TOT_OFF); LAS float* PLv = (LAS float*)(L0 + PL_OFF);
    u32x4 g_r, g_k, g_v; f32x4 g_l0, g_l1, g_a0, g_a1;
#define R1_FETCH(uu) do { const int bh_ = (uu) >> 6, cc_ = (uu) & 63; const size_t tok = (size_t)(bh_ >> 3) * SEQ + (size_t)cc_ * 64 + pt0; const int c_ = (bh_ & 7) * 64 + 8 * j80; \
        g_r = *(const u32x4*)(RK + tok * 1024 + c_); g_k = *(const u32x4*)(RK + tok * 1024 + 512 + c_); g_v = *(const u32x4*)(Vv + tok * C5 + c_); \
        g_l0 = *(const f32x4*)(WAG + tok * N_SM + c_); g_l1 = *(const f32x4*)(WAG + tok * N_SM + c_ + 4); g_a0 = *(const f32x4*)(WAG + tok * N_SM + 512 + c_); g_a1 = *(const f32x4*)(WAG + tok * N_SM + 512 + c_ + 4); } while (0)
    int u = F.vcu;
    if (u < 4096) R1_FETCH(u);
    for (; u < 4096; u += F.G) {
        const int hh = (u >> 6) & 7;
        int tid = tid0; asm volatile("" : "+v"(tid)); const int lane = tid & 63, r = lane & 31, h = lane >> 5, pt = tid >> 3, j8 = tid & 7;
        {
            const int c = hh * 64 + 8 * j8;
            const f32x4 kk0 = *(const f32x4*)(kkw + c), kk1 = *(const f32x4*)(kkw + c + 4), ka0 = *(const f32x4*)(kaw + c), ka1 = *(const f32x4*)(kaw + c + 4);
            float rr[8], k[8], a[8], x[8], lw[8], kap[8], be[8], kp[8]; float ss = 0.f;
#pragma unroll
            for (int j = 0; j < 4; ++j) { rr[2 * j] = bflo(g_r[j]); rr[2 * j + 1] = bfhi(g_r[j]); k[2 * j] = bflo(g_k[j]); k[2 * j + 1] = bfhi(g_k[j]); }
            *(LAS u32x4*)(SL(S_V) + pt * RS + j8 * 16) = g_v;
#pragma unroll
            for (int j = 0; j < 8; ++j) { a[j] = j < 4 ? g_a0[j & 3] : g_a1[j & 3]; lw[j] = j < 4 ? g_l0[j & 3] : g_l1[j & 3]; x[j] = lw[j]; const float q = k[j] * (j < 4 ? kk0[j & 3] : kk1[j & 3]); kap[j] = q; ss += q * q; }
            ss += __shfl_xor(ss, 1); ss += __shfl_xor(ss, 2); ss += __shfl_xor(ss, 4);
            const float inv = 1.0f / fmaxf(sqrtf(ss), 1e-12f);
#pragma unroll
            for (int j = 0; j < 8; ++j) { kap[j] *= inv; be[j] = kap[j] * a[j]; kp[j] = k[j] * (1.0f + (a[j] - 1.0f) * (j < 4 ? ka0[j & 3] : ka1[j & 3])); }
#pragma unroll
            for (int off = 8; off < 64; off <<= 1) {
#pragma unroll
                for (int j = 0; j < 8; ++j) { const float y = __shfl_up(x[j], off); if (lane >= off) x[j] += y; } }
            if (lane >= 56) { *(LAS f32x4*)(tot + wave * 64 + 8 * j8) = (f32x4){x[0], x[1], x[2], x[3]}; *(LAS f32x4*)(tot + wave * 64 + 8 * j8 + 4) = (f32x4){x[4], x[5], x[6], x[7]}; }
            LBAR();
            float csL[8];
#pragma unroll
            for (int j = 0; j < 8; ++j) csL[j] = 0.f;
#pragma unroll
            for (int w2 = 0; w2 < 8; ++w2) { const f32x4 t0 = *(const LAS f32x4*)(tot + w2 * 64 + 8 * j8), t1 = *(const LAS f32x4*)(tot + w2 * 64 + 8 * j8 + 4);
#pragma unroll
                for (int j = 0; j < 8; ++j) { const float tv = j < 4 ? t0[j & 3] : t1[j & 3]; csL[j] += tv; if (w2 < wave) x[j] += tv; } }
            if (pt == 0) {
#pragma unroll
                for (int j = 0; j < 8; ++j) PLv[8 * j8 + j] = __expf(csL[j]); }
            float kt[8], rt[8], bc[8], kc[8], bh[8], kh[8];
#pragma unroll
            for (int j = 0; j < 8; ++j) { const float eP = __expf(x[j]), ePm1 = __expf(x[j] - lw[j]), eInv = __expf(-x[j]), eL = __expf(csL[j] - x[j]);
                kt[j] = kap[j] * ePm1; rt[j] = rr[j] * eP; bc[j] = be[j] * eInv; kc[j] = kp[j] * eInv; bh[j] = be[j] * eL; kh[j] = kp[j] * eL; }
#define PK8(v) (u32x4){cvtpk_c(v[0], v[1]), cvtpk_c(v[2], v[3]), cvtpk_c(v[4], v[5]), cvtpk_c(v[6], v[7])}
            *(LAS u32x4*)(SL(S_KT) + pt * RS + j8 * 16) = PK8(kt); *(LAS u32x4*)(SL(S_RT) + pt * RS + j8 * 16) = PK8(rt);
            *(LAS u32x4*)(SL(S_BC) + pt * RS + j8 * 16) = PK8(bc); *(LAS u32x4*)(SL(S_KC) + pt * RS + j8 * 16) = PK8(kc);
            *(LAS u32x4*)(SL(S_BH) + pt * RS + j8 * 16) = PK8(bh); *(LAS u32x4*)(SL(S_KH) + pt * RS + j8 * 16) = PK8(kh);
#undef PK8
        }
        LBAR();
        {
            const int mat = wave >> 1, ti = wave & 1;
            const LAS unsigned char* X = (mat < 2) ? SL(S_KT) : SL(S_RT); const LAS unsigned char* Y = (mat == 0 || mat == 3) ? SL(S_BC) : SL(S_KC);
            LAS unsigned char* Dm = SL(S_ABK + mat);
            const int t = 32 * ti + r;
            bf16x8 xb[4];
#pragma unroll
            for (int kk = 0; kk < 4; ++kk) xb[kk] = frag_d(X, 32 * ti, 16 * kk, r, h);
#pragma unroll
            for (int si = 0; si < 2; ++si) {
                f32x16 acc = f32x16{};
                if (!(ti == 0 && si == 1)) {
#pragma unroll
                    for (int kk = 0; kk < 4; ++kk) RW_MMA(acc, frag_d(Y, 32 * si, 16 * kk, r, h), xb[kk]); }
#pragma unroll
                for (int g = 0; g < 4; ++g) { float v[4];
#pragma unroll
                    for (int e = 0; e < 4; ++e) { const int sidx = 32 * si + 8 * g + 4 * h + e; const bool keep = (mat < 2) ? (sidx < t) : (sidx <= t); v[e] = keep ? acc[4 * g + e] : 0.f; }
                    u32x2 w; w.x = cvtpk_c(v[0], v[1]); w.y = cvtpk_c(v[2], v[3]);
                    *(LAS u32x2*)(Dm + t * RS + (32 * si + 8 * g + 4 * h) * 2) = w;
                    if (mat == 0 && ti == si) *(LAS f32x4*)(SL(S_ABKF) + ti * 4608 + r * 144 + (8 * g + 4 * h) * 4) = (f32x4){v[0], v[1], v[2], v[3]}; }
            }
        }
        LBAR();
        if (wave == 0) {
            const int hb = lane >> 5, c = lane & 31; const LAS unsigned char* Ab = SL(S_ABKF) + hb * 4608;
            float Tc[32];
#pragma unroll
            for (int t = 0; t < 32; ++t) Tc[t] = 0.f;
#pragma unroll
            for (int t = 0; t < 32; ++t) { float acc0 = (t == c) ? 1.0f : 0.0f, acc1 = 0.f;
#pragma unroll
                for (int s4 = 0; s4 < (t + 3) / 4; ++s4) { const f32x4 a4 = *(const LAS f32x4*)(Ab + t * 144 + s4 * 16);
                    acc0 -= a4.x * Tc[4 * s4]; acc1 -= a4.y * Tc[4 * s4 + 1]; acc0 -= a4.z * Tc[4 * s4 + 2]; acc1 -= a4.w * Tc[4 * s4 + 3]; }
                float acc = acc0 + acc1;
                asm volatile("" : "+v"(acc) :: "memory");
                Tc[t] = acc; }
#pragma unroll
            for (int q = 0; q < 4; ++q) *(LAS u32x4*)(SL(S_TT) + (32 * hb + c) * RS + (32 * hb) * 2 + q * 16) =
                (u32x4){cvtpk_c(Tc[8 * q], Tc[8 * q + 1]), cvtpk_c(Tc[8 * q + 2], Tc[8 * q + 3]), cvtpk_c(Tc[8 * q + 4], Tc[8 * q + 5]), cvtpk_c(Tc[8 * q + 6], Tc[8 * q + 7])};
        } else if (wave == 1) {
            const int row = 32 + (lane >> 1), hf = lane & 1;
            *(LAS u32x4*)(SL(S_TT) + row * RS + hf * 32) = (u32x4){0u, 0u, 0u, 0u}; *(LAS u32x4*)(SL(S_TT) + row * RS + hf * 32 + 16) = (u32x4){0u, 0u, 0u, 0u};
        } else if (wave >= 4) {
            const int ti = (wave - 4) >> 1, ii = (wave - 4) & 1; f32x16 acc = f32x16{};
#pragma unroll
            for (int kk = 0; kk < 4; ++kk) RW_MMA(acc, frag_d(SL(S_AKK), 32 * ti, 16 * kk, r, h), frag_t(SL(S_V), 16 * kk, 32 * ii, lane));
            store_T(SL(S_GT), 32 * ti, 32 * ii, acc, 1.0f, r, h);
        }
        LBAR();
        if (wave == 0) { f32x16 acc = f32x16{};
#pragma unroll
            for (int kk = 0; kk < 2; ++kk) RW_MMA(acc, frag_d(SL(S_ABK), 32, 16 * kk, r, h), frag_d(SL(S_TT), 0, 16 * kk, r, h));
            store_T(SL(S_ZT), 0, 0, acc, 1.0f, r, h); }
        LBAR();
        if (wave == 0) { f32x16 acc = f32x16{};
#pragma unroll
            for (int kk = 0; kk < 2; ++kk) RW_MMA(acc, frag_t(SL(S_TT), 32 + 16 * kk, 32, lane), frag_d(SL(S_ZT), 0, 16 * kk, r, h));
            store_T(SL(S_TT), 32, 0, acc, -1.0f, r, h); }
        LBAR();
        if (u + F.G < 4096) R1_FETCH(u + F.G);
        { const int w4 = wave & 3, ti = w4 >> 1, ci = w4 & 1; f32x16 acc = f32x16{};
          if (wave < 4) {
#pragma unroll
              for (int kk = 0; kk < 4; ++kk) RW_MMA(acc, frag_t(SL(S_TT), 16 * kk, 32 * ti, lane), frag_t(SL(S_KT), 16 * kk, 32 * ci, lane));
              store_T(SL(S_NW1T), 32 * ti, 32 * ci, acc, -1.0f, r, h); }
          else {
#pragma unroll
              for (int kk = 0; kk < 4; ++kk) RW_MMA(acc, frag_t(SL(S_TT), 16 * kk, 32 * ti, lane), frag_d(SL(S_GT), 32 * ci, 16 * kk, r, h));
              store_T(SL(S_NW2T), 32 * ti, 32 * ci, acc, -1.0f, r, h); } }
        LBAR();
        { const int which = wave >> 1, mi = wave & 1; float* dst = CH + ((size_t)u * 4 + which) * 4096;
#pragma unroll
          for (int ni = 0; ni < 2; ++ni) { f32x16 acc = f32x16{};
#pragma unroll
              for (int kk = 0; kk < 4; ++kk) {
                  if (which == 0) RW_MMA(acc, frag_d(SL(S_ABR), 32 * mi, 16 * kk, r, h), frag_d(SL(S_NW1T), 32 * ni, 16 * kk, r, h));
                  else if (which == 1) { RW_MMA(acc, frag_d(SL(S_AKR), 32 * mi, 16 * kk, r, h), frag_t(SL(S_V), 16 * kk, 32 * ni, lane)); RW_MMA(acc, frag_d(SL(S_ABR), 32 * mi, 16 * kk, r, h), frag_d(SL(S_NW2T), 32 * ni, 16 * kk, r, h)); }
                  else if (which == 2) RW_MMA(acc, frag_t(SL(S_BH), 16 * kk, 32 * mi, lane), frag_d(SL(S_NW1T), 32 * ni, 16 * kk, r, h));
                  else { RW_MMA(acc, frag_t(SL(S_KH), 16 * kk, 32 * mi, lane), frag_t(SL(S_V), 16 * kk, 32 * ni, lane)); RW_MMA(acc, frag_t(SL(S_BH), 16 * kk, 32 * mi, lane), frag_d(SL(S_NW2T), 32 * ni, 16 * kk, r, h)); } }
              const int n = 32 * ni + r;
#pragma unroll
              for (int rg = 0; rg < 16; ++rg) { const int m = 32 * mi + crow(rg, h); float v = acc[rg];
                  if (which == 0) v += bf2f(*(const LAS bf16*)(SL(S_RT) + m * RS + n * 2));
                  if (which == 2 && m == n) v += PLv[n];
                  dst[m * 64 + n] = v; } } }
        LBAR();
    }
#undef R1_FETCH
#undef SL
}

__device__ __forceinline__ void phase_rwkv_r2(const Params& p, const Frame& F) {
    const float* CH = WSP(float, WS_CH); float* RO = WSP(float, WS_RO);
    LAS float* stb = (LAS float*)(F.lds);
    constexpr int STB = 4 * 1280;
    const int lane = F.lane, wave = F.wave, q = lane >> 4, li = lane & 15, w4 = wave & 3;
    const int nr2 = F.G >= 4 ? F.G / 4 : 1;
    if (F.vcu >= nr2) return;
    for (int bh = F.vcu; bh < 64; bh += nr2) {
        const int b = bh >> 3, hh = bh & 7;
        __syncthreads();
        for (int i = F.tid; i < 2 * STB; i += NTHREADS) stb[i] = 0.f;
        __syncthreads();
        const int mA = (wave < 4) ? 2 : 0, mC = (wave < 4) ? 3 : 1;
        const float* basec = CH + (size_t)bh * 64 * 4 * 4096;
        f32x4 fa[2][4], fc[2][4];
#define R2_FETCH(cc, st) do { const float* pa = basec + ((size_t)(cc) * 4 + mA) * 4096 + (16 * w4 + li) * 64 + 16 * q; fa[st][0] = *(const f32x4*)(pa); fa[st][1] = *(const f32x4*)(pa + 4); fa[st][2] = *(const f32x4*)(pa + 8); fa[st][3] = *(const f32x4*)(pa + 12); \
            const float* pc = basec + ((size_t)(cc) * 4 + mC) * 4096 + (16 * w4 + 4 * q) * 64 + li; \
            _Pragma("unroll") for (int ct = 0; ct < 4; ++ct) fc[st][ct] = (f32x4){pc[16 * ct], pc[64 + 16 * ct], pc[128 + 16 * ct], pc[192 + 16 * ct]}; } while (0)
        R2_FETCH(0, 0); R2_FETCH(1, 1);
#pragma unroll 1
        for (int c0 = 0; c0 < 64; c0 += 2) {
#pragma unroll
            for (int st = 0; st < 2; ++st) { const int c = c0 + st;
                const f32x4 A0 = fa[st][0], A1 = fa[st][1], A2 = fa[st][2], A3 = fa[st][3];
                f32x4 acc[4];
#pragma unroll
                for (int ct = 0; ct < 4; ++ct) acc[ct] = fc[st][ct];
                if (c + 2 < 64) R2_FETCH(c + 2, st);
#pragma unroll
                for (int ct = 0; ct < 4; ++ct) { const LAS float* sb = stb + (c & 1) * STB + ct * 1280 + lane * 20;
                    const f32x4 b0 = *(const LAS f32x4*)(sb), b1 = *(const LAS f32x4*)(sb + 4), b2 = *(const LAS f32x4*)(sb + 8), b3 = *(const LAS f32x4*)(sb + 12);
#pragma unroll
                    for (int k = 0; k < 4; ++k) acc[ct] = __builtin_amdgcn_mfma_f32_16x16x4f32(A0[k], b0[k], acc[ct], 0, 0, 0);
#pragma unroll
                    for (int k = 0; k < 4; ++k) acc[ct] = __builtin_amdgcn_mfma_f32_16x16x4f32(A1[k], b1[k], acc[ct], 0, 0, 0);
#pragma unroll
                    for (int k = 0; k < 4; ++k) acc[ct] = __builtin_amdgcn_mfma_f32_16x16x4f32(A2[k], b2[k], acc[ct], 0, 0, 0);
#pragma unroll
                    for (int k = 0; k < 4; ++k) acc[ct] = __builtin_amdgcn_mfma_f32_16x16x4f32(A3[k], b3[k], acc[ct], 0, 0, 0); }
                if (wave < 4) {
#pragma unroll
                    for (int ct = 0; ct < 4; ++ct) *(LAS f32x4*)(stb + ((c + 1) & 1) * STB + ct * 1280 + (w4 * 16 + li) * 20 + 4 * q) = acc[ct]; }
                else { float* ro = RO + ((size_t)b * SEQ + (size_t)c * 64 + 16 * w4 + 4 * q) * C5 + hh * 64 + li;
#pragma unroll
                    for (int ct = 0; ct < 4; ++ct) { ro[16 * ct] = acc[ct][0]; ro[C5 + 16 * ct] = acc[ct][1]; ro[2 * C5 + 16 * ct] = acc[ct][2]; ro[3 * C5 + 16 * ct] = acc[ct][3]; } }
                LBAR();
            }
        }
#undef R2_FETCH
    }
    __syncthreads();
}
#undef LBAR

__device__ __forceinline__ void phase_mix(const Params& p, const Frame& F, int l) {
    const int gw = F.vcu * NWAVES + F.wave, NGW = F.G * NWAVES; const int lane = F.lane;
    const bf16* O = WSP(bf16, WS_O); const float* RO = WSP(float, WS_RO); const bf16* RK = WSP(bf16, WS_RK); const float* WAG = WSP(float, WS_WAG);
    const bf16* Vv = l == 0 ? WSP(bf16, WS_VS0) : WSP(bf16, WS_VR); bf16* MIX = WSP(bf16, WS_MIX);
    const float* og = INP(I_MOUTG) + (size_t)l * C5; const float* gng = INP(I_GNG) + (size_t)l * C5; const float* gnb = INP(I_GNB) + (size_t)l * C5;
    const float* kaw = INP(I_KA) + (size_t)l * C5; const float* rkw = INP(I_RK) + (size_t)l * C5;
    for (int t = gw; t < T; t += NGW) {
        const int c = 8 * lane;
        { const u32x4 ow = *(const u32x4*)(O + (size_t)t * C5 + c); float o[8]; float ss = 0.f;
#pragma unroll
          for (int j = 0; j < 4; ++j) { o[2 * j] = bflo(ow[j]); o[2 * j + 1] = bfhi(ow[j]); ss += o[2 * j] * o[2 * j] + o[2 * j + 1] * o[2 * j + 1]; }
          const float rs = 1.f / sqrtf(wave_sum(ss) * (1.f / C5) + RMS_EPS);
          const f32x4 g0 = *(const f32x4*)(og + c), g1 = *(const f32x4*)(og + c + 4);
          u32x4 w; w.x = pk2(o[0] * rs * g0.x, o[1] * rs * g0.y); w.y = pk2(o[2] * rs * g0.z, o[3] * rs * g0.w); w.z = pk2(o[4] * rs * g1.x, o[5] * rs * g1.y); w.w = pk2(o[6] * rs * g1.z, o[7] * rs * g1.w);
          *(u32x4*)(MIX + (size_t)t * D + c) = w; }
        { const f32x4 r0 = *(const f32x4*)(RO + (size_t)t * C5 + c), r1 = *(const f32x4*)(RO + (size_t)t * C5 + c + 4);
          float o[8]; float s = 0.f;
#pragma unroll
          for (int j = 0; j < 8; ++j) { o[j] = j < 4 ? r0[j & 3] : r1[j & 3]; s += o[j]; }
          s += __shfl_xor(s, 1); s += __shfl_xor(s, 2); s += __shfl_xor(s, 4); const float mean = s * (1.f / 64.f); float q = 0.f;
#pragma unroll
          for (int j = 0; j < 8; ++j) { o[j] -= mean; q += o[j] * o[j]; }
          q += __shfl_xor(q, 1); q += __shfl_xor(q, 2); q += __shfl_xor(q, 4); const float rstd = 1.f / sqrtf(q * (1.f / 64.f) + GN_EPS);
          const u32x4 rw = *(const u32x4*)(RK + (size_t)t * 1024 + c), kw = *(const u32x4*)(RK + (size_t)t * 1024 + 512 + c), vw = *(const u32x4*)(Vv + (size_t)t * C5 + c);
          const f32x4 a0 = *(const f32x4*)(WAG + (size_t)t * N_SM + 512 + c), a1 = *(const f32x4*)(WAG + (size_t)t * N_SM + 512 + c + 4);
          const f32x4 g0 = *(const f32x4*)(WAG + (size_t)t * N_SM + 1024 + c), g1 = *(const f32x4*)(WAG + (size_t)t * N_SM + 1024 + c + 4);
          const f32x4 ka0 = *(const f32x4*)(kaw + c), ka1 = *(const f32x4*)(kaw + c + 4), rk0 = *(const f32x4*)(rkw + c), rk1 = *(const f32x4*)(rkw + c + 4);
          const f32x4 gg0 = *(const f32x4*)(gng + c), gg1 = *(const f32x4*)(gng + c + 4), gb0 = *(const f32x4*)(gnb + c), gb1 = *(const f32x4*)(gnb + c + 4);
          float r[8], k[8], v[8]; float bon = 0.f;
#pragma unroll
          for (int j = 0; j < 4; ++j) { r[2 * j] = bflo(rw[j]); r[2 * j + 1] = bfhi(rw[j]); k[2 * j] = bflo(kw[j]); k[2 * j + 1] = bfhi(kw[j]); v[2 * j] = bflo(vw[j]); v[2 * j + 1] = bfhi(vw[j]); }
#pragma unroll
          for (int j = 0; j < 8; ++j) { const float a = j < 4 ? a0[j & 3] : a1[j & 3]; const float kp = k[j] * (1.0f + (a - 1.0f) * (j < 4 ? ka0[j & 3] : ka1[j & 3])); bon += r[j] * kp * (j < 4 ? rk0[j & 3] : rk1[j & 3]); }
          bon += __shfl_xor(bon, 1); bon += __shfl_xor(bon, 2); bon += __shfl_xor(bon, 4);
          float y[8];
#pragma unroll
          for (int j = 0; j < 8; ++j) { const float gn = o[j] * rstd * (j < 4 ? gg0[j & 3] : gg1[j & 3]) + (j < 4 ? gb0[j & 3] : gb1[j & 3]); y[j] = (gn + bon * v[j]) * (j < 4 ? g0[j & 3] : g1[j & 3]); }
          u32x4 w; w.x = pk2(y[0], y[1]); w.y = pk2(y[2], y[3]); w.z = pk2(y[4], y[5]); w.w = pk2(y[6], y[7]);
          *(u32x4*)(MIX + (size_t)t * D + C5 + c) = w; }
    }
}

#define DPPI(x, ctrl) __builtin_amdgcn_update_dpp(0, (x), (ctrl), 0xF, 0xF, true)
__device__ __forceinline__ float row16_max(float x) {
    x = fmaxf(x, __builtin_bit_cast(float, DPPI(__builtin_bit_cast(int, x), 0xB1))); x = fmaxf(x, __builtin_bit_cast(float, DPPI(__builtin_bit_cast(int, x), 0x4E)));
    x = fmaxf(x, __builtin_bit_cast(float, DPPI(__builtin_bit_cast(int, x), 0x141))); x = fmaxf(x, __builtin_bit_cast(float, DPPI(__builtin_bit_cast(int, x), 0x140))); return x; }
__device__ __forceinline__ int row16_min(int x) {
    x = min(x, DPPI(x, 0xB1)); x = min(x, DPPI(x, 0x4E)); x = min(x, DPPI(x, 0x141)); x = min(x, DPPI(x, 0x140)); return x; }
__device__ __forceinline__ void phase_ln1_route(const Params& p, const Frame& F, int l) {
    LAS unsigned char* wl = F.lds;
    LAS int* hist = (LAS int*)(F.lds + LDSX_OFF + 4096);
    LAS int* basep = hist + 32;
    LAS int* rinfo = hist + 64;
    LAS float* rgate = (LAS float*)(rinfo + 512);
    const float* mod = WSP(float, WS_MOD) + (size_t)l * NBATCH * 6144;
    const float* g1 = INP(I_LN1G) + (size_t)l * D; const float* b1 = INP(I_LN1B) + (size_t)l * D;
    const float* rb = INP(I_RB) + (size_t)l * NE;
    unsigned* cnt = (unsigned*)(F.ws + WS_CTL) + CW_CNT + l * 64;
    int* LIST = WSP(int, WS_LIST); float* GATEL = WSP(float, WS_GATEL); int* TOKSLOT = WSP(int, WS_TOKSLOT);
    float* X = WSP(float, WS_X); bf16* H = WSP(bf16, WS_H);
    const int lane = F.lane, li = lane & 15, g = lane >> 4;
    __syncthreads();
    for (int i = F.tid; i < 2 * 4096; i += NTHREADS) { const int part = i >> 12, rem = i & 4095, e = rem >> 7, ch = rem & 127;
        const u32x4 v = *(const u32x4*)(WSP(bf16, WS_RWT) + ((size_t)part * DEPTH + l) * NE * D + (size_t)e * D + ch * 8);
        *(LAS u32x4*)(wl + part * 65536 + e * 2048 + ((ch ^ (e & 15)) << 4)) = v; }
    __syncthreads();
    for (int chunk = F.vcu; chunk < T / 128; chunk += F.G) {
        __syncthreads();
        if (F.tid < 32) hist[F.tid] = 0;
        __syncthreads();
        const int row0 = chunk * 128 + F.wave * 16; const int b = row0 / SEQ;
        float mymean = 0.f, myrstd = 0.f;
#pragma unroll 1
        for (int rr = 0; rr < 16; ++rr) {
            const GAS f32x4* xr = (const GAS f32x4*)(X + (size_t)(row0 + rr) * D) + lane;
            f32x4 v[4]; float s = 0.f;
#pragma unroll
            for (int j = 0; j < 4; ++j) { v[j] = xr[64 * j]; s += (v[j].x + v[j].y) + (v[j].z + v[j].w); }
            const float mean = wave_sum(s) * (1.f / D); float s2 = 0.f;
#pragma unroll
            for (int j = 0; j < 4; ++j) { v[j] = v[j] - mean; s2 += (v[j].x * v[j].x + v[j].y * v[j].y) + (v[j].z * v[j].z + v[j].w * v[j].w); }
            const float rstd = __builtin_amdgcn_rsqf(wave_sum(s2) * (1.f / D) + LN_EPS);
            if (li == rr) { mymean = mean; myrstd = rstd; }
        }
        f32x4 acc0 = (f32x4){0.f, 0.f, 0.f, 0.f}, acc1 = acc0;
        float* xrow = X + (size_t)(row0 + li) * D + 8 * g; bf16* hrow = H + (size_t)(row0 + li) * D + 8 * g;
        const float* shp = mod + (size_t)b * 6144 + 3072 + 8 * g; const float* scp = mod + (size_t)b * 6144 + 4096 + 8 * g;
        const LAS unsigned char* w0 = wl + li * 2048; const LAS unsigned char* w1 = wl + (16 + li) * 2048;
#pragma unroll 2
        for (int s = 0; s < 32; ++s) {
            const int k = 32 * s;
            const f32x4 y0 = *(const f32x4*)(xrow + k), y1 = *(const f32x4*)(xrow + k + 4);
            const f32x4 ga0 = *(const f32x4*)(g1 + k + 8 * g), ga1 = *(const f32x4*)(g1 + k + 8 * g + 4), be0 = *(const f32x4*)(b1 + k + 8 * g), be1 = *(const f32x4*)(b1 + k + 8 * g + 4);
            const f32x4 sc0 = *(const f32x4*)(scp + k), sc1 = *(const f32x4*)(scp + k + 4), sh0 = *(const f32x4*)(shp + k), sh1 = *(const f32x4*)(shp + k + 4);
            const f32x4 x0 = (y0 - mymean) * myrstd * ga0 + be0, x1 = (y1 - mymean) * myrstd * ga1 + be1;
            *(f32x4*)(xrow + k) = x0; *(f32x4*)(xrow + k + 4) = x1;
            const f32x4 h0 = x0 * (sc0 + 1.0f) + sh0, h1 = x1 * (sc1 + 1.0f) + sh1;
            u32x4 hi; hi.x = cvtpk_c(h0.x, h0.y); hi.y = cvtpk_c(h0.z, h0.w); hi.z = cvtpk_c(h1.x, h1.y); hi.w = cvtpk_c(h1.z, h1.w);
            *(u32x4*)(hrow + k) = hi;
            u32x4 lo; lo.x = cvtpk_c(h0.x - bflo(hi.x), h0.y - bfhi(hi.x)); lo.y = cvtpk_c(h0.z - bflo(hi.y), h0.w - bfhi(hi.y)); lo.z = cvtpk_c(h1.x - bflo(hi.z), h1.y - bfhi(hi.z)); lo.w = cvtpk_c(h1.z - bflo(hi.w), h1.w - bfhi(hi.w));
            const int cho = ((4 * s + g) ^ li) << 4;
            const bf16x8 bh0 = *(const LAS bf16x8*)(w0 + cho), bh1 = *(const LAS bf16x8*)(w1 + cho), bl0 = *(const LAS bf16x8*)(w0 + 65536 + cho), bl1 = *(const LAS bf16x8*)(w1 + 65536 + cho);
            const bf16x8 ahi = __builtin_bit_cast(bf16x8, hi), alo = __builtin_bit_cast(bf16x8, lo);
            acc0 = __builtin_amdgcn_mfma_f32_16x16x32_bf16(ahi, bh0, acc0, 0, 0, 0); acc1 = __builtin_amdgcn_mfma_f32_16x16x32_bf16(ahi, bh1, acc1, 0, 0, 0);
            acc0 = __builtin_amdgcn_mfma_f32_16x16x32_bf16(alo, bh0, acc0, 0, 0, 0); acc1 = __builtin_amdgcn_mfma_f32_16x16x32_bf16(alo, bh1, acc1, 0, 0, 0);
            acc0 = __builtin_amdgcn_mfma_f32_16x16x32_bf16(ahi, bl0, acc0, 0, 0, 0); acc1 = __builtin_amdgcn_mfma_f32_16x16x32_bf16(ahi, bl1, acc1, 0, 0, 0);
        }
        const float rb0 = rb[li], rb1 = rb[16 + li];
#pragma unroll
        for (int reg = 0; reg < 4; ++reg) {
            float v0 = acc0[reg] + rb0, v1 = acc1[reg] + rb1;
            float tv0 = 0.f, tv1 = 0.f, tv2 = 0.f, tv3 = 0.f; int te0 = 0, te1 = 0, te2 = 0, te3 = 0;
#pragma unroll
            for (int k = 0; k < 4; ++k) { const float mx = row16_max(fmaxf(v0, v1));
                const int id = (v0 == mx) ? li : ((v1 == mx) ? 16 + li : 99); const int ek = row16_min(id);
                if (k == 0) { tv0 = mx; te0 = ek; } else if (k == 1) { tv1 = mx; te1 = ek; } else if (k == 2) { tv2 = mx; te2 = ek; } else { tv3 = mx; te3 = ek; }
                if (ek == li) v0 = -INFINITY; if (ek == 16 + li) v1 = -INFINITY; }
            const float e1 = __expf(tv1 - tv0), e2 = __expf(tv2 - tv0), e3 = __expf(tv3 - tv0); const float inv = __builtin_amdgcn_rcpf(1.0f + e1 + e2 + e3);
            if (li < 4) { const int lr = F.wave * 16 + 4 * g + reg; const int ek = li == 0 ? te0 : li == 1 ? te1 : li == 2 ? te2 : te3; const float gk = (li == 0 ? 1.0f : li == 1 ? e1 : li == 2 ? e2 : e3) * inv;
                const int lp = __hip_atomic_fetch_add(&hist[ek], 1, __ATOMIC_RELAXED, __HIP_MEMORY_SCOPE_WORKGROUP); rinfo[lr * 4 + li] = (ek << 16) | lp; rgate[lr * 4 + li] = gk; }
        }
        __syncthreads();
        if (F.tid < 32) basep[F.tid] = (int)__hip_atomic_fetch_add(cnt + F.tid, (unsigned)hist[F.tid], RLX_AGENT);
        __syncthreads();
        { const int lr = F.tid >> 2, k = F.tid & 3; const int m = chunk * 128 + lr; const int info = rinfo[F.tid]; const int ek = info >> 16; const int pos = basep[ek] + (info & 0xffff);
          LIST[ek * CAP + pos] = m; GATEL[ek * CAP + pos] = rgate[F.tid]; TOKSLOT[m * 4 + k] = (ek << 16) | pos; }
    }
    __syncthreads();
}

__device__ __forceinline__ void moe_tables(const Frame& F, int l) {
    LAS int* tb = (LAS int*)(F.lds + TB_OFF); LAS int* cn = tb + 40;
    const unsigned* cnt = (const unsigned*)(F.ws + WS_CTL) + CW_CNT + l * 64;
    __syncthreads();
    if (F.tid == 0) { int acc = 0;
        for (int e = 0; e < NE; ++e) { const int c = (int)__hip_atomic_load(cnt + e, RLX_AGENT); cn[e] = c; tb[e] = acc; acc += (c + 255) >> 8; }
        tb[NE] = acc; }
    __syncthreads();
}

__device__ __forceinline__ void phase_combine(const Params& p, const Frame& F, int l) {
    const LAS int* tb = (const LAS int*)(F.lds + TB_OFF);
    const int gw = F.vcu * NWAVES + F.wave, NGW = F.G * NWAVES; const int lane = F.lane;
    const float* mod = WSP(float, WS_MOD) + (size_t)l * NBATCH * 6144; const float* modn = WSP(float, WS_MOD) + (size_t)(l + 1) * NBATCH * 6144;
    const float* g2 = INP(I_LN2G) + (size_t)l * D; const float* b2 = INP(I_LN2B) + (size_t)l * D;
    const bf16* Y = WSP(bf16, WS_Y); const int* TOKSLOT = WSP(int, WS_TOKSLOT);
    const bool lastl = (l == DEPTH - 1);
    for (int m = gw; m < T; m += NGW) {
        const int b = m / SEQ;
        int srow[4];
#pragma unroll
        for (int k = 0; k < 4; ++k) { const int ts = TOKSLOT[m * 4 + k]; const int e = ts >> 16, pos = ts & 0xffff; srow[k] = tb[e] * 256 + pos; }
        GAS f32x4* xr = (GAS f32x4*)(WSP(float, WS_X) + (size_t)m * D) + lane;
        f32x4 v[4]; float s = 0.f;
#pragma unroll
        for (int j = 0; j < 4; ++j) { const int c = 4 * lane + 256 * j; f32x4 y = (f32x4){0.f, 0.f, 0.f, 0.f};
#pragma unroll
            for (int k = 0; k < 4; ++k) { const u32x2 yw = *(const u32x2*)(Y + (size_t)srow[k] * D + c); y.x += bflo(yw.x); y.y += bfhi(yw.x); y.z += bflo(yw.y); y.w += bfhi(yw.y); }
            const f32x4 gt = *(const f32x4*)(mod + (size_t)b * 6144 + 5120 + c) + 1.0f;
            v[j] = xr[64 * j] * DN_ALPHA + gt * y; s += (v[j].x + v[j].y) + (v[j].z + v[j].w); }
        const float mean = wave_sum(s) * (1.f / D); float s2 = 0.f;
#pragma unroll
        for (int j = 0; j < 4; ++j) { v[j] = v[j] - mean; s2 += (v[j].x * v[j].x + v[j].y * v[j].y) + (v[j].z * v[j].z + v[j].w * v[j].w); }
        const float rstd = 1.f / sqrtf(wave_sum(s2) * (1.f / D) + LN_EPS);
        GAS f32x4* oo = (GAS f32x4*)(p.out + (size_t)m * D) + lane;
        GAS u32x2* ho = (GAS u32x2*)(WSP(bf16, WS_H) + (size_t)m * D) + lane;
#pragma unroll
        for (int j = 0; j < 4; ++j) { const int c = 4 * lane + 256 * j;
            const f32x4 g = *(const f32x4*)(g2 + c), be = *(const f32x4*)(b2 + c);
            const f32x4 x2 = v[j] * rstd * g + be;
            if (lastl) oo[64 * j] = x2;
            else { xr[64 * j] = x2;
                const f32x4 sh = *(const f32x4*)(modn + (size_t)b * 6144 + c), sc = *(const f32x4*)(modn + (size_t)b * 6144 + 1024 + c);
                const f32x4 h = x2 * (sc + 1.0f) + sh; u32x2 w; w.x = pk2(h.x, h.y); w.y = pk2(h.z, h.w); ho[64 * j] = w; } }
    }
}

constexpr int PH_PER_LAYER = 11, N_PHASES = 2 + DEPTH * PH_PER_LAYER;
__global__ void __launch_bounds__(NTHREADS, 2) fwd(Params p) {
    extern __shared__ __attribute__((aligned(16))) unsigned char lds[];
    Frame F;
    F.lds = (LAS unsigned char*)lds; F.tid = threadIdx.x; F.lane = F.tid & 63; F.wave = __builtin_amdgcn_readfirstlane(F.tid >> 6);
    F.G = gridDim.x; { const int bx = blockIdx.x; F.vcu = (F.G % 8 == 0) ? (bx % 8) * (F.G / 8) + bx / 8 : bx; }
    F.ws = p.ws;
    volatile LAS unsigned* MISC = (volatile LAS unsigned*)(F.lds + MISC_OFF);
    if (F.tid < 64) MISC[F.tid] = 0u;
    __syncthreads();
    unsigned* ctl = (unsigned*)(p.ws + WS_CTL);
#if MK_ONE_LAUNCH
    XcdBarrier bar = xcd_barrier_post(ctl + CW_BAR, MISC + 8);
#define GRID_BAR() xcd_barrier(bar)
#else
#define GRID_BAR() do {} while (0)
#endif
    const int lo = p.ph_lo, hi = p.ph_hi;
#ifndef PH_MASK
#define PH_MASK 0xFFFFFFFFu
#endif
#define IN(k) (lo <= (k) && (k) < hi)
#define EN(j) ((PH_MASK >> (j)) & 1u)
#define SEAM(k) do { if (IN(k) && IN((k) + 1)) GRID_BAR(); } while (0)
    LAS unsigned char* ring = F.lds;

    if (EN(0) && IN(0)) { for (int rep = 0; rep < REP_PRO; ++rep) phase_prologue(p, F); } SEAM(0);
    if (EN(1) && IN(1)) { phase_ln0(p, F); } SEAM(1);
#define LAYER_BODY \
        constexpr int pb = 2 + l * PH_PER_LAYER; \
        const float* mod = WSP(float, WS_MOD) + (size_t)l * NBATCH * 6144; \
        if (EN(2) && IN(pb + 0)) { \
            pg8::Gemm g{WSP(bf16, WS_H), WSP(bf16, WS_WINT) + (size_t)l * N_INP * D, T, N_INP, D}; pg8::DenseOrder S; S.init(T, N_INP, F.G, (int)blockIdx.x); \
            pg8::EpiBf16Plain E{WSP(bf16, WS_P), N_INP}; \
            for (int rep = 0; rep < REP_WIN; ++rep) pg8::gemm_phase<pg8::EpiBf16Plain, pg8::DenseOrder, true>(ring, g, S, E); \
        } SEAM(pb + 0); \
        if (EN(3) && IN(pb + 1)) { for (int rep = 0; rep < REP_PREP; ++rep) phase_prep(p, F, l); } SEAM(pb + 1); \
        if (EN(4) && IN(pb + 2)) { \
            if (EN(13)) { pg8::Gemm g{WSP(bf16, WS_AN), WSP(bf16, WS_WUPT) + (size_t)l * N_UP * K_UP, T, N_UP, K_UP}; pg8::DenseOrder S; S.init(T, N_UP, F.G, (int)blockIdx.x); \
              pg8::EpiMlaUp E{WSP(bf16, WS_Q), WSP(bf16, WS_KK), WSP(bf16, WS_V), WSP(float, WS_CS)}; \
              pg8::gemm_phase<pg8::EpiMlaUp, pg8::DenseOrder, true>(ring, g, S, E); } \
            if (EN(14)) { pg8::Gemm g{WSP(bf16, WS_A2), WSP(bf16, WS_WSMT) + (size_t)l * N_SM * K_SM, T, N_SM, K_SM}; pg8::DenseOrder S; S.init(T, N_SM, F.G, (int)blockIdx.x); \
              pg8::EpiRwkvSmall E{WSP(float, WS_WAG), INP(I_W0) + (size_t)l * C5, INP(I_A0) + (size_t)l * C5}; \
              pg8::gemm_phase<pg8::EpiRwkvSmall, pg8::DenseOrder, true>(ring, g, S, E); } \
            if (EN(15) && l > 0) { pg8::Gemm g{WSP(bf16, WS_VS1), WSP(bf16, WS_WV12T), T, C5, C5}; pg8::DenseOrder S; S.init(T, C5, F.G, (int)blockIdx.x); \
              pg8::EpiVres E{WSP(bf16, WS_VS1), WSP(bf16, WS_VS0), WSP(bf16, WS_VR), INP(I_V0)}; \
              pg8::gemm_phase<pg8::EpiVres, pg8::DenseOrder, true>(ring, g, S, E); } \
        } SEAM(pb + 2); \
        if (EN(5) && IN(pb + 3)) { phase_rwkv_r1(p, F, l); } SEAM(pb + 3); \
        if (EN(6) && IN(pb + 4)) { phase_rwkv_r2(p, F); phase_attn(p, F, (char*)lds, l); } SEAM(pb + 4); \
        if (EN(7) && IN(pb + 5)) { for (int rep = 0; rep < REP_MIX; ++rep) phase_mix(p, F, l); } SEAM(pb + 5); \
        if (EN(8) && IN(pb + 6)) { \
            pg8::Gemm g{WSP(bf16, WS_MIX), WSP(bf16, WS_WOT) + (size_t)l * D * D, T, D, D}; pg8::DenseOrder S; S.init(T, D, F.G, (int)blockIdx.x); \
            pg8::EpiWo E{WSP(float, WS_X), mod + 2048}; \
            pg8::gemm_phase<pg8::EpiWo, pg8::DenseOrder, true>(ring, g, S, E); \
        } SEAM(pb + 6); \
        if (EN(9) && IN(pb + 7)) { phase_ln1_route(p, F, l); } SEAM(pb + 7); \
        if (EN(10) && IN(pb + 8)) { \
            moe_tables(F, l); \
            const LAS int* tb = (const LAS int*)(F.lds + TB_OFF); \
            pg8::Gemm g{WSP(bf16, WS_H), WSP(bf16, WS_W1T) + (size_t)l * NE * 2048 * D, T, 2048, D}; \
            pg8::MoeOrder<true> S{tb, tb + 40, WSP(int, WS_LIST), 8, F.G, F.vcu, (LAS unsigned*)(F.lds + GT_OFF)}; \
            pg8::EpiSwiglu E{WSP(bf16, WS_H1), WSP(float, WS_B1P) + (size_t)l * NE * 2048}; \
            for (int rep = 0; rep < REP_MOE1; ++rep) pg8::gemm_phase<pg8::EpiSwiglu, pg8::MoeOrder<true>, true>(ring, g, S, E); \
        } SEAM(pb + 8); \
        if (EN(11) && IN(pb + 9)) { \
            moe_tables(F, l); \
            const LAS int* tb = (const LAS int*)(F.lds + TB_OFF); \
            pg8::Gemm g{WSP(bf16, WS_H1), WSP(bf16, WS_W2T) + (size_t)l * NE * D * FF, MAXSLOT, D, FF}; \
            pg8::MoeOrder<false> S{tb, tb + 40, nullptr, 4, F.G, F.vcu, nullptr}; \
            pg8::EpiMoeOut E{WSP(bf16, WS_Y), INP(I_EB2) + (size_t)l * NE * D, WSP(float, WS_GATEL), tb}; \
            for (int rep = 0; rep < REP_MOE2; ++rep) pg8::gemm_phase<pg8::EpiMoeOut, pg8::MoeOrder<false>, true>(ring, g, S, E); \
        } SEAM(pb + 9); \
        if (EN(12) && IN(pb + 10)) { moe_tables(F, l); phase_combine(p, F, l); } SEAM(pb + 10);
    { constexpr int l = 0; LAYER_BODY }
    { constexpr int l = 1; LAYER_BODY }
#undef LAYER_BODY
#undef IN
#undef SEAM
}

extern "C" void kernel_launch(void* const* d_in, const int* in_sizes, int n_in, void* d_out, int out_size, void* d_ws, size_t ws_size, hipStream_t stream) {
    static int grid = 0;
    if (grid == 0) {
        if (n_in != N_INPUTS || out_size != T * D || ws_size < WS_END) { fprintf(stderr, "kernel_launch: unexpected problem: n_in %d out %d ws %zu\n", n_in, out_size, ws_size); grid = -1; return; }
        int dev = 0, cus = 0, per_cu = 0;
        if (hipGetDevice(&dev) != hipSuccess || hipDeviceGetAttribute(&cus, hipDeviceAttributeMultiprocessorCount, dev) != hipSuccess) { grid = -1; return; }
        if (hipFuncSetAttribute((const void*)fwd, hipFuncAttributeMaxDynamicSharedMemorySize, LDS_BYTES) != hipSuccess) { fprintf(stderr, "kernel_launch: hipFuncSetAttribute failed\n"); grid = -1; return; }
        if (hipOccupancyMaxActiveBlocksPerMultiprocessor(&per_cu, (const void*)fwd, NTHREADS, LDS_BYTES) != hipSuccess || per_cu < 1) fprintf(stderr, "kernel_launch: occupancy query reports %d\n", per_cu);
        (void)hipGetLastError();
        grid = cus;
    }
    if (grid < 0) return;
    if (hipMemsetAsync((char*)d_ws + WS_CTL, 0, CTL_ZERO_BYTES, stream) != hipSuccess) return;
    Params p{};
    for (int i = 0; i < N_INPUTS; ++i) p.in[i] = d_in[i];
    p.out = (float*)d_out; p.ws = (unsigned char*)d_ws;
#if MK_ONE_LAUNCH
    p.ph_lo = 0; p.ph_hi = N_PHASES;
    hipLaunchKernelGGL(fwd, dim3(grid), dim3(NTHREADS), LDS_BYTES, stream, p);
#else
    for (int ph = 0; ph < N_PHASES; ++ph) { p.ph_lo = ph; p.ph_hi = ph + 1; hipLaunchKernelGGL(fwd, dim3(grid), dim3(NTHREADS), LDS_BYTES, stream, p); }
#endif
}
```

```cpp
#include <hip/hip_runtime.h>
#include <cstdio>
#include <cstdint>

#define REP_PRO 1
#define REP_ATTN 1
#define REP_RWKV 1
#define REP_MOE1 1
#define REP_MOE2 1
#define REP_WIN 1
#define REP_PREP 1
#define REP_MIX 1
#ifndef MK_ONE_LAUNCH
#define MK_ONE_LAUNCH 1
#endif

#define GAS __attribute__((address_space(1)))
#define LAS __attribute__((address_space(3)))
typedef unsigned short bf16;
typedef short bf16x8 __attribute__((ext_vector_type(8)));
typedef short s16x4 __attribute__((ext_vector_type(4)));
typedef float f32x2 __attribute__((ext_vector_type(2)));
typedef float f32x4 __attribute__((ext_vector_type(4)));
typedef float f32x16 __attribute__((ext_vector_type(16)));
typedef unsigned u32x2 __attribute__((ext_vector_type(2)));
typedef unsigned u32x4 __attribute__((ext_vector_type(4)));

constexpr int D = 1024, NBATCH = 8, SEQ = 4096, T = NBATCH * SEQ, DEPTH = 2;
constexpr int MLA_IN = 416, RWKV_IN = 1792, N_IN = 2208, N_INP = 2304;
constexpr int QLR = 256, KVLR = 128, ROPE = 32, NOPE = 64, QKD = 96, VD = 64, NH = 8;
constexpr int C5 = 512;
constexpr int NE = 32, TOPK = 4, FF = 1024, CAP = 32768;
constexpr int N_UP = 1792, K_UP = 384, N_SM = 1536, K_SM = 256;
constexpr int MAXSLOT = 139264;
constexpr float DN_ALPHA = 1.4142135623730951f;
constexpr float C2Q = 0.14724444602590306f;
constexpr float LN_EPS = 1e-5f, RMS_EPS = 1e-6f, GN_EPS = 64e-5f;
constexpr int NWAVES = 8, NTHREADS = 512;

enum { I_X = 0, I_C, I_POS, I_ELNG, I_ELNB, I_ADAW, I_ADAB, I_WIN, I_QNG, I_WUQ, I_KVNG, I_WUK, I_WUV, I_MOUTG, I_MU, I_W0, I_W2, I_A0, I_A2, I_G2,
       I_KK, I_KA, I_RK, I_GNG, I_GNB, I_V0, I_V1, I_V2, I_WO, I_LN1G, I_LN1B, I_RW, I_RB, I_EW1, I_EB1, I_EW2, I_EB2, I_LN2G, I_LN2B, N_INPUTS };

constexpr size_t MiB = 1u << 20;
constexpr size_t WS_CTL = 0, CTL_ZERO_BYTES = 4 * MiB;
constexpr size_t WS_MOD = 4 * MiB, WS_B1P = 5 * MiB, WS_CS = 6 * MiB, WS_LIST = 10 * MiB, WS_GATEL = 14 * MiB, WS_TOKSLOT = 18 * MiB;
constexpr size_t WS_RWT = 19 * MiB;
constexpr size_t WS_WINT = 20 * MiB, WS_WUPT = 30 * MiB, WS_WSMT = 33 * MiB, WS_WV12T = 35 * MiB, WS_WOT = 36 * MiB, WS_W1T = 40 * MiB, WS_W2T = 296 * MiB;
constexpr size_t WS_X = 424 * MiB, WS_H = 552 * MiB, WS_VS0 = 616 * MiB, WS_VS1 = 648 * MiB;
constexpr size_t WS_P = 680 * MiB, WS_AN = 824 * MiB, WS_A2 = 848 * MiB, WS_RK = 864 * MiB, WS_Q = 928 * MiB, WS_KK = 976 * MiB, WS_V = 1024 * MiB, WS_O = 1056 * MiB;
constexpr size_t WS_WAG = 1088 * MiB, WS_RO = 1280 * MiB, WS_MIX = 1344 * MiB, WS_VR = 1408 * MiB;
constexpr size_t WS_H1 = 680 * MiB, WS_Y = 952 * MiB;
constexpr size_t WS_CH = 1440 * MiB;
constexpr size_t WS_END = 1696 * MiB;
constexpr int CW_TMO = 0, CW_CODE = 1, CW_BAR = 4096, CW_CNT = 8192, CW_ATTQ = 8448;

constexpr int RING_BYTES = 131072;
constexpr int LDSX_OFF = RING_BYTES;
constexpr int MISC_OFF = LDSX_OFF;
constexpr int TB_OFF = LDSX_OFF + 256;
constexpr int GT_OFF = LDSX_OFF + 1024;
constexpr int LDS_BYTES = 147456;

#define RLX_AGENT __ATOMIC_RELAXED, __HIP_MEMORY_SCOPE_AGENT
#define LDS_WAIT() asm volatile("s_waitcnt lgkmcnt(0)" ::: "memory")
#define VM_WAIT() asm volatile("s_waitcnt vmcnt(0)" ::: "memory")

__device__ __forceinline__ unsigned f2bf(float f) { unsigned u = __builtin_bit_cast(unsigned, f); return (u + 0x7fffu + ((u >> 16) & 1u)) >> 16; }
__device__ __forceinline__ unsigned pk2(float lo, float hi) { return f2bf(lo) | (f2bf(hi) << 16); }
__device__ __forceinline__ float bf2f(unsigned b) { return __builtin_bit_cast(float, b << 16); }
__device__ __forceinline__ float bflo(unsigned w) { return __builtin_bit_cast(float, w << 16); }
__device__ __forceinline__ float bfhi(unsigned w) { return __builtin_bit_cast(float, w & 0xffff0000u); }
__device__ __forceinline__ unsigned cvt_pk_bf16(float lo, float hi) { unsigned r; asm volatile("v_cvt_pk_bf16_f32 %0, %1, %2" : "=v"(r) : "v"(lo), "v"(hi)); return r; }
typedef __bf16 bf16x2_t __attribute__((ext_vector_type(2)));
__device__ __forceinline__ unsigned cvtpk_c(float lo, float hi) { f32x2 v = {lo, hi}; bf16x2_t b = __builtin_convertvector(v, bf16x2_t); return __builtin_bit_cast(unsigned, b); }
__device__ __forceinline__ float wave_sum(float v) {
#pragma unroll
    for (int o = 1; o < 64; o <<= 1) v += __shfl_xor(v, o);
    return v;
}
__device__ __forceinline__ float sigmoidf_(float x) { return __builtin_amdgcn_rcpf(1.0f + __expf(-x)); }
__device__ __forceinline__ float tanhf_(float x) { return 1.0f - 2.0f * __builtin_amdgcn_rcpf(1.0f + __expf(2.0f * x)); }

#define XB_TMO      128
#define XB_XCNT(j)  (256  + 64 * (j))
#define XB_XSUB(j)  (1280 + 64 * (j))
#define XB_XGEN(j)  (2304 + 64 * (j))
#define XB_TOP      3328
#define XB_TOPGEN   3392
#define XCD_BAR_WORDS 3456
#define XB_SPIN_CAP (1u << 18)
__device__ __forceinline__ unsigned xb_ld(unsigned* p)              { return __hip_atomic_load(p, __ATOMIC_RELAXED, __HIP_MEMORY_SCOPE_AGENT); }
__device__ __forceinline__ unsigned xb_add(unsigned* p, unsigned v) { return __hip_atomic_fetch_add(p, v, __ATOMIC_RELAXED, __HIP_MEMORY_SCOPE_AGENT); }
__device__ __forceinline__ unsigned xb_xcc_id() { return (unsigned)__builtin_amdgcn_s_getreg((3 << 11) | 20) & 0xFu; }
#define XB_SPIN(cond, bar) do { unsigned _sp = 0; while (cond) { __builtin_amdgcn_s_sleep(1); \
    if ((++_sp & 255u) == 0u) { if (xb_ld(&(bar)[XB_TMO])) break; if (_sp > XB_SPIN_CAP) { atomicAdd(&(bar)[XB_TMO], 1u); break; } } } } while (0)
struct XcdBarrier { unsigned* bar; unsigned x; volatile LAS unsigned* st; };
__device__ __forceinline__ XcdBarrier xcd_barrier_post(unsigned* bar, volatile LAS unsigned* st) {
    XcdBarrier b; b.bar = bar; b.x = xb_xcc_id(); b.st = st;
    if (threadIdx.x == 0) (void)xb_add(&bar[XB_XCNT(b.x)], 1u);
    return b;
}
__device__ __forceinline__ void xcd_barrier_complete(unsigned* bar, unsigned x, unsigned& nloc, unsigned& nx) {
    const unsigned G = gridDim.x * gridDim.y * gridDim.z;
    unsigned sum, cnt, mine, sp = 0u;
    for (;;) {
        sum = 0u; cnt = 0u; mine = 0u;
#pragma unroll
        for (unsigned j = 0; j < 16; ++j) { const unsigned c = xb_ld(&bar[XB_XCNT(j)]); sum += c; cnt += (c > 0u) ? 1u : 0u; mine = (j == x) ? c : mine; }
        if (sum == G) break;
        __builtin_amdgcn_s_sleep(1);
        if ((++sp & 255u) == 0u) { if (xb_ld(&bar[XB_TMO])) break; if (sp > XB_SPIN_CAP) { atomicAdd(&bar[XB_TMO], 1u); break; } }
    }
    nloc = mine > 0u ? mine : 1u; nx = cnt > 0u ? cnt : 1u;
}
__device__ __forceinline__ void xcd_barrier(const XcdBarrier& b) {
    asm volatile("s_waitcnt vmcnt(0)" ::: "memory");
    __syncthreads();
    if (threadIdx.x == 0) {
        unsigned* bar = b.bar;
        __builtin_amdgcn_s_waitcnt(0);
        unsigned nloc = b.st[0], nx = b.st[1];
        if (nloc == 0u) { xcd_barrier_complete(bar, b.x, nloc, nx); b.st[0] = nloc; b.st[1] = nx; }
        const unsigned old = xb_add(&bar[XB_XSUB(b.x)], 1u);
        const unsigned gen = old / nloc;
        if (old + 1u == (gen + 1u) * nloc) {
            __builtin_amdgcn_fence(__ATOMIC_RELEASE, "agent");
            asm volatile("s_waitcnt vmcnt(0)" ::: "memory");
            const unsigned og = xb_add(&bar[XB_TOP], 1u);
            const unsigned tg = og / nx;
            if (og + 1u == (tg + 1u) * nx) xb_add(&bar[XB_TOPGEN], 1u);
            else XB_SPIN(xb_ld(&bar[XB_TOPGEN]) == tg, bar);
            __builtin_amdgcn_fence(__ATOMIC_ACQUIRE, "agent");
            xb_add(&bar[XB_XGEN(b.x)], 1u);
            asm volatile("s_waitcnt vmcnt(0)" ::: "memory");
        } else {
            XB_SPIN(xb_ld(&bar[XB_XGEN(b.x)]) == gen, bar);
            __builtin_amdgcn_fence(__ATOMIC_ACQUIRE, "agent");
            asm volatile("s_waitcnt vmcnt(0)" ::: "memory");
        }
    }
    __syncthreads();
}

namespace pg8 {
constexpr int BM = 256, BK = 64, HALF = 128, HTB = HALF * BK * 2, STAGE_BYTES = 8 * HTB, NXCD = 8, WGM = 8;
__device__ __forceinline__ int lds_byte(int r, int c) { const int st = (r >> 4) * 2 + (c >> 5), rr = r & 15, cc = c & 31, ob = rr * 64 + cc * 2; return st * 1024 + (ob ^ (((ob >> 9) & 1) << 5)); }
__device__ __forceinline__ void stage_rc(int b, int& R, int& C) { const int st = b / 1024, sb = b % 1024, swz = sb ^ (((sb >> 9) & 1) << 5); R = (st >> 1) * 16 + swz / 64; C = (st & 1) * 32 + (swz % 64) / 2; }
__device__ __forceinline__ int perm32(int rho) { const int n = rho >> 4, i = rho & 15; return 8 * (i >> 2) + 4 * n + (i & 3); }

struct Unit { int pm, pn, e; };
struct Gemm { const bf16* A; const bf16* Bt; int M, N, K; };

struct DenseOrder {
    int nM, nN, nwg, G, c;
    __device__ __forceinline__ void init(int M, int N, int G_, int c_) { nM = M / BM; nN = N / BM; nwg = nM * nN; G = G_; c = c_; }
    __device__ __forceinline__ bool next(int i, Unit& u) const {
        const long L = (long)i * G + c; if (L >= nwg) return false;
        int wgid = (int)L; { const int q = nwg / NXCD, r = nwg % NXCD, xcd = wgid % NXCD, off = wgid / NXCD; wgid = (xcd < r ? xcd * (q + 1) : r * (q + 1) + (xcd - r) * q) + off; }
        const int nig = WGM * nN, gid = wgid / nig, fm = gid * WGM, gsz = (nM - fm) < WGM ? (nM - fm) : WGM;
        u.pm = fm + ((wgid % nig) % gsz); u.pn = (wgid % nig) / gsz; u.e = 0; return true;
    }
    static constexpr bool GATHER = false;
    __device__ __forceinline__ size_t b_off(const Unit& u, int N, int K) const { return (size_t)u.pn * BM * K * 2; }
    __device__ __forceinline__ unsigned a_row_off(const Unit& u, int row, int K) const { return 0u; }
    __device__ __forceinline__ LAS unsigned* gtab() const { return nullptr; }
};
template <bool GATHER_> struct MoeOrder {
    static constexpr bool GATHER = GATHER_;
    const LAS int* tb; const LAS int* cnt; const int* list; int nN, G, c; LAS unsigned* gt_;
    __device__ __forceinline__ LAS unsigned* gtab() const { return gt_; }
    __device__ __forceinline__ bool next(int i, Unit& u) const {
        const int L = i * G + c; const int total = tb[NE] * nN; if (L >= total) return false;
        int e = 0;
#pragma unroll 1
        for (int j = 1; j < NE; ++j) if (tb[j] * nN <= L) e = j;
        const int Lr = L - tb[e] * nN, nte = tb[e + 1] - tb[e];
        const int mblk = Lr / (4 * nN), m0 = mblk * 4, gsz = (nte - m0) < 4 ? (nte - m0) : 4, rem = Lr - mblk * 4 * nN;
        u.e = e; u.pn = rem / gsz; u.pm = tb[e] + m0 + (rem % gsz); return true;
    }
    __device__ __forceinline__ size_t b_off(const Unit& u, int N, int K) const { return ((size_t)u.e * N + (size_t)u.pn * BM) * K * 2; }
    __device__ __forceinline__ unsigned a_row_off(const Unit& u, int row, int K) const {
        const int pos = (u.pm - tb[u.e]) * BM + row; const int tok = pos < cnt[u.e] ? list[u.e * CAP + pos] : 0; return (unsigned)tok * (unsigned)(K * 2);
    }
};

template <class Epi, class Sched, bool ALIGN_EPI>
__device__ __forceinline__ void gemm_phase(LAS unsigned char* lds, const Gemm g, const Sched& S, const Epi& E) {
    const int tid = threadIdx.x, wid = __builtin_amdgcn_readfirstlane(tid >> 6), lane = tid & 63, wr = wid >> 2, wc = wid & 3, fr = lane & 15, fq = lane >> 4;
    const int K = g.K, nt = K / BK;
    int RA[2]; unsigned CA[2], voffA[2], voffB[2];
#pragma unroll
    for (int i = 0; i < 2; ++i) { int R, C; stage_rc(tid * 16 + i * 8192, R, C); const int Rb = Epi::PERM ? ((R & ~31) + perm32(R & 31)) : R;
        RA[i] = R; CA[i] = (unsigned)C * 2u; voffA[i] = (unsigned)(R * K + C) * 2u; voffB[i] = (unsigned)(Rb * K + C) * 2u; }
    const size_t kstep = (size_t)(BK * 2);
    const size_t hstep = (size_t)HALF * K * 2;
    const size_t tstep = 2 * hstep;
    const unsigned ldsw = (unsigned)wid * 1024u;
    const int aoff = lds_byte(wr * 64 + fr, fq * 8), boff = lds_byte(wc * 32 + fr, fq * 8);
    const char* Abase = (const char*)g.A;
    LAS unsigned* gtb = S.gtab();
#define PG8_SA(b, h) (((b) * 2 + (h)) * HTB)
#define PG8_SB(b, h) ((4 + (b) * 2 + (h)) * HTB)
#define PG8_STAGE(bufoff, gbase, voff) do { _Pragma("unroll") for (int _i = 0; _i < 2; ++_i) \
        __builtin_amdgcn_global_load_lds((const unsigned*)((const char*)(gbase) + (voff)[_i]), (LAS unsigned*)(lds + (bufoff) + ldsw + _i * 8192), 16, 0, 0); } while (0)
#define PG8_STAGEA(bufoff, h, kb, nx) do { \
        if constexpr (Sched::GATHER) { const LAS unsigned* tp_ = gtb + ((nx) ? tnx : tcu) + (h) * HALF; const unsigned o0_ = tp_[RA[0]] + CA[0], o1_ = tp_[RA[1]] + CA[1]; \
            __builtin_amdgcn_global_load_lds((const unsigned*)(Abase + (size_t)(kb) + o0_), (LAS unsigned*)(lds + (bufoff) + ldsw), 16, 0, 0); \
            __builtin_amdgcn_global_load_lds((const unsigned*)(Abase + (size_t)(kb) + o1_), (LAS unsigned*)(lds + (bufoff) + ldsw + 8192), 16, 0, 0); } \
        else { const char* gb_ = ((nx) ? nA : cA) + (size_t)(h) * hstep + (size_t)(kb); PG8_STAGE(bufoff, gb_, voffA); } } while (0)
#define PG8_LDA(dst, b, h) do { _Pragma("unroll") for (int m = 0; m < 4; ++m) _Pragma("unroll") for (int k = 0; k < 2; ++k) dst[m][k] = *(const LAS bf16x8*)(lds + PG8_SA(b, h) + aoff + m * 2048 + k * 1024); } while (0)
#define PG8_LDB(dst, b, h) do { _Pragma("unroll") for (int n = 0; n < 2; ++n) _Pragma("unroll") for (int k = 0; k < 2; ++k) dst[n][k] = *(const LAS bf16x8*)(lds + PG8_SB(b, h) + boff + n * 2048 + k * 1024); } while (0)
#define PG8_MMA(ai, bj, At, Bt) do { __builtin_amdgcn_s_setprio(1); _Pragma("unroll") for (int m = 0; m < 4; ++m) _Pragma("unroll") for (int n = 0; n < 2; ++n) _Pragma("unroll") for (int k = 0; k < 2; ++k) \
        acc[ai][bj][m][n] = __builtin_amdgcn_mfma_f32_16x16x32_bf16(Bt[n][k], At[m][k], acc[ai][bj][m][n], 0, 0, 0); __builtin_amdgcn_s_setprio(0); } while (0)
#define PG8_WAIT_V(n) asm volatile("s_waitcnt vmcnt(" #n ")" ::: "memory")
#define PG8_WAIT_L(n) asm volatile("s_waitcnt lgkmcnt(" #n ")" ::: "memory")
#define PG8_BAR __builtin_amdgcn_s_barrier()
#define PG8_SCHED __builtin_amdgcn_sched_barrier(0)
    Unit cur, nxt; int ui = 0;
    if (!S.next(0, cur)) return;
    f32x4 acc[2][2][4][2];
#pragma unroll
    for (int a = 0; a < 2; ++a)
#pragma unroll
        for (int b = 0; b < 2; ++b)
#pragma unroll
            for (int m = 0; m < 4; ++m)
#pragma unroll
                for (int n = 0; n < 2; ++n) acc[a][b][m][n] = (f32x4){0.f, 0.f, 0.f, 0.f};
    bf16x8 At[4][2], B0[2][2], B1[2][2];
    const char* cA = Abase + (size_t)cur.pm * tstep; const char* cB = (const char*)g.Bt + S.b_off(cur, g.N, K);
    const char* nA = cA; const char* nB = cB;
    int tcu = 0, tnx = 0;
    if constexpr (Sched::GATHER) {
        if (tid < BM) gtb[tid] = S.a_row_off(cur, tid, K);
        asm volatile("s_waitcnt vmcnt(0) lgkmcnt(0)" ::: "memory"); PG8_BAR; asm volatile("" ::: "memory");
    }
    PG8_STAGE(PG8_SB(0, 0), cB, voffB); PG8_STAGE(PG8_SB(0, 1), cB + hstep, voffB); PG8_STAGEA(PG8_SA(0, 0), 0, 0, false); PG8_STAGEA(PG8_SA(0, 1), 1, 0, false);
    if (wr == 1) PG8_BAR;
    PG8_WAIT_V(2); PG8_BAR;
    PG8_STAGE(PG8_SB(1, 0), cB + kstep, voffB); PG8_STAGEA(PG8_SA(1, 0), 0, kstep, false); PG8_STAGE(PG8_SB(1, 1), cB + hstep + kstep, voffB);
    PG8_WAIT_V(6); PG8_BAR;
    for (;;) {
        const bool has_next = S.next(ui + 1, nxt);
        nA = cA; nB = cB; tnx = tcu;
        if (has_next) { nA = Abase + (size_t)nxt.pm * tstep; nB = (const char*)g.Bt + S.b_off(nxt, g.N, K);
            if constexpr (Sched::GATHER) { tnx = tcu ^ BM; if (tid < BM) gtb[tnx + tid] = S.a_row_off(nxt, tid, K); } }
#pragma unroll 1
        for (int t = 0; t < nt; t += 2) {
            const bool last = (t == nt - 2);
            const size_t k1 = (size_t)(t + 1) * kstep;
            const size_t k2 = last ? 0 : (size_t)(t + 2) * kstep, k3 = k2 + kstep;
            const char* b2 = last ? nB : cB + (size_t)(t + 2) * kstep; const char* b3 = b2 + kstep;
            PG8_LDB(B0, 0, 0); PG8_LDB(B1, 0, 1); PG8_SCHED; PG8_LDA(At, 0, 0); PG8_STAGEA(PG8_SA(1, 1), 1, k1, false);
            PG8_WAIT_V(8); PG8_WAIT_L(0); PG8_BAR; PG8_MMA(0, 0, At, B0); PG8_MMA(0, 1, At, B1); PG8_BAR; PG8_SCHED;
            PG8_LDA(At, 0, 1); PG8_STAGE(PG8_SB(0, 0), b2, voffB); PG8_STAGE(PG8_SB(0, 1), b2 + hstep, voffB); PG8_STAGEA(PG8_SA(0, 0), 0, k2, last);
            PG8_WAIT_V(8); PG8_WAIT_L(0); PG8_BAR; PG8_MMA(1, 0, At, B0); PG8_MMA(1, 1, At, B1); PG8_BAR; PG8_SCHED;
            PG8_LDB(B0, 1, 0); PG8_LDB(B1, 1, 1); PG8_SCHED; PG8_LDA(At, 1, 0); PG8_STAGEA(PG8_SA(0, 1), 1, k2, last);
            PG8_WAIT_V(8); PG8_WAIT_L(0); PG8_BAR; PG8_MMA(0, 0, At, B0); PG8_MMA(0, 1, At, B1); PG8_BAR; PG8_SCHED;
            PG8_LDA(At, 1, 1); PG8_STAGE(PG8_SB(1, 0), b3, voffB); PG8_STAGE(PG8_SB(1, 1), b3 + hstep, voffB); PG8_STAGEA(PG8_SA(1, 0), 0, k3, last);
            PG8_WAIT_V(8); PG8_WAIT_L(0); PG8_BAR; PG8_MMA(1, 0, At, B0); PG8_MMA(1, 1, At, B1); PG8_BAR; PG8_SCHED;
        }
        if constexpr (ALIGN_EPI) { if (wr == 0) PG8_BAR; }
        E(acc, cur, wr, wc, fr, fq);
        if (!has_next) break;
#pragma unroll
        for (int a = 0; a < 2; ++a)
#pragma unroll
            for (int b = 0; b < 2; ++b)
#pragma unroll
                for (int m = 0; m < 4; ++m)
#pragma unroll
                    for (int n = 0; n < 2; ++n) acc[a][b][m][n] = (f32x4){0.f, 0.f, 0.f, 0.f};
        cur = nxt; cA = nA; cB = nB; tcu = tnx; ++ui;
        if constexpr (ALIGN_EPI) { if (wr == 1) PG8_BAR; }
    }
    PG8_WAIT_V(0);
    if constexpr (!ALIGN_EPI) { if (wr == 0) PG8_BAR; }
    PG8_BAR;
#undef PG8_SA
#undef PG8_SB
#undef PG8_STAGE
#undef PG8_STAGEA
#undef PG8_LDA
#undef PG8_LDB
#undef PG8_MMA
#undef PG8_WAIT_V
#undef PG8_WAIT_L
#undef PG8_BAR
#undef PG8_SCHED
}

struct EpiBf16Plain {
    static constexpr bool PERM = true;
    bf16* O; int ldc;
    __device__ __forceinline__ void operator()(const f32x4 (&acc)[2][2][4][2], const Unit& u, int wr, int wc, int fr, int fq) const {
        const int row0 = u.pm * BM + wr * 64 + fr, col0 = u.pn * BM + wc * 32 + 8 * fq;
#pragma unroll
        for (int ai = 0; ai < 2; ++ai)
#pragma unroll
            for (int m = 0; m < 4; ++m) { bf16* rowp = O + (size_t)(row0 + ai * HALF + m * 16) * ldc + col0;
#pragma unroll
                for (int bj = 0; bj < 2; ++bj) { const f32x4 v0 = acc[ai][bj][m][0], v1 = acc[ai][bj][m][1];
                    u32x4 w; w.x = cvt_pk_bf16(v0[0], v0[1]); w.y = cvt_pk_bf16(v0[2], v0[3]); w.z = cvt_pk_bf16(v1[0], v1[1]); w.w = cvt_pk_bf16(v1[2], v1[3]);
                    *(u32x4*)(rowp + bj * HALF) = w; } }
    }
};
struct EpiMlaUp {
    static constexpr bool PERM = true;
    bf16* Q; bf16* KK; bf16* V; const float* cs;
    __device__ __forceinline__ void operator()(const f32x4 (&acc)[2][2][4][2], const Unit& u, int wr, int wc, int fr, int fq) const {
        const int row0 = u.pm * BM + wr * 64 + fr;
#pragma unroll
        for (int bj = 0; bj < 2; ++bj) {
            const int c0 = u.pn * BM + bj * HALF + wc * 32 + 8 * fq;
            if (u.pn < 3) {
                const int h = c0 / QKD, d = c0 - h * QKD;
                const bool rope = d >= NOPE; const int i0 = rope ? (d - NOPE) >> 1 : 0;
#pragma unroll
                for (int ai = 0; ai < 2; ++ai)
#pragma unroll
                    for (int m = 0; m < 4; ++m) { const int row = row0 + ai * HALF + m * 16;
                        f32x4 v0 = acc[ai][bj][m][0], v1 = acc[ai][bj][m][1];
                        if (rope) { const f32x4 cA = *(const f32x4*)(cs + (size_t)row * 32 + i0 * 2), cB = *(const f32x4*)(cs + (size_t)row * 32 + i0 * 2 + 4);
                            const f32x4 a = v0, b = v1;
                            v0[0] = a[0] * cA[0] - a[1] * cA[1]; v0[1] = a[0] * cA[1] + a[1] * cA[0]; v0[2] = a[2] * cA[2] - a[3] * cA[3]; v0[3] = a[2] * cA[3] + a[3] * cA[2];
                            v1[0] = b[0] * cB[0] - b[1] * cB[1]; v1[1] = b[0] * cB[1] + b[1] * cB[0]; v1[2] = b[2] * cB[2] - b[3] * cB[3]; v1[3] = b[2] * cB[3] + b[3] * cB[2]; }
                        v0 = v0 * C2Q; v1 = v1 * C2Q;
                        u32x4 w; w.x = cvt_pk_bf16(v0[0], v0[1]); w.y = cvt_pk_bf16(v0[2], v0[3]); w.z = cvt_pk_bf16(v1[0], v1[1]); w.w = cvt_pk_bf16(v1[2], v1[3]);
                        *(u32x4*)(Q + (size_t)row * 768 + c0) = w; asm volatile("" ::: "memory"); }
            } else {
                bf16* base; int ld, cc;
                if (u.pn < 5) { const int c1 = c0 - 768; const int h = c1 >> 6, d = c1 & 63; base = KK; ld = 768; cc = h * QKD + d; }
                else { base = V; ld = 512; cc = c0 - 1280; }
#pragma unroll
                for (int ai = 0; ai < 2; ++ai)
#pragma unroll
                    for (int m = 0; m < 4; ++m) { const int row = row0 + ai * HALF + m * 16; const f32x4 v0 = acc[ai][bj][m][0], v1 = acc[ai][bj][m][1];
                        u32x4 w; w.x = cvt_pk_bf16(v0[0], v0[1]); w.y = cvt_pk_bf16(v0[2], v0[3]); w.z = cvt_pk_bf16(v1[0], v1[1]); w.w = cvt_pk_bf16(v1[2], v1[3]);
                        *(u32x4*)(base + (size_t)row * ld + cc) = w; asm volatile("" ::: "memory"); }
            }
        }
    }
};
struct EpiRwkvSmall {
    static constexpr bool PERM = false;
    float* O; const float* w0; const float* a0;
    __device__ __forceinline__ void operator()(const f32x4 (&acc)[2][2][4][2], const Unit& u, int wr, int wc, int fr, int fq) const {
        const int row0 = u.pm * BM + wr * 64 + fr, col0 = u.pn * BM + wc * 32 + 4 * fq;
        const int kind = u.pn >> 1;
#pragma unroll
        for (int bj = 0; bj < 2; ++bj)
#pragma unroll
            for (int n = 0; n < 2; ++n) { const int c = col0 + bj * HALF + n * 16;
                f32x4 bv = (f32x4){0.f, 0.f, 0.f, 0.f};
                if (kind == 0) bv = *(const f32x4*)(w0 + c); else if (kind == 1) bv = *(const f32x4*)(a0 + (c - 512));
#pragma unroll
                for (int ai = 0; ai < 2; ++ai)
#pragma unroll
                    for (int m = 0; m < 4; ++m) { f32x4 v = acc[ai][bj][m][n] + bv;
                        if (kind == 0) {
#pragma unroll
                            for (int j = 0; j < 4; ++j) { const float z = -v[j]; const float sp = fmaxf(z, 0.f) + __logf(1.0f + __expf(-fabsf(z))); const float w = -sp - 0.5f; v[j] = -__expf(w); }
                        } else if (kind == 1) {
#pragma unroll
                            for (int j = 0; j < 4; ++j) v[j] = sigmoidf_(v[j]);
                        }
                        *(f32x4*)(O + (size_t)(row0 + ai * HALF + m * 16) * N_SM + c) = v; asm volatile("" ::: "memory"); } }
    }
};
struct EpiVres {
    static constexpr bool PERM = true;
    const bf16* vs; const bf16* vf; bf16* vr; const float* v0;
    __device__ __forceinline__ void operator()(const f32x4 (&acc)[2][2][4][2], const Unit& u, int wr, int wc, int fr, int fq) const {
        const int row0 = u.pm * BM + wr * 64 + fr, col0 = u.pn * BM + wc * 32 + 8 * fq;
#pragma unroll
        for (int bj = 0; bj < 2; ++bj) { const int c = col0 + bj * HALF;
            const f32x4 b0 = *(const f32x4*)(v0 + c), b1 = *(const f32x4*)(v0 + c + 4);
#pragma unroll
            for (int ai = 0; ai < 2; ++ai)
#pragma unroll
                for (int m = 0; m < 4; ++m) { const size_t off = (size_t)(row0 + ai * HALF + m * 16) * C5 + c;
                    const u32x4 s = *(const u32x4*)(vs + off), f = *(const u32x4*)(vf + off);
                    const f32x4 g0 = acc[ai][bj][m][0] + b0, g1 = acc[ai][bj][m][1] + b1;
                    float o[8];
#pragma unroll
                    for (int j = 0; j < 4; ++j) { const float sl = bflo(s[j]), sh = bfhi(s[j]), fl = bflo(f[j]), fh = bfhi(f[j]);
                        const float ga = (j < 2) ? g0[2 * j] : g1[2 * j - 4], gb = (j < 2) ? g0[2 * j + 1] : g1[2 * j - 3];
                        o[2 * j] = sl + (fl - sl) * sigmoidf_(ga); o[2 * j + 1] = sh + (fh - sh) * sigmoidf_(gb); }
                    u32x4 w; w.x = cvt_pk_bf16(o[0], o[1]); w.y = cvt_pk_bf16(o[2], o[3]); w.z = cvt_pk_bf16(o[4], o[5]); w.w = cvt_pk_bf16(o[6], o[7]);
                    *(u32x4*)(vr + off) = w; } }
    }
};
struct EpiWo {
    static constexpr bool PERM = false;
    float* X; const float* gt;
    __device__ __forceinline__ void operator()(const f32x4 (&acc)[2][2][4][2], const Unit& u, int wr, int wc, int fr, int fq) const {
        const int row0 = u.pm * BM + wr * 64 + fr, col0 = u.pn * BM + wc * 32 + 4 * fq;
        const int b = (u.pm * BM) / SEQ;
#pragma unroll
        for (int bj = 0; bj < 2; ++bj)
#pragma unroll
            for (int n = 0; n < 2; ++n) { const int c = col0 + bj * HALF + n * 16; const f32x4 g = *(const f32x4*)(gt + (size_t)b * 6144 + c) + 1.0f;
#pragma unroll
                for (int ai = 0; ai < 2; ++ai)
#pragma unroll
                    for (int m = 0; m < 4; ++m) { float* p = X + (size_t)(row0 + ai * HALF + m * 16) * D + c; const f32x4 x = *(const f32x4*)p; *(f32x4*)p = x * DN_ALPHA + g * acc[ai][bj][m][n]; } }
    }
};
struct EpiSwiglu {
    static constexpr bool PERM = true;
    bf16* O; const float* b1p;
    __device__ __forceinline__ void operator()(const f32x4 (&acc)[2][2][4][2], const Unit& u, int wr, int wc, int fr, int fq) const {
        const int row0 = u.pm * BM + wr * 64 + fr; const int cin = u.pn * BM + wc * 32 + 8 * fq, cout = u.pn * HALF + wc * 32 + 8 * fq;
        const float* bp = b1p + (size_t)u.e * 2048 + cin;
        const f32x4 bg0 = *(const f32x4*)(bp), bg1 = *(const f32x4*)(bp + 4), bl0 = *(const f32x4*)(bp + HALF), bl1 = *(const f32x4*)(bp + HALF + 4);
#pragma unroll
        for (int ai = 0; ai < 2; ++ai)
#pragma unroll
            for (int m = 0; m < 4; ++m) {
                const f32x4 g0 = acc[ai][0][m][0] + bg0, g1 = acc[ai][0][m][1] + bg1, l0 = acc[ai][1][m][0] + bl0, l1 = acc[ai][1][m][1] + bl1;
                float o[8];
#pragma unroll
                for (int j = 0; j < 8; ++j) { const float gv = fminf(j < 4 ? g0[j & 3] : g1[j & 3], 7.0f); const float lv = fminf(fmaxf(j < 4 ? l0[j & 3] : l1[j & 3], -7.0f), 7.0f);
                    o[j] = gv * sigmoidf_(1.702f * gv) * (lv + 1.0f); }
                u32x4 w; w.x = cvt_pk_bf16(o[0], o[1]); w.y = cvt_pk_bf16(o[2], o[3]); w.z = cvt_pk_bf16(o[4], o[5]); w.w = cvt_pk_bf16(o[6], o[7]);
                *(u32x4*)(O + (size_t)(row0 + ai * HALF + m * 16) * FF + cout) = w; }
    }
};
struct EpiMoeOut {
    static constexpr bool PERM = true;
    bf16* O; const float* b2; const float* gatel; const LAS int* tb;
    __device__ __forceinline__ void operator()(const f32x4 (&acc)[2][2][4][2], const Unit& u, int wr, int wc, int fr, int fq) const {
        const int row0 = u.pm * BM + wr * 64 + fr, col0 = u.pn * BM + wc * 32 + 8 * fq;
        const int pos0 = (u.pm - tb[u.e]) * BM + wr * 64 + fr;
        const float* bp = b2 + (size_t)u.e * D + col0;
        f32x4 bv[2][2];
#pragma unroll
        for (int bj = 0; bj < 2; ++bj) { bv[bj][0] = *(const f32x4*)(bp + bj * HALF); bv[bj][1] = *(const f32x4*)(bp + bj * HALF + 4); }
#pragma unroll
        for (int ai = 0; ai < 2; ++ai)
#pragma unroll
            for (int m = 0; m < 4; ++m) { const float gt = gatel[(size_t)u.e * CAP + pos0 + ai * HALF + m * 16];
                bf16* rowp = O + (size_t)(row0 + ai * HALF + m * 16) * D + col0;
#pragma unroll
                for (int bj = 0; bj < 2; ++bj) { const f32x4 v0 = (acc[ai][bj][m][0] + bv[bj][0]) * gt, v1 = (acc[ai][bj][m][1] + bv[bj][1]) * gt;
                    u32x4 w; w.x = cvt_pk_bf16(v0[0], v0[1]); w.y = cvt_pk_bf16(v0[2], v0[3]); w.z = cvt_pk_bf16(v1[0], v1[1]); w.w = cvt_pk_bf16(v1[2], v1[3]);
                    *(u32x4*)(rowp + bj * HALF) = w; } }
    }
};
}

struct Params { const void* in[N_INPUTS]; float* out; unsigned char* ws; int ph_lo, ph_hi; };

struct Frame {
    LAS unsigned char* lds;
    int tid, lane, wave, G, vcu;
    unsigned char* ws;
};
#define WSP(type, off) ((type*)(F.ws + (off)))
#define INP(i) ((const float*)p.in[i])

__device__ const double INV_FREQ[16] = {1.00000000000000000e+00, 5.62341325190349073e-01, 3.16227766016837941e-01, 1.77827941003892293e-01, 1.00000000000000006e-01, 5.62341325190349114e-02,
    3.16227766016837913e-02, 1.77827941003892293e-02, 1.00000000000000002e-02, 5.62341325190349097e-03, 3.16227766016837939e-03, 1.77827941003892275e-03, 1.00000000000000002e-03,
    5.62341325190349097e-04, 3.16227766016837939e-04, 1.77827941003892270e-04};

template <int MODE>
__device__ __forceinline__ void tr_item(const float* W, int ldn, bf16* WT, int ldk, int kofs, int rofs, int k0, int n0, LAS float* scr, int lane) {
    f32x4 ld[8];
#pragma unroll
    for (int i = 0; i < 8; ++i) ld[i] = *(const f32x4*)(W + (size_t)(k0 + 8 * i + (lane >> 3)) * ldn + n0 + 4 * (lane & 7));
#pragma unroll
    for (int i = 0; i < 8; ++i) { LAS float* d = scr + (8 * i + (lane >> 3)) * 33 + 4 * (lane & 7); d[0] = ld[i].x; d[1] = ld[i].y; d[2] = ld[i].z; d[3] = ld[i].w; }
    LDS_WAIT(); asm volatile("" ::: "memory");
    const int c = lane & 7;
#pragma unroll
    for (int j = 0; j < 4; ++j) { const int n = (lane >> 3) + 8 * j; const LAS float* s = scr + (8 * c) * 33 + n;
        u32x4 o; o.x = pk2(s[0 * 33], s[1 * 33]); o.y = pk2(s[2 * 33], s[3 * 33]); o.z = pk2(s[4 * 33], s[5 * 33]); o.w = pk2(s[6 * 33], s[7 * 33]);
        const int ng = n0 + n; int row;
        if (MODE == 0) row = rofs + ng; else { const int jo = ng >> 1, bj = ng & 1; row = rofs + (jo >> 7) * 256 + bj * 128 + (jo & 127); }
        *(GAS u32x4*)(WT + (size_t)row * ldk + kofs + k0 + 8 * c) = o; }
    LDS_WAIT(); asm volatile("" ::: "memory");
}
__device__ __forceinline__ void zero_rect(const Frame& F, bf16* M, int ld, int r0, int nrows, int c0, int ncols) {
    const int gw = F.vcu * NWAVES + F.wave, NGW = F.G * NWAVES; const int nch = ncols / 8;
    for (int r = gw; r < nrows; r += NGW)
        for (int ch = F.lane; ch < nch; ch += 64) *(GAS u32x4*)(M + (size_t)(r0 + r) * ld + c0 + ch * 8) = (u32x4){0u, 0u, 0u, 0u};
}
__device__ __forceinline__ void phase_prologue(const Params& p, const Frame& F) {
    LAS float* scr = (LAS float*)(F.lds + F.wave * 16384);
    const int gw = F.vcu * NWAVES + F.wave, NGW = F.G * NWAVES;
    constexpr int I_IN = 16 * 69, I_UQ = 4 * 24, I_UK = 2 * 16, I_W2s = 16, I_G2s = 2 * 16, I_WO_ = 16 * 32, I_E1 = 16 * 64, I_E2 = 16 * 32;
    constexpr int PER_L = I_IN + I_UQ + 2 * I_UK + 2 * I_W2s + I_G2s + I_WO_;
    constexpr int NSMALL = DEPTH * PER_L;
    for (int it = gw; it < NSMALL; it += NGW) {
        int r = it;
        {
            const int l = r / PER_L; r -= l * PER_L;
            if (r < I_IN) { tr_item<0>(INP(I_WIN) + (size_t)l * D * N_IN, N_IN, WSP(bf16, WS_WINT) + (size_t)l * N_INP * D, D, 0, 0, 64 * (r / 69), 32 * (r % 69), scr, F.lane); continue; } r -= I_IN;
            bf16* up = WSP(bf16, WS_WUPT) + (size_t)l * N_UP * K_UP;
            if (r < I_UQ) { tr_item<0>(INP(I_WUQ) + (size_t)l * QLR * 768, 768, up, K_UP, 0, 0, 64 * (r / 24), 32 * (r % 24), scr, F.lane); continue; } r -= I_UQ;
            if (r < I_UK) { tr_item<0>(INP(I_WUK) + (size_t)l * KVLR * 512, 512, up, K_UP, 256, 768, 64 * (r / 16), 32 * (r % 16), scr, F.lane); continue; } r -= I_UK;
            if (r < I_UK) { tr_item<0>(INP(I_WUV) + (size_t)l * KVLR * 512, 512, up, K_UP, 256, 1280, 64 * (r / 16), 32 * (r % 16), scr, F.lane); continue; } r -= I_UK;
            bf16* sm = WSP(bf16, WS_WSMT) + (size_t)l * N_SM * K_SM;
            if (r < I_W2s) { tr_item<0>(INP(I_W2) + (size_t)l * 64 * 512, 512, sm, K_SM, 0, 0, 0, 32 * r, scr, F.lane); continue; } r -= I_W2s;
            if (r < I_W2s) { tr_item<0>(INP(I_A2) + (size_t)l * 64 * 512, 512, sm, K_SM, 64, 512, 0, 32 * r, scr, F.lane); continue; } r -= I_W2s;
            if (r < I_G2s) { tr_item<0>(INP(I_G2) + (size_t)l * 128 * 512, 512, sm, K_SM, 128, 1024, 64 * (r / 16), 32 * (r % 16), scr, F.lane); continue; } r -= I_G2s;
            tr_item<0>(INP(I_WO) + (size_t)l * D * D, D, WSP(bf16, WS_WOT) + (size_t)l * D * D, D, 0, 0, 64 * (r / 32), 32 * (r % 32), scr, F.lane); continue;
        }
    }
    for (int l = 0; l < DEPTH; ++l) {
        zero_rect(F, WSP(bf16, WS_WINT) + (size_t)l * N_INP * D, D, N_IN, N_INP - N_IN, 0, D);
        bf16* up = WSP(bf16, WS_WUPT) + (size_t)l * N_UP * K_UP;
        zero_rect(F, up, K_UP, 0, 768, 256, 128); zero_rect(F, up, K_UP, 768, 1024, 0, 256);
        bf16* sm = WSP(bf16, WS_WSMT) + (size_t)l * N_SM * K_SM;
        zero_rect(F, sm, K_SM, 0, 512, 64, 192); zero_rect(F, sm, K_SM, 512, 512, 0, 64); zero_rect(F, sm, K_SM, 512, 512, 128, 128); zero_rect(F, sm, K_SM, 1024, 512, 0, 128);
    }
    const int gt = (F.vcu * NTHREADS) + F.tid, NGT = F.G * NTHREADS;
    { const float* v1 = INP(I_V1); const float* v2 = INP(I_V2); bf16* o = WSP(bf16, WS_WV12T);
      for (int i = gt; i < 512 * 512; i += NGT) { const int n = i >> 9, k = i & 511; float s = 0.f;
#pragma unroll 8
          for (int j = 0; j < 32; ++j) s += v1[k * 32 + j] * v2[j * 512 + n];
          o[i] = (bf16)f2bf(s); } }
    { const float* b1 = INP(I_EB1); float* o = WSP(float, WS_B1P);
      for (int i = gt; i < DEPTH * NE * 2048; i += NGT) { const int q = i & 2047, le = i >> 11; const int pn = q >> 8, bj = (q >> 7) & 1, jj = q & 127; o[i] = b1[(size_t)le * 2048 + 2 * (pn * 128 + jj) + bj]; } }
    { const float* rw = INP(I_RW); bf16* o = WSP(bf16, WS_RWT);
      for (int i = gt; i < DEPTH * NE * D; i += NGT) { const int k = i & 1023, e = (i >> 10) & 31, l2 = i >> 15; const float v = rw[((size_t)l2 * D + k) * NE + e]; const unsigned hi = f2bf(v); const float lo = v - bf2f(hi);
          o[i] = (bf16)hi; o[DEPTH * NE * D + i] = (bf16)f2bf(lo); } }
    { const int* pos = (const int*)p.in[I_POS]; float* cs = WSP(float, WS_CS);
      for (int i = gt; i < T * 16; i += NGT) { const int t = i >> 4, k = i & 15; const double a = (double)pos[t] * INV_FREQ[k];
          const double q = __builtin_rint(a * 0.63661977236758134308); const int qi = (int)((long long)q & 3);
          double r = __builtin_fma(-q, 1.57079632679489655800e+00, a); r = __builtin_fma(-q, 6.12323399573676603587e-17, r);
          const double r2 = r * r;
          double sn = -2.50521083854417187751e-08; sn = sn * r2 + 2.75573192239858906526e-06; sn = sn * r2 - 1.98412698412698412698e-04; sn = sn * r2 + 8.33333333333333333333e-03; sn = sn * r2 - 1.66666666666666666667e-01; sn = r + r * r2 * sn;
          double cn = 2.08767569878680989792e-09; cn = cn * r2 - 2.75573192239858906526e-07; cn = cn * r2 + 2.48015873015873015873e-05; cn = cn * r2 - 1.38888888888888888889e-03; cn = cn * r2 + 4.16666666666666666667e-02; cn = cn * r2 - 0.5; cn = 1.0 + r2 * cn;
          double sv, cv;
          if (qi == 0) { sv = sn; cv = cn; } else if (qi == 1) { sv = cn; cv = -sn; } else if (qi == 2) { sv = -sn; cv = -cn; } else { sv = -cn; cv = sn; }
          cs[2 * i] = (float)cv; cs[2 * i + 1] = (float)sv; } }
    { LAS float* cact = (LAS float*)(F.lds);
      LAS float* part = (LAS float*)(F.lds + 32768);
      __syncthreads();
      const float* c = INP(I_C);
      for (int i = F.tid; i < NBATCH * D; i += NTHREADS) { const float v = c[i]; cact[i] = v / (1.0f + __expf(-v)); }
      __syncthreads();
      for (int item = F.vcu; item < DEPTH * 96; item += F.G) { const int l = item / 96, n0 = (item % 96) * 64;
          const float* aw = INP(I_ADAW) + (size_t)l * D * 6144 + n0 + F.lane;
          float a8[8];
#pragma unroll
          for (int b = 0; b < 8; ++b) a8[b] = 0.f;
          const int kb = F.wave * 128;
#pragma unroll 4
          for (int k = 0; k < 128; ++k) { const float wv = aw[(size_t)(kb + k) * 6144];
#pragma unroll
              for (int b = 0; b < 8; ++b) a8[b] += cact[b * D + kb + k] * wv; }
#pragma unroll
          for (int b = 0; b < 8; ++b) part[(F.wave * 8 + b) * 64 + F.lane] = a8[b];
          __syncthreads();
          { const int b = F.wave; float s = 0.f;
#pragma unroll
            for (int w = 0; w < 8; ++w) s += part[(w * 8 + b) * 64 + F.lane];
            WSP(float, WS_MOD)[((size_t)l * NBATCH + b) * 6144 + n0 + F.lane] = s + INP(I_ADAB)[(size_t)l * 6144 + n0 + F.lane]; }
          __syncthreads(); }
    }
}

__device__ __forceinline__ void phase_convert_experts(const Params& p, const Frame& F, int c0, int nc) {
    LAS float* scr = (LAS float*)(F.lds + F.wave * 16384);
    constexpr int I_E1 = 16 * 64, I_E2 = 16 * 32, NE1 = DEPTH * NE * I_E1, NE2 = DEPTH * NE * I_E2;
    const int gw = (F.vcu - c0) * NWAVES + F.wave, NGW = nc * NWAVES; const int lane = F.lane;
    __syncthreads();
    f32x4 ld[8];
#define CV_SRC(it, W_, ldn_, k0_, n0_) do { int r_ = (it); if (r_ < NE1) { const int le_ = r_ / I_E1; r_ -= le_ * I_E1; W_ = INP(I_EW1) + (size_t)le_ * D * 2048; ldn_ = 2048; k0_ = 64 * (r_ / 64); n0_ = 32 * (r_ % 64); } \
        else { r_ -= NE1; const int le_ = r_ / I_E2; r_ -= le_ * I_E2; W_ = INP(I_EW2) + (size_t)le_ * FF * D; ldn_ = D; k0_ = 64 * (r_ / 32); n0_ = 32 * (r_ % 32); } } while (0)
#define CV_LOAD(it) do { const float* W_; int ldn_, k0_, n0_; CV_SRC(it, W_, ldn_, k0_, n0_); \
        _Pragma("unroll") for (int i = 0; i < 8; ++i) ld[i] = *(const f32x4*)(W_ + (size_t)(k0_ + 8 * i + (lane >> 3)) * ldn_ + n0_ + 4 * (lane & 7)); } while (0)
    int it = gw;
    if (it < NE1 + NE2) CV_LOAD(it);
    for (; it < NE1 + NE2; it += NGW) {
#pragma unroll
        for (int i = 0; i < 8; ++i) { LAS float* d = scr + (8 * i + (lane >> 3)) * 33 + 4 * (lane & 7); d[0] = ld[i].x; d[1] = ld[i].y; d[2] = ld[i].z; d[3] = ld[i].w; }
        if (it + NGW < NE1 + NE2) CV_LOAD(it + NGW);
        LDS_WAIT(); asm volatile("" ::: "memory");
        int r = it; bf16* WT; int ldk, k0, n0; bool perm;
        if (r < NE1) { const int le = r / I_E1; r -= le * I_E1; WT = WSP(bf16, WS_W1T) + (size_t)le * 2048 * D; ldk = D; k0 = 64 * (r / 64); n0 = 32 * (r % 64); perm = true; }
        else { r -= NE1; const int le = r / I_E2; r -= le * I_E2; WT = WSP(bf16, WS_W2T) + (size_t)le * D * FF; ldk = FF; k0 = 64 * (r / 32); n0 = 32 * (r % 32); perm = false; }
        const int c = lane & 7;
#pragma unroll
        for (int j = 0; j < 4; ++j) { const int n = (lane >> 3) + 8 * j; const LAS float* sp = scr + (8 * c) * 33 + n;
            u32x4 o; o.x = pk2(sp[0 * 33], sp[1 * 33]); o.y = pk2(sp[2 * 33], sp[3 * 33]); o.z = pk2(sp[4 * 33], sp[5 * 33]); o.w = pk2(sp[6 * 33], sp[7 * 33]);
            const int ng = n0 + n; int row = ng;
            if (perm) { const int jo = ng >> 1, bj = ng & 1; row = (jo >> 7) * 256 + bj * 128 + (jo & 127); }
            *(GAS u32x4*)(WT + (size_t)row * ldk + k0 + 8 * c) = o; }
        LDS_WAIT(); asm volatile("" ::: "memory");
    }
#undef CV_LOAD
#undef CV_SRC
    __syncthreads();
}

__device__ __forceinline__ void phase_ln0(const Params& p, const Frame& F) {
    const int gw = F.vcu * NWAVES + F.wave, NGW = F.G * NWAVES;
    const float* mod = WSP(float, WS_MOD);
    for (int m = gw; m < T; m += NGW) {
        const int b = m / SEQ;
        const GAS f32x4* xr = (const GAS f32x4*)(INP(I_X) + (size_t)m * D) + F.lane;
        f32x4 v[4]; float s = 0.f;
#pragma unroll
        for (int j = 0; j < 4; ++j) { v[j] = xr[64 * j]; s += (v[j].x + v[j].y) + (v[j].z + v[j].w); }
        const float mean = wave_sum(s) * (1.f / D); float s2 = 0.f;
#pragma unroll
        for (int j = 0; j < 4; ++j) { v[j] = v[j] - mean; s2 += (v[j].x * v[j].x + v[j].y * v[j].y) + (v[j].z * v[j].z + v[j].w * v[j].w); }
        const float rstd = 1.f / sqrtf(wave_sum(s2) * (1.f / D) + LN_EPS);
        GAS f32x4* xo = (GAS f32x4*)(WSP(float, WS_X) + (size_t)m * D) + F.lane;
        GAS u32x2* ho = (GAS u32x2*)(WSP(bf16, WS_H) + (size_t)m * D) + F.lane;
#pragma unroll
        for (int j = 0; j < 4; ++j) { const int c = 4 * F.lane + 256 * j;
            const f32x4 g = *(const f32x4*)(INP(I_ELNG) + c), be = *(const f32x4*)(INP(I_ELNB) + c);
            const f32x4 x0 = v[j] * rstd * g + be; xo[64 * j] = x0;
            const f32x4 sh = *(const f32x4*)(mod + (size_t)b * 6144 + c), sc = *(const f32x4*)(mod + (size_t)b * 6144 + 1024 + c);
            const f32x4 h = x0 * (sc + 1.0f) + sh; u32x2 w; w.x = pk2(h.x, h.y); w.y = pk2(h.z, h.w); ho[64 * j] = w; }
    }
}

__device__ __forceinline__ void phase_prep(const Params& p, const Frame& F, int l) {
    const int gw = F.vcu * NWAVES + F.wave, NGW = F.G * NWAVES; const int lane = F.lane;
    const bf16* P = WSP(bf16, WS_P); const float* mu = INP(I_MU) + (size_t)l * RWKV_IN;
    const float* qg = INP(I_QNG) + (size_t)l * QLR; const float* kvg = INP(I_KVNG) + (size_t)l * KVLR;
    bf16* AN = WSP(bf16, WS_AN); bf16* A2 = WSP(bf16, WS_A2); bf16* RK = WSP(bf16, WS_RK); bf16* KKb = WSP(bf16, WS_KK);
    bf16* VS = l == 0 ? WSP(bf16, WS_VS0) : WSP(bf16, WS_VS1);
    const float* cs = WSP(float, WS_CS);
    for (int t = gw; t < T; t += NGW) {
        const bf16* pr = P + (size_t)t * N_INP; const bool first = (t % SEQ) == 0; const bf16* pp = pr - N_INP;
        { const u32x2 qw = *(const u32x2*)(pr + 4 * lane); float q0 = bflo(qw.x), q1 = bfhi(qw.x), q2 = bflo(qw.y), q3 = bfhi(qw.y);
          const float rq = 1.f / sqrtf(wave_sum(q0 * q0 + q1 * q1 + q2 * q2 + q3 * q3) * (1.f / QLR) + RMS_EPS);
          const f32x4 g = *(const f32x4*)(qg + 4 * lane);
          u32x2 w; w.x = pk2(q0 * rq * g.x, q1 * rq * g.y); w.y = pk2(q2 * rq * g.z, q3 * rq * g.w); *(u32x2*)(AN + (size_t)t * K_UP + 4 * lane) = w;
          const unsigned kw = *(const unsigned*)(pr + QLR + 2 * lane); const float k0 = bflo(kw), k1 = bfhi(kw);
          const float rk = 1.f / sqrtf(wave_sum(k0 * k0 + k1 * k1) * (1.f / KVLR) + RMS_EPS);
          const f32x2 g2 = *(const f32x2*)(kvg + 2 * lane);
          *(unsigned*)(AN + (size_t)t * K_UP + QLR + 2 * lane) = pk2(k0 * rk * g2.x, k1 * rk * g2.y);
          const int i = lane & 15; const unsigned rw = *(const unsigned*)(pr + QLR + KVLR + 2 * i); const float x0 = bflo(rw), x1 = bfhi(rw);
          const f32x2 csv = *(const f32x2*)(cs + (size_t)t * 32 + 2 * i); const unsigned ro = pk2(x0 * csv.x - x1 * csv.y, x0 * csv.y + x1 * csv.x);
          const int h0 = (lane >> 4) * 2;
          *(unsigned*)(KKb + (size_t)t * 768 + h0 * QKD + NOPE + 2 * i) = ro; *(unsigned*)(KKb + (size_t)t * 768 + (h0 + 1) * QKD + NOPE + 2 * i) = ro; }
        const bf16* rr = pr + MLA_IN; const bf16* rp = pp + MLA_IN;
#pragma unroll
        for (int part = 0; part < 3; ++part) {
            const int c = part * 512 + 8 * lane; const u32x4 cw = *(const u32x4*)(rr + c); u32x4 pw = (u32x4){0u, 0u, 0u, 0u}; if (!first) pw = *(const u32x4*)(rp + c);
            const f32x4 m0 = *(const f32x4*)(mu + c), m1 = *(const f32x4*)(mu + c + 4);
            float o[8];
#pragma unroll
            for (int j = 0; j < 4; ++j) { const float a = bflo(cw[j]), b = bfhi(cw[j]), pa = bflo(pw[j]), pb = bfhi(pw[j]); const float ma = j < 2 ? m0[2 * j] : m1[2 * j - 4], mb = j < 2 ? m0[2 * j + 1] : m1[2 * j - 3];
                o[2 * j] = a + ma * (pa - a); o[2 * j + 1] = b + mb * (pb - b); }
            u32x4 w; w.x = pk2(o[0], o[1]); w.y = pk2(o[2], o[3]); w.z = pk2(o[4], o[5]); w.w = pk2(o[6], o[7]);
            if (part < 2) *(u32x4*)(RK + (size_t)t * 1024 + part * 512 + 8 * lane) = w; else *(u32x4*)(VS + (size_t)t * C5 + 8 * lane) = w;
        }
        { const int c = 1536 + lane; const float a = bf2f(rr[c]), pa = first ? 0.f : bf2f(rp[c]); const float v = a + mu[c] * (pa - a); A2[(size_t)t * K_SM + lane] = (bf16)f2bf(tanhf_(v)); }
        { const int c = 1600 + lane; const float a = bf2f(rr[c]), pa = first ? 0.f : bf2f(rp[c]); const float v = a + mu[c] * (pa - a); A2[(size_t)t * K_SM + 64 + lane] = (bf16)f2bf(v); }
        { const int c = 1664 + 2 * lane; const unsigned cw = *(const unsigned*)(rr + c); const unsigned pw = first ? 0u : *(const unsigned*)(rp + c);
          const f32x2 m = *(const f32x2*)(mu + c); const float a = bflo(cw), b = bfhi(cw); const float va = a + m.x * (bflo(pw) - a), vb = b + m.y * (bfhi(pw) - b);
          *(unsigned*)(A2 + (size_t)t * K_SM + 128 + 2 * lane) = pk2(sigmoidf_(va), sigmoidf_(vb)); }
    }
}

namespace att {
__device__ __forceinline__ int crow(int r, int hi) { return (r & 3) + 8 * (r >> 2) + 4 * hi; }
constexpr int KSLOT = 12288, VSLOT = 8192;
constexpr int NSLOT = 3;
constexpr int LDS_K = 0, LDS_V = NSLOT * KSLOT, LDS_WS = LDS_V + NSLOT * VSLOT, LDS_OST = LDS_WS + NWAVES * 64 * 4, LDS_TOTAL = LDS_OST + NWAVES * 4096;
__device__ __forceinline__ void glds16(const void* gsrc, unsigned lds_dst) { unsigned keep;
    asm volatile("s_mov_b32 %0, m0\n\ts_mov_b32 m0, %2\n\ts_nop 0\n\tglobal_load_lds_dwordx4 %1, off\n\ts_mov_b32 m0, %0" : "=&s"(keep) : "v"(gsrc), "s"(lds_dst) : "memory"); }
__device__ __forceinline__ float max3f(float a, float b, float c) { return fmaxf(fmaxf(a, b), c); }
#define ATT_WAIT_BAR() asm volatile("s_waitcnt vmcnt(0) lgkmcnt(0)\n\ts_barrier" ::: "memory")
__device__ __forceinline__ float rowmax(const f32x16& p0, const f32x16& p1) {
    float a = max3f(p0[0], p0[1], p1[0]), b = max3f(p0[2], p0[3], p1[1]); a = max3f(a, p1[2], p1[3]);
#pragma unroll
    for (int r = 4; r < 16; r += 4) { a = max3f(a, p0[r], p0[r + 1]); b = max3f(b, p0[r + 2], p0[r + 3]); a = max3f(a, p1[r], p1[r + 1]); b = max3f(b, p1[r + 2], p1[r + 3]); }
    const float m = fmaxf(a, b);
    auto rr = __builtin_amdgcn_permlane32_swap(__float_as_uint(m), __float_as_uint(m), false, false);
    return fmaxf(__uint_as_float(rr[0]), __uint_as_float(rr[1]));
}
__device__ __forceinline__ void pv(f32x16* o, int vb, bf16x8 pa0, bf16x8 pa1, bf16x8 pa2, bf16x8 pa3) {
#pragma unroll
    for (int d0 = 0; d0 < 2; ++d0) { s16x4 lo[4], hi[4];
#pragma unroll
        for (int ks = 0; ks < 4; ++ks) {
            asm volatile("ds_read_b64_tr_b16 %0,%1 offset:%c2" : "=&v"(lo[ks]) : "v"(vb), "i"(d0 * 4096 + ks * 1024) : "memory");
            asm volatile("ds_read_b64_tr_b16 %0,%1 offset:%c2" : "=&v"(hi[ks]) : "v"(vb), "i"(d0 * 4096 + ks * 1024 + 512) : "memory"); }
        asm volatile("s_waitcnt lgkmcnt(0)" ::: "memory"); __builtin_amdgcn_sched_barrier(0);
#define PK(k) (bf16x8){lo[k][0], lo[k][1], lo[k][2], lo[k][3], hi[k][0], hi[k][1], hi[k][2], hi[k][3]}
        o[d0] = __builtin_amdgcn_mfma_f32_32x32x16_bf16(pa0, PK(0), o[d0], 0, 0, 0);
        o[d0] = __builtin_amdgcn_mfma_f32_32x32x16_bf16(pa1, PK(1), o[d0], 0, 0, 0);
        o[d0] = __builtin_amdgcn_mfma_f32_32x32x16_bf16(pa2, PK(2), o[d0], 0, 0, 0);
        o[d0] = __builtin_amdgcn_mfma_f32_32x32x16_bf16(pa3, PK(3), o[d0], 0, 0, 0);
#undef PK
    }
}
__device__ __forceinline__ void attn_unit(int b, int h, int qb, const bf16* Q, const bf16* __restrict__ KKp, const bf16* __restrict__ Vp, bf16* O, char* shm) {
    const int tid = threadIdx.x, lane = tid & 63, r32 = lane & 31, hi = lane >> 5; const int wid = __builtin_amdgcn_readfirstlane(tid >> 6);
    const long rowbase = (long)b * SEQ; const int q0 = qb * 256;
    const bf16* Qw = Q + (rowbase + q0 + wid * 32) * 768 + h * QKD;
    const bf16* Kh = KKp + rowbase * 768 + h * QKD; const bf16* Vh = Vp + rowbase * 512 + h * VD;
    const unsigned lds0 = (unsigned)(uintptr_t)shm;
    float* wsf = (float*)(shm + LDS_WS) + wid * 64;
    const bf16* ksrc0 = Kh + (long)lane * 768 + wid * 8;
    const bf16* ksrc1 = Kh + (long)lane * 768 + (8 + (wid & 3)) * 8;
    const bf16* vsrc = Vh + (long)(16 * (wid & 3) + (lane >> 2)) * 512 + (wid >> 2) * 32 + (lane & 3) * 8;
    const unsigned kdst0 = lds0 + LDS_K + wid * 1024, kdst1 = lds0 + LDS_K + (8 + (wid & 3)) * 1024, vdst = lds0 + LDS_V + wid * 1024;
#define DMA_KV(t, s) do { glds16(ksrc0 + (long)(t) * 64 * 768, (unsigned)__builtin_amdgcn_readfirstlane(kdst0 + (s) * KSLOT)); \
        if (wid < 4) glds16(ksrc1 + (long)(t) * 64 * 768, (unsigned)__builtin_amdgcn_readfirstlane(kdst1 + (s) * KSLOT)); \
        glds16(vsrc + (long)(t) * 64 * 512, (unsigned)__builtin_amdgcn_readfirstlane(vdst + (s) * VSLOT)); } while (0)
    const int vb0 = (int)(lds0 + LDS_V) + ((lane >> 4) & 1) * 32 + (lane & 3) * 8 + (4 * hi + ((lane & 15) >> 2)) * 64;
    const int NT = (q0 + 256) / 64;
    DMA_KV(0, 0); DMA_KV(1, 1);
    bf16x8 qr[6];
#pragma unroll
    for (int d0 = 0; d0 < 6; ++d0) qr[d0] = *reinterpret_cast<const bf16x8*>(&Qw[(long)r32 * 768 + d0 * 16 + hi * 8]);
    float mhat = 0.f, l_reg = 0.f; f32x16 o[2]; o[0] = f32x16{}; o[1] = f32x16{};
    f32x16 negm = f32x16{};
    const int qrel = wid * 32 + r32;
    typedef short v4i16_t __attribute__((ext_vector_type(4)));
    typedef __attribute__((address_space(3))) v4i16_t* lds_v4p;
    int sl_cur = 0, sl_nn = 2;
    for (int t = 0; t < NT; ++t) {
        if (t + 1 < NT && t > 0) { if (wid < 4) asm volatile("s_waitcnt vmcnt(3) lgkmcnt(0)\n\ts_barrier" ::: "memory"); else asm volatile("s_waitcnt vmcnt(2) lgkmcnt(0)\n\ts_barrier" ::: "memory"); }
        else ATT_WAIT_BAR();
        if (t + 2 < NT) DMA_KV(t + 2, sl_nn);
        const char* Kslot = shm + LDS_K + sl_cur * KSLOT;
        f32x16 p0 = negm, p1 = negm;
        { const char* kb = Kslot + hi * 1024 + r32 * 16;
#pragma unroll
          for (int d0 = 0; d0 < 6; ++d0) { const bf16x8 b0 = *reinterpret_cast<const bf16x8*>(kb + d0 * 2048); const bf16x8 b1 = *reinterpret_cast<const bf16x8*>(kb + d0 * 2048 + 512);
              p0 = __builtin_amdgcn_mfma_f32_32x32x16_bf16(b0, qr[d0], p0, 0, 0, 0); p1 = __builtin_amdgcn_mfma_f32_32x32x16_bf16(b1, qr[d0], p1, 0, 0, 0); } }
        s16x4 vlo[8], vhi[8];
        { const int vb = vb0 + sl_cur * VSLOT;
#pragma unroll
          for (int i = 0; i < 8; ++i) { const int off = (i >> 2) * 4096 + (i & 3) * 1024;
              vlo[i] = __builtin_bit_cast(s16x4, __builtin_amdgcn_ds_read_tr16_b64_v4i16((lds_v4p)(vb + off))); vhi[i] = __builtin_bit_cast(s16x4, __builtin_amdgcn_ds_read_tr16_b64_v4i16((lds_v4p)(vb + off + 512))); } }
        const int jb = t - (NT - 4);
        if (jb >= 0) { const int kbase = 64 * jb + 4 * hi;
#pragma unroll
            for (int r = 0; r < 16; ++r) { const int kv = kbase + (r & 3) + 8 * (r >> 2); if (kv > qrel) p0[r] = -INFINITY; if (kv + 32 > qrel) p1[r] = -INFINITY; } }
        const float rm = rowmax(p0, p1);
        bool resc = false;
        if (t == 0 || __any(rm > 8.0f)) {
            const float dl = (t == 0) ? rm : fmaxf(rm, 0.f); mhat += dl;
#pragma unroll
            for (int r = 0; r < 16; ++r) { p0[r] -= dl; p1[r] -= dl; negm[r] = -mhat; }
            const float f = (t == 0) ? 1.0f : __builtin_amdgcn_exp2f(-dl); l_reg *= f; if (hi == 0) wsf[r32] = f; resc = true; }
        float sacc = 0.f;
#pragma unroll
        for (int r = 0; r < 16; ++r) { p0[r] = __builtin_amdgcn_exp2f(p0[r]); p1[r] = __builtin_amdgcn_exp2f(p1[r]); sacc += p0[r] + p1[r]; }
        l_reg += sacc;
        if (resc) { asm volatile("s_waitcnt lgkmcnt(0)" ::: "memory");
#pragma unroll
            for (int r = 0; r < 16; ++r) { const float fr_ = wsf[crow(r, hi)]; o[0][r] *= fr_; o[1][r] *= fr_; } }
        u32x4 pw[4];
        pw[0] = (u32x4){cvtpk_c(p0[0], p0[1]), cvtpk_c(p0[2], p0[3]), cvtpk_c(p0[4], p0[5]), cvtpk_c(p0[6], p0[7])};
        pw[1] = (u32x4){cvtpk_c(p0[8], p0[9]), cvtpk_c(p0[10], p0[11]), cvtpk_c(p0[12], p0[13]), cvtpk_c(p0[14], p0[15])};
        pw[2] = (u32x4){cvtpk_c(p1[0], p1[1]), cvtpk_c(p1[2], p1[3]), cvtpk_c(p1[4], p1[5]), cvtpk_c(p1[6], p1[7])};
        pw[3] = (u32x4){cvtpk_c(p1[8], p1[9]), cvtpk_c(p1[10], p1[11]), cvtpk_c(p1[12], p1[13]), cvtpk_c(p1[14], p1[15])};
#pragma unroll
        for (int i = 0; i < 8; ++i) { const bf16x8 vf = (bf16x8){vlo[i][0], vlo[i][1], vlo[i][2], vlo[i][3], vhi[i][0], vhi[i][1], vhi[i][2], vhi[i][3]};
            o[i >> 2] = __builtin_amdgcn_mfma_f32_32x32x16_bf16(__builtin_bit_cast(bf16x8, pw[i & 3]), vf, o[i >> 2], 0, 0, 0); }
        sl_cur = (sl_cur == NSLOT - 1) ? 0 : sl_cur + 1; sl_nn = (sl_nn == NSLOT - 1) ? 0 : sl_nn + 1;
    }
    { auto rr = __builtin_amdgcn_permlane32_swap(__float_as_uint(l_reg), __float_as_uint(l_reg), false, false); l_reg = __uint_as_float(rr[0]) + __uint_as_float(rr[1]); }
    if (hi == 0) wsf[32 + r32] = l_reg; asm volatile("s_waitcnt lgkmcnt(0)" ::: "memory");
    float rli[16];
#pragma unroll
    for (int r = 0; r < 16; ++r) rli[r] = __builtin_amdgcn_rcpf(wsf[32 + crow(r, hi)]);
    bf16* Ow = O + (rowbase + q0 + wid * 32) * 512 + h * VD;
    { bf16* stg = (bf16*)(shm + LDS_OST) + wid * 2048;
#pragma unroll
      for (int r = 0; r < 16; ++r) { const int orow = crow(r, hi);
#pragma unroll
          for (int d0 = 0; d0 < 2; ++d0) stg[orow * 64 + d0 * 32 + r32] = (bf16)f2bf(o[d0][r] * rli[r]); }
      asm volatile("s_waitcnt lgkmcnt(0)" ::: "memory");
#pragma unroll
      for (int i = 0; i < 4; ++i) { const int row = i * 8 + (lane >> 3), ch = lane & 7; const u32x4 v = *(const u32x4*)(stg + row * 64 + ch * 8); *(u32x4*)(Ow + (long)row * 512 + ch * 8) = v; } }
    asm volatile("s_waitcnt vmcnt(0) lgkmcnt(0)\n\ts_barrier" ::: "memory");
#undef DMA_KV
}
}

__device__ __forceinline__ void phase_attn(const Params& p, const Frame& F, char* lds_generic, int l) {
    const bf16* Q = WSP(bf16, WS_Q); const bf16* KKp = WSP(bf16, WS_KK); const bf16* Vp = WSP(bf16, WS_V); bf16* O = WSP(bf16, WS_O);
    unsigned* head = (unsigned*)(F.ws + WS_CTL) + CW_ATTQ + l * 64;
    volatile LAS unsigned* MISC = (volatile LAS unsigned*)(F.lds + MISC_OFF);
    for (;;) {
        if (F.tid == 0) MISC[16] = __hip_atomic_fetch_add(head, 1u, RLX_AGENT);
        __syncthreads();
        const unsigned k = MISC[16];
        __syncthreads();
        if (k >= 1024u) break;
        const int qb = 15 - (int)(k >> 6), bh = (int)(k & 63u);
        att::attn_unit(bh >> 3, bh & 7, qb, Q, KKp, Vp, O, lds_generic);
    }
}

namespace rw {
constexpr int RS = 144;
constexpr int SLOT = 64 * RS;
constexpr int S_KT = 0, S_RT = 1, S_BC = 2, S_KC = 3, S_V = 4, S_BH = 5, S_KH = 6, S_GT = 7, S_ABK = 8, S_AKK = 9, S_AKR = 10, S_ABR = 11, S_ABKF = 12;
constexpr int S_TT = S_BC, S_ZT = S_KC, S_NW1T = S_AKK, S_NW2T = S_ABK;
constexpr int TOT_OFF = 13 * SLOT, PL_OFF = TOT_OFF + 8 * 64 * 4;
typedef short v4i16_t __attribute__((ext_vector_type(4)));
__device__ __forceinline__ int crow(int r, int hi) { return (r & 3) + 8 * (r >> 2) + 4 * hi; }
__device__ __forceinline__ bf16x8 frag_d(const LAS unsigned char* M, int row0, int k0, int r, int h) { return *(const LAS bf16x8*)(M + (row0 + r) * RS + (k0 + 8 * h) * 2); }
__device__ __forceinline__ bf16x8 frag_t(const LAS unsigned char* M, int k0, int col0, int lane) {
    const int h = lane >> 5, blk = (lane >> 4) & 1, q = (lane & 15) >> 2, pp = lane & 3;
    const LAS unsigned char* a = M + (k0 + 8 * h + q) * RS + (col0 + 16 * blk + 4 * pp) * 2;
    const v4i16_t lo = __builtin_amdgcn_ds_read_tr16_b64_v4i16((LAS v4i16_t*)a), hi = __builtin_amdgcn_ds_read_tr16_b64_v4i16((LAS v4i16_t*)(a + 4 * RS));
    return (bf16x8){lo[0], lo[1], lo[2], lo[3], hi[0], hi[1], hi[2], hi[3]};
}
__device__ __forceinline__ void store_T(LAS unsigned char* D, int m0, int n0, const f32x16& acc, float sgn, int r, int h) {
#pragma unroll
    for (int g = 0; g < 4; ++g) { u32x2 w; w.x = cvtpk_c(acc[4 * g] * sgn, acc[4 * g + 1] * sgn); w.y = cvtpk_c(acc[4 * g + 2] * sgn, acc[4 * g + 3] * sgn);
        *(LAS u32x2*)(D + (n0 + r) * RS + (m0 + 8 * g + 4 * h) * 2) = w; }
}
#define RW_MMA(acc, A, B) acc = __builtin_amdgcn_mfma_f32_32x32x16_bf16((A), (B), acc, 0, 0, 0)
}

#define LBAR() asm volatile("s_waitcnt lgkmcnt(0)\n\ts_barrier" ::: "memory")
__device__ __forceinline__ void phase_rwkv_r1(const Params& p, const Frame& F, int l) {
    using namespace rw;
    LAS unsigned char* L0 = F.lds;
#define SL(i) (L0 + (i) * SLOT)
    const bf16* RK = WSP(bf16, WS_RK); const float* WAG = WSP(float, WS_WAG);
    const bf16* Vv = l == 0 ? WSP(bf16, WS_VS0) : WSP(bf16, WS_VR);
    float* CH = WSP(float, WS_CH);
    const float* kkw = INP(I_KK) + (size_t)l * C5; const float* kaw = INP(I_KA) + (size_t)l * C5;
    const int tid0 = F.tid, wave = F.wave;
    const int pt0 = tid0 >> 3, j80 = tid0 & 7;
    LAS float* tot = (LAS float*)(L0 + TOT_OFF); LAS float* PLv = (LAS float*)(L0 + PL_OFF);
    u32x4 g_r, g_k, g_v; f32x4 g_l0, g_l1, g_a0, g_a1;
#define R1_FETCH(uu) do { const int bh_ = (uu) >> 6, cc_ = (uu) & 63; const size_t tok = (size_t)(bh_ >> 3) * SEQ + (size_t)cc_ * 64 + pt0; const int c_ = (bh_ & 7) * 64 + 8 * j80; \
        g_r = *(const u32x4*)(RK + tok * 1024 + c_); g_k = *(const u32x4*)(RK + tok * 1024 + 512 + c_); g_v = *(const u32x4*)(Vv + tok * C5 + c_); \
        g_l0 = *(const f32x4*)(WAG + tok * N_SM + c_); g_l1 = *(const f32x4*)(WAG + tok * N_SM + c_ + 4); g_a0 = *(const f32x4*)(WAG + tok * N_SM + 512 + c_); g_a1 = *(const f32x4*)(WAG + tok * N_SM + 512 + c_ + 4); } while (0)
    int u = F.vcu;
    if (u < 4096) R1_FETCH(u);
    for (; u < 4096; u += F.G) {
        const int hh = (u >> 6) & 7;
        int tid = tid0; asm volatile("" : "+v"(tid)); const int lane = tid & 63, r = lane & 31, h = lane >> 5, pt = tid >> 3, j8 = tid & 7;
        {
            const int c = hh * 64 + 8 * j8;
            const f32x4 kk0 = *(const f32x4*)(kkw + c), kk1 = *(const f32x4*)(kkw + c + 4), ka0 = *(const f32x4*)(kaw + c), ka1 = *(const f32x4*)(kaw + c + 4);
            float rr[8], k[8], a[8], x[8], lw[8], kap[8], be[8], kp[8]; float ss = 0.f;
#pragma unroll
            for (int j = 0; j < 4; ++j) { rr[2 * j] = bflo(g_r[j]); rr[2 * j + 1] = bfhi(g_r[j]); k[2 * j] = bflo(g_k[j]); k[2 * j + 1] = bfhi(g_k[j]); }
            *(LAS u32x4*)(SL(S_V) + pt * RS + j8 * 16) = g_v;
#pragma unroll
            for (int j = 0; j < 8; ++j) { a[j] = j < 4 ? g_a0[j & 3] : g_a1[j & 3]; lw[j] = j < 4 ? g_l0[j & 3] : g_l1[j & 3]; x[j] = lw[j]; const float q = k[j] * (j < 4 ? kk0[j & 3] : kk1[j & 3]); kap[j] = q; ss += q * q; }
            ss += __shfl_xor(ss, 1); ss += __shfl_xor(ss, 2); ss += __shfl_xor(ss, 4);
            const float inv = 1.0f / fmaxf(sqrtf(ss), 1e-12f);
#pragma unroll
            for (int j = 0; j < 8; ++j) { kap[j] *= inv; be[j] = kap[j] * a[j]; kp[j] = k[j] * (1.0f + (a[j] - 1.0f) * (j < 4 ? ka0[j & 3] : ka1[j & 3])); }
#pragma unroll
            for (int off = 8; off < 64; off <<= 1) {
#pragma unroll
                for (int j = 0; j < 8; ++j) { const float y = __shfl_up(x[j], off); if (lane >= off) x[j] += y; } }
            if (lane >= 56) { *(LAS f32x4*)(tot + wave * 64 + 8 * j8) = (f32x4){x[0], x[1], x[2], x[3]}; *(LAS f32x4*)(tot + wave * 64 + 8 * j8 + 4) = (f32x4){x[4], x[5], x[6], x[7]}; }
            LBAR();
            float csL[8];
#pragma unroll
            for (int j = 0; j < 8; ++j) csL[j] = 0.f;
#pragma unroll
            for (int w2 = 0; w2 < 8; ++w2) { const f32x4 t0 = *(const LAS f32x4*)(tot + w2 * 64 + 8 * j8), t1 = *(const LAS f32x4*)(tot + w2 * 64 + 8 * j8 + 4);
#pragma unroll
                for (int j = 0; j < 8; ++j) { const float tv = j < 4 ? t0[j & 3] : t1[j & 3]; csL[j] += tv; if (w2 < wave) x[j] += tv; } }
            if (pt == 0) {
#pragma unroll
                for (int j = 0; j < 8; ++j) PLv[8 * j8 + j] = __expf(csL[j]); }
            float kt[8], rt[8], bc[8], kc[8], bh[8], kh[8];
#pragma unroll
            for (int j = 0; j < 8; ++j) { const float eP = __expf(x[j]), ePm1 = __expf(x[j] - lw[j]), eInv = __expf(-x[j]), eL = __expf(csL[j] - x[j]);
                kt[j] = kap[j] * ePm1; rt[j] = rr[j] * eP; bc[j] = be[j] * eInv; kc[j] = kp[j] * eInv; bh[j] = be[j] * eL; kh[j] = kp[j] * eL; }
#define PK8(v) (u32x4){cvtpk_c(v[0], v[1]), cvtpk_c(v[2], v[3]), cvtpk_c(v[4], v[5]), cvtpk_c(v[6], v[7])}
            *(LAS u32x4*)(SL(S_KT) + pt * RS + j8 * 16) = PK8(kt); *(LAS u32x4*)(SL(S_RT) + pt * RS + j8 * 16) = PK8(rt);
            *(LAS u32x4*)(SL(S_BC) + pt * RS + j8 * 16) = PK8(bc); *(LAS u32x4*)(SL(S_KC) + pt * RS + j8 * 16) = PK8(kc);
            *(LAS u32x4*)(SL(S_BH) + pt * RS + j8 * 16) = PK8(bh); *(LAS u32x4*)(SL(S_KH) + pt * RS + j8 * 16) = PK8(kh);
#undef PK8
        }
        LBAR();
        {
            const int mat = wave >> 1, ti = wave & 1;
            const LAS unsigned char* X = (mat < 2) ? SL(S_KT) : SL(S_RT); const LAS unsigned char* Y = (mat == 0 || mat == 3) ? SL(S_BC) : SL(S_KC);
            LAS unsigned char* Dm = SL(S_ABK + mat);
            const int t = 32 * ti + r;
            bf16x8 xb[4];
#pragma unroll
            for (int kk = 0; kk < 4; ++kk) xb[kk] = frag_d(X, 32 * ti, 16 * kk, r, h);
#pragma unroll
            for (int si = 0; si < 2; ++si) {
                f32x16 acc = f32x16{};
                if (!(ti == 0 && si == 1)) {
#pragma unroll
                    for (int kk = 0; kk < 4; ++kk) RW_MMA(acc, frag_d(Y, 32 * si, 16 * kk, r, h), xb[kk]); }
#pragma unroll
                for (int g = 0; g < 4; ++g) { float v[4];
#pragma unroll
                    for (int e = 0; e < 4; ++e) { const int sidx = 32 * si + 8 * g + 4 * h + e; const bool keep = (mat < 2) ? (sidx < t) : (sidx <= t); v[e] = keep ? acc[4 * g + e] : 0.f; }
                    u32x2 w; w.x = cvtpk_c(v[0], v[1]); w.y = cvtpk_c(v[2], v[3]);
                    *(LAS u32x2*)(Dm + t * RS + (32 * si + 8 * g + 4 * h) * 2) = w;
                    if (mat == 0 && ti == si) *(LAS f32x4*)(SL(S_ABKF) + ti * 4608 + r * 144 + (8 * g + 4 * h) * 4) = (f32x4){v[0], v[1], v[2], v[3]}; }
            }
        }
        LBAR();
        if (wave == 0) {
            const int hb = lane >> 5, c = lane & 31; const LAS unsigned char* Ab = SL(S_ABKF) + hb * 4608;
            float Tc[32];
#pragma unroll
            for (int t = 0; t < 32; ++t) Tc[t] = 0.f;
#pragma unroll
            for (int t = 0; t < 32; ++t) { float acc0 = (t == c) ? 1.0f : 0.0f, acc1 = 0.f;
#pragma unroll
                for (int s4 = 0; s4 < (t + 3) / 4; ++s4) { const f32x4 a4 = *(const LAS f32x4*)(Ab + t * 144 + s4 * 16);
                    acc0 -= a4.x * Tc[4 * s4]; acc1 -= a4.y * Tc[4 * s4 + 1]; acc0 -= a4.z * Tc[4 * s4 + 2]; acc1 -= a4.w * Tc[4 * s4 + 3]; }
                float acc = acc0 + acc1;
                asm volatile("" : "+v"(acc) :: "memory");
                Tc[t] = acc; }
#pragma unroll
            for (int q = 0; q < 4; ++q) *(LAS u32x4*)(SL(S_TT) + (32 * hb + c) * RS + (32 * hb) * 2 + q * 16) =
                (u32x4){cvtpk_c(Tc[8 * q], Tc[8 * q + 1]), cvtpk_c(Tc[8 * q + 2], Tc[8 * q + 3]), cvtpk_c(Tc[8 * q + 4], Tc[8 * q + 5]), cvtpk_c(Tc[8 * q + 6], Tc[8 * q + 7])};
        } else if (wave == 1) {
            const int row = 32 + (lane >> 1), hf = lane & 1;
            *(LAS u32x4*)(SL(S_TT) + row * RS + hf * 32) = (u32x4){0u, 0u, 0u, 0u}; *(LAS u32x4*)(SL(S_TT) + row * RS + hf * 32 + 16) = (u32x4){0u, 0u, 0u, 0u};
        } else if (wave >= 4) {
            const int ti = (wave - 4) >> 1, ii = (wave - 4) & 1; f32x16 acc = f32x16{};
#pragma unroll
            for (int kk = 0; kk < 4; ++kk) RW_MMA(acc, frag_d(SL(S_AKK), 32 * ti, 16 * kk, r, h), frag_t(SL(S_V), 16 * kk, 32 * ii, lane));
            store_T(SL(S_GT), 32 * ti, 32 * ii, acc, 1.0f, r, h);
        }
        LBAR();
        if (wave == 0) { f32x16 acc = f32x16{};
#pragma unroll
            for (int kk = 0; kk < 2; ++kk) RW_MMA(acc, frag_d(SL(S_ABK), 32, 16 * kk, r, h), frag_d(SL(S_TT), 0, 16 * kk, r, h));
            store_T(SL(S_ZT), 0, 0, acc, 1.0f, r, h); }
        LBAR();
        if (wave == 0) { f32x16 acc = f32x16{};
#pragma unroll
            for (int kk = 0; kk < 2; ++kk) RW_MMA(acc, frag_t(SL(S_TT), 32 + 16 * kk, 32, lane), frag_d(SL(S_ZT), 0, 16 * kk, r, h));
            store_T(SL(S_TT), 32, 0, acc, -1.0f, r, h); }
        LBAR();
        if (u + F.G < 4096) R1_FETCH(u + F.G);
        { const int w4 = wave & 3, ti = w4 >> 1, ci = w4 & 1; f32x16 acc = f32x16{};
          if (wave < 4) {
#pragma unroll
              for (int kk = 0; kk < 4; ++kk) RW_MMA(acc, frag_t(SL(S_TT), 16 * kk, 32 * ti, lane), frag_t(SL(S_KT), 16 * kk, 32 * ci, lane));
              store_T(SL(S_NW1T), 32 * ti, 32 * ci, acc, -1.0f, r, h); }
          else {
#pragma unroll
              for (int kk = 0; kk < 4; ++kk) RW_MMA(acc, frag_t(SL(S_TT), 16 * kk, 32 * ti, lane), frag_d(SL(S_GT), 32 * ci, 16 * kk, r, h));
              store_T(SL(S_NW2T), 32 * ti, 32 * ci, acc, -1.0f, r, h); } }
        LBAR();
        { const int which = wave >> 1, mi = wave & 1; float* dst = CH + ((size_t)u * 4 + which) * 4096;
#pragma unroll
          for (int ni = 0; ni < 2; ++ni) { f32x16 acc = f32x16{};
#pragma unroll
              for (int kk = 0; kk < 4; ++kk) {
                  if (which == 0) RW_MMA(acc, frag_d(SL(S_ABR), 32 * mi, 16 * kk, r, h), frag_d(SL(S_NW1T), 32 * ni, 16 * kk, r, h));
                  else if (which == 1) { RW_MMA(acc, frag_d(SL(S_AKR), 32 * mi, 16 * kk, r, h), frag_t(SL(S_V), 16 * kk, 32 * ni, lane)); RW_MMA(acc, frag_d(SL(S_ABR), 32 * mi, 16 * kk, r, h), frag_d(SL(S_NW2T), 32 * ni, 16 * kk, r, h)); }
                  else if (which == 2) RW_MMA(acc, frag_t(SL(S_BH), 16 * kk, 32 * mi, lane), frag_d(SL(S_NW1T), 32 * ni, 16 * kk, r, h));
                  else { RW_MMA(acc, frag_t(SL(S_KH), 16 * kk, 32 * mi, lane), frag_t(SL(S_V), 16 * kk, 32 * ni, lane)); RW_MMA(acc, frag_t(SL(S_BH), 16 * kk, 32 * mi, lane), frag_d(SL(S_NW2T), 32 * ni, 16 * kk, r, h)); } }
              const int n = 32 * ni + r;
#pragma unroll
              for (int rg = 0; rg < 16; ++rg) { const int m = 32 * mi + crow(rg, h); float v = acc[rg];
                  if (which == 0) v += bf2f(*(const LAS bf16*)(SL(S_RT) + m * RS + n * 2));
                  if (which == 2 && m == n) v += PLv[n];
                  dst[m * 64 + n] = v; } } }
        LBAR();
    }
#undef R1_FETCH
#undef SL
}

__device__ __forceinline__ void phase_rwkv_r2(const Params& p, const Frame& F) {
    const float* CH = WSP(float, WS_CH); float* RO = WSP(float, WS_RO);
    LAS float* stb = (LAS float*)(F.lds);
    constexpr int STB = 4 * 1280;
    const int lane = F.lane, wave = F.wave, q = lane >> 4, li = lane & 15, w4 = wave & 3;
    const int nr2 = F.G >= 4 ? F.G / 4 : 1;
    if (F.vcu >= nr2) return;
    for (int bh = F.vcu; bh < 64; bh += nr2) {
        const int b = bh >> 3, hh = bh & 7;
        __syncthreads();
        for (int i = F.tid; i < 2 * STB; i += NTHREADS) stb[i] = 0.f;
        __syncthreads();
        const int mA = (wave < 4) ? 2 : 0, mC = (wave < 4) ? 3 : 1;
        const float* basec = CH + (size_t)bh * 64 * 4 * 4096;
        f32x4 fa[2][4], fc[2][4];
#define R2_FETCH(cc, st) do { const float* pa = basec + ((size_t)(cc) * 4 + mA) * 4096 + (16 * w4 + li) * 64 + 16 * q; fa[st][0] = *(const f32x4*)(pa); fa[st][1] = *(const f32x4*)(pa + 4); fa[st][2] = *(const f32x4*)(pa + 8); fa[st][3] = *(const f32x4*)(pa + 12); \
            const float* pc = basec + ((size_t)(cc) * 4 + mC) * 4096 + (16 * w4 + 4 * q) * 64 + li; \
            _Pragma("unroll") for (int ct = 0; ct < 4; ++ct) fc[st][ct] = (f32x4){pc[16 * ct], pc[64 + 16 * ct], pc[128 + 16 * ct], pc[192 + 16 * ct]}; } while (0)
        R2_FETCH(0, 0); R2_FETCH(1, 1);
#pragma unroll 1
        for (int c0 = 0; c0 < 64; c0 += 2) {
#pragma unroll
            for (int st = 0; st < 2; ++st) { const int c = c0 + st;
                const f32x4 A0 = fa[st][0], A1 = fa[st][1], A2 = fa[st][2], A3 = fa[st][3];
                f32x4 acc[4];
#pragma unroll
                for (int ct = 0; ct < 4; ++ct) acc[ct] = fc[st][ct];
                if (c + 2 < 64) R2_FETCH(c + 2, st);
#pragma unroll
                for (int ct = 0; ct < 4; ++ct) { const LAS float* sb = stb + (c & 1) * STB + ct * 1280 + lane * 20;
                    const f32x4 b0 = *(const LAS f32x4*)(sb), b1 = *(const LAS f32x4*)(sb + 4), b2 = *(const LAS f32x4*)(sb + 8), b3 = *(const LAS f32x4*)(sb + 12);
#pragma unroll
                    for (int k = 0; k < 4; ++k) acc[ct] = __builtin_amdgcn_mfma_f32_16x16x4f32(A0[k], b0[k], acc[ct], 0, 0, 0);
#pragma unroll
                    for (int k = 0; k < 4; ++k) acc[ct] = __builtin_amdgcn_mfma_f32_16x16x4f32(A1[k], b1[k], acc[ct], 0, 0, 0);
#pragma unroll
                    for (int k = 0; k < 4; ++k) acc[ct] = __builtin_amdgcn_mfma_f32_16x16x4f32(A2[k], b2[k], acc[ct], 0, 0, 0);
#pragma unroll
                    for (int k = 0; k < 4; ++k) acc[ct] = __builtin_amdgcn_mfma_f32_16x16x4f32(A3[k], b3[k], acc[ct], 0, 0, 0); }
                if (wave < 4) {
#pragma unroll
                    for (int ct = 0; ct < 4; ++ct) *(LAS f32x4*)(stb + ((c + 1) & 1) * STB + ct * 1280 + (w4 * 16 + li) * 20 + 4 * q) = acc[ct]; }
                else { float* ro = RO + ((size_t)b * SEQ + (size_t)c * 64 + 16 * w4 + 4 * q) * C5 + hh * 64 + li;
#pragma unroll
                    for (int ct = 0; ct < 4; ++ct) { ro[16 * ct] = acc[ct][0]; ro[C5 + 16 * ct] = acc[ct][1]; ro[2 * C5 + 16 * ct] = acc[ct][2]; ro[3 * C5 + 16 * ct] = acc[ct][3]; } }
                LBAR();
            }
        }
#undef R2_FETCH
    }
    __syncthreads();
}
#undef LBAR

__device__ __forceinline__ void phase_mix(const Params& p, const Frame& F, int l) {
    const int gw = F.vcu * NWAVES + F.wave, NGW = F.G * NWAVES; const int lane = F.lane;
    const bf16* O = WSP(bf16, WS_O); const float* RO = WSP(float, WS_RO); const bf16* RK = WSP(bf16, WS_RK); const float* WAG = WSP(float, WS_WAG);
    const bf16* Vv = l == 0 ? WSP(bf16, WS_VS0) : WSP(bf16, WS_VR); bf16* MIX = WSP(bf16, WS_MIX);
    const float* og = INP(I_MOUTG) + (size_t)l * C5; const float* gng = INP(I_GNG) + (size_t)l * C5; const float* gnb = INP(I_GNB) + (size_t)l * C5;
    const float* kaw = INP(I_KA) + (size_t)l * C5; const float* rkw = INP(I_RK) + (size_t)l * C5;
    for (int t = gw; t < T; t += NGW) {
        const int c = 8 * lane;
        { const u32x4 ow = *(const u32x4*)(O + (size_t)t * C5 + c); float o[8]; float ss = 0.f;
#pragma unroll
          for (int j = 0; j < 4; ++j) { o[2 * j] = bflo(ow[j]); o[2 * j + 1] = bfhi(ow[j]); ss += o[2 * j] * o[2 * j] + o[2 * j + 1] * o[2 * j + 1]; }
          const float rs = 1.f / sqrtf(wave_sum(ss) * (1.f / C5) + RMS_EPS);
          const f32x4 g0 = *(const f32x4*)(og + c), g1 = *(const f32x4*)(og + c + 4);
          u32x4 w; w.x = pk2(o[0] * rs * g0.x, o[1] * rs * g0.y); w.y = pk2(o[2] * rs * g0.z, o[3] * rs * g0.w); w.z = pk2(o[4] * rs * g1.x, o[5] * rs * g1.y); w.w = pk2(o[6] * rs * g1.z, o[7] * rs * g1.w);
          *(u32x4*)(MIX + (size_t)t * D + c) = w; }
        { const f32x4 r0 = *(const f32x4*)(RO + (size_t)t * C5 + c), r1 = *(const f32x4*)(RO + (size_t)t * C5 + c + 4);
          float o[8]; float s = 0.f;
#pragma unroll
          for (int j = 0; j < 8; ++j) { o[j] = j < 4 ? r0[j & 3] : r1[j & 3]; s += o[j]; }
          s += __shfl_xor(s, 1); s += __shfl_xor(s, 2); s += __shfl_xor(s, 4); const float mean = s * (1.f / 64.f); float q = 0.f;
#pragma unroll
          for (int j = 0; j < 8; ++j) { o[j] -= mean; q += o[j] * o[j]; }
          q += __shfl_xor(q, 1); q += __shfl_xor(q, 2); q += __shfl_xor(q, 4); const float rstd = 1.f / sqrtf(q * (1.f / 64.f) + GN_EPS);
          const u32x4 rw = *(const u32x4*)(RK + (size_t)t * 1024 + c), kw = *(const u32x4*)(RK + (size_t)t * 1024 + 512 + c), vw = *(const u32x4*)(Vv + (size_t)t * C5 + c);
          const f32x4 a0 = *(const f32x4*)(WAG + (size_t)t * N_SM + 512 + c), a1 = *(const f32x4*)(WAG + (size_t)t * N_SM + 512 + c + 4);
          const f32x4 g0 = *(const f32x4*)(WAG + (size_t)t * N_SM + 1024 + c), g1 = *(const f32x4*)(WAG + (size_t)t * N_SM + 1024 + c + 4);
          const f32x4 ka0 = *(const f32x4*)(kaw + c), ka1 = *(const f32x4*)(kaw + c + 4), rk0 = *(const f32x4*)(rkw + c), rk1 = *(const f32x4*)(rkw + c + 4);
          const f32x4 gg0 = *(const f32x4*)(gng + c), gg1 = *(const f32x4*)(gng + c + 4), gb0 = *(const f32x4*)(gnb + c), gb1 = *(const f32x4*)(gnb + c + 4);
          float r[8], k[8], v[8]; float bon = 0.f;
#pragma unroll
          for (int j = 0; j < 4; ++j) { r[2 * j] = bflo(rw[j]); r[2 * j + 1] = bfhi(rw[j]); k[2 * j] = bflo(kw[j]); k[2 * j + 1] = bfhi(kw[j]); v[2 * j] = bflo(vw[j]); v[2 * j + 1] = bfhi(vw[j]); }
#pragma unroll
          for (int j = 0; j < 8; ++j) { const float a = j < 4 ? a0[j & 3] : a1[j & 3]; const float kp = k[j] * (1.0f + (a - 1.0f) * (j < 4 ? ka0[j & 3] : ka1[j & 3])); bon += r[j] * kp * (j < 4 ? rk0[j & 3] : rk1[j & 3]); }
          bon += __shfl_xor(bon, 1); bon += __shfl_xor(bon, 2); bon += __shfl_xor(bon, 4);
          float y[8];
#pragma unroll
          for (int j = 0; j < 8; ++j) { const float gn = o[j] * rstd * (j < 4 ? gg0[j & 3] : gg1[j & 3]) + (j < 4 ? gb0[j & 3] : gb1[j & 3]); y[j] = (gn + bon * v[j]) * (j < 4 ? g0[j & 3] : g1[j & 3]); }
          u32x4 w; w.x = pk2(y[0], y[1]); w.y = pk2(y[2], y[3]); w.z = pk2(y[4], y[5]); w.w = pk2(y[6], y[7]);
          *(u32x4*)(MIX + (size_t)t * D + C5 + c) = w; }
    }
}

#define DPPI(x, ctrl) __builtin_amdgcn_update_dpp(0, (x), (ctrl), 0xF, 0xF, true)
__device__ __forceinline__ float row16_max(float x) {
    x = fmaxf(x, __builtin_bit_cast(float, DPPI(__builtin_bit_cast(int, x), 0xB1))); x = fmaxf(x, __builtin_bit_cast(float, DPPI(__builtin_bit_cast(int, x), 0x4E)));
    x = fmaxf(x, __builtin_bit_cast(float, DPPI(__builtin_bit_cast(int, x), 0x141))); x = fmaxf(x, __builtin_bit_cast(float, DPPI(__builtin_bit_cast(int, x), 0x140))); return x; }
__device__ __forceinline__ int row16_min(int x) {
    x = min(x, DPPI(x, 0xB1)); x = min(x, DPPI(x, 0x4E)); x = min(x, DPPI(x, 0x141)); x = min(x, DPPI(x, 0x140)); return x; }
__device__ __forceinline__ void phase_ln1_route(const Params& p, const Frame& F, int l) {
    LAS unsigned char* wl = F.lds;
    LAS int* hist = (LAS int*)(F.lds + LDSX_OFF + 4096);
    LAS int* basep = hist + 32;
    LAS int* rinfo = hist + 64;
    LAS float* rgate = (LAS float*)(rinfo + 512);
    const float* mod = WSP(float, WS_MOD) + (size_t)l * NBATCH * 6144;
    const float* g1 = INP(I_LN1G) + (size_t)l * D; const float* b1 = INP(I_LN1B) + (size_t)l * D;
    const float* rb = INP(I_RB) + (size_t)l * NE;
    unsigned* cnt = (unsigned*)(F.ws + WS_CTL) + CW_CNT + l * 64;
    int* LIST = WSP(int, WS_LIST); float* GATEL = WSP(float, WS_GATEL); int* TOKSLOT = WSP(int, WS_TOKSLOT);
    float* X = WSP(float, WS_X); bf16* H = WSP(bf16, WS_H);
    const int lane = F.lane, li = lane & 15, g = lane >> 4;
    __syncthreads();
    for (int i = F.tid; i < 2 * 4096; i += NTHREADS) { const int part = i >> 12, rem = i & 4095, e = rem >> 7, ch = rem & 127;
        const u32x4 v = *(const u32x4*)(WSP(bf16, WS_RWT) + ((size_t)part * DEPTH + l) * NE * D + (size_t)e * D + ch * 8);
        *(LAS u32x4*)(wl + part * 65536 + e * 2048 + ((ch ^ (e & 15)) << 4)) = v; }
    __syncthreads();
    for (int chunk = F.vcu; chunk < T / 128; chunk += F.G) {
        __syncthreads();
        if (F.tid < 32) hist[F.tid] = 0;
        __syncthreads();
        const int row0 = chunk * 128 + F.wave * 16; const int b = row0 / SEQ;
        float mymean = 0.f, myrstd = 0.f;
#pragma unroll 1
        for (int rr = 0; rr < 16; ++rr) {
            const GAS f32x4* xr = (const GAS f32x4*)(X + (size_t)(row0 + rr) * D) + lane;
            f32x4 v[4]; float s = 0.f;
#pragma unroll
            for (int j = 0; j < 4; ++j) { v[j] = xr[64 * j]; s += (v[j].x + v[j].y) + (v[j].z + v[j].w); }
            const float mean = wave_sum(s) * (1.f / D); float s2 = 0.f;
#pragma unroll
            for (int j = 0; j < 4; ++j) { v[j] = v[j] - mean; s2 += (v[j].x * v[j].x + v[j].y * v[j].y) + (v[j].z * v[j].z + v[j].w * v[j].w); }
            const float rstd = __builtin_amdgcn_rsqf(wave_sum(s2) * (1.f / D) + LN_EPS);
            if (li == rr) { mymean = mean; myrstd = rstd; }
        }
        f32x4 acc0 = (f32x4){0.f, 0.f, 0.f, 0.f}, acc1 = acc0;
        float* xrow = X + (size_t)(row0 + li) * D + 8 * g; bf16* hrow = H + (size_t)(row0 + li) * D + 8 * g;
        const float* shp = mod + (size_t)b * 6144 + 3072 + 8 * g; const float* scp = mod + (size_t)b * 6144 + 4096 + 8 * g;
        const LAS unsigned char* w0 = wl + li * 2048; const LAS unsigned char* w1 = wl + (16 + li) * 2048;
#pragma unroll 2
        for (int s = 0; s < 32; ++s) {
            const int k = 32 * s;
            const f32x4 y0 = *(const f32x4*)(xrow + k), y1 = *(const f32x4*)(xrow + k + 4);
            const f32x4 ga0 = *(const f32x4*)(g1 + k + 8 * g), ga1 = *(const f32x4*)(g1 + k + 8 * g + 4), be0 = *(const f32x4*)(b1 + k + 8 * g), be1 = *(const f32x4*)(b1 + k + 8 * g + 4);
            const f32x4 sc0 = *(const f32x4*)(scp + k), sc1 = *(const f32x4*)(scp + k + 4), sh0 = *(const f32x4*)(shp + k), sh1 = *(const f32x4*)(shp + k + 4);
            const f32x4 x0 = (y0 - mymean) * myrstd * ga0 + be0, x1 = (y1 - mymean) * myrstd * ga1 + be1;
            *(f32x4*)(xrow + k) = x0; *(f32x4*)(xrow + k + 4) = x1;
            const f32x4 h0 = x0 * (sc0 + 1.0f) + sh0, h1 = x1 * (sc1 + 1.0f) + sh1;
            u32x4 hi; hi.x = cvtpk_c(h0.x, h0.y); hi.y = cvtpk_c(h0.z, h0.w); hi.z = cvtpk_c(h1.x, h1.y); hi.w = cvtpk_c(h1.z, h1.w);
            *(u32x4*)(hrow + k) = hi;
            u32x4 lo; lo.x = cvtpk_c(h0.x - bflo(hi.x), h0.y - bfhi(hi.x)); lo.y = cvtpk_c(h0.z - bflo(hi.y), h0.w - bfhi(hi.y)); lo.z = cvtpk_c(h1.x - bflo(hi.z), h1.y - bfhi(hi.z)); lo.w = cvtpk_c(h1.z - bflo(hi.w), h1.w - bfhi(hi.w));
            const int cho = ((4 * s + g) ^ li) << 4;
            const bf16x8 bh0 = *(const LAS bf16x8*)(w0 + cho), bh1 = *(const LAS bf16x8*)(w1 + cho), bl0 = *(const LAS bf16x8*)(w0 + 65536 + cho), bl1 = *(const LAS bf16x8*)(w1 + 65536 + cho);
            const bf16x8 ahi = __builtin_bit_cast(bf16x8, hi), alo = __builtin_bit_cast(bf16x8, lo);
            acc0 = __builtin_amdgcn_mfma_f32_16x16x32_bf16(ahi, bh0, acc0, 0, 0, 0); acc1 = __builtin_amdgcn_mfma_f32_16x16x32_bf16(ahi, bh1, acc1, 0, 0, 0);
            acc0 = __builtin_amdgcn_mfma_f32_16x16x32_bf16(alo, bh0, acc0, 0, 0, 0); acc1 = __builtin_amdgcn_mfma_f32_16x16x32_bf16(alo, bh1, acc1, 0, 0, 0);
            acc0 = __builtin_amdgcn_mfma_f32_16x16x32_bf16(ahi, bl0, acc0, 0, 0, 0); acc1 = __builtin_amdgcn_mfma_f32_16x16x32_bf16(ahi, bl1, acc1, 0, 0, 0);
        }
        const float rb0 = rb[li], rb1 = rb[16 + li];
#pragma unroll
        for (int reg = 0; reg < 4; ++reg) {
            float v0 = acc0[reg] + rb0, v1 = acc1[reg] + rb1;
            float tv0 = 0.f, tv1 = 0.f, tv2 = 0.f, tv3 = 0.f; int te0 = 0, te1 = 0, te2 = 0, te3 = 0;
#pragma unroll
            for (int k = 0; k < 4; ++k) { const float mx = row16_max(fmaxf(v0, v1));
                const int id = (v0 == mx) ? li : ((v1 == mx) ? 16 + li : 99); const int ek = row16_min(id);
                if (k == 0) { tv0 = mx; te0 = ek; } else if (k == 1) { tv1 = mx; te1 = ek; } else if (k == 2) { tv2 = mx; te2 = ek; } else { tv3 = mx; te3 = ek; }
                if (ek == li) v0 = -INFINITY; if (ek == 16 + li) v1 = -INFINITY; }
            const float e1 = __expf(tv1 - tv0), e2 = __expf(tv2 - tv0), e3 = __expf(tv3 - tv0); const float inv = __builtin_amdgcn_rcpf(1.0f + e1 + e2 + e3);
            if (li < 4) { const int lr = F.wave * 16 + 4 * g + reg; const int ek = li == 0 ? te0 : li == 1 ? te1 : li == 2 ? te2 : te3; const float gk = (li == 0 ? 1.0f : li == 1 ? e1 : li == 2 ? e2 : e3) * inv;
                const int lp = __hip_atomic_fetch_add(&hist[ek], 1, __ATOMIC_RELAXED, __HIP_MEMORY_SCOPE_WORKGROUP); rinfo[lr * 4 + li] = (ek << 16) | lp; rgate[lr * 4 + li] = gk; }
        }
        __syncthreads();
        if (F.tid < 32) basep[F.tid] = (int)__hip_atomic_fetch_add(cnt + F.tid, (unsigned)hist[F.tid], RLX_AGENT);
        __syncthreads();
        { const int lr = F.tid >> 2, k = F.tid & 3; const int m = chunk * 128 + lr; const int info = rinfo[F.tid]; const int ek = info >> 16; const int pos = basep[ek] + (info & 0xffff);
          LIST[ek * CAP + pos] = m; GATEL[ek * CAP + pos] = rgate[F.tid]; TOKSLOT[m * 4 + k] = (ek << 16) | pos; }
    }
    __syncthreads();
}

__device__ __forceinline__ void moe_tables(const Frame& F, int l) {
    LAS int* tb = (LAS int*)(F.lds + TB_OFF); LAS int* cn = tb + 40;
    const unsigned* cnt = (const unsigned*)(F.ws + WS_CTL) + CW_CNT + l * 64;
    __syncthreads();
    if (F.tid == 0) { int acc = 0;
        for (int e = 0; e < NE; ++e) { const int c = (int)__hip_atomic_load(cnt + e, RLX_AGENT); cn[e] = c; tb[e] = acc; acc += (c + 255) >> 8; }
        tb[NE] = acc; }
    __syncthreads();
}

__device__ __forceinline__ void phase_combine(const Params& p, const Frame& F, int l) {
    const LAS int* tb = (const LAS int*)(F.lds + TB_OFF);
    const int gw = F.vcu * NWAVES + F.wave, NGW = F.G * NWAVES; const int lane = F.lane;
    const float* mod = WSP(float, WS_MOD) + (size_t)l * NBATCH * 6144; const float* modn = WSP(float, WS_MOD) + (size_t)(l + 1) * NBATCH * 6144;
    const float* g2 = INP(I_LN2G) + (size_t)l * D; const float* b2 = INP(I_LN2B) + (size_t)l * D;
    const bf16* Y = WSP(bf16, WS_Y); const int* TOKSLOT = WSP(int, WS_TOKSLOT);
    const bool lastl = (l == DEPTH - 1);
    for (int m = gw; m < T; m += NGW) {
        const int b = m / SEQ;
        int srow[4];
#pragma unroll
        for (int k = 0; k < 4; ++k) { const int ts = TOKSLOT[m * 4 + k]; const int e = ts >> 16, pos = ts & 0xffff; srow[k] = tb[e] * 256 + pos; }
        GAS f32x4* xr = (GAS f32x4*)(WSP(float, WS_X) + (size_t)m * D) + lane;
        f32x4 v[4]; float s = 0.f;
#pragma unroll
        for (int j = 0; j < 4; ++j) { const int c = 4 * lane + 256 * j; f32x4 y = (f32x4){0.f, 0.f, 0.f, 0.f};
#pragma unroll
            for (int k = 0; k < 4; ++k) { const u32x2 yw = *(const u32x2*)(Y + (size_t)srow[k] * D + c); y.x += bflo(yw.x); y.y += bfhi(yw.x); y.z += bflo(yw.y); y.w += bfhi(yw.y); }
            const f32x4 gt = *(const f32x4*)(mod + (size_t)b * 6144 + 5120 + c) + 1.0f;
            v[j] = xr[64 * j] * DN_ALPHA + gt * y; s += (v[j].x + v[j].y) + (v[j].z + v[j].w); }
        const float mean = wave_sum(s) * (1.f / D); float s2 = 0.f;
#pragma unroll
        for (int j = 0; j < 4; ++j) { v[j] = v[j] - mean; s2 += (v[j].x * v[j].x + v[j].y * v[j].y) + (v[j].z * v[j].z + v[j].w * v[j].w); }
        const float rstd = 1.f / sqrtf(wave_sum(s2) * (1.f / D) + LN_EPS);
        GAS f32x4* oo = (GAS f32x4*)(p.out + (size_t)m * D) + lane;
        GAS u32x2* ho = (GAS u32x2*)(WSP(bf16, WS_H) + (size_t)m * D) + lane;
#pragma unroll
        for (int j = 0; j < 4; ++j) { const int c = 4 * lane + 256 * j;
            const f32x4 g = *(const f32x4*)(g2 + c), be = *(const f32x4*)(b2 + c);
            const f32x4 x2 = v[j] * rstd * g + be;
            if (lastl) oo[64 * j] = x2;
            else { xr[64 * j] = x2;
                const f32x4 sh = *(const f32x4*)(modn + (size_t)b * 6144 + c), sc = *(const f32x4*)(modn + (size_t)b * 6144 + 1024 + c);
                const f32x4 h = x2 * (sc + 1.0f) + sh; u32x2 w; w.x = pk2(h.x, h.y); w.y = pk2(h.z, h.w); ho[64 * j] = w; } }
    }
}

constexpr int PH_PER_LAYER = 11, N_PHASES = 2 + DEPTH * PH_PER_LAYER;
__global__ void __launch_bounds__(NTHREADS, 2) fwd(Params p) {
    extern __shared__ __attribute__((aligned(16))) unsigned char lds[];
    Frame F;
    F.lds = (LAS unsigned char*)lds; F.tid = threadIdx.x; F.lane = F.tid & 63; F.wave = __builtin_amdgcn_readfirstlane(F.tid >> 6);
    F.G = gridDim.x; { const int bx = blockIdx.x; F.vcu = (F.G % 8 == 0) ? (bx % 8) * (F.G / 8) + bx / 8 : bx; }
    F.ws = p.ws;
    volatile LAS unsigned* MISC = (volatile LAS unsigned*)(F.lds + MISC_OFF);
    if (F.tid < 64) MISC[F.tid] = 0u;
    __syncthreads();
    unsigned* ctl = (unsigned*)(p.ws + WS_CTL);
#if MK_ONE_LAUNCH
    XcdBarrier bar = xcd_barrier_post(ctl + CW_BAR, MISC + 8);
#define GRID_BAR() xcd_barrier(bar)
#else
#define GRID_BAR() do {} while (0)
#endif
    const int lo = p.ph_lo, hi = p.ph_hi;
#ifndef PH_MASK
#define PH_MASK 0xFFFFFFFFu
#endif
#define IN(k) (lo <= (k) && (k) < hi)
#define EN(j) ((PH_MASK >> (j)) & 1u)
#define SEAM(k) do { if (IN(k) && IN((k) + 1)) GRID_BAR(); } while (0)
    LAS unsigned char* ring = F.lds;

    if (EN(0) && IN(0)) { for (int rep = 0; rep < REP_PRO; ++rep) phase_prologue(p, F); } SEAM(0);
    if (EN(1) && IN(1)) { phase_ln0(p, F); } SEAM(1);
#define LAYER_BODY \
        constexpr int pb = 2 + l * PH_PER_LAYER; \
        const float* mod = WSP(float, WS_MOD) + (size_t)l * NBATCH * 6144; \
        if (EN(2) && IN(pb + 0)) { \
            pg8::Gemm g{WSP(bf16, WS_H), WSP(bf16, WS_WINT) + (size_t)l * N_INP * D, T, N_INP, D}; pg8::DenseOrder S; S.init(T, N_INP, F.G, (int)blockIdx.x); \
            pg8::EpiBf16Plain E{WSP(bf16, WS_P), N_INP}; \
            for (int rep = 0; rep < REP_WIN; ++rep) pg8::gemm_phase<pg8::EpiBf16Plain, pg8::DenseOrder, true>(ring, g, S, E); \
        } SEAM(pb + 0); \
        if (EN(3) && IN(pb + 1)) { for (int rep = 0; rep < REP_PREP; ++rep) phase_prep(p, F, l); } SEAM(pb + 1); \
        if (EN(4) && IN(pb + 2)) { \
            if (EN(13)) { pg8::Gemm g{WSP(bf16, WS_AN), WSP(bf16, WS_WUPT) + (size_t)l * N_UP * K_UP, T, N_UP, K_UP}; pg8::DenseOrder S; S.init(T, N_UP, F.G, (int)blockIdx.x); \
              pg8::EpiMlaUp E{WSP(bf16, WS_Q), WSP(bf16, WS_KK), WSP(bf16, WS_V), WSP(float, WS_CS)}; \
              pg8::gemm_phase<pg8::EpiMlaUp, pg8::DenseOrder, true>(ring, g, S, E); } \
            if (EN(14)) { pg8::Gemm g{WSP(bf16, WS_A2), WSP(bf16, WS_WSMT) + (size_t)l * N_SM * K_SM, T, N_SM, K_SM}; pg8::DenseOrder S; S.init(T, N_SM, F.G, (int)blockIdx.x); \
              pg8::EpiRwkvSmall E{WSP(float, WS_WAG), INP(I_W0) + (size_t)l * C5, INP(I_A0) + (size_t)l * C5}; \
              pg8::gemm_phase<pg8::EpiRwkvSmall, pg8::DenseOrder, true>(ring, g, S, E); } \
            if (EN(15) && l > 0) { pg8::Gemm g{WSP(bf16, WS_VS1), WSP(bf16, WS_WV12T), T, C5, C5}; pg8::DenseOrder S; S.init(T, C5, F.G, (int)blockIdx.x); \
              pg8::EpiVres E{WSP(bf16, WS_VS1), WSP(bf16, WS_VS0), WSP(bf16, WS_VR), INP(I_V0)}; \
              pg8::gemm_phase<pg8::EpiVres, pg8::DenseOrder, true>(ring, g, S, E); } \
        } SEAM(pb + 2); \
        if (EN(5) && IN(pb + 3)) { phase_rwkv_r1(p, F, l); } SEAM(pb + 3); \
        if (EN(6) && IN(pb + 4)) { phase_rwkv_r2(p, F); if (l == 0) { const int c0 = F.G / 4, nc = (F.G * 3) / 8; if (F.vcu >= c0 && F.vcu < c0 + nc) phase_convert_experts(p, F, c0, nc); } phase_attn(p, F, (char*)lds, l); } SEAM(pb + 4); \
        if (EN(7) && IN(pb + 5)) { for (int rep = 0; rep < REP_MIX; ++rep) phase_mix(p, F, l); } SEAM(pb + 5); \
        if (EN(8) && IN(pb + 6)) { \
            pg8::Gemm g{WSP(bf16, WS_MIX), WSP(bf16, WS_WOT) + (size_t)l * D * D, T, D, D}; pg8::DenseOrder S; S.init(T, D, F.G, (int)blockIdx.x); \
            pg8::EpiWo E{WSP(float, WS_X), mod + 2048}; \
            pg8::gemm_phase<pg8::EpiWo, pg8::DenseOrder, true>(ring, g, S, E); \
        } SEAM(pb + 6); \
        if (EN(9) && IN(pb + 7)) { phase_ln1_route(p, F, l); } SEAM(pb + 7); \
        if (EN(10) && IN(pb + 8)) { \
            moe_tables(F, l); \
            const LAS int* tb = (const LAS int*)(F.lds + TB_OFF); \
            pg8::Gemm g{WSP(bf16, WS_H), WSP(bf16, WS_W1T) + (size_t)l * NE * 2048 * D, T, 2048, D}; \
            pg8::MoeOrder<true> S{tb, tb + 40, WSP(int, WS_LIST), 8, F.G, F.vcu, (LAS unsigned*)(F.lds + GT_OFF)}; \
            pg8::EpiSwiglu E{WSP(bf16, WS_H1), WSP(float, WS_B1P) + (size_t)l * NE * 2048}; \
            for (int rep = 0; rep < REP_MOE1; ++rep) pg8::gemm_phase<pg8::EpiSwiglu, pg8::MoeOrder<true>, true>(ring, g, S, E); \
        } SEAM(pb + 8); \
        if (EN(11) && IN(pb + 9)) { \
            moe_tables(F, l); \
            const LAS int* tb = (const LAS int*)(F.lds + TB_OFF); \
            pg8::Gemm g{WSP(bf16, WS_H1), WSP(bf16, WS_W2T) + (size_t)l * NE * D * FF, MAXSLOT, D, FF}; \
            pg8::MoeOrder<false> S{tb, tb + 40, nullptr, 4, F.G, F.vcu, nullptr}; \
            pg8::EpiMoeOut E{WSP(bf16, WS_Y), INP(I_EB2) + (size_t)l * NE * D, WSP(float, WS_GATEL), tb}; \
            for (int rep = 0; rep < REP_MOE2; ++rep) pg8::gemm_phase<pg8::EpiMoeOut, pg8::MoeOrder<false>, true>(ring, g, S, E); \
        } SEAM(pb + 9); \
        if (EN(12) && IN(pb + 10)) { moe_tables(F, l); phase_combine(p, F, l); } SEAM(pb + 10);
    { constexpr int l = 0; LAYER_BODY }
    { constexpr int l = 1; LAYER_BODY }
#undef LAYER_BODY
#undef IN
#undef SEAM
}

extern "C" void kernel_launch(void* const* d_in, const int* in_sizes, int n_in, void* d_out, int out_size, void* d_ws, size_t ws_size, hipStream_t stream) {
    static int grid = 0;
    if (grid == 0) {
        if (n_in != N_INPUTS || out_size != T * D || ws_size < WS_END) { fprintf(stderr, "kernel_launch: unexpected problem: n_in %d out %d ws %zu\n", n_in, out_size, ws_size); grid = -1; return; }
        int dev = 0, cus = 0, per_cu = 0;
        if (hipGetDevice(&dev) != hipSuccess || hipDeviceGetAttribute(&cus, hipDeviceAttributeMultiprocessorCount, dev) != hipSuccess) { grid = -1; return; }
        if (hipFuncSetAttribute((const void*)fwd, hipFuncAttributeMaxDynamicSharedMemorySize, LDS_BYTES) != hipSuccess) { fprintf(stderr, "kernel_launch: hipFuncSetAttribute failed\n"); grid = -1; return; }
        if (hipOccupancyMaxActiveBlocksPerMultiprocessor(&per_cu, (const void*)fwd, NTHREADS, LDS_BYTES) != hipSuccess || per_cu < 1) fprintf(stderr, "kernel_launch: occupancy query reports %d\n", per_cu);
        (void)hipGetLastError();
        grid = cus;
    }
    if (grid < 0) return;
    if (hipMemsetAsync((char*)d_ws + WS_CTL, 0, CTL_ZERO_BYTES, stream) != hipSuccess) return;
    Params p{};
    for (int i = 0; i < N_INPUTS; ++i) p.in[i] = d_in[i];
    p.out = (float*)d_out; p.ws = (unsigned char*)d_ws;
#if MK_ONE_LAUNCH
    p.ph_lo = 0; p.ph_hi = N_PHASES;
    hipLaunchKernelGGL(fwd, dim3(grid), dim3(NTHREADS), LDS_BYTES, stream, p);
#else
    for (int ph = 0; ph < N_PHASES; ++ph) { p.ph_lo = ph; p.ph_hi = ph + 1; hipLaunchKernelGGL(fwd, dim3(grid), dim3(NTHREADS), LDS_BYTES, stream, p); }
#endif
}
```

```cpp
#include <hip/hip_runtime.h>
#include <cstdio>
#include <cstdint>

#define REP_PRO 1
#define REP_ATTN 1
#define REP_RWKV 1
#define REP_MOE1 1
#define REP_MOE2 1
#define REP_WIN 1
#define REP_PREP 1
#define REP_MIX 1
#ifndef MK_ONE_LAUNCH
#define MK_ONE_LAUNCH 1
#endif

#define GAS __attribute__((address_space(1)))
#define LAS __attribute__((address_space(3)))
typedef unsigned short bf16;
typedef short bf16x8 __attribute__((ext_vector_type(8)));
typedef short s16x4 __attribute__((ext_vector_type(4)));
typedef float f32x2 __attribute__((ext_vector_type(2)));
typedef float f32x4 __attribute__((ext_vector_type(4)));
typedef float f32x16 __attribute__((ext_vector_type(16)));
typedef unsigned u32x2 __attribute__((ext_vector_type(2)));
typedef unsigned u32x4 __attribute__((ext_vector_type(4)));

constexpr int D = 1024, NBATCH = 8, SEQ = 4096, T = NBATCH * SEQ, DEPTH = 2;
constexpr int MLA_IN = 416, RWKV_IN = 1792, N_IN = 2208, N_INP = 2304;
constexpr int QLR = 256, KVLR = 128, ROPE = 32, NOPE = 64, QKD = 96, VD = 64, NH = 8;
constexpr int C5 = 512;
constexpr int NE = 32, TOPK = 4, FF = 1024, CAP = 32768;
constexpr int N_UP = 1792, K_UP = 384, N_SM = 1536, K_SM = 256;
constexpr int MAXSLOT = 139264;
constexpr float DN_ALPHA = 1.4142135623730951f;
constexpr float C2Q = 0.14724444602590306f;
constexpr float LN_EPS = 1e-5f, RMS_EPS = 1e-6f, GN_EPS = 64e-5f;
constexpr int NWAVES = 8, NTHREADS = 512;

enum { I_X = 0, I_C, I_POS, I_ELNG, I_ELNB, I_ADAW, I_ADAB, I_WIN, I_QNG, I_WUQ, I_KVNG, I_WUK, I_WUV, I_MOUTG, I_MU, I_W0, I_W2, I_A0, I_A2, I_G2,
       I_KK, I_KA, I_RK, I_GNG, I_GNB, I_V0, I_V1, I_V2, I_WO, I_LN1G, I_LN1B, I_RW, I_RB, I_EW1, I_EB1, I_EW2, I_EB2, I_LN2G, I_LN2B, N_INPUTS };

constexpr size_t MiB = 1u << 20;
constexpr size_t WS_CTL = 0, CTL_ZERO_BYTES = 4 * MiB;
constexpr size_t WS_MOD = 4 * MiB, WS_B1P = 5 * MiB, WS_CS = 6 * MiB, WS_LIST = 10 * MiB, WS_GATEL = 14 * MiB, WS_TOKSLOT = 18 * MiB;
constexpr size_t WS_RWT = 19 * MiB;
constexpr size_t WS_WINT = 20 * MiB, WS_WUPT = 30 * MiB, WS_WSMT = 33 * MiB, WS_WV12T = 35 * MiB, WS_WOT = 36 * MiB, WS_W1T = 40 * MiB, WS_W2T = 296 * MiB;
constexpr size_t WS_X = 424 * MiB, WS_H = 552 * MiB, WS_VS0 = 616 * MiB, WS_VS1 = 648 * MiB;
constexpr size_t WS_P = 680 * MiB, WS_AN = 824 * MiB, WS_A2 = 848 * MiB, WS_RK = 864 * MiB, WS_Q = 928 * MiB, WS_KK = 976 * MiB, WS_V = 1024 * MiB, WS_O = 1056 * MiB;
constexpr size_t WS_WAG = 1088 * MiB, WS_RO = 1280 * MiB, WS_MIX = 1344 * MiB, WS_VR = 1408 * MiB;
constexpr size_t WS_H1 = 680 * MiB, WS_Y = 952 * MiB;
constexpr size_t WS_CH = 1440 * MiB;
constexpr size_t WS_END = 1696 * MiB;
constexpr int CW_TMO = 0, CW_CODE = 1, CW_BAR = 4096, CW_CNT = 8192, CW_ATTQ = 8448;

constexpr int RING_BYTES = 131072;
constexpr int LDSX_OFF = RING_BYTES;
constexpr int MISC_OFF = LDSX_OFF;
constexpr int TB_OFF = LDSX_OFF + 256;
constexpr int GT_OFF = LDSX_OFF + 1024;
constexpr int LDS_BYTES = 147456;

#define RLX_AGENT __ATOMIC_RELAXED, __HIP_MEMORY_SCOPE_AGENT
#define LDS_WAIT() asm volatile("s_waitcnt lgkmcnt(0)" ::: "memory")
#define VM_WAIT() asm volatile("s_waitcnt vmcnt(0)" ::: "memory")

__device__ __forceinline__ unsigned f2bf(float f) { unsigned u = __builtin_bit_cast(unsigned, f); return (u + 0x7fffu + ((u >> 16) & 1u)) >> 16; }
__device__ __forceinline__ unsigned pk2(float lo, float hi) { return f2bf(lo) | (f2bf(hi) << 16); }
__device__ __forceinline__ float bf2f(unsigned b) { return __builtin_bit_cast(float, b << 16); }
__device__ __forceinline__ float bflo(unsigned w) { return __builtin_bit_cast(float, w << 16); }
__device__ __forceinline__ float bfhi(unsigned w) { return __builtin_bit_cast(float, w & 0xffff0000u); }
__device__ __forceinline__ unsigned cvt_pk_bf16(float lo, float hi) { unsigned r; asm volatile("v_cvt_pk_bf16_f32 %0, %1, %2" : "=v"(r) : "v"(lo), "v"(hi)); return r; }
typedef __bf16 bf16x2_t __attribute__((ext_vector_type(2)));
__device__ __forceinline__ unsigned cvtpk_c(float lo, float hi) { f32x2 v = {lo, hi}; bf16x2_t b = __builtin_convertvector(v, bf16x2_t); return __builtin_bit_cast(unsigned, b); }
__device__ __forceinline__ float wave_sum(float v) {
#pragma unroll
    for (int o = 1; o < 64; o <<= 1) v += __shfl_xor(v, o);
    return v;
}
__device__ __forceinline__ float sigmoidf_(float x) { return __builtin_amdgcn_rcpf(1.0f + __expf(-x)); }
__device__ __forceinline__ float tanhf_(float x) { return 1.0f - 2.0f * __builtin_amdgcn_rcpf(1.0f + __expf(2.0f * x)); }

#define XB_TMO      128
#define XB_XCNT(j)  (256  + 64 * (j))
#define XB_XSUB(j)  (1280 + 64 * (j))
#define XB_XGEN(j)  (2304 + 64 * (j))
#define XB_TOP      3328
#define XB_TOPGEN   3392
#define XCD_BAR_WORDS 3456
#define XB_SPIN_CAP (1u << 18)
__device__ __forceinline__ unsigned xb_ld(unsigned* p)              { return __hip_atomic_load(p, __ATOMIC_RELAXED, __HIP_MEMORY_SCOPE_AGENT); }
__device__ __forceinline__ unsigned xb_add(unsigned* p, unsigned v) { return __hip_atomic_fetch_add(p, v, __ATOMIC_RELAXED, __HIP_MEMORY_SCOPE_AGENT); }
__device__ __forceinline__ unsigned xb_xcc_id() { return (unsigned)__builtin_amdgcn_s_getreg((3 << 11) | 20) & 0xFu; }
#define XB_SPIN(cond, bar) do { unsigned _sp = 0; while (cond) { __builtin_amdgcn_s_sleep(1); \
    if ((++_sp & 255u) == 0u) { if (xb_ld(&(bar)[XB_TMO])) break; if (_sp > XB_SPIN_CAP) { atomicAdd(&(bar)[XB_TMO], 1u); break; } } } } while (0)
struct XcdBarrier { unsigned* bar; unsigned x; volatile LAS unsigned* st; };
__device__ __forceinline__ XcdBarrier xcd_barrier_post(unsigned* bar, volatile LAS unsigned* st) {
    XcdBarrier b; b.bar = bar; b.x = xb_xcc_id(); b.st = st;
    if (threadIdx.x == 0) (void)xb_add(&bar[XB_XCNT(b.x)], 1u);
    return b;
}
__device__ __forceinline__ void xcd_barrier_complete(unsigned* bar, unsigned x, unsigned& nloc, unsigned& nx) {
    const unsigned G = gridDim.x * gridDim.y * gridDim.z;
    unsigned sum, cnt, mine, sp = 0u;
    for (;;) {
        sum = 0u; cnt = 0u; mine = 0u;
#pragma unroll
        for (unsigned j = 0; j < 16; ++j) { const unsigned c = xb_ld(&bar[XB_XCNT(j)]); sum += c; cnt += (c > 0u) ? 1u : 0u; mine = (j == x) ? c : mine; }
        if (sum == G) break;
        __builtin_amdgcn_s_sleep(1);
        if ((++sp & 255u) == 0u) { if (xb_ld(&bar[XB_TMO])) break; if (sp > XB_SPIN_CAP) { atomicAdd(&bar[XB_TMO], 1u); break; } }
    }
    nloc = mine > 0u ? mine : 1u; nx = cnt > 0u ? cnt : 1u;
}
__device__ __forceinline__ void xcd_barrier(const XcdBarrier& b) {
    asm volatile("s_waitcnt vmcnt(0)" ::: "memory");
    __syncthreads();
    if (threadIdx.x == 0) {
        unsigned* bar = b.bar;
        __builtin_amdgcn_s_waitcnt(0);
        unsigned nloc = b.st[0], nx = b.st[1];
        if (nloc == 0u) { xcd_barrier_complete(bar, b.x, nloc, nx); b.st[0] = nloc; b.st[1] = nx; }
        const unsigned old = xb_add(&bar[XB_XSUB(b.x)], 1u);
        const unsigned gen = old / nloc;
        if (old + 1u == (gen + 1u) * nloc) {
            __builtin_amdgcn_fence(__ATOMIC_RELEASE, "agent");
            asm volatile("s_waitcnt vmcnt(0)" ::: "memory");
            const unsigned og = xb_add(&bar[XB_TOP], 1u);
            const unsigned tg = og / nx;
            if (og + 1u == (tg + 1u) * nx) xb_add(&bar[XB_TOPGEN], 1u);
            else XB_SPIN(xb_ld(&bar[XB_TOPGEN]) == tg, bar);
            __builtin_amdgcn_fence(__ATOMIC_ACQUIRE, "agent");
            xb_add(&bar[XB_XGEN(b.x)], 1u);
            asm volatile("s_waitcnt vmcnt(0)" ::: "memory");
        } else {
            XB_SPIN(xb_ld(&bar[XB_XGEN(b.x)]) == gen, bar);
            __builtin_amdgcn_fence(__ATOMIC_ACQUIRE, "agent");
            asm volatile("s_waitcnt vmcnt(0)" ::: "memory");
        }
    }
    __syncthreads();
}

namespace pg8 {
constexpr int BM = 256, BK = 64, HALF = 128, HTB = HALF * BK * 2, STAGE_BYTES = 8 * HTB, NXCD = 8, WGM = 8;
__device__ __forceinline__ int lds_byte(int r, int c) { const int st = (r >> 4) * 2 + (c >> 5), rr = r & 15, cc = c & 31, ob = rr * 64 + cc * 2; return st * 1024 + (ob ^ (((ob >> 9) & 1) << 5)); }
__device__ __forceinline__ void stage_rc(int b, int& R, int& C) { const int st = b / 1024, sb = b % 1024, swz = sb ^ (((sb >> 9) & 1) << 5); R = (st >> 1) * 16 + swz / 64; C = (st & 1) * 32 + (swz % 64) / 2; }
__device__ __forceinline__ int perm32(int rho) { const int n = rho >> 4, i = rho & 15; return 8 * (i >> 2) + 4 * n + (i & 3); }

struct Unit { int pm, pn, e; };
struct Gemm { const bf16* A; const bf16* Bt; int M, N, K; };

struct DenseOrder {
    int nM, nN, nwg, G, c;
    __device__ __forceinline__ void init(int M, int N, int G_, int c_) { nM = M / BM; nN = N / BM; nwg = nM * nN; G = G_; c = c_; }
    __device__ __forceinline__ bool next(int i, Unit& u) const {
        const long L = (long)i * G + c; if (L >= nwg) return false;
        int wgid = (int)L; { const int q = nwg / NXCD, r = nwg % NXCD, xcd = wgid % NXCD, off = wgid / NXCD; wgid = (xcd < r ? xcd * (q + 1) : r * (q + 1) + (xcd - r) * q) + off; }
        const int nig = WGM * nN, gid = wgid / nig, fm = gid * WGM, gsz = (nM - fm) < WGM ? (nM - fm) : WGM;
        u.pm = fm + ((wgid % nig) % gsz); u.pn = (wgid % nig) / gsz; u.e = 0; return true;
    }
    static constexpr bool GATHER = false;
    __device__ __forceinline__ size_t b_off(const Unit& u, int N, int K) const { return (size_t)u.pn * BM * K * 2; }
    __device__ __forceinline__ unsigned a_row_off(const Unit& u, int row, int K) const { return 0u; }
    __device__ __forceinline__ LAS unsigned* gtab() const { return nullptr; }
};
template <bool GATHER_> struct MoeOrder {
    static constexpr bool GATHER = GATHER_;
    const LAS int* tb; const LAS int* cnt; const int* list; int nN, G, c; LAS unsigned* gt_;
    __device__ __forceinline__ LAS unsigned* gtab() const { return gt_; }
    __device__ __forceinline__ bool next(int i, Unit& u) const {
        const int L = i * G + c; const int total = tb[NE] * nN; if (L >= total) return false;
        int e = 0;
#pragma unroll 1
        for (int j = 1; j < NE; ++j) if (tb[j] * nN <= L) e = j;
        const int Lr = L - tb[e] * nN, nte = tb[e + 1] - tb[e];
        const int mblk = Lr / (4 * nN), m0 = mblk * 4, gsz = (nte - m0) < 4 ? (nte - m0) : 4, rem = Lr - mblk * 4 * nN;
        u.e = e; u.pn = rem / gsz; u.pm = tb[e] + m0 + (rem % gsz); return true;
    }
    __device__ __forceinline__ size_t b_off(const Unit& u, int N, int K) const { return ((size_t)u.e * N + (size_t)u.pn * BM) * K * 2; }
    __device__ __forceinline__ unsigned a_row_off(const Unit& u, int row, int K) const {
        const int pos = (u.pm - tb[u.e]) * BM + row; const int tok = pos < cnt[u.e] ? list[u.e * CAP + pos] : 0; return (unsigned)tok * (unsigned)(K * 2);
    }
};

template <class Epi, class Sched, bool ALIGN_EPI>
__device__ __forceinline__ void gemm_phase(LAS unsigned char* lds, const Gemm g, const Sched& S, const Epi& E) {
    const int tid = threadIdx.x, wid = __builtin_amdgcn_readfirstlane(tid >> 6), lane = tid & 63, wr = wid >> 2, wc = wid & 3, fr = lane & 15, fq = lane >> 4;
    const int K = g.K, nt = K / BK;
    int RA[2]; unsigned CA[2], voffA[2], voffB[2];
#pragma unroll
    for (int i = 0; i < 2; ++i) { int R, C; stage_rc(tid * 16 + i * 8192, R, C); const int Rb = Epi::PERM ? ((R & ~31) + perm32(R & 31)) : R;
        RA[i] = R; CA[i] = (unsigned)C * 2u; voffA[i] = (unsigned)(R * K + C) * 2u; voffB[i] = (unsigned)(Rb * K + C) * 2u; }
    const size_t kstep = (size_t)(BK * 2);
    const size_t hstep = (size_t)HALF * K * 2;
    const size_t tstep = 2 * hstep;
    const unsigned ldsw = (unsigned)wid * 1024u;
    const int aoff = lds_byte(wr * 64 + fr, fq * 8), boff = lds_byte(wc * 32 + fr, fq * 8);
    const char* Abase = (const char*)g.A;
    LAS unsigned* gtb = S.gtab();
#define PG8_SA(b, h) (((b) * 2 + (h)) * HTB)
#define PG8_SB(b, h) ((4 + (b) * 2 + (h)) * HTB)
#define PG8_STAGE(bufoff, gbase, voff) do { _Pragma("unroll") for (int _i = 0; _i < 2; ++_i) \
        __builtin_amdgcn_global_load_lds((const unsigned*)((const char*)(gbase) + (voff)[_i]), (LAS unsigned*)(lds + (bufoff) + ldsw + _i * 8192), 16, 0, 0); } while (0)
#define PG8_STAGEA(bufoff, h, kb, nx) do { \
        if constexpr (Sched::GATHER) { const LAS unsigned* tp_ = gtb + ((nx) ? tnx : tcu) + (h) * HALF; const unsigned o0_ = tp_[RA[0]] + CA[0], o1_ = tp_[RA[1]] + CA[1]; \
            __builtin_amdgcn_global_load_lds((const unsigned*)(Abase + (size_t)(kb) + o0_), (LAS unsigned*)(lds + (bufoff) + ldsw), 16, 0, 0); \
            __builtin_amdgcn_global_load_lds((const unsigned*)(Abase + (size_t)(kb) + o1_), (LAS unsigned*)(lds + (bufoff) + ldsw + 8192), 16, 0, 0); } \
        else { const char* gb_ = ((nx) ? nA : cA) + (size_t)(h) * hstep + (size_t)(kb); PG8_STAGE(bufoff, gb_, voffA); } } while (0)
#define PG8_LDA(dst, b, h) do { _Pragma("unroll") for (int m = 0; m < 4; ++m) _Pragma("unroll") for (int k = 0; k < 2; ++k) dst[m][k] = *(const LAS bf16x8*)(lds + PG8_SA(b, h) + aoff + m * 2048 + k * 1024); } while (0)
#define PG8_LDB(dst, b, h) do { _Pragma("unroll") for (int n = 0; n < 2; ++n) _Pragma("unroll") for (int k = 0; k < 2; ++k) dst[n][k] = *(const LAS bf16x8*)(lds + PG8_SB(b, h) + boff + n * 2048 + k * 1024); } while (0)
#define PG8_MMA(ai, bj, At, Bt) do { __builtin_amdgcn_s_setprio(1); _Pragma("unroll") for (int m = 0; m < 4; ++m) _Pragma("unroll") for (int n = 0; n < 2; ++n) _Pragma("unroll") for (int k = 0; k < 2; ++k) \
        acc[ai][bj][m][n] = __builtin_amdgcn_mfma_f32_16x16x32_bf16(Bt[n][k], At[m][k], acc[ai][bj][m][n], 0, 0, 0); __builtin_amdgcn_s_setprio(0); } while (0)
#define PG8_WAIT_V(n) asm volatile("s_waitcnt vmcnt(" #n ")" ::: "memory")
#define PG8_WAIT_L(n) asm volatile("s_waitcnt lgkmcnt(" #n ")" ::: "memory")
#define PG8_BAR __builtin_amdgcn_s_barrier()
#define PG8_SCHED __builtin_amdgcn_sched_barrier(0)
    Unit cur, nxt; int ui = 0;
    if (!S.next(0, cur)) return;
    f32x4 acc[2][2][4][2];
#pragma unroll
    for (int a = 0; a < 2; ++a)
#pragma unroll
        for (int b = 0; b < 2; ++b)
#pragma unroll
            for (int m = 0; m < 4; ++m)
#pragma unroll
                for (int n = 0; n < 2; ++n) acc[a][b][m][n] = (f32x4){0.f, 0.f, 0.f, 0.f};
    bf16x8 At[4][2], B0[2][2], B1[2][2];
    const char* cA = Abase + (size_t)cur.pm * tstep; const char* cB = (const char*)g.Bt + S.b_off(cur, g.N, K);
    const char* nA = cA; const char* nB = cB;
    int tcu = 0, tnx = 0;
    if constexpr (Sched::GATHER) {
        if (tid < BM) gtb[tid] = S.a_row_off(cur, tid, K);
        asm volatile("s_waitcnt vmcnt(0) lgkmcnt(0)" ::: "memory"); PG8_BAR; asm volatile("" ::: "memory");
    }
    PG8_STAGE(PG8_SB(0, 0), cB, voffB); PG8_STAGE(PG8_SB(0, 1), cB + hstep, voffB); PG8_STAGEA(PG8_SA(0, 0), 0, 0, false); PG8_STAGEA(PG8_SA(0, 1), 1, 0, false);
    if (wr == 1) PG8_BAR;
    PG8_WAIT_V(2); PG8_BAR;
    PG8_STAGE(PG8_SB(1, 0), cB + kstep, voffB); PG8_STAGEA(PG8_SA(1, 0), 0, kstep, false); PG8_STAGE(PG8_SB(1, 1), cB + hstep + kstep, voffB);
    PG8_WAIT_V(6); PG8_BAR;
    for (;;) {
        const bool has_next = S.next(ui + 1, nxt);
        nA = cA; nB = cB; tnx = tcu;
        if (has_next) { nA = Abase + (size_t)nxt.pm * tstep; nB = (const char*)g.Bt + S.b_off(nxt, g.N, K);
            if constexpr (Sched::GATHER) { tnx = tcu ^ BM; if (tid < BM) gtb[tnx + tid] = S.a_row_off(nxt, tid, K); } }
#pragma unroll 1
        for (int t = 0; t < nt; t += 2) {
            const bool last = (t == nt - 2);
            const size_t k1 = (size_t)(t + 1) * kstep;
            const size_t k2 = last ? 0 : (size_t)(t + 2) * kstep, k3 = k2 + kstep;
            const char* b2 = last ? nB : cB + (size_t)(t + 2) * kstep; const char* b3 = b2 + kstep;
            PG8_LDB(B0, 0, 0); PG8_LDB(B1, 0, 1); PG8_SCHED; PG8_LDA(At, 0, 0); PG8_STAGEA(PG8_SA(1, 1), 1, k1, false);
            PG8_WAIT_V(8); PG8_WAIT_L(0); PG8_BAR; PG8_MMA(0, 0, At, B0); PG8_MMA(0, 1, At, B1); PG8_BAR; PG8_SCHED;
            PG8_LDA(At, 0, 1); PG8_STAGE(PG8_SB(0, 0), b2, voffB); PG8_STAGE(PG8_SB(0, 1), b2 + hstep, voffB); PG8_STAGEA(PG8_SA(0, 0), 0, k2, last);
            PG8_WAIT_V(8); PG8_WAIT_L(0); PG8_BAR; PG8_MMA(1, 0, At, B0); PG8_MMA(1, 1, At, B1); PG8_BAR; PG8_SCHED;
            PG8_LDB(B0, 1, 0); PG8_LDB(B1, 1, 1); PG8_SCHED; PG8_LDA(At, 1, 0); PG8_STAGEA(PG8_SA(0, 1), 1, k2, last);
            PG8_WAIT_V(8); PG8_WAIT_L(0); PG8_BAR; PG8_MMA(0, 0, At, B0); PG8_MMA(0, 1, At, B1); PG8_BAR; PG8_SCHED;
            PG8_LDA(At, 1, 1); PG8_STAGE(PG8_SB(1, 0), b3, voffB); PG8_STAGE(PG8_SB(1, 1), b3 + hstep, voffB); PG8_STAGEA(PG8_SA(1, 0), 0, k3, last);
            PG8_WAIT_V(8); PG8_WAIT_L(0); PG8_BAR; PG8_MMA(1, 0, At, B0); PG8_MMA(1, 1, At, B1); PG8_BAR; PG8_SCHED;
        }
        if constexpr (ALIGN_EPI) { if (wr == 0) PG8_BAR; }
        E(acc, cur, wr, wc, fr, fq);
        if (!has_next) break;
#pragma unroll
        for (int a = 0; a < 2; ++a)
#pragma unroll
            for (int b = 0; b < 2; ++b)
#pragma unroll
                for (int m = 0; m < 4; ++m)
#pragma unroll
                    for (int n = 0; n < 2; ++n) acc[a][b][m][n] = (f32x4){0.f, 0.f, 0.f, 0.f};
        cur = nxt; cA = nA; cB = nB; tcu = tnx; ++ui;
        if constexpr (ALIGN_EPI) { if (wr == 1) PG8_BAR; }
    }
    PG8_WAIT_V(0);
    if constexpr (!ALIGN_EPI) { if (wr == 0) PG8_BAR; }
    PG8_BAR;
#undef PG8_SA
#undef PG8_SB
#undef PG8_STAGE
#undef PG8_STAGEA
#undef PG8_LDA
#undef PG8_LDB
#undef PG8_MMA
#undef PG8_WAIT_V
#undef PG8_WAIT_L
#undef PG8_BAR
#undef PG8_SCHED
}

struct EpiBf16Plain {
    static constexpr bool PERM = true;
    bf16* O; int ldc;
    __device__ __forceinline__ void operator()(const f32x4 (&acc)[2][2][4][2], const Unit& u, int wr, int wc, int fr, int fq) const {
        const int row0 = u.pm * BM + wr * 64 + fr, col0 = u.pn * BM + wc * 32 + 8 * fq;
#pragma unroll
        for (int ai = 0; ai < 2; ++ai)
#pragma unroll
            for (int m = 0; m < 4; ++m) { bf16* rowp = O + (size_t)(row0 + ai * HALF + m * 16) * ldc + col0;
#pragma unroll
                for (int bj = 0; bj < 2; ++bj) { const f32x4 v0 = acc[ai][bj][m][0], v1 = acc[ai][bj][m][1];
                    u32x4 w; w.x = cvt_pk_bf16(v0[0], v0[1]); w.y = cvt_pk_bf16(v0[2], v0[3]); w.z = cvt_pk_bf16(v1[0], v1[1]); w.w = cvt_pk_bf16(v1[2], v1[3]);
                    *(u32x4*)(rowp + bj * HALF) = w; } }
    }
};
struct EpiMlaUp {
    static constexpr bool PERM = true;
    bf16* Q; bf16* KK; bf16* V; const float* cs;
    __device__ __forceinline__ void operator()(const f32x4 (&acc)[2][2][4][2], const Unit& u, int wr, int wc, int fr, int fq) const {
        const int row0 = u.pm * BM + wr * 64 + fr;
#pragma unroll
        for (int bj = 0; bj < 2; ++bj) {
            const int c0 = u.pn * BM + bj * HALF + wc * 32 + 8 * fq;
            if (u.pn < 3) {
                const int h = c0 / QKD, d = c0 - h * QKD;
                const bool rope = d >= NOPE; const int i0 = rope ? (d - NOPE) >> 1 : 0;
#pragma unroll
                for (int ai = 0; ai < 2; ++ai)
#pragma unroll
                    for (int m = 0; m < 4; ++m) { const int row = row0 + ai * HALF + m * 16;
                        f32x4 v0 = acc[ai][bj][m][0], v1 = acc[ai][bj][m][1];
                        if (rope) { const f32x4 cA = *(const f32x4*)(cs + (size_t)row * 32 + i0 * 2), cB = *(const f32x4*)(cs + (size_t)row * 32 + i0 * 2 + 4);
                            const f32x4 a = v0, b = v1;
                            v0[0] = a[0] * cA[0] - a[1] * cA[1]; v0[1] = a[0] * cA[1] + a[1] * cA[0]; v0[2] = a[2] * cA[2] - a[3] * cA[3]; v0[3] = a[2] * cA[3] + a[3] * cA[2];
                            v1[0] = b[0] * cB[0] - b[1] * cB[1]; v1[1] = b[0] * cB[1] + b[1] * cB[0]; v1[2] = b[2] * cB[2] - b[3] * cB[3]; v1[3] = b[2] * cB[3] + b[3] * cB[2]; }
                        v0 = v0 * C2Q; v1 = v1 * C2Q;
                        u32x4 w; w.x = cvt_pk_bf16(v0[0], v0[1]); w.y = cvt_pk_bf16(v0[2], v0[3]); w.z = cvt_pk_bf16(v1[0], v1[1]); w.w = cvt_pk_bf16(v1[2], v1[3]);
                        *(u32x4*)(Q + (size_t)row * 768 + c0) = w; asm volatile("" ::: "memory"); }
            } else {
                bf16* base; int ld, cc;
                if (u.pn < 5) { const int c1 = c0 - 768; const int h = c1 >> 6, d = c1 & 63; base = KK; ld = 768; cc = h * QKD + d; }
                else { base = V; ld = 512; cc = c0 - 1280; }
#pragma unroll
                for (int ai = 0; ai < 2; ++ai)
#pragma unroll
                    for (int m = 0; m < 4; ++m) { const int row = row0 + ai * HALF + m * 16; const f32x4 v0 = acc[ai][bj][m][0], v1 = acc[ai][bj][m][1];
                        u32x4 w; w.x = cvt_pk_bf16(v0[0], v0[1]); w.y = cvt_pk_bf16(v0[2], v0[3]); w.z = cvt_pk_bf16(v1[0], v1[1]); w.w = cvt_pk_bf16(v1[2], v1[3]);
                        *(u32x4*)(base + (size_t)row * ld + cc) = w; asm volatile("" ::: "memory"); }
            }
        }
    }
};
struct EpiRwkvSmall {
    static constexpr bool PERM = false;
    float* O; const float* w0; const float* a0;
    __device__ __forceinline__ void operator()(const f32x4 (&acc)[2][2][4][2], const Unit& u, int wr, int wc, int fr, int fq) const {
        const int row0 = u.pm * BM + wr * 64 + fr, col0 = u.pn * BM + wc * 32 + 4 * fq;
        const int kind = u.pn >> 1;
#pragma unroll
        for (int bj = 0; bj < 2; ++bj)
#pragma unroll
            for (int n = 0; n < 2; ++n) { const int c = col0 + bj * HALF + n * 16;
                f32x4 bv = (f32x4){0.f, 0.f, 0.f, 0.f};
                if (kind == 0) bv = *(const f32x4*)(w0 + c); else if (kind == 1) bv = *(const f32x4*)(a0 + (c - 512));
#pragma unroll
                for (int ai = 0; ai < 2; ++ai)
#pragma unroll
                    for (int m = 0; m < 4; ++m) { f32x4 v = acc[ai][bj][m][n] + bv;
                        if (kind == 0) {
#pragma unroll
                            for (int j = 0; j < 4; ++j) { const float z = -v[j]; const float sp = fmaxf(z, 0.f) + __logf(1.0f + __expf(-fabsf(z))); const float w = -sp - 0.5f; v[j] = -__expf(w); }
                        } else if (kind == 1) {
#pragma unroll
                            for (int j = 0; j < 4; ++j) v[j] = sigmoidf_(v[j]);
                        }
                        *(f32x4*)(O + (size_t)(row0 + ai * HALF + m * 16) * N_SM + c) = v; asm volatile("" ::: "memory"); } }
    }
};
struct EpiVres {
    static constexpr bool PERM = true;
    const bf16* vs; const bf16* vf; bf16* vr; const float* v0;
    __device__ __forceinline__ void operator()(const f32x4 (&acc)[2][2][4][2], const Unit& u, int wr, int wc, int fr, int fq) const {
        const int row0 = u.pm * BM + wr * 64 + fr, col0 = u.pn * BM + wc * 32 + 8 * fq;
#pragma unroll
        for (int bj = 0; bj < 2; ++bj) { const int c = col0 + bj * HALF;
            const f32x4 b0 = *(const f32x4*)(v0 + c), b1 = *(const f32x4*)(v0 + c + 4);
#pragma unroll
            for (int ai = 0; ai < 2; ++ai)
#pragma unroll
                for (int m = 0; m < 4; ++m) { const size_t off = (size_t)(row0 + ai * HALF + m * 16) * C5 + c;
                    const u32x4 s = *(const u32x4*)(vs + off), f = *(const u32x4*)(vf + off);
                    const f32x4 g0 = acc[ai][bj][m][0] + b0, g1 = acc[ai][bj][m][1] + b1;
                    float o[8];
#pragma unroll
                    for (int j = 0; j < 4; ++j) { const float sl = bflo(s[j]), sh = bfhi(s[j]), fl = bflo(f[j]), fh = bfhi(f[j]);
                        const float ga = (j < 2) ? g0[2 * j] : g1[2 * j - 4], gb = (j < 2) ? g0[2 * j + 1] : g1[2 * j - 3];
                        o[2 * j] = sl + (fl - sl) * sigmoidf_(ga); o[2 * j + 1] = sh + (fh - sh) * sigmoidf_(gb); }
                    u32x4 w; w.x = cvt_pk_bf16(o[0], o[1]); w.y = cvt_pk_bf16(o[2], o[3]); w.z = cvt_pk_bf16(o[4], o[5]); w.w = cvt_pk_bf16(o[6], o[7]);
                    *(u32x4*)(vr + off) = w; } }
    }
};
struct EpiWo {
    static constexpr bool PERM = true;
    bf16* X; const float* gt;
    __device__ __forceinline__ void operator()(const f32x4 (&acc)[2][2][4][2], const Unit& u, int wr, int wc, int fr, int fq) const {
        const int row0 = u.pm * BM + wr * 64 + fr, col0 = u.pn * BM + wc * 32 + 8 * fq;
        const int b = (u.pm * BM) / SEQ;
#pragma unroll
        for (int bj = 0; bj < 2; ++bj) { const int c = col0 + bj * HALF;
            const f32x4 g0 = *(const f32x4*)(gt + (size_t)b * 6144 + c) + 1.0f, g1 = *(const f32x4*)(gt + (size_t)b * 6144 + c + 4) + 1.0f;
#pragma unroll
            for (int ai = 0; ai < 2; ++ai)
#pragma unroll
                for (int m = 0; m < 4; ++m) { bf16* px = X + (size_t)(row0 + ai * HALF + m * 16) * D + c; const u32x4 xw = *(const u32x4*)px;
                    const f32x4 a0 = acc[ai][bj][m][0], a1 = acc[ai][bj][m][1];
                    u32x4 w; w.x = cvt_pk_bf16(bflo(xw.x) * DN_ALPHA + g0[0] * a0[0], bfhi(xw.x) * DN_ALPHA + g0[1] * a0[1]); w.y = cvt_pk_bf16(bflo(xw.y) * DN_ALPHA + g0[2] * a0[2], bfhi(xw.y) * DN_ALPHA + g0[3] * a0[3]);
                    w.z = cvt_pk_bf16(bflo(xw.z) * DN_ALPHA + g1[0] * a1[0], bfhi(xw.z) * DN_ALPHA + g1[1] * a1[1]); w.w = cvt_pk_bf16(bflo(xw.w) * DN_ALPHA + g1[2] * a1[2], bfhi(xw.w) * DN_ALPHA + g1[3] * a1[3]);
                    *(u32x4*)px = w; } }
    }
};
struct EpiSwiglu {
    static constexpr bool PERM = true;
    bf16* O; const float* b1p;
    __device__ __forceinline__ void operator()(const f32x4 (&acc)[2][2][4][2], const Unit& u, int wr, int wc, int fr, int fq) const {
        const int row0 = u.pm * BM + wr * 64 + fr; const int cin = u.pn * BM + wc * 32 + 8 * fq, cout = u.pn * HALF + wc * 32 + 8 * fq;
        const float* bp = b1p + (size_t)u.e * 2048 + cin;
        const f32x4 bg0 = *(const f32x4*)(bp), bg1 = *(const f32x4*)(bp + 4), bl0 = *(const f32x4*)(bp + HALF), bl1 = *(const f32x4*)(bp + HALF + 4);
#pragma unroll
        for (int ai = 0; ai < 2; ++ai)
#pragma unroll
            for (int m = 0; m < 4; ++m) {
                const f32x4 g0 = acc[ai][0][m][0] + bg0, g1 = acc[ai][0][m][1] + bg1, l0 = acc[ai][1][m][0] + bl0, l1 = acc[ai][1][m][1] + bl1;
                float o[8];
#pragma unroll
                for (int j = 0; j < 8; ++j) { const float gv = fminf(j < 4 ? g0[j & 3] : g1[j & 3], 7.0f); const float lv = fminf(fmaxf(j < 4 ? l0[j & 3] : l1[j & 3], -7.0f), 7.0f);
                    o[j] = gv * sigmoidf_(1.702f * gv) * (lv + 1.0f); }
                u32x4 w; w.x = cvt_pk_bf16(o[0], o[1]); w.y = cvt_pk_bf16(o[2], o[3]); w.z = cvt_pk_bf16(o[4], o[5]); w.w = cvt_pk_bf16(o[6], o[7]);
                *(u32x4*)(O + (size_t)(row0 + ai * HALF + m * 16) * FF + cout) = w; }
    }
};
struct EpiMoeOut {
    static constexpr bool PERM = true;
    bf16* O; const float* b2; const float* gatel; const LAS int* tb;
    __device__ __forceinline__ void operator()(const f32x4 (&acc)[2][2][4][2], const Unit& u, int wr, int wc, int fr, int fq) const {
        const int row0 = u.pm * BM + wr * 64 + fr, col0 = u.pn * BM + wc * 32 + 8 * fq;
        const int pos0 = (u.pm - tb[u.e]) * BM + wr * 64 + fr;
        const float* bp = b2 + (size_t)u.e * D + col0;
        f32x4 bv[2][2];
#pragma unroll
        for (int bj = 0; bj < 2; ++bj) { bv[bj][0] = *(const f32x4*)(bp + bj * HALF); bv[bj][1] = *(const f32x4*)(bp + bj * HALF + 4); }
#pragma unroll
        for (int ai = 0; ai < 2; ++ai)
#pragma unroll
            for (int m = 0; m < 4; ++m) { const float gt = gatel[(size_t)u.e * CAP + pos0 + ai * HALF + m * 16];
                bf16* rowp = O + (size_t)(row0 + ai * HALF + m * 16) * D + col0;
#pragma unroll
                for (int bj = 0; bj < 2; ++bj) { const f32x4 v0 = (acc[ai][bj][m][0] + bv[bj][0]) * gt, v1 = (acc[ai][bj][m][1] + bv[bj][1]) * gt;
                    u32x4 w; w.x = cvt_pk_bf16(v0[0], v0[1]); w.y = cvt_pk_bf16(v0[2], v0[3]); w.z = cvt_pk_bf16(v1[0], v1[1]); w.w = cvt_pk_bf16(v1[2], v1[3]);
                    *(u32x4*)(rowp + bj * HALF) = w; } }
    }
};
}

struct Params { const void* in[N_INPUTS]; float* out; unsigned char* ws; int ph_lo, ph_hi; };

struct Frame {
    LAS unsigned char* lds;
    int tid, lane, wave, G, vcu;
    unsigned char* ws;
};
#define WSP(type, off) ((type*)(F.ws + (off)))
#define INP(i) ((const float*)p.in[i])

__device__ const double INV_FREQ[16] = {1.00000000000000000e+00, 5.62341325190349073e-01, 3.16227766016837941e-01, 1.77827941003892293e-01, 1.00000000000000006e-01, 5.62341325190349114e-02,
    3.16227766016837913e-02, 1.77827941003892293e-02, 1.00000000000000002e-02, 5.62341325190349097e-03, 3.16227766016837939e-03, 1.77827941003892275e-03, 1.00000000000000002e-03,
    5.62341325190349097e-04, 3.16227766016837939e-04, 1.77827941003892270e-04};

template <int MODE>
__device__ __forceinline__ void tr_item(const float* W, int ldn, bf16* WT, int ldk, int kofs, int rofs, int k0, int n0, LAS float* scr, int lane) {
    f32x4 ld[8];
#pragma unroll
    for (int i = 0; i < 8; ++i) ld[i] = *(const f32x4*)(W + (size_t)(k0 + 8 * i + (lane >> 3)) * ldn + n0 + 4 * (lane & 7));
#pragma unroll
    for (int i = 0; i < 8; ++i) { LAS float* d = scr + (8 * i + (lane >> 3)) * 33 + 4 * (lane & 7); d[0] = ld[i].x; d[1] = ld[i].y; d[2] = ld[i].z; d[3] = ld[i].w; }
    LDS_WAIT(); asm volatile("" ::: "memory");
    const int c = lane & 7;
#pragma unroll
    for (int j = 0; j < 4; ++j) { const int n = (lane >> 3) + 8 * j; const LAS float* s = scr + (8 * c) * 33 + n;
        u32x4 o; o.x = pk2(s[0 * 33], s[1 * 33]); o.y = pk2(s[2 * 33], s[3 * 33]); o.z = pk2(s[4 * 33], s[5 * 33]); o.w = pk2(s[6 * 33], s[7 * 33]);
        const int ng = n0 + n; int row;
        if (MODE == 0) row = rofs + ng; else { const int jo = ng >> 1, bj = ng & 1; row = rofs + (jo >> 7) * 256 + bj * 128 + (jo & 127); }
        *(GAS u32x4*)(WT + (size_t)row * ldk + kofs + k0 + 8 * c) = o; }
    LDS_WAIT(); asm volatile("" ::: "memory");
}
__device__ __forceinline__ void zero_rect(const Frame& F, bf16* M, int ld, int r0, int nrows, int c0, int ncols) {
    const int gw = F.vcu * NWAVES + F.wave, NGW = F.G * NWAVES; const int nch = ncols / 8;
    for (int r = gw; r < nrows; r += NGW)
        for (int ch = F.lane; ch < nch; ch += 64) *(GAS u32x4*)(M + (size_t)(r0 + r) * ld + c0 + ch * 8) = (u32x4){0u, 0u, 0u, 0u};
}
__device__ __forceinline__ void phase_prologue(const Params& p, const Frame& F) {
    LAS float* scr = (LAS float*)(F.lds + F.wave * 16384);
    const int gw = F.vcu * NWAVES + F.wave, NGW = F.G * NWAVES;
    constexpr int I_IN = 16 * 69, I_UQ = 4 * 24, I_UK = 2 * 16, I_W2s = 16, I_G2s = 2 * 16, I_WO_ = 16 * 32, I_E1 = 16 * 64, I_E2 = 16 * 32;
    constexpr int PER_L = I_IN + I_UQ + 2 * I_UK + 2 * I_W2s + I_G2s + I_WO_;
    constexpr int NSMALL = DEPTH * PER_L;
    for (int it = gw; it < NSMALL; it += NGW) {
        int r = it;
        {
            const int l = r / PER_L; r -= l * PER_L;
            if (r < I_IN) { tr_item<0>(INP(I_WIN) + (size_t)l * D * N_IN, N_IN, WSP(bf16, WS_WINT) + (size_t)l * N_INP * D, D, 0, 0, 64 * (r / 69), 32 * (r % 69), scr, F.lane); continue; } r -= I_IN;
            bf16* up = WSP(bf16, WS_WUPT) + (size_t)l * N_UP * K_UP;
            if (r < I_UQ) { tr_item<0>(INP(I_WUQ) + (size_t)l * QLR * 768, 768, up, K_UP, 0, 0, 64 * (r / 24), 32 * (r % 24), scr, F.lane); continue; } r -= I_UQ;
            if (r < I_UK) { tr_item<0>(INP(I_WUK) + (size_t)l * KVLR * 512, 512, up, K_UP, 256, 768, 64 * (r / 16), 32 * (r % 16), scr, F.lane); continue; } r -= I_UK;
            if (r < I_UK) { tr_item<0>(INP(I_WUV) + (size_t)l * KVLR * 512, 512, up, K_UP, 256, 1280, 64 * (r / 16), 32 * (r % 16), scr, F.lane); continue; } r -= I_UK;
            bf16* sm = WSP(bf16, WS_WSMT) + (size_t)l * N_SM * K_SM;
            if (r < I_W2s) { tr_item<0>(INP(I_W2) + (size_t)l * 64 * 512, 512, sm, K_SM, 0, 0, 0, 32 * r, scr, F.lane); continue; } r -= I_W2s;
            if (r < I_W2s) { tr_item<0>(INP(I_A2) + (size_t)l * 64 * 512, 512, sm, K_SM, 64, 512, 0, 32 * r, scr, F.lane); continue; } r -= I_W2s;
            if (r < I_G2s) { tr_item<0>(INP(I_G2) + (size_t)l * 128 * 512, 512, sm, K_SM, 128, 1024, 64 * (r / 16), 32 * (r % 16), scr, F.lane); continue; } r -= I_G2s;
            tr_item<0>(INP(I_WO) + (size_t)l * D * D, D, WSP(bf16, WS_WOT) + (size_t)l * D * D, D, 0, 0, 64 * (r / 32), 32 * (r % 32), scr, F.lane); continue;
        }
    }
    for (int l = 0; l < DEPTH; ++l) {
        zero_rect(F, WSP(bf16, WS_WINT) + (size_t)l * N_INP * D, D, N_IN, N_INP - N_IN, 0, D);
        bf16* up = WSP(bf16, WS_WUPT) + (size_t)l * N_UP * K_UP;
        zero_rect(F, up, K_UP, 0, 768, 256, 128); zero_rect(F, up, K_UP, 768, 1024, 0, 256);
        bf16* sm = WSP(bf16, WS_WSMT) + (size_t)l * N_SM * K_SM;
        zero_rect(F, sm, K_SM, 0, 512, 64, 192); zero_rect(F, sm, K_SM, 512, 512, 0, 64); zero_rect(F, sm, K_SM, 512, 512, 128, 128); zero_rect(F, sm, K_SM, 1024, 512, 0, 128);
    }
    const int gt = (F.vcu * NTHREADS) + F.tid, NGT = F.G * NTHREADS;
    { const float* v1 = INP(I_V1); const float* v2 = INP(I_V2); bf16* o = WSP(bf16, WS_WV12T);
      for (int i = gt; i < 512 * 512; i += NGT) { const int n = i >> 9, k = i & 511; float s = 0.f;
#pragma unroll 8
          for (int j = 0; j < 32; ++j) s += v1[k * 32 + j] * v2[j * 512 + n];
          o[i] = (bf16)f2bf(s); } }
    { const float* b1 = INP(I_EB1); float* o = WSP(float, WS_B1P);
      for (int i = gt; i < DEPTH * NE * 2048; i += NGT) { const int q = i & 2047, le = i >> 11; const int pn = q >> 8, bj = (q >> 7) & 1, jj = q & 127; o[i] = b1[(size_t)le * 2048 + 2 * (pn * 128 + jj) + bj]; } }
    { const float* rw = INP(I_RW); bf16* o = WSP(bf16, WS_RWT);
      for (int i = gt; i < DEPTH * NE * D; i += NGT) { const int k = i & 1023, e = (i >> 10) & 31, l2 = i >> 15; const float v = rw[((size_t)l2 * D + k) * NE + e]; const unsigned hi = f2bf(v); const float lo = v - bf2f(hi);
          o[i] = (bf16)hi; o[DEPTH * NE * D + i] = (bf16)f2bf(lo); } }
    { const int* pos = (const int*)p.in[I_POS]; float* cs = WSP(float, WS_CS);
      for (int i = gt; i < T * 16; i += NGT) { const int t = i >> 4, k = i & 15; const double a = (double)pos[t] * INV_FREQ[k];
          const double q = __builtin_rint(a * 0.63661977236758134308); const int qi = (int)((long long)q & 3);
          double r = __builtin_fma(-q, 1.57079632679489655800e+00, a); r = __builtin_fma(-q, 6.12323399573676603587e-17, r);
          const double r2 = r * r;
          double sn = -2.50521083854417187751e-08; sn = sn * r2 + 2.75573192239858906526e-06; sn = sn * r2 - 1.98412698412698412698e-04; sn = sn * r2 + 8.33333333333333333333e-03; sn = sn * r2 - 1.66666666666666666667e-01; sn = r + r * r2 * sn;
          double cn = 2.08767569878680989792e-09; cn = cn * r2 - 2.75573192239858906526e-07; cn = cn * r2 + 2.48015873015873015873e-05; cn = cn * r2 - 1.38888888888888888889e-03; cn = cn * r2 + 4.16666666666666666667e-02; cn = cn * r2 - 0.5; cn = 1.0 + r2 * cn;
          double sv, cv;
          if (qi == 0) { sv = sn; cv = cn; } else if (qi == 1) { sv = cn; cv = -sn; } else if (qi == 2) { sv = -sn; cv = -cn; } else { sv = -cn; cv = sn; }
          cs[2 * i] = (float)cv; cs[2 * i + 1] = (float)sv; } }
    { LAS float* cact = (LAS float*)(F.lds);
      LAS float* part = (LAS float*)(F.lds + 32768);
      __syncthreads();
      const float* c = INP(I_C);
      for (int i = F.tid; i < NBATCH * D; i += NTHREADS) { const float v = c[i]; cact[i] = v / (1.0f + __expf(-v)); }
      __syncthreads();
      for (int item = F.vcu; item < DEPTH * 96; item += F.G) { const int l = item / 96, n0 = (item % 96) * 64;
          const float* aw = INP(I_ADAW) + (size_t)l * D * 6144 + n0 + F.lane;
          float a8[8];
#pragma unroll
          for (int b = 0; b < 8; ++b) a8[b] = 0.f;
          const int kb = F.wave * 128;
#pragma unroll 4
          for (int k = 0; k < 128; ++k) { const float wv = aw[(size_t)(kb + k) * 6144];
#pragma unroll
              for (int b = 0; b < 8; ++b) a8[b] += cact[b * D + kb + k] * wv; }
#pragma unroll
          for (int b = 0; b < 8; ++b) part[(F.wave * 8 + b) * 64 + F.lane] = a8[b];
          __syncthreads();
          { const int b = F.wave; float s = 0.f;
#pragma unroll
            for (int w = 0; w < 8; ++w) s += part[(w * 8 + b) * 64 + F.lane];
            WSP(float, WS_MOD)[((size_t)l * NBATCH + b) * 6144 + n0 + F.lane] = s + INP(I_ADAB)[(size_t)l * 6144 + n0 + F.lane]; }
          __syncthreads(); }
    }
}

__device__ __forceinline__ void phase_convert_experts(const Params& p, const Frame& F, int c0, int nc) {
    LAS float* scr = (LAS float*)(F.lds + F.wave * 16384);
    constexpr int I_E1 = 16 * 64, I_E2 = 16 * 32, NE1 = DEPTH * NE * I_E1, NE2 = DEPTH * NE * I_E2;
    const int gw = (F.vcu - c0) * NWAVES + F.wave, NGW = nc * NWAVES; const int lane = F.lane;
    __syncthreads();
    f32x4 ld[8];
#define CV_SRC(it, W_, ldn_, k0_, n0_) do { int r_ = (it); if (r_ < NE1) { const int le_ = r_ / I_E1; r_ -= le_ * I_E1; W_ = INP(I_EW1) + (size_t)le_ * D * 2048; ldn_ = 2048; k0_ = 64 * (r_ / 64); n0_ = 32 * (r_ % 64); } \
        else { r_ -= NE1; const int le_ = r_ / I_E2; r_ -= le_ * I_E2; W_ = INP(I_EW2) + (size_t)le_ * FF * D; ldn_ = D; k0_ = 64 * (r_ / 32); n0_ = 32 * (r_ % 32); } } while (0)
#define CV_LOAD(it) do { const float* W_; int ldn_, k0_, n0_; CV_SRC(it, W_, ldn_, k0_, n0_); \
        _Pragma("unroll") for (int i = 0; i < 8; ++i) ld[i] = *(const f32x4*)(W_ + (size_t)(k0_ + 8 * i + (lane >> 3)) * ldn_ + n0_ + 4 * (lane & 7)); } while (0)
    int it = gw;
    if (it < NE1 + NE2) CV_LOAD(it);
    for (; it < NE1 + NE2; it += NGW) {
#pragma unroll
        for (int i = 0; i < 8; ++i) { LAS float* d = scr + (8 * i + (lane >> 3)) * 33 + 4 * (lane & 7); d[0] = ld[i].x; d[1] = ld[i].y; d[2] = ld[i].z; d[3] = ld[i].w; }
        if (it + NGW < NE1 + NE2) CV_LOAD(it + NGW);
        LDS_WAIT(); asm volatile("" ::: "memory");
        int r = it; bf16* WT; int ldk, k0, n0; bool perm;
        if (r < NE1) { const int le = r / I_E1; r -= le * I_E1; WT = WSP(bf16, WS_W1T) + (size_t)le * 2048 * D; ldk = D; k0 = 64 * (r / 64); n0 = 32 * (r % 64); perm = true; }
        else { r -= NE1; const int le = r / I_E2; r -= le * I_E2; WT = WSP(bf16, WS_W2T) + (size_t)le * D * FF; ldk = FF; k0 = 64 * (r / 32); n0 = 32 * (r % 32); perm = false; }
        const int c = lane & 7;
#pragma unroll
        for (int j = 0; j < 4; ++j) { const int n = (lane >> 3) + 8 * j; const LAS float* sp = scr + (8 * c) * 33 + n;
            u32x4 o; o.x = pk2(sp[0 * 33], sp[1 * 33]); o.y = pk2(sp[2 * 33], sp[3 * 33]); o.z = pk2(sp[4 * 33], sp[5 * 33]); o.w = pk2(sp[6 * 33], sp[7 * 33]);
            const int ng = n0 + n; int row = ng;
            if (perm) { const int jo = ng >> 1, bj = ng & 1; row = (jo >> 7) * 256 + bj * 128 + (jo & 127); }
            *(GAS u32x4*)(WT + (size_t)row * ldk + k0 + 8 * c) = o; }
        LDS_WAIT(); asm volatile("" ::: "memory");
    }
#undef CV_LOAD
#undef CV_SRC
    __syncthreads();
}

__device__ __forceinline__ void phase_ln0(const Params& p, const Frame& F) {
    const int gw = F.vcu * NWAVES + F.wave, NGW = F.G * NWAVES;
    const float* mod = WSP(float, WS_MOD);
#pragma unroll 2
    for (int m = gw; m < T; m += NGW) {
        const int b = m / SEQ;
        const GAS f32x4* xr = (const GAS f32x4*)(INP(I_X) + (size_t)m * D) + F.lane;
        f32x4 v[4]; float s = 0.f;
#pragma unroll
        for (int j = 0; j < 4; ++j) { v[j] = xr[64 * j]; s += (v[j].x + v[j].y) + (v[j].z + v[j].w); }
        const float mean = wave_sum(s) * (1.f / D); float s2 = 0.f;
#pragma unroll
        for (int j = 0; j < 4; ++j) { v[j] = v[j] - mean; s2 += (v[j].x * v[j].x + v[j].y * v[j].y) + (v[j].z * v[j].z + v[j].w * v[j].w); }
        const float rstd = 1.f / sqrtf(wave_sum(s2) * (1.f / D) + LN_EPS);
        GAS u32x2* xo = (GAS u32x2*)(WSP(bf16, WS_X) + (size_t)m * D) + F.lane;
        GAS u32x2* ho = (GAS u32x2*)(WSP(bf16, WS_H) + (size_t)m * D) + F.lane;
#pragma unroll
        for (int j = 0; j < 4; ++j) { const int c = 4 * F.lane + 256 * j;
            const f32x4 g = *(const f32x4*)(INP(I_ELNG) + c), be = *(const f32x4*)(INP(I_ELNB) + c);
            const f32x4 x0 = v[j] * rstd * g + be; { u32x2 xw; xw.x = pk2(x0.x, x0.y); xw.y = pk2(x0.z, x0.w); xo[64 * j] = xw; }
            const f32x4 sh = *(const f32x4*)(mod + (size_t)b * 6144 + c), sc = *(const f32x4*)(mod + (size_t)b * 6144 + 1024 + c);
            const f32x4 h = x0 * (sc + 1.0f) + sh; u32x2 w; w.x = pk2(h.x, h.y); w.y = pk2(h.z, h.w); ho[64 * j] = w; }
    }
}

__device__ __forceinline__ void phase_prep(const Params& p, const Frame& F, int l) {
    const int gw = F.vcu * NWAVES + F.wave, NGW = F.G * NWAVES; const int lane = F.lane;
    const bf16* P = WSP(bf16, WS_P); const float* mu = INP(I_MU) + (size_t)l * RWKV_IN;
    const float* qg = INP(I_QNG) + (size_t)l * QLR; const float* kvg = INP(I_KVNG) + (size_t)l * KVLR;
    bf16* AN = WSP(bf16, WS_AN); bf16* A2 = WSP(bf16, WS_A2); bf16* RK = WSP(bf16, WS_RK); bf16* KKb = WSP(bf16, WS_KK);
    bf16* VS = l == 0 ? WSP(bf16, WS_VS0) : WSP(bf16, WS_VS1);
    const float* cs = WSP(float, WS_CS);
    const int RPW = (T + NGW - 1) / NGW; const int t0 = gw * RPW; const int t1 = (t0 + RPW < T) ? t0 + RPW : T;
    f32x4 mu0[3], mu1[3];
#pragma unroll
    for (int part = 0; part < 3; ++part) { mu0[part] = *(const f32x4*)(mu + part * 512 + 8 * lane); mu1[part] = *(const f32x4*)(mu + part * 512 + 8 * lane + 4); }
    const float mu_wd = mu[1536 + lane], mu_ad = mu[1600 + lane]; const f32x2 mu_gd = *(const f32x2*)(mu + 1664 + 2 * lane);
    const f32x4 gq = *(const f32x4*)(qg + 4 * lane); const f32x2 gkv = *(const f32x2*)(kvg + 2 * lane);
    u32x4 pw[3]; pw[0] = pw[1] = pw[2] = (u32x4){0u, 0u, 0u, 0u}; float p_wd = 0.f, p_ad = 0.f; unsigned p_gd = 0u;
    if (t0 < t1 && (t0 % SEQ) != 0) { const bf16* rp = P + (size_t)(t0 - 1) * N_INP + MLA_IN;
#pragma unroll
        for (int part = 0; part < 3; ++part) pw[part] = *(const u32x4*)(rp + part * 512 + 8 * lane);
        p_wd = bf2f(rp[1536 + lane]); p_ad = bf2f(rp[1600 + lane]); p_gd = *(const unsigned*)(rp + 1664 + 2 * lane); }
#pragma unroll 2
    for (int t = t0; t < t1; ++t) {
        const bf16* pr = P + (size_t)t * N_INP;
        if ((t % SEQ) == 0) { pw[0] = pw[1] = pw[2] = (u32x4){0u, 0u, 0u, 0u}; p_wd = 0.f; p_ad = 0.f; p_gd = 0u; }
        { const u32x2 qw = *(const u32x2*)(pr + 4 * lane); float q0 = bflo(qw.x), q1 = bfhi(qw.x), q2 = bflo(qw.y), q3 = bfhi(qw.y);
          const float rq = __builtin_amdgcn_rsqf(wave_sum(q0 * q0 + q1 * q1 + q2 * q2 + q3 * q3) * (1.f / QLR) + RMS_EPS);
          u32x2 w; w.x = pk2(q0 * rq * gq.x, q1 * rq * gq.y); w.y = pk2(q2 * rq * gq.z, q3 * rq * gq.w); *(u32x2*)(AN + (size_t)t * K_UP + 4 * lane) = w;
          const unsigned kw = *(const unsigned*)(pr + QLR + 2 * lane); const float k0 = bflo(kw), k1 = bfhi(kw);
          const float rk = __builtin_amdgcn_rsqf(wave_sum(k0 * k0 + k1 * k1) * (1.f / KVLR) + RMS_EPS);
          *(unsigned*)(AN + (size_t)t * K_UP + QLR + 2 * lane) = pk2(k0 * rk * gkv.x, k1 * rk * gkv.y);
          const int i = lane & 15; const unsigned rw = *(const unsigned*)(pr + QLR + KVLR + 2 * i); const float x0 = bflo(rw), x1 = bfhi(rw);
          const f32x2 csv = *(const f32x2*)(cs + (size_t)t * 32 + 2 * i); const unsigned ro = pk2(x0 * csv.x - x1 * csv.y, x0 * csv.y + x1 * csv.x);
          const int h0 = (lane >> 4) * 2;
          *(unsigned*)(KKb + (size_t)t * 768 + h0 * QKD + NOPE + 2 * i) = ro; *(unsigned*)(KKb + (size_t)t * 768 + (h0 + 1) * QKD + NOPE + 2 * i) = ro; }
        const bf16* rr = pr + MLA_IN;
#pragma unroll
        for (int part = 0; part < 3; ++part) {
            const u32x4 cw = *(const u32x4*)(rr + part * 512 + 8 * lane); const u32x4 pv_ = pw[part]; pw[part] = cw;
            float o[8];
#pragma unroll
            for (int j = 0; j < 4; ++j) { const float a = bflo(cw[j]), b = bfhi(cw[j]), pa = bflo(pv_[j]), pb = bfhi(pv_[j]); const float ma = j < 2 ? mu0[part][2 * j] : mu1[part][2 * j - 4], mb = j < 2 ? mu0[part][2 * j + 1] : mu1[part][2 * j - 3];
                o[2 * j] = a + ma * (pa - a); o[2 * j + 1] = b + mb * (pb - b); }
            u32x4 w; w.x = pk2(o[0], o[1]); w.y = pk2(o[2], o[3]); w.z = pk2(o[4], o[5]); w.w = pk2(o[6], o[7]);
            if (part < 2) *(u32x4*)(RK + (size_t)t * 1024 + part * 512 + 8 * lane) = w; else *(u32x4*)(VS + (size_t)t * C5 + 8 * lane) = w;
        }
        { const float a = bf2f(rr[1536 + lane]); const float v = a + mu_wd * (p_wd - a); p_wd = a; A2[(size_t)t * K_SM + lane] = (bf16)f2bf(tanhf_(v)); }
        { const float a = bf2f(rr[1600 + lane]); const float v = a + mu_ad * (p_ad - a); p_ad = a; A2[(size_t)t * K_SM + 64 + lane] = (bf16)f2bf(v); }
        { const unsigned cw = *(const unsigned*)(rr + 1664 + 2 * lane); const float a = bflo(cw), b = bfhi(cw); const float va = a + mu_gd.x * (bflo(p_gd) - a), vb = b + mu_gd.y * (bfhi(p_gd) - b); p_gd = cw;
          *(unsigned*)(A2 + (size_t)t * K_SM + 128 + 2 * lane) = pk2(sigmoidf_(va), sigmoidf_(vb)); }
    }
}

namespace att {
__device__ __forceinline__ int crow(int r, int hi) { return (r & 3) + 8 * (r >> 2) + 4 * hi; }
constexpr int KSLOT = 12288, VSLOT = 8192;
constexpr int NSLOT = 3;
constexpr int LDS_K = 0, LDS_V = NSLOT * KSLOT, LDS_WS = LDS_V + NSLOT * VSLOT, LDS_OST = LDS_WS + NWAVES * 64 * 4, LDS_TOTAL = LDS_OST + NWAVES * 4096;
__device__ __forceinline__ void glds16(const void* gsrc, unsigned lds_dst) { unsigned keep;
    asm volatile("s_mov_b32 %0, m0\n\ts_mov_b32 m0, %2\n\ts_nop 0\n\tglobal_load_lds_dwordx4 %1, off\n\ts_mov_b32 m0, %0" : "=&s"(keep) : "v"(gsrc), "s"(lds_dst) : "memory"); }
__device__ __forceinline__ float max3f(float a, float b, float c) { return fmaxf(fmaxf(a, b), c); }
#define ATT_WAIT_BAR() asm volatile("s_waitcnt vmcnt(0) lgkmcnt(0)\n\ts_barrier" ::: "memory")
__device__ __forceinline__ float rowmax(const f32x16& p0, const f32x16& p1) {
    float a = max3f(p0[0], p0[1], p1[0]), b = max3f(p0[2], p0[3], p1[1]); a = max3f(a, p1[2], p1[3]);
#pragma unroll
    for (int r = 4; r < 16; r += 4) { a = max3f(a, p0[r], p0[r + 1]); b = max3f(b, p0[r + 2], p0[r + 3]); a = max3f(a, p1[r], p1[r + 1]); b = max3f(b, p1[r + 2], p1[r + 3]); }
    const float m = fmaxf(a, b);
    auto rr = __builtin_amdgcn_permlane32_swap(__float_as_uint(m), __float_as_uint(m), false, false);
    return fmaxf(__uint_as_float(rr[0]), __uint_as_float(rr[1]));
}
__device__ __forceinline__ void pv(f32x16* o, int vb, bf16x8 pa0, bf16x8 pa1, bf16x8 pa2, bf16x8 pa3) {
#pragma unroll
    for (int d0 = 0; d0 < 2; ++d0) { s16x4 lo[4], hi[4];
#pragma unroll
        for (int ks = 0; ks < 4; ++ks) {
            asm volatile("ds_read_b64_tr_b16 %0,%1 offset:%c2" : "=&v"(lo[ks]) : "v"(vb), "i"(d0 * 4096 + ks * 1024) : "memory");
            asm volatile("ds_read_b64_tr_b16 %0,%1 offset:%c2" : "=&v"(hi[ks]) : "v"(vb), "i"(d0 * 4096 + ks * 1024 + 512) : "memory"); }
        asm volatile("s_waitcnt lgkmcnt(0)" ::: "memory"); __builtin_amdgcn_sched_barrier(0);
#define PK(k) (bf16x8){lo[k][0], lo[k][1], lo[k][2], lo[k][3], hi[k][0], hi[k][1], hi[k][2], hi[k][3]}
        o[d0] = __builtin_amdgcn_mfma_f32_32x32x16_bf16(pa0, PK(0), o[d0], 0, 0, 0);
        o[d0] = __builtin_amdgcn_mfma_f32_32x32x16_bf16(pa1, PK(1), o[d0], 0, 0, 0);
        o[d0] = __builtin_amdgcn_mfma_f32_32x32x16_bf16(pa2, PK(2), o[d0], 0, 0, 0);
        o[d0] = __builtin_amdgcn_mfma_f32_32x32x16_bf16(pa3, PK(3), o[d0], 0, 0, 0);
#undef PK
    }
}
__device__ __forceinline__ void attn_unit(int b, int h, int qb, const bf16* Q, const bf16* __restrict__ KKp, const bf16* __restrict__ Vp, bf16* O, char* shm) {
    const int tid = threadIdx.x, lane = tid & 63, r32 = lane & 31, hi = lane >> 5; const int wid = __builtin_amdgcn_readfirstlane(tid >> 6);
    const long rowbase = (long)b * SEQ; const int q0 = qb * 256;
    const bf16* Qw = Q + (rowbase + q0 + wid * 32) * 768 + h * QKD;
    const bf16* Kh = KKp + rowbase * 768 + h * QKD; const bf16* Vh = Vp + rowbase * 512 + h * VD;
    const unsigned lds0 = (unsigned)(uintptr_t)shm;
    float* wsf = (float*)(shm + LDS_WS) + wid * 64;
    const bf16* ksrc0 = Kh + (long)lane * 768 + wid * 8;
    const bf16* ksrc1 = Kh + (long)lane * 768 + (8 + (wid & 3)) * 8;
    const bf16* vsrc = Vh + (long)(16 * (wid & 3) + (lane >> 2)) * 512 + (wid >> 2) * 32 + (lane & 3) * 8;
    const unsigned kdst0 = lds0 + LDS_K + wid * 1024, kdst1 = lds0 + LDS_K + (8 + (wid & 3)) * 1024, vdst = lds0 + LDS_V + wid * 1024;
#define DMA_KV(t, s) do { glds16(ksrc0 + (long)(t) * 64 * 768, (unsigned)__builtin_amdgcn_readfirstlane(kdst0 + (s) * KSLOT)); \
        if (wid < 4) glds16(ksrc1 + (long)(t) * 64 * 768, (unsigned)__builtin_amdgcn_readfirstlane(kdst1 + (s) * KSLOT)); \
        glds16(vsrc + (long)(t) * 64 * 512, (unsigned)__builtin_amdgcn_readfirstlane(vdst + (s) * VSLOT)); } while (0)
    const int vb0 = (int)(lds0 + LDS_V) + ((lane >> 4) & 1) * 32 + (lane & 3) * 8 + (4 * hi + ((lane & 15) >> 2)) * 64;
    const int NT = (q0 + 256) / 64;
    DMA_KV(0, 0); DMA_KV(1, 1);
    bf16x8 qr[6];
#pragma unroll
    for (int d0 = 0; d0 < 6; ++d0) qr[d0] = *reinterpret_cast<const bf16x8*>(&Qw[(long)r32 * 768 + d0 * 16 + hi * 8]);
    float mhat = 0.f, l_reg = 0.f; f32x16 o[2]; o[0] = f32x16{}; o[1] = f32x16{};
    f32x16 negm = f32x16{};
    const int qrel = wid * 32 + r32;
    typedef short v4i16_t __attribute__((ext_vector_type(4)));
    typedef __attribute__((address_space(3))) v4i16_t* lds_v4p;
    int sl_cur = 0, sl_nn = 2;
    for (int t = 0; t < NT; ++t) {
        if (t + 1 < NT && t > 0) { if (wid < 4) asm volatile("s_waitcnt vmcnt(3) lgkmcnt(0)\n\ts_barrier" ::: "memory"); else asm volatile("s_waitcnt vmcnt(2) lgkmcnt(0)\n\ts_barrier" ::: "memory"); }
        else ATT_WAIT_BAR();
        if (t + 2 < NT) DMA_KV(t + 2, sl_nn);
        const char* Kslot = shm + LDS_K + sl_cur * KSLOT;
        f32x16 p0 = negm, p1 = negm;
        { const char* kb = Kslot + hi * 1024 + r32 * 16;
#pragma unroll
          for (int d0 = 0; d0 < 6; ++d0) { const bf16x8 b0 = *reinterpret_cast<const bf16x8*>(kb + d0 * 2048); const bf16x8 b1 = *reinterpret_cast<const bf16x8*>(kb + d0 * 2048 + 512);
              p0 = __builtin_amdgcn_mfma_f32_32x32x16_bf16(b0, qr[d0], p0, 0, 0, 0); p1 = __builtin_amdgcn_mfma_f32_32x32x16_bf16(b1, qr[d0], p1, 0, 0, 0); } }
        s16x4 vlo[8], vhi[8];
        { const int vb = vb0 + sl_cur * VSLOT;
#pragma unroll
          for (int i = 0; i < 8; ++i) { const int off = (i >> 2) * 4096 + (i & 3) * 1024;
              vlo[i] = __builtin_bit_cast(s16x4, __builtin_amdgcn_ds_read_tr16_b64_v4i16((lds_v4p)(vb + off))); vhi[i] = __builtin_bit_cast(s16x4, __builtin_amdgcn_ds_read_tr16_b64_v4i16((lds_v4p)(vb + off + 512))); } }
        const int jb = t - (NT - 4);
        if (jb >= 0) { const int kbase = 64 * jb + 4 * hi;
#pragma unroll
            for (int r = 0; r < 16; ++r) { const int kv = kbase + (r & 3) + 8 * (r >> 2); if (kv > qrel) p0[r] = -INFINITY; if (kv + 32 > qrel) p1[r] = -INFINITY; } }
        const float rm = rowmax(p0, p1);
        bool resc = false;
        if (t == 0 || __any(rm > 8.0f)) {
            const float dl = (t == 0) ? rm : fmaxf(rm, 0.f); mhat += dl;
#pragma unroll
            for (int r = 0; r < 16; ++r) { p0[r] -= dl; p1[r] -= dl; negm[r] = -mhat; }
            const float f = (t == 0) ? 1.0f : __builtin_amdgcn_exp2f(-dl); l_reg *= f; if (hi == 0) wsf[r32] = f; resc = true; }
        float sacc = 0.f;
#pragma unroll
        for (int r = 0; r < 16; ++r) { p0[r] = __builtin_amdgcn_exp2f(p0[r]); p1[r] = __builtin_amdgcn_exp2f(p1[r]); sacc += p0[r] + p1[r]; }
        l_reg += sacc;
        if (resc) { asm volatile("s_waitcnt lgkmcnt(0)" ::: "memory");
#pragma unroll
            for (int r = 0; r < 16; ++r) { const float fr_ = wsf[crow(r, hi)]; o[0][r] *= fr_; o[1][r] *= fr_; } }
        u32x4 pw[4];
        pw[0] = (u32x4){cvtpk_c(p0[0], p0[1]), cvtpk_c(p0[2], p0[3]), cvtpk_c(p0[4], p0[5]), cvtpk_c(p0[6], p0[7])};
        pw[1] = (u32x4){cvtpk_c(p0[8], p0[9]), cvtpk_c(p0[10], p0[11]), cvtpk_c(p0[12], p0[13]), cvtpk_c(p0[14], p0[15])};
        pw[2] = (u32x4){cvtpk_c(p1[0], p1[1]), cvtpk_c(p1[2], p1[3]), cvtpk_c(p1[4], p1[5]), cvtpk_c(p1[6], p1[7])};
        pw[3] = (u32x4){cvtpk_c(p1[8], p1[9]), cvtpk_c(p1[10], p1[11]), cvtpk_c(p1[12], p1[13]), cvtpk_c(p1[14], p1[15])};
#pragma unroll
        for (int i = 0; i < 8; ++i) { const bf16x8 vf = (bf16x8){vlo[i][0], vlo[i][1], vlo[i][2], vlo[i][3], vhi[i][0], vhi[i][1], vhi[i][2], vhi[i][3]};
            o[i >> 2] = __builtin_amdgcn_mfma_f32_32x32x16_bf16(__builtin_bit_cast(bf16x8, pw[i & 3]), vf, o[i >> 2], 0, 0, 0); }
        sl_cur = (sl_cur == NSLOT - 1) ? 0 : sl_cur + 1; sl_nn = (sl_nn == NSLOT - 1) ? 0 : sl_nn + 1;
    }
    { auto rr = __builtin_amdgcn_permlane32_swap(__float_as_uint(l_reg), __float_as_uint(l_reg), false, false); l_reg = __uint_as_float(rr[0]) + __uint_as_float(rr[1]); }
    if (hi == 0) wsf[32 + r32] = l_reg; asm volatile("s_waitcnt lgkmcnt(0)" ::: "memory");
    float rli[16];
#pragma unroll
    for (int r = 0; r < 16; ++r) rli[r] = __builtin_amdgcn_rcpf(wsf[32 + crow(r, hi)]);
    bf16* Ow = O + (rowbase + q0 + wid * 32) * 512 + h * VD;
    { bf16* stg = (bf16*)(shm + LDS_OST) + wid * 2048;
#pragma unroll
      for (int r = 0; r < 16; ++r) { const int orow = crow(r, hi);
#pragma unroll
          for (int d0 = 0; d0 < 2; ++d0) stg[orow * 64 + d0 * 32 + r32] = (bf16)f2bf(o[d0][r] * rli[r]); }
      asm volatile("s_waitcnt lgkmcnt(0)" ::: "memory");
#pragma unroll
      for (int i = 0; i < 4; ++i) { const int row = i * 8 + (lane >> 3), ch = lane & 7; const u32x4 v = *(const u32x4*)(stg + row * 64 + ch * 8); *(u32x4*)(Ow + (long)row * 512 + ch * 8) = v; } }
    asm volatile("s_waitcnt vmcnt(0) lgkmcnt(0)\n\ts_barrier" ::: "memory");
#undef DMA_KV
}
}

__device__ __forceinline__ void phase_attn(const Params& p, const Frame& F, char* lds_generic, int l) {
    const bf16* Q = WSP(bf16, WS_Q); const bf16* KKp = WSP(bf16, WS_KK); const bf16* Vp = WSP(bf16, WS_V); bf16* O = WSP(bf16, WS_O);
    unsigned* head = (unsigned*)(F.ws + WS_CTL) + CW_ATTQ + l * 64;
    volatile LAS unsigned* MISC = (volatile LAS unsigned*)(F.lds + MISC_OFF);
    for (;;) {
        if (F.tid == 0) MISC[16] = __hip_atomic_fetch_add(head, 1u, RLX_AGENT);
        __syncthreads();
        const unsigned k = MISC[16];
        __syncthreads();
        if (k >= 1024u) break;
        const int qb = 15 - (int)(k >> 6), bh = (int)(k & 63u);
        att::attn_unit(bh >> 3, bh & 7, qb, Q, KKp, Vp, O, lds_generic);
    }
}

namespace rw {
constexpr int RS = 144;
constexpr int SLOT = 64 * RS;
constexpr int S_KT = 0, S_RT = 1, S_BC = 2, S_KC = 3, S_V = 4, S_BH = 5, S_KH = 6, S_GT = 7, S_ABK = 8, S_AKK = 9, S_AKR = 10, S_ABR = 11, S_ABKF = 12;
constexpr int S_TT = S_BC, S_ZT = S_KC, S_NW1T = S_AKK, S_NW2T = S_ABK;
constexpr int TOT_OFF = 13 * SLOT, PL_OFF = TOT_OFF + 8 * 64 * 4;
typedef short v4i16_t __attribute__((ext_vector_type(4)));
__device__ __forceinline__ int crow(int r, int hi) { return (r & 3) + 8 * (r >> 2) + 4 * hi; }
__device__ __forceinline__ bf16x8 frag_d(const LAS unsigned char* M, int row0, int k0, int r, int h) { return *(const LAS bf16x8*)(M + (row0 + r) * RS + (k0 + 8 * h) * 2); }
__device__ __forceinline__ bf16x8 frag_t(const LAS unsigned char* M, int k0, int col0, int lane) {
    const int h = lane >> 5, blk = (lane >> 4) & 1, q = (lane & 15) >> 2, pp = lane & 3;
    const LAS unsigned char* a = M + (k0 + 8 * h + q) * RS + (col0 + 16 * blk + 4 * pp) * 2;
    const v4i16_t lo = __builtin_amdgcn_ds_read_tr16_b64_v4i16((LAS v4i16_t*)a), hi = __builtin_amdgcn_ds_read_tr16_b64_v4i16((LAS v4i16_t*)(a + 4 * RS));
    return (bf16x8){lo[0], lo[1], lo[2], lo[3], hi[0], hi[1], hi[2], hi[3]};
}
__device__ __forceinline__ void store_T(LAS unsigned char* D, int m0, int n0, const f32x16& acc, float sgn, int r, int h) {
#pragma unroll
    for (int g = 0; g < 4; ++g) { u32x2 w; w.x = cvtpk_c(acc[4 * g] * sgn, acc[4 * g + 1] * sgn); w.y = cvtpk_c(acc[4 * g + 2] * sgn, acc[4 * g + 3] * sgn);
        *(LAS u32x2*)(D + (n0 + r) * RS + (m0 + 8 * g + 4 * h) * 2) = w; }
}
#define RW_MMA(acc, A, B) acc = __builtin_amdgcn_mfma_f32_32x32x16_bf16((A), (B), acc, 0, 0, 0)
}

#define LBAR() asm volatile("s_waitcnt lgkmcnt(0)\n\ts_barrier" ::: "memory")
__device__ __forceinline__ void phase_rwkv_r1(const Params& p, const Frame& F, int l) {
    using namespace rw;
    LAS unsigned char* L0 = F.lds;
#define SL(i) (L0 + (i) * SLOT)
    const bf16* RK = WSP(bf16, WS_RK); const float* WAG = WSP(float, WS_WAG);
    const bf16* Vv = l == 0 ? WSP(bf16, WS_VS0) : WSP(bf16, WS_VR);
    float* CH = WSP(float, WS_CH);
    const float* kkw = INP(I_KK) + (size_t)l * C5; const float* kaw = INP(I_KA) + (size_t)l * C5;
    const int tid0 = F.tid, wave = F.wave;
    const int pt0 = tid0 >> 3, j80 = tid0 & 7;
    LAS float* tot = (LAS float*)(L0 + TOT_OFF); LAS float* PLv = (LAS float*)(L0 + PL_OFF);
    u32x4 g_r, g_k, g_v; f32x4 g_l0, g_l1, g_a0, g_a1;
#define R1_FETCH(uu) do { const int bh_ = (uu) >> 6, cc_ = (uu) & 63; const size_t tok = (size_t)(bh_ >> 3) * SEQ + (size_t)cc_ * 64 + pt0; const int c_ = (bh_ & 7) * 64 + 8 * j80; \
        g_r = *(const u32x4*)(RK + tok * 1024 + c_); g_k = *(const u32x4*)(RK + tok * 1024 + 512 + c_); g_v = *(const u32x4*)(Vv + tok * C5 + c_); \
        g_l0 = *(const f32x4*)(WAG + tok * N_SM + c_); g_l1 = *(const f32x4*)(WAG + tok * N_SM + c_ + 4); g_a0 = *(const f32x4*)(WAG + tok * N_SM + 512 + c_); g_a1 = *(const f32x4*)(WAG + tok * N_SM + 512 + c_ + 4); } while (0)
    int u = F.vcu;
    if (u < 4096) R1_FETCH(u);
    for (; u < 4096; u += F.G) {
        const int hh = (u >> 6) & 7;
        int tid = tid0; asm volatile("" : "+v"(tid)); const int lane = tid & 63, r = lane & 31, h = lane >> 5, pt = tid >> 3, j8 = tid & 7;
        {
            const int c = hh * 64 + 8 * j8;
            const f32x4 kk0 = *(const f32x4*)(kkw + c), kk1 = *(const f32x4*)(kkw + c + 4), ka0 = *(const f32x4*)(kaw + c), ka1 = *(const f32x4*)(kaw + c + 4);
            float rr[8], k[8], a[8], x[8], lw[8], kap[8], be[8], kp[8]; float ss = 0.f;
#pragma unroll
            for (int j = 0; j < 4; ++j) { rr[2 * j] = bflo(g_r[j]); rr[2 * j + 1] = bfhi(g_r[j]); k[2 * j] = bflo(g_k[j]); k[2 * j + 1] = bfhi(g_k[j]); }
            *(LAS u32x4*)(SL(S_V) + pt * RS + j8 * 16) = g_v;
#pragma unroll
            for (int j = 0; j < 8; ++j) { a[j] = j < 4 ? g_a0[j & 3] : g_a1[j & 3]; lw[j] = j < 4 ? g_l0[j & 3] : g_l1[j & 3]; x[j] = lw[j]; const float q = k[j] * (j < 4 ? kk0[j & 3] : kk1[j & 3]); kap[j] = q; ss += q * q; }
            ss += __shfl_xor(ss, 1); ss += __shfl_xor(ss, 2); ss += __shfl_xor(ss, 4);
            const float inv = 1.0f / fmaxf(sqrtf(ss), 1e-12f);
#pragma unroll
            for (int j = 0; j < 8; ++j) { kap[j] *= inv; be[j] = kap[j] * a[j]; kp[j] = k[j] * (1.0f + (a[j] - 1.0f) * (j < 4 ? ka0[j & 3] : ka1[j & 3])); }
#pragma unroll
            for (int off = 8; off < 64; off <<= 1) {
#pragma unroll
                for (int j = 0; j < 8; ++j) { const float y = __shfl_up(x[j], off); if (lane >= off) x[j] += y; } }
            if (lane >= 56) { *(LAS f32x4*)(tot + wave * 64 + 8 * j8) = (f32x4){x[0], x[1], x[2], x[3]}; *(LAS f32x4*)(tot + wave * 64 + 8 * j8 + 4) = (f32x4){x[4], x[5], x[6], x[7]}; }
            LBAR();
            float csL[8];
#pragma unroll
            for (int j = 0; j < 8; ++j) csL[j] = 0.f;
#pragma unroll
            for (int w2 = 0; w2 < 8; ++w2) { const f32x4 t0 = *(const LAS f32x4*)(tot + w2 * 64 + 8 * j8), t1 = *(const LAS f32x4*)(tot + w2 * 64 + 8 * j8 + 4);
#pragma unroll
                for (int j = 0; j < 8; ++j) { const float tv = j < 4 ? t0[j & 3] : t1[j & 3]; csL[j] += tv; if (w2 < wave) x[j] += tv; } }
            if (pt == 0) {
#pragma unroll
                for (int j = 0; j < 8; ++j) PLv[8 * j8 + j] = __expf(csL[j]); }
            float kt[8], rt[8], bc[8], kc[8], bh[8], kh[8];
#pragma unroll
            for (int j = 0; j < 8; ++j) { const float eP = __expf(x[j]), ePm1 = __expf(x[j] - lw[j]), eInv = __expf(-x[j]), eL = __expf(csL[j] - x[j]);
                kt[j] = kap[j] * ePm1; rt[j] = rr[j] * eP; bc[j] = be[j] * eInv; kc[j] = kp[j] * eInv; bh[j] = be[j] * eL; kh[j] = kp[j] * eL; }
#define PK8(v) (u32x4){cvtpk_c(v[0], v[1]), cvtpk_c(v[2], v[3]), cvtpk_c(v[4], v[5]), cvtpk_c(v[6], v[7])}
            *(LAS u32x4*)(SL(S_KT) + pt * RS + j8 * 16) = PK8(kt); *(LAS u32x4*)(SL(S_RT) + pt * RS + j8 * 16) = PK8(rt);
            *(LAS u32x4*)(SL(S_BC) + pt * RS + j8 * 16) = PK8(bc); *(LAS u32x4*)(SL(S_KC) + pt * RS + j8 * 16) = PK8(kc);
            *(LAS u32x4*)(SL(S_BH) + pt * RS + j8 * 16) = PK8(bh); *(LAS u32x4*)(SL(S_KH) + pt * RS + j8 * 16) = PK8(kh);
#undef PK8
        }
        LBAR();
        {
            const int mat = wave >> 1, ti = wave & 1;
            const LAS unsigned char* X = (mat < 2) ? SL(S_KT) : SL(S_RT); const LAS unsigned char* Y = (mat == 0 || mat == 3) ? SL(S_BC) : SL(S_KC);
            LAS unsigned char* Dm = SL(S_ABK + mat);
            const int t = 32 * ti + r;
            bf16x8 xb[4];
#pragma unroll
            for (int kk = 0; kk < 4; ++kk) xb[kk] = frag_d(X, 32 * ti, 16 * kk, r, h);
#pragma unroll
            for (int si = 0; si < 2; ++si) {
                f32x16 acc = f32x16{};
                if (!(ti == 0 && si == 1)) {
#pragma unroll
                    for (int kk = 0; kk < 4; ++kk) RW_MMA(acc, frag_d(Y, 32 * si, 16 * kk, r, h), xb[kk]); }
#pragma unroll
                for (int g = 0; g < 4; ++g) { float v[4];
#pragma unroll
                    for (int e = 0; e < 4; ++e) { const int sidx = 32 * si + 8 * g + 4 * h + e; const bool keep = (mat < 2) ? (sidx < t) : (sidx <= t); v[e] = keep ? acc[4 * g + e] : 0.f; }
                    u32x2 w; w.x = cvtpk_c(v[0], v[1]); w.y = cvtpk_c(v[2], v[3]);
                    *(LAS u32x2*)(Dm + t * RS + (32 * si + 8 * g + 4 * h) * 2) = w;
                    if (mat == 0 && ti == si) *(LAS f32x4*)(SL(S_ABKF) + ti * 4608 + r * 144 + (8 * g + 4 * h) * 4) = (f32x4){v[0], v[1], v[2], v[3]}; }
            }
        }
        LBAR();
        if (wave == 0) {
            const int hb = lane >> 5, c = lane & 31; const LAS unsigned char* Ab = SL(S_ABKF) + hb * 4608;
            float Tc[32];
#pragma unroll
            for (int t = 0; t < 32; ++t) Tc[t] = 0.f;
#pragma unroll
            for (int t = 0; t < 32; ++t) { float acc0 = (t == c) ? 1.0f : 0.0f, acc1 = 0.f;
#pragma unroll
                for (int s4 = 0; s4 < (t + 3) / 4; ++s4) { const f32x4 a4 = *(const LAS f32x4*)(Ab + t * 144 + s4 * 16);
                    acc0 -= a4.x * Tc[4 * s4]; acc1 -= a4.y * Tc[4 * s4 + 1]; acc0 -= a4.z * Tc[4 * s4 + 2]; acc1 -= a4.w * Tc[4 * s4 + 3]; }
                float acc = acc0 + acc1;
                asm volatile("" : "+v"(acc) :: "memory");
                Tc[t] = acc; }
#pragma unroll
            for (int q = 0; q < 4; ++q) *(LAS u32x4*)(SL(S_TT) + (32 * hb + c) * RS + (32 * hb) * 2 + q * 16) =
                (u32x4){cvtpk_c(Tc[8 * q], Tc[8 * q + 1]), cvtpk_c(Tc[8 * q + 2], Tc[8 * q + 3]), cvtpk_c(Tc[8 * q + 4], Tc[8 * q + 5]), cvtpk_c(Tc[8 * q + 6], Tc[8 * q + 7])};
        } else if (wave == 1) {
            const int row = 32 + (lane >> 1), hf = lane & 1;
            *(LAS u32x4*)(SL(S_TT) + row * RS + hf * 32) = (u32x4){0u, 0u, 0u, 0u}; *(LAS u32x4*)(SL(S_TT) + row * RS + hf * 32 + 16) = (u32x4){0u, 0u, 0u, 0u};
        } else if (wave >= 4) {
            const int ti = (wave - 4) >> 1, ii = (wave - 4) & 1; f32x16 acc = f32x16{};
#pragma unroll
            for (int kk = 0; kk < 4; ++kk) RW_MMA(acc, frag_d(SL(S_AKK), 32 * ti, 16 * kk, r, h), frag_t(SL(S_V), 16 * kk, 32 * ii, lane));
            store_T(SL(S_GT), 32 * ti, 32 * ii, acc, 1.0f, r, h);
        }
        LBAR();
        if (wave == 0) { f32x16 acc = f32x16{};
#pragma unroll
            for (int kk = 0; kk < 2; ++kk) RW_MMA(acc, frag_d(SL(S_ABK), 32, 16 * kk, r, h), frag_d(SL(S_TT), 0, 16 * kk, r, h));
            store_T(SL(S_ZT), 0, 0, acc, 1.0f, r, h); }
        LBAR();
        if (wave == 0) { f32x16 acc = f32x16{};
#pragma unroll
            for (int kk = 0; kk < 2; ++kk) RW_MMA(acc, frag_t(SL(S_TT), 32 + 16 * kk, 32, lane), frag_d(SL(S_ZT), 0, 16 * kk, r, h));
            store_T(SL(S_TT), 32, 0, acc, -1.0f, r, h); }
        LBAR();
        if (u + F.G < 4096) R1_FETCH(u + F.G);
        { const int w4 = wave & 3, ti = w4 >> 1, ci = w4 & 1; f32x16 acc = f32x16{};
          if (wave < 4) {
#pragma unroll
              for (int kk = 0; kk < 4; ++kk) RW_MMA(acc, frag_t(SL(S_TT), 16 * kk, 32 * ti, lane), frag_t(SL(S_KT), 16 * kk, 32 * ci, lane));
              store_T(SL(S_NW1T), 32 * ti, 32 * ci, acc, -1.0f, r, h); }
          else {
#pragma unroll
              for (int kk = 0; kk < 4; ++kk) RW_MMA(acc, frag_t(SL(S_TT), 16 * kk, 32 * ti, lane), frag_d(SL(S_GT), 32 * ci, 16 * kk, r, h));
              store_T(SL(S_NW2T), 32 * ti, 32 * ci, acc, -1.0f, r, h); } }
        LBAR();
        { const int which = wave >> 1, mi = wave & 1; float* dst = CH + ((size_t)u * 4 + which) * 4096;
#pragma unroll
          for (int ni = 0; ni < 2; ++ni) { f32x16 acc = f32x16{};
#pragma unroll
              for (int kk = 0; kk < 4; ++kk) {
                  if (which == 0) RW_MMA(acc, frag_d(SL(S_ABR), 32 * mi, 16 * kk, r, h), frag_d(SL(S_NW1T), 32 * ni, 16 * kk, r, h));
                  else if (which == 1) { RW_MMA(acc, frag_d(SL(S_AKR), 32 * mi, 16 * kk, r, h), frag_t(SL(S_V), 16 * kk, 32 * ni, lane)); RW_MMA(acc, frag_d(SL(S_ABR), 32 * mi, 16 * kk, r, h), frag_d(SL(S_NW2T), 32 * ni, 16 * kk, r, h)); }
                  else if (which == 2) RW_MMA(acc, frag_t(SL(S_BH), 16 * kk, 32 * mi, lane), frag_d(SL(S_NW1T), 32 * ni, 16 * kk, r, h));
                  else { RW_MMA(acc, frag_t(SL(S_KH), 16 * kk, 32 * mi, lane), frag_t(SL(S_V), 16 * kk, 32 * ni, lane)); RW_MMA(acc, frag_t(SL(S_BH), 16 * kk, 32 * mi, lane), frag_d(SL(S_NW2T), 32 * ni, 16 * kk, r, h)); } }
              const int n = 32 * ni + r;
#pragma unroll
              for (int rg = 0; rg < 16; ++rg) { const int m = 32 * mi + crow(rg, h); float v = acc[rg];
                  if (which == 0) v += bf2f(*(const LAS bf16*)(SL(S_RT) + m * RS + n * 2));
                  if (which == 2 && m == n) v += PLv[n];
                  dst[m * 64 + n] = v; } } }
        LBAR();
    }
#undef R1_FETCH
#undef SL
}

__device__ __forceinline__ void phase_rwkv_r2(const Params& p, const Frame& F) {
    const float* CH = WSP(float, WS_CH); float* RO = WSP(float, WS_RO);
    LAS float* stb = (LAS float*)(F.lds);
    constexpr int STB = 4 * 1280;
    const int lane = F.lane, wave = F.wave, q = lane >> 4, li = lane & 15, w4 = wave & 3;
    const int nr2 = F.G >= 4 ? F.G / 4 : 1;
    if (F.vcu >= nr2) return;
    for (int bh = F.vcu; bh < 64; bh += nr2) {
        const int b = bh >> 3, hh = bh & 7;
        __syncthreads();
        for (int i = F.tid; i < 2 * STB; i += NTHREADS) stb[i] = 0.f;
        __syncthreads();
        const int mA = (wave < 4) ? 2 : 0, mC = (wave < 4) ? 3 : 1;
        const float* basec = CH + (size_t)bh * 64 * 4 * 4096;
        f32x4 fa[2][4], fc[2][4];
#define R2_FETCH(cc, st) do { const float* pa = basec + ((size_t)(cc) * 4 + mA) * 4096 + (16 * w4 + li) * 64 + 16 * q; fa[st][0] = *(const f32x4*)(pa); fa[st][1] = *(const f32x4*)(pa + 4); fa[st][2] = *(const f32x4*)(pa + 8); fa[st][3] = *(const f32x4*)(pa + 12); \
            const float* pc = basec + ((size_t)(cc) * 4 + mC) * 4096 + (16 * w4 + 4 * q) * 64 + li; \
            _Pragma("unroll") for (int ct = 0; ct < 4; ++ct) fc[st][ct] = (f32x4){pc[16 * ct], pc[64 + 16 * ct], pc[128 + 16 * ct], pc[192 + 16 * ct]}; } while (0)
        R2_FETCH(0, 0); R2_FETCH(1, 1);
#pragma unroll 1
        for (int c0 = 0; c0 < 64; c0 += 2) {
#pragma unroll
            for (int st = 0; st < 2; ++st) { const int c = c0 + st;
                const f32x4 A0 = fa[st][0], A1 = fa[st][1], A2 = fa[st][2], A3 = fa[st][3];
                f32x4 acc[4];
#pragma unroll
                for (int ct = 0; ct < 4; ++ct) acc[ct] = fc[st][ct];
                if (c + 2 < 64) R2_FETCH(c + 2, st);
#pragma unroll
                for (int ct = 0; ct < 4; ++ct) { const LAS float* sb = stb + (c & 1) * STB + ct * 1280 + lane * 20;
                    const f32x4 b0 = *(const LAS f32x4*)(sb), b1 = *(const LAS f32x4*)(sb + 4), b2 = *(const LAS f32x4*)(sb + 8), b3 = *(const LAS f32x4*)(sb + 12);
#pragma unroll
                    for (int k = 0; k < 4; ++k) acc[ct] = __builtin_amdgcn_mfma_f32_16x16x4f32(A0[k], b0[k], acc[ct], 0, 0, 0);
#pragma unroll
                    for (int k = 0; k < 4; ++k) acc[ct] = __builtin_amdgcn_mfma_f32_16x16x4f32(A1[k], b1[k], acc[ct], 0, 0, 0);
#pragma unroll
                    for (int k = 0; k < 4; ++k) acc[ct] = __builtin_amdgcn_mfma_f32_16x16x4f32(A2[k], b2[k], acc[ct], 0, 0, 0);
#pragma unroll
                    for (int k = 0; k < 4; ++k) acc[ct] = __builtin_amdgcn_mfma_f32_16x16x4f32(A3[k], b3[k], acc[ct], 0, 0, 0); }
                if (wave < 4) {
#pragma unroll
                    for (int ct = 0; ct < 4; ++ct) *(LAS f32x4*)(stb + ((c + 1) & 1) * STB + ct * 1280 + (w4 * 16 + li) * 20 + 4 * q) = acc[ct]; }
                else { float* ro = RO + ((size_t)b * SEQ + (size_t)c * 64 + 16 * w4 + 4 * q) * C5 + hh * 64 + li;
#pragma unroll
                    for (int ct = 0; ct < 4; ++ct) { ro[16 * ct] = acc[ct][0]; ro[C5 + 16 * ct] = acc[ct][1]; ro[2 * C5 + 16 * ct] = acc[ct][2]; ro[3 * C5 + 16 * ct] = acc[ct][3]; } }
                LBAR();
            }
        }
#undef R2_FETCH
    }
    __syncthreads();
}
#undef LBAR

__device__ __forceinline__ void phase_mix(const Params& p, const Frame& F, int l) {
    const int gw = F.vcu * NWAVES + F.wave, NGW = F.G * NWAVES; const int lane = F.lane;
    const bf16* O = WSP(bf16, WS_O); const float* RO = WSP(float, WS_RO); const bf16* RK = WSP(bf16, WS_RK); const float* WAG = WSP(float, WS_WAG);
    const bf16* Vv = l == 0 ? WSP(bf16, WS_VS0) : WSP(bf16, WS_VR); bf16* MIX = WSP(bf16, WS_MIX);
    const float* og = INP(I_MOUTG) + (size_t)l * C5; const float* gng = INP(I_GNG) + (size_t)l * C5; const float* gnb = INP(I_GNB) + (size_t)l * C5;
    const float* kaw = INP(I_KA) + (size_t)l * C5; const float* rkw = INP(I_RK) + (size_t)l * C5;
#pragma unroll 2
    for (int t = gw; t < T; t += NGW) {
        const int c = 8 * lane;
        { const u32x4 ow = *(const u32x4*)(O + (size_t)t * C5 + c); float o[8]; float ss = 0.f;
#pragma unroll
          for (int j = 0; j < 4; ++j) { o[2 * j] = bflo(ow[j]); o[2 * j + 1] = bfhi(ow[j]); ss += o[2 * j] * o[2 * j] + o[2 * j + 1] * o[2 * j + 1]; }
          const float rs = 1.f / sqrtf(wave_sum(ss) * (1.f / C5) + RMS_EPS);
          const f32x4 g0 = *(const f32x4*)(og + c), g1 = *(const f32x4*)(og + c + 4);
          u32x4 w; w.x = pk2(o[0] * rs * g0.x, o[1] * rs * g0.y); w.y = pk2(o[2] * rs * g0.z, o[3] * rs * g0.w); w.z = pk2(o[4] * rs * g1.x, o[5] * rs * g1.y); w.w = pk2(o[6] * rs * g1.z, o[7] * rs * g1.w);
          *(u32x4*)(MIX + (size_t)t * D + c) = w; }
        { const f32x4 r0 = *(const f32x4*)(RO + (size_t)t * C5 + c), r1 = *(const f32x4*)(RO + (size_t)t * C5 + c + 4);
          float o[8]; float s = 0.f;
#pragma unroll
          for (int j = 0; j < 8; ++j) { o[j] = j < 4 ? r0[j & 3] : r1[j & 3]; s += o[j]; }
          s += __shfl_xor(s, 1); s += __shfl_xor(s, 2); s += __shfl_xor(s, 4); const float mean = s * (1.f / 64.f); float q = 0.f;
#pragma unroll
          for (int j = 0; j < 8; ++j) { o[j] -= mean; q += o[j] * o[j]; }
          q += __shfl_xor(q, 1); q += __shfl_xor(q, 2); q += __shfl_xor(q, 4); const float rstd = 1.f / sqrtf(q * (1.f / 64.f) + GN_EPS);
          const u32x4 rw = *(const u32x4*)(RK + (size_t)t * 1024 + c), kw = *(const u32x4*)(RK + (size_t)t * 1024 + 512 + c), vw = *(const u32x4*)(Vv + (size_t)t * C5 + c);
          const f32x4 a0 = *(const f32x4*)(WAG + (size_t)t * N_SM + 512 + c), a1 = *(const f32x4*)(WAG + (size_t)t * N_SM + 512 + c + 4);
          const f32x4 g0 = *(const f32x4*)(WAG + (size_t)t * N_SM + 1024 + c), g1 = *(const f32x4*)(WAG + (size_t)t * N_SM + 1024 + c + 4);
          const f32x4 ka0 = *(const f32x4*)(kaw + c), ka1 = *(const f32x4*)(kaw + c + 4), rk0 = *(const f32x4*)(rkw + c), rk1 = *(const f32x4*)(rkw + c + 4);
          const f32x4 gg0 = *(const f32x4*)(gng + c), gg1 = *(const f32x4*)(gng + c + 4), gb0 = *(const f32x4*)(gnb + c), gb1 = *(const f32x4*)(gnb + c + 4);
          float r[8], k[8], v[8]; float bon = 0.f;
#pragma unroll
          for (int j = 0; j < 4; ++j) { r[2 * j] = bflo(rw[j]); r[2 * j + 1] = bfhi(rw[j]); k[2 * j] = bflo(kw[j]); k[2 * j + 1] = bfhi(kw[j]); v[2 * j] = bflo(vw[j]); v[2 * j + 1] = bfhi(vw[j]); }
#pragma unroll
          for (int j = 0; j < 8; ++j) { const float a = j < 4 ? a0[j & 3] : a1[j & 3]; const float kp = k[j] * (1.0f + (a - 1.0f) * (j < 4 ? ka0[j & 3] : ka1[j & 3])); bon += r[j] * kp * (j < 4 ? rk0[j & 3] : rk1[j & 3]); }
          bon += __shfl_xor(bon, 1); bon += __shfl_xor(bon, 2); bon += __shfl_xor(bon, 4);
          float y[8];
#pragma unroll
          for (int j = 0; j < 8; ++j) { const float gn = o[j] * rstd * (j < 4 ? gg0[j & 3] : gg1[j & 3]) + (j < 4 ? gb0[j & 3] : gb1[j & 3]); y[j] = (gn + bon * v[j]) * (j < 4 ? g0[j & 3] : g1[j & 3]); }
          u32x4 w; w.x = pk2(y[0], y[1]); w.y = pk2(y[2], y[3]); w.z = pk2(y[4], y[5]); w.w = pk2(y[6], y[7]);
          *(u32x4*)(MIX + (size_t)t * D + C5 + c) = w; }
    }
}

#define DPPI(x, ctrl) __builtin_amdgcn_update_dpp(0, (x), (ctrl), 0xF, 0xF, true)
__device__ __forceinline__ float row16_max(float x) {
    x = fmaxf(x, __builtin_bit_cast(float, DPPI(__builtin_bit_cast(int, x), 0xB1))); x = fmaxf(x, __builtin_bit_cast(float, DPPI(__builtin_bit_cast(int, x), 0x4E)));
    x = fmaxf(x, __builtin_bit_cast(float, DPPI(__builtin_bit_cast(int, x), 0x141))); x = fmaxf(x, __builtin_bit_cast(float, DPPI(__builtin_bit_cast(int, x), 0x140))); return x; }
__device__ __forceinline__ int row16_min(int x) {
    x = min(x, DPPI(x, 0xB1)); x = min(x, DPPI(x, 0x4E)); x = min(x, DPPI(x, 0x141)); x = min(x, DPPI(x, 0x140)); return x; }
__device__ __forceinline__ void phase_ln1_route(const Params& p, const Frame& F, int l) {
    LAS unsigned char* wl = F.lds;
    LAS int* hist = (LAS int*)(F.lds + LDSX_OFF + 4096);
    LAS int* basep = hist + 32;
    LAS int* rinfo = hist + 64;
    LAS float* rgate = (LAS float*)(rinfo + 512);
    const float* mod = WSP(float, WS_MOD) + (size_t)l * NBATCH * 6144;
    const float* g1 = INP(I_LN1G) + (size_t)l * D; const float* b1 = INP(I_LN1B) + (size_t)l * D;
    const float* rb = INP(I_RB) + (size_t)l * NE;
    unsigned* cnt = (unsigned*)(F.ws + WS_CTL) + CW_CNT + l * 64;
    int* LIST = WSP(int, WS_LIST); float* GATEL = WSP(float, WS_GATEL); int* TOKSLOT = WSP(int, WS_TOKSLOT);
    bf16* X = WSP(bf16, WS_X); bf16* H = WSP(bf16, WS_H);
    const int lane = F.lane, li = lane & 15, g = lane >> 4;
    __syncthreads();
    for (int i = F.tid; i < 2 * 4096; i += NTHREADS) { const int part = i >> 12, rem = i & 4095, e = rem >> 7, ch = rem & 127;
        const u32x4 v = *(const u32x4*)(WSP(bf16, WS_RWT) + ((size_t)part * DEPTH + l) * NE * D + (size_t)e * D + ch * 8);
        *(LAS u32x4*)(wl + part * 65536 + e * 2048 + ((ch ^ (e & 15)) << 4)) = v; }
    __syncthreads();
    for (int chunk = F.vcu; chunk < T / 128; chunk += F.G) {
        __syncthreads();
        if (F.tid < 32) hist[F.tid] = 0;
        __syncthreads();
        const int row0 = chunk * 128 + F.wave * 16; const int b = row0 / SEQ;
        float mymean = 0.f, myrstd = 0.f;
#pragma unroll 1
        for (int rr = 0; rr < 16; ++rr) {
            const GAS u32x2* xr = (const GAS u32x2*)(X + (size_t)(row0 + rr) * D) + lane;
            f32x4 v[4]; float s = 0.f;
#pragma unroll
            for (int j = 0; j < 4; ++j) { const u32x2 w = xr[64 * j]; v[j] = (f32x4){bflo(w.x), bfhi(w.x), bflo(w.y), bfhi(w.y)}; s += (v[j].x + v[j].y) + (v[j].z + v[j].w); }
            const float mean = wave_sum(s) * (1.f / D); float s2 = 0.f;
#pragma unroll
            for (int j = 0; j < 4; ++j) { v[j] = v[j] - mean; s2 += (v[j].x * v[j].x + v[j].y * v[j].y) + (v[j].z * v[j].z + v[j].w * v[j].w); }
            const float rstd = __builtin_amdgcn_rsqf(wave_sum(s2) * (1.f / D) + LN_EPS);
            if (li == rr) { mymean = mean; myrstd = rstd; }
        }
        f32x4 acc0 = (f32x4){0.f, 0.f, 0.f, 0.f}, acc1 = acc0;
        bf16* xrow = X + (size_t)(row0 + li) * D + 8 * g; bf16* hrow = H + (size_t)(row0 + li) * D + 8 * g;
        const float* shp = mod + (size_t)b * 6144 + 3072 + 8 * g; const float* scp = mod + (size_t)b * 6144 + 4096 + 8 * g;
        const LAS unsigned char* w0 = wl + li * 2048; const LAS unsigned char* w1 = wl + (16 + li) * 2048;
#pragma unroll 2
        for (int s = 0; s < 32; ++s) {
            const int k = 32 * s;
            const u32x4 yw = *(const u32x4*)(xrow + k); const f32x4 y0 = (f32x4){bflo(yw.x), bfhi(yw.x), bflo(yw.y), bfhi(yw.y)}, y1 = (f32x4){bflo(yw.z), bfhi(yw.z), bflo(yw.w), bfhi(yw.w)};
            const f32x4 ga0 = *(const f32x4*)(g1 + k + 8 * g), ga1 = *(const f32x4*)(g1 + k + 8 * g + 4), be0 = *(const f32x4*)(b1 + k + 8 * g), be1 = *(const f32x4*)(b1 + k + 8 * g + 4);
            const f32x4 sc0 = *(const f32x4*)(scp + k), sc1 = *(const f32x4*)(scp + k + 4), sh0 = *(const f32x4*)(shp + k), sh1 = *(const f32x4*)(shp + k + 4);
            const f32x4 x0 = (y0 - mymean) * myrstd * ga0 + be0, x1 = (y1 - mymean) * myrstd * ga1 + be1;
            { u32x4 xw; xw.x = cvtpk_c(x0.x, x0.y); xw.y = cvtpk_c(x0.z, x0.w); xw.z = cvtpk_c(x1.x, x1.y); xw.w = cvtpk_c(x1.z, x1.w); *(u32x4*)(xrow + k) = xw; }
            const f32x4 h0 = x0 * (sc0 + 1.0f) + sh0, h1 = x1 * (sc1 + 1.0f) + sh1;
            u32x4 hi; hi.x = cvtpk_c(h0.x, h0.y); hi.y = cvtpk_c(h0.z, h0.w); hi.z = cvtpk_c(h1.x, h1.y); hi.w = cvtpk_c(h1.z, h1.w);
            *(u32x4*)(hrow + k) = hi;
            u32x4 lo; lo.x = cvtpk_c(h0.x - bflo(hi.x), h0.y - bfhi(hi.x)); lo.y = cvtpk_c(h0.z - bflo(hi.y), h0.w - bfhi(hi.y)); lo.z = cvtpk_c(h1.x - bflo(hi.z), h1.y - bfhi(hi.z)); lo.w = cvtpk_c(h1.z - bflo(hi.w), h1.w - bfhi(hi.w));
            const int cho = ((4 * s + g) ^ li) << 4;
            const bf16x8 bh0 = *(const LAS bf16x8*)(w0 + cho), bh1 = *(const LAS bf16x8*)(w1 + cho), bl0 = *(const LAS bf16x8*)(w0 + 65536 + cho), bl1 = *(const LAS bf16x8*)(w1 + 65536 + cho);
            const bf16x8 ahi = __builtin_bit_cast(bf16x8, hi), alo = __builtin_bit_cast(bf16x8, lo);
            acc0 = __builtin_amdgcn_mfma_f32_16x16x32_bf16(ahi, bh0, acc0, 0, 0, 0); acc1 = __builtin_amdgcn_mfma_f32_16x16x32_bf16(ahi, bh1, acc1, 0, 0, 0);
            acc0 = __builtin_amdgcn_mfma_f32_16x16x32_bf16(alo, bh0, acc0, 0, 0, 0); acc1 = __builtin_amdgcn_mfma_f32_16x16x32_bf16(alo, bh1, acc1, 0, 0, 0);
            acc0 = __builtin_amdgcn_mfma_f32_16x16x32_bf16(ahi, bl0, acc0, 0, 0, 0); acc1 = __builtin_amdgcn_mfma_f32_16x16x32_bf16(ahi, bl1, acc1, 0, 0, 0);
        }
        const float rb0 = rb[li], rb1 = rb[16 + li];
#pragma unroll
        for (int reg = 0; reg < 4; ++reg) {
            float v0 = acc0[reg] + rb0, v1 = acc1[reg] + rb1;
            float tv0 = 0.f, tv1 = 0.f, tv2 = 0.f, tv3 = 0.f; int te0 = 0, te1 = 0, te2 = 0, te3 = 0;
#pragma unroll
            for (int k = 0; k < 4; ++k) { const float mx = row16_max(fmaxf(v0, v1));
                const int id = (v0 == mx) ? li : ((v1 == mx) ? 16 + li : 99); const int ek = row16_min(id);
                if (k == 0) { tv0 = mx; te0 = ek; } else if (k == 1) { tv1 = mx; te1 = ek; } else if (k == 2) { tv2 = mx; te2 = ek; } else { tv3 = mx; te3 = ek; }
                if (ek == li) v0 = -INFINITY; if (ek == 16 + li) v1 = -INFINITY; }
            const float e1 = __expf(tv1 - tv0), e2 = __expf(tv2 - tv0), e3 = __expf(tv3 - tv0); const float inv = __builtin_amdgcn_rcpf(1.0f + e1 + e2 + e3);
            if (li < 4) { const int lr = F.wave * 16 + 4 * g + reg; const int ek = li == 0 ? te0 : li == 1 ? te1 : li == 2 ? te2 : te3; const float gk = (li == 0 ? 1.0f : li == 1 ? e1 : li == 2 ? e2 : e3) * inv;
                const int lp = __hip_atomic_fetch_add(&hist[ek], 1, __ATOMIC_RELAXED, __HIP_MEMORY_SCOPE_WORKGROUP); rinfo[lr * 4 + li] = (ek << 16) | lp; rgate[lr * 4 + li] = gk; }
        }
        __syncthreads();
        if (F.tid < 32) basep[F.tid] = (int)__hip_atomic_fetch_add(cnt + F.tid, (unsigned)hist[F.tid], RLX_AGENT);
        __syncthreads();
        { const int lr = F.tid >> 2, k = F.tid & 3; const int m = chunk * 128 + lr; const int info = rinfo[F.tid]; const int ek = info >> 16; const int pos = basep[ek] + (info & 0xffff);
          LIST[ek * CAP + pos] = m; GATEL[ek * CAP + pos] = rgate[F.tid]; TOKSLOT[m * 4 + k] = (ek << 16) | pos; }
    }
    __syncthreads();
}

__device__ __forceinline__ void moe_tables(const Frame& F, int l) {
    LAS int* tb = (LAS int*)(F.lds + TB_OFF); LAS int* cn = tb + 40;
    const unsigned* cnt = (const unsigned*)(F.ws + WS_CTL) + CW_CNT + l * 64;
    __syncthreads();
    if (F.tid == 0) { int acc = 0;
        for (int e = 0; e < NE; ++e) { const int c = (int)__hip_atomic_load(cnt + e, RLX_AGENT); cn[e] = c; tb[e] = acc; acc += (c + 255) >> 8; }
        tb[NE] = acc; }
    __syncthreads();
}

__device__ __forceinline__ void phase_combine(const Params& p, const Frame& F, int l) {
    const LAS int* tb = (const LAS int*)(F.lds + TB_OFF);
    const int gw = F.vcu * NWAVES + F.wave, NGW = F.G * NWAVES; const int lane = F.lane;
    const float* mod = WSP(float, WS_MOD) + (size_t)l * NBATCH * 6144; const float* modn = WSP(float, WS_MOD) + (size_t)(l + 1) * NBATCH * 6144;
    const float* g2 = INP(I_LN2G) + (size_t)l * D; const float* b2 = INP(I_LN2B) + (size_t)l * D;
    const bf16* Y = WSP(bf16, WS_Y); const int* TOKSLOT = WSP(int, WS_TOKSLOT);
    const bool lastl = (l == DEPTH - 1);
#pragma unroll 2
    for (int m = gw; m < T; m += NGW) {
        const int b = m / SEQ;
        int srow[4];
#pragma unroll
        for (int k = 0; k < 4; ++k) { const int ts = TOKSLOT[m * 4 + k]; const int e = ts >> 16, pos = ts & 0xffff; srow[k] = tb[e] * 256 + pos; }
        GAS u32x2* xr = (GAS u32x2*)(WSP(bf16, WS_X) + (size_t)m * D) + lane;
        f32x4 v[4]; float s = 0.f;
#pragma unroll
        for (int j = 0; j < 4; ++j) { const int c = 4 * lane + 256 * j; f32x4 y = (f32x4){0.f, 0.f, 0.f, 0.f};
#pragma unroll
            for (int k = 0; k < 4; ++k) { const u32x2 yw = *(const u32x2*)(Y + (size_t)srow[k] * D + c); y.x += bflo(yw.x); y.y += bfhi(yw.x); y.z += bflo(yw.y); y.w += bfhi(yw.y); }
            const f32x4 gt = *(const f32x4*)(mod + (size_t)b * 6144 + 5120 + c) + 1.0f;
            const u32x2 xw = xr[64 * j]; v[j] = (f32x4){bflo(xw.x), bfhi(xw.x), bflo(xw.y), bfhi(xw.y)} * DN_ALPHA + gt * y; s += (v[j].x + v[j].y) + (v[j].z + v[j].w); }
        const float mean = wave_sum(s) * (1.f / D); float s2 = 0.f;
#pragma unroll
        for (int j = 0; j < 4; ++j) { v[j] = v[j] - mean; s2 += (v[j].x * v[j].x + v[j].y * v[j].y) + (v[j].z * v[j].z + v[j].w * v[j].w); }
        const float rstd = 1.f / sqrtf(wave_sum(s2) * (1.f / D) + LN_EPS);
        GAS f32x4* oo = (GAS f32x4*)(p.out + (size_t)m * D) + lane;
        GAS u32x2* ho = (GAS u32x2*)(WSP(bf16, WS_H) + (size_t)m * D) + lane;
#pragma unroll
        for (int j = 0; j < 4; ++j) { const int c = 4 * lane + 256 * j;
            const f32x4 g = *(const f32x4*)(g2 + c), be = *(const f32x4*)(b2 + c);
            const f32x4 x2 = v[j] * rstd * g + be;
            if (lastl) oo[64 * j] = x2;
            else { { u32x2 xw; xw.x = pk2(x2.x, x2.y); xw.y = pk2(x2.z, x2.w); xr[64 * j] = xw; }
                const f32x4 sh = *(const f32x4*)(modn + (size_t)b * 6144 + c), sc = *(const f32x4*)(modn + (size_t)b * 6144 + 1024 + c);
                const f32x4 h = x2 * (sc + 1.0f) + sh; u32x2 w; w.x = pk2(h.x, h.y); w.y = pk2(h.z, h.w); ho[64 * j] = w; } }
    }
}

constexpr int PH_PER_LAYER = 11, N_PHASES = 2 + DEPTH * PH_PER_LAYER;
__global__ void __launch_bounds__(NTHREADS, 2) fwd(Params p) {
    extern __shared__ __attribute__((aligned(16))) unsigned char lds[];
    Frame F;
    F.lds = (LAS unsigned char*)lds; F.tid = threadIdx.x; F.lane = F.tid & 63; F.wave = __builtin_amdgcn_readfirstlane(F.tid >> 6);
    F.G = gridDim.x; { const int bx = blockIdx.x; F.vcu = (F.G % 8 == 0) ? (bx % 8) * (F.G / 8) + bx / 8 : bx; }
    F.ws = p.ws;
    volatile LAS unsigned* MISC = (volatile LAS unsigned*)(F.lds + MISC_OFF);
    if (F.tid < 64) MISC[F.tid] = 0u;
    __syncthreads();
    unsigned* ctl = (unsigned*)(p.ws + WS_CTL);
#if MK_ONE_LAUNCH
    XcdBarrier bar = xcd_barrier_post(ctl + CW_BAR, MISC + 8);
#define GRID_BAR() xcd_barrier(bar)
#else
#define GRID_BAR() do {} while (0)
#endif
    const int lo = p.ph_lo, hi = p.ph_hi;
#ifndef PH_MASK
#define PH_MASK 0xFFFFFFFFu
#endif
#define IN(k) (lo <= (k) && (k) < hi)
#define EN(j) ((PH_MASK >> (j)) & 1u)
#define SEAM(k) do { if (IN(k) && IN((k) + 1)) GRID_BAR(); } while (0)
    LAS unsigned char* ring = F.lds;

    if (EN(0) && IN(0)) { for (int rep = 0; rep < REP_PRO; ++rep) phase_prologue(p, F); } SEAM(0);
    if (EN(1) && IN(1)) { phase_ln0(p, F); } SEAM(1);
#define LAYER_BODY \
        constexpr int pb = 2 + l * PH_PER_LAYER; \
        const float* mod = WSP(float, WS_MOD) + (size_t)l * NBATCH * 6144; \
        if (EN(2) && IN(pb + 0)) { \
            pg8::Gemm g{WSP(bf16, WS_H), WSP(bf16, WS_WINT) + (size_t)l * N_INP * D, T, N_INP, D}; pg8::DenseOrder S; S.init(T, N_INP, F.G, (int)blockIdx.x); \
            pg8::EpiBf16Plain E{WSP(bf16, WS_P), N_INP}; \
            for (int rep = 0; rep < REP_WIN; ++rep) pg8::gemm_phase<pg8::EpiBf16Plain, pg8::DenseOrder, true>(ring, g, S, E); \
        } SEAM(pb + 0); \
        if (EN(3) && IN(pb + 1)) { for (int rep = 0; rep < REP_PREP; ++rep) phase_prep(p, F, l); } SEAM(pb + 1); \
        if (EN(4) && IN(pb + 2)) { \
            if (EN(13)) { pg8::Gemm g{WSP(bf16, WS_AN), WSP(bf16, WS_WUPT) + (size_t)l * N_UP * K_UP, T, N_UP, K_UP}; pg8::DenseOrder S; S.init(T, N_UP, F.G, (int)blockIdx.x); \
              pg8::EpiMlaUp E{WSP(bf16, WS_Q), WSP(bf16, WS_KK), WSP(bf16, WS_V), WSP(float, WS_CS)}; \
              pg8::gemm_phase<pg8::EpiMlaUp, pg8::DenseOrder, true>(ring, g, S, E); } \
            if (EN(14)) { pg8::Gemm g{WSP(bf16, WS_A2), WSP(bf16, WS_WSMT) + (size_t)l * N_SM * K_SM, T, N_SM, K_SM}; pg8::DenseOrder S; S.init(T, N_SM, F.G, (int)blockIdx.x); \
              pg8::EpiRwkvSmall E{WSP(float, WS_WAG), INP(I_W0) + (size_t)l * C5, INP(I_A0) + (size_t)l * C5}; \
              pg8::gemm_phase<pg8::EpiRwkvSmall, pg8::DenseOrder, true>(ring, g, S, E); } \
            if (EN(15) && l > 0) { pg8::Gemm g{WSP(bf16, WS_VS1), WSP(bf16, WS_WV12T), T, C5, C5}; pg8::DenseOrder S; S.init(T, C5, F.G, (int)blockIdx.x); \
              pg8::EpiVres E{WSP(bf16, WS_VS1), WSP(bf16, WS_VS0), WSP(bf16, WS_VR), INP(I_V0)}; \
              pg8::gemm_phase<pg8::EpiVres, pg8::DenseOrder, true>(ring, g, S, E); } \
        } SEAM(pb + 2); \
        if (EN(5) && IN(pb + 3)) { phase_rwkv_r1(p, F, l); } SEAM(pb + 3); \
        if (EN(6) && IN(pb + 4)) { phase_rwkv_r2(p, F); if (l == 0) { const int c0 = F.G / 4, nc = (F.G * 3) / 8; if (F.vcu >= c0 && F.vcu < c0 + nc) phase_convert_experts(p, F, c0, nc); } phase_attn(p, F, (char*)lds, l); } SEAM(pb + 4); \
        if (EN(7) && IN(pb + 5)) { for (int rep = 0; rep < REP_MIX; ++rep) phase_mix(p, F, l); } SEAM(pb + 5); \
        if (EN(8) && IN(pb + 6)) { \
            pg8::Gemm g{WSP(bf16, WS_MIX), WSP(bf16, WS_WOT) + (size_t)l * D * D, T, D, D}; pg8::DenseOrder S; S.init(T, D, F.G, (int)blockIdx.x); \
            pg8::EpiWo E{WSP(bf16, WS_X), mod + 2048}; \
            pg8::gemm_phase<pg8::EpiWo, pg8::DenseOrder, true>(ring, g, S, E); \
        } SEAM(pb + 6); \
        if (EN(9) && IN(pb + 7)) { phase_ln1_route(p, F, l); } SEAM(pb + 7); \
        if (EN(10) && IN(pb + 8)) { \
            moe_tables(F, l); \
            const LAS int* tb = (const LAS int*)(F.lds + TB_OFF); \
            pg8::Gemm g{WSP(bf16, WS_H), WSP(bf16, WS_W1T) + (size_t)l * NE * 2048 * D, T, 2048, D}; \
            pg8::MoeOrder<true> S{tb, tb + 40, WSP(int, WS_LIST), 8, F.G, F.vcu, (LAS unsigned*)(F.lds + GT_OFF)}; \
            pg8::EpiSwiglu E{WSP(bf16, WS_H1), WSP(float, WS_B1P) + (size_t)l * NE * 2048}; \
            for (int rep = 0; rep < REP_MOE1; ++rep) pg8::gemm_phase<pg8::EpiSwiglu, pg8::MoeOrder<true>, true>(ring, g, S, E); \
        } SEAM(pb + 8); \
        if (EN(11) && IN(pb + 9)) { \
            moe_tables(F, l); \
            const LAS int* tb = (const LAS int*)(F.lds + TB_OFF); \
            pg8::Gemm g{WSP(bf16, WS_H1), WSP(bf16, WS_W2T) + (size_t)l * NE * D * FF, MAXSLOT, D, FF}; \
            pg8::MoeOrder<false> S{tb, tb + 40, nullptr, 4, F.G, F.vcu, nullptr}; \
            pg8::EpiMoeOut E{WSP(bf16, WS_Y), INP(I_EB2) + (size_t)l * NE * D, WSP(float, WS_GATEL), tb}; \
            for (int rep = 0; rep < REP_MOE2; ++rep) pg8::gemm_phase<pg8::EpiMoeOut, pg8::MoeOrder<false>, true>(ring, g, S, E); \
        } SEAM(pb + 9); \
        if (EN(12) && IN(pb + 10)) { moe_tables(F, l); phase_combine(p, F, l); } SEAM(pb + 10);
    { constexpr int l = 0; LAYER_BODY }
    { constexpr int l = 1; LAYER_BODY }
#undef LAYER_BODY
#undef IN
#undef SEAM
}

extern "C" void kernel_launch(void* const* d_in, const int* in_sizes, int n_in, void* d_out, int out_size, void* d_ws, size_t ws_size, hipStream_t stream) {
    static int grid = 0;
    if (grid == 0) {
        if (n_in != N_INPUTS || out_size != T * D || ws_size < WS_END) { fprintf(stderr, "kernel_launch: unexpected problem: n_in %d out %d ws %zu\n", n_in, out_size, ws_size); grid = -1; return; }
        int dev = 0, cus = 0, per_cu = 0;
        if (hipGetDevice(&dev) != hipSuccess || hipDeviceGetAttribute(&cus, hipDeviceAttributeMultiprocessorCount, dev) != hipSuccess) { grid = -1; return; }
        if (hipFuncSetAttribute((const void*)fwd, hipFuncAttributeMaxDynamicSharedMemorySize, LDS_BYTES) != hipSuccess) { fprintf(stderr, "kernel_launch: hipFuncSetAttribute failed\n"); grid = -1; return; }
        if (hipOccupancyMaxActiveBlocksPerMultiprocessor(&per_cu, (const void*)fwd, NTHREADS, LDS_BYTES) != hipSuccess || per_cu < 1) fprintf(stderr, "kernel_launch: occupancy query reports %d\n", per_cu);
        (void)hipGetLastError();
        grid = cus;
    }
    if (grid < 0) return;
    if (hipMemsetAsync((char*)d_ws + WS_CTL, 0, CTL_ZERO_BYTES, stream) != hipSuccess) return;
    Params p{};
    for (int i = 0; i < N_INPUTS; ++i) p.in[i] = d_in[i];
    p.out = (float*)d_out; p.ws = (unsigned char*)d_ws;
#if MK_ONE_LAUNCH
    p.ph_lo = 0; p.ph_hi = N_PHASES;
    hipLaunchKernelGGL(fwd, dim3(grid), dim3(NTHREADS), LDS_BYTES, stream, p);
#else
    for (int ph = 0; ph < N_PHASES; ++ph) { p.ph_lo = ph; p.ph_hi = ph + 1; hipLaunchKernelGGL(fwd, dim3(grid), dim3(NTHREADS), LDS_BYTES, stream, p); }
#endif
}
```

```cpp
#include <hip/hip_runtime.h>
#include <cstdio>
#include <cstdint>

#define REP_PRO 1
#define REP_ATTN 1
#define REP_RWKV 1
#define REP_MOE1 1
#define REP_MOE2 1
#define REP_WIN 1
#define REP_PREP 1
#define REP_MIX 1
#ifndef MK_ONE_LAUNCH
#define MK_ONE_LAUNCH 1
#endif

#define GAS __attribute__((address_space(1)))
#define LAS __attribute__((address_space(3)))
typedef unsigned short bf16;
typedef short bf16x8 __attribute__((ext_vector_type(8)));
typedef short s16x4 __attribute__((ext_vector_type(4)));
typedef float f32x2 __attribute__((ext_vector_type(2)));
typedef float f32x4 __attribute__((ext_vector_type(4)));
typedef float f32x16 __attribute__((ext_vector_type(16)));
typedef unsigned u32x2 __attribute__((ext_vector_type(2)));
typedef unsigned u32x4 __attribute__((ext_vector_type(4)));

constexpr int D = 1024, NBATCH = 8, SEQ = 4096, T = NBATCH * SEQ, DEPTH = 2;
constexpr int MLA_IN = 416, RWKV_IN = 1792, N_IN = 2208, N_INP = 2304;
constexpr int QLR = 256, KVLR = 128, ROPE = 32, NOPE = 64, QKD = 96, VD = 64, NH = 8;
constexpr int C5 = 512;
constexpr int NE = 32, TOPK = 4, FF = 1024, CAP = 32768;
constexpr int N_UP = 1792, K_UP = 384, N_SM = 1536, K_SM = 256;
constexpr int MAXSLOT = 139264;
constexpr float DN_ALPHA = 1.4142135623730951f;
constexpr float C2Q = 0.14724444602590306f;
constexpr float LN_EPS = 1e-5f, RMS_EPS = 1e-6f, GN_EPS = 64e-5f;
constexpr int NWAVES = 8, NTHREADS = 512;
constexpr int PGW_Q = 0, PGW_KN = 384, PGW_V = 512, PGW_W = 640, PGW_A = 704, PGW_G = 768, PGW_VR = 896, PGW_NFRAG = 1408;

enum { I_X = 0, I_C, I_POS, I_ELNG, I_ELNB, I_ADAW, I_ADAB, I_WIN, I_QNG, I_WUQ, I_KVNG, I_WUK, I_WUV, I_MOUTG, I_MU, I_W0, I_W2, I_A0, I_A2, I_G2,
       I_KK, I_KA, I_RK, I_GNG, I_GNB, I_V0, I_V1, I_V2, I_WO, I_LN1G, I_LN1B, I_RW, I_RB, I_EW1, I_EB1, I_EW2, I_EB2, I_LN2G, I_LN2B, N_INPUTS };

constexpr size_t MiB = 1u << 20;
constexpr size_t WS_CTL = 0, CTL_ZERO_BYTES = 4 * MiB;
constexpr size_t WS_MOD = 4 * MiB, WS_B1P = 5 * MiB, WS_CS = 6 * MiB, WS_LIST = 10 * MiB, WS_GATEL = 14 * MiB, WS_TOKSLOT = 18 * MiB;
constexpr size_t WS_RWT = 19 * MiB;
constexpr size_t WS_WINT = 20 * MiB, WS_WUPT = 30 * MiB, WS_WSMT = 33 * MiB, WS_WV12T = 35 * MiB, WS_WOT = 36 * MiB, WS_W1T = 40 * MiB, WS_W2T = 296 * MiB;
constexpr size_t WS_X = 424 * MiB, WS_H = 552 * MiB, WS_VS0 = 616 * MiB, WS_VS1 = 648 * MiB;
constexpr size_t WS_P = 680 * MiB, WS_AN = 824 * MiB, WS_A2 = 848 * MiB, WS_RK = 864 * MiB, WS_Q = 928 * MiB, WS_KK = 976 * MiB, WS_V = 1024 * MiB, WS_O = 1056 * MiB;
constexpr size_t WS_WAG = 1088 * MiB, WS_RO = 1280 * MiB, WS_MIX = 1344 * MiB, WS_VR = 1408 * MiB;
constexpr size_t WS_LW = WS_WAG, WS_AG = WS_WAG + 64 * MiB;
constexpr size_t WS_H1 = 680 * MiB, WS_Y = 952 * MiB;
constexpr size_t WS_CH = 1440 * MiB;
constexpr size_t WS_PGW = 1696 * MiB;
constexpr size_t WS_END = 1700 * MiB;
constexpr int CW_TMO = 0, CW_CODE = 1, CW_BAR = 4096, CW_CNT = 8192, CW_ATTQ = 8448;

constexpr int RING_BYTES = 131072;
constexpr int LDSX_OFF = RING_BYTES;
constexpr int MISC_OFF = LDSX_OFF;
constexpr int TB_OFF = LDSX_OFF + 256;
constexpr int GT_OFF = LDSX_OFF + 1024;
constexpr int LDS_BYTES = 147456;

#define RLX_AGENT __ATOMIC_RELAXED, __HIP_MEMORY_SCOPE_AGENT
#define LDS_WAIT() asm volatile("s_waitcnt lgkmcnt(0)" ::: "memory")
#define VM_WAIT() asm volatile("s_waitcnt vmcnt(0)" ::: "memory")

__device__ __forceinline__ unsigned f2bf(float f) { unsigned u = __builtin_bit_cast(unsigned, f); return (u + 0x7fffu + ((u >> 16) & 1u)) >> 16; }
__device__ __forceinline__ unsigned pk2(float lo, float hi) { return f2bf(lo) | (f2bf(hi) << 16); }
__device__ __forceinline__ float bf2f(unsigned b) { return __builtin_bit_cast(float, b << 16); }
__device__ __forceinline__ float bflo(unsigned w) { return __builtin_bit_cast(float, w << 16); }
__device__ __forceinline__ float bfhi(unsigned w) { return __builtin_bit_cast(float, w & 0xffff0000u); }
__device__ __forceinline__ unsigned cvt_pk_bf16(float lo, float hi) { unsigned r; asm volatile("v_cvt_pk_bf16_f32 %0, %1, %2" : "=v"(r) : "v"(lo), "v"(hi)); return r; }
typedef __bf16 bf16x2_t __attribute__((ext_vector_type(2)));
__device__ __forceinline__ unsigned cvtpk_c(float lo, float hi) { f32x2 v = {lo, hi}; bf16x2_t b = __builtin_convertvector(v, bf16x2_t); return __builtin_bit_cast(unsigned, b); }
__device__ __forceinline__ float wave_sum(float v) {
#pragma unroll
    for (int o = 1; o < 64; o <<= 1) v += __shfl_xor(v, o);
    return v;
}
__device__ __forceinline__ float sigmoidf_(float x) { return __builtin_amdgcn_rcpf(1.0f + __expf(-x)); }
__device__ __forceinline__ float tanhf_(float x) { return 1.0f - 2.0f * __builtin_amdgcn_rcpf(1.0f + __expf(2.0f * x)); }

#define XB_TMO      128
#define XB_XCNT(j)  (256  + 64 * (j))
#define XB_XSUB(j)  (1280 + 64 * (j))
#define XB_XGEN(j)  (2304 + 64 * (j))
#define XB_TOP      3328
#define XB_TOPGEN   3392
#define XCD_BAR_WORDS 3456
#define XB_SPIN_CAP (1u << 18)
__device__ __forceinline__ unsigned xb_ld(unsigned* p)              { return __hip_atomic_load(p, __ATOMIC_RELAXED, __HIP_MEMORY_SCOPE_AGENT); }
__device__ __forceinline__ unsigned xb_add(unsigned* p, unsigned v) { return __hip_atomic_fetch_add(p, v, __ATOMIC_RELAXED, __HIP_MEMORY_SCOPE_AGENT); }
__device__ __forceinline__ unsigned xb_xcc_id() { return (unsigned)__builtin_amdgcn_s_getreg((3 << 11) | 20) & 0xFu; }
#define XB_SPIN(cond, bar) do { unsigned _sp = 0; while (cond) { __builtin_amdgcn_s_sleep(1); \
    if ((++_sp & 255u) == 0u) { if (xb_ld(&(bar)[XB_TMO])) break; if (_sp > XB_SPIN_CAP) { atomicAdd(&(bar)[XB_TMO], 1u); break; } } } } while (0)
struct XcdBarrier { unsigned* bar; unsigned x; volatile LAS unsigned* st; };
__device__ __forceinline__ XcdBarrier xcd_barrier_post(unsigned* bar, volatile LAS unsigned* st) {
    XcdBarrier b; b.bar = bar; b.x = xb_xcc_id(); b.st = st;
    if (threadIdx.x == 0) (void)xb_add(&bar[XB_XCNT(b.x)], 1u);
    return b;
}
__device__ __forceinline__ void xcd_barrier_complete(unsigned* bar, unsigned x, unsigned& nloc, unsigned& nx) {
    const unsigned G = gridDim.x * gridDim.y * gridDim.z;
    unsigned sum, cnt, mine, sp = 0u;
    for (;;) {
        sum = 0u; cnt = 0u; mine = 0u;
#pragma unroll
        for (unsigned j = 0; j < 16; ++j) { const unsigned c = xb_ld(&bar[XB_XCNT(j)]); sum += c; cnt += (c > 0u) ? 1u : 0u; mine = (j == x) ? c : mine; }
        if (sum == G) break;
        __builtin_amdgcn_s_sleep(1);
        if ((++sp & 255u) == 0u) { if (xb_ld(&bar[XB_TMO])) break; if (sp > XB_SPIN_CAP) { atomicAdd(&bar[XB_TMO], 1u); break; } }
    }
    nloc = mine > 0u ? mine : 1u; nx = cnt > 0u ? cnt : 1u;
}
__device__ __forceinline__ void xcd_barrier(const XcdBarrier& b) {
    asm volatile("s_waitcnt vmcnt(0)" ::: "memory");
    __syncthreads();
    if (threadIdx.x == 0) {
        unsigned* bar = b.bar;
        __builtin_amdgcn_s_waitcnt(0);
        unsigned nloc = b.st[0], nx = b.st[1];
        if (nloc == 0u) { xcd_barrier_complete(bar, b.x, nloc, nx); b.st[0] = nloc; b.st[1] = nx; }
        const unsigned old = xb_add(&bar[XB_XSUB(b.x)], 1u);
        const unsigned gen = old / nloc;
        if (old + 1u == (gen + 1u) * nloc) {
            __builtin_amdgcn_fence(__ATOMIC_RELEASE, "agent");
            asm volatile("s_waitcnt vmcnt(0)" ::: "memory");
            const unsigned og = xb_add(&bar[XB_TOP], 1u);
            const unsigned tg = og / nx;
            if (og + 1u == (tg + 1u) * nx) xb_add(&bar[XB_TOPGEN], 1u);
            else XB_SPIN(xb_ld(&bar[XB_TOPGEN]) == tg, bar);
            __builtin_amdgcn_fence(__ATOMIC_ACQUIRE, "agent");
            xb_add(&bar[XB_XGEN(b.x)], 1u);
            asm volatile("s_waitcnt vmcnt(0)" ::: "memory");
        } else {
            XB_SPIN(xb_ld(&bar[XB_XGEN(b.x)]) == gen, bar);
            __builtin_amdgcn_fence(__ATOMIC_ACQUIRE, "agent");
            asm volatile("s_waitcnt vmcnt(0)" ::: "memory");
        }
    }
    __syncthreads();
}

namespace pg8 {
constexpr int BM = 256, BK = 64, HALF = 128, HTB = HALF * BK * 2, STAGE_BYTES = 8 * HTB, NXCD = 8, WGM = 8;
__device__ __forceinline__ int lds_byte(int r, int c) { const int st = (r >> 4) * 2 + (c >> 5), rr = r & 15, cc = c & 31, ob = rr * 64 + cc * 2; return st * 1024 + (ob ^ (((ob >> 9) & 1) << 5)); }
__device__ __forceinline__ void stage_rc(int b, int& R, int& C) { const int st = b / 1024, sb = b % 1024, swz = sb ^ (((sb >> 9) & 1) << 5); R = (st >> 1) * 16 + swz / 64; C = (st & 1) * 32 + (swz % 64) / 2; }
__device__ __forceinline__ int perm32(int rho) { const int n = rho >> 4, i = rho & 15; return 8 * (i >> 2) + 4 * n + (i & 3); }

struct Unit { int pm, pn, e; };
struct Gemm { const bf16* A; const bf16* Bt; int M, N, K; };

struct DenseOrder {
    int nM, nN, nwg, G, c;
    __device__ __forceinline__ void init(int M, int N, int G_, int c_) { nM = M / BM; nN = N / BM; nwg = nM * nN; G = G_; c = c_; }
    __device__ __forceinline__ bool next(int i, Unit& u) const {
        const long L = (long)i * G + c; if (L >= nwg) return false;
        int wgid = (int)L; { const int q = nwg / NXCD, r = nwg % NXCD, xcd = wgid % NXCD, off = wgid / NXCD; wgid = (xcd < r ? xcd * (q + 1) : r * (q + 1) + (xcd - r) * q) + off; }
        const int nig = WGM * nN, gid = wgid / nig, fm = gid * WGM, gsz = (nM - fm) < WGM ? (nM - fm) : WGM;
        u.pm = fm + ((wgid % nig) % gsz); u.pn = (wgid % nig) / gsz; u.e = 0; return true;
    }
    static constexpr bool GATHER = false;
    __device__ __forceinline__ size_t b_off(const Unit& u, int N, int K) const { return (size_t)u.pn * BM * K * 2; }
    __device__ __forceinline__ unsigned a_row_off(const Unit& u, int row, int K) const { return 0u; }
    __device__ __forceinline__ LAS unsigned* gtab() const { return nullptr; }
};
template <bool GATHER_> struct MoeOrder {
    static constexpr bool GATHER = GATHER_;
    const LAS int* tb; const LAS int* cnt; const int* list; int nN, G, c; LAS unsigned* gt_;
    __device__ __forceinline__ LAS unsigned* gtab() const { return gt_; }
    __device__ __forceinline__ bool next(int i, Unit& u) const {
        const int L = i * G + c; const int total = tb[NE] * nN; if (L >= total) return false;
        int e = 0;
#pragma unroll 1
        for (int j = 1; j < NE; ++j) if (tb[j] * nN <= L) e = j;
        const int Lr = L - tb[e] * nN, nte = tb[e + 1] - tb[e];
        const int mblk = Lr / (4 * nN), m0 = mblk * 4, gsz = (nte - m0) < 4 ? (nte - m0) : 4, rem = Lr - mblk * 4 * nN;
        u.e = e; u.pn = rem / gsz; u.pm = tb[e] + m0 + (rem % gsz); return true;
    }
    __device__ __forceinline__ size_t b_off(const Unit& u, int N, int K) const { return ((size_t)u.e * N + (size_t)u.pn * BM) * K * 2; }
    __device__ __forceinline__ unsigned a_row_off(const Unit& u, int row, int K) const {
        const int pos = (u.pm - tb[u.e]) * BM + row; const int tok = pos < cnt[u.e] ? list[u.e * CAP + pos] : 0; return (unsigned)tok * (unsigned)(K * 2);
    }
};

template <class Epi, class Sched, bool ALIGN_EPI>
__device__ __forceinline__ void gemm_phase(LAS unsigned char* lds, const Gemm g, const Sched& S, const Epi& E) {
    const int tid = threadIdx.x, wid = __builtin_amdgcn_readfirstlane(tid >> 6), lane = tid & 63, wr = wid >> 2, wc = wid & 3, fr = lane & 15, fq = lane >> 4;
    const int K = g.K, nt = K / BK;
    int RA[2]; unsigned CA[2], voffA[2], voffB[2];
#pragma unroll
    for (int i = 0; i < 2; ++i) { int R, C; stage_rc(tid * 16 + i * 8192, R, C); const int Rb = Epi::PERM ? ((R & ~31) + perm32(R & 31)) : R;
        RA[i] = R; CA[i] = (unsigned)C * 2u; voffA[i] = (unsigned)(R * K + C) * 2u; voffB[i] = (unsigned)(Rb * K + C) * 2u; }
    const size_t kstep = (size_t)(BK * 2);
    const size_t hstep = (size_t)HALF * K * 2;
    const size_t tstep = 2 * hstep;
    const unsigned ldsw = (unsigned)wid * 1024u;
    const int aoff = lds_byte(wr * 64 + fr, fq * 8), boff = lds_byte(wc * 32 + fr, fq * 8);
    const char* Abase = (const char*)g.A;
    LAS unsigned* gtb = S.gtab();
#define PG8_SA(b, h) (((b) * 2 + (h)) * HTB)
#define PG8_SB(b, h) ((4 + (b) * 2 + (h)) * HTB)
#define PG8_STAGE(bufoff, gbase, voff) do { _Pragma("unroll") for (int _i = 0; _i < 2; ++_i) \
        __builtin_amdgcn_global_load_lds((const unsigned*)((const char*)(gbase) + (voff)[_i]), (LAS unsigned*)(lds + (bufoff) + ldsw + _i * 8192), 16, 0, 0); } while (0)
#define PG8_STAGEA(bufoff, h, kb, nx) do { \
        if constexpr (Sched::GATHER) { const LAS unsigned* tp_ = gtb + ((nx) ? tnx : tcu) + (h) * HALF; const unsigned o0_ = tp_[RA[0]] + CA[0], o1_ = tp_[RA[1]] + CA[1]; \
            __builtin_amdgcn_global_load_lds((const unsigned*)(Abase + (size_t)(kb) + o0_), (LAS unsigned*)(lds + (bufoff) + ldsw), 16, 0, 0); \
            __builtin_amdgcn_global_load_lds((const unsigned*)(Abase + (size_t)(kb) + o1_), (LAS unsigned*)(lds + (bufoff) + ldsw + 8192), 16, 0, 0); } \
        else { const char* gb_ = ((nx) ? nA : cA) + (size_t)(h) * hstep + (size_t)(kb); PG8_STAGE(bufoff, gb_, voffA); } } while (0)
#define PG8_LDA(dst, b, h) do { _Pragma("unroll") for (int m = 0; m < 4; ++m) _Pragma("unroll") for (int k = 0; k < 2; ++k) dst[m][k] = *(const LAS bf16x8*)(lds + PG8_SA(b, h) + aoff + m * 2048 + k * 1024); } while (0)
#define PG8_LDB(dst, b, h) do { _Pragma("unroll") for (int n = 0; n < 2; ++n) _Pragma("unroll") for (int k = 0; k < 2; ++k) dst[n][k] = *(const LAS bf16x8*)(lds + PG8_SB(b, h) + boff + n * 2048 + k * 1024); } while (0)
#define PG8_MMA(ai, bj, At, Bt) do { __builtin_amdgcn_s_setprio(1); _Pragma("unroll") for (int m = 0; m < 4; ++m) _Pragma("unroll") for (int n = 0; n < 2; ++n) _Pragma("unroll") for (int k = 0; k < 2; ++k) \
        acc[ai][bj][m][n] = __builtin_amdgcn_mfma_f32_16x16x32_bf16(Bt[n][k], At[m][k], acc[ai][bj][m][n], 0, 0, 0); __builtin_amdgcn_s_setprio(0); } while (0)
#define PG8_WAIT_V(n) asm volatile("s_waitcnt vmcnt(" #n ")" ::: "memory")
#define PG8_WAIT_L(n) asm volatile("s_waitcnt lgkmcnt(" #n ")" ::: "memory")
#define PG8_BAR __builtin_amdgcn_s_barrier()
#define PG8_SCHED __builtin_amdgcn_sched_barrier(0)
    Unit cur, nxt; int ui = 0;
    if (!S.next(0, cur)) return;
    f32x4 acc[2][2][4][2];
#pragma unroll
    for (int a = 0; a < 2; ++a)
#pragma unroll
        for (int b = 0; b < 2; ++b)
#pragma unroll
            for (int m = 0; m < 4; ++m)
#pragma unroll
                for (int n = 0; n < 2; ++n) acc[a][b][m][n] = (f32x4){0.f, 0.f, 0.f, 0.f};
    bf16x8 At[4][2], B0[2][2], B1[2][2];
    const char* cA = Abase + (size_t)cur.pm * tstep; const char* cB = (const char*)g.Bt + S.b_off(cur, g.N, K);
    const char* nA = cA; const char* nB = cB;
    int tcu = 0, tnx = 0;
    if constexpr (Sched::GATHER) {
        if (tid < BM) gtb[tid] = S.a_row_off(cur, tid, K);
        asm volatile("s_waitcnt vmcnt(0) lgkmcnt(0)" ::: "memory"); PG8_BAR; asm volatile("" ::: "memory");
    }
    PG8_STAGE(PG8_SB(0, 0), cB, voffB); PG8_STAGE(PG8_SB(0, 1), cB + hstep, voffB); PG8_STAGEA(PG8_SA(0, 0), 0, 0, false); PG8_STAGEA(PG8_SA(0, 1), 1, 0, false);
    if (wr == 1) PG8_BAR;
    PG8_WAIT_V(2); PG8_BAR;
    PG8_STAGE(PG8_SB(1, 0), cB + kstep, voffB); PG8_STAGEA(PG8_SA(1, 0), 0, kstep, false); PG8_STAGE(PG8_SB(1, 1), cB + hstep + kstep, voffB);
    PG8_WAIT_V(6); PG8_BAR;
    for (;;) {
        const bool has_next = S.next(ui + 1, nxt);
        nA = cA; nB = cB; tnx = tcu;
        if (has_next) { nA = Abase + (size_t)nxt.pm * tstep; nB = (const char*)g.Bt + S.b_off(nxt, g.N, K);
            if constexpr (Sched::GATHER) { tnx = tcu ^ BM; if (tid < BM) gtb[tnx + tid] = S.a_row_off(nxt, tid, K); } }
#pragma unroll 1
        for (int t = 0; t < nt; t += 2) {
            const bool last = (t == nt - 2);
            const size_t k1 = (size_t)(t + 1) * kstep;
            const size_t k2 = last ? 0 : (size_t)(t + 2) * kstep, k3 = k2 + kstep;
            const char* b2 = last ? nB : cB + (size_t)(t + 2) * kstep; const char* b3 = b2 + kstep;
            PG8_LDB(B0, 0, 0); PG8_LDB(B1, 0, 1); PG8_SCHED; PG8_LDA(At, 0, 0); PG8_STAGEA(PG8_SA(1, 1), 1, k1, false);
            PG8_WAIT_V(8); PG8_WAIT_L(0); PG8_BAR; PG8_MMA(0, 0, At, B0); PG8_MMA(0, 1, At, B1); PG8_BAR; PG8_SCHED;
            PG8_LDA(At, 0, 1); PG8_STAGE(PG8_SB(0, 0), b2, voffB); PG8_STAGE(PG8_SB(0, 1), b2 + hstep, voffB); PG8_STAGEA(PG8_SA(0, 0), 0, k2, last);
            PG8_WAIT_V(8); PG8_WAIT_L(0); PG8_BAR; PG8_MMA(1, 0, At, B0); PG8_MMA(1, 1, At, B1); PG8_BAR; PG8_SCHED;
            PG8_LDB(B0, 1, 0); PG8_LDB(B1, 1, 1); PG8_SCHED; PG8_LDA(At, 1, 0); PG8_STAGEA(PG8_SA(0, 1), 1, k2, last);
            PG8_WAIT_V(8); PG8_WAIT_L(0); PG8_BAR; PG8_MMA(0, 0, At, B0); PG8_MMA(0, 1, At, B1); PG8_BAR; PG8_SCHED;
            PG8_LDA(At, 1, 1); PG8_STAGE(PG8_SB(1, 0), b3, voffB); PG8_STAGE(PG8_SB(1, 1), b3 + hstep, voffB); PG8_STAGEA(PG8_SA(1, 0), 0, k3, last);
            PG8_WAIT_V(8); PG8_WAIT_L(0); PG8_BAR; PG8_MMA(1, 0, At, B0); PG8_MMA(1, 1, At, B1); PG8_BAR; PG8_SCHED;
        }
        if constexpr (ALIGN_EPI) { if (wr == 0) PG8_BAR; }
        E(acc, cur, wr, wc, fr, fq);
        if (!has_next) break;
#pragma unroll
        for (int a = 0; a < 2; ++a)
#pragma unroll
            for (int b = 0; b < 2; ++b)
#pragma unroll
                for (int m = 0; m < 4; ++m)
#pragma unroll
                    for (int n = 0; n < 2; ++n) acc[a][b][m][n] = (f32x4){0.f, 0.f, 0.f, 0.f};
        cur = nxt; cA = nA; cB = nB; tcu = tnx; ++ui;
        if constexpr (ALIGN_EPI) { if (wr == 1) PG8_BAR; }
    }
    PG8_WAIT_V(0);
    if constexpr (!ALIGN_EPI) { if (wr == 0) PG8_BAR; }
    PG8_BAR;
#undef PG8_SA
#undef PG8_SB
#undef PG8_STAGE
#undef PG8_STAGEA
#undef PG8_LDA
#undef PG8_LDB
#undef PG8_MMA
#undef PG8_WAIT_V
#undef PG8_WAIT_L
#undef PG8_BAR
#undef PG8_SCHED
}

struct EpiBf16Plain {
    static constexpr bool PERM = true;
    bf16* O; int ldc;
    __device__ __forceinline__ void operator()(const f32x4 (&acc)[2][2][4][2], const Unit& u, int wr, int wc, int fr, int fq) const {
        const int row0 = u.pm * BM + wr * 64 + fr, col0 = u.pn * BM + wc * 32 + 8 * fq;
#pragma unroll
        for (int ai = 0; ai < 2; ++ai)
#pragma unroll
            for (int m = 0; m < 4; ++m) { bf16* rowp = O + (size_t)(row0 + ai * HALF + m * 16) * ldc + col0;
#pragma unroll
                for (int bj = 0; bj < 2; ++bj) { const f32x4 v0 = acc[ai][bj][m][0], v1 = acc[ai][bj][m][1];
                    u32x4 w; w.x = cvt_pk_bf16(v0[0], v0[1]); w.y = cvt_pk_bf16(v0[2], v0[3]); w.z = cvt_pk_bf16(v1[0], v1[1]); w.w = cvt_pk_bf16(v1[2], v1[3]);
                    *(u32x4*)(rowp + bj * HALF) = w; } }
    }
};
struct EpiMlaUp {
    static constexpr bool PERM = true;
    bf16* Q; bf16* KK; bf16* V; const float* cs;
    __device__ __forceinline__ void operator()(const f32x4 (&acc)[2][2][4][2], const Unit& u, int wr, int wc, int fr, int fq) const {
        const int row0 = u.pm * BM + wr * 64 + fr;
#pragma unroll
        for (int bj = 0; bj < 2; ++bj) {
            const int c0 = u.pn * BM + bj * HALF + wc * 32 + 8 * fq;
            if (u.pn < 3) {
                const int h = c0 / QKD, d = c0 - h * QKD;
                const bool rope = d >= NOPE; const int i0 = rope ? (d - NOPE) >> 1 : 0;
#pragma unroll
                for (int ai = 0; ai < 2; ++ai)
#pragma unroll
                    for (int m = 0; m < 4; ++m) { const int row = row0 + ai * HALF + m * 16;
                        f32x4 v0 = acc[ai][bj][m][0], v1 = acc[ai][bj][m][1];
                        if (rope) { const f32x4 cA = *(const f32x4*)(cs + (size_t)row * 32 + i0 * 2), cB = *(const f32x4*)(cs + (size_t)row * 32 + i0 * 2 + 4);
                            const f32x4 a = v0, b = v1;
                            v0[0] = a[0] * cA[0] - a[1] * cA[1]; v0[1] = a[0] * cA[1] + a[1] * cA[0]; v0[2] = a[2] * cA[2] - a[3] * cA[3]; v0[3] = a[2] * cA[3] + a[3] * cA[2];
                            v1[0] = b[0] * cB[0] - b[1] * cB[1]; v1[1] = b[0] * cB[1] + b[1] * cB[0]; v1[2] = b[2] * cB[2] - b[3] * cB[3]; v1[3] = b[2] * cB[3] + b[3] * cB[2]; }
                        v0 = v0 * C2Q; v1 = v1 * C2Q;
                        u32x4 w; w.x = cvt_pk_bf16(v0[0], v0[1]); w.y = cvt_pk_bf16(v0[2], v0[3]); w.z = cvt_pk_bf16(v1[0], v1[1]); w.w = cvt_pk_bf16(v1[2], v1[3]);
                        *(u32x4*)(Q + (size_t)row * 768 + c0) = w; asm volatile("" ::: "memory"); }
            } else {
                bf16* base; int ld, cc;
                if (u.pn < 5) { const int c1 = c0 - 768; const int h = c1 >> 6, d = c1 & 63; base = KK; ld = 768; cc = h * QKD + d; }
                else { base = V; ld = 512; cc = c0 - 1280; }
#pragma unroll
                for (int ai = 0; ai < 2; ++ai)
#pragma unroll
                    for (int m = 0; m < 4; ++m) { const int row = row0 + ai * HALF + m * 16; const f32x4 v0 = acc[ai][bj][m][0], v1 = acc[ai][bj][m][1];
                        u32x4 w; w.x = cvt_pk_bf16(v0[0], v0[1]); w.y = cvt_pk_bf16(v0[2], v0[3]); w.z = cvt_pk_bf16(v1[0], v1[1]); w.w = cvt_pk_bf16(v1[2], v1[3]);
                        *(u32x4*)(base + (size_t)row * ld + cc) = w; asm volatile("" ::: "memory"); }
            }
        }
    }
};
struct EpiRwkvSmall {
    static constexpr bool PERM = false;
    float* O; const float* w0; const float* a0;
    __device__ __forceinline__ void operator()(const f32x4 (&acc)[2][2][4][2], const Unit& u, int wr, int wc, int fr, int fq) const {
        const int row0 = u.pm * BM + wr * 64 + fr, col0 = u.pn * BM + wc * 32 + 4 * fq;
        const int kind = u.pn >> 1;
#pragma unroll
        for (int bj = 0; bj < 2; ++bj)
#pragma unroll
            for (int n = 0; n < 2; ++n) { const int c = col0 + bj * HALF + n * 16;
                f32x4 bv = (f32x4){0.f, 0.f, 0.f, 0.f};
                if (kind == 0) bv = *(const f32x4*)(w0 + c); else if (kind == 1) bv = *(const f32x4*)(a0 + (c - 512));
#pragma unroll
                for (int ai = 0; ai < 2; ++ai)
#pragma unroll
                    for (int m = 0; m < 4; ++m) { f32x4 v = acc[ai][bj][m][n] + bv;
                        if (kind == 0) {
#pragma unroll
                            for (int j = 0; j < 4; ++j) { const float z = -v[j]; const float sp = fmaxf(z, 0.f) + __logf(1.0f + __expf(-fabsf(z))); const float w = -sp - 0.5f; v[j] = -__expf(w); }
                        } else if (kind == 1) {
#pragma unroll
                            for (int j = 0; j < 4; ++j) v[j] = sigmoidf_(v[j]);
                        }
                        *(f32x4*)(O + (size_t)(row0 + ai * HALF + m * 16) * N_SM + c) = v; asm volatile("" ::: "memory"); } }
    }
};
struct EpiVres {
    static constexpr bool PERM = true;
    const bf16* vs; const bf16* vf; bf16* vr; const float* v0;
    __device__ __forceinline__ void operator()(const f32x4 (&acc)[2][2][4][2], const Unit& u, int wr, int wc, int fr, int fq) const {
        const int row0 = u.pm * BM + wr * 64 + fr, col0 = u.pn * BM + wc * 32 + 8 * fq;
#pragma unroll
        for (int bj = 0; bj < 2; ++bj) { const int c = col0 + bj * HALF;
            const f32x4 b0 = *(const f32x4*)(v0 + c), b1 = *(const f32x4*)(v0 + c + 4);
#pragma unroll
            for (int ai = 0; ai < 2; ++ai)
#pragma unroll
                for (int m = 0; m < 4; ++m) { const size_t off = (size_t)(row0 + ai * HALF + m * 16) * C5 + c;
                    const u32x4 s = *(const u32x4*)(vs + off), f = *(const u32x4*)(vf + off);
                    const f32x4 g0 = acc[ai][bj][m][0] + b0, g1 = acc[ai][bj][m][1] + b1;
                    float o[8];
#pragma unroll
                    for (int j = 0; j < 4; ++j) { const float sl = bflo(s[j]), sh = bfhi(s[j]), fl = bflo(f[j]), fh = bfhi(f[j]);
                        const float ga = (j < 2) ? g0[2 * j] : g1[2 * j - 4], gb = (j < 2) ? g0[2 * j + 1] : g1[2 * j - 3];
                        o[2 * j] = sl + (fl - sl) * sigmoidf_(ga); o[2 * j + 1] = sh + (fh - sh) * sigmoidf_(gb); }
                    u32x4 w; w.x = cvt_pk_bf16(o[0], o[1]); w.y = cvt_pk_bf16(o[2], o[3]); w.z = cvt_pk_bf16(o[4], o[5]); w.w = cvt_pk_bf16(o[6], o[7]);
                    *(u32x4*)(vr + off) = w; } }
    }
};
struct EpiWo {
    static constexpr bool PERM = true;
    bf16* X; const float* gt;
    __device__ __forceinline__ void operator()(const f32x4 (&acc)[2][2][4][2], const Unit& u, int wr, int wc, int fr, int fq) const {
        const int row0 = u.pm * BM + wr * 64 + fr, col0 = u.pn * BM + wc * 32 + 8 * fq;
        const int b = (u.pm * BM) / SEQ;
#pragma unroll
        for (int bj = 0; bj < 2; ++bj) { const int c = col0 + bj * HALF;
            const f32x4 g0 = *(const f32x4*)(gt + (size_t)b * 6144 + c) + 1.0f, g1 = *(const f32x4*)(gt + (size_t)b * 6144 + c + 4) + 1.0f;
#pragma unroll
            for (int ai = 0; ai < 2; ++ai)
#pragma unroll
                for (int m = 0; m < 4; ++m) { bf16* px = X + (size_t)(row0 + ai * HALF + m * 16) * D + c; const u32x4 xw = *(const u32x4*)px;
                    const f32x4 a0 = acc[ai][bj][m][0], a1 = acc[ai][bj][m][1];
                    u32x4 w; w.x = cvt_pk_bf16(bflo(xw.x) * DN_ALPHA + g0[0] * a0[0], bfhi(xw.x) * DN_ALPHA + g0[1] * a0[1]); w.y = cvt_pk_bf16(bflo(xw.y) * DN_ALPHA + g0[2] * a0[2], bfhi(xw.y) * DN_ALPHA + g0[3] * a0[3]);
                    w.z = cvt_pk_bf16(bflo(xw.z) * DN_ALPHA + g1[0] * a1[0], bfhi(xw.z) * DN_ALPHA + g1[1] * a1[1]); w.w = cvt_pk_bf16(bflo(xw.w) * DN_ALPHA + g1[2] * a1[2], bfhi(xw.w) * DN_ALPHA + g1[3] * a1[3]);
                    *(u32x4*)px = w; } }
    }
};
struct EpiSwiglu {
    static constexpr bool PERM = true;
    bf16* O; const float* b1p;
    __device__ __forceinline__ void operator()(const f32x4 (&acc)[2][2][4][2], const Unit& u, int wr, int wc, int fr, int fq) const {
        const int row0 = u.pm * BM + wr * 64 + fr; const int cin = u.pn * BM + wc * 32 + 8 * fq, cout = u.pn * HALF + wc * 32 + 8 * fq;
        const float* bp = b1p + (size_t)u.e * 2048 + cin;
        const f32x4 bg0 = *(const f32x4*)(bp), bg1 = *(const f32x4*)(bp + 4), bl0 = *(const f32x4*)(bp + HALF), bl1 = *(const f32x4*)(bp + HALF + 4);
#pragma unroll
        for (int ai = 0; ai < 2; ++ai)
#pragma unroll
            for (int m = 0; m < 4; ++m) {
                const f32x4 g0 = acc[ai][0][m][0] + bg0, g1 = acc[ai][0][m][1] + bg1, l0 = acc[ai][1][m][0] + bl0, l1 = acc[ai][1][m][1] + bl1;
                float o[8];
#pragma unroll
                for (int j = 0; j < 8; ++j) { const float gv = fminf(j < 4 ? g0[j & 3] : g1[j & 3], 7.0f); const float lv = fminf(fmaxf(j < 4 ? l0[j & 3] : l1[j & 3], -7.0f), 7.0f);
                    o[j] = gv * sigmoidf_(1.702f * gv) * (lv + 1.0f); }
                u32x4 w; w.x = cvt_pk_bf16(o[0], o[1]); w.y = cvt_pk_bf16(o[2], o[3]); w.z = cvt_pk_bf16(o[4], o[5]); w.w = cvt_pk_bf16(o[6], o[7]);
                *(u32x4*)(O + (size_t)(row0 + ai * HALF + m * 16) * FF + cout) = w; }
    }
};
struct EpiMoeOut {
    static constexpr bool PERM = true;
    bf16* O; const float* b2; const float* gatel; const LAS int* tb;
    __device__ __forceinline__ void operator()(const f32x4 (&acc)[2][2][4][2], const Unit& u, int wr, int wc, int fr, int fq) const {
        const int row0 = u.pm * BM + wr * 64 + fr, col0 = u.pn * BM + wc * 32 + 8 * fq;
        const int pos0 = (u.pm - tb[u.e]) * BM + wr * 64 + fr;
        const float* bp = b2 + (size_t)u.e * D + col0;
        f32x4 bv[2][2];
#pragma unroll
        for (int bj = 0; bj < 2; ++bj) { bv[bj][0] = *(const f32x4*)(bp + bj * HALF); bv[bj][1] = *(const f32x4*)(bp + bj * HALF + 4); }
#pragma unroll
        for (int ai = 0; ai < 2; ++ai)
#pragma unroll
            for (int m = 0; m < 4; ++m) { const float gt = gatel[(size_t)u.e * CAP + pos0 + ai * HALF + m * 16];
                bf16* rowp = O + (size_t)(row0 + ai * HALF + m * 16) * D + col0;
#pragma unroll
                for (int bj = 0; bj < 2; ++bj) { const f32x4 v0 = (acc[ai][bj][m][0] + bv[bj][0]) * gt, v1 = (acc[ai][bj][m][1] + bv[bj][1]) * gt;
                    u32x4 w; w.x = cvt_pk_bf16(v0[0], v0[1]); w.y = cvt_pk_bf16(v0[2], v0[3]); w.z = cvt_pk_bf16(v1[0], v1[1]); w.w = cvt_pk_bf16(v1[2], v1[3]);
                    *(u32x4*)(rowp + bj * HALF) = w; } }
    }
};
}

struct Params { const void* in[N_INPUTS]; float* out; unsigned char* ws; int ph_lo, ph_hi; };

struct Frame {
    LAS unsigned char* lds;
    int tid, lane, wave, G, vcu;
    unsigned char* ws;
};
#define WSP(type, off) ((type*)(F.ws + (off)))
#define INP(i) ((const float*)p.in[i])

__device__ const double INV_FREQ[16] = {1.00000000000000000e+00, 5.62341325190349073e-01, 3.16227766016837941e-01, 1.77827941003892293e-01, 1.00000000000000006e-01, 5.62341325190349114e-02,
    3.16227766016837913e-02, 1.77827941003892293e-02, 1.00000000000000002e-02, 5.62341325190349097e-03, 3.16227766016837939e-03, 1.77827941003892275e-03, 1.00000000000000002e-03,
    5.62341325190349097e-04, 3.16227766016837939e-04, 1.77827941003892270e-04};

template <int MODE>
__device__ __forceinline__ void tr_item(const float* W, int ldn, bf16* WT, int ldk, int kofs, int rofs, int k0, int n0, LAS float* scr, int lane) {
    f32x4 ld[8];
#pragma unroll
    for (int i = 0; i < 8; ++i) ld[i] = *(const f32x4*)(W + (size_t)(k0 + 8 * i + (lane >> 3)) * ldn + n0 + 4 * (lane & 7));
#pragma unroll
    for (int i = 0; i < 8; ++i) { LAS float* d = scr + (8 * i + (lane >> 3)) * 33 + 4 * (lane & 7); d[0] = ld[i].x; d[1] = ld[i].y; d[2] = ld[i].z; d[3] = ld[i].w; }
    LDS_WAIT(); asm volatile("" ::: "memory");
    const int c = lane & 7;
#pragma unroll
    for (int j = 0; j < 4; ++j) { const int n = (lane >> 3) + 8 * j; const LAS float* s = scr + (8 * c) * 33 + n;
        u32x4 o; o.x = pk2(s[0 * 33], s[1 * 33]); o.y = pk2(s[2 * 33], s[3 * 33]); o.z = pk2(s[4 * 33], s[5 * 33]); o.w = pk2(s[6 * 33], s[7 * 33]);
        const int ng = n0 + n; int row;
        if (MODE == 0) row = rofs + ng; else { const int jo = ng >> 1, bj = ng & 1; row = rofs + (jo >> 7) * 256 + bj * 128 + (jo & 127); }
        *(GAS u32x4*)(WT + (size_t)row * ldk + kofs + k0 + 8 * c) = o; }
    LDS_WAIT(); asm volatile("" ::: "memory");
}
__device__ __forceinline__ void zero_rect(const Frame& F, bf16* M, int ld, int r0, int nrows, int c0, int ncols) {
    const int gw = F.vcu * NWAVES + F.wave, NGW = F.G * NWAVES; const int nch = ncols / 8;
    for (int r = gw; r < nrows; r += NGW)
        for (int ch = F.lane; ch < nch; ch += 64) *(GAS u32x4*)(M + (size_t)(r0 + r) * ld + c0 + ch * 8) = (u32x4){0u, 0u, 0u, 0u};
}
__device__ __forceinline__ void phase_prologue(const Params& p, const Frame& F) {
    LAS float* scr = (LAS float*)(F.lds + F.wave * 16384);
    const int gw = F.vcu * NWAVES + F.wave, NGW = F.G * NWAVES;
    constexpr int I_IN = 16 * 69, I_UQ = 4 * 24, I_UK = 2 * 16, I_W2s = 16, I_G2s = 2 * 16, I_WO_ = 16 * 32, I_E1 = 16 * 64, I_E2 = 16 * 32;
    constexpr int PER_L = I_IN + I_UQ + 2 * I_UK + 2 * I_W2s + I_G2s + I_WO_;
    constexpr int NSMALL = DEPTH * PER_L;
    for (int it = gw; it < NSMALL; it += NGW) {
        int r = it;
        {
            const int l = r / PER_L; r -= l * PER_L;
            if (r < I_IN) { tr_item<0>(INP(I_WIN) + (size_t)l * D * N_IN, N_IN, WSP(bf16, WS_WINT) + (size_t)l * N_INP * D, D, 0, 0, 64 * (r / 69), 32 * (r % 69), scr, F.lane); continue; } r -= I_IN;
            bf16* up = WSP(bf16, WS_WUPT) + (size_t)l * N_UP * K_UP;
            if (r < I_UQ) { tr_item<0>(INP(I_WUQ) + (size_t)l * QLR * 768, 768, up, K_UP, 0, 0, 64 * (r / 24), 32 * (r % 24), scr, F.lane); continue; } r -= I_UQ;
            if (r < I_UK) { tr_item<0>(INP(I_WUK) + (size_t)l * KVLR * 512, 512, up, K_UP, 256, 768, 64 * (r / 16), 32 * (r % 16), scr, F.lane); continue; } r -= I_UK;
            if (r < I_UK) { tr_item<0>(INP(I_WUV) + (size_t)l * KVLR * 512, 512, up, K_UP, 256, 1280, 64 * (r / 16), 32 * (r % 16), scr, F.lane); continue; } r -= I_UK;
            bf16* sm = WSP(bf16, WS_WSMT) + (size_t)l * N_SM * K_SM;
            if (r < I_W2s) { tr_item<0>(INP(I_W2) + (size_t)l * 64 * 512, 512, sm, K_SM, 0, 0, 0, 32 * r, scr, F.lane); continue; } r -= I_W2s;
            if (r < I_W2s) { tr_item<0>(INP(I_A2) + (size_t)l * 64 * 512, 512, sm, K_SM, 64, 512, 0, 32 * r, scr, F.lane); continue; } r -= I_W2s;
            if (r < I_G2s) { tr_item<0>(INP(I_G2) + (size_t)l * 128 * 512, 512, sm, K_SM, 128, 1024, 64 * (r / 16), 32 * (r % 16), scr, F.lane); continue; } r -= I_G2s;
            tr_item<0>(INP(I_WO) + (size_t)l * D * D, D, WSP(bf16, WS_WOT) + (size_t)l * D * D, D, 0, 0, 64 * (r / 32), 32 * (r % 32), scr, F.lane); continue;
        }
    }
    for (int l = 0; l < DEPTH; ++l) {
        zero_rect(F, WSP(bf16, WS_WINT) + (size_t)l * N_INP * D, D, N_IN, N_INP - N_IN, 0, D);
        bf16* up = WSP(bf16, WS_WUPT) + (size_t)l * N_UP * K_UP;
        zero_rect(F, up, K_UP, 0, 768, 256, 128); zero_rect(F, up, K_UP, 768, 1024, 0, 256);
        bf16* sm = WSP(bf16, WS_WSMT) + (size_t)l * N_SM * K_SM;
        zero_rect(F, sm, K_SM, 0, 512, 64, 192); zero_rect(F, sm, K_SM, 512, 512, 0, 64); zero_rect(F, sm, K_SM, 512, 512, 128, 128); zero_rect(F, sm, K_SM, 1024, 512, 0, 128);
    }
    const int gt = (F.vcu * NTHREADS) + F.tid, NGT = F.G * NTHREADS;
    { const float* v1 = INP(I_V1); const float* v2 = INP(I_V2); bf16* o = WSP(bf16, WS_WV12T);
      for (int i = gt; i < 512 * 512; i += NGT) { const int n = i >> 9, k = i & 511; float s = 0.f;
#pragma unroll 8
          for (int j = 0; j < 32; ++j) s += v1[k * 32 + j] * v2[j * 512 + n];
          o[i] = (bf16)f2bf(s); } }
    { const float* b1 = INP(I_EB1); float* o = WSP(float, WS_B1P);
      for (int i = gt; i < DEPTH * NE * 2048; i += NGT) { const int q = i & 2047, le = i >> 11; const int pn = q >> 8, bj = (q >> 7) & 1, jj = q & 127; o[i] = b1[(size_t)le * 2048 + 2 * (pn * 128 + jj) + bj]; } }
    { bf16* pg = WSP(bf16, WS_PGW);
      for (int i = gt; i < DEPTH * PGW_NFRAG * 64; i += NGT) { const int ln = i & 63, fi = (i >> 6) % PGW_NFRAG, l2 = (i >> 6) / PGW_NFRAG; const int rr = ln & 31, hh = ln >> 5;
          const float* W; int ldw, KS, f0; bool v12 = false;
          if (fi < PGW_KN) { W = INP(I_WUQ) + (size_t)l2 * QLR * 768; ldw = 768; KS = 16; f0 = PGW_Q; }
          else if (fi < PGW_V) { W = INP(I_WUK) + (size_t)l2 * KVLR * 512; ldw = 512; KS = 8; f0 = PGW_KN; }
          else if (fi < PGW_W) { W = INP(I_WUV) + (size_t)l2 * KVLR * 512; ldw = 512; KS = 8; f0 = PGW_V; }
          else if (fi < PGW_A) { W = INP(I_W2) + (size_t)l2 * 64 * 512; ldw = 512; KS = 4; f0 = PGW_W; }
          else if (fi < PGW_G) { W = INP(I_A2) + (size_t)l2 * 64 * 512; ldw = 512; KS = 4; f0 = PGW_A; }
          else if (fi < PGW_VR) { W = INP(I_G2) + (size_t)l2 * 128 * 512; ldw = 512; KS = 8; f0 = PGW_G; }
          else { W = nullptr; ldw = 512; KS = 32; f0 = PGW_VR; v12 = true; }
          const int nb = (fi - f0) / KS, ks = (fi - f0) % KS, n = 32 * nb + rr, k0 = 16 * ks + 8 * hh;
          float v[8];
          if (!v12) {
#pragma unroll
              for (int j = 0; j < 8; ++j) v[j] = W[(size_t)(k0 + j) * ldw + n]; }
          else { const float* v1 = INP(I_V1); const float* v2 = INP(I_V2);
#pragma unroll
              for (int j = 0; j < 8; ++j) { float sacc = 0.f;
#pragma unroll 8
                  for (int q = 0; q < 32; ++q) sacc += v1[(k0 + j) * 32 + q] * v2[q * 512 + n];
                  v[j] = (l2 == 0) ? 0.f : sacc; } }
          u32x4 o; o.x = pk2(v[0], v[1]); o.y = pk2(v[2], v[3]); o.z = pk2(v[4], v[5]); o.w = pk2(v[6], v[7]);
          *(u32x4*)(pg + (size_t)i * 8) = o; } }
    { const float* rw = INP(I_RW); bf16* o = WSP(bf16, WS_RWT);
      for (int i = gt; i < DEPTH * NE * D; i += NGT) { const int k = i & 1023, e = (i >> 10) & 31, l2 = i >> 15; const float v = rw[((size_t)l2 * D + k) * NE + e]; const unsigned hi = f2bf(v); const float lo = v - bf2f(hi);
          o[i] = (bf16)hi; o[DEPTH * NE * D + i] = (bf16)f2bf(lo); } }
    { const int* pos = (const int*)p.in[I_POS]; float* cs = WSP(float, WS_CS);
      for (int i = gt; i < T * 16; i += NGT) { const int t = i >> 4, k = i & 15; const double a = (double)pos[t] * INV_FREQ[k];
          const double q = __builtin_rint(a * 0.63661977236758134308); const int qi = (int)((long long)q & 3);
          double r = __builtin_fma(-q, 1.57079632679489655800e+00, a); r = __builtin_fma(-q, 6.12323399573676603587e-17, r);
          const double r2 = r * r;
          double sn = -2.50521083854417187751e-08; sn = sn * r2 + 2.75573192239858906526e-06; sn = sn * r2 - 1.98412698412698412698e-04; sn = sn * r2 + 8.33333333333333333333e-03; sn = sn * r2 - 1.66666666666666666667e-01; sn = r + r * r2 * sn;
          double cn = 2.08767569878680989792e-09; cn = cn * r2 - 2.75573192239858906526e-07; cn = cn * r2 + 2.48015873015873015873e-05; cn = cn * r2 - 1.38888888888888888889e-03; cn = cn * r2 + 4.16666666666666666667e-02; cn = cn * r2 - 0.5; cn = 1.0 + r2 * cn;
          double sv, cv;
          if (qi == 0) { sv = sn; cv = cn; } else if (qi == 1) { sv = cn; cv = -sn; } else if (qi == 2) { sv = -sn; cv = -cn; } else { sv = -cn; cv = sn; }
          cs[2 * i] = (float)cv; cs[2 * i + 1] = (float)sv; } }
    { LAS float* cact = (LAS float*)(F.lds);
      LAS float* part = (LAS float*)(F.lds + 32768);
      __syncthreads();
      const float* c = INP(I_C);
      for (int i = F.tid; i < NBATCH * D; i += NTHREADS) { const float v = c[i]; cact[i] = v / (1.0f + __expf(-v)); }
      __syncthreads();
      for (int item = F.vcu; item < DEPTH * 96; item += F.G) { const int l = item / 96, n0 = (item % 96) * 64;
          const float* aw = INP(I_ADAW) + (size_t)l * D * 6144 + n0 + F.lane;
          float a8[8];
#pragma unroll
          for (int b = 0; b < 8; ++b) a8[b] = 0.f;
          const int kb = F.wave * 128;
#pragma unroll 4
          for (int k = 0; k < 128; ++k) { const float wv = aw[(size_t)(kb + k) * 6144];
#pragma unroll
              for (int b = 0; b < 8; ++b) a8[b] += cact[b * D + kb + k] * wv; }
#pragma unroll
          for (int b = 0; b < 8; ++b) part[(F.wave * 8 + b) * 64 + F.lane] = a8[b];
          __syncthreads();
          { const int b = F.wave; float s = 0.f;
#pragma unroll
            for (int w = 0; w < 8; ++w) s += part[(w * 8 + b) * 64 + F.lane];
            WSP(float, WS_MOD)[((size_t)l * NBATCH + b) * 6144 + n0 + F.lane] = s + INP(I_ADAB)[(size_t)l * 6144 + n0 + F.lane]; }
          __syncthreads(); }
    }
}

__device__ __forceinline__ void phase_convert_experts(const Params& p, const Frame& F, int c0, int nc) {
    LAS float* scr = (LAS float*)(F.lds + F.wave * 16384);
    constexpr int I_E1 = 16 * 64, I_E2 = 16 * 32, NE1 = DEPTH * NE * I_E1, NE2 = DEPTH * NE * I_E2;
    const int gw = (F.vcu - c0) * NWAVES + F.wave, NGW = nc * NWAVES; const int lane = F.lane;
    __syncthreads();
    f32x4 ld[8];
#define CV_SRC(it, W_, ldn_, k0_, n0_) do { int r_ = (it); if (r_ < NE1) { const int le_ = r_ / I_E1; r_ -= le_ * I_E1; W_ = INP(I_EW1) + (size_t)le_ * D * 2048; ldn_ = 2048; k0_ = 64 * (r_ / 64); n0_ = 32 * (r_ % 64); } \
        else { r_ -= NE1; const int le_ = r_ / I_E2; r_ -= le_ * I_E2; W_ = INP(I_EW2) + (size_t)le_ * FF * D; ldn_ = D; k0_ = 64 * (r_ / 32); n0_ = 32 * (r_ % 32); } } while (0)
#define CV_LOAD(it) do { const float* W_; int ldn_, k0_, n0_; CV_SRC(it, W_, ldn_, k0_, n0_); \
        _Pragma("unroll") for (int i = 0; i < 8; ++i) ld[i] = *(const f32x4*)(W_ + (size_t)(k0_ + 8 * i + (lane >> 3)) * ldn_ + n0_ + 4 * (lane & 7)); } while (0)
    int it = gw;
    if (it < NE1 + NE2) CV_LOAD(it);
    for (; it < NE1 + NE2; it += NGW) {
#pragma unroll
        for (int i = 0; i < 8; ++i) { LAS float* d = scr + (8 * i + (lane >> 3)) * 33 + 4 * (lane & 7); d[0] = ld[i].x; d[1] = ld[i].y; d[2] = ld[i].z; d[3] = ld[i].w; }
        if (it + NGW < NE1 + NE2) CV_LOAD(it + NGW);
        LDS_WAIT(); asm volatile("" ::: "memory");
        int r = it; bf16* WT; int ldk, k0, n0; bool perm;
        if (r < NE1) { const int le = r / I_E1; r -= le * I_E1; WT = WSP(bf16, WS_W1T) + (size_t)le * 2048 * D; ldk = D; k0 = 64 * (r / 64); n0 = 32 * (r % 64); perm = true; }
        else { r -= NE1; const int le = r / I_E2; r -= le * I_E2; WT = WSP(bf16, WS_W2T) + (size_t)le * D * FF; ldk = FF; k0 = 64 * (r / 32); n0 = 32 * (r % 32); perm = false; }
        const int c = lane & 7;
#pragma unroll
        for (int j = 0; j < 4; ++j) { const int n = (lane >> 3) + 8 * j; const LAS float* sp = scr + (8 * c) * 33 + n;
            u32x4 o; o.x = pk2(sp[0 * 33], sp[1 * 33]); o.y = pk2(sp[2 * 33], sp[3 * 33]); o.z = pk2(sp[4 * 33], sp[5 * 33]); o.w = pk2(sp[6 * 33], sp[7 * 33]);
            const int ng = n0 + n; int row = ng;
            if (perm) { const int jo = ng >> 1, bj = ng & 1; row = (jo >> 7) * 256 + bj * 128 + (jo & 127); }
            *(GAS u32x4*)(WT + (size_t)row * ldk + k0 + 8 * c) = o; }
        LDS_WAIT(); asm volatile("" ::: "memory");
    }
#undef CV_LOAD
#undef CV_SRC
    __syncthreads();
}

__device__ __forceinline__ void phase_ln0(const Params& p, const Frame& F) {
    const int gw = F.vcu * NWAVES + F.wave, NGW = F.G * NWAVES;
    const float* mod = WSP(float, WS_MOD);
#pragma unroll 2
    for (int m = gw; m < T; m += NGW) {
        const int b = m / SEQ;
        const GAS f32x4* xr = (const GAS f32x4*)(INP(I_X) + (size_t)m * D) + F.lane;
        f32x4 v[4]; float s = 0.f;
#pragma unroll
        for (int j = 0; j < 4; ++j) { v[j] = xr[64 * j]; s += (v[j].x + v[j].y) + (v[j].z + v[j].w); }
        const float mean = wave_sum(s) * (1.f / D); float s2 = 0.f;
#pragma unroll
        for (int j = 0; j < 4; ++j) { v[j] = v[j] - mean; s2 += (v[j].x * v[j].x + v[j].y * v[j].y) + (v[j].z * v[j].z + v[j].w * v[j].w); }
        const float rstd = 1.f / sqrtf(wave_sum(s2) * (1.f / D) + LN_EPS);
        GAS u32x2* xo = (GAS u32x2*)(WSP(bf16, WS_X) + (size_t)m * D) + F.lane;
        GAS u32x2* ho = (GAS u32x2*)(WSP(bf16, WS_H) + (size_t)m * D) + F.lane;
#pragma unroll
        for (int j = 0; j < 4; ++j) { const int c = 4 * F.lane + 256 * j;
            const f32x4 g = *(const f32x4*)(INP(I_ELNG) + c), be = *(const f32x4*)(INP(I_ELNB) + c);
            const f32x4 x0 = v[j] * rstd * g + be; { u32x2 xw; xw.x = pk2(x0.x, x0.y); xw.y = pk2(x0.z, x0.w); xo[64 * j] = xw; }
            const f32x4 sh = *(const f32x4*)(mod + (size_t)b * 6144 + c), sc = *(const f32x4*)(mod + (size_t)b * 6144 + 1024 + c);
            const f32x4 h = x0 * (sc + 1.0f) + sh; u32x2 w; w.x = pk2(h.x, h.y); w.y = pk2(h.z, h.w); ho[64 * j] = w; }
    }
}

__device__ __forceinline__ void phase_prep(const Params& p, const Frame& F, int l) {
    const int gw = F.vcu * NWAVES + F.wave, NGW = F.G * NWAVES; const int lane = F.lane;
    const bf16* P = WSP(bf16, WS_P); const float* mu = INP(I_MU) + (size_t)l * RWKV_IN;
    const float* qg = INP(I_QNG) + (size_t)l * QLR; const float* kvg = INP(I_KVNG) + (size_t)l * KVLR;
    bf16* AN = WSP(bf16, WS_AN); bf16* A2 = WSP(bf16, WS_A2); bf16* RK = WSP(bf16, WS_RK); bf16* KKb = WSP(bf16, WS_KK);
    bf16* VS = l == 0 ? WSP(bf16, WS_VS0) : WSP(bf16, WS_VS1);
    const float* cs = WSP(float, WS_CS);
    const int RPW = (T + NGW - 1) / NGW; const int t0 = gw * RPW; const int t1 = (t0 + RPW < T) ? t0 + RPW : T;
    f32x4 mu0[3], mu1[3];
#pragma unroll
    for (int part = 0; part < 3; ++part) { mu0[part] = *(const f32x4*)(mu + part * 512 + 8 * lane); mu1[part] = *(const f32x4*)(mu + part * 512 + 8 * lane + 4); }
    const float mu_wd = mu[1536 + lane], mu_ad = mu[1600 + lane]; const f32x2 mu_gd = *(const f32x2*)(mu + 1664 + 2 * lane);
    const f32x4 gq = *(const f32x4*)(qg + 4 * lane); const f32x2 gkv = *(const f32x2*)(kvg + 2 * lane);
    u32x4 pw[3]; pw[0] = pw[1] = pw[2] = (u32x4){0u, 0u, 0u, 0u}; float p_wd = 0.f, p_ad = 0.f; unsigned p_gd = 0u;
    if (t0 < t1 && (t0 % SEQ) != 0) { const bf16* rp = P + (size_t)(t0 - 1) * N_INP + MLA_IN;
#pragma unroll
        for (int part = 0; part < 3; ++part) pw[part] = *(const u32x4*)(rp + part * 512 + 8 * lane);
        p_wd = bf2f(rp[1536 + lane]); p_ad = bf2f(rp[1600 + lane]); p_gd = *(const unsigned*)(rp + 1664 + 2 * lane); }
#pragma unroll 2
    for (int t = t0; t < t1; ++t) {
        const bf16* pr = P + (size_t)t * N_INP;
        if ((t % SEQ) == 0) { pw[0] = pw[1] = pw[2] = (u32x4){0u, 0u, 0u, 0u}; p_wd = 0.f; p_ad = 0.f; p_gd = 0u; }
        { const u32x2 qw = *(const u32x2*)(pr + 4 * lane); float q0 = bflo(qw.x), q1 = bfhi(qw.x), q2 = bflo(qw.y), q3 = bfhi(qw.y);
          const float rq = __builtin_amdgcn_rsqf(wave_sum(q0 * q0 + q1 * q1 + q2 * q2 + q3 * q3) * (1.f / QLR) + RMS_EPS);
          u32x2 w; w.x = pk2(q0 * rq * gq.x, q1 * rq * gq.y); w.y = pk2(q2 * rq * gq.z, q3 * rq * gq.w); *(u32x2*)(AN + (size_t)t * K_UP + 4 * lane) = w;
          const unsigned kw = *(const unsigned*)(pr + QLR + 2 * lane); const float k0 = bflo(kw), k1 = bfhi(kw);
          const float rk = __builtin_amdgcn_rsqf(wave_sum(k0 * k0 + k1 * k1) * (1.f / KVLR) + RMS_EPS);
          *(unsigned*)(AN + (size_t)t * K_UP + QLR + 2 * lane) = pk2(k0 * rk * gkv.x, k1 * rk * gkv.y);
          const int i = lane & 15; const unsigned rw = *(const unsigned*)(pr + QLR + KVLR + 2 * i); const float x0 = bflo(rw), x1 = bfhi(rw);
          const f32x2 csv = *(const f32x2*)(cs + (size_t)t * 32 + 2 * i); const unsigned ro = pk2(x0 * csv.x - x1 * csv.y, x0 * csv.y + x1 * csv.x);
          const int h0 = (lane >> 4) * 2;
          *(unsigned*)(KKb + (size_t)t * 768 + h0 * QKD + NOPE + 2 * i) = ro; *(unsigned*)(KKb + (size_t)t * 768 + (h0 + 1) * QKD + NOPE + 2 * i) = ro; }
        const bf16* rr = pr + MLA_IN;
#pragma unroll
        for (int part = 0; part < 3; ++part) {
            const u32x4 cw = *(const u32x4*)(rr + part * 512 + 8 * lane); const u32x4 pv_ = pw[part]; pw[part] = cw;
            float o[8];
#pragma unroll
            for (int j = 0; j < 4; ++j) { const float a = bflo(cw[j]), b = bfhi(cw[j]), pa = bflo(pv_[j]), pb = bfhi(pv_[j]); const float ma = j < 2 ? mu0[part][2 * j] : mu1[part][2 * j - 4], mb = j < 2 ? mu0[part][2 * j + 1] : mu1[part][2 * j - 3];
                o[2 * j] = a + ma * (pa - a); o[2 * j + 1] = b + mb * (pb - b); }
            u32x4 w; w.x = pk2(o[0], o[1]); w.y = pk2(o[2], o[3]); w.z = pk2(o[4], o[5]); w.w = pk2(o[6], o[7]);
            if (part < 2) *(u32x4*)(RK + (size_t)t * 1024 + part * 512 + 8 * lane) = w; else *(u32x4*)(VS + (size_t)t * C5 + 8 * lane) = w;
        }
        { const float a = bf2f(rr[1536 + lane]); const float v = a + mu_wd * (p_wd - a); p_wd = a; A2[(size_t)t * K_SM + lane] = (bf16)f2bf(tanhf_(v)); }
        { const float a = bf2f(rr[1600 + lane]); const float v = a + mu_ad * (p_ad - a); p_ad = a; A2[(size_t)t * K_SM + 64 + lane] = (bf16)f2bf(v); }
        { const unsigned cw = *(const unsigned*)(rr + 1664 + 2 * lane); const float a = bflo(cw), b = bfhi(cw); const float va = a + mu_gd.x * (bflo(p_gd) - a), vb = b + mu_gd.y * (bfhi(p_gd) - b); p_gd = cw;
          *(unsigned*)(A2 + (size_t)t * K_SM + 128 + 2 * lane) = pk2(sigmoidf_(va), sigmoidf_(vb)); }
    }
}

namespace pgm {
constexpr int RP = 64, LDA_AN = 784, LDA_A2 = 528, LDA_VS = 1040, OFF_A2 = RP * LDA_AN, OFF_VS = 0;
__device__ __forceinline__ int crow(int r, int hi) { return (r & 3) + 8 * (r >> 2) + 4 * hi; }
template <int KSTEPS>
__device__ __forceinline__ void block_mma(f32x16 (&acc)[2], const LAS unsigned char* A, int lda, const bf16* Bt, int ldb, int nrow0, int kofs, int r, int h) {
    const bf16* bp = Bt + (size_t)(nrow0 + r) * ldb + kofs + 8 * h;
    const LAS unsigned char* a0 = A + r * lda + (kofs + 8 * h) * 2; const LAS unsigned char* a1 = a0 + 32 * lda;
    bf16x8 cur[4], nxt[4];
#pragma unroll
    for (int j = 0; j < 4; ++j) cur[j] = *(const bf16x8*)(bp + 16 * j);
#pragma unroll
    for (int g = 0; g < KSTEPS / 4; ++g) {
        if (g + 1 < KSTEPS / 4) {
#pragma unroll
            for (int j = 0; j < 4; ++j) nxt[j] = *(const bf16x8*)(bp + 16 * (4 * g + 4 + j)); }
#pragma unroll
        for (int j = 0; j < 4; ++j) { const int ks = 4 * g + j; const bf16x8 x0 = *(const LAS bf16x8*)(a0 + ks * 32), x1 = *(const LAS bf16x8*)(a1 + ks * 32);
            acc[0] = __builtin_amdgcn_mfma_f32_32x32x16_bf16(cur[j], x0, acc[0], 0, 0, 0); acc[1] = __builtin_amdgcn_mfma_f32_32x32x16_bf16(cur[j], x1, acc[1], 0, 0, 0); }
        asm volatile("" ::: "memory");
#pragma unroll
        for (int j = 0; j < 4; ++j) cur[j] = nxt[j];
    }
}
template <int KSTEPS>
__device__ __forceinline__ void load_frags(bf16x8 (&fr)[KSTEPS], const bf16* pg, int frag0, int lane) {
    const bf16* bp = pg + ((size_t)frag0 * 64 + lane) * 8;
#pragma unroll
    for (int ks = 0; ks < KSTEPS; ++ks) fr[ks] = *(const bf16x8*)(bp + (size_t)ks * 512);
}
template <int KSTEPS>
__device__ __forceinline__ void mma_frags(f32x16 (&acc)[2], const LAS unsigned char* A, int lda, int kofs, const bf16x8 (&fr)[KSTEPS], int r, int h) {
    const LAS unsigned char* a0 = A + r * lda + (kofs + 8 * h) * 2; const LAS unsigned char* a1 = a0 + 32 * lda;
#pragma unroll
    for (int ks = 0; ks < KSTEPS; ++ks) { const bf16x8 x0 = *(const LAS bf16x8*)(a0 + ks * 32), x1 = *(const LAS bf16x8*)(a1 + ks * 32);
        acc[0] = __builtin_amdgcn_mfma_f32_32x32x16_bf16(fr[ks], x0, acc[0], 0, 0, 0); acc[1] = __builtin_amdgcn_mfma_f32_32x32x16_bf16(fr[ks], x1, acc[1], 0, 0, 0); }
}
constexpr int STG_LD = 80, STG_BYTES = RP * STG_LD, OFF_STG = RP * LDA_AN + RP * LDA_A2;
__device__ __forceinline__ void stage_put4(LAS unsigned char* stg, int mt, int g, int r, int h, float v0, float v1, float v2, float v3) {
    u32x2 w; w.x = cvtpk_c(v0, v1); w.y = cvtpk_c(v2, v3); *(LAS u32x2*)(stg + (32 * mt + r) * STG_LD + (8 * g + 4 * h) * 2) = w; }
__device__ __forceinline__ void stage_flush(const LAS unsigned char* stg, bf16* dst, int ldd, int lane) {
#pragma unroll
    for (int j = 0; j < 4; ++j) { const int row = 16 * j + (lane >> 2), ch = lane & 3; const u32x4 v = *(const LAS u32x4*)(stg + row * STG_LD + ch * 16); *(u32x4*)(dst + (size_t)row * ldd + 8 * ch) = v; }
}
}

__device__ __forceinline__ void phase_pgemm(const Params& p, const Frame& F, int l) {
    using namespace pgm;
    const int lane0 = F.lane, wave = F.wave;
    const bf16* P = WSP(bf16, WS_P); const float* mu = INP(I_MU) + (size_t)l * RWKV_IN;
    const float* qg = INP(I_QNG) + (size_t)l * QLR; const float* kvg = INP(I_KVNG) + (size_t)l * KVLR;
    bf16* RK = WSP(bf16, WS_RK); bf16* KKb = WSP(bf16, WS_KK); bf16* Qb = WSP(bf16, WS_Q); bf16* Vb = WSP(bf16, WS_V);
    bf16* VS = l == 0 ? WSP(bf16, WS_VS0) : WSP(bf16, WS_VS1);
    float* LWb = WSP(float, WS_LW); bf16* AGb = WSP(bf16, WS_AG);
    const float* cs = WSP(float, WS_CS);
    const bf16* PGW = WSP(bf16, WS_PGW) + (size_t)l * PGW_NFRAG * 512;
    const float* w0 = INP(I_W0) + (size_t)l * C5; const float* a0p = INP(I_A0) + (size_t)l * C5;
    LAS unsigned char* AN = F.lds; LAS unsigned char* A2 = F.lds + OFF_A2; LAS unsigned char* VSl = F.lds + OFF_VS;
    for (int panel = F.vcu; panel < T / RP; panel += F.G) {
        const int row0 = panel * RP;
        int lane = lane0; asm volatile("" : "+v"(lane)); const int r = lane & 31, h = lane >> 5;
        __syncthreads();
        {
            f32x4 mu0[3], mu1[3];
#pragma unroll
            for (int part = 0; part < 3; ++part) { mu0[part] = *(const f32x4*)(mu + part * 512 + 8 * lane); mu1[part] = *(const f32x4*)(mu + part * 512 + 8 * lane + 4); }
            const float mu_wd = mu[1536 + lane], mu_ad = mu[1600 + lane]; const f32x2 mu_gd = *(const f32x2*)(mu + 1664 + 2 * lane);
            const f32x4 gq = *(const f32x4*)(qg + 4 * lane); const f32x2 gkv = *(const f32x2*)(kvg + 2 * lane);
            const int t0 = row0 + 8 * wave;
            u32x4 pw[3]; pw[0] = pw[1] = pw[2] = (u32x4){0u, 0u, 0u, 0u}; float p_wd = 0.f, p_ad = 0.f; unsigned p_gd = 0u;
            if ((t0 % SEQ) != 0) { const bf16* rp = P + (size_t)(t0 - 1) * N_INP + MLA_IN;
#pragma unroll
                for (int part = 0; part < 3; ++part) pw[part] = *(const u32x4*)(rp + part * 512 + 8 * lane);
                p_wd = bf2f(rp[1536 + lane]); p_ad = bf2f(rp[1600 + lane]); p_gd = *(const unsigned*)(rp + 1664 + 2 * lane); }
#pragma unroll 2
            for (int i8 = 0; i8 < 8; ++i8) { const int t = t0 + i8, rl = 8 * wave + i8;
                const bf16* pr = P + (size_t)t * N_INP;
                { const u32x2 qw = *(const u32x2*)(pr + 4 * lane); float q0 = bflo(qw.x), q1 = bfhi(qw.x), q2 = bflo(qw.y), q3 = bfhi(qw.y);
                  const float rq = __builtin_amdgcn_rsqf(wave_sum(q0 * q0 + q1 * q1 + q2 * q2 + q3 * q3) * (1.f / QLR) + RMS_EPS);
                  u32x2 w; w.x = pk2(q0 * rq * gq.x, q1 * rq * gq.y); w.y = pk2(q2 * rq * gq.z, q3 * rq * gq.w); *(LAS u32x2*)(AN + rl * LDA_AN + lane * 8) = w;
                  const unsigned kw = *(const unsigned*)(pr + QLR + 2 * lane); const float k0 = bflo(kw), k1 = bfhi(kw);
                  const float rk = __builtin_amdgcn_rsqf(wave_sum(k0 * k0 + k1 * k1) * (1.f / KVLR) + RMS_EPS);
                  *(LAS unsigned*)(AN + rl * LDA_AN + (QLR + 2 * lane) * 2) = pk2(k0 * rk * gkv.x, k1 * rk * gkv.y);
                  const int i = lane & 15; const unsigned rw = *(const unsigned*)(pr + QLR + KVLR + 2 * i); const float x0 = bflo(rw), x1 = bfhi(rw);
                  const f32x2 csv = *(const f32x2*)(cs + (size_t)t * 32 + 2 * i); const unsigned ro = pk2(x0 * csv.x - x1 * csv.y, x0 * csv.y + x1 * csv.x);
                  const int h0 = (lane >> 4) * 2;
                  *(unsigned*)(KKb + (size_t)t * 768 + h0 * QKD + NOPE + 2 * i) = ro; *(unsigned*)(KKb + (size_t)t * 768 + (h0 + 1) * QKD + NOPE + 2 * i) = ro; }
                const bf16* rr = pr + MLA_IN;
#pragma unroll
                for (int part = 0; part < 3; ++part) {
                    const u32x4 cw = *(const u32x4*)(rr + part * 512 + 8 * lane); const u32x4 pv_ = pw[part]; pw[part] = cw;
                    float o[8];
#pragma unroll
                    for (int j = 0; j < 4; ++j) { const float a = bflo(cw[j]), b = bfhi(cw[j]), pa = bflo(pv_[j]), pb = bfhi(pv_[j]); const float ma = j < 2 ? mu0[part][2 * j] : mu1[part][2 * j - 4], mb = j < 2 ? mu0[part][2 * j + 1] : mu1[part][2 * j - 3];
                        o[2 * j] = a + ma * (pa - a); o[2 * j + 1] = b + mb * (pb - b); }
                    u32x4 w; w.x = pk2(o[0], o[1]); w.y = pk2(o[2], o[3]); w.z = pk2(o[4], o[5]); w.w = pk2(o[6], o[7]);
                    if (part < 2) *(u32x4*)(RK + (size_t)t * 1024 + part * 512 + 8 * lane) = w; else *(u32x4*)(VS + (size_t)t * C5 + 8 * lane) = w;
                }
                { const float a = bf2f(rr[1536 + lane]); const float v = a + mu_wd * (p_wd - a); p_wd = a; *(LAS bf16*)(A2 + rl * LDA_A2 + lane * 2) = (bf16)f2bf(tanhf_(v)); }
                { const float a = bf2f(rr[1600 + lane]); const float v = a + mu_ad * (p_ad - a); p_ad = a; *(LAS bf16*)(A2 + rl * LDA_A2 + (64 + lane) * 2) = (bf16)f2bf(v); }
                { const unsigned cw = *(const unsigned*)(rr + 1664 + 2 * lane); const float a = bflo(cw), b = bfhi(cw); const float va = a + mu_gd.x * (bflo(p_gd) - a), vb = b + mu_gd.y * (bfhi(p_gd) - b); p_gd = cw;
                  *(LAS unsigned*)(A2 + rl * LDA_A2 + (128 + 2 * lane) * 2) = pk2(sigmoidf_(va), sigmoidf_(vb)); }
            }
        }
        __syncthreads();
        LAS unsigned char* stg = F.lds + OFF_STG + wave * STG_BYTES;
        bf16x8 fq[16], fqn[16];
        load_frags<16>(fqn, PGW, PGW_Q + 16 * wave, lane);
#pragma unroll 1
        for (int nb = wave; nb < 24; nb += 8) { f32x16 acc[2]; acc[0] = f32x16{}; acc[1] = f32x16{};
#pragma unroll
            for (int ks = 0; ks < 16; ++ks) fq[ks] = fqn[ks];
            if (nb + 8 < 24) load_frags<16>(fqn, PGW, PGW_Q + 16 * (nb + 8), lane);
            const bool rope = (nb % 3) == 2;
            f32x4 c48[2][4];
#pragma unroll
            for (int mt = 0; mt < 2; ++mt)
#pragma unroll
                for (int g = 0; g < 4; ++g) c48[mt][g] = rope ? *(const f32x4*)(cs + (size_t)(row0 + 32 * mt + r) * 32 + 8 * g + 4 * h) : (f32x4){1.f, 0.f, 1.f, 0.f};
            __builtin_amdgcn_sched_barrier(0);
            mma_frags<16>(acc, AN, LDA_AN, 0, fq, r, h);
#pragma unroll
            for (int mt = 0; mt < 2; ++mt) {
#pragma unroll
                for (int g = 0; g < 4; ++g) { float v0 = acc[mt][4 * g], v1 = acc[mt][4 * g + 1], v2 = acc[mt][4 * g + 2], v3 = acc[mt][4 * g + 3];
                    if (rope) { const f32x4 c4 = c48[mt][g];
                        const float a0 = v0, a1 = v1, a2 = v2, a3 = v3; v0 = a0 * c4.x - a1 * c4.y; v1 = a0 * c4.y + a1 * c4.x; v2 = a2 * c4.z - a3 * c4.w; v3 = a2 * c4.w + a3 * c4.z; }
                    stage_put4(stg, mt, g, r, h, v0 * C2Q, v1 * C2Q, v2 * C2Q, v3 * C2Q); } }
            stage_flush(stg, Qb + (size_t)row0 * 768 + 32 * nb, 768, lane); }
        bf16x8 fk[8], fkn[8];
        load_frags<8>(fkn, PGW, PGW_KN + 8 * wave, lane);
#pragma unroll 1
        for (int nb = wave; nb < 32; nb += 8) { f32x16 acc[2]; acc[0] = f32x16{}; acc[1] = f32x16{};
            const bool isv = nb >= 16; const int n0 = 32 * (nb & 15);
#pragma unroll
            for (int ks = 0; ks < 8; ++ks) fk[ks] = fkn[ks];
            if (nb + 8 < 32) load_frags<8>(fkn, PGW, PGW_KN + 8 * (nb + 8), lane);
            __builtin_amdgcn_sched_barrier(0);
            mma_frags<8>(acc, AN, LDA_AN, 256, fk, r, h);
#pragma unroll
            for (int mt = 0; mt < 2; ++mt)
#pragma unroll
                for (int g = 0; g < 4; ++g) stage_put4(stg, mt, g, r, h, acc[mt][4 * g], acc[mt][4 * g + 1], acc[mt][4 * g + 2], acc[mt][4 * g + 3]);
            if (isv) stage_flush(stg, Vb + (size_t)row0 * C5 + n0, C5, lane); else stage_flush(stg, KKb + (size_t)row0 * 768 + (n0 >> 6) * QKD + (n0 & 63), 768, lane); }
        bf16x8 fs[8], fsn[8];
#pragma unroll
        for (int ks = 0; ks < 8; ++ks) fsn[ks] = (bf16x8){0, 0, 0, 0, 0, 0, 0, 0};
        { bf16x8 t4[4]; load_frags<4>(t4, PGW, PGW_W + 4 * wave, lane); fsn[0] = t4[0]; fsn[1] = t4[1]; fsn[2] = t4[2]; fsn[3] = t4[3]; }
#pragma unroll 1
        for (int nb = wave; nb < 48; nb += 8) { f32x16 acc[2]; acc[0] = f32x16{}; acc[1] = f32x16{};
            const int kind = nb >> 4, n0 = 32 * (nb & 15);
#pragma unroll
            for (int ks = 0; ks < 8; ++ks) fs[ks] = fsn[ks];
            if (nb + 8 < 48) { const int nn = nb + 8, kn = nn >> 4;
                if (kn == 2) load_frags<8>(fsn, PGW, PGW_G + 8 * (nn & 15), lane);
                else { bf16x8 t4[4]; load_frags<4>(t4, PGW, (kn == 0 ? PGW_W : PGW_A) + 4 * (nn & 15), lane); fsn[0] = t4[0]; fsn[1] = t4[1]; fsn[2] = t4[2]; fsn[3] = t4[3]; } }
            f32x4 bz4[4];
#pragma unroll
            for (int g = 0; g < 4; ++g) bz4[g] = kind == 2 ? (f32x4){0.f, 0.f, 0.f, 0.f} : *(const f32x4*)((kind == 0 ? w0 : a0p) + n0 + 8 * g + 4 * h);
            __builtin_amdgcn_sched_barrier(0);
            if (kind == 2) mma_frags<8>(acc, A2, LDA_A2, 128, fs, r, h);
            else { bf16x8 t4[4]; t4[0] = fs[0]; t4[1] = fs[1]; t4[2] = fs[2]; t4[3] = fs[3]; mma_frags<4>(acc, A2, LDA_A2, kind == 0 ? 0 : 64, t4, r, h); }
            if (kind == 0) {
#pragma unroll
                for (int mt = 0; mt < 2; ++mt) { float* lrow = LWb + (size_t)(row0 + 32 * mt + r) * C5 + n0;
#pragma unroll
                    for (int g = 0; g < 4; ++g) { const f32x4 bz = bz4[g]; f32x4 o;
#pragma unroll
                        for (int e = 0; e < 4; ++e) { const float z = -(acc[mt][4 * g + e] + bz[e]); const float sp = fmaxf(z, 0.f) + __logf(1.0f + __expf(-fabsf(z))); o[e] = -__expf(-sp - 0.5f); }
                        *(f32x4*)(lrow + 8 * g + 4 * h) = o; } }
            } else {
#pragma unroll
                for (int mt = 0; mt < 2; ++mt)
#pragma unroll
                    for (int g = 0; g < 4; ++g) { float v0 = acc[mt][4 * g], v1 = acc[mt][4 * g + 1], v2 = acc[mt][4 * g + 2], v3 = acc[mt][4 * g + 3];
                        if (kind == 1) { const f32x4 bz = bz4[g]; v0 = sigmoidf_(v0 + bz.x); v1 = sigmoidf_(v1 + bz.y); v2 = sigmoidf_(v2 + bz.z); v3 = sigmoidf_(v3 + bz.w); }
                        stage_put4(stg, mt, g, r, h, v0, v1, v2, v3); }
                stage_flush(stg, AGb + (size_t)row0 * 1024 + (kind - 1) * 512 + n0, 1024, lane); } }
        if (l > 0) {
            int tid2 = F.tid; asm volatile("" : "+v"(tid2)); const int lane2 = tid2 & 63, r2 = tid2 & 31, h2 = (tid2 >> 5) & 1;
            __syncthreads();
            const bf16* VS1 = WSP(bf16, WS_VS1); const bf16* VS0 = WSP(bf16, WS_VS0); bf16* VR = WSP(bf16, WS_VR); const float* v0 = INP(I_V0);
            asm volatile("s_waitcnt vmcnt(0)" ::: "memory");
            __builtin_amdgcn_fence(__ATOMIC_ACQUIRE, "agent"); asm volatile("s_waitcnt vmcnt(0)" ::: "memory");
            for (int i = tid2; i < RP * 64; i += NTHREADS) { const int rl = i >> 6, ch = i & 63; *(LAS u32x4*)(VSl + rl * LDA_VS + ch * 16) = *(const u32x4*)(VS1 + (size_t)(row0 + rl) * C5 + ch * 8); }
            __syncthreads();
#pragma unroll 1
            for (int nb = wave; nb < 16; nb += 8) { f32x16 acc[2]; acc[0] = f32x16{}; acc[1] = f32x16{};
                { bf16x8 fv[16]; load_frags<16>(fv, PGW, PGW_VR + 32 * nb, lane2); mma_frags<16>(acc, VSl, LDA_VS, 0, fv, r2, h2); load_frags<16>(fv, PGW, PGW_VR + 32 * nb + 16, lane2); mma_frags<16>(acc, VSl, LDA_VS, 256, fv, r2, h2); }
#pragma unroll
                for (int mt = 0; mt < 2; ++mt) { const int rl = 32 * mt + r2; const size_t row = (size_t)(row0 + rl);
#pragma unroll
                    for (int g = 0; g < 4; ++g) { const int n = 32 * nb + 8 * g + 4 * h2; const f32x4 bz = *(const f32x4*)(v0 + n);
                        const u32x2 sw = *(const LAS u32x2*)(VSl + rl * LDA_VS + n * 2); const u32x2 fw = *(const u32x2*)(VS0 + row * C5 + n);
                        const float s0 = bflo(sw.x), s1 = bfhi(sw.x), s2 = bflo(sw.y), s3 = bfhi(sw.y), f0 = bflo(fw.x), f1 = bfhi(fw.x), f2 = bflo(fw.y), f3 = bfhi(fw.y);
                        stage_put4(stg, mt, g, r2, h2, s0 + (f0 - s0) * sigmoidf_(acc[mt][4 * g] + bz.x), s1 + (f1 - s1) * sigmoidf_(acc[mt][4 * g + 1] + bz.y),
                                   s2 + (f2 - s2) * sigmoidf_(acc[mt][4 * g + 2] + bz.z), s3 + (f3 - s3) * sigmoidf_(acc[mt][4 * g + 3] + bz.w)); } }
                stage_flush(stg, VR + (size_t)row0 * C5 + 32 * nb, C5, lane2); }
        }
    }
    __syncthreads();
}

namespace att {
__device__ __forceinline__ int crow(int r, int hi) { return (r & 3) + 8 * (r >> 2) + 4 * hi; }
constexpr int KSLOT = 12288, VSLOT = 8192;
constexpr int NSLOT = 3;
constexpr int LDS_K = 0, LDS_V = NSLOT * KSLOT, LDS_WS = LDS_V + NSLOT * VSLOT, LDS_OST = LDS_WS + NWAVES * 64 * 4, LDS_TOTAL = LDS_OST + NWAVES * 4096;
__device__ __forceinline__ void glds16(const void* gsrc, unsigned lds_dst) { unsigned keep;
    asm volatile("s_mov_b32 %0, m0\n\ts_mov_b32 m0, %2\n\ts_nop 0\n\tglobal_load_lds_dwordx4 %1, off\n\ts_mov_b32 m0, %0" : "=&s"(keep) : "v"(gsrc), "s"(lds_dst) : "memory"); }
__device__ __forceinline__ float max3f(float a, float b, float c) { return fmaxf(fmaxf(a, b), c); }
#define ATT_WAIT_BAR() asm volatile("s_waitcnt vmcnt(0) lgkmcnt(0)\n\ts_barrier" ::: "memory")
__device__ __forceinline__ float rowmax(const f32x16& p0, const f32x16& p1) {
    float a = max3f(p0[0], p0[1], p1[0]), b = max3f(p0[2], p0[3], p1[1]); a = max3f(a, p1[2], p1[3]);
#pragma unroll
    for (int r = 4; r < 16; r += 4) { a = max3f(a, p0[r], p0[r + 1]); b = max3f(b, p0[r + 2], p0[r + 3]); a = max3f(a, p1[r], p1[r + 1]); b = max3f(b, p1[r + 2], p1[r + 3]); }
    const float m = fmaxf(a, b);
    auto rr = __builtin_amdgcn_permlane32_swap(__float_as_uint(m), __float_as_uint(m), false, false);
    return fmaxf(__uint_as_float(rr[0]), __uint_as_float(rr[1]));
}
__device__ __forceinline__ void pv(f32x16* o, int vb, bf16x8 pa0, bf16x8 pa1, bf16x8 pa2, bf16x8 pa3) {
#pragma unroll
    for (int d0 = 0; d0 < 2; ++d0) { s16x4 lo[4], hi[4];
#pragma unroll
        for (int ks = 0; ks < 4; ++ks) {
            asm volatile("ds_read_b64_tr_b16 %0,%1 offset:%c2" : "=&v"(lo[ks]) : "v"(vb), "i"(d0 * 4096 + ks * 1024) : "memory");
            asm volatile("ds_read_b64_tr_b16 %0,%1 offset:%c2" : "=&v"(hi[ks]) : "v"(vb), "i"(d0 * 4096 + ks * 1024 + 512) : "memory"); }
        asm volatile("s_waitcnt lgkmcnt(0)" ::: "memory"); __builtin_amdgcn_sched_barrier(0);
#define PK(k) (bf16x8){lo[k][0], lo[k][1], lo[k][2], lo[k][3], hi[k][0], hi[k][1], hi[k][2], hi[k][3]}
        o[d0] = __builtin_amdgcn_mfma_f32_32x32x16_bf16(pa0, PK(0), o[d0], 0, 0, 0);
        o[d0] = __builtin_amdgcn_mfma_f32_32x32x16_bf16(pa1, PK(1), o[d0], 0, 0, 0);
        o[d0] = __builtin_amdgcn_mfma_f32_32x32x16_bf16(pa2, PK(2), o[d0], 0, 0, 0);
        o[d0] = __builtin_amdgcn_mfma_f32_32x32x16_bf16(pa3, PK(3), o[d0], 0, 0, 0);
#undef PK
    }
}
__device__ __forceinline__ void attn_unit(int b, int h, int qb, const bf16* Q, const bf16* __restrict__ KKp, const bf16* __restrict__ Vp, bf16* O, char* shm) {
    const int tid = threadIdx.x, lane = tid & 63, r32 = lane & 31, hi = lane >> 5; const int wid = __builtin_amdgcn_readfirstlane(tid >> 6);
    const long rowbase = (long)b * SEQ; const int q0 = qb * 256;
    const bf16* Qw = Q + (rowbase + q0 + wid * 32) * 768 + h * QKD;
    const bf16* Kh = KKp + rowbase * 768 + h * QKD; const bf16* Vh = Vp + rowbase * 512 + h * VD;
    const unsigned lds0 = (unsigned)(uintptr_t)shm;
    float* wsf = (float*)(shm + LDS_WS) + wid * 64;
    const bf16* ksrc0 = Kh + (long)lane * 768 + wid * 8;
    const bf16* ksrc1 = Kh + (long)lane * 768 + (8 + (wid & 3)) * 8;
    const bf16* vsrc = Vh + (long)(16 * (wid & 3) + (lane >> 2)) * 512 + (wid >> 2) * 32 + (lane & 3) * 8;
    const unsigned kdst0 = lds0 + LDS_K + wid * 1024, kdst1 = lds0 + LDS_K + (8 + (wid & 3)) * 1024, vdst = lds0 + LDS_V + wid * 1024;
#define DMA_KV(t, s) do { glds16(ksrc0 + (long)(t) * 64 * 768, (unsigned)__builtin_amdgcn_readfirstlane(kdst0 + (s) * KSLOT)); \
        if (wid < 4) glds16(ksrc1 + (long)(t) * 64 * 768, (unsigned)__builtin_amdgcn_readfirstlane(kdst1 + (s) * KSLOT)); \
        glds16(vsrc + (long)(t) * 64 * 512, (unsigned)__builtin_amdgcn_readfirstlane(vdst + (s) * VSLOT)); } while (0)
    const int vb0 = (int)(lds0 + LDS_V) + ((lane >> 4) & 1) * 32 + (lane & 3) * 8 + (4 * hi + ((lane & 15) >> 2)) * 64;
    const int NT = (q0 + 256) / 64;
    DMA_KV(0, 0); DMA_KV(1, 1);
    bf16x8 qr[6];
#pragma unroll
    for (int d0 = 0; d0 < 6; ++d0) qr[d0] = *reinterpret_cast<const bf16x8*>(&Qw[(long)r32 * 768 + d0 * 16 + hi * 8]);
    float mhat = 0.f, l_reg = 0.f; f32x16 o[2]; o[0] = f32x16{}; o[1] = f32x16{};
    f32x16 negm = f32x16{};
    const int qrel = wid * 32 + r32;
    typedef short v4i16_t __attribute__((ext_vector_type(4)));
    typedef __attribute__((address_space(3))) v4i16_t* lds_v4p;
    int sl_cur = 0, sl_nn = 2;
    for (int t = 0; t < NT; ++t) {
        if (t + 1 < NT && t > 0) { if (wid < 4) asm volatile("s_waitcnt vmcnt(3) lgkmcnt(0)\n\ts_barrier" ::: "memory"); else asm volatile("s_waitcnt vmcnt(2) lgkmcnt(0)\n\ts_barrier" ::: "memory"); }
        else ATT_WAIT_BAR();
        if (t + 2 < NT) DMA_KV(t + 2, sl_nn);
        const char* Kslot = shm + LDS_K + sl_cur * KSLOT;
        f32x16 p0 = negm, p1 = negm;
        { const char* kb = Kslot + hi * 1024 + r32 * 16;
#pragma unroll
          for (int d0 = 0; d0 < 6; ++d0) { const bf16x8 b0 = *reinterpret_cast<const bf16x8*>(kb + d0 * 2048); const bf16x8 b1 = *reinterpret_cast<const bf16x8*>(kb + d0 * 2048 + 512);
              p0 = __builtin_amdgcn_mfma_f32_32x32x16_bf16(b0, qr[d0], p0, 0, 0, 0); p1 = __builtin_amdgcn_mfma_f32_32x32x16_bf16(b1, qr[d0], p1, 0, 0, 0); } }
        s16x4 vlo[8], vhi[8];
        { const int vb = vb0 + sl_cur * VSLOT;
#pragma unroll
          for (int i = 0; i < 8; ++i) { const int off = (i >> 2) * 4096 + (i & 3) * 1024;
              vlo[i] = __builtin_bit_cast(s16x4, __builtin_amdgcn_ds_read_tr16_b64_v4i16((lds_v4p)(vb + off))); vhi[i] = __builtin_bit_cast(s16x4, __builtin_amdgcn_ds_read_tr16_b64_v4i16((lds_v4p)(vb + off + 512))); } }
        const int jb = t - (NT - 4);
        if (jb >= 0) { const int kbase = 64 * jb + 4 * hi;
#pragma unroll
            for (int r = 0; r < 16; ++r) { const int kv = kbase + (r & 3) + 8 * (r >> 2); if (kv > qrel) p0[r] = -INFINITY; if (kv + 32 > qrel) p1[r] = -INFINITY; } }
        const float rm = rowmax(p0, p1);
        bool resc = false;
        if (t == 0 || __any(rm > 8.0f)) {
            const float dl = (t == 0) ? rm : fmaxf(rm, 0.f); mhat += dl;
#pragma unroll
            for (int r = 0; r < 16; ++r) { p0[r] -= dl; p1[r] -= dl; negm[r] = -mhat; }
            const float f = (t == 0) ? 1.0f : __builtin_amdgcn_exp2f(-dl); l_reg *= f; if (hi == 0) wsf[r32] = f; resc = true; }
        float sacc = 0.f;
#pragma unroll
        for (int r = 0; r < 16; ++r) { p0[r] = __builtin_amdgcn_exp2f(p0[r]); p1[r] = __builtin_amdgcn_exp2f(p1[r]); sacc += p0[r] + p1[r]; }
        l_reg += sacc;
        if (resc) { asm volatile("s_waitcnt lgkmcnt(0)" ::: "memory");
#pragma unroll
            for (int r = 0; r < 16; ++r) { const float fr_ = wsf[crow(r, hi)]; o[0][r] *= fr_; o[1][r] *= fr_; } }
        u32x4 pw[4];
        pw[0] = (u32x4){cvtpk_c(p0[0], p0[1]), cvtpk_c(p0[2], p0[3]), cvtpk_c(p0[4], p0[5]), cvtpk_c(p0[6], p0[7])};
        pw[1] = (u32x4){cvtpk_c(p0[8], p0[9]), cvtpk_c(p0[10], p0[11]), cvtpk_c(p0[12], p0[13]), cvtpk_c(p0[14], p0[15])};
        pw[2] = (u32x4){cvtpk_c(p1[0], p1[1]), cvtpk_c(p1[2], p1[3]), cvtpk_c(p1[4], p1[5]), cvtpk_c(p1[6], p1[7])};
        pw[3] = (u32x4){cvtpk_c(p1[8], p1[9]), cvtpk_c(p1[10], p1[11]), cvtpk_c(p1[12], p1[13]), cvtpk_c(p1[14], p1[15])};
#pragma unroll
        for (int i = 0; i < 8; ++i) { const bf16x8 vf = (bf16x8){vlo[i][0], vlo[i][1], vlo[i][2], vlo[i][3], vhi[i][0], vhi[i][1], vhi[i][2], vhi[i][3]};
            o[i >> 2] = __builtin_amdgcn_mfma_f32_32x32x16_bf16(__builtin_bit_cast(bf16x8, pw[i & 3]), vf, o[i >> 2], 0, 0, 0); }
        sl_cur = (sl_cur == NSLOT - 1) ? 0 : sl_cur + 1; sl_nn = (sl_nn == NSLOT - 1) ? 0 : sl_nn + 1;
    }
    { auto rr = __builtin_amdgcn_permlane32_swap(__float_as_uint(l_reg), __float_as_uint(l_reg), false, false); l_reg = __uint_as_float(rr[0]) + __uint_as_float(rr[1]); }
    if (hi == 0) wsf[32 + r32] = l_reg; asm volatile("s_waitcnt lgkmcnt(0)" ::: "memory");
    float rli[16];
#pragma unroll
    for (int r = 0; r < 16; ++r) rli[r] = __builtin_amdgcn_rcpf(wsf[32 + crow(r, hi)]);
    bf16* Ow = O + (rowbase + q0 + wid * 32) * 512 + h * VD;
    { bf16* stg = (bf16*)(shm + LDS_OST) + wid * 2048;
#pragma unroll
      for (int r = 0; r < 16; ++r) { const int orow = crow(r, hi);
#pragma unroll
          for (int d0 = 0; d0 < 2; ++d0) stg[orow * 64 + d0 * 32 + r32] = (bf16)f2bf(o[d0][r] * rli[r]); }
      asm volatile("s_waitcnt lgkmcnt(0)" ::: "memory");
#pragma unroll
      for (int i = 0; i < 4; ++i) { const int row = i * 8 + (lane >> 3), ch = lane & 7; const u32x4 v = *(const u32x4*)(stg + row * 64 + ch * 8); *(u32x4*)(Ow + (long)row * 512 + ch * 8) = v; } }
    asm volatile("s_waitcnt vmcnt(0) lgkmcnt(0)\n\ts_barrier" ::: "memory");
#undef DMA_KV
}
}

__device__ __forceinline__ void phase_attn(const Params& p, const Frame& F, char* lds_generic, int l) {
    const bf16* Q = WSP(bf16, WS_Q); const bf16* KKp = WSP(bf16, WS_KK); const bf16* Vp = WSP(bf16, WS_V); bf16* O = WSP(bf16, WS_O);
    unsigned* head = (unsigned*)(F.ws + WS_CTL) + CW_ATTQ + l * 64;
    volatile LAS unsigned* MISC = (volatile LAS unsigned*)(F.lds + MISC_OFF);
    for (;;) {
        if (F.tid == 0) MISC[16] = __hip_atomic_fetch_add(head, 1u, RLX_AGENT);
        __syncthreads();
        const unsigned k = MISC[16];
        __syncthreads();
        if (k >= 1024u) break;
        const int qb = 15 - (int)(k >> 6), bh = (int)(k & 63u);
        att::attn_unit(bh >> 3, bh & 7, qb, Q, KKp, Vp, O, lds_generic);
    }
}

namespace rw {
constexpr int RS = 144;
constexpr int SLOT = 64 * RS;
constexpr int S_KT = 0, S_RT = 1, S_BC = 2, S_KC = 3, S_V = 4, S_BH = 5, S_KH = 6, S_GT = 7, S_ABK = 8, S_AKK = 9, S_AKR = 10, S_ABR = 11, S_ABKF = 12;
constexpr int S_TT = S_BC, S_ZT = S_KC, S_NW1T = S_AKK, S_NW2T = S_ABK;
constexpr int TOT_OFF = 13 * SLOT, PL_OFF = TOT_OFF + 8 * 64 * 4;
typedef short v4i16_t __attribute__((ext_vector_type(4)));
__device__ __forceinline__ int crow(int r, int hi) { return (r & 3) + 8 * (r >> 2) + 4 * hi; }
__device__ __forceinline__ bf16x8 frag_d(const LAS unsigned char* M, int row0, int k0, int r, int h) { return *(const LAS bf16x8*)(M + (row0 + r) * RS + (k0 + 8 * h) * 2); }
__device__ __forceinline__ bf16x8 frag_t(const LAS unsigned char* M, int k0, int col0, int lane) {
    const int h = lane >> 5, blk = (lane >> 4) & 1, q = (lane & 15) >> 2, pp = lane & 3;
    const LAS unsigned char* a = M + (k0 + 8 * h + q) * RS + (col0 + 16 * blk + 4 * pp) * 2;
    const v4i16_t lo = __builtin_amdgcn_ds_read_tr16_b64_v4i16((LAS v4i16_t*)a), hi = __builtin_amdgcn_ds_read_tr16_b64_v4i16((LAS v4i16_t*)(a + 4 * RS));
    return (bf16x8){lo[0], lo[1], lo[2], lo[3], hi[0], hi[1], hi[2], hi[3]};
}
__device__ __forceinline__ void store_T(LAS unsigned char* D, int m0, int n0, const f32x16& acc, float sgn, int r, int h) {
#pragma unroll
    for (int g = 0; g < 4; ++g) { u32x2 w; w.x = cvtpk_c(acc[4 * g] * sgn, acc[4 * g + 1] * sgn); w.y = cvtpk_c(acc[4 * g + 2] * sgn, acc[4 * g + 3] * sgn);
        *(LAS u32x2*)(D + (n0 + r) * RS + (m0 + 8 * g + 4 * h) * 2) = w; }
}
#define RW_MMA(acc, A, B) acc = __builtin_amdgcn_mfma_f32_32x32x16_bf16((A), (B), acc, 0, 0, 0)
}

#define LBAR() asm volatile("s_waitcnt lgkmcnt(0)\n\ts_barrier" ::: "memory")
__device__ __forceinline__ void phase_rwkv_r1(const Params& p, const Frame& F, int l) {
    using namespace rw;
    LAS unsigned char* L0 = F.lds;
#define SL(i) (L0 + (i) * SLOT)
    const bf16* RK = WSP(bf16, WS_RK); const float* LWp = WSP(float, WS_LW); const bf16* AGp = WSP(bf16, WS_AG);
    const bf16* Vv = l == 0 ? WSP(bf16, WS_VS0) : WSP(bf16, WS_VR);
    float* CH = WSP(float, WS_CH);
    const float* kkw = INP(I_KK) + (size_t)l * C5; const float* kaw = INP(I_KA) + (size_t)l * C5;
    const int tid0 = F.tid, wave = F.wave;
    const int pt0 = tid0 >> 3, j80 = tid0 & 7;
    LAS float* tot = (LAS float*)(L0 + TOT_OFF); LAS float* PLv = (LAS float*)(L0 + PL_OFF);
    u32x4 g_r, g_k, g_v, g_a; f32x4 g_l0, g_l1;
#define R1_FETCH(uu) do { const int bh_ = (uu) >> 6, cc_ = (uu) & 63; const size_t tok = (size_t)(bh_ >> 3) * SEQ + (size_t)cc_ * 64 + pt0; const int c_ = (bh_ & 7) * 64 + 8 * j80; \
        g_r = *(const u32x4*)(RK + tok * 1024 + c_); g_k = *(const u32x4*)(RK + tok * 1024 + 512 + c_); g_v = *(const u32x4*)(Vv + tok * C5 + c_); \
        g_l0 = *(const f32x4*)(LWp + tok * C5 + c_); g_l1 = *(const f32x4*)(LWp + tok * C5 + c_ + 4); g_a = *(const u32x4*)(AGp + tok * 1024 + c_); } while (0)
    int u = F.vcu;
    if (u < 4096) R1_FETCH(u);
    for (; u < 4096; u += F.G) {
        const int hh = (u >> 6) & 7;
        int tid = tid0; asm volatile("" : "+v"(tid)); const int lane = tid & 63, r = lane & 31, h = lane >> 5, pt = tid >> 3, j8 = tid & 7;
        {
            const int c = hh * 64 + 8 * j8;
            const f32x4 kk0 = *(const f32x4*)(kkw + c), kk1 = *(const f32x4*)(kkw + c + 4), ka0 = *(const f32x4*)(kaw + c), ka1 = *(const f32x4*)(kaw + c + 4);
            float rr[8], k[8], a[8], x[8], lw[8], kap[8], be[8], kp[8]; float ss = 0.f;
#pragma unroll
            for (int j = 0; j < 4; ++j) { rr[2 * j] = bflo(g_r[j]); rr[2 * j + 1] = bfhi(g_r[j]); k[2 * j] = bflo(g_k[j]); k[2 * j + 1] = bfhi(g_k[j]); }
            *(LAS u32x4*)(SL(S_V) + pt * RS + j8 * 16) = g_v;
#pragma unroll
            for (int j = 0; j < 8; ++j) { a[j] = (j & 1) ? bfhi(g_a[j >> 1]) : bflo(g_a[j >> 1]); lw[j] = j < 4 ? g_l0[j & 3] : g_l1[j & 3]; x[j] = lw[j]; const float q = k[j] * (j < 4 ? kk0[j & 3] : kk1[j & 3]); kap[j] = q; ss += q * q; }
            ss += __shfl_xor(ss, 1); ss += __shfl_xor(ss, 2); ss += __shfl_xor(ss, 4);
            const float inv = 1.0f / fmaxf(sqrtf(ss), 1e-12f);
#pragma unroll
            for (int j = 0; j < 8; ++j) { kap[j] *= inv; be[j] = kap[j] * a[j]; kp[j] = k[j] * (1.0f + (a[j] - 1.0f) * (j < 4 ? ka0[j & 3] : ka1[j & 3])); }
#pragma unroll
            for (int off = 8; off < 64; off <<= 1) {
#pragma unroll
                for (int j = 0; j < 8; ++j) { const float y = __shfl_up(x[j], off); if (lane >= off) x[j] += y; } }
            if (lane >= 56) { *(LAS f32x4*)(tot + wave * 64 + 8 * j8) = (f32x4){x[0], x[1], x[2], x[3]}; *(LAS f32x4*)(tot + wave * 64 + 8 * j8 + 4) = (f32x4){x[4], x[5], x[6], x[7]}; }
            LBAR();
            float csL[8];
#pragma unroll
            for (int j = 0; j < 8; ++j) csL[j] = 0.f;
#pragma unroll
            for (int w2 = 0; w2 < 8; ++w2) { const f32x4 t0 = *(const LAS f32x4*)(tot + w2 * 64 + 8 * j8), t1 = *(const LAS f32x4*)(tot + w2 * 64 + 8 * j8 + 4);
#pragma unroll
                for (int j = 0; j < 8; ++j) { const float tv = j < 4 ? t0[j & 3] : t1[j & 3]; csL[j] += tv; if (w2 < wave) x[j] += tv; } }
            if (pt == 0) {
#pragma unroll
                for (int j = 0; j < 8; ++j) PLv[8 * j8 + j] = __expf(csL[j]); }
            float kt[8], rt[8], bc[8], kc[8], bh[8], kh[8];
#pragma unroll
            for (int j = 0; j < 8; ++j) { const float eP = __expf(x[j]), ePm1 = __expf(x[j] - lw[j]), eInv = __expf(-x[j]), eL = __expf(csL[j] - x[j]);
                kt[j] = kap[j] * ePm1; rt[j] = rr[j] * eP; bc[j] = be[j] * eInv; kc[j] = kp[j] * eInv; bh[j] = be[j] * eL; kh[j] = kp[j] * eL; }
#define PK8(v) (u32x4){cvtpk_c(v[0], v[1]), cvtpk_c(v[2], v[3]), cvtpk_c(v[4], v[5]), cvtpk_c(v[6], v[7])}
            *(LAS u32x4*)(SL(S_KT) + pt * RS + j8 * 16) = PK8(kt); *(LAS u32x4*)(SL(S_RT) + pt * RS + j8 * 16) = PK8(rt);
            *(LAS u32x4*)(SL(S_BC) + pt * RS + j8 * 16) = PK8(bc); *(LAS u32x4*)(SL(S_KC) + pt * RS + j8 * 16) = PK8(kc);
            *(LAS u32x4*)(SL(S_BH) + pt * RS + j8 * 16) = PK8(bh); *(LAS u32x4*)(SL(S_KH) + pt * RS + j8 * 16) = PK8(kh);
#undef PK8
        }
        LBAR();
        {
            const int mat = wave >> 1, ti = wave & 1;
            const LAS unsigned char* X = (mat < 2) ? SL(S_KT) : SL(S_RT); const LAS unsigned char* Y = (mat == 0 || mat == 3) ? SL(S_BC) : SL(S_KC);
            LAS unsigned char* Dm = SL(S_ABK + mat);
            const int t = 32 * ti + r;
            bf16x8 xb[4];
#pragma unroll
            for (int kk = 0; kk < 4; ++kk) xb[kk] = frag_d(X, 32 * ti, 16 * kk, r, h);
#pragma unroll
            for (int si = 0; si < 2; ++si) {
                f32x16 acc = f32x16{};
                if (!(ti == 0 && si == 1)) {
#pragma unroll
                    for (int kk = 0; kk < 4; ++kk) RW_MMA(acc, frag_d(Y, 32 * si, 16 * kk, r, h), xb[kk]); }
#pragma unroll
                for (int g = 0; g < 4; ++g) { float v[4];
#pragma unroll
                    for (int e = 0; e < 4; ++e) { const int sidx = 32 * si + 8 * g + 4 * h + e; const bool keep = (mat < 2) ? (sidx < t) : (sidx <= t); v[e] = keep ? acc[4 * g + e] : 0.f; }
                    u32x2 w; w.x = cvtpk_c(v[0], v[1]); w.y = cvtpk_c(v[2], v[3]);
                    *(LAS u32x2*)(Dm + t * RS + (32 * si + 8 * g + 4 * h) * 2) = w;
                    if (mat == 0 && ti == si) *(LAS f32x4*)(SL(S_ABKF) + ti * 4608 + r * 144 + (8 * g + 4 * h) * 4) = (f32x4){v[0], v[1], v[2], v[3]}; }
            }
        }
        LBAR();
        if (wave == 0) {
            const int hb = lane >> 5, c = lane & 31; const LAS unsigned char* Ab = SL(S_ABKF) + hb * 4608;
            float Tc[32];
#pragma unroll
            for (int t = 0; t < 32; ++t) Tc[t] = 0.f;
#pragma unroll
            for (int t = 0; t < 32; ++t) { float acc0 = (t == c) ? 1.0f : 0.0f, acc1 = 0.f;
#pragma unroll
                for (int s4 = 0; s4 < (t + 3) / 4; ++s4) { const f32x4 a4 = *(const LAS f32x4*)(Ab + t * 144 + s4 * 16);
                    acc0 -= a4.x * Tc[4 * s4]; acc1 -= a4.y * Tc[4 * s4 + 1]; acc0 -= a4.z * Tc[4 * s4 + 2]; acc1 -= a4.w * Tc[4 * s4 + 3]; }
                float acc = acc0 + acc1;
                asm volatile("" : "+v"(acc) :: "memory");
                Tc[t] = acc; }
#pragma unroll
            for (int q = 0; q < 4; ++q) *(LAS u32x4*)(SL(S_TT) + (32 * hb + c) * RS + (32 * hb) * 2 + q * 16) =
                (u32x4){cvtpk_c(Tc[8 * q], Tc[8 * q + 1]), cvtpk_c(Tc[8 * q + 2], Tc[8 * q + 3]), cvtpk_c(Tc[8 * q + 4], Tc[8 * q + 5]), cvtpk_c(Tc[8 * q + 6], Tc[8 * q + 7])};
        } else if (wave == 1) {
            const int row = 32 + (lane >> 1), hf = lane & 1;
            *(LAS u32x4*)(SL(S_TT) + row * RS + hf * 32) = (u32x4){0u, 0u, 0u, 0u}; *(LAS u32x4*)(SL(S_TT) + row * RS + hf * 32 + 16) = (u32x4){0u, 0u, 0u, 0u};
        } else if (wave >= 4) {
            const int ti = (wave - 4) >> 1, ii = (wave - 4) & 1; f32x16 acc = f32x16{};
#pragma unroll
            for (int kk = 0; kk < 4; ++kk) RW_MMA(acc, frag_d(SL(S_AKK), 32 * ti, 16 * kk, r, h), frag_t(SL(S_V), 16 * kk, 32 * ii, lane));
            store_T(SL(S_GT), 32 * ti, 32 * ii, acc, 1.0f, r, h);
        }
        LBAR();
        if (wave == 0) { f32x16 acc = f32x16{};
#pragma unroll
            for (int kk = 0; kk < 2; ++kk) RW_MMA(acc, frag_d(SL(S_ABK), 32, 16 * kk, r, h), frag_d(SL(S_TT), 0, 16 * kk, r, h));
            store_T(SL(S_ZT), 0, 0, acc, 1.0f, r, h); }
        LBAR();
        if (wave == 0) { f32x16 acc = f32x16{};
#pragma unroll
            for (int kk = 0; kk < 2; ++kk) RW_MMA(acc, frag_t(SL(S_TT), 32 + 16 * kk, 32, lane), frag_d(SL(S_ZT), 0, 16 * kk, r, h));
            store_T(SL(S_TT), 32, 0, acc, -1.0f, r, h); }
        LBAR();
        if (u + F.G < 4096) R1_FETCH(u + F.G);
        { const int w4 = wave & 3, ti = w4 >> 1, ci = w4 & 1; f32x16 acc = f32x16{};
          if (wave < 4) {
#pragma unroll
              for (int kk = 0; kk < 4; ++kk) RW_MMA(acc, frag_t(SL(S_TT), 16 * kk, 32 * ti, lane), frag_t(SL(S_KT), 16 * kk, 32 * ci, lane));
              store_T(SL(S_NW1T), 32 * ti, 32 * ci, acc, -1.0f, r, h); }
          else {
#pragma unroll
              for (int kk = 0; kk < 4; ++kk) RW_MMA(acc, frag_t(SL(S_TT), 16 * kk, 32 * ti, lane), frag_d(SL(S_GT), 32 * ci, 16 * kk, r, h));
              store_T(SL(S_NW2T), 32 * ti, 32 * ci, acc, -1.0f, r, h); } }
        LBAR();
        { const int which = wave >> 1, mi = wave & 1; float* dst = CH + ((size_t)u * 4 + which) * 4096;
#pragma unroll
          for (int ni = 0; ni < 2; ++ni) { f32x16 acc = f32x16{};
#pragma unroll
              for (int kk = 0; kk < 4; ++kk) {
                  if (which == 0) RW_MMA(acc, frag_d(SL(S_ABR), 32 * mi, 16 * kk, r, h), frag_d(SL(S_NW1T), 32 * ni, 16 * kk, r, h));
                  else if (which == 1) { RW_MMA(acc, frag_d(SL(S_AKR), 32 * mi, 16 * kk, r, h), frag_t(SL(S_V), 16 * kk, 32 * ni, lane)); RW_MMA(acc, frag_d(SL(S_ABR), 32 * mi, 16 * kk, r, h), frag_d(SL(S_NW2T), 32 * ni, 16 * kk, r, h)); }
                  else if (which == 2) RW_MMA(acc, frag_t(SL(S_BH), 16 * kk, 32 * mi, lane), frag_d(SL(S_NW1T), 32 * ni, 16 * kk, r, h));
                  else { RW_MMA(acc, frag_t(SL(S_KH), 16 * kk, 32 * mi, lane), frag_t(SL(S_V), 16 * kk, 32 * ni, lane)); RW_MMA(acc, frag_t(SL(S_BH), 16 * kk, 32 * mi, lane), frag_d(SL(S_NW2T), 32 * ni, 16 * kk, r, h)); } }
              const int n = 32 * ni + r;
#pragma unroll
              for (int rg = 0; rg < 16; ++rg) { const int m = 32 * mi + crow(rg, h); float v = acc[rg];
                  if (which == 0) v += bf2f(*(const LAS bf16*)(SL(S_RT) + m * RS + n * 2));
                  if (which == 2 && m == n) v += PLv[n];
                  dst[m * 64 + n] = v; } } }
        LBAR();
    }
#undef R1_FETCH
#undef SL
}

__device__ __forceinline__ void phase_rwkv_r2(const Params& p, const Frame& F) {
    const float* CH = WSP(float, WS_CH); float* RO = WSP(float, WS_RO);
    LAS float* stb = (LAS float*)(F.lds);
    constexpr int STB = 4 * 1280;
    const int lane = F.lane, wave = F.wave, q = lane >> 4, li = lane & 15, w4 = wave & 3;
    const int nr2 = F.G >= 4 ? F.G / 4 : 1;
    if (F.vcu >= nr2) return;
    for (int bh = F.vcu; bh < 64; bh += nr2) {
        const int b = bh >> 3, hh = bh & 7;
        __syncthreads();
        for (int i = F.tid; i < 2 * STB; i += NTHREADS) stb[i] = 0.f;
        __syncthreads();
        const int mA = (wave < 4) ? 2 : 0, mC = (wave < 4) ? 3 : 1;
        const float* basec = CH + (size_t)bh * 64 * 4 * 4096;
        f32x4 fa[2][4], fc[2][4];
#define R2_FETCH(cc, st) do { const float* pa = basec + ((size_t)(cc) * 4 + mA) * 4096 + (16 * w4 + li) * 64 + 16 * q; fa[st][0] = *(const f32x4*)(pa); fa[st][1] = *(const f32x4*)(pa + 4); fa[st][2] = *(const f32x4*)(pa + 8); fa[st][3] = *(const f32x4*)(pa + 12); \
            const float* pc = basec + ((size_t)(cc) * 4 + mC) * 4096 + (16 * w4 + 4 * q) * 64 + li; \
            _Pragma("unroll") for (int ct = 0; ct < 4; ++ct) fc[st][ct] = (f32x4){pc[16 * ct], pc[64 + 16 * ct], pc[128 + 16 * ct], pc[192 + 16 * ct]}; } while (0)
        R2_FETCH(0, 0); R2_FETCH(1, 1);
#pragma unroll 1
        for (int c0 = 0; c0 < 64; c0 += 2) {
#pragma unroll
            for (int st = 0; st < 2; ++st) { const int c = c0 + st;
                const f32x4 A0 = fa[st][0], A1 = fa[st][1], A2 = fa[st][2], A3 = fa[st][3];
                f32x4 acc[4];
#pragma unroll
                for (int ct = 0; ct < 4; ++ct) acc[ct] = fc[st][ct];
                if (c + 2 < 64) R2_FETCH(c + 2, st);
#pragma unroll
                for (int ct = 0; ct < 4; ++ct) { const LAS float* sb = stb + (c & 1) * STB + ct * 1280 + lane * 20;
                    const f32x4 b0 = *(const LAS f32x4*)(sb), b1 = *(const LAS f32x4*)(sb + 4), b2 = *(const LAS f32x4*)(sb + 8), b3 = *(const LAS f32x4*)(sb + 12);
#pragma unroll
                    for (int k = 0; k < 4; ++k) acc[ct] = __builtin_amdgcn_mfma_f32_16x16x4f32(A0[k], b0[k], acc[ct], 0, 0, 0);
#pragma unroll
                    for (int k = 0; k < 4; ++k) acc[ct] = __builtin_amdgcn_mfma_f32_16x16x4f32(A1[k], b1[k], acc[ct], 0, 0, 0);
#pragma unroll
                    for (int k = 0; k < 4; ++k) acc[ct] = __builtin_amdgcn_mfma_f32_16x16x4f32(A2[k], b2[k], acc[ct], 0, 0, 0);
#pragma unroll
                    for (int k = 0; k < 4; ++k) acc[ct] = __builtin_amdgcn_mfma_f32_16x16x4f32(A3[k], b3[k], acc[ct], 0, 0, 0); }
                if (wave < 4) {
#pragma unroll
                    for (int ct = 0; ct < 4; ++ct) *(LAS f32x4*)(stb + ((c + 1) & 1) * STB + ct * 1280 + (w4 * 16 + li) * 20 + 4 * q) = acc[ct]; }
                else { float* ro = RO + ((size_t)b * SEQ + (size_t)c * 64 + 16 * w4 + 4 * q) * C5 + hh * 64 + li;
#pragma unroll
                    for (int ct = 0; ct < 4; ++ct) { ro[16 * ct] = acc[ct][0]; ro[C5 + 16 * ct] = acc[ct][1]; ro[2 * C5 + 16 * ct] = acc[ct][2]; ro[3 * C5 + 16 * ct] = acc[ct][3]; } }
                LBAR();
            }
        }
#undef R2_FETCH
    }
    __syncthreads();
}
#undef LBAR

__device__ __forceinline__ void phase_mix(const Params& p, const Frame& F, int l) {
    const int gw = F.vcu * NWAVES + F.wave, NGW = F.G * NWAVES; const int lane = F.lane;
    const bf16* O = WSP(bf16, WS_O); const float* RO = WSP(float, WS_RO); const bf16* RK = WSP(bf16, WS_RK); const bf16* AGp = WSP(bf16, WS_AG);
    const bf16* Vv = l == 0 ? WSP(bf16, WS_VS0) : WSP(bf16, WS_VR); bf16* MIX = WSP(bf16, WS_MIX);
    const float* og = INP(I_MOUTG) + (size_t)l * C5; const float* gng = INP(I_GNG) + (size_t)l * C5; const float* gnb = INP(I_GNB) + (size_t)l * C5;
    const float* kaw = INP(I_KA) + (size_t)l * C5; const float* rkw = INP(I_RK) + (size_t)l * C5;
#pragma unroll 2
    for (int t = gw; t < T; t += NGW) {
        const int c = 8 * lane;
        { const u32x4 ow = *(const u32x4*)(O + (size_t)t * C5 + c); float o[8]; float ss = 0.f;
#pragma unroll
          for (int j = 0; j < 4; ++j) { o[2 * j] = bflo(ow[j]); o[2 * j + 1] = bfhi(ow[j]); ss += o[2 * j] * o[2 * j] + o[2 * j + 1] * o[2 * j + 1]; }
          const float rs = 1.f / sqrtf(wave_sum(ss) * (1.f / C5) + RMS_EPS);
          const f32x4 g0 = *(const f32x4*)(og + c), g1 = *(const f32x4*)(og + c + 4);
          u32x4 w; w.x = pk2(o[0] * rs * g0.x, o[1] * rs * g0.y); w.y = pk2(o[2] * rs * g0.z, o[3] * rs * g0.w); w.z = pk2(o[4] * rs * g1.x, o[5] * rs * g1.y); w.w = pk2(o[6] * rs * g1.z, o[7] * rs * g1.w);
          *(u32x4*)(MIX + (size_t)t * D + c) = w; }
        { const f32x4 r0 = *(const f32x4*)(RO + (size_t)t * C5 + c), r1 = *(const f32x4*)(RO + (size_t)t * C5 + c + 4);
          float o[8]; float s = 0.f;
#pragma unroll
          for (int j = 0; j < 8; ++j) { o[j] = j < 4 ? r0[j & 3] : r1[j & 3]; s += o[j]; }
          s += __shfl_xor(s, 1); s += __shfl_xor(s, 2); s += __shfl_xor(s, 4); const float mean = s * (1.f / 64.f); float q = 0.f;
#pragma unroll
          for (int j = 0; j < 8; ++j) { o[j] -= mean; q += o[j] * o[j]; }
          q += __shfl_xor(q, 1); q += __shfl_xor(q, 2); q += __shfl_xor(q, 4); const float rstd = 1.f / sqrtf(q * (1.f / 64.f) + GN_EPS);
          const u32x4 rw = *(const u32x4*)(RK + (size_t)t * 1024 + c), kw = *(const u32x4*)(RK + (size_t)t * 1024 + 512 + c), vw = *(const u32x4*)(Vv + (size_t)t * C5 + c);
          const u32x4 aw = *(const u32x4*)(AGp + (size_t)t * 1024 + c), gw = *(const u32x4*)(AGp + (size_t)t * 1024 + 512 + c);
          const f32x4 a0 = (f32x4){bflo(aw.x), bfhi(aw.x), bflo(aw.y), bfhi(aw.y)}, a1 = (f32x4){bflo(aw.z), bfhi(aw.z), bflo(aw.w), bfhi(aw.w)};
          const f32x4 g0 = (f32x4){bflo(gw.x), bfhi(gw.x), bflo(gw.y), bfhi(gw.y)}, g1 = (f32x4){bflo(gw.z), bfhi(gw.z), bflo(gw.w), bfhi(gw.w)};
          const f32x4 ka0 = *(const f32x4*)(kaw + c), ka1 = *(const f32x4*)(kaw + c + 4), rk0 = *(const f32x4*)(rkw + c), rk1 = *(const f32x4*)(rkw + c + 4);
          const f32x4 gg0 = *(const f32x4*)(gng + c), gg1 = *(const f32x4*)(gng + c + 4), gb0 = *(const f32x4*)(gnb + c), gb1 = *(const f32x4*)(gnb + c + 4);
          float r[8], k[8], v[8]; float bon = 0.f;
#pragma unroll
          for (int j = 0; j < 4; ++j) { r[2 * j] = bflo(rw[j]); r[2 * j + 1] = bfhi(rw[j]); k[2 * j] = bflo(kw[j]); k[2 * j + 1] = bfhi(kw[j]); v[2 * j] = bflo(vw[j]); v[2 * j + 1] = bfhi(vw[j]); }
#pragma unroll
          for (int j = 0; j < 8; ++j) { const float a = j < 4 ? a0[j & 3] : a1[j & 3]; const float kp = k[j] * (1.0f + (a - 1.0f) * (j < 4 ? ka0[j & 3] : ka1[j & 3])); bon += r[j] * kp * (j < 4 ? rk0[j & 3] : rk1[j & 3]); }
          bon += __shfl_xor(bon, 1); bon += __shfl_xor(bon, 2); bon += __shfl_xor(bon, 4);
          float y[8];
#pragma unroll
          for (int j = 0; j < 8; ++j) { const float gn = o[j] * rstd * (j < 4 ? gg0[j & 3] : gg1[j & 3]) + (j < 4 ? gb0[j & 3] : gb1[j & 3]); y[j] = (gn + bon * v[j]) * (j < 4 ? g0[j & 3] : g1[j & 3]); }
          u32x4 w; w.x = pk2(y[0], y[1]); w.y = pk2(y[2], y[3]); w.z = pk2(y[4], y[5]); w.w = pk2(y[6], y[7]);
          *(u32x4*)(MIX + (size_t)t * D + C5 + c) = w; }
    }
}

#define DPPI(x, ctrl) __builtin_amdgcn_update_dpp(0, (x), (ctrl), 0xF, 0xF, true)
__device__ __forceinline__ float row16_max(float x) {
    x = fmaxf(x, __builtin_bit_cast(float, DPPI(__builtin_bit_cast(int, x), 0xB1))); x = fmaxf(x, __builtin_bit_cast(float, DPPI(__builtin_bit_cast(int, x), 0x4E)));
    x = fmaxf(x, __builtin_bit_cast(float, DPPI(__builtin_bit_cast(int, x), 0x141))); x = fmaxf(x, __builtin_bit_cast(float, DPPI(__builtin_bit_cast(int, x), 0x140))); return x; }
__device__ __forceinline__ int row16_min(int x) {
    x = min(x, DPPI(x, 0xB1)); x = min(x, DPPI(x, 0x4E)); x = min(x, DPPI(x, 0x141)); x = min(x, DPPI(x, 0x140)); return x; }
__device__ __forceinline__ void phase_ln1_route(const Params& p, const Frame& F, int l) {
    LAS unsigned char* wl = F.lds;
    LAS int* hist = (LAS int*)(F.lds + LDSX_OFF + 4096);
    LAS int* basep = hist + 32;
    LAS int* rinfo = hist + 64;
    LAS float* rgate = (LAS float*)(rinfo + 512);
    const float* mod = WSP(float, WS_MOD) + (size_t)l * NBATCH * 6144;
    const float* g1 = INP(I_LN1G) + (size_t)l * D; const float* b1 = INP(I_LN1B) + (size_t)l * D;
    const float* rb = INP(I_RB) + (size_t)l * NE;
    unsigned* cnt = (unsigned*)(F.ws + WS_CTL) + CW_CNT + l * 64;
    int* LIST = WSP(int, WS_LIST); float* GATEL = WSP(float, WS_GATEL); int* TOKSLOT = WSP(int, WS_TOKSLOT);
    bf16* X = WSP(bf16, WS_X); bf16* H = WSP(bf16, WS_H);
    const int lane = F.lane, li = lane & 15, g = lane >> 4;
    __syncthreads();
    for (int i = F.tid; i < 2 * 4096; i += NTHREADS) { const int part = i >> 12, rem = i & 4095, e = rem >> 7, ch = rem & 127;
        const u32x4 v = *(const u32x4*)(WSP(bf16, WS_RWT) + ((size_t)part * DEPTH + l) * NE * D + (size_t)e * D + ch * 8);
        *(LAS u32x4*)(wl + part * 65536 + e * 2048 + ((ch ^ (e & 15)) << 4)) = v; }
    __syncthreads();
    for (int chunk = F.vcu; chunk < T / 128; chunk += F.G) {
        __syncthreads();
        if (F.tid < 32) hist[F.tid] = 0;
        __syncthreads();
        const int row0 = chunk * 128 + F.wave * 16; const int b = row0 / SEQ;
        float mymean = 0.f, myrstd = 0.f;
#pragma unroll 1
        for (int rr = 0; rr < 16; ++rr) {
            const GAS u32x2* xr = (const GAS u32x2*)(X + (size_t)(row0 + rr) * D) + lane;
            f32x4 v[4]; float s = 0.f;
#pragma unroll
            for (int j = 0; j < 4; ++j) { const u32x2 w = xr[64 * j]; v[j] = (f32x4){bflo(w.x), bfhi(w.x), bflo(w.y), bfhi(w.y)}; s += (v[j].x + v[j].y) + (v[j].z + v[j].w); }
            const float mean = wave_sum(s) * (1.f / D); float s2 = 0.f;
#pragma unroll
            for (int j = 0; j < 4; ++j) { v[j] = v[j] - mean; s2 += (v[j].x * v[j].x + v[j].y * v[j].y) + (v[j].z * v[j].z + v[j].w * v[j].w); }
            const float rstd = __builtin_amdgcn_rsqf(wave_sum(s2) * (1.f / D) + LN_EPS);
            if (li == rr) { mymean = mean; myrstd = rstd; }
        }
        f32x4 acc0 = (f32x4){0.f, 0.f, 0.f, 0.f}, acc1 = acc0;
        bf16* xrow = X + (size_t)(row0 + li) * D + 8 * g; bf16* hrow = H + (size_t)(row0 + li) * D + 8 * g;
        const float* shp = mod + (size_t)b * 6144 + 3072 + 8 * g; const float* scp = mod + (size_t)b * 6144 + 4096 + 8 * g;
        const LAS unsigned char* w0 = wl + li * 2048; const LAS unsigned char* w1 = wl + (16 + li) * 2048;
#pragma unroll 2
        for (int s = 0; s < 32; ++s) {
            const int k = 32 * s;
            const u32x4 yw = *(const u32x4*)(xrow + k); const f32x4 y0 = (f32x4){bflo(yw.x), bfhi(yw.x), bflo(yw.y), bfhi(yw.y)}, y1 = (f32x4){bflo(yw.z), bfhi(yw.z), bflo(yw.w), bfhi(yw.w)};
            const f32x4 ga0 = *(const f32x4*)(g1 + k + 8 * g), ga1 = *(const f32x4*)(g1 + k + 8 * g + 4), be0 = *(const f32x4*)(b1 + k + 8 * g), be1 = *(const f32x4*)(b1 + k + 8 * g + 4);
            const f32x4 sc0 = *(const f32x4*)(scp + k), sc1 = *(const f32x4*)(scp + k + 4), sh0 = *(const f32x4*)(shp + k), sh1 = *(const f32x4*)(shp + k + 4);
            const f32x4 x0 = (y0 - mymean) * myrstd * ga0 + be0, x1 = (y1 - mymean) * myrstd * ga1 + be1;
            { u32x4 xw; xw.x = cvtpk_c(x0.x, x0.y); xw.y = cvtpk_c(x0.z, x0.w); xw.z = cvtpk_c(x1.x, x1.y); xw.w = cvtpk_c(x1.z, x1.w); *(u32x4*)(xrow + k) = xw; }
            const f32x4 h0 = x0 * (sc0 + 1.0f) + sh0, h1 = x1 * (sc1 + 1.0f) + sh1;
            u32x4 hi; hi.x = cvtpk_c(h0.x, h0.y); hi.y = cvtpk_c(h0.z, h0.w); hi.z = cvtpk_c(h1.x, h1.y); hi.w = cvtpk_c(h1.z, h1.w);
            *(u32x4*)(hrow + k) = hi;
            u32x4 lo; lo.x = cvtpk_c(h0.x - bflo(hi.x), h0.y - bfhi(hi.x)); lo.y = cvtpk_c(h0.z - bflo(hi.y), h0.w - bfhi(hi.y)); lo.z = cvtpk_c(h1.x - bflo(hi.z), h1.y - bfhi(hi.z)); lo.w = cvtpk_c(h1.z - bflo(hi.w), h1.w - bfhi(hi.w));
            const int cho = ((4 * s + g) ^ li) << 4;
            const bf16x8 bh0 = *(const LAS bf16x8*)(w0 + cho), bh1 = *(const LAS bf16x8*)(w1 + cho), bl0 = *(const LAS bf16x8*)(w0 + 65536 + cho), bl1 = *(const LAS bf16x8*)(w1 + 65536 + cho);
            const bf16x8 ahi = __builtin_bit_cast(bf16x8, hi), alo = __builtin_bit_cast(bf16x8, lo);
            acc0 = __builtin_amdgcn_mfma_f32_16x16x32_bf16(ahi, bh0, acc0, 0, 0, 0); acc1 = __builtin_amdgcn_mfma_f32_16x16x32_bf16(ahi, bh1, acc1, 0, 0, 0);
            acc0 = __builtin_amdgcn_mfma_f32_16x16x32_bf16(alo, bh0, acc0, 0, 0, 0); acc1 = __builtin_amdgcn_mfma_f32_16x16x32_bf16(alo, bh1, acc1, 0, 0, 0);
            acc0 = __builtin_amdgcn_mfma_f32_16x16x32_bf16(ahi, bl0, acc0, 0, 0, 0); acc1 = __builtin_amdgcn_mfma_f32_16x16x32_bf16(ahi, bl1, acc1, 0, 0, 0);
        }
        const float rb0 = rb[li], rb1 = rb[16 + li];
#pragma unroll
        for (int reg = 0; reg < 4; ++reg) {
            float v0 = acc0[reg] + rb0, v1 = acc1[reg] + rb1;
            float tv0 = 0.f, tv1 = 0.f, tv2 = 0.f, tv3 = 0.f; int te0 = 0, te1 = 0, te2 = 0, te3 = 0;
#pragma unroll
            for (int k = 0; k < 4; ++k) { const float mx = row16_max(fmaxf(v0, v1));
                const int id = (v0 == mx) ? li : ((v1 == mx) ? 16 + li : 99); const int ek = row16_min(id);
                if (k == 0) { tv0 = mx; te0 = ek; } else if (k == 1) { tv1 = mx; te1 = ek; } else if (k == 2) { tv2 = mx; te2 = ek; } else { tv3 = mx; te3 = ek; }
                if (ek == li) v0 = -INFINITY; if (ek == 16 + li) v1 = -INFINITY; }
            const float e1 = __expf(tv1 - tv0), e2 = __expf(tv2 - tv0), e3 = __expf(tv3 - tv0); const float inv = __builtin_amdgcn_rcpf(1.0f + e1 + e2 + e3);
            if (li < 4) { const int lr = F.wave * 16 + 4 * g + reg; const int ek = li == 0 ? te0 : li == 1 ? te1 : li == 2 ? te2 : te3; const float gk = (li == 0 ? 1.0f : li == 1 ? e1 : li == 2 ? e2 : e3) * inv;
                const int lp = __hip_atomic_fetch_add(&hist[ek], 1, __ATOMIC_RELAXED, __HIP_MEMORY_SCOPE_WORKGROUP); rinfo[lr * 4 + li] = (ek << 16) | lp; rgate[lr * 4 + li] = gk; }
        }
        __syncthreads();
        if (F.tid < 32) basep[F.tid] = (int)__hip_atomic_fetch_add(cnt + F.tid, (unsigned)hist[F.tid], RLX_AGENT);
        __syncthreads();
        { const int lr = F.tid >> 2, k = F.tid & 3; const int m = chunk * 128 + lr; const int info = rinfo[F.tid]; const int ek = info >> 16; const int pos = basep[ek] + (info & 0xffff);
          LIST[ek * CAP + pos] = m; GATEL[ek * CAP + pos] = rgate[F.tid]; TOKSLOT[m * 4 + k] = (ek << 16) | pos; }
    }
    __syncthreads();
}

__device__ __forceinline__ void moe_tables(const Frame& F, int l) {
    LAS int* tb = (LAS int*)(F.lds + TB_OFF); LAS int* cn = tb + 40;
    const unsigned* cnt = (const unsigned*)(F.ws + WS_CTL) + CW_CNT + l * 64;
    __syncthreads();
    if (F.tid == 0) { int acc = 0;
        for (int e = 0; e < NE; ++e) { const int c = (int)__hip_atomic_load(cnt + e, RLX_AGENT); cn[e] = c; tb[e] = acc; acc += (c + 255) >> 8; }
        tb[NE] = acc; }
    __syncthreads();
}

__device__ __forceinline__ void phase_combine(const Params& p, const Frame& F, int l) {
    const LAS int* tb = (const LAS int*)(F.lds + TB_OFF);
    const int gw = F.vcu * NWAVES + F.wave, NGW = F.G * NWAVES; const int lane = F.lane;
    const float* mod = WSP(float, WS_MOD) + (size_t)l * NBATCH * 6144; const float* modn = WSP(float, WS_MOD) + (size_t)(l + 1) * NBATCH * 6144;
    const float* g2 = INP(I_LN2G) + (size_t)l * D; const float* b2 = INP(I_LN2B) + (size_t)l * D;
    const bf16* Y = WSP(bf16, WS_Y); const int* TOKSLOT = WSP(int, WS_TOKSLOT);
    const bool lastl = (l == DEPTH - 1);
#pragma unroll 2
    for (int m = gw; m < T; m += NGW) {
        const int b = m / SEQ;
        int srow[4];
#pragma unroll
        for (int k = 0; k < 4; ++k) { const int ts = TOKSLOT[m * 4 + k]; const int e = ts >> 16, pos = ts & 0xffff; srow[k] = tb[e] * 256 + pos; }
        GAS u32x2* xr = (GAS u32x2*)(WSP(bf16, WS_X) + (size_t)m * D) + lane;
        f32x4 v[4]; float s = 0.f;
#pragma unroll
        for (int j = 0; j < 4; ++j) { const int c = 4 * lane + 256 * j; f32x4 y = (f32x4){0.f, 0.f, 0.f, 0.f};
#pragma unroll
            for (int k = 0; k < 4; ++k) { const u32x2 yw = *(const u32x2*)(Y + (size_t)srow[k] * D + c); y.x += bflo(yw.x); y.y += bfhi(yw.x); y.z += bflo(yw.y); y.w += bfhi(yw.y); }
            const f32x4 gt = *(const f32x4*)(mod + (size_t)b * 6144 + 5120 + c) + 1.0f;
            const u32x2 xw = xr[64 * j]; v[j] = (f32x4){bflo(xw.x), bfhi(xw.x), bflo(xw.y), bfhi(xw.y)} * DN_ALPHA + gt * y; s += (v[j].x + v[j].y) + (v[j].z + v[j].w); }
        const float mean = wave_sum(s) * (1.f / D); float s2 = 0.f;
#pragma unroll
        for (int j = 0; j < 4; ++j) { v[j] = v[j] - mean; s2 += (v[j].x * v[j].x + v[j].y * v[j].y) + (v[j].z * v[j].z + v[j].w * v[j].w); }
        const float rstd = 1.f / sqrtf(wave_sum(s2) * (1.f / D) + LN_EPS);
        GAS f32x4* oo = (GAS f32x4*)(p.out + (size_t)m * D) + lane;
        GAS u32x2* ho = (GAS u32x2*)(WSP(bf16, WS_H) + (size_t)m * D) + lane;
#pragma unroll
        for (int j = 0; j < 4; ++j) { const int c = 4 * lane + 256 * j;
            const f32x4 g = *(const f32x4*)(g2 + c), be = *(const f32x4*)(b2 + c);
            const f32x4 x2 = v[j] * rstd * g + be;
            if (lastl) oo[64 * j] = x2;
            else { { u32x2 xw; xw.x = pk2(x2.x, x2.y); xw.y = pk2(x2.z, x2.w); xr[64 * j] = xw; }
                const f32x4 sh = *(const f32x4*)(modn + (size_t)b * 6144 + c), sc = *(const f32x4*)(modn + (size_t)b * 6144 + 1024 + c);
                const f32x4 h = x2 * (sc + 1.0f) + sh; u32x2 w; w.x = pk2(h.x, h.y); w.y = pk2(h.z, h.w); ho[64 * j] = w; } }
    }
}

constexpr int PH_PER_LAYER = 11, N_PHASES = 2 + DEPTH * PH_PER_LAYER;
__global__ void __launch_bounds__(NTHREADS, 2) fwd(Params p) {
    extern __shared__ __attribute__((aligned(16))) unsigned char lds[];
    Frame F;
    F.lds = (LAS unsigned char*)lds; F.tid = threadIdx.x; F.lane = F.tid & 63; F.wave = __builtin_amdgcn_readfirstlane(F.tid >> 6);
    F.G = gridDim.x; { const int bx = blockIdx.x; F.vcu = (F.G % 8 == 0) ? (bx % 8) * (F.G / 8) + bx / 8 : bx; }
    F.ws = p.ws;
    volatile LAS unsigned* MISC = (volatile LAS unsigned*)(F.lds + MISC_OFF);
    if (F.tid < 64) MISC[F.tid] = 0u;
    __syncthreads();
    unsigned* ctl = (unsigned*)(p.ws + WS_CTL);
#if MK_ONE_LAUNCH
    XcdBarrier bar = xcd_barrier_post(ctl + CW_BAR, MISC + 8);
#define GRID_BAR() xcd_barrier(bar)
#else
#define GRID_BAR() do {} while (0)
#endif
    const int lo = p.ph_lo, hi = p.ph_hi;
#ifndef PH_MASK
#define PH_MASK 0xFFFFFFFFu
#endif
#define IN(k) (lo <= (k) && (k) < hi)
#define EN(j) ((PH_MASK >> (j)) & 1u)
#define SEAM(k) do { if (IN(k) && IN((k) + 1)) GRID_BAR(); } while (0)
    LAS unsigned char* ring = F.lds;

    if (EN(0) && IN(0)) { for (int rep = 0; rep < REP_PRO; ++rep) phase_prologue(p, F); } SEAM(0);
    if (EN(1) && IN(1)) { phase_ln0(p, F); } SEAM(1);
#define LAYER_BODY \
        constexpr int pb = 2 + l * PH_PER_LAYER; \
        const float* mod = WSP(float, WS_MOD) + (size_t)l * NBATCH * 6144; \
        if (EN(2) && IN(pb + 0)) { \
            pg8::Gemm g{WSP(bf16, WS_H), WSP(bf16, WS_WINT) + (size_t)l * N_INP * D, T, N_INP, D}; pg8::DenseOrder S; S.init(T, N_INP, F.G, (int)blockIdx.x); \
            pg8::EpiBf16Plain E{WSP(bf16, WS_P), N_INP}; \
            for (int rep = 0; rep < REP_WIN; ++rep) pg8::gemm_phase<pg8::EpiBf16Plain, pg8::DenseOrder, true>(ring, g, S, E); \
        } SEAM(pb + 0); \
        if (EN(3) && IN(pb + 1)) { phase_pgemm(p, F, l); } SEAM(pb + 1); \
        if (EN(5) && IN(pb + 3)) { phase_rwkv_r1(p, F, l); } SEAM(pb + 3); \
        if (EN(6) && IN(pb + 4)) { phase_rwkv_r2(p, F); if (l == 0) { const int c0 = F.G / 4, nc = (F.G * 3) / 8; if (F.vcu >= c0 && F.vcu < c0 + nc) phase_convert_experts(p, F, c0, nc); } phase_attn(p, F, (char*)lds, l); } SEAM(pb + 4); \
        if (EN(7) && IN(pb + 5)) { for (int rep = 0; rep < REP_MIX; ++rep) phase_mix(p, F, l); } SEAM(pb + 5); \
        if (EN(8) && IN(pb + 6)) { \
            pg8::Gemm g{WSP(bf16, WS_MIX), WSP(bf16, WS_WOT) + (size_t)l * D * D, T, D, D}; pg8::DenseOrder S; S.init(T, D, F.G, (int)blockIdx.x); \
            pg8::EpiWo E{WSP(bf16, WS_X), mod + 2048}; \
            pg8::gemm_phase<pg8::EpiWo, pg8::DenseOrder, true>(ring, g, S, E); \
        } SEAM(pb + 6); \
        if (EN(9) && IN(pb + 7)) { phase_ln1_route(p, F, l); } SEAM(pb + 7); \
        if (EN(10) && IN(pb + 8)) { \
            moe_tables(F, l); \
            const LAS int* tb = (const LAS int*)(F.lds + TB_OFF); \
            pg8::Gemm g{WSP(bf16, WS_H), WSP(bf16, WS_W1T) + (size_t)l * NE * 2048 * D, T, 2048, D}; \
            pg8::MoeOrder<true> S{tb, tb + 40, WSP(int, WS_LIST), 8, F.G, F.vcu, (LAS unsigned*)(F.lds + GT_OFF)}; \
            pg8::EpiSwiglu E{WSP(bf16, WS_H1), WSP(float, WS_B1P) + (size_t)l * NE * 2048}; \
            for (int rep = 0; rep < REP_MOE1; ++rep) pg8::gemm_phase<pg8::EpiSwiglu, pg8::MoeOrder<true>, true>(ring, g, S, E); \
        } SEAM(pb + 8); \
        if (EN(11) && IN(pb + 9)) { \
            moe_tables(F, l); \
            const LAS int* tb = (const LAS int*)(F.lds + TB_OFF); \
            pg8::Gemm g{WSP(bf16, WS_H1), WSP(bf16, WS_W2T) + (size_t)l * NE * D * FF, MAXSLOT, D, FF}; \
            pg8::MoeOrder<false> S{tb, tb + 40, nullptr, 4, F.G, F.vcu, nullptr}; \
            pg8::EpiMoeOut E{WSP(bf16, WS_Y), INP(I_EB2) + (size_t)l * NE * D, WSP(float, WS_GATEL), tb}; \
            for (int rep = 0; rep < REP_MOE2; ++rep) pg8::gemm_phase<pg8::EpiMoeOut, pg8::MoeOrder<false>, true>(ring, g, S, E); \
        } SEAM(pb + 9); \
        if (EN(12) && IN(pb + 10)) { moe_tables(F, l); phase_combine(p, F, l); } SEAM(pb + 10);
    { constexpr int l = 0; LAYER_BODY }
    { constexpr int l = 1; LAYER_BODY }
#undef LAYER_BODY
#undef IN
#undef SEAM
}

extern "C" void kernel_launch(void* const* d_in, const int* in_sizes, int n_in, void* d_out, int out_size, void* d_ws, size_t ws_size, hipStream_t stream) {
    static int grid = 0;
    if (grid == 0) {
        if (n_in != N_INPUTS || out_size != T * D || ws_size < WS_END) { fprintf(stderr, "kernel_launch: unexpected problem: n_in %d out %d ws %zu\n", n_in, out_size, ws_size); grid = -1; return; }
        int dev = 0, cus = 0, per_cu = 0;
        if (hipGetDevice(&dev) != hipSuccess || hipDeviceGetAttribute(&cus, hipDeviceAttributeMultiprocessorCount, dev) != hipSuccess) { grid = -1; return; }
        if (hipFuncSetAttribute((const void*)fwd, hipFuncAttributeMaxDynamicSharedMemorySize, LDS_BYTES) != hipSuccess) { fprintf(stderr, "kernel_launch: hipFuncSetAttribute failed\n"); grid = -1; return; }
        if (hipOccupancyMaxActiveBlocksPerMultiprocessor(&per_cu, (const void*)fwd, NTHREADS, LDS_BYTES) != hipSuccess || per_cu < 1) fprintf(stderr, "kernel_launch: occupancy query reports %d\n", per_cu);
        (void)hipGetLastError();
        grid = cus;
    }
    if (grid < 0) return;
    if (hipMemsetAsync((char*)d_ws + WS_CTL, 0, CTL_ZERO_BYTES, stream) != hipSuccess) return;
    Params p{};
    for (int i = 0; i < N_INPUTS; ++i) p.in[i] = d_in[i];
    p.out = (float*)d_out; p.ws = (unsigned char*)d_ws;
#if MK_ONE_LAUNCH
    p.ph_lo = 0; p.ph_hi = N_PHASES;
    hipLaunchKernelGGL(fwd, dim3(grid), dim3(NTHREADS), LDS_BYTES, stream, p);
#else
    for (int ph = 0; ph < N_PHASES; ++ph) { p.ph_lo = ph; p.ph_hi = ph + 1; hipLaunchKernelGGL(fwd, dim3(grid), dim3(NTHREADS), LDS_BYTES, stream, p); }
#endif
}
```

```cpp
#include <hip/hip_runtime.h>
#include <cstdio>
#include <cstdint>

#define REP_PRO 1
#define REP_ATTN 1
#define REP_RWKV 1
#define REP_MOE1 1
#define REP_MOE2 1
#define REP_WIN 1
#define REP_PREP 1
#define REP_MIX 1
#ifndef MK_ONE_LAUNCH
#define MK_ONE_LAUNCH 1
#endif

#define GAS __attribute__((address_space(1)))
#define LAS __attribute__((address_space(3)))
typedef unsigned short bf16;
typedef short bf16x8 __attribute__((ext_vector_type(8)));
typedef short s16x4 __attribute__((ext_vector_type(4)));
typedef float f32x2 __attribute__((ext_vector_type(2)));
typedef float f32x4 __attribute__((ext_vector_type(4)));
typedef float f32x16 __attribute__((ext_vector_type(16)));
typedef unsigned u32x2 __attribute__((ext_vector_type(2)));
typedef unsigned u32x4 __attribute__((ext_vector_type(4)));
typedef int i32x4 __attribute__((ext_vector_type(4)));

constexpr int D = 1024, NBATCH = 8, SEQ = 4096, T = NBATCH * SEQ, DEPTH = 2;
constexpr int MLA_IN = 416, RWKV_IN = 1792, N_IN = 2208, N_INP = 2304;
constexpr int QLR = 256, KVLR = 128, ROPE = 32, NOPE = 64, QKD = 96, VD = 64, NH = 8;
constexpr int C5 = 512;
constexpr int NE = 32, TOPK = 4, FF = 1024, CAP = 32768;
constexpr int N_UP = 1792, K_UP = 384, N_SM = 1536, K_SM = 256;
constexpr int MAXSLOT = 139264;
constexpr float DN_ALPHA = 1.4142135623730951f;
constexpr float C2Q = 0.14724444602590306f;
constexpr float LN_EPS = 1e-5f, RMS_EPS = 1e-6f, GN_EPS = 64e-5f;
constexpr int NWAVES = 8, NTHREADS = 512;
constexpr float QS_H = 16.f, QS_W1 = 512.f, QS_U = 8.f, QS_W2 = 1024.f;
constexpr int PGW_Q = 0, PGW_KN = 384, PGW_V = 512, PGW_W = 640, PGW_A = 704, PGW_G = 768, PGW_VR = 896, PGW_NFRAG = 1408;

enum { I_X = 0, I_C, I_POS, I_ELNG, I_ELNB, I_ADAW, I_ADAB, I_WIN, I_QNG, I_WUQ, I_KVNG, I_WUK, I_WUV, I_MOUTG, I_MU, I_W0, I_W2, I_A0, I_A2, I_G2,
       I_KK, I_KA, I_RK, I_GNG, I_GNB, I_V0, I_V1, I_V2, I_WO, I_LN1G, I_LN1B, I_RW, I_RB, I_EW1, I_EB1, I_EW2, I_EB2, I_LN2G, I_LN2B, N_INPUTS };

constexpr size_t MiB = 1u << 20;
constexpr size_t WS_CTL = 0, CTL_ZERO_BYTES = 4 * MiB;
constexpr size_t WS_MOD = 4 * MiB, WS_B1P = 5 * MiB, WS_CS = 6 * MiB, WS_LIST = 10 * MiB, WS_GATEL = 14 * MiB, WS_TOKSLOT = 18 * MiB;
constexpr size_t WS_RWT = 19 * MiB;
constexpr size_t WS_WINT = 20 * MiB, WS_WUPT = 30 * MiB, WS_WSMT = 33 * MiB, WS_WV12T = 35 * MiB, WS_WOT = 36 * MiB, WS_W1T = 40 * MiB, WS_W2T = 296 * MiB;
constexpr size_t WS_X = 424 * MiB, WS_H = 552 * MiB, WS_VS0 = 616 * MiB, WS_VS1 = 648 * MiB;
constexpr size_t WS_P = 680 * MiB, WS_AN = 824 * MiB, WS_A2 = 848 * MiB, WS_RK = 864 * MiB, WS_Q = 928 * MiB, WS_KK = 976 * MiB, WS_V = 1024 * MiB, WS_O = 1056 * MiB;
constexpr size_t WS_WAG = 1088 * MiB, WS_RO = 1280 * MiB, WS_MIX = 1344 * MiB, WS_VR = 1408 * MiB;
constexpr size_t WS_LW = WS_WAG, WS_AG = WS_WAG + 64 * MiB;
constexpr size_t WS_H8 = WS_MIX;
constexpr size_t WS_H1 = 680 * MiB, WS_Y = 952 * MiB;
constexpr size_t WS_CH = 1440 * MiB;
constexpr size_t WS_PGW = 1696 * MiB;
constexpr size_t WS_END = 1700 * MiB;
constexpr int CW_TMO = 0, CW_CODE = 1, CW_BAR = 4096, CW_CNT = 8192, CW_ATTQ = 8448;

constexpr int RING_BYTES = 131072;
constexpr int LDSX_OFF = RING_BYTES;
constexpr int MISC_OFF = LDSX_OFF;
constexpr int TB_OFF = LDSX_OFF + 256;
constexpr int GT_OFF = LDSX_OFF + 1024;
constexpr int LDS_BYTES = 147456;

#define RLX_AGENT __ATOMIC_RELAXED, __HIP_MEMORY_SCOPE_AGENT
#define LDS_WAIT() asm volatile("s_waitcnt lgkmcnt(0)" ::: "memory")
#define VM_WAIT() asm volatile("s_waitcnt vmcnt(0)" ::: "memory")

__device__ __forceinline__ unsigned f2bf(float f) { unsigned u = __builtin_bit_cast(unsigned, f); return (u + 0x7fffu + ((u >> 16) & 1u)) >> 16; }
__device__ __forceinline__ unsigned pk2(float lo, float hi) { return f2bf(lo) | (f2bf(hi) << 16); }
__device__ __forceinline__ float bf2f(unsigned b) { return __builtin_bit_cast(float, b << 16); }
__device__ __forceinline__ float bflo(unsigned w) { return __builtin_bit_cast(float, w << 16); }
__device__ __forceinline__ float bfhi(unsigned w) { return __builtin_bit_cast(float, w & 0xffff0000u); }
__device__ __forceinline__ unsigned cvt_pk_bf16(float lo, float hi) { unsigned r; asm volatile("v_cvt_pk_bf16_f32 %0, %1, %2" : "=v"(r) : "v"(lo), "v"(hi)); return r; }
typedef __bf16 bf16x2_t __attribute__((ext_vector_type(2)));
__device__ __forceinline__ unsigned cvtpk_c(float lo, float hi) { f32x2 v = {lo, hi}; bf16x2_t b = __builtin_convertvector(v, bf16x2_t); return __builtin_bit_cast(unsigned, b); }
__device__ __forceinline__ unsigned q8(float x) { return (unsigned)(int)__builtin_rintf(fminf(fmaxf(x, -127.f), 127.f)) & 0xffu; }
__device__ __forceinline__ unsigned q8x4(float a, float b, float c, float d) { return q8(a) | (q8(b) << 8) | (q8(c) << 16) | (q8(d) << 24); }
__device__ __forceinline__ float wave_sum(float v) {
#pragma unroll
    for (int o = 1; o < 64; o <<= 1) v += __shfl_xor(v, o);
    return v;
}
__device__ __forceinline__ float sigmoidf_(float x) { return __builtin_amdgcn_rcpf(1.0f + __expf(-x)); }
__device__ __forceinline__ float tanhf_(float x) { return 1.0f - 2.0f * __builtin_amdgcn_rcpf(1.0f + __expf(2.0f * x)); }

#define XB_TMO      128
#define XB_XCNT(j)  (256  + 64 * (j))
#define XB_XSUB(j)  (1280 + 64 * (j))
#define XB_XGEN(j)  (2304 + 64 * (j))
#define XB_TOP      3328
#define XB_TOPGEN   3392
#define XCD_BAR_WORDS 3456
#define XB_SPIN_CAP (1u << 18)
__device__ __forceinline__ unsigned xb_ld(unsigned* p)              { return __hip_atomic_load(p, __ATOMIC_RELAXED, __HIP_MEMORY_SCOPE_AGENT); }
__device__ __forceinline__ unsigned xb_add(unsigned* p, unsigned v) { return __hip_atomic_fetch_add(p, v, __ATOMIC_RELAXED, __HIP_MEMORY_SCOPE_AGENT); }
__device__ __forceinline__ unsigned xb_xcc_id() { return (unsigned)__builtin_amdgcn_s_getreg((3 << 11) | 20) & 0xFu; }
#define XB_SPIN(cond, bar) do { unsigned _sp = 0; while (cond) { __builtin_amdgcn_s_sleep(1); \
    if ((++_sp & 255u) == 0u) { if (xb_ld(&(bar)[XB_TMO])) break; if (_sp > XB_SPIN_CAP) { atomicAdd(&(bar)[XB_TMO], 1u); break; } } } } while (0)
struct XcdBarrier { unsigned* bar; unsigned x; volatile LAS unsigned* st; };
__device__ __forceinline__ XcdBarrier xcd_barrier_post(unsigned* bar, volatile LAS unsigned* st) {
    XcdBarrier b; b.bar = bar; b.x = xb_xcc_id(); b.st = st;
    if (threadIdx.x == 0) (void)xb_add(&bar[XB_XCNT(b.x)], 1u);
    return b;
}
__device__ __forceinline__ void xcd_barrier_complete(unsigned* bar, unsigned x, unsigned& nloc, unsigned& nx) {
    const unsigned G = gridDim.x * gridDim.y * gridDim.z;
    unsigned sum, cnt, mine, sp = 0u;
    for (;;) {
        sum = 0u; cnt = 0u; mine = 0u;
#pragma unroll
        for (unsigned j = 0; j < 16; ++j) { const unsigned c = xb_ld(&bar[XB_XCNT(j)]); sum += c; cnt += (c > 0u) ? 1u : 0u; mine = (j == x) ? c : mine; }
        if (sum == G) break;
        __builtin_amdgcn_s_sleep(1);
        if ((++sp & 255u) == 0u) { if (xb_ld(&bar[XB_TMO])) break; if (sp > XB_SPIN_CAP) { atomicAdd(&bar[XB_TMO], 1u); break; } }
    }
    nloc = mine > 0u ? mine : 1u; nx = cnt > 0u ? cnt : 1u;
}
__device__ __forceinline__ void xcd_barrier(const XcdBarrier& b) {
    asm volatile("s_waitcnt vmcnt(0)" ::: "memory");
    __syncthreads();
    if (threadIdx.x == 0) {
        unsigned* bar = b.bar;
        __builtin_amdgcn_s_waitcnt(0);
        unsigned nloc = b.st[0], nx = b.st[1];
        if (nloc == 0u) { xcd_barrier_complete(bar, b.x, nloc, nx); b.st[0] = nloc; b.st[1] = nx; }
        const unsigned old = xb_add(&bar[XB_XSUB(b.x)], 1u);
        const unsigned gen = old / nloc;
        if (old + 1u == (gen + 1u) * nloc) {
            __builtin_amdgcn_fence(__ATOMIC_RELEASE, "agent");
            asm volatile("s_waitcnt vmcnt(0)" ::: "memory");
            const unsigned og = xb_add(&bar[XB_TOP], 1u);
            const unsigned tg = og / nx;
            if (og + 1u == (tg + 1u) * nx) xb_add(&bar[XB_TOPGEN], 1u);
            else XB_SPIN(xb_ld(&bar[XB_TOPGEN]) == tg, bar);
            __builtin_amdgcn_fence(__ATOMIC_ACQUIRE, "agent");
            xb_add(&bar[XB_XGEN(b.x)], 1u);
            asm volatile("s_waitcnt vmcnt(0)" ::: "memory");
        } else {
            XB_SPIN(xb_ld(&bar[XB_XGEN(b.x)]) == gen, bar);
            __builtin_amdgcn_fence(__ATOMIC_ACQUIRE, "agent");
            asm volatile("s_waitcnt vmcnt(0)" ::: "memory");
        }
    }
    __syncthreads();
}

namespace pg8 {
constexpr int BM = 256, BK = 64, HALF = 128, HTB = HALF * BK * 2, STAGE_BYTES = 8 * HTB, NXCD = 8, WGM = 8;
__device__ __forceinline__ int lds_byte(int r, int c) { const int st = (r >> 4) * 2 + (c >> 5), rr = r & 15, cc = c & 31, ob = rr * 64 + cc * 2; return st * 1024 + (ob ^ (((ob >> 9) & 1) << 5)); }
__device__ __forceinline__ void stage_rc(int b, int& R, int& C) { const int st = b / 1024, sb = b % 1024, swz = sb ^ (((sb >> 9) & 1) << 5); R = (st >> 1) * 16 + swz / 64; C = (st & 1) * 32 + (swz % 64) / 2; }
__device__ __forceinline__ int perm32(int rho) { const int n = rho >> 4, i = rho & 15; return 8 * (i >> 2) + 4 * n + (i & 3); }

struct Unit { int pm, pn, e; };
struct Gemm { const bf16* A; const bf16* Bt; int M, N, K; };

struct DenseOrder {
    int nM, nN, nwg, G, c;
    __device__ __forceinline__ void init(int M, int N, int G_, int c_) { nM = M / BM; nN = N / BM; nwg = nM * nN; G = G_; c = c_; }
    __device__ __forceinline__ bool next(int i, Unit& u) const {
        const long L = (long)i * G + c; if (L >= nwg) return false;
        int wgid = (int)L; { const int q = nwg / NXCD, r = nwg % NXCD, xcd = wgid % NXCD, off = wgid / NXCD; wgid = (xcd < r ? xcd * (q + 1) : r * (q + 1) + (xcd - r) * q) + off; }
        const int nig = WGM * nN, gid = wgid / nig, fm = gid * WGM, gsz = (nM - fm) < WGM ? (nM - fm) : WGM;
        u.pm = fm + ((wgid % nig) % gsz); u.pn = (wgid % nig) / gsz; u.e = 0; return true;
    }
    static constexpr bool GATHER = false;
    __device__ __forceinline__ size_t b_off(const Unit& u, int N, int K) const { return (size_t)u.pn * BM * K * 2; }
    __device__ __forceinline__ unsigned a_row_off(const Unit& u, int row, int K) const { return 0u; }
    __device__ __forceinline__ LAS unsigned* gtab() const { return nullptr; }
};
template <bool GATHER_> struct MoeOrder {
    static constexpr bool GATHER = GATHER_;
    const LAS int* tb; const LAS int* cnt; const int* list; int nN, G, c; LAS unsigned* gt_;
    __device__ __forceinline__ LAS unsigned* gtab() const { return gt_; }
    __device__ __forceinline__ bool next(int i, Unit& u) const {
        const int L = i * G + c; const int total = tb[NE] * nN; if (L >= total) return false;
        int e = 0;
#pragma unroll 1
        for (int j = 1; j < NE; ++j) if (tb[j] * nN <= L) e = j;
        const int Lr = L - tb[e] * nN, nte = tb[e + 1] - tb[e];
        const int mblk = Lr / (4 * nN), m0 = mblk * 4, gsz = (nte - m0) < 4 ? (nte - m0) : 4, rem = Lr - mblk * 4 * nN;
        u.e = e; u.pn = rem / gsz; u.pm = tb[e] + m0 + (rem % gsz); return true;
    }
    __device__ __forceinline__ size_t b_off(const Unit& u, int N, int K) const { return ((size_t)u.e * N + (size_t)u.pn * BM) * K * 2; }
    __device__ __forceinline__ unsigned a_row_off(const Unit& u, int row, int K) const {
        const int pos = (u.pm - tb[u.e]) * BM + row; const int tok = pos < cnt[u.e] ? list[u.e * CAP + pos] : 0; return (unsigned)tok * (unsigned)(K * 2);
    }
};

template <class Epi, class Sched, bool ALIGN_EPI, bool I8 = false>
__device__ __forceinline__ void gemm_phase(LAS unsigned char* lds, const Gemm g, const Sched& S, const Epi& E) {
    const int tid = threadIdx.x, wid = __builtin_amdgcn_readfirstlane(tid >> 6), lane = tid & 63, wr = wid >> 2, wc = wid & 3, fr = lane & 15, fq = lane >> 4;
    const int K = g.K, nt = K / BK;
    int RA[2]; unsigned CA[2], voffA[2], voffB[2];
#pragma unroll
    for (int i = 0; i < 2; ++i) { int R, C; stage_rc(tid * 16 + i * 8192, R, C); const int Rb = Epi::PERM ? ((R & ~31) + perm32(R & 31)) : R;
        RA[i] = R; CA[i] = (unsigned)C * 2u; voffA[i] = (unsigned)(R * K + C) * 2u; voffB[i] = (unsigned)(Rb * K + C) * 2u; }
    const size_t kstep = (size_t)(BK * 2);
    const size_t hstep = (size_t)HALF * K * 2;
    const size_t tstep = 2 * hstep;
    const unsigned ldsw = (unsigned)wid * 1024u;
    const int aoff = lds_byte(wr * 64 + fr, fq * 8), boff = lds_byte(wc * 32 + fr, fq * 8);
    const char* Abase = (const char*)g.A;
    LAS unsigned* gtb = S.gtab();
#define PG8_SA(b, h) (((b) * 2 + (h)) * HTB)
#define PG8_SB(b, h) ((4 + (b) * 2 + (h)) * HTB)
#define PG8_STAGE(bufoff, gbase, voff) do { _Pragma("unroll") for (int _i = 0; _i < 2; ++_i) \
        __builtin_amdgcn_global_load_lds((const unsigned*)((const char*)(gbase) + (voff)[_i]), (LAS unsigned*)(lds + (bufoff) + ldsw + _i * 8192), 16, 0, 0); } while (0)
#define PG8_STAGEA(bufoff, h, kb, nx) do { \
        if constexpr (Sched::GATHER) { const LAS unsigned* tp_ = gtb + ((nx) ? tnx : tcu) + (h) * HALF; const unsigned o0_ = tp_[RA[0]] + CA[0], o1_ = tp_[RA[1]] + CA[1]; \
            __builtin_amdgcn_global_load_lds((const unsigned*)(Abase + (size_t)(kb) + o0_), (LAS unsigned*)(lds + (bufoff) + ldsw), 16, 0, 0); \
            __builtin_amdgcn_global_load_lds((const unsigned*)(Abase + (size_t)(kb) + o1_), (LAS unsigned*)(lds + (bufoff) + ldsw + 8192), 16, 0, 0); } \
        else { const char* gb_ = ((nx) ? nA : cA) + (size_t)(h) * hstep + (size_t)(kb); PG8_STAGE(bufoff, gb_, voffA); } } while (0)
#define PG8_LDA(dst, b, h) do { _Pragma("unroll") for (int m = 0; m < 4; ++m) _Pragma("unroll") for (int k = 0; k < 2; ++k) dst[m][k] = *(const LAS bf16x8*)(lds + PG8_SA(b, h) + aoff + m * 2048 + k * 1024); } while (0)
#define PG8_LDB(dst, b, h) do { _Pragma("unroll") for (int n = 0; n < 2; ++n) _Pragma("unroll") for (int k = 0; k < 2; ++k) dst[n][k] = *(const LAS bf16x8*)(lds + PG8_SB(b, h) + boff + n * 2048 + k * 1024); } while (0)
#define PG8_MMA(ai, bj, At, Bt) do { __builtin_amdgcn_s_setprio(1); _Pragma("unroll") for (int m = 0; m < 4; ++m) _Pragma("unroll") for (int n = 0; n < 2; ++n) _Pragma("unroll") for (int k = 0; k < 2; ++k) { \
        if constexpr (I8) acc[ai][bj][m][n] = __builtin_bit_cast(f32x4, __builtin_amdgcn_mfma_i32_16x16x64_i8(__builtin_bit_cast(i32x4, Bt[n][k]), __builtin_bit_cast(i32x4, At[m][k]), __builtin_bit_cast(i32x4, acc[ai][bj][m][n]), 0, 0, 0)); \
        else acc[ai][bj][m][n] = __builtin_amdgcn_mfma_f32_16x16x32_bf16(Bt[n][k], At[m][k], acc[ai][bj][m][n], 0, 0, 0); } __builtin_amdgcn_s_setprio(0); } while (0)
#define PG8_WAIT_V(n) asm volatile("s_waitcnt vmcnt(" #n ")" ::: "memory")
#define PG8_WAIT_L(n) asm volatile("s_waitcnt lgkmcnt(" #n ")" ::: "memory")
#define PG8_BAR __builtin_amdgcn_s_barrier()
#define PG8_SCHED __builtin_amdgcn_sched_barrier(0)
    Unit cur, nxt; int ui = 0;
    if (!S.next(0, cur)) return;
    f32x4 acc[2][2][4][2];
#pragma unroll
    for (int a = 0; a < 2; ++a)
#pragma unroll
        for (int b = 0; b < 2; ++b)
#pragma unroll
            for (int m = 0; m < 4; ++m)
#pragma unroll
                for (int n = 0; n < 2; ++n) acc[a][b][m][n] = (f32x4){0.f, 0.f, 0.f, 0.f};
    bf16x8 At[4][2], B0[2][2], B1[2][2];
    const char* cA = Abase + (size_t)cur.pm * tstep; const char* cB = (const char*)g.Bt + S.b_off(cur, g.N, K);
    const char* nA = cA; const char* nB = cB;
    int tcu = 0, tnx = 0;
    if constexpr (Sched::GATHER) {
        if (tid < BM) gtb[tid] = S.a_row_off(cur, tid, K);
        asm volatile("s_waitcnt vmcnt(0) lgkmcnt(0)" ::: "memory"); PG8_BAR; asm volatile("" ::: "memory");
    }
    PG8_STAGE(PG8_SB(0, 0), cB, voffB); PG8_STAGE(PG8_SB(0, 1), cB + hstep, voffB); PG8_STAGEA(PG8_SA(0, 0), 0, 0, false); PG8_STAGEA(PG8_SA(0, 1), 1, 0, false);
    if (wr == 1) PG8_BAR;
    PG8_WAIT_V(2); PG8_BAR;
    PG8_STAGE(PG8_SB(1, 0), cB + kstep, voffB); PG8_STAGEA(PG8_SA(1, 0), 0, kstep, false); PG8_STAGE(PG8_SB(1, 1), cB + hstep + kstep, voffB);
    PG8_WAIT_V(6); PG8_BAR;
    for (;;) {
        const bool has_next = S.next(ui + 1, nxt);
        nA = cA; nB = cB; tnx = tcu;
        if (has_next) { nA = Abase + (size_t)nxt.pm * tstep; nB = (const char*)g.Bt + S.b_off(nxt, g.N, K);
            if constexpr (Sched::GATHER) { tnx = tcu ^ BM; if (tid < BM) gtb[tnx + tid] = S.a_row_off(nxt, tid, K); } }
#pragma unroll 1
        for (int t = 0; t < nt; t += 2) {
            const bool last = (t == nt - 2);
            const size_t k1 = (size_t)(t + 1) * kstep;
            const size_t k2 = last ? 0 : (size_t)(t + 2) * kstep, k3 = k2 + kstep;
            const char* b2 = last ? nB : cB + (size_t)(t + 2) * kstep; const char* b3 = b2 + kstep;
            PG8_LDB(B0, 0, 0); PG8_LDB(B1, 0, 1); PG8_SCHED; PG8_LDA(At, 0, 0); PG8_STAGEA(PG8_SA(1, 1), 1, k1, false);
            PG8_WAIT_V(8); PG8_WAIT_L(0); PG8_BAR; PG8_MMA(0, 0, At, B0); PG8_MMA(0, 1, At, B1); PG8_BAR; PG8_SCHED;
            PG8_LDA(At, 0, 1); PG8_STAGE(PG8_SB(0, 0), b2, voffB); PG8_STAGE(PG8_SB(0, 1), b2 + hstep, voffB); PG8_STAGEA(PG8_SA(0, 0), 0, k2, last);
            PG8_WAIT_V(8); PG8_WAIT_L(0); PG8_BAR; PG8_MMA(1, 0, At, B0); PG8_MMA(1, 1, At, B1); PG8_BAR; PG8_SCHED;
            PG8_LDB(B0, 1, 0); PG8_LDB(B1, 1, 1); PG8_SCHED; PG8_LDA(At, 1, 0); PG8_STAGEA(PG8_SA(0, 1), 1, k2, last);
            PG8_WAIT_V(8); PG8_WAIT_L(0); PG8_BAR; PG8_MMA(0, 0, At, B0); PG8_MMA(0, 1, At, B1); PG8_BAR; PG8_SCHED;
            PG8_LDA(At, 1, 1); PG8_STAGE(PG8_SB(1, 0), b3, voffB); PG8_STAGE(PG8_SB(1, 1), b3 + hstep, voffB); PG8_STAGEA(PG8_SA(1, 0), 0, k3, last);
            PG8_WAIT_V(8); PG8_WAIT_L(0); PG8_BAR; PG8_MMA(1, 0, At, B0); PG8_MMA(1, 1, At, B1); PG8_BAR; PG8_SCHED;
        }
        if constexpr (ALIGN_EPI) { if (wr == 0) PG8_BAR; }
        E(acc, cur, wr, wc, fr, fq);
        if (!has_next) break;
#pragma unroll
        for (int a = 0; a < 2; ++a)
#pragma unroll
            for (int b = 0; b < 2; ++b)
#pragma unroll
                for (int m = 0; m < 4; ++m)
#pragma unroll
                    for (int n = 0; n < 2; ++n) acc[a][b][m][n] = (f32x4){0.f, 0.f, 0.f, 0.f};
        cur = nxt; cA = nA; cB = nB; tcu = tnx; ++ui;
        if constexpr (ALIGN_EPI) { if (wr == 1) PG8_BAR; }
    }
    PG8_WAIT_V(0);
    if constexpr (!ALIGN_EPI) { if (wr == 0) PG8_BAR; }
    PG8_BAR;
#undef PG8_SA
#undef PG8_SB
#undef PG8_STAGE
#undef PG8_STAGEA
#undef PG8_LDA
#undef PG8_LDB
#undef PG8_MMA
#undef PG8_WAIT_V
#undef PG8_WAIT_L
#undef PG8_BAR
#undef PG8_SCHED
}

struct EpiBf16Plain {
    static constexpr bool PERM = true;
    bf16* O; int ldc;
    __device__ __forceinline__ void operator()(const f32x4 (&acc)[2][2][4][2], const Unit& u, int wr, int wc, int fr, int fq) const {
        const int row0 = u.pm * BM + wr * 64 + fr, col0 = u.pn * BM + wc * 32 + 8 * fq;
#pragma unroll
        for (int ai = 0; ai < 2; ++ai)
#pragma unroll
            for (int m = 0; m < 4; ++m) { bf16* rowp = O + (size_t)(row0 + ai * HALF + m * 16) * ldc + col0;
#pragma unroll
                for (int bj = 0; bj < 2; ++bj) { const f32x4 v0 = acc[ai][bj][m][0], v1 = acc[ai][bj][m][1];
                    u32x4 w; w.x = cvt_pk_bf16(v0[0], v0[1]); w.y = cvt_pk_bf16(v0[2], v0[3]); w.z = cvt_pk_bf16(v1[0], v1[1]); w.w = cvt_pk_bf16(v1[2], v1[3]);
                    *(u32x4*)(rowp + bj * HALF) = w; } }
    }
};
struct EpiMlaUp {
    static constexpr bool PERM = true;
    bf16* Q; bf16* KK; bf16* V; const float* cs;
    __device__ __forceinline__ void operator()(const f32x4 (&acc)[2][2][4][2], const Unit& u, int wr, int wc, int fr, int fq) const {
        const int row0 = u.pm * BM + wr * 64 + fr;
#pragma unroll
        for (int bj = 0; bj < 2; ++bj) {
            const int c0 = u.pn * BM + bj * HALF + wc * 32 + 8 * fq;
            if (u.pn < 3) {
                const int h = c0 / QKD, d = c0 - h * QKD;
                const bool rope = d >= NOPE; const int i0 = rope ? (d - NOPE) >> 1 : 0;
#pragma unroll
                for (int ai = 0; ai < 2; ++ai)
#pragma unroll
                    for (int m = 0; m < 4; ++m) { const int row = row0 + ai * HALF + m * 16;
                        f32x4 v0 = acc[ai][bj][m][0], v1 = acc[ai][bj][m][1];
                        if (rope) { const f32x4 cA = *(const f32x4*)(cs + (size_t)row * 32 + i0 * 2), cB = *(const f32x4*)(cs + (size_t)row * 32 + i0 * 2 + 4);
                            const f32x4 a = v0, b = v1;
                            v0[0] = a[0] * cA[0] - a[1] * cA[1]; v0[1] = a[0] * cA[1] + a[1] * cA[0]; v0[2] = a[2] * cA[2] - a[3] * cA[3]; v0[3] = a[2] * cA[3] + a[3] * cA[2];
                            v1[0] = b[0] * cB[0] - b[1] * cB[1]; v1[1] = b[0] * cB[1] + b[1] * cB[0]; v1[2] = b[2] * cB[2] - b[3] * cB[3]; v1[3] = b[2] * cB[3] + b[3] * cB[2]; }
                        v0 = v0 * C2Q; v1 = v1 * C2Q;
                        u32x4 w; w.x = cvt_pk_bf16(v0[0], v0[1]); w.y = cvt_pk_bf16(v0[2], v0[3]); w.z = cvt_pk_bf16(v1[0], v1[1]); w.w = cvt_pk_bf16(v1[2], v1[3]);
                        *(u32x4*)(Q + (size_t)row * 768 + c0) = w; asm volatile("" ::: "memory"); }
            } else {
                bf16* base; int ld, cc;
                if (u.pn < 5) { const int c1 = c0 - 768; const int h = c1 >> 6, d = c1 & 63; base = KK; ld = 768; cc = h * QKD + d; }
                else { base = V; ld = 512; cc = c0 - 1280; }
#pragma unroll
                for (int ai = 0; ai < 2; ++ai)
#pragma unroll
                    for (int m = 0; m < 4; ++m) { const int row = row0 + ai * HALF + m * 16; const f32x4 v0 = acc[ai][bj][m][0], v1 = acc[ai][bj][m][1];
                        u32x4 w; w.x = cvt_pk_bf16(v0[0], v0[1]); w.y = cvt_pk_bf16(v0[2], v0[3]); w.z = cvt_pk_bf16(v1[0], v1[1]); w.w = cvt_pk_bf16(v1[2], v1[3]);
                        *(u32x4*)(base + (size_t)row * ld + cc) = w; asm volatile("" ::: "memory"); }
            }
        }
    }
};
struct EpiRwkvSmall {
    static constexpr bool PERM = false;
    float* O; const float* w0; const float* a0;
    __device__ __forceinline__ void operator()(const f32x4 (&acc)[2][2][4][2], const Unit& u, int wr, int wc, int fr, int fq) const {
        const int row0 = u.pm * BM + wr * 64 + fr, col0 = u.pn * BM + wc * 32 + 4 * fq;
        const int kind = u.pn >> 1;
#pragma unroll
        for (int bj = 0; bj < 2; ++bj)
#pragma unroll
            for (int n = 0; n < 2; ++n) { const int c = col0 + bj * HALF + n * 16;
                f32x4 bv = (f32x4){0.f, 0.f, 0.f, 0.f};
                if (kind == 0) bv = *(const f32x4*)(w0 + c); else if (kind == 1) bv = *(const f32x4*)(a0 + (c - 512));
#pragma unroll
                for (int ai = 0; ai < 2; ++ai)
#pragma unroll
                    for (int m = 0; m < 4; ++m) { f32x4 v = acc[ai][bj][m][n] + bv;
                        if (kind == 0) {
#pragma unroll
                            for (int j = 0; j < 4; ++j) { const float z = -v[j]; const float sp = fmaxf(z, 0.f) + __logf(1.0f + __expf(-fabsf(z))); const float w = -sp - 0.5f; v[j] = -__expf(w); }
                        } else if (kind == 1) {
#pragma unroll
                            for (int j = 0; j < 4; ++j) v[j] = sigmoidf_(v[j]);
                        }
                        *(f32x4*)(O + (size_t)(row0 + ai * HALF + m * 16) * N_SM + c) = v; asm volatile("" ::: "memory"); } }
    }
};
struct EpiVres {
    static constexpr bool PERM = true;
    const bf16* vs; const bf16* vf; bf16* vr; const float* v0;
    __device__ __forceinline__ void operator()(const f32x4 (&acc)[2][2][4][2], const Unit& u, int wr, int wc, int fr, int fq) const {
        const int row0 = u.pm * BM + wr * 64 + fr, col0 = u.pn * BM + wc * 32 + 8 * fq;
#pragma unroll
        for (int bj = 0; bj < 2; ++bj) { const int c = col0 + bj * HALF;
            const f32x4 b0 = *(const f32x4*)(v0 + c), b1 = *(const f32x4*)(v0 + c + 4);
#pragma unroll
            for (int ai = 0; ai < 2; ++ai)
#pragma unroll
                for (int m = 0; m < 4; ++m) { const size_t off = (size_t)(row0 + ai * HALF + m * 16) * C5 + c;
                    const u32x4 s = *(const u32x4*)(vs + off), f = *(const u32x4*)(vf + off);
                    const f32x4 g0 = acc[ai][bj][m][0] + b0, g1 = acc[ai][bj][m][1] + b1;
                    float o[8];
#pragma unroll
                    for (int j = 0; j < 4; ++j) { const float sl = bflo(s[j]), sh = bfhi(s[j]), fl = bflo(f[j]), fh = bfhi(f[j]);
                        const float ga = (j < 2) ? g0[2 * j] : g1[2 * j - 4], gb = (j < 2) ? g0[2 * j + 1] : g1[2 * j - 3];
                        o[2 * j] = sl + (fl - sl) * sigmoidf_(ga); o[2 * j + 1] = sh + (fh - sh) * sigmoidf_(gb); }
                    u32x4 w; w.x = cvt_pk_bf16(o[0], o[1]); w.y = cvt_pk_bf16(o[2], o[3]); w.z = cvt_pk_bf16(o[4], o[5]); w.w = cvt_pk_bf16(o[6], o[7]);
                    *(u32x4*)(vr + off) = w; } }
    }
};
struct EpiWo {
    static constexpr bool PERM = true;
    bf16* X; const float* gt;
    __device__ __forceinline__ void operator()(const f32x4 (&acc)[2][2][4][2], const Unit& u, int wr, int wc, int fr, int fq) const {
        const int row0 = u.pm * BM + wr * 64 + fr, col0 = u.pn * BM + wc * 32 + 8 * fq;
        const int b = (u.pm * BM) / SEQ;
#pragma unroll
        for (int bj = 0; bj < 2; ++bj) { const int c = col0 + bj * HALF;
            const f32x4 g0 = *(const f32x4*)(gt + (size_t)b * 6144 + c) + 1.0f, g1 = *(const f32x4*)(gt + (size_t)b * 6144 + c + 4) + 1.0f;
#pragma unroll
            for (int ai = 0; ai < 2; ++ai)
#pragma unroll
                for (int m = 0; m < 4; ++m) { bf16* px = X + (size_t)(row0 + ai * HALF + m * 16) * D + c; const u32x4 xw = *(const u32x4*)px;
                    const f32x4 a0 = acc[ai][bj][m][0], a1 = acc[ai][bj][m][1];
                    u32x4 w; w.x = cvt_pk_bf16(bflo(xw.x) * DN_ALPHA + g0[0] * a0[0], bfhi(xw.x) * DN_ALPHA + g0[1] * a0[1]); w.y = cvt_pk_bf16(bflo(xw.y) * DN_ALPHA + g0[2] * a0[2], bfhi(xw.y) * DN_ALPHA + g0[3] * a0[3]);
                    w.z = cvt_pk_bf16(bflo(xw.z) * DN_ALPHA + g1[0] * a1[0], bfhi(xw.z) * DN_ALPHA + g1[1] * a1[1]); w.w = cvt_pk_bf16(bflo(xw.w) * DN_ALPHA + g1[2] * a1[2], bfhi(xw.w) * DN_ALPHA + g1[3] * a1[3]);
                    *(u32x4*)px = w; } }
    }
};
struct EpiSwiglu {
    static constexpr bool PERM = true;
    unsigned char* O; const float* b1p;
    __device__ __forceinline__ void operator()(const f32x4 (&acc)[2][2][4][2], const Unit& u, int wr, int wc, int fr, int fq) const {
        const int row0 = u.pm * BM + wr * 64 + fr; const int cin = u.pn * BM + wc * 32 + 8 * fq, cout = u.pn * HALF + wc * 32 + 8 * fq;
        const float* bp = b1p + (size_t)u.e * 2048 + cin;
        const f32x4 bg0 = *(const f32x4*)(bp), bg1 = *(const f32x4*)(bp + 4), bl0 = *(const f32x4*)(bp + HALF), bl1 = *(const f32x4*)(bp + HALF + 4);
        constexpr float inv = 1.0f / (QS_H * QS_W1);
#pragma unroll
        for (int ai = 0; ai < 2; ++ai)
#pragma unroll
            for (int m = 0; m < 4; ++m) {
                const i32x4 ig0 = __builtin_bit_cast(i32x4, acc[ai][0][m][0]), ig1 = __builtin_bit_cast(i32x4, acc[ai][0][m][1]), il0 = __builtin_bit_cast(i32x4, acc[ai][1][m][0]), il1 = __builtin_bit_cast(i32x4, acc[ai][1][m][1]);
                float o[8];
#pragma unroll
                for (int j = 0; j < 8; ++j) { const float gv = fminf((float)(j < 4 ? ig0[j & 3] : ig1[j & 3]) * inv + (j < 4 ? bg0[j & 3] : bg1[j & 3]), 7.0f);
                    const float lv = fminf(fmaxf((float)(j < 4 ? il0[j & 3] : il1[j & 3]) * inv + (j < 4 ? bl0[j & 3] : bl1[j & 3]), -7.0f), 7.0f);
                    o[j] = gv * sigmoidf_(1.702f * gv) * (lv + 1.0f) * QS_U; }
                u32x2 w; w.x = q8x4(o[0], o[1], o[2], o[3]); w.y = q8x4(o[4], o[5], o[6], o[7]);
                *(u32x2*)(O + (size_t)(row0 + ai * HALF + m * 16) * FF + cout) = w; }
    }
};
struct EpiMoeOut {
    static constexpr bool PERM = true;
    bf16* O; const float* b2; const float* gatel; const LAS int* tb;
    __device__ __forceinline__ void operator()(const f32x4 (&acc)[2][2][4][2], const Unit& u, int wr, int wc, int fr, int fq) const {
        const int row0 = u.pm * BM + wr * 64 + fr, col0 = u.pn * BM + wc * 32 + 8 * fq;
        const int pos0 = (u.pm - tb[u.e]) * BM + wr * 64 + fr;
        const float* bp = b2 + (size_t)u.e * D + col0;
        constexpr float inv = 1.0f / (QS_U * QS_W2);
        f32x4 bv[2][2];
#pragma unroll
        for (int bj = 0; bj < 2; ++bj) { bv[bj][0] = *(const f32x4*)(bp + bj * HALF); bv[bj][1] = *(const f32x4*)(bp + bj * HALF + 4); }
#pragma unroll
        for (int ai = 0; ai < 2; ++ai)
#pragma unroll
            for (int m = 0; m < 4; ++m) { const float gt = gatel[(size_t)u.e * CAP + pos0 + ai * HALF + m * 16];
                bf16* rowp = O + (size_t)(row0 + ai * HALF + m * 16) * D + col0;
#pragma unroll
                for (int bj = 0; bj < 2; ++bj) { const i32x4 i0 = __builtin_bit_cast(i32x4, acc[ai][bj][m][0]), i1 = __builtin_bit_cast(i32x4, acc[ai][bj][m][1]);
                    f32x4 v0, v1;
#pragma unroll
                    for (int j = 0; j < 4; ++j) { v0[j] = ((float)i0[j] * inv + bv[bj][0][j]) * gt; v1[j] = ((float)i1[j] * inv + bv[bj][1][j]) * gt; }
                    u32x4 w; w.x = cvt_pk_bf16(v0[0], v0[1]); w.y = cvt_pk_bf16(v0[2], v0[3]); w.z = cvt_pk_bf16(v1[0], v1[1]); w.w = cvt_pk_bf16(v1[2], v1[3]);
                    *(u32x4*)(rowp + bj * HALF) = w; } }
    }
};
}

struct Params { const void* in[N_INPUTS]; float* out; unsigned char* ws; int ph_lo, ph_hi; };

struct Frame {
    LAS unsigned char* lds;
    int tid, lane, wave, G, vcu;
    unsigned char* ws;
};
#define WSP(type, off) ((type*)(F.ws + (off)))
#define INP(i) ((const float*)p.in[i])

__device__ const double INV_FREQ[16] = {1.00000000000000000e+00, 5.62341325190349073e-01, 3.16227766016837941e-01, 1.77827941003892293e-01, 1.00000000000000006e-01, 5.62341325190349114e-02,
    3.16227766016837913e-02, 1.77827941003892293e-02, 1.00000000000000002e-02, 5.62341325190349097e-03, 3.16227766016837939e-03, 1.77827941003892275e-03, 1.00000000000000002e-03,
    5.62341325190349097e-04, 3.16227766016837939e-04, 1.77827941003892270e-04};

template <int MODE>
__device__ __forceinline__ void tr_item(const float* W, int ldn, bf16* WT, int ldk, int kofs, int rofs, int k0, int n0, LAS float* scr, int lane) {
    f32x4 ld[8];
#pragma unroll
    for (int i = 0; i < 8; ++i) ld[i] = *(const f32x4*)(W + (size_t)(k0 + 8 * i + (lane >> 3)) * ldn + n0 + 4 * (lane & 7));
#pragma unroll
    for (int i = 0; i < 8; ++i) { LAS float* d = scr + (8 * i + (lane >> 3)) * 33 + 4 * (lane & 7); d[0] = ld[i].x; d[1] = ld[i].y; d[2] = ld[i].z; d[3] = ld[i].w; }
    LDS_WAIT(); asm volatile("" ::: "memory");
    const int c = lane & 7;
#pragma unroll
    for (int j = 0; j < 4; ++j) { const int n = (lane >> 3) + 8 * j; const LAS float* s = scr + (8 * c) * 33 + n;
        u32x4 o; o.x = pk2(s[0 * 33], s[1 * 33]); o.y = pk2(s[2 * 33], s[3 * 33]); o.z = pk2(s[4 * 33], s[5 * 33]); o.w = pk2(s[6 * 33], s[7 * 33]);
        const int ng = n0 + n; int row;
        if (MODE == 0) row = rofs + ng; else { const int jo = ng >> 1, bj = ng & 1; row = rofs + (jo >> 7) * 256 + bj * 128 + (jo & 127); }
        *(GAS u32x4*)(WT + (size_t)row * ldk + kofs + k0 + 8 * c) = o; }
    LDS_WAIT(); asm volatile("" ::: "memory");
}
__device__ __forceinline__ void zero_rect(const Frame& F, bf16* M, int ld, int r0, int nrows, int c0, int ncols) {
    const int gw = F.vcu * NWAVES + F.wave, NGW = F.G * NWAVES; const int nch = ncols / 8;
    for (int r = gw; r < nrows; r += NGW)
        for (int ch = F.lane; ch < nch; ch += 64) *(GAS u32x4*)(M + (size_t)(r0 + r) * ld + c0 + ch * 8) = (u32x4){0u, 0u, 0u, 0u};
}
__device__ __forceinline__ void phase_prologue(const Params& p, const Frame& F) {
    LAS float* scr = (LAS float*)(F.lds + F.wave * 16384);
    const int gw = F.vcu * NWAVES + F.wave, NGW = F.G * NWAVES;
    constexpr int I_IN = 16 * 69, I_UQ = 4 * 24, I_UK = 2 * 16, I_W2s = 16, I_G2s = 2 * 16, I_WO_ = 16 * 32, I_E1 = 16 * 64, I_E2 = 16 * 32;
    constexpr int PER_L = I_IN + I_UQ + 2 * I_UK + 2 * I_W2s + I_G2s + I_WO_;
    constexpr int NSMALL = DEPTH * PER_L;
    for (int it = gw; it < NSMALL; it += NGW) {
        int r = it;
        {
            const int l = r / PER_L; r -= l * PER_L;
            if (r < I_IN) { tr_item<0>(INP(I_WIN) + (size_t)l * D * N_IN, N_IN, WSP(bf16, WS_WINT) + (size_t)l * N_INP * D, D, 0, 0, 64 * (r / 69), 32 * (r % 69), scr, F.lane); continue; } r -= I_IN;
            bf16* up = WSP(bf16, WS_WUPT) + (size_t)l * N_UP * K_UP;
            if (r < I_UQ) { tr_item<0>(INP(I_WUQ) + (size_t)l * QLR * 768, 768, up, K_UP, 0, 0, 64 * (r / 24), 32 * (r % 24), scr, F.lane); continue; } r -= I_UQ;
            if (r < I_UK) { tr_item<0>(INP(I_WUK) + (size_t)l * KVLR * 512, 512, up, K_UP, 256, 768, 64 * (r / 16), 32 * (r % 16), scr, F.lane); continue; } r -= I_UK;
            if (r < I_UK) { tr_item<0>(INP(I_WUV) + (size_t)l * KVLR * 512, 512, up, K_UP, 256, 1280, 64 * (r / 16), 32 * (r % 16), scr, F.lane); continue; } r -= I_UK;
            bf16* sm = WSP(bf16, WS_WSMT) + (size_t)l * N_SM * K_SM;
            if (r < I_W2s) { tr_item<0>(INP(I_W2) + (size_t)l * 64 * 512, 512, sm, K_SM, 0, 0, 0, 32 * r, scr, F.lane); continue; } r -= I_W2s;
            if (r < I_W2s) { tr_item<0>(INP(I_A2) + (size_t)l * 64 * 512, 512, sm, K_SM, 64, 512, 0, 32 * r, scr, F.lane); continue; } r -= I_W2s;
            if (r < I_G2s) { tr_item<0>(INP(I_G2) + (size_t)l * 128 * 512, 512, sm, K_SM, 128, 1024, 64 * (r / 16), 32 * (r % 16), scr, F.lane); continue; } r -= I_G2s;
            tr_item<0>(INP(I_WO) + (size_t)l * D * D, D, WSP(bf16, WS_WOT) + (size_t)l * D * D, D, 0, 0, 64 * (r / 32), 32 * (r % 32), scr, F.lane); continue;
        }
    }
    for (int l = 0; l < DEPTH; ++l) {
        zero_rect(F, WSP(bf16, WS_WINT) + (size_t)l * N_INP * D, D, N_IN, N_INP - N_IN, 0, D);
        bf16* up = WSP(bf16, WS_WUPT) + (size_t)l * N_UP * K_UP;
        zero_rect(F, up, K_UP, 0, 768, 256, 128); zero_rect(F, up, K_UP, 768, 1024, 0, 256);
        bf16* sm = WSP(bf16, WS_WSMT) + (size_t)l * N_SM * K_SM;
        zero_rect(F, sm, K_SM, 0, 512, 64, 192); zero_rect(F, sm, K_SM, 512, 512, 0, 64); zero_rect(F, sm, K_SM, 512, 512, 128, 128); zero_rect(F, sm, K_SM, 1024, 512, 0, 128);
    }
    const int gt = (F.vcu * NTHREADS) + F.tid, NGT = F.G * NTHREADS;
    { const float* v1 = INP(I_V1); const float* v2 = INP(I_V2); bf16* o = WSP(bf16, WS_WV12T);
      for (int i = gt; i < 512 * 512; i += NGT) { const int n = i >> 9, k = i & 511; float s = 0.f;
#pragma unroll 8
          for (int j = 0; j < 32; ++j) s += v1[k * 32 + j] * v2[j * 512 + n];
          o[i] = (bf16)f2bf(s); } }
    { const float* b1 = INP(I_EB1); float* o = WSP(float, WS_B1P);
      for (int i = gt; i < DEPTH * NE * 2048; i += NGT) { const int q = i & 2047, le = i >> 11; const int pn = q >> 8, bj = (q >> 7) & 1, jj = q & 127; o[i] = b1[(size_t)le * 2048 + 2 * (pn * 128 + jj) + bj]; } }
    { bf16* pg = WSP(bf16, WS_PGW);
      for (int i = gt; i < DEPTH * PGW_NFRAG * 64; i += NGT) { const int ln = i & 63, fi = (i >> 6) % PGW_NFRAG, l2 = (i >> 6) / PGW_NFRAG; const int rr = ln & 31, hh = ln >> 5;
          const float* W; int ldw, KS, f0; bool v12 = false;
          if (fi < PGW_KN) { W = INP(I_WUQ) + (size_t)l2 * QLR * 768; ldw = 768; KS = 16; f0 = PGW_Q; }
          else if (fi < PGW_V) { W = INP(I_WUK) + (size_t)l2 * KVLR * 512; ldw = 512; KS = 8; f0 = PGW_KN; }
          else if (fi < PGW_W) { W = INP(I_WUV) + (size_t)l2 * KVLR * 512; ldw = 512; KS = 8; f0 = PGW_V; }
          else if (fi < PGW_A) { W = INP(I_W2) + (size_t)l2 * 64 * 512; ldw = 512; KS = 4; f0 = PGW_W; }
          else if (fi < PGW_G) { W = INP(I_A2) + (size_t)l2 * 64 * 512; ldw = 512; KS = 4; f0 = PGW_A; }
          else if (fi < PGW_VR) { W = INP(I_G2) + (size_t)l2 * 128 * 512; ldw = 512; KS = 8; f0 = PGW_G; }
          else { W = nullptr; ldw = 512; KS = 32; f0 = PGW_VR; v12 = true; }
          const int nb = (fi - f0) / KS, ks = (fi - f0) % KS, n = 32 * nb + rr, k0 = 16 * ks + 8 * hh;
          float v[8];
          if (!v12) {
#pragma unroll
              for (int j = 0; j < 8; ++j) v[j] = W[(size_t)(k0 + j) * ldw + n]; }
          else { const float* v1 = INP(I_V1); const float* v2 = INP(I_V2);
#pragma unroll
              for (int j = 0; j < 8; ++j) { float sacc = 0.f;
#pragma unroll 8
                  for (int q = 0; q < 32; ++q) sacc += v1[(k0 + j) * 32 + q] * v2[q * 512 + n];
                  v[j] = (l2 == 0) ? 0.f : sacc; } }
          u32x4 o; o.x = pk2(v[0], v[1]); o.y = pk2(v[2], v[3]); o.z = pk2(v[4], v[5]); o.w = pk2(v[6], v[7]);
          *(u32x4*)(pg + (size_t)i * 8) = o; } }
    { const float* rw = INP(I_RW); bf16* o = WSP(bf16, WS_RWT);
      for (int i = gt; i < DEPTH * NE * D; i += NGT) { const int k = i & 1023, e = (i >> 10) & 31, l2 = i >> 15; const float v = rw[((size_t)l2 * D + k) * NE + e]; const unsigned hi = f2bf(v); const float lo = v - bf2f(hi);
          o[i] = (bf16)hi; o[DEPTH * NE * D + i] = (bf16)f2bf(lo); } }
    { const int* pos = (const int*)p.in[I_POS]; float* cs = WSP(float, WS_CS);
      for (int i = gt; i < T * 16; i += NGT) { const int t = i >> 4, k = i & 15; const double a = (double)pos[t] * INV_FREQ[k];
          const double q = __builtin_rint(a * 0.63661977236758134308); const int qi = (int)((long long)q & 3);
          double r = __builtin_fma(-q, 1.57079632679489655800e+00, a); r = __builtin_fma(-q, 6.12323399573676603587e-17, r);
          const double r2 = r * r;
          double sn = -2.50521083854417187751e-08; sn = sn * r2 + 2.75573192239858906526e-06; sn = sn * r2 - 1.98412698412698412698e-04; sn = sn * r2 + 8.33333333333333333333e-03; sn = sn * r2 - 1.66666666666666666667e-01; sn = r + r * r2 * sn;
          double cn = 2.08767569878680989792e-09; cn = cn * r2 - 2.75573192239858906526e-07; cn = cn * r2 + 2.48015873015873015873e-05; cn = cn * r2 - 1.38888888888888888889e-03; cn = cn * r2 + 4.16666666666666666667e-02; cn = cn * r2 - 0.5; cn = 1.0 + r2 * cn;
          double sv, cv;
          if (qi == 0) { sv = sn; cv = cn; } else if (qi == 1) { sv = cn; cv = -sn; } else if (qi == 2) { sv = -sn; cv = -cn; } else { sv = -cn; cv = sn; }
          cs[2 * i] = (float)cv; cs[2 * i + 1] = (float)sv; } }
    { LAS float* cact = (LAS float*)(F.lds);
      LAS float* part = (LAS float*)(F.lds + 32768);
      __syncthreads();
      const float* c = INP(I_C);
      for (int i = F.tid; i < NBATCH * D; i += NTHREADS) { const float v = c[i]; cact[i] = v / (1.0f + __expf(-v)); }
      __syncthreads();
      for (int item = F.vcu; item < DEPTH * 96; item += F.G) { const int l = item / 96, n0 = (item % 96) * 64;
          const float* aw = INP(I_ADAW) + (size_t)l * D * 6144 + n0 + F.lane;
          float a8[8];
#pragma unroll
          for (int b = 0; b < 8; ++b) a8[b] = 0.f;
          const int kb = F.wave * 128;
#pragma unroll 4
          for (int k = 0; k < 128; ++k) { const float wv = aw[(size_t)(kb + k) * 6144];
#pragma unroll
              for (int b = 0; b < 8; ++b) a8[b] += cact[b * D + kb + k] * wv; }
#pragma unroll
          for (int b = 0; b < 8; ++b) part[(F.wave * 8 + b) * 64 + F.lane] = a8[b];
          __syncthreads();
          { const int b = F.wave; float s = 0.f;
#pragma unroll
            for (int w = 0; w < 8; ++w) s += part[(w * 8 + b) * 64 + F.lane];
            WSP(float, WS_MOD)[((size_t)l * NBATCH + b) * 6144 + n0 + F.lane] = s + INP(I_ADAB)[(size_t)l * 6144 + n0 + F.lane]; }
          __syncthreads(); }
    }
}

__device__ __forceinline__ void phase_convert_experts(const Params& p, const Frame& F, int c0, int nc) {
    LAS float* scr = (LAS float*)(F.lds + F.wave * 16384);
    constexpr int I_E1 = 16 * 64, I_E2 = 16 * 32, NE1 = DEPTH * NE * I_E1, NE2 = DEPTH * NE * I_E2;
    const int gw = (F.vcu - c0) * NWAVES + F.wave, NGW = nc * NWAVES; const int lane = F.lane;
    __syncthreads();
    f32x4 ld[8];
#define CV_SRC(it, W_, ldn_, k0_, n0_) do { int r_ = (it); if (r_ < NE1) { const int le_ = r_ / I_E1; r_ -= le_ * I_E1; W_ = INP(I_EW1) + (size_t)le_ * D * 2048; ldn_ = 2048; k0_ = 64 * (r_ / 64); n0_ = 32 * (r_ % 64); } \
        else { r_ -= NE1; const int le_ = r_ / I_E2; r_ -= le_ * I_E2; W_ = INP(I_EW2) + (size_t)le_ * FF * D; ldn_ = D; k0_ = 64 * (r_ / 32); n0_ = 32 * (r_ % 32); } } while (0)
#define CV_LOAD(it) do { const float* W_; int ldn_, k0_, n0_; CV_SRC(it, W_, ldn_, k0_, n0_); \
        _Pragma("unroll") for (int i = 0; i < 8; ++i) ld[i] = *(const f32x4*)(W_ + (size_t)(k0_ + 8 * i + (lane >> 3)) * ldn_ + n0_ + 4 * (lane & 7)); } while (0)
    int it = gw;
    if (it < NE1 + NE2) CV_LOAD(it);
    for (; it < NE1 + NE2; it += NGW) {
#pragma unroll
        for (int i = 0; i < 8; ++i) { LAS float* d = scr + (8 * i + (lane >> 3)) * 33 + 4 * (lane & 7); d[0] = ld[i].x; d[1] = ld[i].y; d[2] = ld[i].z; d[3] = ld[i].w; }
        if (it + NGW < NE1 + NE2) CV_LOAD(it + NGW);
        LDS_WAIT(); asm volatile("" ::: "memory");
        int r = it; unsigned char* WT; int ldk, k0, n0; bool perm; float qs;
        if (r < NE1) { const int le = r / I_E1; r -= le * I_E1; WT = WSP(unsigned char, WS_W1T) + (size_t)le * 2048 * D; ldk = D; k0 = 64 * (r / 64); n0 = 32 * (r % 64); perm = true; qs = QS_W1; }
        else { r -= NE1; const int le = r / I_E2; r -= le * I_E2; WT = WSP(unsigned char, WS_W2T) + (size_t)le * D * FF; ldk = FF; k0 = 64 * (r / 32); n0 = 32 * (r % 32); perm = false; qs = QS_W2; }
        { const int n = lane >> 1, hf = lane & 1; const LAS float* sp = scr + (32 * hf) * 33 + n;
          u32x4 o0, o1;
          o0.x = q8x4(sp[0 * 33] * qs, sp[1 * 33] * qs, sp[2 * 33] * qs, sp[3 * 33] * qs); o0.y = q8x4(sp[4 * 33] * qs, sp[5 * 33] * qs, sp[6 * 33] * qs, sp[7 * 33] * qs);
          o0.z = q8x4(sp[8 * 33] * qs, sp[9 * 33] * qs, sp[10 * 33] * qs, sp[11 * 33] * qs); o0.w = q8x4(sp[12 * 33] * qs, sp[13 * 33] * qs, sp[14 * 33] * qs, sp[15 * 33] * qs);
          o1.x = q8x4(sp[16 * 33] * qs, sp[17 * 33] * qs, sp[18 * 33] * qs, sp[19 * 33] * qs); o1.y = q8x4(sp[20 * 33] * qs, sp[21 * 33] * qs, sp[22 * 33] * qs, sp[23 * 33] * qs);
          o1.z = q8x4(sp[24 * 33] * qs, sp[25 * 33] * qs, sp[26 * 33] * qs, sp[27 * 33] * qs); o1.w = q8x4(sp[28 * 33] * qs, sp[29 * 33] * qs, sp[30 * 33] * qs, sp[31 * 33] * qs);
          const int ng = n0 + n; int row = ng;
          if (perm) { const int jo = ng >> 1, bj = ng & 1; row = (jo >> 7) * 256 + bj * 128 + (jo & 127); }
          unsigned char* dp = WT + (size_t)row * ldk + k0 + 32 * hf;
          *(GAS u32x4*)dp = o0; *(GAS u32x4*)(dp + 16) = o1; }
        LDS_WAIT(); asm volatile("" ::: "memory");
    }
#undef CV_LOAD
#undef CV_SRC
    __syncthreads();
}

__device__ __forceinline__ void phase_ln0(const Params& p, const Frame& F) {
    const int gw = F.vcu * NWAVES + F.wave, NGW = F.G * NWAVES;
    const float* mod = WSP(float, WS_MOD);
#pragma unroll 2
    for (int m = gw; m < T; m += NGW) {
        const int b = m / SEQ;
        const GAS f32x4* xr = (const GAS f32x4*)(INP(I_X) + (size_t)m * D) + F.lane;
        f32x4 v[4]; float s = 0.f;
#pragma unroll
        for (int j = 0; j < 4; ++j) { v[j] = xr[64 * j]; s += (v[j].x + v[j].y) + (v[j].z + v[j].w); }
        const float mean = wave_sum(s) * (1.f / D); float s2 = 0.f;
#pragma unroll
        for (int j = 0; j < 4; ++j) { v[j] = v[j] - mean; s2 += (v[j].x * v[j].x + v[j].y * v[j].y) + (v[j].z * v[j].z + v[j].w * v[j].w); }
        const float rstd = 1.f / sqrtf(wave_sum(s2) * (1.f / D) + LN_EPS);
        GAS u32x2* xo = (GAS u32x2*)(WSP(bf16, WS_X) + (size_t)m * D) + F.lane;
        GAS u32x2* ho = (GAS u32x2*)(WSP(bf16, WS_H) + (size_t)m * D) + F.lane;
#pragma unroll
        for (int j = 0; j < 4; ++j) { const int c = 4 * F.lane + 256 * j;
            const f32x4 g = *(const f32x4*)(INP(I_ELNG) + c), be = *(const f32x4*)(INP(I_ELNB) + c);
            const f32x4 x0 = v[j] * rstd * g + be; { u32x2 xw; xw.x = pk2(x0.x, x0.y); xw.y = pk2(x0.z, x0.w); xo[64 * j] = xw; }
            const f32x4 sh = *(const f32x4*)(mod + (size_t)b * 6144 + c), sc = *(const f32x4*)(mod + (size_t)b * 6144 + 1024 + c);
            const f32x4 h = x0 * (sc + 1.0f) + sh; u32x2 w; w.x = pk2(h.x, h.y); w.y = pk2(h.z, h.w); ho[64 * j] = w; }
    }
}

__device__ __forceinline__ void phase_prep(const Params& p, const Frame& F, int l) {
    const int gw = F.vcu * NWAVES + F.wave, NGW = F.G * NWAVES; const int lane = F.lane;
    const bf16* P = WSP(bf16, WS_P); const float* mu = INP(I_MU) + (size_t)l * RWKV_IN;
    const float* qg = INP(I_QNG) + (size_t)l * QLR; const float* kvg = INP(I_KVNG) + (size_t)l * KVLR;
    bf16* AN = WSP(bf16, WS_AN); bf16* A2 = WSP(bf16, WS_A2); bf16* RK = WSP(bf16, WS_RK); bf16* KKb = WSP(bf16, WS_KK);
    bf16* VS = l == 0 ? WSP(bf16, WS_VS0) : WSP(bf16, WS_VS1);
    const float* cs = WSP(float, WS_CS);
    const int RPW = (T + NGW - 1) / NGW; const int t0 = gw * RPW; const int t1 = (t0 + RPW < T) ? t0 + RPW : T;
    f32x4 mu0[3], mu1[3];
#pragma unroll
    for (int part = 0; part < 3; ++part) { mu0[part] = *(const f32x4*)(mu + part * 512 + 8 * lane); mu1[part] = *(const f32x4*)(mu + part * 512 + 8 * lane + 4); }
    const float mu_wd = mu[1536 + lane], mu_ad = mu[1600 + lane]; const f32x2 mu_gd = *(const f32x2*)(mu + 1664 + 2 * lane);
    const f32x4 gq = *(const f32x4*)(qg + 4 * lane); const f32x2 gkv = *(const f32x2*)(kvg + 2 * lane);
    u32x4 pw[3]; pw[0] = pw[1] = pw[2] = (u32x4){0u, 0u, 0u, 0u}; float p_wd = 0.f, p_ad = 0.f; unsigned p_gd = 0u;
    if (t0 < t1 && (t0 % SEQ) != 0) { const bf16* rp = P + (size_t)(t0 - 1) * N_INP + MLA_IN;
#pragma unroll
        for (int part = 0; part < 3; ++part) pw[part] = *(const u32x4*)(rp + part * 512 + 8 * lane);
        p_wd = bf2f(rp[1536 + lane]); p_ad = bf2f(rp[1600 + lane]); p_gd = *(const unsigned*)(rp + 1664 + 2 * lane); }
#pragma unroll 2
    for (int t = t0; t < t1; ++t) {
        const bf16* pr = P + (size_t)t * N_INP;
        if ((t % SEQ) == 0) { pw[0] = pw[1] = pw[2] = (u32x4){0u, 0u, 0u, 0u}; p_wd = 0.f; p_ad = 0.f; p_gd = 0u; }
        { const u32x2 qw = *(const u32x2*)(pr + 4 * lane); float q0 = bflo(qw.x), q1 = bfhi(qw.x), q2 = bflo(qw.y), q3 = bfhi(qw.y);
          const float rq = __builtin_amdgcn_rsqf(wave_sum(q0 * q0 + q1 * q1 + q2 * q2 + q3 * q3) * (1.f / QLR) + RMS_EPS);
          u32x2 w; w.x = pk2(q0 * rq * gq.x, q1 * rq * gq.y); w.y = pk2(q2 * rq * gq.z, q3 * rq * gq.w); *(u32x2*)(AN + (size_t)t * K_UP + 4 * lane) = w;
          const unsigned kw = *(const unsigned*)(pr + QLR + 2 * lane); const float k0 = bflo(kw), k1 = bfhi(kw);
          const float rk = __builtin_amdgcn_rsqf(wave_sum(k0 * k0 + k1 * k1) * (1.f / KVLR) + RMS_EPS);
          *(unsigned*)(AN + (size_t)t * K_UP + QLR + 2 * lane) = pk2(k0 * rk * gkv.x, k1 * rk * gkv.y);
          const int i = lane & 15; const unsigned rw = *(const unsigned*)(pr + QLR + KVLR + 2 * i); const float x0 = bflo(rw), x1 = bfhi(rw);
          const f32x2 csv = *(const f32x2*)(cs + (size_t)t * 32 + 2 * i); const unsigned ro = pk2(x0 * csv.x - x1 * csv.y, x0 * csv.y + x1 * csv.x);
          const int h0 = (lane >> 4) * 2;
          *(unsigned*)(KKb + (size_t)t * 768 + h0 * QKD + NOPE + 2 * i) = ro; *(unsigned*)(KKb + (size_t)t * 768 + (h0 + 1) * QKD + NOPE + 2 * i) = ro; }
        const bf16* rr = pr + MLA_IN;
#pragma unroll
        for (int part = 0; part < 3; ++part) {
            const u32x4 cw = *(const u32x4*)(rr + part * 512 + 8 * lane); const u32x4 pv_ = pw[part]; pw[part] = cw;
            float o[8];
#pragma unroll
            for (int j = 0; j < 4; ++j) { const float a = bflo(cw[j]), b = bfhi(cw[j]), pa = bflo(pv_[j]), pb = bfhi(pv_[j]); const float ma = j < 2 ? mu0[part][2 * j] : mu1[part][2 * j - 4], mb = j < 2 ? mu0[part][2 * j + 1] : mu1[part][2 * j - 3];
                o[2 * j] = a + ma * (pa - a); o[2 * j + 1] = b + mb * (pb - b); }
            u32x4 w; w.x = pk2(o[0], o[1]); w.y = pk2(o[2], o[3]); w.z = pk2(o[4], o[5]); w.w = pk2(o[6], o[7]);
            if (part < 2) *(u32x4*)(RK + (size_t)t * 1024 + part * 512 + 8 * lane) = w; else *(u32x4*)(VS + (size_t)t * C5 + 8 * lane) = w;
        }
        { const float a = bf2f(rr[1536 + lane]); const float v = a + mu_wd * (p_wd - a); p_wd = a; A2[(size_t)t * K_SM + lane] = (bf16)f2bf(tanhf_(v)); }
        { const float a = bf2f(rr[1600 + lane]); const float v = a + mu_ad * (p_ad - a); p_ad = a; A2[(size_t)t * K_SM + 64 + lane] = (bf16)f2bf(v); }
        { const unsigned cw = *(const unsigned*)(rr + 1664 + 2 * lane); const float a = bflo(cw), b = bfhi(cw); const float va = a + mu_gd.x * (bflo(p_gd) - a), vb = b + mu_gd.y * (bfhi(p_gd) - b); p_gd = cw;
          *(unsigned*)(A2 + (size_t)t * K_SM + 128 + 2 * lane) = pk2(sigmoidf_(va), sigmoidf_(vb)); }
    }
}

namespace pgm {
constexpr int RP = 64, LDA_AN = 784, LDA_A2 = 528, LDA_VS = 1040, OFF_A2 = RP * LDA_AN, OFF_VS = 0;
__device__ __forceinline__ int crow(int r, int hi) { return (r & 3) + 8 * (r >> 2) + 4 * hi; }
template <int KSTEPS>
__device__ __forceinline__ void block_mma(f32x16 (&acc)[2], const LAS unsigned char* A, int lda, const bf16* Bt, int ldb, int nrow0, int kofs, int r, int h) {
    const bf16* bp = Bt + (size_t)(nrow0 + r) * ldb + kofs + 8 * h;
    const LAS unsigned char* a0 = A + r * lda + (kofs + 8 * h) * 2; const LAS unsigned char* a1 = a0 + 32 * lda;
    bf16x8 cur[4], nxt[4];
#pragma unroll
    for (int j = 0; j < 4; ++j) cur[j] = *(const bf16x8*)(bp + 16 * j);
#pragma unroll
    for (int g = 0; g < KSTEPS / 4; ++g) {
        if (g + 1 < KSTEPS / 4) {
#pragma unroll
            for (int j = 0; j < 4; ++j) nxt[j] = *(const bf16x8*)(bp + 16 * (4 * g + 4 + j)); }
#pragma unroll
        for (int j = 0; j < 4; ++j) { const int ks = 4 * g + j; const bf16x8 x0 = *(const LAS bf16x8*)(a0 + ks * 32), x1 = *(const LAS bf16x8*)(a1 + ks * 32);
            acc[0] = __builtin_amdgcn_mfma_f32_32x32x16_bf16(cur[j], x0, acc[0], 0, 0, 0); acc[1] = __builtin_amdgcn_mfma_f32_32x32x16_bf16(cur[j], x1, acc[1], 0, 0, 0); }
        asm volatile("" ::: "memory");
#pragma unroll
        for (int j = 0; j < 4; ++j) cur[j] = nxt[j];
    }
}
template <int KSTEPS>
__device__ __forceinline__ void load_frags(bf16x8 (&fr)[KSTEPS], const bf16* pg, int frag0, int lane) {
    const bf16* bp = pg + ((size_t)frag0 * 64 + lane) * 8;
#pragma unroll
    for (int ks = 0; ks < KSTEPS; ++ks) fr[ks] = *(const bf16x8*)(bp + (size_t)ks * 512);
}
template <int KSTEPS>
__device__ __forceinline__ void mma_frags(f32x16 (&acc)[2], const LAS unsigned char* A, int lda, int kofs, const bf16x8 (&fr)[KSTEPS], int r, int h) {
    const LAS unsigned char* a0 = A + r * lda + (kofs + 8 * h) * 2; const LAS unsigned char* a1 = a0 + 32 * lda;
#pragma unroll
    for (int ks = 0; ks < KSTEPS; ++ks) { const bf16x8 x0 = *(const LAS bf16x8*)(a0 + ks * 32), x1 = *(const LAS bf16x8*)(a1 + ks * 32);
        acc[0] = __builtin_amdgcn_mfma_f32_32x32x16_bf16(fr[ks], x0, acc[0], 0, 0, 0); acc[1] = __builtin_amdgcn_mfma_f32_32x32x16_bf16(fr[ks], x1, acc[1], 0, 0, 0); }
}
constexpr int STG_LD = 80, STG_BYTES = RP * STG_LD, OFF_STG = RP * LDA_AN + RP * LDA_A2;
__device__ __forceinline__ void stage_put4(LAS unsigned char* stg, int mt, int g, int r, int h, float v0, float v1, float v2, float v3) {
    u32x2 w; w.x = cvtpk_c(v0, v1); w.y = cvtpk_c(v2, v3); *(LAS u32x2*)(stg + (32 * mt + r) * STG_LD + (8 * g + 4 * h) * 2) = w; }
__device__ __forceinline__ void stage_flush(const LAS unsigned char* stg, bf16* dst, int ldd, int lane) {
#pragma unroll
    for (int j = 0; j < 4; ++j) { const int row = 16 * j + (lane >> 2), ch = lane & 3; const u32x4 v = *(const LAS u32x4*)(stg + row * STG_LD + ch * 16); *(u32x4*)(dst + (size_t)row * ldd + 8 * ch) = v; }
}
}

__device__ __forceinline__ void phase_pgemm(const Params& p, const Frame& F, int l) {
    using namespace pgm;
    const int lane0 = F.lane, wave = F.wave;
    const bf16* P = WSP(bf16, WS_P); const float* mu = INP(I_MU) + (size_t)l * RWKV_IN;
    const float* qg = INP(I_QNG) + (size_t)l * QLR; const float* kvg = INP(I_KVNG) + (size_t)l * KVLR;
    bf16* RK = WSP(bf16, WS_RK); bf16* KKb = WSP(bf16, WS_KK); bf16* Qb = WSP(bf16, WS_Q); bf16* Vb = WSP(bf16, WS_V);
    bf16* VS = l == 0 ? WSP(bf16, WS_VS0) : WSP(bf16, WS_VS1);
    float* LWb = WSP(float, WS_LW); bf16* AGb = WSP(bf16, WS_AG);
    const float* cs = WSP(float, WS_CS);
    const bf16* PGW = WSP(bf16, WS_PGW) + (size_t)l * PGW_NFRAG * 512;
    const float* w0 = INP(I_W0) + (size_t)l * C5; const float* a0p = INP(I_A0) + (size_t)l * C5;
    LAS unsigned char* AN = F.lds; LAS unsigned char* A2 = F.lds + OFF_A2; LAS unsigned char* VSl = F.lds + OFF_VS;
    for (int panel = F.vcu; panel < T / RP; panel += F.G) {
        const int row0 = panel * RP;
        int lane = lane0; asm volatile("" : "+v"(lane)); const int r = lane & 31, h = lane >> 5;
        __syncthreads();
        {
            f32x4 mu0[3], mu1[3];
#pragma unroll
            for (int part = 0; part < 3; ++part) { mu0[part] = *(const f32x4*)(mu + part * 512 + 8 * lane); mu1[part] = *(const f32x4*)(mu + part * 512 + 8 * lane + 4); }
            const float mu_wd = mu[1536 + lane], mu_ad = mu[1600 + lane]; const f32x2 mu_gd = *(const f32x2*)(mu + 1664 + 2 * lane);
            const f32x4 gq = *(const f32x4*)(qg + 4 * lane); const f32x2 gkv = *(const f32x2*)(kvg + 2 * lane);
            const int t0 = row0 + 8 * wave;
            u32x4 pw[3]; pw[0] = pw[1] = pw[2] = (u32x4){0u, 0u, 0u, 0u}; float p_wd = 0.f, p_ad = 0.f; unsigned p_gd = 0u;
            if ((t0 % SEQ) != 0) { const bf16* rp = P + (size_t)(t0 - 1) * N_INP + MLA_IN;
#pragma unroll
                for (int part = 0; part < 3; ++part) pw[part] = *(const u32x4*)(rp + part * 512 + 8 * lane);
                p_wd = bf2f(rp[1536 + lane]); p_ad = bf2f(rp[1600 + lane]); p_gd = *(const unsigned*)(rp + 1664 + 2 * lane); }
#pragma unroll 2
            for (int i8 = 0; i8 < 8; ++i8) { const int t = t0 + i8, rl = 8 * wave + i8;
                const bf16* pr = P + (size_t)t * N_INP;
                { const u32x2 qw = *(const u32x2*)(pr + 4 * lane); float q0 = bflo(qw.x), q1 = bfhi(qw.x), q2 = bflo(qw.y), q3 = bfhi(qw.y);
                  const float rq = __builtin_amdgcn_rsqf(wave_sum(q0 * q0 + q1 * q1 + q2 * q2 + q3 * q3) * (1.f / QLR) + RMS_EPS);
                  u32x2 w; w.x = pk2(q0 * rq * gq.x, q1 * rq * gq.y); w.y = pk2(q2 * rq * gq.z, q3 * rq * gq.w); *(LAS u32x2*)(AN + rl * LDA_AN + lane * 8) = w;
                  const unsigned kw = *(const unsigned*)(pr + QLR + 2 * lane); const float k0 = bflo(kw), k1 = bfhi(kw);
                  const float rk = __builtin_amdgcn_rsqf(wave_sum(k0 * k0 + k1 * k1) * (1.f / KVLR) + RMS_EPS);
                  *(LAS unsigned*)(AN + rl * LDA_AN + (QLR + 2 * lane) * 2) = pk2(k0 * rk * gkv.x, k1 * rk * gkv.y);
                  const int i = lane & 15; const unsigned rw = *(const unsigned*)(pr + QLR + KVLR + 2 * i); const float x0 = bflo(rw), x1 = bfhi(rw);
                  const f32x2 csv = *(const f32x2*)(cs + (size_t)t * 32 + 2 * i); const unsigned ro = pk2(x0 * csv.x - x1 * csv.y, x0 * csv.y + x1 * csv.x);
                  const int h0 = (lane >> 4) * 2;
                  *(unsigned*)(KKb + (size_t)t * 768 + h0 * QKD + NOPE + 2 * i) = ro; *(unsigned*)(KKb + (size_t)t * 768 + (h0 + 1) * QKD + NOPE + 2 * i) = ro; }
                const bf16* rr = pr + MLA_IN;
#pragma unroll
                for (int part = 0; part < 3; ++part) {
                    const u32x4 cw = *(const u32x4*)(rr + part * 512 + 8 * lane); const u32x4 pv_ = pw[part]; pw[part] = cw;
                    float o[8];
#pragma unroll
                    for (int j = 0; j < 4; ++j) { const float a = bflo(cw[j]), b = bfhi(cw[j]), pa = bflo(pv_[j]), pb = bfhi(pv_[j]); const float ma = j < 2 ? mu0[part][2 * j] : mu1[part][2 * j - 4], mb = j < 2 ? mu0[part][2 * j + 1] : mu1[part][2 * j - 3];
                        o[2 * j] = a + ma * (pa - a); o[2 * j + 1] = b + mb * (pb - b); }
                    u32x4 w; w.x = pk2(o[0], o[1]); w.y = pk2(o[2], o[3]); w.z = pk2(o[4], o[5]); w.w = pk2(o[6], o[7]);
                    if (part < 2) *(u32x4*)(RK + (size_t)t * 1024 + part * 512 + 8 * lane) = w; else *(u32x4*)(VS + (size_t)t * C5 + 8 * lane) = w;
                }
                { const float a = bf2f(rr[1536 + lane]); const float v = a + mu_wd * (p_wd - a); p_wd = a; *(LAS bf16*)(A2 + rl * LDA_A2 + lane * 2) = (bf16)f2bf(tanhf_(v)); }
                { const float a = bf2f(rr[1600 + lane]); const float v = a + mu_ad * (p_ad - a); p_ad = a; *(LAS bf16*)(A2 + rl * LDA_A2 + (64 + lane) * 2) = (bf16)f2bf(v); }
                { const unsigned cw = *(const unsigned*)(rr + 1664 + 2 * lane); const float a = bflo(cw), b = bfhi(cw); const float va = a + mu_gd.x * (bflo(p_gd) - a), vb = b + mu_gd.y * (bfhi(p_gd) - b); p_gd = cw;
                  *(LAS unsigned*)(A2 + rl * LDA_A2 + (128 + 2 * lane) * 2) = pk2(sigmoidf_(va), sigmoidf_(vb)); }
            }
        }
        __syncthreads();
        LAS unsigned char* stg = F.lds + OFF_STG + wave * STG_BYTES;
        bf16x8 fq[16], fqn[16];
        load_frags<16>(fqn, PGW, PGW_Q + 16 * wave, lane);
#pragma unroll 1
        for (int nb = wave; nb < 24; nb += 8) { f32x16 acc[2]; acc[0] = f32x16{}; acc[1] = f32x16{};
#pragma unroll
            for (int ks = 0; ks < 16; ++ks) fq[ks] = fqn[ks];
            if (nb + 8 < 24) load_frags<16>(fqn, PGW, PGW_Q + 16 * (nb + 8), lane);
            const bool rope = (nb % 3) == 2;
            f32x4 c48[2][4];
#pragma unroll
            for (int mt = 0; mt < 2; ++mt)
#pragma unroll
                for (int g = 0; g < 4; ++g) c48[mt][g] = rope ? *(const f32x4*)(cs + (size_t)(row0 + 32 * mt + r) * 32 + 8 * g + 4 * h) : (f32x4){1.f, 0.f, 1.f, 0.f};
            __builtin_amdgcn_sched_barrier(0);
            mma_frags<16>(acc, AN, LDA_AN, 0, fq, r, h);
#pragma unroll
            for (int mt = 0; mt < 2; ++mt) {
#pragma unroll
                for (int g = 0; g < 4; ++g) { float v0 = acc[mt][4 * g], v1 = acc[mt][4 * g + 1], v2 = acc[mt][4 * g + 2], v3 = acc[mt][4 * g + 3];
                    if (rope) { const f32x4 c4 = c48[mt][g];
                        const float a0 = v0, a1 = v1, a2 = v2, a3 = v3; v0 = a0 * c4.x - a1 * c4.y; v1 = a0 * c4.y + a1 * c4.x; v2 = a2 * c4.z - a3 * c4.w; v3 = a2 * c4.w + a3 * c4.z; }
                    stage_put4(stg, mt, g, r, h, v0 * C2Q, v1 * C2Q, v2 * C2Q, v3 * C2Q); } }
            stage_flush(stg, Qb + (size_t)row0 * 768 + 32 * nb, 768, lane); }
        bf16x8 fk[8], fkn[8];
        load_frags<8>(fkn, PGW, PGW_KN + 8 * wave, lane);
#pragma unroll 1
        for (int nb = wave; nb < 32; nb += 8) { f32x16 acc[2]; acc[0] = f32x16{}; acc[1] = f32x16{};
            const bool isv = nb >= 16; const int n0 = 32 * (nb & 15);
#pragma unroll
            for (int ks = 0; ks < 8; ++ks) fk[ks] = fkn[ks];
            if (nb + 8 < 32) load_frags<8>(fkn, PGW, PGW_KN + 8 * (nb + 8), lane);
            __builtin_amdgcn_sched_barrier(0);
            mma_frags<8>(acc, AN, LDA_AN, 256, fk, r, h);
#pragma unroll
            for (int mt = 0; mt < 2; ++mt)
#pragma unroll
                for (int g = 0; g < 4; ++g) stage_put4(stg, mt, g, r, h, acc[mt][4 * g], acc[mt][4 * g + 1], acc[mt][4 * g + 2], acc[mt][4 * g + 3]);
            if (isv) stage_flush(stg, Vb + (size_t)row0 * C5 + n0, C5, lane); else stage_flush(stg, KKb + (size_t)row0 * 768 + (n0 >> 6) * QKD + (n0 & 63), 768, lane); }
        bf16x8 fs[8], fsn[8];
#pragma unroll
        for (int ks = 0; ks < 8; ++ks) fsn[ks] = (bf16x8){0, 0, 0, 0, 0, 0, 0, 0};
        { bf16x8 t4[4]; load_frags<4>(t4, PGW, PGW_W + 4 * wave, lane); fsn[0] = t4[0]; fsn[1] = t4[1]; fsn[2] = t4[2]; fsn[3] = t4[3]; }
#pragma unroll 1
        for (int nb = wave; nb < 48; nb += 8) { f32x16 acc[2]; acc[0] = f32x16{}; acc[1] = f32x16{};
            const int kind = nb >> 4, n0 = 32 * (nb & 15);
#pragma unroll
            for (int ks = 0; ks < 8; ++ks) fs[ks] = fsn[ks];
            if (nb + 8 < 48) { const int nn = nb + 8, kn = nn >> 4;
                if (kn == 2) load_frags<8>(fsn, PGW, PGW_G + 8 * (nn & 15), lane);
                else { bf16x8 t4[4]; load_frags<4>(t4, PGW, (kn == 0 ? PGW_W : PGW_A) + 4 * (nn & 15), lane); fsn[0] = t4[0]; fsn[1] = t4[1]; fsn[2] = t4[2]; fsn[3] = t4[3]; } }
            f32x4 bz4[4];
#pragma unroll
            for (int g = 0; g < 4; ++g) bz4[g] = kind == 2 ? (f32x4){0.f, 0.f, 0.f, 0.f} : *(const f32x4*)((kind == 0 ? w0 : a0p) + n0 + 8 * g + 4 * h);
            __builtin_amdgcn_sched_barrier(0);
            if (kind == 2) mma_frags<8>(acc, A2, LDA_A2, 128, fs, r, h);
            else { bf16x8 t4[4]; t4[0] = fs[0]; t4[1] = fs[1]; t4[2] = fs[2]; t4[3] = fs[3]; mma_frags<4>(acc, A2, LDA_A2, kind == 0 ? 0 : 64, t4, r, h); }
            if (kind == 0) {
#pragma unroll
                for (int mt = 0; mt < 2; ++mt) { float* lrow = LWb + (size_t)(row0 + 32 * mt + r) * C5 + n0;
#pragma unroll
                    for (int g = 0; g < 4; ++g) { const f32x4 bz = bz4[g]; f32x4 o;
#pragma unroll
                        for (int e = 0; e < 4; ++e) { const float z = -(acc[mt][4 * g + e] + bz[e]); const float sp = fmaxf(z, 0.f) + __logf(1.0f + __expf(-fabsf(z))); o[e] = -__expf(-sp - 0.5f); }
                        *(f32x4*)(lrow + 8 * g + 4 * h) = o; } }
            } else {
#pragma unroll
                for (int mt = 0; mt < 2; ++mt)
#pragma unroll
                    for (int g = 0; g < 4; ++g) { float v0 = acc[mt][4 * g], v1 = acc[mt][4 * g + 1], v2 = acc[mt][4 * g + 2], v3 = acc[mt][4 * g + 3];
                        if (kind == 1) { const f32x4 bz = bz4[g]; v0 = sigmoidf_(v0 + bz.x); v1 = sigmoidf_(v1 + bz.y); v2 = sigmoidf_(v2 + bz.z); v3 = sigmoidf_(v3 + bz.w); }
                        stage_put4(stg, mt, g, r, h, v0, v1, v2, v3); }
                stage_flush(stg, AGb + (size_t)row0 * 1024 + (kind - 1) * 512 + n0, 1024, lane); } }
        if (l > 0) {
            int tid2 = F.tid; asm volatile("" : "+v"(tid2)); const int lane2 = tid2 & 63, r2 = tid2 & 31, h2 = (tid2 >> 5) & 1;
            __syncthreads();
            const bf16* VS1 = WSP(bf16, WS_VS1); const bf16* VS0 = WSP(bf16, WS_VS0); bf16* VR = WSP(bf16, WS_VR); const float* v0 = INP(I_V0);
            asm volatile("s_waitcnt vmcnt(0)" ::: "memory");
            __builtin_amdgcn_fence(__ATOMIC_ACQUIRE, "agent"); asm volatile("s_waitcnt vmcnt(0)" ::: "memory");
            for (int i = tid2; i < RP * 64; i += NTHREADS) { const int rl = i >> 6, ch = i & 63; *(LAS u32x4*)(VSl + rl * LDA_VS + ch * 16) = *(const u32x4*)(VS1 + (size_t)(row0 + rl) * C5 + ch * 8); }
            __syncthreads();
#pragma unroll 1
            for (int nb = wave; nb < 16; nb += 8) { f32x16 acc[2]; acc[0] = f32x16{}; acc[1] = f32x16{};
                { bf16x8 fv[16]; load_frags<16>(fv, PGW, PGW_VR + 32 * nb, lane2); mma_frags<16>(acc, VSl, LDA_VS, 0, fv, r2, h2); load_frags<16>(fv, PGW, PGW_VR + 32 * nb + 16, lane2); mma_frags<16>(acc, VSl, LDA_VS, 256, fv, r2, h2); }
#pragma unroll
                for (int mt = 0; mt < 2; ++mt) { const int rl = 32 * mt + r2; const size_t row = (size_t)(row0 + rl);
#pragma unroll
                    for (int g = 0; g < 4; ++g) { const int n = 32 * nb + 8 * g + 4 * h2; const f32x4 bz = *(const f32x4*)(v0 + n);
                        const u32x2 sw = *(const LAS u32x2*)(VSl + rl * LDA_VS + n * 2); const u32x2 fw = *(const u32x2*)(VS0 + row * C5 + n);
                        const float s0 = bflo(sw.x), s1 = bfhi(sw.x), s2 = bflo(sw.y), s3 = bfhi(sw.y), f0 = bflo(fw.x), f1 = bfhi(fw.x), f2 = bflo(fw.y), f3 = bfhi(fw.y);
                        stage_put4(stg, mt, g, r2, h2, s0 + (f0 - s0) * sigmoidf_(acc[mt][4 * g] + bz.x), s1 + (f1 - s1) * sigmoidf_(acc[mt][4 * g + 1] + bz.y),
                                   s2 + (f2 - s2) * sigmoidf_(acc[mt][4 * g + 2] + bz.z), s3 + (f3 - s3) * sigmoidf_(acc[mt][4 * g + 3] + bz.w)); } }
                stage_flush(stg, VR + (size_t)row0 * C5 + 32 * nb, C5, lane2); }
        }
    }
    __syncthreads();
}

namespace att {
__device__ __forceinline__ int crow(int r, int hi) { return (r & 3) + 8 * (r >> 2) + 4 * hi; }
constexpr int KSLOT = 12288, VSLOT = 8192;
constexpr int NSLOT = 3;
constexpr int LDS_K = 0, LDS_V = NSLOT * KSLOT, LDS_WS = LDS_V + NSLOT * VSLOT, LDS_OST = LDS_WS + NWAVES * 64 * 4, LDS_TOTAL = LDS_OST + NWAVES * 4096;
__device__ __forceinline__ void glds16(const void* gsrc, unsigned lds_dst) { unsigned keep;
    asm volatile("s_mov_b32 %0, m0\n\ts_mov_b32 m0, %2\n\ts_nop 0\n\tglobal_load_lds_dwordx4 %1, off\n\ts_mov_b32 m0, %0" : "=&s"(keep) : "v"(gsrc), "s"(lds_dst) : "memory"); }
__device__ __forceinline__ float max3f(float a, float b, float c) { return fmaxf(fmaxf(a, b), c); }
#define ATT_WAIT_BAR() asm volatile("s_waitcnt vmcnt(0) lgkmcnt(0)\n\ts_barrier" ::: "memory")
__device__ __forceinline__ float rowmax(const f32x16& p0, const f32x16& p1) {
    float a = max3f(p0[0], p0[1], p1[0]), b = max3f(p0[2], p0[3], p1[1]); a = max3f(a, p1[2], p1[3]);
#pragma unroll
    for (int r = 4; r < 16; r += 4) { a = max3f(a, p0[r], p0[r + 1]); b = max3f(b, p0[r + 2], p0[r + 3]); a = max3f(a, p1[r], p1[r + 1]); b = max3f(b, p1[r + 2], p1[r + 3]); }
    const float m = fmaxf(a, b);
    auto rr = __builtin_amdgcn_permlane32_swap(__float_as_uint(m), __float_as_uint(m), false, false);
    return fmaxf(__uint_as_float(rr[0]), __uint_as_float(rr[1]));
}
__device__ __forceinline__ void pv(f32x16* o, int vb, bf16x8 pa0, bf16x8 pa1, bf16x8 pa2, bf16x8 pa3) {
#pragma unroll
    for (int d0 = 0; d0 < 2; ++d0) { s16x4 lo[4], hi[4];
#pragma unroll
        for (int ks = 0; ks < 4; ++ks) {
            asm volatile("ds_read_b64_tr_b16 %0,%1 offset:%c2" : "=&v"(lo[ks]) : "v"(vb), "i"(d0 * 4096 + ks * 1024) : "memory");
            asm volatile("ds_read_b64_tr_b16 %0,%1 offset:%c2" : "=&v"(hi[ks]) : "v"(vb), "i"(d0 * 4096 + ks * 1024 + 512) : "memory"); }
        asm volatile("s_waitcnt lgkmcnt(0)" ::: "memory"); __builtin_amdgcn_sched_barrier(0);
#define PK(k) (bf16x8){lo[k][0], lo[k][1], lo[k][2], lo[k][3], hi[k][0], hi[k][1], hi[k][2], hi[k][3]}
        o[d0] = __builtin_amdgcn_mfma_f32_32x32x16_bf16(pa0, PK(0), o[d0], 0, 0, 0);
        o[d0] = __builtin_amdgcn_mfma_f32_32x32x16_bf16(pa1, PK(1), o[d0], 0, 0, 0);
        o[d0] = __builtin_amdgcn_mfma_f32_32x32x16_bf16(pa2, PK(2), o[d0], 0, 0, 0);
        o[d0] = __builtin_amdgcn_mfma_f32_32x32x16_bf16(pa3, PK(3), o[d0], 0, 0, 0);
#undef PK
    }
}
__device__ __forceinline__ void attn_unit(int b, int h, int qb, const bf16* Q, const bf16* __restrict__ KKp, const bf16* __restrict__ Vp, bf16* O, char* shm) {
    const int tid = threadIdx.x, lane = tid & 63, r32 = lane & 31, hi = lane >> 5; const int wid = __builtin_amdgcn_readfirstlane(tid >> 6);
    const long rowbase = (long)b * SEQ; const int q0 = qb * 256;
    const bf16* Qw = Q + (rowbase + q0 + wid * 32) * 768 + h * QKD;
    const bf16* Kh = KKp + rowbase * 768 + h * QKD; const bf16* Vh = Vp + rowbase * 512 + h * VD;
    const unsigned lds0 = (unsigned)(uintptr_t)shm;
    float* wsf = (float*)(shm + LDS_WS) + wid * 64;
    const bf16* ksrc0 = Kh + (long)lane * 768 + wid * 8;
    const bf16* ksrc1 = Kh + (long)lane * 768 + (8 + (wid & 3)) * 8;
    const bf16* vsrc = Vh + (long)(16 * (wid & 3) + (lane >> 2)) * 512 + (wid >> 2) * 32 + (lane & 3) * 8;
    const unsigned kdst0 = lds0 + LDS_K + wid * 1024, kdst1 = lds0 + LDS_K + (8 + (wid & 3)) * 1024, vdst = lds0 + LDS_V + wid * 1024;
#define DMA_KV(t, s) do { glds16(ksrc0 + (long)(t) * 64 * 768, (unsigned)__builtin_amdgcn_readfirstlane(kdst0 + (s) * KSLOT)); \
        if (wid < 4) glds16(ksrc1 + (long)(t) * 64 * 768, (unsigned)__builtin_amdgcn_readfirstlane(kdst1 + (s) * KSLOT)); \
        glds16(vsrc + (long)(t) * 64 * 512, (unsigned)__builtin_amdgcn_readfirstlane(vdst + (s) * VSLOT)); } while (0)
    const int vb0 = (int)(lds0 + LDS_V) + ((lane >> 4) & 1) * 32 + (lane & 3) * 8 + (4 * hi + ((lane & 15) >> 2)) * 64;
    const int NT = (q0 + 256) / 64;
    DMA_KV(0, 0); DMA_KV(1, 1);
    bf16x8 qr[6];
#pragma unroll
    for (int d0 = 0; d0 < 6; ++d0) qr[d0] = *reinterpret_cast<const bf16x8*>(&Qw[(long)r32 * 768 + d0 * 16 + hi * 8]);
    float mhat = 0.f, l_reg = 0.f; f32x16 o[2]; o[0] = f32x16{}; o[1] = f32x16{};
    f32x16 negm = f32x16{};
    const int qrel = wid * 32 + r32;
    typedef short v4i16_t __attribute__((ext_vector_type(4)));
    typedef __attribute__((address_space(3))) v4i16_t* lds_v4p;
    int sl_cur = 0, sl_nn = 2;
    for (int t = 0; t < NT; ++t) {
        if (t + 1 < NT && t > 0) { if (wid < 4) asm volatile("s_waitcnt vmcnt(3) lgkmcnt(0)\n\ts_barrier" ::: "memory"); else asm volatile("s_waitcnt vmcnt(2) lgkmcnt(0)\n\ts_barrier" ::: "memory"); }
        else ATT_WAIT_BAR();
        if (t + 2 < NT) DMA_KV(t + 2, sl_nn);
        const char* Kslot = shm + LDS_K + sl_cur * KSLOT;
        f32x16 p0 = negm, p1 = negm;
        { const char* kb = Kslot + hi * 1024 + r32 * 16;
#pragma unroll
          for (int d0 = 0; d0 < 6; ++d0) { const bf16x8 b0 = *reinterpret_cast<const bf16x8*>(kb + d0 * 2048); const bf16x8 b1 = *reinterpret_cast<const bf16x8*>(kb + d0 * 2048 + 512);
              p0 = __builtin_amdgcn_mfma_f32_32x32x16_bf16(b0, qr[d0], p0, 0, 0, 0); p1 = __builtin_amdgcn_mfma_f32_32x32x16_bf16(b1, qr[d0], p1, 0, 0, 0); } }
        s16x4 vlo[8], vhi[8];
        { const int vb = vb0 + sl_cur * VSLOT;
#pragma unroll
          for (int i = 0; i < 8; ++i) { const int off = (i >> 2) * 4096 + (i & 3) * 1024;
              vlo[i] = __builtin_bit_cast(s16x4, __builtin_amdgcn_ds_read_tr16_b64_v4i16((lds_v4p)(vb + off))); vhi[i] = __builtin_bit_cast(s16x4, __builtin_amdgcn_ds_read_tr16_b64_v4i16((lds_v4p)(vb + off + 512))); } }
        const int jb = t - (NT - 4);
        if (jb >= 0) { const int kbase = 64 * jb + 4 * hi;
#pragma unroll
            for (int r = 0; r < 16; ++r) { const int kv = kbase + (r & 3) + 8 * (r >> 2); if (kv > qrel) p0[r] = -INFINITY; if (kv + 32 > qrel) p1[r] = -INFINITY; } }
        const float rm = rowmax(p0, p1);
        bool resc = false;
        if (t == 0 || __any(rm > 8.0f)) {
            const float dl = (t == 0) ? rm : fmaxf(rm, 0.f); mhat += dl;
#pragma unroll
            for (int r = 0; r < 16; ++r) { p0[r] -= dl; p1[r] -= dl; negm[r] = -mhat; }
            const float f = (t == 0) ? 1.0f : __builtin_amdgcn_exp2f(-dl); l_reg *= f; if (hi == 0) wsf[r32] = f; resc = true; }
        float sacc = 0.f;
#pragma unroll
        for (int r = 0; r < 16; ++r) { p0[r] = __builtin_amdgcn_exp2f(p0[r]); p1[r] = __builtin_amdgcn_exp2f(p1[r]); sacc += p0[r] + p1[r]; }
        l_reg += sacc;
        if (resc) { asm volatile("s_waitcnt lgkmcnt(0)" ::: "memory");
#pragma unroll
            for (int r = 0; r < 16; ++r) { const float fr_ = wsf[crow(r, hi)]; o[0][r] *= fr_; o[1][r] *= fr_; } }
        u32x4 pw[4];
        pw[0] = (u32x4){cvtpk_c(p0[0], p0[1]), cvtpk_c(p0[2], p0[3]), cvtpk_c(p0[4], p0[5]), cvtpk_c(p0[6], p0[7])};
        pw[1] = (u32x4){cvtpk_c(p0[8], p0[9]), cvtpk_c(p0[10], p0[11]), cvtpk_c(p0[12], p0[13]), cvtpk_c(p0[14], p0[15])};
        pw[2] = (u32x4){cvtpk_c(p1[0], p1[1]), cvtpk_c(p1[2], p1[3]), cvtpk_c(p1[4], p1[5]), cvtpk_c(p1[6], p1[7])};
        pw[3] = (u32x4){cvtpk_c(p1[8], p1[9]), cvtpk_c(p1[10], p1[11]), cvtpk_c(p1[12], p1[13]), cvtpk_c(p1[14], p1[15])};
#pragma unroll
        for (int i = 0; i < 8; ++i) { const bf16x8 vf = (bf16x8){vlo[i][0], vlo[i][1], vlo[i][2], vlo[i][3], vhi[i][0], vhi[i][1], vhi[i][2], vhi[i][3]};
            o[i >> 2] = __builtin_amdgcn_mfma_f32_32x32x16_bf16(__builtin_bit_cast(bf16x8, pw[i & 3]), vf, o[i >> 2], 0, 0, 0); }
        sl_cur = (sl_cur == NSLOT - 1) ? 0 : sl_cur + 1; sl_nn = (sl_nn == NSLOT - 1) ? 0 : sl_nn + 1;
    }
    { auto rr = __builtin_amdgcn_permlane32_swap(__float_as_uint(l_reg), __float_as_uint(l_reg), false, false); l_reg = __uint_as_float(rr[0]) + __uint_as_float(rr[1]); }
    if (hi == 0) wsf[32 + r32] = l_reg; asm volatile("s_waitcnt lgkmcnt(0)" ::: "memory");
    float rli[16];
#pragma unroll
    for (int r = 0; r < 16; ++r) rli[r] = __builtin_amdgcn_rcpf(wsf[32 + crow(r, hi)]);
    bf16* Ow = O + (rowbase + q0 + wid * 32) * 512 + h * VD;
    { bf16* stg = (bf16*)(shm + LDS_OST) + wid * 2048;
#pragma unroll
      for (int r = 0; r < 16; ++r) { const int orow = crow(r, hi);
#pragma unroll
          for (int d0 = 0; d0 < 2; ++d0) stg[orow * 64 + d0 * 32 + r32] = (bf16)f2bf(o[d0][r] * rli[r]); }
      asm volatile("s_waitcnt lgkmcnt(0)" ::: "memory");
#pragma unroll
      for (int i = 0; i < 4; ++i) { const int row = i * 8 + (lane >> 3), ch = lane & 7; const u32x4 v = *(const u32x4*)(stg + row * 64 + ch * 8); *(u32x4*)(Ow + (long)row * 512 + ch * 8) = v; } }
    asm volatile("s_waitcnt vmcnt(0) lgkmcnt(0)\n\ts_barrier" ::: "memory");
#undef DMA_KV
}
}

__device__ __forceinline__ void phase_attn(const Params& p, const Frame& F, char* lds_generic, int l) {
    const bf16* Q = WSP(bf16, WS_Q); const bf16* KKp = WSP(bf16, WS_KK); const bf16* Vp = WSP(bf16, WS_V); bf16* O = WSP(bf16, WS_O);
    unsigned* head = (unsigned*)(F.ws + WS_CTL) + CW_ATTQ + l * 64;
    volatile LAS unsigned* MISC = (volatile LAS unsigned*)(F.lds + MISC_OFF);
    for (;;) {
        if (F.tid == 0) MISC[16] = __hip_atomic_fetch_add(head, 1u, RLX_AGENT);
        __syncthreads();
        const unsigned k = MISC[16];
        __syncthreads();
        if (k >= 1024u) break;
        const int qb = 15 - (int)(k >> 6), bh = (int)(k & 63u);
        att::attn_unit(bh >> 3, bh & 7, qb, Q, KKp, Vp, O, lds_generic);
    }
}

namespace rw {
constexpr int RS = 144;
constexpr int SLOT = 64 * RS;
constexpr int S_KT = 0, S_RT = 1, S_BC = 2, S_KC = 3, S_V = 4, S_BH = 5, S_KH = 6, S_GT = 7, S_ABK = 8, S_AKK = 9, S_AKR = 10, S_ABR = 11, S_ABKF = 12;
constexpr int S_TT = S_BC, S_ZT = S_KC, S_NW1T = S_AKK, S_NW2T = S_ABK;
constexpr int TOT_OFF = 13 * SLOT, PL_OFF = TOT_OFF + 8 * 64 * 4;
typedef short v4i16_t __attribute__((ext_vector_type(4)));
__device__ __forceinline__ int crow(int r, int hi) { return (r & 3) + 8 * (r >> 2) + 4 * hi; }
__device__ __forceinline__ bf16x8 frag_d(const LAS unsigned char* M, int row0, int k0, int r, int h) { return *(const LAS bf16x8*)(M + (row0 + r) * RS + (k0 + 8 * h) * 2); }
__device__ __forceinline__ bf16x8 frag_t(const LAS unsigned char* M, int k0, int col0, int lane) {
    const int h = lane >> 5, blk = (lane >> 4) & 1, q = (lane & 15) >> 2, pp = lane & 3;
    const LAS unsigned char* a = M + (k0 + 8 * h + q) * RS + (col0 + 16 * blk + 4 * pp) * 2;
    const v4i16_t lo = __builtin_amdgcn_ds_read_tr16_b64_v4i16((LAS v4i16_t*)a), hi = __builtin_amdgcn_ds_read_tr16_b64_v4i16((LAS v4i16_t*)(a + 4 * RS));
    return (bf16x8){lo[0], lo[1], lo[2], lo[3], hi[0], hi[1], hi[2], hi[3]};
}
__device__ __forceinline__ void store_T(LAS unsigned char* D, int m0, int n0, const f32x16& acc, float sgn, int r, int h) {
#pragma unroll
    for (int g = 0; g < 4; ++g) { u32x2 w; w.x = cvtpk_c(acc[4 * g] * sgn, acc[4 * g + 1] * sgn); w.y = cvtpk_c(acc[4 * g + 2] * sgn, acc[4 * g + 3] * sgn);
        *(LAS u32x2*)(D + (n0 + r) * RS + (m0 + 8 * g + 4 * h) * 2) = w; }
}
#define RW_MMA(acc, A, B) acc = __builtin_amdgcn_mfma_f32_32x32x16_bf16((A), (B), acc, 0, 0, 0)
}

#define LBAR() asm volatile("s_waitcnt lgkmcnt(0)\n\ts_barrier" ::: "memory")
__device__ __forceinline__ void phase_rwkv_r1(const Params& p, const Frame& F, int l) {
    using namespace rw;
    LAS unsigned char* L0 = F.lds;
#define SL(i) (L0 + (i) * SLOT)
    const bf16* RK = WSP(bf16, WS_RK); const float* LWp = WSP(float, WS_LW); const bf16* AGp = WSP(bf16, WS_AG);
    const bf16* Vv = l == 0 ? WSP(bf16, WS_VS0) : WSP(bf16, WS_VR);
    float* CH = WSP(float, WS_CH);
    const float* kkw = INP(I_KK) + (size_t)l * C5; const float* kaw = INP(I_KA) + (size_t)l * C5;
    const int tid0 = F.tid, wave = F.wave;
    const int pt0 = tid0 >> 3, j80 = tid0 & 7;
    LAS float* tot = (LAS float*)(L0 + TOT_OFF); LAS float* PLv = (LAS float*)(L0 + PL_OFF);
    u32x4 g_r, g_k, g_v, g_a; f32x4 g_l0, g_l1;
#define R1_FETCH(uu) do { const int bh_ = (uu) >> 6, cc_ = (uu) & 63; const size_t tok = (size_t)(bh_ >> 3) * SEQ + (size_t)cc_ * 64 + pt0; const int c_ = (bh_ & 7) * 64 + 8 * j80; \
        g_r = *(const u32x4*)(RK + tok * 1024 + c_); g_k = *(const u32x4*)(RK + tok * 1024 + 512 + c_); g_v = *(const u32x4*)(Vv + tok * C5 + c_); \
        g_l0 = *(const f32x4*)(LWp + tok * C5 + c_); g_l1 = *(const f32x4*)(LWp + tok * C5 + c_ + 4); g_a = *(const u32x4*)(AGp + tok * 1024 + c_); } while (0)
    int u = F.vcu;
    if (u < 4096) R1_FETCH(u);
    for (; u < 4096; u += F.G) {
        const int hh = (u >> 6) & 7;
        int tid = tid0; asm volatile("" : "+v"(tid)); const int lane = tid & 63, r = lane & 31, h = lane >> 5, pt = tid >> 3, j8 = tid & 7;
        {
            const int c = hh * 64 + 8 * j8;
            const f32x4 kk0 = *(const f32x4*)(kkw + c), kk1 = *(const f32x4*)(kkw + c + 4), ka0 = *(const f32x4*)(kaw + c), ka1 = *(const f32x4*)(kaw + c + 4);
            float rr[8], k[8], a[8], x[8], lw[8], kap[8], be[8], kp[8]; float ss = 0.f;
#pragma unroll
            for (int j = 0; j < 4; ++j) { rr[2 * j] = bflo(g_r[j]); rr[2 * j + 1] = bfhi(g_r[j]); k[2 * j] = bflo(g_k[j]); k[2 * j + 1] = bfhi(g_k[j]); }
            *(LAS u32x4*)(SL(S_V) + pt * RS + j8 * 16) = g_v;
#pragma unroll
            for (int j = 0; j < 8; ++j) { a[j] = (j & 1) ? bfhi(g_a[j >> 1]) : bflo(g_a[j >> 1]); lw[j] = j < 4 ? g_l0[j & 3] : g_l1[j & 3]; x[j] = lw[j]; const float q = k[j] * (j < 4 ? kk0[j & 3] : kk1[j & 3]); kap[j] = q; ss += q * q; }
            ss += __shfl_xor(ss, 1); ss += __shfl_xor(ss, 2); ss += __shfl_xor(ss, 4);
            const float inv = 1.0f / fmaxf(sqrtf(ss), 1e-12f);
#pragma unroll
            for (int j = 0; j < 8; ++j) { kap[j] *= inv; be[j] = kap[j] * a[j]; kp[j] = k[j] * (1.0f + (a[j] - 1.0f) * (j < 4 ? ka0[j & 3] : ka1[j & 3])); }
#pragma unroll
            for (int off = 8; off < 64; off <<= 1) {
#pragma unroll
                for (int j = 0; j < 8; ++j) { const float y = __shfl_up(x[j], off); if (lane >= off) x[j] += y; } }
            if (lane >= 56) { *(LAS f32x4*)(tot + wave * 64 + 8 * j8) = (f32x4){x[0], x[1], x[2], x[3]}; *(LAS f32x4*)(tot + wave * 64 + 8 * j8 + 4) = (f32x4){x[4], x[5], x[6], x[7]}; }
            LBAR();
            float csL[8];
#pragma unroll
            for (int j = 0; j < 8; ++j) csL[j] = 0.f;
#pragma unroll
            for (int w2 = 0; w2 < 8; ++w2) { const f32x4 t0 = *(const LAS f32x4*)(tot + w2 * 64 + 8 * j8), t1 = *(const LAS f32x4*)(tot + w2 * 64 + 8 * j8 + 4);
#pragma unroll
                for (int j = 0; j < 8; ++j) { const float tv = j < 4 ? t0[j & 3] : t1[j & 3]; csL[j] += tv; if (w2 < wave) x[j] += tv; } }
            if (pt == 0) {
#pragma unroll
                for (int j = 0; j < 8; ++j) PLv[8 * j8 + j] = __expf(csL[j]); }
            float kt[8], rt[8], bc[8], kc[8], bh[8], kh[8];
#pragma unroll
            for (int j = 0; j < 8; ++j) { const float eP = __expf(x[j]), ePm1 = __expf(x[j] - lw[j]), eInv = __expf(-x[j]), eL = __expf(csL[j] - x[j]);
                kt[j] = kap[j] * ePm1; rt[j] = rr[j] * eP; bc[j] = be[j] * eInv; kc[j] = kp[j] * eInv; bh[j] = be[j] * eL; kh[j] = kp[j] * eL; }
#define PK8(v) (u32x4){cvtpk_c(v[0], v[1]), cvtpk_c(v[2], v[3]), cvtpk_c(v[4], v[5]), cvtpk_c(v[6], v[7])}
            *(LAS u32x4*)(SL(S_KT) + pt * RS + j8 * 16) = PK8(kt); *(LAS u32x4*)(SL(S_RT) + pt * RS + j8 * 16) = PK8(rt);
            *(LAS u32x4*)(SL(S_BC) + pt * RS + j8 * 16) = PK8(bc); *(LAS u32x4*)(SL(S_KC) + pt * RS + j8 * 16) = PK8(kc);
            *(LAS u32x4*)(SL(S_BH) + pt * RS + j8 * 16) = PK8(bh); *(LAS u32x4*)(SL(S_KH) + pt * RS + j8 * 16) = PK8(kh);
#undef PK8
        }
        LBAR();
        {
            const int mat = wave >> 1, ti = wave & 1;
            const LAS unsigned char* X = (mat < 2) ? SL(S_KT) : SL(S_RT); const LAS unsigned char* Y = (mat == 0 || mat == 3) ? SL(S_BC) : SL(S_KC);
            LAS unsigned char* Dm = SL(S_ABK + mat);
            const int t = 32 * ti + r;
            bf16x8 xb[4];
#pragma unroll
            for (int kk = 0; kk < 4; ++kk) xb[kk] = frag_d(X, 32 * ti, 16 * kk, r, h);
#pragma unroll
            for (int si = 0; si < 2; ++si) {
                f32x16 acc = f32x16{};
                if (!(ti == 0 && si == 1)) {
#pragma unroll
                    for (int kk = 0; kk < 4; ++kk) RW_MMA(acc, frag_d(Y, 32 * si, 16 * kk, r, h), xb[kk]); }
#pragma unroll
                for (int g = 0; g < 4; ++g) { float v[4];
#pragma unroll
                    for (int e = 0; e < 4; ++e) { const int sidx = 32 * si + 8 * g + 4 * h + e; const bool keep = (mat < 2) ? (sidx < t) : (sidx <= t); v[e] = keep ? acc[4 * g + e] : 0.f; }
                    u32x2 w; w.x = cvtpk_c(v[0], v[1]); w.y = cvtpk_c(v[2], v[3]);
                    *(LAS u32x2*)(Dm + t * RS + (32 * si + 8 * g + 4 * h) * 2) = w;
                    if (mat == 0 && ti == si) *(LAS f32x4*)(SL(S_ABKF) + ti * 4608 + r * 144 + (8 * g + 4 * h) * 4) = (f32x4){v[0], v[1], v[2], v[3]}; }
            }
        }
        LBAR();
        if (wave == 0) {
            const int hb = lane >> 5, c = lane & 31; const LAS unsigned char* Ab = SL(S_ABKF) + hb * 4608;
            float Tc[32];
#pragma unroll
            for (int t = 0; t < 32; ++t) Tc[t] = 0.f;
#pragma unroll
            for (int t = 0; t < 32; ++t) { float acc0 = (t == c) ? 1.0f : 0.0f, acc1 = 0.f;
#pragma unroll
                for (int s4 = 0; s4 < (t + 3) / 4; ++s4) { const f32x4 a4 = *(const LAS f32x4*)(Ab + t * 144 + s4 * 16);
                    acc0 -= a4.x * Tc[4 * s4]; acc1 -= a4.y * Tc[4 * s4 + 1]; acc0 -= a4.z * Tc[4 * s4 + 2]; acc1 -= a4.w * Tc[4 * s4 + 3]; }
                float acc = acc0 + acc1;
                asm volatile("" : "+v"(acc) :: "memory");
                Tc[t] = acc; }
#pragma unroll
            for (int q = 0; q < 4; ++q) *(LAS u32x4*)(SL(S_TT) + (32 * hb + c) * RS + (32 * hb) * 2 + q * 16) =
                (u32x4){cvtpk_c(Tc[8 * q], Tc[8 * q + 1]), cvtpk_c(Tc[8 * q + 2], Tc[8 * q + 3]), cvtpk_c(Tc[8 * q + 4], Tc[8 * q + 5]), cvtpk_c(Tc[8 * q + 6], Tc[8 * q + 7])};
        } else if (wave == 1) {
            const int row = 32 + (lane >> 1), hf = lane & 1;
            *(LAS u32x4*)(SL(S_TT) + row * RS + hf * 32) = (u32x4){0u, 0u, 0u, 0u}; *(LAS u32x4*)(SL(S_TT) + row * RS + hf * 32 + 16) = (u32x4){0u, 0u, 0u, 0u};
        } else if (wave >= 4) {
            const int ti = (wave - 4) >> 1, ii = (wave - 4) & 1; f32x16 acc = f32x16{};
#pragma unroll
            for (int kk = 0; kk < 4; ++kk) RW_MMA(acc, frag_d(SL(S_AKK), 32 * ti, 16 * kk, r, h), frag_t(SL(S_V), 16 * kk, 32 * ii, lane));
            store_T(SL(S_GT), 32 * ti, 32 * ii, acc, 1.0f, r, h);
        }
        LBAR();
        if (wave == 0) { f32x16 acc = f32x16{};
#pragma unroll
            for (int kk = 0; kk < 2; ++kk) RW_MMA(acc, frag_d(SL(S_ABK), 32, 16 * kk, r, h), frag_d(SL(S_TT), 0, 16 * kk, r, h));
            store_T(SL(S_ZT), 0, 0, acc, 1.0f, r, h); }
        LBAR();
        if (wave == 0) { f32x16 acc = f32x16{};
#pragma unroll
            for (int kk = 0; kk < 2; ++kk) RW_MMA(acc, frag_t(SL(S_TT), 32 + 16 * kk, 32, lane), frag_d(SL(S_ZT), 0, 16 * kk, r, h));
            store_T(SL(S_TT), 32, 0, acc, -1.0f, r, h); }
        LBAR();
        if (u + F.G < 4096) R1_FETCH(u + F.G);
        { const int w4 = wave & 3, ti = w4 >> 1, ci = w4 & 1; f32x16 acc = f32x16{};
          if (wave < 4) {
#pragma unroll
              for (int kk = 0; kk < 4; ++kk) RW_MMA(acc, frag_t(SL(S_TT), 16 * kk, 32 * ti, lane), frag_t(SL(S_KT), 16 * kk, 32 * ci, lane));
              store_T(SL(S_NW1T), 32 * ti, 32 * ci, acc, -1.0f, r, h); }
          else {
#pragma unroll
              for (int kk = 0; kk < 4; ++kk) RW_MMA(acc, frag_t(SL(S_TT), 16 * kk, 32 * ti, lane), frag_d(SL(S_GT), 32 * ci, 16 * kk, r, h));
              store_T(SL(S_NW2T), 32 * ti, 32 * ci, acc, -1.0f, r, h); } }
        LBAR();
        { const int which = wave >> 1, mi = wave & 1; float* dst = CH + ((size_t)u * 4 + which) * 4096;
#pragma unroll
          for (int ni = 0; ni < 2; ++ni) { f32x16 acc = f32x16{};
#pragma unroll
              for (int kk = 0; kk < 4; ++kk) {
                  if (which == 0) RW_MMA(acc, frag_d(SL(S_ABR), 32 * mi, 16 * kk, r, h), frag_d(SL(S_NW1T), 32 * ni, 16 * kk, r, h));
                  else if (which == 1) { RW_MMA(acc, frag_d(SL(S_AKR), 32 * mi, 16 * kk, r, h), frag_t(SL(S_V), 16 * kk, 32 * ni, lane)); RW_MMA(acc, frag_d(SL(S_ABR), 32 * mi, 16 * kk, r, h), frag_d(SL(S_NW2T), 32 * ni, 16 * kk, r, h)); }
                  else if (which == 2) RW_MMA(acc, frag_t(SL(S_BH), 16 * kk, 32 * mi, lane), frag_d(SL(S_NW1T), 32 * ni, 16 * kk, r, h));
                  else { RW_MMA(acc, frag_t(SL(S_KH), 16 * kk, 32 * mi, lane), frag_t(SL(S_V), 16 * kk, 32 * ni, lane)); RW_MMA(acc, frag_t(SL(S_BH), 16 * kk, 32 * mi, lane), frag_d(SL(S_NW2T), 32 * ni, 16 * kk, r, h)); } }
              const int n = 32 * ni + r;
#pragma unroll
              for (int rg = 0; rg < 16; ++rg) { const int m = 32 * mi + crow(rg, h); float v = acc[rg];
                  if (which == 0) v += bf2f(*(const LAS bf16*)(SL(S_RT) + m * RS + n * 2));
                  if (which == 2 && m == n) v += PLv[n];
                  dst[m * 64 + n] = v; } } }
        LBAR();
    }
#undef R1_FETCH
#undef SL
}

__device__ __forceinline__ void phase_rwkv_r2(const Params& p, const Frame& F) {
    const float* CH = WSP(float, WS_CH); float* RO = WSP(float, WS_RO);
    LAS float* stb = (LAS float*)(F.lds);
    constexpr int STB = 4 * 1280;
    const int lane = F.lane, wave = F.wave, q = lane >> 4, li = lane & 15, w4 = wave & 3;
    const int nr2 = F.G >= 4 ? F.G / 4 : 1;
    if (F.vcu >= nr2) return;
    for (int bh = F.vcu; bh < 64; bh += nr2) {
        const int b = bh >> 3, hh = bh & 7;
        __syncthreads();
        for (int i = F.tid; i < 2 * STB; i += NTHREADS) stb[i] = 0.f;
        __syncthreads();
        const int mA = (wave < 4) ? 2 : 0, mC = (wave < 4) ? 3 : 1;
        const float* basec = CH + (size_t)bh * 64 * 4 * 4096;
        f32x4 fa[2][4], fc[2][4];
#define R2_FETCH(cc, st) do { const float* pa = basec + ((size_t)(cc) * 4 + mA) * 4096 + (16 * w4 + li) * 64 + 16 * q; fa[st][0] = *(const f32x4*)(pa); fa[st][1] = *(const f32x4*)(pa + 4); fa[st][2] = *(const f32x4*)(pa + 8); fa[st][3] = *(const f32x4*)(pa + 12); \
            const float* pc = basec + ((size_t)(cc) * 4 + mC) * 4096 + (16 * w4 + 4 * q) * 64 + li; \
            _Pragma("unroll") for (int ct = 0; ct < 4; ++ct) fc[st][ct] = (f32x4){pc[16 * ct], pc[64 + 16 * ct], pc[128 + 16 * ct], pc[192 + 16 * ct]}; } while (0)
        R2_FETCH(0, 0); R2_FETCH(1, 1);
#pragma unroll 1
        for (int c0 = 0; c0 < 64; c0 += 2) {
#pragma unroll
            for (int st = 0; st < 2; ++st) { const int c = c0 + st;
                const f32x4 A0 = fa[st][0], A1 = fa[st][1], A2 = fa[st][2], A3 = fa[st][3];
                f32x4 acc[4];
#pragma unroll
                for (int ct = 0; ct < 4; ++ct) acc[ct] = fc[st][ct];
                if (c + 2 < 64) R2_FETCH(c + 2, st);
#pragma unroll
                for (int ct = 0; ct < 4; ++ct) { const LAS float* sb = stb + (c & 1) * STB + ct * 1280 + lane * 20;
                    const f32x4 b0 = *(const LAS f32x4*)(sb), b1 = *(const LAS f32x4*)(sb + 4), b2 = *(const LAS f32x4*)(sb + 8), b3 = *(const LAS f32x4*)(sb + 12);
#pragma unroll
                    for (int k = 0; k < 4; ++k) acc[ct] = __builtin_amdgcn_mfma_f32_16x16x4f32(A0[k], b0[k], acc[ct], 0, 0, 0);
#pragma unroll
                    for (int k = 0; k < 4; ++k) acc[ct] = __builtin_amdgcn_mfma_f32_16x16x4f32(A1[k], b1[k], acc[ct], 0, 0, 0);
#pragma unroll
                    for (int k = 0; k < 4; ++k) acc[ct] = __builtin_amdgcn_mfma_f32_16x16x4f32(A2[k], b2[k], acc[ct], 0, 0, 0);
#pragma unroll
                    for (int k = 0; k < 4; ++k) acc[ct] = __builtin_amdgcn_mfma_f32_16x16x4f32(A3[k], b3[k], acc[ct], 0, 0, 0); }
                if (wave < 4) {
#pragma unroll
                    for (int ct = 0; ct < 4; ++ct) *(LAS f32x4*)(stb + ((c + 1) & 1) * STB + ct * 1280 + (w4 * 16 + li) * 20 + 4 * q) = acc[ct]; }
                else { float* ro = RO + ((size_t)b * SEQ + (size_t)c * 64 + 16 * w4 + 4 * q) * C5 + hh * 64 + li;
#pragma unroll
                    for (int ct = 0; ct < 4; ++ct) { ro[16 * ct] = acc[ct][0]; ro[C5 + 16 * ct] = acc[ct][1]; ro[2 * C5 + 16 * ct] = acc[ct][2]; ro[3 * C5 + 16 * ct] = acc[ct][3]; } }
                LBAR();
            }
        }
#undef R2_FETCH
    }
    __syncthreads();
}
#undef LBAR

__device__ __forceinline__ void phase_mix(const Params& p, const Frame& F, int l) {
    const int gw = F.vcu * NWAVES + F.wave, NGW = F.G * NWAVES; const int lane = F.lane;
    const bf16* O = WSP(bf16, WS_O); const float* RO = WSP(float, WS_RO); const bf16* RK = WSP(bf16, WS_RK); const bf16* AGp = WSP(bf16, WS_AG);
    const bf16* Vv = l == 0 ? WSP(bf16, WS_VS0) : WSP(bf16, WS_VR); bf16* MIX = WSP(bf16, WS_MIX);
    const float* og = INP(I_MOUTG) + (size_t)l * C5; const float* gng = INP(I_GNG) + (size_t)l * C5; const float* gnb = INP(I_GNB) + (size_t)l * C5;
    const float* kaw = INP(I_KA) + (size_t)l * C5; const float* rkw = INP(I_RK) + (size_t)l * C5;
#pragma unroll 2
    for (int t = gw; t < T; t += NGW) {
        const int c = 8 * lane;
        { const u32x4 ow = *(const u32x4*)(O + (size_t)t * C5 + c); float o[8]; float ss = 0.f;
#pragma unroll
          for (int j = 0; j < 4; ++j) { o[2 * j] = bflo(ow[j]); o[2 * j + 1] = bfhi(ow[j]); ss += o[2 * j] * o[2 * j] + o[2 * j + 1] * o[2 * j + 1]; }
          const float rs = 1.f / sqrtf(wave_sum(ss) * (1.f / C5) + RMS_EPS);
          const f32x4 g0 = *(const f32x4*)(og + c), g1 = *(const f32x4*)(og + c + 4);
          u32x4 w; w.x = pk2(o[0] * rs * g0.x, o[1] * rs * g0.y); w.y = pk2(o[2] * rs * g0.z, o[3] * rs * g0.w); w.z = pk2(o[4] * rs * g1.x, o[5] * rs * g1.y); w.w = pk2(o[6] * rs * g1.z, o[7] * rs * g1.w);
          *(u32x4*)(MIX + (size_t)t * D + c) = w; }
        { const f32x4 r0 = *(const f32x4*)(RO + (size_t)t * C5 + c), r1 = *(const f32x4*)(RO + (size_t)t * C5 + c + 4);
          float o[8]; float s = 0.f;
#pragma unroll
          for (int j = 0; j < 8; ++j) { o[j] = j < 4 ? r0[j & 3] : r1[j & 3]; s += o[j]; }
          s += __shfl_xor(s, 1); s += __shfl_xor(s, 2); s += __shfl_xor(s, 4); const float mean = s * (1.f / 64.f); float q = 0.f;
#pragma unroll
          for (int j = 0; j < 8; ++j) { o[j] -= mean; q += o[j] * o[j]; }
          q += __shfl_xor(q, 1); q += __shfl_xor(q, 2); q += __shfl_xor(q, 4); const float rstd = 1.f / sqrtf(q * (1.f / 64.f) + GN_EPS);
          const u32x4 rw = *(const u32x4*)(RK + (size_t)t * 1024 + c), kw = *(const u32x4*)(RK + (size_t)t * 1024 + 512 + c), vw = *(const u32x4*)(Vv + (size_t)t * C5 + c);
          const u32x4 aw = *(const u32x4*)(AGp + (size_t)t * 1024 + c), gw = *(const u32x4*)(AGp + (size_t)t * 1024 + 512 + c);
          const f32x4 a0 = (f32x4){bflo(aw.x), bfhi(aw.x), bflo(aw.y), bfhi(aw.y)}, a1 = (f32x4){bflo(aw.z), bfhi(aw.z), bflo(aw.w), bfhi(aw.w)};
          const f32x4 g0 = (f32x4){bflo(gw.x), bfhi(gw.x), bflo(gw.y), bfhi(gw.y)}, g1 = (f32x4){bflo(gw.z), bfhi(gw.z), bflo(gw.w), bfhi(gw.w)};
          const f32x4 ka0 = *(const f32x4*)(kaw + c), ka1 = *(const f32x4*)(kaw + c + 4), rk0 = *(const f32x4*)(rkw + c), rk1 = *(const f32x4*)(rkw + c + 4);
          const f32x4 gg0 = *(const f32x4*)(gng + c), gg1 = *(const f32x4*)(gng + c + 4), gb0 = *(const f32x4*)(gnb + c), gb1 = *(const f32x4*)(gnb + c + 4);
          float r[8], k[8], v[8]; float bon = 0.f;
#pragma unroll
          for (int j = 0; j < 4; ++j) { r[2 * j] = bflo(rw[j]); r[2 * j + 1] = bfhi(rw[j]); k[2 * j] = bflo(kw[j]); k[2 * j + 1] = bfhi(kw[j]); v[2 * j] = bflo(vw[j]); v[2 * j + 1] = bfhi(vw[j]); }
#pragma unroll
          for (int j = 0; j < 8; ++j) { const float a = j < 4 ? a0[j & 3] : a1[j & 3]; const float kp = k[j] * (1.0f + (a - 1.0f) * (j < 4 ? ka0[j & 3] : ka1[j & 3])); bon += r[j] * kp * (j < 4 ? rk0[j & 3] : rk1[j & 3]); }
          bon += __shfl_xor(bon, 1); bon += __shfl_xor(bon, 2); bon += __shfl_xor(bon, 4);
          float y[8];
#pragma unroll
          for (int j = 0; j < 8; ++j) { const float gn = o[j] * rstd * (j < 4 ? gg0[j & 3] : gg1[j & 3]) + (j < 4 ? gb0[j & 3] : gb1[j & 3]); y[j] = (gn + bon * v[j]) * (j < 4 ? g0[j & 3] : g1[j & 3]); }
          u32x4 w; w.x = pk2(y[0], y[1]); w.y = pk2(y[2], y[3]); w.z = pk2(y[4], y[5]); w.w = pk2(y[6], y[7]);
          *(u32x4*)(MIX + (size_t)t * D + C5 + c) = w; }
    }
}

#define DPPI(x, ctrl) __builtin_amdgcn_update_dpp(0, (x), (ctrl), 0xF, 0xF, true)
__device__ __forceinline__ float row16_max(float x) {
    x = fmaxf(x, __builtin_bit_cast(float, DPPI(__builtin_bit_cast(int, x), 0xB1))); x = fmaxf(x, __builtin_bit_cast(float, DPPI(__builtin_bit_cast(int, x), 0x4E)));
    x = fmaxf(x, __builtin_bit_cast(float, DPPI(__builtin_bit_cast(int, x), 0x141))); x = fmaxf(x, __builtin_bit_cast(float, DPPI(__builtin_bit_cast(int, x), 0x140))); return x; }
__device__ __forceinline__ int row16_min(int x) {
    x = min(x, DPPI(x, 0xB1)); x = min(x, DPPI(x, 0x4E)); x = min(x, DPPI(x, 0x141)); x = min(x, DPPI(x, 0x140)); return x; }
__device__ __forceinline__ void phase_ln1_route(const Params& p, const Frame& F, int l) {
    LAS unsigned char* wl = F.lds;
    LAS int* hist = (LAS int*)(F.lds + LDSX_OFF + 4096);
    LAS int* basep = hist + 32;
    LAS int* rinfo = hist + 64;
    LAS float* rgate = (LAS float*)(rinfo + 512);
    const float* mod = WSP(float, WS_MOD) + (size_t)l * NBATCH * 6144;
    const float* g1 = INP(I_LN1G) + (size_t)l * D; const float* b1 = INP(I_LN1B) + (size_t)l * D;
    const float* rb = INP(I_RB) + (size_t)l * NE;
    unsigned* cnt = (unsigned*)(F.ws + WS_CTL) + CW_CNT + l * 64;
    int* LIST = WSP(int, WS_LIST); float* GATEL = WSP(float, WS_GATEL); int* TOKSLOT = WSP(int, WS_TOKSLOT);
    bf16* X = WSP(bf16, WS_X); unsigned char* H8 = WSP(unsigned char, WS_H8);
    const int lane = F.lane, li = lane & 15, g = lane >> 4;
    __syncthreads();
    for (int i = F.tid; i < 2 * 4096; i += NTHREADS) { const int part = i >> 12, rem = i & 4095, e = rem >> 7, ch = rem & 127;
        const u32x4 v = *(const u32x4*)(WSP(bf16, WS_RWT) + ((size_t)part * DEPTH + l) * NE * D + (size_t)e * D + ch * 8);
        *(LAS u32x4*)(wl + part * 65536 + e * 2048 + ((ch ^ (e & 15)) << 4)) = v; }
    __syncthreads();
    for (int chunk = F.vcu; chunk < T / 128; chunk += F.G) {
        __syncthreads();
        if (F.tid < 32) hist[F.tid] = 0;
        __syncthreads();
        const int row0 = chunk * 128 + F.wave * 16; const int b = row0 / SEQ;
        float mymean = 0.f, myrstd = 0.f;
#pragma unroll 1
        for (int rr = 0; rr < 16; ++rr) {
            const GAS u32x2* xr = (const GAS u32x2*)(X + (size_t)(row0 + rr) * D) + lane;
            f32x4 v[4]; float s = 0.f;
#pragma unroll
            for (int j = 0; j < 4; ++j) { const u32x2 w = xr[64 * j]; v[j] = (f32x4){bflo(w.x), bfhi(w.x), bflo(w.y), bfhi(w.y)}; s += (v[j].x + v[j].y) + (v[j].z + v[j].w); }
            const float mean = wave_sum(s) * (1.f / D); float s2 = 0.f;
#pragma unroll
            for (int j = 0; j < 4; ++j) { v[j] = v[j] - mean; s2 += (v[j].x * v[j].x + v[j].y * v[j].y) + (v[j].z * v[j].z + v[j].w * v[j].w); }
            const float rstd = __builtin_amdgcn_rsqf(wave_sum(s2) * (1.f / D) + LN_EPS);
            if (li == rr) { mymean = mean; myrstd = rstd; }
        }
        f32x4 acc0 = (f32x4){0.f, 0.f, 0.f, 0.f}, acc1 = acc0;
        bf16* xrow = X + (size_t)(row0 + li) * D + 8 * g; unsigned char* hrow = H8 + (size_t)(row0 + li) * D + 8 * g;
        const float* shp = mod + (size_t)b * 6144 + 3072 + 8 * g; const float* scp = mod + (size_t)b * 6144 + 4096 + 8 * g;
        const LAS unsigned char* w0 = wl + li * 2048; const LAS unsigned char* w1 = wl + (16 + li) * 2048;
#pragma unroll 2
        for (int s = 0; s < 32; ++s) {
            const int k = 32 * s;
            const u32x4 yw = *(const u32x4*)(xrow + k); const f32x4 y0 = (f32x4){bflo(yw.x), bfhi(yw.x), bflo(yw.y), bfhi(yw.y)}, y1 = (f32x4){bflo(yw.z), bfhi(yw.z), bflo(yw.w), bfhi(yw.w)};
            const f32x4 ga0 = *(const f32x4*)(g1 + k + 8 * g), ga1 = *(const f32x4*)(g1 + k + 8 * g + 4), be0 = *(const f32x4*)(b1 + k + 8 * g), be1 = *(const f32x4*)(b1 + k + 8 * g + 4);
            const f32x4 sc0 = *(const f32x4*)(scp + k), sc1 = *(const f32x4*)(scp + k + 4), sh0 = *(const f32x4*)(shp + k), sh1 = *(const f32x4*)(shp + k + 4);
            const f32x4 x0 = (y0 - mymean) * myrstd * ga0 + be0, x1 = (y1 - mymean) * myrstd * ga1 + be1;
            { u32x4 xw; xw.x = cvtpk_c(x0.x, x0.y); xw.y = cvtpk_c(x0.z, x0.w); xw.z = cvtpk_c(x1.x, x1.y); xw.w = cvtpk_c(x1.z, x1.w); *(u32x4*)(xrow + k) = xw; }
            const f32x4 h0 = x0 * (sc0 + 1.0f) + sh0, h1 = x1 * (sc1 + 1.0f) + sh1;
            u32x4 hi; hi.x = cvtpk_c(h0.x, h0.y); hi.y = cvtpk_c(h0.z, h0.w); hi.z = cvtpk_c(h1.x, h1.y); hi.w = cvtpk_c(h1.z, h1.w);
            { u32x2 h8; h8.x = q8x4(h0.x * QS_H, h0.y * QS_H, h0.z * QS_H, h0.w * QS_H); h8.y = q8x4(h1.x * QS_H, h1.y * QS_H, h1.z * QS_H, h1.w * QS_H); *(u32x2*)(hrow + k) = h8; }
            u32x4 lo; lo.x = cvtpk_c(h0.x - bflo(hi.x), h0.y - bfhi(hi.x)); lo.y = cvtpk_c(h0.z - bflo(hi.y), h0.w - bfhi(hi.y)); lo.z = cvtpk_c(h1.x - bflo(hi.z), h1.y - bfhi(hi.z)); lo.w = cvtpk_c(h1.z - bflo(hi.w), h1.w - bfhi(hi.w));
            const int cho = ((4 * s + g) ^ li) << 4;
            const bf16x8 bh0 = *(const LAS bf16x8*)(w0 + cho), bh1 = *(const LAS bf16x8*)(w1 + cho), bl0 = *(const LAS bf16x8*)(w0 + 65536 + cho), bl1 = *(const LAS bf16x8*)(w1 + 65536 + cho);
            const bf16x8 ahi = __builtin_bit_cast(bf16x8, hi), alo = __builtin_bit_cast(bf16x8, lo);
            acc0 = __builtin_amdgcn_mfma_f32_16x16x32_bf16(ahi, bh0, acc0, 0, 0, 0); acc1 = __builtin_amdgcn_mfma_f32_16x16x32_bf16(ahi, bh1, acc1, 0, 0, 0);
            acc0 = __builtin_amdgcn_mfma_f32_16x16x32_bf16(alo, bh0, acc0, 0, 0, 0); acc1 = __builtin_amdgcn_mfma_f32_16x16x32_bf16(alo, bh1, acc1, 0, 0, 0);
            acc0 = __builtin_amdgcn_mfma_f32_16x16x32_bf16(ahi, bl0, acc0, 0, 0, 0); acc1 = __builtin_amdgcn_mfma_f32_16x16x32_bf16(ahi, bl1, acc1, 0, 0, 0);
        }
        const float rb0 = rb[li], rb1 = rb[16 + li];
#pragma unroll
        for (int reg = 0; reg < 4; ++reg) {
            float v0 = acc0[reg] + rb0, v1 = acc1[reg] + rb1;
            float tv0 = 0.f, tv1 = 0.f, tv2 = 0.f, tv3 = 0.f; int te0 = 0, te1 = 0, te2 = 0, te3 = 0;
#pragma unroll
            for (int k = 0; k < 4; ++k) { const float mx = row16_max(fmaxf(v0, v1));
                const int id = (v0 == mx) ? li : ((v1 == mx) ? 16 + li : 99); const int ek = row16_min(id);
                if (k == 0) { tv0 = mx; te0 = ek; } else if (k == 1) { tv1 = mx; te1 = ek; } else if (k == 2) { tv2 = mx; te2 = ek; } else { tv3 = mx; te3 = ek; }
                if (ek == li) v0 = -INFINITY; if (ek == 16 + li) v1 = -INFINITY; }
            const float e1 = __expf(tv1 - tv0), e2 = __expf(tv2 - tv0), e3 = __expf(tv3 - tv0); const float inv = __builtin_amdgcn_rcpf(1.0f + e1 + e2 + e3);
            if (li < 4) { const int lr = F.wave * 16 + 4 * g + reg; const int ek = li == 0 ? te0 : li == 1 ? te1 : li == 2 ? te2 : te3; const float gk = (li == 0 ? 1.0f : li == 1 ? e1 : li == 2 ? e2 : e3) * inv;
                const int lp = __hip_atomic_fetch_add(&hist[ek], 1, __ATOMIC_RELAXED, __HIP_MEMORY_SCOPE_WORKGROUP); rinfo[lr * 4 + li] = (ek << 16) | lp; rgate[lr * 4 + li] = gk; }
        }
        __syncthreads();
        if (F.tid < 32) basep[F.tid] = (int)__hip_atomic_fetch_add(cnt + F.tid, (unsigned)hist[F.tid], RLX_AGENT);
        __syncthreads();
        { const int lr = F.tid >> 2, k = F.tid & 3; const int m = chunk * 128 + lr; const int info = rinfo[F.tid]; const int ek = info >> 16; const int pos = basep[ek] + (info & 0xffff);
          LIST[ek * CAP + pos] = m; GATEL[ek * CAP + pos] = rgate[F.tid]; TOKSLOT[m * 4 + k] = (ek << 16) | pos; }
    }
    __syncthreads();
}

__device__ __forceinline__ void moe_tables(const Frame& F, int l) {
    LAS int* tb = (LAS int*)(F.lds + TB_OFF); LAS int* cn = tb + 40;
    const unsigned* cnt = (const unsigned*)(F.ws + WS_CTL) + CW_CNT + l * 64;
    __syncthreads();
    if (F.tid == 0) { int acc = 0;
        for (int e = 0; e < NE; ++e) { const int c = (int)__hip_atomic_load(cnt + e, RLX_AGENT); cn[e] = c; tb[e] = acc; acc += (c + 255) >> 8; }
        tb[NE] = acc; }
    __syncthreads();
}

__device__ __forceinline__ void phase_combine(const Params& p, const Frame& F, int l) {
    const LAS int* tb = (const LAS int*)(F.lds + TB_OFF);
    const int gw = F.vcu * NWAVES + F.wave, NGW = F.G * NWAVES; const int lane = F.lane;
    const float* mod = WSP(float, WS_MOD) + (size_t)l * NBATCH * 6144; const float* modn = WSP(float, WS_MOD) + (size_t)(l + 1) * NBATCH * 6144;
    const float* g2 = INP(I_LN2G) + (size_t)l * D; const float* b2 = INP(I_LN2B) + (size_t)l * D;
    const bf16* Y = WSP(bf16, WS_Y); const int* TOKSLOT = WSP(int, WS_TOKSLOT);
    const bool lastl = (l == DEPTH - 1);
#pragma unroll 2
    for (int m = gw; m < T; m += NGW) {
        const int b = m / SEQ;
        int srow[4];
#pragma unroll
        for (int k = 0; k < 4; ++k) { const int ts = TOKSLOT[m * 4 + k]; const int e = ts >> 16, pos = ts & 0xffff; srow[k] = tb[e] * 256 + pos; }
        GAS u32x2* xr = (GAS u32x2*)(WSP(bf16, WS_X) + (size_t)m * D) + lane;
        f32x4 v[4]; float s = 0.f;
#pragma unroll
        for (int j = 0; j < 4; ++j) { const int c = 4 * lane + 256 * j; f32x4 y = (f32x4){0.f, 0.f, 0.f, 0.f};
#pragma unroll
            for (int k = 0; k < 4; ++k) { const u32x2 yw = *(const u32x2*)(Y + (size_t)srow[k] * D + c); y.x += bflo(yw.x); y.y += bfhi(yw.x); y.z += bflo(yw.y); y.w += bfhi(yw.y); }
            const f32x4 gt = *(const f32x4*)(mod + (size_t)b * 6144 + 5120 + c) + 1.0f;
            const u32x2 xw = xr[64 * j]; v[j] = (f32x4){bflo(xw.x), bfhi(xw.x), bflo(xw.y), bfhi(xw.y)} * DN_ALPHA + gt * y; s += (v[j].x + v[j].y) + (v[j].z + v[j].w); }
        const float mean = wave_sum(s) * (1.f / D); float s2 = 0.f;
#pragma unroll
        for (int j = 0; j < 4; ++j) { v[j] = v[j] - mean; s2 += (v[j].x * v[j].x + v[j].y * v[j].y) + (v[j].z * v[j].z + v[j].w * v[j].w); }
        const float rstd = 1.f / sqrtf(wave_sum(s2) * (1.f / D) + LN_EPS);
        GAS f32x4* oo = (GAS f32x4*)(p.out + (size_t)m * D) + lane;
        GAS u32x2* ho = (GAS u32x2*)(WSP(bf16, WS_H) + (size_t)m * D) + lane;
#pragma unroll
        for (int j = 0; j < 4; ++j) { const int c = 4 * lane + 256 * j;
            const f32x4 g = *(const f32x4*)(g2 + c), be = *(const f32x4*)(b2 + c);
            const f32x4 x2 = v[j] * rstd * g + be;
            if (lastl) oo[64 * j] = x2;
            else { { u32x2 xw; xw.x = pk2(x2.x, x2.y); xw.y = pk2(x2.z, x2.w); xr[64 * j] = xw; }
                const f32x4 sh = *(const f32x4*)(modn + (size_t)b * 6144 + c), sc = *(const f32x4*)(modn + (size_t)b * 6144 + 1024 + c);
                const f32x4 h = x2 * (sc + 1.0f) + sh; u32x2 w; w.x = pk2(h.x, h.y); w.y = pk2(h.z, h.w); ho[64 * j] = w; } }
    }
}

constexpr int PH_PER_LAYER = 11, N_PHASES = 2 + DEPTH * PH_PER_LAYER;
__global__ void __launch_bounds__(NTHREADS, 2) fwd(Params p) {
    extern __shared__ __attribute__((aligned(16))) unsigned char lds[];
    Frame F;
    F.lds = (LAS unsigned char*)lds; F.tid = threadIdx.x; F.lane = F.tid & 63; F.wave = __builtin_amdgcn_readfirstlane(F.tid >> 6);
    F.G = gridDim.x; { const int bx = blockIdx.x; F.vcu = (F.G % 8 == 0) ? (bx % 8) * (F.G / 8) + bx / 8 : bx; }
    F.ws = p.ws;
    volatile LAS unsigned* MISC = (volatile LAS unsigned*)(F.lds + MISC_OFF);
    if (F.tid < 64) MISC[F.tid] = 0u;
    __syncthreads();
    unsigned* ctl = (unsigned*)(p.ws + WS_CTL);
#if MK_ONE_LAUNCH
    XcdBarrier bar = xcd_barrier_post(ctl + CW_BAR, MISC + 8);
#define GRID_BAR() xcd_barrier(bar)
#else
#define GRID_BAR() do {} while (0)
#endif
    const int lo = p.ph_lo, hi = p.ph_hi;
#ifndef PH_MASK
#define PH_MASK 0xFFFFFFFFu
#endif
#define IN(k) (lo <= (k) && (k) < hi)
#define EN(j) ((PH_MASK >> (j)) & 1u)
#define SEAM(k) do { if (IN(k) && IN((k) + 1)) GRID_BAR(); } while (0)
    LAS unsigned char* ring = F.lds;

    if (EN(0) && IN(0)) { for (int rep = 0; rep < REP_PRO; ++rep) phase_prologue(p, F); } SEAM(0);
    if (EN(1) && IN(1)) { phase_ln0(p, F); } SEAM(1);
#define LAYER_BODY \
        constexpr int pb = 2 + l * PH_PER_LAYER; \
        const float* mod = WSP(float, WS_MOD) + (size_t)l * NBATCH * 6144; \
        if (EN(2) && IN(pb + 0)) { \
            pg8::Gemm g{WSP(bf16, WS_H), WSP(bf16, WS_WINT) + (size_t)l * N_INP * D, T, N_INP, D}; pg8::DenseOrder S; S.init(T, N_INP, F.G, (int)blockIdx.x); \
            pg8::EpiBf16Plain E{WSP(bf16, WS_P), N_INP}; \
            for (int rep = 0; rep < REP_WIN; ++rep) pg8::gemm_phase<pg8::EpiBf16Plain, pg8::DenseOrder, true>(ring, g, S, E); \
        } SEAM(pb + 0); \
        if (EN(3) && IN(pb + 1)) { phase_pgemm(p, F, l); } SEAM(pb + 1); \
        if (EN(5) && IN(pb + 3)) { phase_rwkv_r1(p, F, l); } SEAM(pb + 3); \
        if (EN(6) && IN(pb + 4)) { phase_rwkv_r2(p, F); if (l == 0) { const int c0 = F.G / 4, nc = (F.G * 3) / 8; if (F.vcu >= c0 && F.vcu < c0 + nc) phase_convert_experts(p, F, c0, nc); } phase_attn(p, F, (char*)lds, l); } SEAM(pb + 4); \
        if (EN(7) && IN(pb + 5)) { for (int rep = 0; rep < REP_MIX; ++rep) phase_mix(p, F, l); } SEAM(pb + 5); \
        if (EN(8) && IN(pb + 6)) { \
            pg8::Gemm g{WSP(bf16, WS_MIX), WSP(bf16, WS_WOT) + (size_t)l * D * D, T, D, D}; pg8::DenseOrder S; S.init(T, D, F.G, (int)blockIdx.x); \
            pg8::EpiWo E{WSP(bf16, WS_X), mod + 2048}; \
            pg8::gemm_phase<pg8::EpiWo, pg8::DenseOrder, true>(ring, g, S, E); \
        } SEAM(pb + 6); \
        if (EN(9) && IN(pb + 7)) { phase_ln1_route(p, F, l); } SEAM(pb + 7); \
        if (EN(10) && IN(pb + 8)) { \
            moe_tables(F, l); \
            const LAS int* tb = (const LAS int*)(F.lds + TB_OFF); \
            pg8::Gemm g{WSP(bf16, WS_H8), (const bf16*)(WSP(unsigned char, WS_W1T) + (size_t)l * NE * 2048 * D), T, 2048, D / 2};        \
            pg8::MoeOrder<true> S{tb, tb + 40, WSP(int, WS_LIST), 8, F.G, F.vcu, (LAS unsigned*)(F.lds + GT_OFF)}; \
            pg8::EpiSwiglu E{WSP(unsigned char, WS_H1), WSP(float, WS_B1P) + (size_t)l * NE * 2048}; \
            for (int rep = 0; rep < REP_MOE1; ++rep) pg8::gemm_phase<pg8::EpiSwiglu, pg8::MoeOrder<true>, true, true>(ring, g, S, E); \
        } SEAM(pb + 8); \
        if (EN(11) && IN(pb + 9)) { \
            moe_tables(F, l); \
            const LAS int* tb = (const LAS int*)(F.lds + TB_OFF); \
            pg8::Gemm g{WSP(bf16, WS_H1), (const bf16*)(WSP(unsigned char, WS_W2T) + (size_t)l * NE * D * FF), MAXSLOT, D, FF / 2}; \
            pg8::MoeOrder<false> S{tb, tb + 40, nullptr, 4, F.G, F.vcu, nullptr}; \
            pg8::EpiMoeOut E{WSP(bf16, WS_Y), INP(I_EB2) + (size_t)l * NE * D, WSP(float, WS_GATEL), tb}; \
            for (int rep = 0; rep < REP_MOE2; ++rep) pg8::gemm_phase<pg8::EpiMoeOut, pg8::MoeOrder<false>, true, true>(ring, g, S, E); \
        } SEAM(pb + 9); \
        if (EN(12) && IN(pb + 10)) { moe_tables(F, l); phase_combine(p, F, l); } SEAM(pb + 10);
    { constexpr int l = 0; LAYER_BODY }
    { constexpr int l = 1; LAYER_BODY }
#undef LAYER_BODY
#undef IN
#undef SEAM
}

extern "C" void kernel_launch(void* const* d_in, const int* in_sizes, int n_in, void* d_out, int out_size, void* d_ws, size_t ws_size, hipStream_t stream) {
    static int grid = 0;
    if (grid == 0) {
        if (n_in != N_INPUTS || out_size != T * D || ws_size < WS_END) { fprintf(stderr, "kernel_launch: unexpected problem: n_in %d out %d ws %zu\n", n_in, out_size, ws_size); grid = -1; return; }
        int dev = 0, cus = 0, per_cu = 0;
        if (hipGetDevice(&dev) != hipSuccess || hipDeviceGetAttribute(&cus, hipDeviceAttributeMultiprocessorCount, dev) != hipSuccess) { grid = -1; return; }
        if (hipFuncSetAttribute((const void*)fwd, hipFuncAttributeMaxDynamicSharedMemorySize, LDS_BYTES) != hipSuccess) { fprintf(stderr, "kernel_launch: hipFuncSetAttribute failed\n"); grid = -1; return; }
        if (hipOccupancyMaxActiveBlocksPerMultiprocessor(&per_cu, (const void*)fwd, NTHREADS, LDS_BYTES) != hipSuccess || per_cu < 1) fprintf(stderr, "kernel_launch: occupancy query reports %d\n", per_cu);
        (void)hipGetLastError();
        grid = cus;
    }
    if (grid < 0) return;
    if (hipMemsetAsync((char*)d_ws + WS_CTL, 0, CTL_ZERO_BYTES, stream) != hipSuccess) return;
    Params p{};
    for (int i = 0; i < N_INPUTS; ++i) p.in[i] = d_in[i];
    p.out = (float*)d_out; p.ws = (unsigned char*)d_ws;
#if MK_ONE_LAUNCH
    p.ph_lo = 0; p.ph_hi = N_PHASES;
    hipLaunchKernelGGL(fwd, dim3(grid), dim3(NTHREADS), LDS_BYTES, stream, p);
#else
    for (int ph = 0; ph < N_PHASES; ++ph) { p.ph_lo = ph; p.ph_hi = ph + 1; hipLaunchKernelGGL(fwd, dim3(grid), dim3(NTHREADS), LDS_BYTES, stream, p); }
#endif
}
```

```cpp
#include <hip/hip_runtime.h>
#include <cstdio>
#include <cstdint>

#define REP_PRO 1
#define REP_ATTN 1
#define REP_RWKV 1
#define REP_MOE1 1
#define REP_MOE2 1
#define REP_WIN 1
#define REP_PREP 1
#define REP_MIX 1
#ifndef MK_ONE_LAUNCH
#define MK_ONE_LAUNCH 1
#endif

#define GAS __attribute__((address_space(1)))
#define LAS __attribute__((address_space(3)))
typedef unsigned short bf16;
typedef short bf16x8 __attribute__((ext_vector_type(8)));
typedef short s16x4 __attribute__((ext_vector_type(4)));
typedef float f32x2 __attribute__((ext_vector_type(2)));
typedef float f32x4 __attribute__((ext_vector_type(4)));
typedef float f32x16 __attribute__((ext_vector_type(16)));
typedef unsigned u32x2 __attribute__((ext_vector_type(2)));
typedef unsigned u32x4 __attribute__((ext_vector_type(4)));
typedef int i32x4 __attribute__((ext_vector_type(4)));

constexpr int D = 1024, NBATCH = 8, SEQ = 4096, T = NBATCH * SEQ, DEPTH = 2;
constexpr int MLA_IN = 416, RWKV_IN = 1792, N_IN = 2208, N_INP = 2304;
constexpr int QLR = 256, KVLR = 128, ROPE = 32, NOPE = 64, QKD = 96, VD = 64, NH = 8;
constexpr int C5 = 512;
constexpr int NE = 32, TOPK = 4, FF = 1024, CAP = 32768;
constexpr int N_UP = 1792, K_UP = 384, N_SM = 1536, K_SM = 256;
constexpr int MAXSLOT = 139264;
constexpr float DN_ALPHA = 1.4142135623730951f;
constexpr float C2Q = 0.14724444602590306f;
constexpr float LN_EPS = 1e-5f, RMS_EPS = 1e-6f, GN_EPS = 64e-5f;
constexpr int NWAVES = 8, NTHREADS = 512;
constexpr float QS_H = 16.f, QS_W1 = 640.f, QS_U = 16.f, QS_W2 = 1280.f, QS_WIN = 640.f;
constexpr int PGW_Q = 0, PGW_KN = 384, PGW_V = 512, PGW_W = 640, PGW_A = 704, PGW_G = 768, PGW_VR = 896, PGW_NFRAG = 1408;

enum { I_X = 0, I_C, I_POS, I_ELNG, I_ELNB, I_ADAW, I_ADAB, I_WIN, I_QNG, I_WUQ, I_KVNG, I_WUK, I_WUV, I_MOUTG, I_MU, I_W0, I_W2, I_A0, I_A2, I_G2,
       I_KK, I_KA, I_RK, I_GNG, I_GNB, I_V0, I_V1, I_V2, I_WO, I_LN1G, I_LN1B, I_RW, I_RB, I_EW1, I_EB1, I_EW2, I_EB2, I_LN2G, I_LN2B, N_INPUTS };

constexpr size_t MiB = 1u << 20;
constexpr size_t WS_CTL = 0, CTL_ZERO_BYTES = 4 * MiB;
constexpr size_t WS_MOD = 4 * MiB, WS_B1P = 5 * MiB, WS_CS = 6 * MiB, WS_LIST = 10 * MiB, WS_GATEL = 14 * MiB, WS_TOKSLOT = 18 * MiB;
constexpr size_t WS_HS = 18 * MiB + 512 * 1024;
constexpr size_t WS_RWT = 19 * MiB;
constexpr size_t WS_WINT = 20 * MiB, WS_WUPT = 30 * MiB, WS_WSMT = 33 * MiB, WS_WV12T = 35 * MiB, WS_WOT = 36 * MiB, WS_W1T = 40 * MiB, WS_W2T = 296 * MiB;
constexpr size_t WS_X = 424 * MiB, WS_H = 552 * MiB, WS_VS0 = 616 * MiB, WS_VS1 = 648 * MiB;
constexpr size_t WS_P = 680 * MiB, WS_AN = 824 * MiB, WS_A2 = 848 * MiB, WS_RK = 864 * MiB, WS_Q = 928 * MiB, WS_KK = 976 * MiB, WS_V = 1024 * MiB, WS_O = 1056 * MiB;
constexpr size_t WS_WAG = 1088 * MiB, WS_RO = 1280 * MiB, WS_MIX = 1344 * MiB, WS_VR = 1408 * MiB;
constexpr size_t WS_LW = WS_WAG, WS_AG = WS_WAG + 64 * MiB;
constexpr size_t WS_H8 = WS_MIX;
constexpr size_t WS_H1 = 680 * MiB, WS_Y = 952 * MiB;
constexpr size_t WS_CH = 1440 * MiB;
constexpr size_t WS_PGW = 1696 * MiB;
constexpr size_t WS_END = 1700 * MiB;
constexpr int CW_TMO = 0, CW_CODE = 1, CW_BAR = 4096, CW_CNT = 8192, CW_ATTQ = 8448;

constexpr int RING_BYTES = 131072;
constexpr int LDSX_OFF = RING_BYTES;
constexpr int MISC_OFF = LDSX_OFF;
constexpr int TB_OFF = LDSX_OFF + 256;
constexpr int GT_OFF = LDSX_OFF + 1024;
constexpr int LDS_BYTES = 147456;

#define RLX_AGENT __ATOMIC_RELAXED, __HIP_MEMORY_SCOPE_AGENT
#define LDS_WAIT() asm volatile("s_waitcnt lgkmcnt(0)" ::: "memory")
#define VM_WAIT() asm volatile("s_waitcnt vmcnt(0)" ::: "memory")

__device__ __forceinline__ unsigned f2bf(float f) { unsigned u = __builtin_bit_cast(unsigned, f); return (u + 0x7fffu + ((u >> 16) & 1u)) >> 16; }
__device__ __forceinline__ unsigned pk2(float lo, float hi) { return f2bf(lo) | (f2bf(hi) << 16); }
__device__ __forceinline__ float bf2f(unsigned b) { return __builtin_bit_cast(float, b << 16); }
__device__ __forceinline__ float bflo(unsigned w) { return __builtin_bit_cast(float, w << 16); }
__device__ __forceinline__ float bfhi(unsigned w) { return __builtin_bit_cast(float, w & 0xffff0000u); }
__device__ __forceinline__ unsigned cvt_pk_bf16(float lo, float hi) { unsigned r; asm volatile("v_cvt_pk_bf16_f32 %0, %1, %2" : "=v"(r) : "v"(lo), "v"(hi)); return r; }
typedef __bf16 bf16x2_t __attribute__((ext_vector_type(2)));
__device__ __forceinline__ unsigned cvtpk_c(float lo, float hi) { f32x2 v = {lo, hi}; bf16x2_t b = __builtin_convertvector(v, bf16x2_t); return __builtin_bit_cast(unsigned, b); }
__device__ __forceinline__ unsigned q8r(float x) { return __builtin_bit_cast(unsigned, __builtin_amdgcn_fmed3f(x, -127.f, 127.f) + 12582912.f); }
__device__ __forceinline__ unsigned q8x4(float a, float b, float c, float d) { return (q8r(a) & 0xffu) | ((q8r(b) & 0xffu) << 8) | ((q8r(c) & 0xffu) << 16) | (q8r(d) << 24); }
__device__ __forceinline__ float wave_sum(float v) {
#pragma unroll
    for (int o = 1; o < 64; o <<= 1) v += __shfl_xor(v, o);
    return v;
}
__device__ __forceinline__ float sigmoidf_(float x) { return __builtin_amdgcn_rcpf(1.0f + __expf(-x)); }
__device__ __forceinline__ float tanhf_(float x) { return 1.0f - 2.0f * __builtin_amdgcn_rcpf(1.0f + __expf(2.0f * x)); }

#define XB_TMO      128
#define XB_XCNT(j)  (256  + 64 * (j))
#define XB_XSUB(j)  (1280 + 64 * (j))
#define XB_XGEN(j)  (2304 + 64 * (j))
#define XB_TOP      3328
#define XB_TOPGEN   3392
#define XCD_BAR_WORDS 3456
#define XB_SPIN_CAP (1u << 18)
__device__ __forceinline__ unsigned xb_ld(unsigned* p)              { return __hip_atomic_load(p, __ATOMIC_RELAXED, __HIP_MEMORY_SCOPE_AGENT); }
__device__ __forceinline__ unsigned xb_add(unsigned* p, unsigned v) { return __hip_atomic_fetch_add(p, v, __ATOMIC_RELAXED, __HIP_MEMORY_SCOPE_AGENT); }
__device__ __forceinline__ unsigned xb_xcc_id() { return (unsigned)__builtin_amdgcn_s_getreg((3 << 11) | 20) & 0xFu; }
#define XB_SPIN(cond, bar) do { unsigned _sp = 0; while (cond) { __builtin_amdgcn_s_sleep(1); \
    if ((++_sp & 255u) == 0u) { if (xb_ld(&(bar)[XB_TMO])) break; if (_sp > XB_SPIN_CAP) { atomicAdd(&(bar)[XB_TMO], 1u); break; } } } } while (0)
struct XcdBarrier { unsigned* bar; unsigned x; volatile LAS unsigned* st; };
__device__ __forceinline__ XcdBarrier xcd_barrier_post(unsigned* bar, volatile LAS unsigned* st) {
    XcdBarrier b; b.bar = bar; b.x = xb_xcc_id(); b.st = st;
    if (threadIdx.x == 0) (void)xb_add(&bar[XB_XCNT(b.x)], 1u);
    return b;
}
__device__ __forceinline__ void xcd_barrier_complete(unsigned* bar, unsigned x, unsigned& nloc, unsigned& nx) {
    const unsigned G = gridDim.x * gridDim.y * gridDim.z;
    unsigned sum, cnt, mine, sp = 0u;
    for (;;) {
        sum = 0u; cnt = 0u; mine = 0u;
#pragma unroll
        for (unsigned j = 0; j < 16; ++j) { const unsigned c = xb_ld(&bar[XB_XCNT(j)]); sum += c; cnt += (c > 0u) ? 1u : 0u; mine = (j == x) ? c : mine; }
        if (sum == G) break;
        __builtin_amdgcn_s_sleep(1);
        if ((++sp & 255u) == 0u) { if (xb_ld(&bar[XB_TMO])) break; if (sp > XB_SPIN_CAP) { atomicAdd(&bar[XB_TMO], 1u); break; } }
    }
    nloc = mine > 0u ? mine : 1u; nx = cnt > 0u ? cnt : 1u;
}
__device__ __forceinline__ void xcd_barrier(const XcdBarrier& b) {
    asm volatile("s_waitcnt vmcnt(0)" ::: "memory");
    __syncthreads();
    if (threadIdx.x == 0) {
        unsigned* bar = b.bar;
        __builtin_amdgcn_s_waitcnt(0);
        unsigned nloc = b.st[0], nx = b.st[1];
        if (nloc == 0u) { xcd_barrier_complete(bar, b.x, nloc, nx); b.st[0] = nloc; b.st[1] = nx; }
        const unsigned old = xb_add(&bar[XB_XSUB(b.x)], 1u);
        const unsigned gen = old / nloc;
        if (old + 1u == (gen + 1u) * nloc) {
            __builtin_amdgcn_fence(__ATOMIC_RELEASE, "agent");
            asm volatile("s_waitcnt vmcnt(0)" ::: "memory");
            const unsigned og = xb_add(&bar[XB_TOP], 1u);
            const unsigned tg = og / nx;
            if (og + 1u == (tg + 1u) * nx) xb_add(&bar[XB_TOPGEN], 1u);
            else XB_SPIN(xb_ld(&bar[XB_TOPGEN]) == tg, bar);
            __builtin_amdgcn_fence(__ATOMIC_ACQUIRE, "agent");
            xb_add(&bar[XB_XGEN(b.x)], 1u);
            asm volatile("s_waitcnt vmcnt(0)" ::: "memory");
        } else {
            XB_SPIN(xb_ld(&bar[XB_XGEN(b.x)]) == gen, bar);
            __builtin_amdgcn_fence(__ATOMIC_ACQUIRE, "agent");
            asm volatile("s_waitcnt vmcnt(0)" ::: "memory");
        }
    }
    __syncthreads();
}

namespace pg8 {
constexpr int BM = 256, BK = 64, HALF = 128, HTB = HALF * BK * 2, STAGE_BYTES = 8 * HTB, NXCD = 8, WGM = 8;
__device__ __forceinline__ int lds_byte(int r, int c) { const int st = (r >> 4) * 2 + (c >> 5), rr = r & 15, cc = c & 31, ob = rr * 64 + cc * 2; return st * 1024 + (ob ^ (((ob >> 9) & 1) << 5)); }
__device__ __forceinline__ void stage_rc(int b, int& R, int& C) { const int st = b / 1024, sb = b % 1024, swz = sb ^ (((sb >> 9) & 1) << 5); R = (st >> 1) * 16 + swz / 64; C = (st & 1) * 32 + (swz % 64) / 2; }
__device__ __forceinline__ int perm32(int rho) { const int n = rho >> 4, i = rho & 15; return 8 * (i >> 2) + 4 * n + (i & 3); }

struct Unit { int pm, pn, e; };
struct Gemm { const bf16* A; const bf16* Bt; int M, N, K; };

struct DenseOrder {
    int nM, nN, nwg, G, c;
    __device__ __forceinline__ void init(int M, int N, int G_, int c_) { nM = M / BM; nN = N / BM; nwg = nM * nN; G = G_; c = c_; }
    __device__ __forceinline__ bool next(int i, Unit& u) const {
        const long L = (long)i * G + c; if (L >= nwg) return false;
        int wgid = (int)L; { const int q = nwg / NXCD, r = nwg % NXCD, xcd = wgid % NXCD, off = wgid / NXCD; wgid = (xcd < r ? xcd * (q + 1) : r * (q + 1) + (xcd - r) * q) + off; }
        const int nig = WGM * nN, gid = wgid / nig, fm = gid * WGM, gsz = (nM - fm) < WGM ? (nM - fm) : WGM;
        u.pm = fm + ((wgid % nig) % gsz); u.pn = (wgid % nig) / gsz; u.e = 0; return true;
    }
    static constexpr bool GATHER = false;
    __device__ __forceinline__ size_t b_off(const Unit& u, int N, int K) const { return (size_t)u.pn * BM * K * 2; }
    __device__ __forceinline__ unsigned a_row_off(const Unit& u, int row, int K) const { return 0u; }
    __device__ __forceinline__ LAS unsigned* gtab() const { return nullptr; }
};
template <bool GATHER_> struct MoeOrder {
    static constexpr bool GATHER = GATHER_;
    const LAS int* tb; const LAS int* cnt; const int* list; int nN, G, c; LAS unsigned* gt_;
    __device__ __forceinline__ LAS unsigned* gtab() const { return gt_; }
    __device__ __forceinline__ bool next(int i, Unit& u) const {
        const int L = i * G + c; const int total = tb[NE] * nN; if (L >= total) return false;
        int e = 0;
#pragma unroll 1
        for (int j = 1; j < NE; ++j) if (tb[j] * nN <= L) e = j;
        const int Lr = L - tb[e] * nN, nte = tb[e + 1] - tb[e];
        const int mblk = Lr / (4 * nN), m0 = mblk * 4, gsz = (nte - m0) < 4 ? (nte - m0) : 4, rem = Lr - mblk * 4 * nN;
        u.e = e; u.pn = rem / gsz; u.pm = tb[e] + m0 + (rem % gsz); return true;
    }
    __device__ __forceinline__ size_t b_off(const Unit& u, int N, int K) const { return ((size_t)u.e * N + (size_t)u.pn * BM) * K * 2; }
    __device__ __forceinline__ unsigned a_row_off(const Unit& u, int row, int K) const {
        const int pos = (u.pm - tb[u.e]) * BM + row; const int tok = pos < cnt[u.e] ? list[u.e * CAP + pos] : 0; return (unsigned)tok * (unsigned)(K * 2);
    }
};

template <class Epi, class Sched, bool ALIGN_EPI, bool I8 = false>
__device__ __forceinline__ void gemm_phase(LAS unsigned char* lds, const Gemm g, const Sched& S, const Epi& E) {
    const int tid = threadIdx.x, wid = __builtin_amdgcn_readfirstlane(tid >> 6), lane = tid & 63, wr = wid >> 2, wc = wid & 3, fr = lane & 15, fq = lane >> 4;
    const int K = g.K, nt = K / BK;
    int RA[2]; unsigned CA[2], voffA[2], voffB[2];
#pragma unroll
    for (int i = 0; i < 2; ++i) { int R, C; stage_rc(tid * 16 + i * 8192, R, C); const int Rb = Epi::PERM ? ((R & ~31) + perm32(R & 31)) : R;
        RA[i] = R; CA[i] = (unsigned)C * 2u; voffA[i] = (unsigned)(R * K + C) * 2u; voffB[i] = (unsigned)(Rb * K + C) * 2u; }
    const size_t kstep = (size_t)(BK * 2);
    const size_t hstep = (size_t)HALF * K * 2;
    const size_t tstep = 2 * hstep;
    const unsigned ldsw = (unsigned)wid * 1024u;
    const int aoff = lds_byte(wr * 64 + fr, fq * 8), boff = lds_byte(wc * 32 + fr, fq * 8);
    const char* Abase = (const char*)g.A;
    LAS unsigned* gtb = S.gtab();
#define PG8_SA(b, h) (((b) * 2 + (h)) * HTB)
#define PG8_SB(b, h) ((4 + (b) * 2 + (h)) * HTB)
#define PG8_STAGE(bufoff, gbase, voff) do { _Pragma("unroll") for (int _i = 0; _i < 2; ++_i) \
        __builtin_amdgcn_global_load_lds((const unsigned*)((const char*)(gbase) + (voff)[_i]), (LAS unsigned*)(lds + (bufoff) + ldsw + _i * 8192), 16, 0, 0); } while (0)
#define PG8_STAGEA(bufoff, h, kb, nx) do { \
        if constexpr (Sched::GATHER) { const LAS unsigned* tp_ = gtb + ((nx) ? tnx : tcu) + (h) * HALF; const unsigned o0_ = tp_[RA[0]] + CA[0], o1_ = tp_[RA[1]] + CA[1]; \
            __builtin_amdgcn_global_load_lds((const unsigned*)(Abase + (size_t)(kb) + o0_), (LAS unsigned*)(lds + (bufoff) + ldsw), 16, 0, 0); \
            __builtin_amdgcn_global_load_lds((const unsigned*)(Abase + (size_t)(kb) + o1_), (LAS unsigned*)(lds + (bufoff) + ldsw + 8192), 16, 0, 0); } \
        else { const char* gb_ = ((nx) ? nA : cA) + (size_t)(h) * hstep + (size_t)(kb); PG8_STAGE(bufoff, gb_, voffA); } } while (0)
#define PG8_LDA(dst, b, h) do { _Pragma("unroll") for (int m = 0; m < 4; ++m) _Pragma("unroll") for (int k = 0; k < 2; ++k) dst[m][k] = *(const LAS bf16x8*)(lds + PG8_SA(b, h) + aoff + m * 2048 + k * 1024); } while (0)
#define PG8_LDB(dst, b, h) do { _Pragma("unroll") for (int n = 0; n < 2; ++n) _Pragma("unroll") for (int k = 0; k < 2; ++k) dst[n][k] = *(const LAS bf16x8*)(lds + PG8_SB(b, h) + boff + n * 2048 + k * 1024); } while (0)
#define PG8_MMA(ai, bj, At, Bt) do { __builtin_amdgcn_s_setprio(1); _Pragma("unroll") for (int m = 0; m < 4; ++m) _Pragma("unroll") for (int n = 0; n < 2; ++n) _Pragma("unroll") for (int k = 0; k < 2; ++k) { \
        if constexpr (I8) acc[ai][bj][m][n] = __builtin_bit_cast(f32x4, __builtin_amdgcn_mfma_i32_16x16x64_i8(__builtin_bit_cast(i32x4, Bt[n][k]), __builtin_bit_cast(i32x4, At[m][k]), __builtin_bit_cast(i32x4, acc[ai][bj][m][n]), 0, 0, 0)); \
        else acc[ai][bj][m][n] = __builtin_amdgcn_mfma_f32_16x16x32_bf16(Bt[n][k], At[m][k], acc[ai][bj][m][n], 0, 0, 0); } __builtin_amdgcn_s_setprio(0); } while (0)
#define PG8_WAIT_V(n) asm volatile("s_waitcnt vmcnt(" #n ")" ::: "memory")
#define PG8_WAIT_L(n) asm volatile("s_waitcnt lgkmcnt(" #n ")" ::: "memory")
#define PG8_BAR __builtin_amdgcn_s_barrier()
#define PG8_SCHED __builtin_amdgcn_sched_barrier(0)
    Unit cur, nxt; int ui = 0;
    if (!S.next(0, cur)) return;
    f32x4 acc[2][2][4][2];
#pragma unroll
    for (int a = 0; a < 2; ++a)
#pragma unroll
        for (int b = 0; b < 2; ++b)
#pragma unroll
            for (int m = 0; m < 4; ++m)
#pragma unroll
                for (int n = 0; n < 2; ++n) acc[a][b][m][n] = (f32x4){0.f, 0.f, 0.f, 0.f};
    bf16x8 At[4][2], B0[2][2], B1[2][2];
    const char* cA = Abase + (size_t)cur.pm * tstep; const char* cB = (const char*)g.Bt + S.b_off(cur, g.N, K);
    const char* nA = cA; const char* nB = cB;
    int tcu = 0, tnx = 0;
    if constexpr (Sched::GATHER) {
        if (tid < BM) gtb[tid] = S.a_row_off(cur, tid, K);
        asm volatile("s_waitcnt vmcnt(0) lgkmcnt(0)" ::: "memory"); PG8_BAR; asm volatile("" ::: "memory");
    }
    PG8_STAGE(PG8_SB(0, 0), cB, voffB); PG8_STAGE(PG8_SB(0, 1), cB + hstep, voffB); PG8_STAGEA(PG8_SA(0, 0), 0, 0, false); PG8_STAGEA(PG8_SA(0, 1), 1, 0, false);
    if (wr == 1) PG8_BAR;
    PG8_WAIT_V(2); PG8_BAR;
    PG8_STAGE(PG8_SB(1, 0), cB + kstep, voffB); PG8_STAGEA(PG8_SA(1, 0), 0, kstep, false); PG8_STAGE(PG8_SB(1, 1), cB + hstep + kstep, voffB);
    PG8_WAIT_V(6); PG8_BAR;
    for (;;) {
        const bool has_next = S.next(ui + 1, nxt);
        nA = cA; nB = cB; tnx = tcu;
        if (has_next) { nA = Abase + (size_t)nxt.pm * tstep; nB = (const char*)g.Bt + S.b_off(nxt, g.N, K);
            if constexpr (Sched::GATHER) { tnx = tcu ^ BM; if (tid < BM) gtb[tnx + tid] = S.a_row_off(nxt, tid, K); } }
#pragma unroll 1
        for (int t = 0; t < nt; t += 2) {
            const bool last = (t == nt - 2);
            const size_t k1 = (size_t)(t + 1) * kstep;
            const size_t k2 = last ? 0 : (size_t)(t + 2) * kstep, k3 = k2 + kstep;
            const char* b2 = last ? nB : cB + (size_t)(t + 2) * kstep; const char* b3 = b2 + kstep;
            PG8_LDB(B0, 0, 0); PG8_LDB(B1, 0, 1); PG8_SCHED; PG8_LDA(At, 0, 0); PG8_STAGEA(PG8_SA(1, 1), 1, k1, false);
            PG8_WAIT_V(8); PG8_WAIT_L(0); PG8_BAR; PG8_MMA(0, 0, At, B0); PG8_MMA(0, 1, At, B1); PG8_BAR; PG8_SCHED;
            PG8_LDA(At, 0, 1); PG8_STAGE(PG8_SB(0, 0), b2, voffB); PG8_STAGE(PG8_SB(0, 1), b2 + hstep, voffB); PG8_STAGEA(PG8_SA(0, 0), 0, k2, last);
            PG8_WAIT_V(8); PG8_WAIT_L(0); PG8_BAR; PG8_MMA(1, 0, At, B0); PG8_MMA(1, 1, At, B1); PG8_BAR; PG8_SCHED;
            PG8_LDB(B0, 1, 0); PG8_LDB(B1, 1, 1); PG8_SCHED; PG8_LDA(At, 1, 0); PG8_STAGEA(PG8_SA(0, 1), 1, k2, last);
            PG8_WAIT_V(8); PG8_WAIT_L(0); PG8_BAR; PG8_MMA(0, 0, At, B0); PG8_MMA(0, 1, At, B1); PG8_BAR; PG8_SCHED;
            PG8_LDA(At, 1, 1); PG8_STAGE(PG8_SB(1, 0), b3, voffB); PG8_STAGE(PG8_SB(1, 1), b3 + hstep, voffB); PG8_STAGEA(PG8_SA(1, 0), 0, k3, last);
            PG8_WAIT_V(8); PG8_WAIT_L(0); PG8_BAR; PG8_MMA(1, 0, At, B0); PG8_MMA(1, 1, At, B1); PG8_BAR; PG8_SCHED;
        }
        if constexpr (ALIGN_EPI) { if (wr == 0) PG8_BAR; }
        E(acc, cur, wr, wc, fr, fq);
        if (!has_next) break;
#pragma unroll
        for (int a = 0; a < 2; ++a)
#pragma unroll
            for (int b = 0; b < 2; ++b)
#pragma unroll
                for (int m = 0; m < 4; ++m)
#pragma unroll
                    for (int n = 0; n < 2; ++n) acc[a][b][m][n] = (f32x4){0.f, 0.f, 0.f, 0.f};
        cur = nxt; cA = nA; cB = nB; tcu = tnx; ++ui;
        if constexpr (ALIGN_EPI) { if (wr == 1) PG8_BAR; }
    }
    PG8_WAIT_V(0);
    if constexpr (!ALIGN_EPI) { if (wr == 0) PG8_BAR; }
    PG8_BAR;
#undef PG8_SA
#undef PG8_SB
#undef PG8_STAGE
#undef PG8_STAGEA
#undef PG8_LDA
#undef PG8_LDB
#undef PG8_MMA
#undef PG8_WAIT_V
#undef PG8_WAIT_L
#undef PG8_BAR
#undef PG8_SCHED
}

struct EpiBf16Plain {
    static constexpr bool PERM = true;
    bf16* O; int ldc;
    __device__ __forceinline__ void operator()(const f32x4 (&acc)[2][2][4][2], const Unit& u, int wr, int wc, int fr, int fq) const {
        const int row0 = u.pm * BM + wr * 64 + fr, col0 = u.pn * BM + wc * 32 + 8 * fq;
#pragma unroll
        for (int ai = 0; ai < 2; ++ai)
#pragma unroll
            for (int m = 0; m < 4; ++m) { bf16* rowp = O + (size_t)(row0 + ai * HALF + m * 16) * ldc + col0;
#pragma unroll
                for (int bj = 0; bj < 2; ++bj) { const f32x4 v0 = acc[ai][bj][m][0], v1 = acc[ai][bj][m][1];
                    u32x4 w; w.x = cvt_pk_bf16(v0[0], v0[1]); w.y = cvt_pk_bf16(v0[2], v0[3]); w.z = cvt_pk_bf16(v1[0], v1[1]); w.w = cvt_pk_bf16(v1[2], v1[3]);
                    *(u32x4*)(rowp + bj * HALF) = w; } }
    }
};
struct EpiPlainI8 {
    static constexpr bool PERM = true;
    bf16* O; int ldc; float inv; int v0, v1; const float* rs;
    __device__ __forceinline__ void operator()(const f32x4 (&acc)[2][2][4][2], const Unit& u, int wr, int wc, int fr, int fq) const {
        const int row0 = u.pm * BM + wr * 64 + fr, col0 = u.pn * BM + wc * 32 + 8 * fq;
        float rsc[2][4];
#pragma unroll
        for (int ai = 0; ai < 2; ++ai)
#pragma unroll
            for (int m = 0; m < 4; ++m) rsc[ai][m] = rs[row0 + ai * HALF + m * 16];
#pragma unroll
        for (int bj = 0; bj < 2; ++bj) { const int c = col0 + bj * HALF; const float scc = (c >= v0 && c < v1) ? inv * 0.5f : inv;
#pragma unroll
            for (int ai = 0; ai < 2; ++ai)
#pragma unroll
                for (int m = 0; m < 4; ++m) { const i32x4 i0 = __builtin_bit_cast(i32x4, acc[ai][bj][m][0]), i1 = __builtin_bit_cast(i32x4, acc[ai][bj][m][1]); const float sc = scc * rsc[ai][m];
                    u32x4 w; w.x = cvt_pk_bf16((float)i0[0] * sc, (float)i0[1] * sc); w.y = cvt_pk_bf16((float)i0[2] * sc, (float)i0[3] * sc); w.z = cvt_pk_bf16((float)i1[0] * sc, (float)i1[1] * sc); w.w = cvt_pk_bf16((float)i1[2] * sc, (float)i1[3] * sc);
                    *(u32x4*)(O + (size_t)(row0 + ai * HALF + m * 16) * ldc + c) = w; } }
    }
};
struct EpiMlaUp {
    static constexpr bool PERM = true;
    bf16* Q; bf16* KK; bf16* V; const float* cs;
    __device__ __forceinline__ void operator()(const f32x4 (&acc)[2][2][4][2], const Unit& u, int wr, int wc, int fr, int fq) const {
        const int row0 = u.pm * BM + wr * 64 + fr;
#pragma unroll
        for (int bj = 0; bj < 2; ++bj) {
            const int c0 = u.pn * BM + bj * HALF + wc * 32 + 8 * fq;
            if (u.pn < 3) {
                const int h = c0 / QKD, d = c0 - h * QKD;
                const bool rope = d >= NOPE; const int i0 = rope ? (d - NOPE) >> 1 : 0;
#pragma unroll
                for (int ai = 0; ai < 2; ++ai)
#pragma unroll
                    for (int m = 0; m < 4; ++m) { const int row = row0 + ai * HALF + m * 16;
                        f32x4 v0 = acc[ai][bj][m][0], v1 = acc[ai][bj][m][1];
                        if (rope) { const f32x4 cA = *(const f32x4*)(cs + (size_t)row * 32 + i0 * 2), cB = *(const f32x4*)(cs + (size_t)row * 32 + i0 * 2 + 4);
                            const f32x4 a = v0, b = v1;
                            v0[0] = a[0] * cA[0] - a[1] * cA[1]; v0[1] = a[0] * cA[1] + a[1] * cA[0]; v0[2] = a[2] * cA[2] - a[3] * cA[3]; v0[3] = a[2] * cA[3] + a[3] * cA[2];
                            v1[0] = b[0] * cB[0] - b[1] * cB[1]; v1[1] = b[0] * cB[1] + b[1] * cB[0]; v1[2] = b[2] * cB[2] - b[3] * cB[3]; v1[3] = b[2] * cB[3] + b[3] * cB[2]; }
                        v0 = v0 * C2Q; v1 = v1 * C2Q;
                        u32x4 w; w.x = cvt_pk_bf16(v0[0], v0[1]); w.y = cvt_pk_bf16(v0[2], v0[3]); w.z = cvt_pk_bf16(v1[0], v1[1]); w.w = cvt_pk_bf16(v1[2], v1[3]);
                        *(u32x4*)(Q + (size_t)row * 768 + c0) = w; asm volatile("" ::: "memory"); }
            } else {
                bf16* base; int ld, cc;
                if (u.pn < 5) { const int c1 = c0 - 768; const int h = c1 >> 6, d = c1 & 63; base = KK; ld = 768; cc = h * QKD + d; }
                else { base = V; ld = 512; cc = c0 - 1280; }
#pragma unroll
                for (int ai = 0; ai < 2; ++ai)
#pragma unroll
                    for (int m = 0; m < 4; ++m) { const int row = row0 + ai * HALF + m * 16; const f32x4 v0 = acc[ai][bj][m][0], v1 = acc[ai][bj][m][1];
                        u32x4 w; w.x = cvt_pk_bf16(v0[0], v0[1]); w.y = cvt_pk_bf16(v0[2], v0[3]); w.z = cvt_pk_bf16(v1[0], v1[1]); w.w = cvt_pk_bf16(v1[2], v1[3]);
                        *(u32x4*)(base + (size_t)row * ld + cc) = w; asm volatile("" ::: "memory"); }
            }
        }
    }
};
struct EpiRwkvSmall {
    static constexpr bool PERM = false;
    float* O; const float* w0; const float* a0;
    __device__ __forceinline__ void operator()(const f32x4 (&acc)[2][2][4][2], const Unit& u, int wr, int wc, int fr, int fq) const {
        const int row0 = u.pm * BM + wr * 64 + fr, col0 = u.pn * BM + wc * 32 + 4 * fq;
        const int kind = u.pn >> 1;
#pragma unroll
        for (int bj = 0; bj < 2; ++bj)
#pragma unroll
            for (int n = 0; n < 2; ++n) { const int c = col0 + bj * HALF + n * 16;
                f32x4 bv = (f32x4){0.f, 0.f, 0.f, 0.f};
                if (kind == 0) bv = *(const f32x4*)(w0 + c); else if (kind == 1) bv = *(const f32x4*)(a0 + (c - 512));
#pragma unroll
                for (int ai = 0; ai < 2; ++ai)
#pragma unroll
                    for (int m = 0; m < 4; ++m) { f32x4 v = acc[ai][bj][m][n] + bv;
                        if (kind == 0) {
#pragma unroll
                            for (int j = 0; j < 4; ++j) { const float z = -v[j]; const float sp = fmaxf(z, 0.f) + __logf(1.0f + __expf(-fabsf(z))); const float w = -sp - 0.5f; v[j] = -__expf(w); }
                        } else if (kind == 1) {
#pragma unroll
                            for (int j = 0; j < 4; ++j) v[j] = sigmoidf_(v[j]);
                        }
                        *(f32x4*)(O + (size_t)(row0 + ai * HALF + m * 16) * N_SM + c) = v; asm volatile("" ::: "memory"); } }
    }
};
struct EpiVres {
    static constexpr bool PERM = true;
    const bf16* vs; const bf16* vf; bf16* vr; const float* v0;
    __device__ __forceinline__ void operator()(const f32x4 (&acc)[2][2][4][2], const Unit& u, int wr, int wc, int fr, int fq) const {
        const int row0 = u.pm * BM + wr * 64 + fr, col0 = u.pn * BM + wc * 32 + 8 * fq;
#pragma unroll
        for (int bj = 0; bj < 2; ++bj) { const int c = col0 + bj * HALF;
            const f32x4 b0 = *(const f32x4*)(v0 + c), b1 = *(const f32x4*)(v0 + c + 4);
#pragma unroll
            for (int ai = 0; ai < 2; ++ai)
#pragma unroll
                for (int m = 0; m < 4; ++m) { const size_t off = (size_t)(row0 + ai * HALF + m * 16) * C5 + c;
                    const u32x4 s = *(const u32x4*)(vs + off), f = *(const u32x4*)(vf + off);
                    const f32x4 g0 = acc[ai][bj][m][0] + b0, g1 = acc[ai][bj][m][1] + b1;
                    float o[8];
#pragma unroll
                    for (int j = 0; j < 4; ++j) { const float sl = bflo(s[j]), sh = bfhi(s[j]), fl = bflo(f[j]), fh = bfhi(f[j]);
                        const float ga = (j < 2) ? g0[2 * j] : g1[2 * j - 4], gb = (j < 2) ? g0[2 * j + 1] : g1[2 * j - 3];
                        o[2 * j] = sl + (fl - sl) * sigmoidf_(ga); o[2 * j + 1] = sh + (fh - sh) * sigmoidf_(gb); }
                    u32x4 w; w.x = cvt_pk_bf16(o[0], o[1]); w.y = cvt_pk_bf16(o[2], o[3]); w.z = cvt_pk_bf16(o[4], o[5]); w.w = cvt_pk_bf16(o[6], o[7]);
                    *(u32x4*)(vr + off) = w; } }
    }
};
struct EpiWo {
    static constexpr bool PERM = true;
    bf16* X; const float* gt;
    __device__ __forceinline__ void operator()(const f32x4 (&acc)[2][2][4][2], const Unit& u, int wr, int wc, int fr, int fq) const {
        const int row0 = u.pm * BM + wr * 64 + fr, col0 = u.pn * BM + wc * 32 + 8 * fq;
        const int b = (u.pm * BM) / SEQ;
#pragma unroll
        for (int bj = 0; bj < 2; ++bj) { const int c = col0 + bj * HALF;
            const f32x4 g0 = *(const f32x4*)(gt + (size_t)b * 6144 + c) + 1.0f, g1 = *(const f32x4*)(gt + (size_t)b * 6144 + c + 4) + 1.0f;
#pragma unroll
            for (int ai = 0; ai < 2; ++ai)
#pragma unroll
                for (int m = 0; m < 4; ++m) { bf16* px = X + (size_t)(row0 + ai * HALF + m * 16) * D + c; const u32x4 xw = *(const u32x4*)px;
                    const f32x4 a0 = acc[ai][bj][m][0], a1 = acc[ai][bj][m][1];
                    u32x4 w; w.x = cvt_pk_bf16(bflo(xw.x) * DN_ALPHA + g0[0] * a0[0], bfhi(xw.x) * DN_ALPHA + g0[1] * a0[1]); w.y = cvt_pk_bf16(bflo(xw.y) * DN_ALPHA + g0[2] * a0[2], bfhi(xw.y) * DN_ALPHA + g0[3] * a0[3]);
                    w.z = cvt_pk_bf16(bflo(xw.z) * DN_ALPHA + g1[0] * a1[0], bfhi(xw.z) * DN_ALPHA + g1[1] * a1[1]); w.w = cvt_pk_bf16(bflo(xw.w) * DN_ALPHA + g1[2] * a1[2], bfhi(xw.w) * DN_ALPHA + g1[3] * a1[3]);
                    *(u32x4*)px = w; } }
    }
};
struct EpiSwiglu {
    static constexpr bool PERM = true;
    unsigned char* O; const float* b1p;
    __device__ __forceinline__ void operator()(const f32x4 (&acc)[2][2][4][2], const Unit& u, int wr, int wc, int fr, int fq) const {
        const int row0 = u.pm * BM + wr * 64 + fr; const int cin = u.pn * BM + wc * 32 + 8 * fq, cout = u.pn * HALF + wc * 32 + 8 * fq;
        const float* bp = b1p + (size_t)u.e * 2048 + cin;
        const f32x4 bg0 = *(const f32x4*)(bp), bg1 = *(const f32x4*)(bp + 4), bl0 = *(const f32x4*)(bp + HALF), bl1 = *(const f32x4*)(bp + HALF + 4);
        constexpr float inv = 1.0f / (QS_H * QS_W1);
#pragma unroll
        for (int ai = 0; ai < 2; ++ai)
#pragma unroll
            for (int m = 0; m < 4; ++m) {
                const i32x4 ig0 = __builtin_bit_cast(i32x4, acc[ai][0][m][0]), ig1 = __builtin_bit_cast(i32x4, acc[ai][0][m][1]), il0 = __builtin_bit_cast(i32x4, acc[ai][1][m][0]), il1 = __builtin_bit_cast(i32x4, acc[ai][1][m][1]);
                float o[8];
#pragma unroll
                for (int j = 0; j < 8; ++j) { const float gv = fminf((float)(j < 4 ? ig0[j & 3] : ig1[j & 3]) * inv + (j < 4 ? bg0[j & 3] : bg1[j & 3]), 7.0f);
                    const float lv = __builtin_amdgcn_fmed3f((float)(j < 4 ? il0[j & 3] : il1[j & 3]) * inv + (j < 4 ? bl0[j & 3] : bl1[j & 3]), -7.0f, 7.0f);
                    const float sg = __builtin_amdgcn_rcpf(1.0f + __builtin_amdgcn_exp2f(gv * (-1.702f * 1.4426950408889634f)));
                    o[j] = (gv * sg) * (lv * QS_U + QS_U); }
                u32x2 w; w.x = q8x4(o[0], o[1], o[2], o[3]); w.y = q8x4(o[4], o[5], o[6], o[7]);
                *(u32x2*)(O + (size_t)(row0 + ai * HALF + m * 16) * FF + cout) = w; }
    }
};
struct EpiMoeOut {
    static constexpr bool PERM = true;
    bf16* O; const float* b2; const float* gatel; const LAS int* tb;
    __device__ __forceinline__ void operator()(const f32x4 (&acc)[2][2][4][2], const Unit& u, int wr, int wc, int fr, int fq) const {
        const int row0 = u.pm * BM + wr * 64 + fr, col0 = u.pn * BM + wc * 32 + 8 * fq;
        const int pos0 = (u.pm - tb[u.e]) * BM + wr * 64 + fr;
        const float* bp = b2 + (size_t)u.e * D + col0;
        constexpr float inv = 1.0f / (QS_U * QS_W2);
        f32x4 bv[2][2];
#pragma unroll
        for (int bj = 0; bj < 2; ++bj) { bv[bj][0] = *(const f32x4*)(bp + bj * HALF); bv[bj][1] = *(const f32x4*)(bp + bj * HALF + 4); }
#pragma unroll
        for (int ai = 0; ai < 2; ++ai)
#pragma unroll
            for (int m = 0; m < 4; ++m) { const float gt = gatel[(size_t)u.e * CAP + pos0 + ai * HALF + m * 16];
                bf16* rowp = O + (size_t)(row0 + ai * HALF + m * 16) * D + col0;
#pragma unroll
                for (int bj = 0; bj < 2; ++bj) { const i32x4 i0 = __builtin_bit_cast(i32x4, acc[ai][bj][m][0]), i1 = __builtin_bit_cast(i32x4, acc[ai][bj][m][1]);
                    f32x4 v0, v1;
#pragma unroll
                    for (int j = 0; j < 4; ++j) { v0[j] = ((float)i0[j] * inv + bv[bj][0][j]) * gt; v1[j] = ((float)i1[j] * inv + bv[bj][1][j]) * gt; }
                    u32x4 w; w.x = cvt_pk_bf16(v0[0], v0[1]); w.y = cvt_pk_bf16(v0[2], v0[3]); w.z = cvt_pk_bf16(v1[0], v1[1]); w.w = cvt_pk_bf16(v1[2], v1[3]);
                    *(u32x4*)(rowp + bj * HALF) = w; } }
    }
};
}

struct Params { const void* in[N_INPUTS]; float* out; unsigned char* ws; int ph_lo, ph_hi; };

struct Frame {
    LAS unsigned char* lds;
    int tid, lane, wave, G, vcu;
    unsigned char* ws;
};
#define WSP(type, off) ((type*)(F.ws + (off)))
#define INP(i) ((const float*)p.in[i])

__device__ const double INV_FREQ[16] = {1.00000000000000000e+00, 5.62341325190349073e-01, 3.16227766016837941e-01, 1.77827941003892293e-01, 1.00000000000000006e-01, 5.62341325190349114e-02,
    3.16227766016837913e-02, 1.77827941003892293e-02, 1.00000000000000002e-02, 5.62341325190349097e-03, 3.16227766016837939e-03, 1.77827941003892275e-03, 1.00000000000000002e-03,
    5.62341325190349097e-04, 3.16227766016837939e-04, 1.77827941003892270e-04};

template <int MODE>
__device__ __forceinline__ void tr_item(const float* W, int ldn, bf16* WT, int ldk, int kofs, int rofs, int k0, int n0, LAS float* scr, int lane) {
    f32x4 ld[8];
#pragma unroll
    for (int i = 0; i < 8; ++i) ld[i] = *(const f32x4*)(W + (size_t)(k0 + 8 * i + (lane >> 3)) * ldn + n0 + 4 * (lane & 7));
#pragma unroll
    for (int i = 0; i < 8; ++i) { LAS float* d = scr + (8 * i + (lane >> 3)) * 33 + 4 * (lane & 7); d[0] = ld[i].x; d[1] = ld[i].y; d[2] = ld[i].z; d[3] = ld[i].w; }
    LDS_WAIT(); asm volatile("" ::: "memory");
    const int c = lane & 7;
#pragma unroll
    for (int j = 0; j < 4; ++j) { const int n = (lane >> 3) + 8 * j; const LAS float* s = scr + (8 * c) * 33 + n;
        u32x4 o; o.x = pk2(s[0 * 33], s[1 * 33]); o.y = pk2(s[2 * 33], s[3 * 33]); o.z = pk2(s[4 * 33], s[5 * 33]); o.w = pk2(s[6 * 33], s[7 * 33]);
        const int ng = n0 + n; int row;
        if (MODE == 0) row = rofs + ng; else { const int jo = ng >> 1, bj = ng & 1; row = rofs + (jo >> 7) * 256 + bj * 128 + (jo & 127); }
        *(GAS u32x4*)(WT + (size_t)row * ldk + kofs + k0 + 8 * c) = o; }
    LDS_WAIT(); asm volatile("" ::: "memory");
}
__device__ __forceinline__ void tr_item_i8(const float* W, int ldn, unsigned char* WT, int ldk, int k0, int n0, LAS float* scr, int lane) {
    f32x4 ld[8];
#pragma unroll
    for (int i = 0; i < 8; ++i) ld[i] = *(const f32x4*)(W + (size_t)(k0 + 8 * i + (lane >> 3)) * ldn + n0 + 4 * (lane & 7));
#pragma unroll
    for (int i = 0; i < 8; ++i) { LAS float* d = scr + (8 * i + (lane >> 3)) * 33 + 4 * (lane & 7); d[0] = ld[i].x; d[1] = ld[i].y; d[2] = ld[i].z; d[3] = ld[i].w; }
    LDS_WAIT(); asm volatile("" ::: "memory");
    { const int n = lane >> 1, hf = lane & 1; const LAS float* sp = scr + (32 * hf) * 33 + n; const int ng = n0 + n;
      const float qs = (ng >= 1440 && ng < 1952) ? 2.0f * QS_WIN : QS_WIN;
      u32x4 o0, o1;
      o0.x = q8x4(sp[0 * 33] * qs, sp[1 * 33] * qs, sp[2 * 33] * qs, sp[3 * 33] * qs); o0.y = q8x4(sp[4 * 33] * qs, sp[5 * 33] * qs, sp[6 * 33] * qs, sp[7 * 33] * qs);
      o0.z = q8x4(sp[8 * 33] * qs, sp[9 * 33] * qs, sp[10 * 33] * qs, sp[11 * 33] * qs); o0.w = q8x4(sp[12 * 33] * qs, sp[13 * 33] * qs, sp[14 * 33] * qs, sp[15 * 33] * qs);
      o1.x = q8x4(sp[16 * 33] * qs, sp[17 * 33] * qs, sp[18 * 33] * qs, sp[19 * 33] * qs); o1.y = q8x4(sp[20 * 33] * qs, sp[21 * 33] * qs, sp[22 * 33] * qs, sp[23 * 33] * qs);
      o1.z = q8x4(sp[24 * 33] * qs, sp[25 * 33] * qs, sp[26 * 33] * qs, sp[27 * 33] * qs); o1.w = q8x4(sp[28 * 33] * qs, sp[29 * 33] * qs, sp[30 * 33] * qs, sp[31 * 33] * qs);
      unsigned char* dp = WT + (size_t)ng * ldk + k0 + 32 * hf;
      *(GAS u32x4*)dp = o0; *(GAS u32x4*)(dp + 16) = o1; }
    LDS_WAIT(); asm volatile("" ::: "memory");
}
__device__ __forceinline__ void zero_rect(const Frame& F, bf16* M, int ld, int r0, int nrows, int c0, int ncols) {
    const int gw = F.vcu * NWAVES + F.wave, NGW = F.G * NWAVES; const int nch = ncols / 8;
    for (int r = gw; r < nrows; r += NGW)
        for (int ch = F.lane; ch < nch; ch += 64) *(GAS u32x4*)(M + (size_t)(r0 + r) * ld + c0 + ch * 8) = (u32x4){0u, 0u, 0u, 0u};
}
__device__ __forceinline__ void phase_prologue(const Params& p, const Frame& F) {
    LAS float* scr = (LAS float*)(F.lds + F.wave * 16384);
    const int gw = F.vcu * NWAVES + F.wave, NGW = F.G * NWAVES;
    constexpr int I_IN = 16 * 69, I_UQ = 4 * 24, I_UK = 2 * 16, I_W2s = 16, I_G2s = 2 * 16, I_WO_ = 16 * 32, I_E1 = 16 * 64, I_E2 = 16 * 32;
    constexpr int PER_L = I_IN + I_UQ + 2 * I_UK + 2 * I_W2s + I_G2s + I_WO_;
    constexpr int NSMALL = DEPTH * PER_L;
    for (int it = gw; it < NSMALL; it += NGW) {
        int r = it;
        {
            const int l = r / PER_L; r -= l * PER_L;
            if (r < I_IN) { tr_item_i8(INP(I_WIN) + (size_t)l * D * N_IN, N_IN, WSP(unsigned char, WS_WINT) + (size_t)l * N_INP * D, D, 64 * (r / 69), 32 * (r % 69), scr, F.lane); continue; } r -= I_IN;
            bf16* up = WSP(bf16, WS_WUPT) + (size_t)l * N_UP * K_UP;
            if (r < I_UQ) { tr_item<0>(INP(I_WUQ) + (size_t)l * QLR * 768, 768, up, K_UP, 0, 0, 64 * (r / 24), 32 * (r % 24), scr, F.lane); continue; } r -= I_UQ;
            if (r < I_UK) { tr_item<0>(INP(I_WUK) + (size_t)l * KVLR * 512, 512, up, K_UP, 256, 768, 64 * (r / 16), 32 * (r % 16), scr, F.lane); continue; } r -= I_UK;
            if (r < I_UK) { tr_item<0>(INP(I_WUV) + (size_t)l * KVLR * 512, 512, up, K_UP, 256, 1280, 64 * (r / 16), 32 * (r % 16), scr, F.lane); continue; } r -= I_UK;
            bf16* sm = WSP(bf16, WS_WSMT) + (size_t)l * N_SM * K_SM;
            if (r < I_W2s) { tr_item<0>(INP(I_W2) + (size_t)l * 64 * 512, 512, sm, K_SM, 0, 0, 0, 32 * r, scr, F.lane); continue; } r -= I_W2s;
            if (r < I_W2s) { tr_item<0>(INP(I_A2) + (size_t)l * 64 * 512, 512, sm, K_SM, 64, 512, 0, 32 * r, scr, F.lane); continue; } r -= I_W2s;
            if (r < I_G2s) { tr_item<0>(INP(I_G2) + (size_t)l * 128 * 512, 512, sm, K_SM, 128, 1024, 64 * (r / 16), 32 * (r % 16), scr, F.lane); continue; } r -= I_G2s;
            tr_item<0>(INP(I_WO) + (size_t)l * D * D, D, WSP(bf16, WS_WOT) + (size_t)l * D * D, D, 0, 0, 64 * (r / 32), 32 * (r % 32), scr, F.lane); continue;
        }
    }
    for (int l = 0; l < DEPTH; ++l) {
        zero_rect(F, (bf16*)(WSP(unsigned char, WS_WINT) + (size_t)l * N_INP * D), D / 2, N_IN, N_INP - N_IN, 0, D / 2);
        bf16* up = WSP(bf16, WS_WUPT) + (size_t)l * N_UP * K_UP;
        zero_rect(F, up, K_UP, 0, 768, 256, 128); zero_rect(F, up, K_UP, 768, 1024, 0, 256);
        bf16* sm = WSP(bf16, WS_WSMT) + (size_t)l * N_SM * K_SM;
        zero_rect(F, sm, K_SM, 0, 512, 64, 192); zero_rect(F, sm, K_SM, 512, 512, 0, 64); zero_rect(F, sm, K_SM, 512, 512, 128, 128); zero_rect(F, sm, K_SM, 1024, 512, 0, 128);
    }
    const int gt = (F.vcu * NTHREADS) + F.tid, NGT = F.G * NTHREADS;
    { const float* v1 = INP(I_V1); const float* v2 = INP(I_V2); bf16* o = WSP(bf16, WS_WV12T);
      for (int i = gt; i < 512 * 512; i += NGT) { const int n = i >> 9, k = i & 511; float s = 0.f;
#pragma unroll 8
          for (int j = 0; j < 32; ++j) s += v1[k * 32 + j] * v2[j * 512 + n];
          o[i] = (bf16)f2bf(s); } }
    { const float* b1 = INP(I_EB1); float* o = WSP(float, WS_B1P);
      for (int i = gt; i < DEPTH * NE * 2048; i += NGT) { const int q = i & 2047, le = i >> 11; const int pn = q >> 8, bj = (q >> 7) & 1, jj = q & 127; o[i] = b1[(size_t)le * 2048 + 2 * (pn * 128 + jj) + bj]; } }
    { bf16* pg = WSP(bf16, WS_PGW);
      for (int i = gt; i < DEPTH * PGW_NFRAG * 64; i += NGT) { const int ln = i & 63, fi = (i >> 6) % PGW_NFRAG, l2 = (i >> 6) / PGW_NFRAG; const int rr = ln & 31, hh = ln >> 5;
          const float* W; int ldw, KS, f0; bool v12 = false;
          if (fi < PGW_KN) { W = INP(I_WUQ) + (size_t)l2 * QLR * 768; ldw = 768; KS = 16; f0 = PGW_Q; }
          else if (fi < PGW_V) { W = INP(I_WUK) + (size_t)l2 * KVLR * 512; ldw = 512; KS = 8; f0 = PGW_KN; }
          else if (fi < PGW_W) { W = INP(I_WUV) + (size_t)l2 * KVLR * 512; ldw = 512; KS = 8; f0 = PGW_V; }
          else if (fi < PGW_A) { W = INP(I_W2) + (size_t)l2 * 64 * 512; ldw = 512; KS = 4; f0 = PGW_W; }
          else if (fi < PGW_G) { W = INP(I_A2) + (size_t)l2 * 64 * 512; ldw = 512; KS = 4; f0 = PGW_A; }
          else if (fi < PGW_VR) { W = INP(I_G2) + (size_t)l2 * 128 * 512; ldw = 512; KS = 8; f0 = PGW_G; }
          else { W = nullptr; ldw = 512; KS = 32; f0 = PGW_VR; v12 = true; }
          const int nb = (fi - f0) / KS, ks = (fi - f0) % KS, n = 32 * nb + rr, k0 = 16 * ks + 8 * hh;
          float v[8];
          if (!v12) {
#pragma unroll
              for (int j = 0; j < 8; ++j) v[j] = W[(size_t)(k0 + j) * ldw + n]; }
          else { const float* v1 = INP(I_V1); const float* v2 = INP(I_V2);
#pragma unroll
              for (int j = 0; j < 8; ++j) { float sacc = 0.f;
#pragma unroll 8
                  for (int q = 0; q < 32; ++q) sacc += v1[(k0 + j) * 32 + q] * v2[q * 512 + n];
                  v[j] = (l2 == 0) ? 0.f : sacc; } }
          u32x4 o; o.x = pk2(v[0], v[1]); o.y = pk2(v[2], v[3]); o.z = pk2(v[4], v[5]); o.w = pk2(v[6], v[7]);
          *(u32x4*)(pg + (size_t)i * 8) = o; } }
    { const float* rw = INP(I_RW); bf16* o = WSP(bf16, WS_RWT);
      for (int i = gt; i < DEPTH * NE * D; i += NGT) { const int k = i & 1023, e = (i >> 10) & 31, l2 = i >> 15; const float v = rw[((size_t)l2 * D + k) * NE + e]; const unsigned hi = f2bf(v); const float lo = v - bf2f(hi);
          o[i] = (bf16)hi; o[DEPTH * NE * D + i] = (bf16)f2bf(lo); } }
    { const int* pos = (const int*)p.in[I_POS]; float* cs = WSP(float, WS_CS);
      for (int i = gt; i < T * 16; i += NGT) { const int t = i >> 4, k = i & 15; const double a = (double)pos[t] * INV_FREQ[k];
          const double q = __builtin_rint(a * 0.63661977236758134308); const int qi = (int)((long long)q & 3);
          double r = __builtin_fma(-q, 1.57079632679489655800e+00, a); r = __builtin_fma(-q, 6.12323399573676603587e-17, r);
          const double r2 = r * r;
          double sn = -2.50521083854417187751e-08; sn = sn * r2 + 2.75573192239858906526e-06; sn = sn * r2 - 1.98412698412698412698e-04; sn = sn * r2 + 8.33333333333333333333e-03; sn = sn * r2 - 1.66666666666666666667e-01; sn = r + r * r2 * sn;
          double cn = 2.08767569878680989792e-09; cn = cn * r2 - 2.75573192239858906526e-07; cn = cn * r2 + 2.48015873015873015873e-05; cn = cn * r2 - 1.38888888888888888889e-03; cn = cn * r2 + 4.16666666666666666667e-02; cn = cn * r2 - 0.5; cn = 1.0 + r2 * cn;
          double sv, cv;
          if (qi == 0) { sv = sn; cv = cn; } else if (qi == 1) { sv = cn; cv = -sn; } else if (qi == 2) { sv = -sn; cv = -cn; } else { sv = -cn; cv = sn; }
          cs[2 * i] = (float)cv; cs[2 * i + 1] = (float)sv; } }
    { LAS float* cact = (LAS float*)(F.lds);
      LAS float* part = (LAS float*)(F.lds + 32768);
      __syncthreads();
      const float* c = INP(I_C);
      for (int i = F.tid; i < NBATCH * D; i += NTHREADS) { const float v = c[i]; cact[i] = v / (1.0f + __expf(-v)); }
      __syncthreads();
      for (int item = F.vcu; item < DEPTH * 96; item += F.G) { const int l = item / 96, n0 = (item % 96) * 64;
          const float* aw = INP(I_ADAW) + (size_t)l * D * 6144 + n0 + F.lane;
          float a8[8];
#pragma unroll
          for (int b = 0; b < 8; ++b) a8[b] = 0.f;
          const int kb = F.wave * 128;
#pragma unroll 4
          for (int k = 0; k < 128; ++k) { const float wv = aw[(size_t)(kb + k) * 6144];
#pragma unroll
              for (int b = 0; b < 8; ++b) a8[b] += cact[b * D + kb + k] * wv; }
#pragma unroll
          for (int b = 0; b < 8; ++b) part[(F.wave * 8 + b) * 64 + F.lane] = a8[b];
          __syncthreads();
          { const int b = F.wave; float s = 0.f;
#pragma unroll
            for (int w = 0; w < 8; ++w) s += part[(w * 8 + b) * 64 + F.lane];
            WSP(float, WS_MOD)[((size_t)l * NBATCH + b) * 6144 + n0 + F.lane] = s + INP(I_ADAB)[(size_t)l * 6144 + n0 + F.lane]; }
          __syncthreads(); }
    }
}

__device__ __forceinline__ void phase_convert_experts(const Params& p, const Frame& F, int c0, int nc) {
    LAS float* scr = (LAS float*)(F.lds + F.wave * 16384);
    constexpr int I_E1 = 16 * 64, I_E2 = 16 * 32, NE1 = DEPTH * NE * I_E1, NE2 = DEPTH * NE * I_E2;
    const int gw = (F.vcu - c0) * NWAVES + F.wave, NGW = nc * NWAVES; const int lane = F.lane;
    __syncthreads();
    f32x4 ld[8];
#define CV_SRC(it, W_, ldn_, k0_, n0_) do { int r_ = (it); if (r_ < NE1) { const int le_ = r_ / I_E1; r_ -= le_ * I_E1; W_ = INP(I_EW1) + (size_t)le_ * D * 2048; ldn_ = 2048; k0_ = 64 * (r_ / 64); n0_ = 32 * (r_ % 64); } \
        else { r_ -= NE1; const int le_ = r_ / I_E2; r_ -= le_ * I_E2; W_ = INP(I_EW2) + (size_t)le_ * FF * D; ldn_ = D; k0_ = 64 * (r_ / 32); n0_ = 32 * (r_ % 32); } } while (0)
#define CV_LOAD(it) do { const float* W_; int ldn_, k0_, n0_; CV_SRC(it, W_, ldn_, k0_, n0_); \
        _Pragma("unroll") for (int i = 0; i < 8; ++i) ld[i] = *(const f32x4*)(W_ + (size_t)(k0_ + 8 * i + (lane >> 3)) * ldn_ + n0_ + 4 * (lane & 7)); } while (0)
    int it = gw;
    if (it < NE1 + NE2) CV_LOAD(it);
    for (; it < NE1 + NE2; it += NGW) {
#pragma unroll
        for (int i = 0; i < 8; ++i) { LAS float* d = scr + (8 * i + (lane >> 3)) * 33 + 4 * (lane & 7); d[0] = ld[i].x; d[1] = ld[i].y; d[2] = ld[i].z; d[3] = ld[i].w; }
        if (it + NGW < NE1 + NE2) CV_LOAD(it + NGW);
        LDS_WAIT(); asm volatile("" ::: "memory");
        int r = it; unsigned char* WT; int ldk, k0, n0; bool perm; float qs;
        if (r < NE1) { const int le = r / I_E1; r -= le * I_E1; WT = WSP(unsigned char, WS_W1T) + (size_t)le * 2048 * D; ldk = D; k0 = 64 * (r / 64); n0 = 32 * (r % 64); perm = true; qs = QS_W1; }
        else { r -= NE1; const int le = r / I_E2; r -= le * I_E2; WT = WSP(unsigned char, WS_W2T) + (size_t)le * D * FF; ldk = FF; k0 = 64 * (r / 32); n0 = 32 * (r % 32); perm = false; qs = QS_W2; }
        { const int n = lane >> 1, hf = lane & 1; const LAS float* sp = scr + (32 * hf) * 33 + n;
          u32x4 o0, o1;
          o0.x = q8x4(sp[0 * 33] * qs, sp[1 * 33] * qs, sp[2 * 33] * qs, sp[3 * 33] * qs); o0.y = q8x4(sp[4 * 33] * qs, sp[5 * 33] * qs, sp[6 * 33] * qs, sp[7 * 33] * qs);
          o0.z = q8x4(sp[8 * 33] * qs, sp[9 * 33] * qs, sp[10 * 33] * qs, sp[11 * 33] * qs); o0.w = q8x4(sp[12 * 33] * qs, sp[13 * 33] * qs, sp[14 * 33] * qs, sp[15 * 33] * qs);
          o1.x = q8x4(sp[16 * 33] * qs, sp[17 * 33] * qs, sp[18 * 33] * qs, sp[19 * 33] * qs); o1.y = q8x4(sp[20 * 33] * qs, sp[21 * 33] * qs, sp[22 * 33] * qs, sp[23 * 33] * qs);
          o1.z = q8x4(sp[24 * 33] * qs, sp[25 * 33] * qs, sp[26 * 33] * qs, sp[27 * 33] * qs); o1.w = q8x4(sp[28 * 33] * qs, sp[29 * 33] * qs, sp[30 * 33] * qs, sp[31 * 33] * qs);
          const int ng = n0 + n; int row = ng;
          if (perm) { const int jo = ng >> 1, bj = ng & 1; row = (jo >> 7) * 256 + bj * 128 + (jo & 127); }
          unsigned char* dp = WT + (size_t)row * ldk + k0 + 32 * hf;
          *(GAS u32x4*)dp = o0; *(GAS u32x4*)(dp + 16) = o1; }
        LDS_WAIT(); asm volatile("" ::: "memory");
    }
#undef CV_LOAD
#undef CV_SRC
    __syncthreads();
}

__device__ __forceinline__ void phase_ln0(const Params& p, const Frame& F) {
    const int gw = F.vcu * NWAVES + F.wave, NGW = F.G * NWAVES;
    const float* mod = WSP(float, WS_MOD);
#pragma unroll 2
    for (int m = gw; m < T; m += NGW) {
        const int b = m / SEQ;
        const GAS f32x4* xr = (const GAS f32x4*)(INP(I_X) + (size_t)m * D) + F.lane;
        f32x4 v[4]; float s = 0.f;
#pragma unroll
        for (int j = 0; j < 4; ++j) { v[j] = xr[64 * j]; s += (v[j].x + v[j].y) + (v[j].z + v[j].w); }
        const float mean = wave_sum(s) * (1.f / D); float s2 = 0.f;
#pragma unroll
        for (int j = 0; j < 4; ++j) { v[j] = v[j] - mean; s2 += (v[j].x * v[j].x + v[j].y * v[j].y) + (v[j].z * v[j].z + v[j].w * v[j].w); }
        const float rstd = 1.f / sqrtf(wave_sum(s2) * (1.f / D) + LN_EPS);
        GAS u32x2* xo = (GAS u32x2*)(WSP(bf16, WS_X) + (size_t)m * D) + F.lane;
        GAS unsigned* ho = (GAS unsigned*)(WSP(unsigned char, WS_H) + (size_t)m * D) + F.lane;
        f32x4 hq[4];
#pragma unroll
        for (int j = 0; j < 4; ++j) { const int c = 4 * F.lane + 256 * j;
            const f32x4 g = *(const f32x4*)(INP(I_ELNG) + c), be = *(const f32x4*)(INP(I_ELNB) + c);
            const f32x4 x0 = v[j] * rstd * g + be; { u32x2 xw; xw.x = pk2(x0.x, x0.y); xw.y = pk2(x0.z, x0.w); xo[64 * j] = xw; }
            const f32x4 sh = *(const f32x4*)(mod + (size_t)b * 6144 + c), sc = *(const f32x4*)(mod + (size_t)b * 6144 + 1024 + c);
            hq[j] = x0 * (sc + 1.0f) + sh; }
        float mx = 0.f;
#pragma unroll
        for (int j = 0; j < 4; ++j) mx = fmaxf(mx, fmaxf(fmaxf(fabsf(hq[j].x), fabsf(hq[j].y)), fmaxf(fabsf(hq[j].z), fabsf(hq[j].w))));
#pragma unroll
        for (int o = 1; o < 64; o <<= 1) mx = fmaxf(mx, __shfl_xor(mx, o));
        mx = fmaxf(mx, 1e-20f); const float qsr = 127.0f / mx;
#pragma unroll
        for (int j = 0; j < 4; ++j) ho[64 * j] = q8x4(hq[j].x * qsr, hq[j].y * qsr, hq[j].z * qsr, hq[j].w * qsr);
        if (F.lane == 0) WSP(float, WS_HS)[m] = mx * (1.0f / 127.0f);
    }
}

__device__ __forceinline__ void phase_prep(const Params& p, const Frame& F, int l) {
    const int gw = F.vcu * NWAVES + F.wave, NGW = F.G * NWAVES; const int lane = F.lane;
    const bf16* P = WSP(bf16, WS_P); const float* mu = INP(I_MU) + (size_t)l * RWKV_IN;
    const float* qg = INP(I_QNG) + (size_t)l * QLR; const float* kvg = INP(I_KVNG) + (size_t)l * KVLR;
    bf16* AN = WSP(bf16, WS_AN); bf16* A2 = WSP(bf16, WS_A2); bf16* RK = WSP(bf16, WS_RK); bf16* KKb = WSP(bf16, WS_KK);
    bf16* VS = l == 0 ? WSP(bf16, WS_VS0) : WSP(bf16, WS_VS1);
    const float* cs = WSP(float, WS_CS);
    const int RPW = (T + NGW - 1) / NGW; const int t0 = gw * RPW; const int t1 = (t0 + RPW < T) ? t0 + RPW : T;
    f32x4 mu0[3], mu1[3];
#pragma unroll
    for (int part = 0; part < 3; ++part) { mu0[part] = *(const f32x4*)(mu + part * 512 + 8 * lane); mu1[part] = *(const f32x4*)(mu + part * 512 + 8 * lane + 4); }
    const float mu_wd = mu[1536 + lane], mu_ad = mu[1600 + lane]; const f32x2 mu_gd = *(const f32x2*)(mu + 1664 + 2 * lane);
    const f32x4 gq = *(const f32x4*)(qg + 4 * lane); const f32x2 gkv = *(const f32x2*)(kvg + 2 * lane);
    u32x4 pw[3]; pw[0] = pw[1] = pw[2] = (u32x4){0u, 0u, 0u, 0u}; float p_wd = 0.f, p_ad = 0.f; unsigned p_gd = 0u;
    if (t0 < t1 && (t0 % SEQ) != 0) { const bf16* rp = P + (size_t)(t0 - 1) * N_INP + MLA_IN;
#pragma unroll
        for (int part = 0; part < 3; ++part) pw[part] = *(const u32x4*)(rp + part * 512 + 8 * lane);
        p_wd = bf2f(rp[1536 + lane]); p_ad = bf2f(rp[1600 + lane]); p_gd = *(const unsigned*)(rp + 1664 + 2 * lane); }
#pragma unroll 2
    for (int t = t0; t < t1; ++t) {
        const bf16* pr = P + (size_t)t * N_INP;
        if ((t % SEQ) == 0) { pw[0] = pw[1] = pw[2] = (u32x4){0u, 0u, 0u, 0u}; p_wd = 0.f; p_ad = 0.f; p_gd = 0u; }
        { const u32x2 qw = *(const u32x2*)(pr + 4 * lane); float q0 = bflo(qw.x), q1 = bfhi(qw.x), q2 = bflo(qw.y), q3 = bfhi(qw.y);
          const float rq = __builtin_amdgcn_rsqf(wave_sum(q0 * q0 + q1 * q1 + q2 * q2 + q3 * q3) * (1.f / QLR) + RMS_EPS);
          u32x2 w; w.x = pk2(q0 * rq * gq.x, q1 * rq * gq.y); w.y = pk2(q2 * rq * gq.z, q3 * rq * gq.w); *(u32x2*)(AN + (size_t)t * K_UP + 4 * lane) = w;
          const unsigned kw = *(const unsigned*)(pr + QLR + 2 * lane); const float k0 = bflo(kw), k1 = bfhi(kw);
          const float rk = __builtin_amdgcn_rsqf(wave_sum(k0 * k0 + k1 * k1) * (1.f / KVLR) + RMS_EPS);
          *(unsigned*)(AN + (size_t)t * K_UP + QLR + 2 * lane) = pk2(k0 * rk * gkv.x, k1 * rk * gkv.y);
          const int i = lane & 15; const unsigned rw = *(const unsigned*)(pr + QLR + KVLR + 2 * i); const float x0 = bflo(rw), x1 = bfhi(rw);
          const f32x2 csv = *(const f32x2*)(cs + (size_t)t * 32 + 2 * i); const unsigned ro = pk2(x0 * csv.x - x1 * csv.y, x0 * csv.y + x1 * csv.x);
          const int h0 = (lane >> 4) * 2;
          *(unsigned*)(KKb + (size_t)t * 768 + h0 * QKD + NOPE + 2 * i) = ro; *(unsigned*)(KKb + (size_t)t * 768 + (h0 + 1) * QKD + NOPE + 2 * i) = ro; }
        const bf16* rr = pr + MLA_IN;
#pragma unroll
        for (int part = 0; part < 3; ++part) {
            const u32x4 cw = *(const u32x4*)(rr + part * 512 + 8 * lane); const u32x4 pv_ = pw[part]; pw[part] = cw;
            float o[8];
#pragma unroll
            for (int j = 0; j < 4; ++j) { const float a = bflo(cw[j]), b = bfhi(cw[j]), pa = bflo(pv_[j]), pb = bfhi(pv_[j]); const float ma = j < 2 ? mu0[part][2 * j] : mu1[part][2 * j - 4], mb = j < 2 ? mu0[part][2 * j + 1] : mu1[part][2 * j - 3];
                o[2 * j] = a + ma * (pa - a); o[2 * j + 1] = b + mb * (pb - b); }
            u32x4 w; w.x = pk2(o[0], o[1]); w.y = pk2(o[2], o[3]); w.z = pk2(o[4], o[5]); w.w = pk2(o[6], o[7]);
            if (part < 2) *(u32x4*)(RK + (size_t)t * 1024 + part * 512 + 8 * lane) = w; else *(u32x4*)(VS + (size_t)t * C5 + 8 * lane) = w;
        }
        { const float a = bf2f(rr[1536 + lane]); const float v = a + mu_wd * (p_wd - a); p_wd = a; A2[(size_t)t * K_SM + lane] = (bf16)f2bf(tanhf_(v)); }
        { const float a = bf2f(rr[1600 + lane]); const float v = a + mu_ad * (p_ad - a); p_ad = a; A2[(size_t)t * K_SM + 64 + lane] = (bf16)f2bf(v); }
        { const unsigned cw = *(const unsigned*)(rr + 1664 + 2 * lane); const float a = bflo(cw), b = bfhi(cw); const float va = a + mu_gd.x * (bflo(p_gd) - a), vb = b + mu_gd.y * (bfhi(p_gd) - b); p_gd = cw;
          *(unsigned*)(A2 + (size_t)t * K_SM + 128 + 2 * lane) = pk2(sigmoidf_(va), sigmoidf_(vb)); }
    }
}

namespace pgm {
constexpr int RP = 64, LDA_AN = 784, LDA_A2 = 528, LDA_VS = 1040, OFF_A2 = RP * LDA_AN, OFF_VS = 0;
__device__ __forceinline__ int crow(int r, int hi) { return (r & 3) + 8 * (r >> 2) + 4 * hi; }
template <int KSTEPS>
__device__ __forceinline__ void block_mma(f32x16 (&acc)[2], const LAS unsigned char* A, int lda, const bf16* Bt, int ldb, int nrow0, int kofs, int r, int h) {
    const bf16* bp = Bt + (size_t)(nrow0 + r) * ldb + kofs + 8 * h;
    const LAS unsigned char* a0 = A + r * lda + (kofs + 8 * h) * 2; const LAS unsigned char* a1 = a0 + 32 * lda;
    bf16x8 cur[4], nxt[4];
#pragma unroll
    for (int j = 0; j < 4; ++j) cur[j] = *(const bf16x8*)(bp + 16 * j);
#pragma unroll
    for (int g = 0; g < KSTEPS / 4; ++g) {
        if (g + 1 < KSTEPS / 4) {
#pragma unroll
            for (int j = 0; j < 4; ++j) nxt[j] = *(const bf16x8*)(bp + 16 * (4 * g + 4 + j)); }
#pragma unroll
        for (int j = 0; j < 4; ++j) { const int ks = 4 * g + j; const bf16x8 x0 = *(const LAS bf16x8*)(a0 + ks * 32), x1 = *(const LAS bf16x8*)(a1 + ks * 32);
            acc[0] = __builtin_amdgcn_mfma_f32_32x32x16_bf16(cur[j], x0, acc[0], 0, 0, 0); acc[1] = __builtin_amdgcn_mfma_f32_32x32x16_bf16(cur[j], x1, acc[1], 0, 0, 0); }
        asm volatile("" ::: "memory");
#pragma unroll
        for (int j = 0; j < 4; ++j) cur[j] = nxt[j];
    }
}
template <int KSTEPS>
__device__ __forceinline__ void load_frags(bf16x8 (&fr)[KSTEPS], const bf16* pg, int frag0, int lane) {
    const bf16* bp = pg + ((size_t)frag0 * 64 + lane) * 8;
#pragma unroll
    for (int ks = 0; ks < KSTEPS; ++ks) fr[ks] = *(const bf16x8*)(bp + (size_t)ks * 512);
}
template <int KSTEPS>
__device__ __forceinline__ void mma_frags(f32x16 (&acc)[2], const LAS unsigned char* A, int lda, int kofs, const bf16x8 (&fr)[KSTEPS], int r, int h) {
    const LAS unsigned char* a0 = A + r * lda + (kofs + 8 * h) * 2; const LAS unsigned char* a1 = a0 + 32 * lda;
#pragma unroll
    for (int ks = 0; ks < KSTEPS; ++ks) { const bf16x8 x0 = *(const LAS bf16x8*)(a0 + ks * 32), x1 = *(const LAS bf16x8*)(a1 + ks * 32);
        acc[0] = __builtin_amdgcn_mfma_f32_32x32x16_bf16(fr[ks], x0, acc[0], 0, 0, 0); acc[1] = __builtin_amdgcn_mfma_f32_32x32x16_bf16(fr[ks], x1, acc[1], 0, 0, 0); }
}
constexpr int STG_LD = 80, STG_BYTES = RP * STG_LD, OFF_STG = RP * LDA_AN + RP * LDA_A2;
__device__ __forceinline__ void stage_put4(LAS unsigned char* stg, int mt, int g, int r, int h, float v0, float v1, float v2, float v3) {
    u32x2 w; w.x = cvtpk_c(v0, v1); w.y = cvtpk_c(v2, v3); *(LAS u32x2*)(stg + (32 * mt + r) * STG_LD + (8 * g + 4 * h) * 2) = w; }
__device__ __forceinline__ void stage_flush(const LAS unsigned char* stg, bf16* dst, int ldd, int lane) {
#pragma unroll
    for (int j = 0; j < 4; ++j) { const int row = 16 * j + (lane >> 2), ch = lane & 3; const u32x4 v = *(const LAS u32x4*)(stg + row * STG_LD + ch * 16); *(u32x4*)(dst + (size_t)row * ldd + 8 * ch) = v; }
}
}

__device__ __forceinline__ void phase_pgemm(const Params& p, const Frame& F, int l) {
    using namespace pgm;
    const int lane0 = F.lane, wave = F.wave;
    const bf16* P = WSP(bf16, WS_P); const float* mu = INP(I_MU) + (size_t)l * RWKV_IN;
    const float* qg = INP(I_QNG) + (size_t)l * QLR; const float* kvg = INP(I_KVNG) + (size_t)l * KVLR;
    bf16* RK = WSP(bf16, WS_RK); bf16* KKb = WSP(bf16, WS_KK); bf16* Qb = WSP(bf16, WS_Q); bf16* Vb = WSP(bf16, WS_V);
    bf16* VS = l == 0 ? WSP(bf16, WS_VS0) : WSP(bf16, WS_VS1);
    float* LWb = WSP(float, WS_LW); bf16* AGb = WSP(bf16, WS_AG);
    const float* cs = WSP(float, WS_CS);
    const bf16* PGW = WSP(bf16, WS_PGW) + (size_t)l * PGW_NFRAG * 512;
    const float* w0 = INP(I_W0) + (size_t)l * C5; const float* a0p = INP(I_A0) + (size_t)l * C5;
    LAS unsigned char* AN = F.lds; LAS unsigned char* A2 = F.lds + OFF_A2; LAS unsigned char* VSl = F.lds + OFF_VS;
    for (int panel = F.vcu; panel < T / RP; panel += F.G) {
        const int row0 = panel * RP;
        int lane = lane0; asm volatile("" : "+v"(lane)); const int r = lane & 31, h = lane >> 5;
        __syncthreads();
        {
            f32x4 mu0[3], mu1[3];
#pragma unroll
            for (int part = 0; part < 3; ++part) { mu0[part] = *(const f32x4*)(mu + part * 512 + 8 * lane); mu1[part] = *(const f32x4*)(mu + part * 512 + 8 * lane + 4); }
            const float mu_wd = mu[1536 + lane], mu_ad = mu[1600 + lane]; const f32x2 mu_gd = *(const f32x2*)(mu + 1664 + 2 * lane);
            const f32x4 gq = *(const f32x4*)(qg + 4 * lane); const f32x2 gkv = *(const f32x2*)(kvg + 2 * lane);
            const int t0 = row0 + 8 * wave;
            u32x4 pw[3]; pw[0] = pw[1] = pw[2] = (u32x4){0u, 0u, 0u, 0u}; float p_wd = 0.f, p_ad = 0.f; unsigned p_gd = 0u;
            if ((t0 % SEQ) != 0) { const bf16* rp = P + (size_t)(t0 - 1) * N_INP + MLA_IN;
#pragma unroll
                for (int part = 0; part < 3; ++part) pw[part] = *(const u32x4*)(rp + part * 512 + 8 * lane);
                p_wd = bf2f(rp[1536 + lane]); p_ad = bf2f(rp[1600 + lane]); p_gd = *(const unsigned*)(rp + 1664 + 2 * lane); }
#pragma unroll 2
            for (int i8 = 0; i8 < 8; ++i8) { const int t = t0 + i8, rl = 8 * wave + i8;
                const bf16* pr = P + (size_t)t * N_INP;
                { const u32x2 qw = *(const u32x2*)(pr + 4 * lane); float q0 = bflo(qw.x), q1 = bfhi(qw.x), q2 = bflo(qw.y), q3 = bfhi(qw.y);
                  const float rq = __builtin_amdgcn_rsqf(wave_sum(q0 * q0 + q1 * q1 + q2 * q2 + q3 * q3) * (1.f / QLR) + RMS_EPS);
                  u32x2 w; w.x = pk2(q0 * rq * gq.x, q1 * rq * gq.y); w.y = pk2(q2 * rq * gq.z, q3 * rq * gq.w); *(LAS u32x2*)(AN + rl * LDA_AN + lane * 8) = w;
                  const unsigned kw = *(const unsigned*)(pr + QLR + 2 * lane); const float k0 = bflo(kw), k1 = bfhi(kw);
                  const float rk = __builtin_amdgcn_rsqf(wave_sum(k0 * k0 + k1 * k1) * (1.f / KVLR) + RMS_EPS);
                  *(LAS unsigned*)(AN + rl * LDA_AN + (QLR + 2 * lane) * 2) = pk2(k0 * rk * gkv.x, k1 * rk * gkv.y);
                  const int i = lane & 15; const unsigned rw = *(const unsigned*)(pr + QLR + KVLR + 2 * i); const float x0 = bflo(rw), x1 = bfhi(rw);
                  const f32x2 csv = *(const f32x2*)(cs + (size_t)t * 32 + 2 * i); const unsigned ro = pk2(x0 * csv.x - x1 * csv.y, x0 * csv.y + x1 * csv.x);
                  const int h0 = (lane >> 4) * 2;
                  *(unsigned*)(KKb + (size_t)t * 768 + h0 * QKD + NOPE + 2 * i) = ro; *(unsigned*)(KKb + (size_t)t * 768 + (h0 + 1) * QKD + NOPE + 2 * i) = ro; }
                const bf16* rr = pr + MLA_IN;
#pragma unroll
                for (int part = 0; part < 3; ++part) {
                    const u32x4 cw = *(const u32x4*)(rr + part * 512 + 8 * lane); const u32x4 pv_ = pw[part]; pw[part] = cw;
                    float o[8];
#pragma unroll
                    for (int j = 0; j < 4; ++j) { const float a = bflo(cw[j]), b = bfhi(cw[j]), pa = bflo(pv_[j]), pb = bfhi(pv_[j]); const float ma = j < 2 ? mu0[part][2 * j] : mu1[part][2 * j - 4], mb = j < 2 ? mu0[part][2 * j + 1] : mu1[part][2 * j - 3];
                        o[2 * j] = a + ma * (pa - a); o[2 * j + 1] = b + mb * (pb - b); }
                    u32x4 w; w.x = pk2(o[0], o[1]); w.y = pk2(o[2], o[3]); w.z = pk2(o[4], o[5]); w.w = pk2(o[6], o[7]);
                    if (part < 2) *(u32x4*)(RK + (size_t)t * 1024 + part * 512 + 8 * lane) = w; else *(u32x4*)(VS + (size_t)t * C5 + 8 * lane) = w;
                }
                { const float a = bf2f(rr[1536 + lane]); const float v = a + mu_wd * (p_wd - a); p_wd = a; *(LAS bf16*)(A2 + rl * LDA_A2 + lane * 2) = (bf16)f2bf(tanhf_(v)); }
                { const float a = bf2f(rr[1600 + lane]); const float v = a + mu_ad * (p_ad - a); p_ad = a; *(LAS bf16*)(A2 + rl * LDA_A2 + (64 + lane) * 2) = (bf16)f2bf(v); }
                { const unsigned cw = *(const unsigned*)(rr + 1664 + 2 * lane); const float a = bflo(cw), b = bfhi(cw); const float va = a + mu_gd.x * (bflo(p_gd) - a), vb = b + mu_gd.y * (bfhi(p_gd) - b); p_gd = cw;
                  *(LAS unsigned*)(A2 + rl * LDA_A2 + (128 + 2 * lane) * 2) = pk2(sigmoidf_(va), sigmoidf_(vb)); }
            }
        }
        __syncthreads();
        LAS unsigned char* stg = F.lds + OFF_STG + wave * STG_BYTES;
        bf16x8 fq[16], fqn[16];
        load_frags<16>(fqn, PGW, PGW_Q + 16 * wave, lane);
#pragma unroll 1
        for (int nb = wave; nb < 24; nb += 8) { f32x16 acc[2]; acc[0] = f32x16{}; acc[1] = f32x16{};
#pragma unroll
            for (int ks = 0; ks < 16; ++ks) fq[ks] = fqn[ks];
            if (nb + 8 < 24) load_frags<16>(fqn, PGW, PGW_Q + 16 * (nb + 8), lane);
            const bool rope = (nb % 3) == 2;
            f32x4 c48[2][4];
#pragma unroll
            for (int mt = 0; mt < 2; ++mt)
#pragma unroll
                for (int g = 0; g < 4; ++g) c48[mt][g] = rope ? *(const f32x4*)(cs + (size_t)(row0 + 32 * mt + r) * 32 + 8 * g + 4 * h) : (f32x4){1.f, 0.f, 1.f, 0.f};
            __builtin_amdgcn_sched_barrier(0);
            mma_frags<16>(acc, AN, LDA_AN, 0, fq, r, h);
#pragma unroll
            for (int mt = 0; mt < 2; ++mt) {
#pragma unroll
                for (int g = 0; g < 4; ++g) { float v0 = acc[mt][4 * g], v1 = acc[mt][4 * g + 1], v2 = acc[mt][4 * g + 2], v3 = acc[mt][4 * g + 3];
                    if (rope) { const f32x4 c4 = c48[mt][g];
                        const float a0 = v0, a1 = v1, a2 = v2, a3 = v3; v0 = a0 * c4.x - a1 * c4.y; v1 = a0 * c4.y + a1 * c4.x; v2 = a2 * c4.z - a3 * c4.w; v3 = a2 * c4.w + a3 * c4.z; }
                    stage_put4(stg, mt, g, r, h, v0 * C2Q, v1 * C2Q, v2 * C2Q, v3 * C2Q); } }
            stage_flush(stg, Qb + (size_t)row0 * 768 + 32 * nb, 768, lane); }
        bf16x8 fk[8], fkn[8];
        load_frags<8>(fkn, PGW, PGW_KN + 8 * wave, lane);
#pragma unroll 1
        for (int nb = wave; nb < 32; nb += 8) { f32x16 acc[2]; acc[0] = f32x16{}; acc[1] = f32x16{};
            const bool isv = nb >= 16; const int n0 = 32 * (nb & 15);
#pragma unroll
            for (int ks = 0; ks < 8; ++ks) fk[ks] = fkn[ks];
            if (nb + 8 < 32) load_frags<8>(fkn, PGW, PGW_KN + 8 * (nb + 8), lane);
            __builtin_amdgcn_sched_barrier(0);
            mma_frags<8>(acc, AN, LDA_AN, 256, fk, r, h);
#pragma unroll
            for (int mt = 0; mt < 2; ++mt)
#pragma unroll
                for (int g = 0; g < 4; ++g) stage_put4(stg, mt, g, r, h, acc[mt][4 * g], acc[mt][4 * g + 1], acc[mt][4 * g + 2], acc[mt][4 * g + 3]);
            if (isv) stage_flush(stg, Vb + (size_t)row0 * C5 + n0, C5, lane); else stage_flush(stg, KKb + (size_t)row0 * 768 + (n0 >> 6) * QKD + (n0 & 63), 768, lane); }
        bf16x8 fs[8], fsn[8];
#pragma unroll
        for (int ks = 0; ks < 8; ++ks) fsn[ks] = (bf16x8){0, 0, 0, 0, 0, 0, 0, 0};
        { bf16x8 t4[4]; load_frags<4>(t4, PGW, PGW_W + 4 * wave, lane); fsn[0] = t4[0]; fsn[1] = t4[1]; fsn[2] = t4[2]; fsn[3] = t4[3]; }
#pragma unroll 1
        for (int nb = wave; nb < 48; nb += 8) { f32x16 acc[2]; acc[0] = f32x16{}; acc[1] = f32x16{};
            const int kind = nb >> 4, n0 = 32 * (nb & 15);
#pragma unroll
            for (int ks = 0; ks < 8; ++ks) fs[ks] = fsn[ks];
            if (nb + 8 < 48) { const int nn = nb + 8, kn = nn >> 4;
                if (kn == 2) load_frags<8>(fsn, PGW, PGW_G + 8 * (nn & 15), lane);
                else { bf16x8 t4[4]; load_frags<4>(t4, PGW, (kn == 0 ? PGW_W : PGW_A) + 4 * (nn & 15), lane); fsn[0] = t4[0]; fsn[1] = t4[1]; fsn[2] = t4[2]; fsn[3] = t4[3]; } }
            f32x4 bz4[4];
#pragma unroll
            for (int g = 0; g < 4; ++g) bz4[g] = kind == 2 ? (f32x4){0.f, 0.f, 0.f, 0.f} : *(const f32x4*)((kind == 0 ? w0 : a0p) + n0 + 8 * g + 4 * h);
            __builtin_amdgcn_sched_barrier(0);
            if (kind == 2) mma_frags<8>(acc, A2, LDA_A2, 128, fs, r, h);
            else { bf16x8 t4[4]; t4[0] = fs[0]; t4[1] = fs[1]; t4[2] = fs[2]; t4[3] = fs[3]; mma_frags<4>(acc, A2, LDA_A2, kind == 0 ? 0 : 64, t4, r, h); }
            if (kind == 0) {
#pragma unroll
                for (int mt = 0; mt < 2; ++mt) { float* lrow = LWb + (size_t)(row0 + 32 * mt + r) * C5 + n0;
#pragma unroll
                    for (int g = 0; g < 4; ++g) { const f32x4 bz = bz4[g]; f32x4 o;
#pragma unroll
                        for (int e = 0; e < 4; ++e) { const float z = -(acc[mt][4 * g + e] + bz[e]); const float sp = fmaxf(z, 0.f) + __logf(1.0f + __expf(-fabsf(z))); o[e] = -__expf(-sp - 0.5f); }
                        *(f32x4*)(lrow + 8 * g + 4 * h) = o; } }
            } else {
#pragma unroll
                for (int mt = 0; mt < 2; ++mt)
#pragma unroll
                    for (int g = 0; g < 4; ++g) { float v0 = acc[mt][4 * g], v1 = acc[mt][4 * g + 1], v2 = acc[mt][4 * g + 2], v3 = acc[mt][4 * g + 3];
                        if (kind == 1) { const f32x4 bz = bz4[g]; v0 = sigmoidf_(v0 + bz.x); v1 = sigmoidf_(v1 + bz.y); v2 = sigmoidf_(v2 + bz.z); v3 = sigmoidf_(v3 + bz.w); }
                        stage_put4(stg, mt, g, r, h, v0, v1, v2, v3); }
                stage_flush(stg, AGb + (size_t)row0 * 1024 + (kind - 1) * 512 + n0, 1024, lane); } }
        if (l > 0) {
            int tid2 = F.tid; asm volatile("" : "+v"(tid2)); const int lane2 = tid2 & 63, r2 = tid2 & 31, h2 = (tid2 >> 5) & 1;
            __syncthreads();
            const bf16* VS1 = WSP(bf16, WS_VS1); const bf16* VS0 = WSP(bf16, WS_VS0); bf16* VR = WSP(bf16, WS_VR); const float* v0 = INP(I_V0);
            asm volatile("s_waitcnt vmcnt(0)" ::: "memory");
            __builtin_amdgcn_fence(__ATOMIC_ACQUIRE, "agent"); asm volatile("s_waitcnt vmcnt(0)" ::: "memory");
            for (int i = tid2; i < RP * 64; i += NTHREADS) { const int rl = i >> 6, ch = i & 63; *(LAS u32x4*)(VSl + rl * LDA_VS + ch * 16) = *(const u32x4*)(VS1 + (size_t)(row0 + rl) * C5 + ch * 8); }
            __syncthreads();
#pragma unroll 1
            for (int nb = wave; nb < 16; nb += 8) { f32x16 acc[2]; acc[0] = f32x16{}; acc[1] = f32x16{};
                { bf16x8 fv[16]; load_frags<16>(fv, PGW, PGW_VR + 32 * nb, lane2); mma_frags<16>(acc, VSl, LDA_VS, 0, fv, r2, h2); load_frags<16>(fv, PGW, PGW_VR + 32 * nb + 16, lane2); mma_frags<16>(acc, VSl, LDA_VS, 256, fv, r2, h2); }
#pragma unroll
                for (int mt = 0; mt < 2; ++mt) { const int rl = 32 * mt + r2; const size_t row = (size_t)(row0 + rl);
#pragma unroll
                    for (int g = 0; g < 4; ++g) { const int n = 32 * nb + 8 * g + 4 * h2; const f32x4 bz = *(const f32x4*)(v0 + n);
                        const u32x2 sw = *(const LAS u32x2*)(VSl + rl * LDA_VS + n * 2); const u32x2 fw = *(const u32x2*)(VS0 + row * C5 + n);
                        const float s0 = bflo(sw.x), s1 = bfhi(sw.x), s2 = bflo(sw.y), s3 = bfhi(sw.y), f0 = bflo(fw.x), f1 = bfhi(fw.x), f2 = bflo(fw.y), f3 = bfhi(fw.y);
                        stage_put4(stg, mt, g, r2, h2, s0 + (f0 - s0) * sigmoidf_(acc[mt][4 * g] + bz.x), s1 + (f1 - s1) * sigmoidf_(acc[mt][4 * g + 1] + bz.y),
                                   s2 + (f2 - s2) * sigmoidf_(acc[mt][4 * g + 2] + bz.z), s3 + (f3 - s3) * sigmoidf_(acc[mt][4 * g + 3] + bz.w)); } }
                stage_flush(stg, VR + (size_t)row0 * C5 + 32 * nb, C5, lane2); }
        }
    }
    __syncthreads();
}

namespace att {
__device__ __forceinline__ int crow(int r, int hi) { return (r & 3) + 8 * (r >> 2) + 4 * hi; }
constexpr int KSLOT = 12288, VSLOT = 8192;
constexpr int NSLOT = 4;
constexpr int LDS_K = 0, LDS_V = NSLOT * KSLOT, LDS_WS = LDS_V + NSLOT * VSLOT, LDS_OST = LDS_WS + NWAVES * 64 * 4, LDS_TOTAL = LDS_OST + NWAVES * 4096;
__device__ __forceinline__ void glds16(const void* gsrc, unsigned lds_dst) { unsigned keep;
    asm volatile("s_mov_b32 %0, m0\n\ts_mov_b32 m0, %2\n\ts_nop 0\n\tglobal_load_lds_dwordx4 %1, off\n\ts_mov_b32 m0, %0" : "=&s"(keep) : "v"(gsrc), "s"(lds_dst) : "memory"); }
__device__ __forceinline__ float max3f(float a, float b, float c) { return fmaxf(fmaxf(a, b), c); }
#define ATT_WAIT_BAR() asm volatile("s_waitcnt vmcnt(0) lgkmcnt(0)\n\ts_barrier" ::: "memory")
__device__ __forceinline__ float rowmax(const f32x16& p0, const f32x16& p1) {
    float a = max3f(p0[0], p0[1], p1[0]), b = max3f(p0[2], p0[3], p1[1]); a = max3f(a, p1[2], p1[3]);
#pragma unroll
    for (int r = 4; r < 16; r += 4) { a = max3f(a, p0[r], p0[r + 1]); b = max3f(b, p0[r + 2], p0[r + 3]); a = max3f(a, p1[r], p1[r + 1]); b = max3f(b, p1[r + 2], p1[r + 3]); }
    const float m = fmaxf(a, b);
    auto rr = __builtin_amdgcn_permlane32_swap(__float_as_uint(m), __float_as_uint(m), false, false);
    return fmaxf(__uint_as_float(rr[0]), __uint_as_float(rr[1]));
}
__device__ __forceinline__ void pv(f32x16* o, int vb, bf16x8 pa0, bf16x8 pa1, bf16x8 pa2, bf16x8 pa3) {
#pragma unroll
    for (int d0 = 0; d0 < 2; ++d0) { s16x4 lo[4], hi[4];
#pragma unroll
        for (int ks = 0; ks < 4; ++ks) {
            asm volatile("ds_read_b64_tr_b16 %0,%1 offset:%c2" : "=&v"(lo[ks]) : "v"(vb), "i"(d0 * 4096 + ks * 1024) : "memory");
            asm volatile("ds_read_b64_tr_b16 %0,%1 offset:%c2" : "=&v"(hi[ks]) : "v"(vb), "i"(d0 * 4096 + ks * 1024 + 512) : "memory"); }
        asm volatile("s_waitcnt lgkmcnt(0)" ::: "memory"); __builtin_amdgcn_sched_barrier(0);
#define PK(k) (bf16x8){lo[k][0], lo[k][1], lo[k][2], lo[k][3], hi[k][0], hi[k][1], hi[k][2], hi[k][3]}
        o[d0] = __builtin_amdgcn_mfma_f32_32x32x16_bf16(pa0, PK(0), o[d0], 0, 0, 0);
        o[d0] = __builtin_amdgcn_mfma_f32_32x32x16_bf16(pa1, PK(1), o[d0], 0, 0, 0);
        o[d0] = __builtin_amdgcn_mfma_f32_32x32x16_bf16(pa2, PK(2), o[d0], 0, 0, 0);
        o[d0] = __builtin_amdgcn_mfma_f32_32x32x16_bf16(pa3, PK(3), o[d0], 0, 0, 0);
#undef PK
    }
}
__device__ __forceinline__ void attn_unit(int b, int h, int qb, const bf16* Q, const bf16* __restrict__ KKp, const bf16* __restrict__ Vp, bf16* O, char* shm) {
    const int tid = threadIdx.x, lane = tid & 63, r32 = lane & 31, hi = lane >> 5; const int wid = __builtin_amdgcn_readfirstlane(tid >> 6);
    const long rowbase = (long)b * SEQ; const int q0 = qb * 256;
    const bf16* Qw = Q + (rowbase + q0 + wid * 32) * 768 + h * QKD;
    const bf16* Kh = KKp + rowbase * 768 + h * QKD; const bf16* Vh = Vp + rowbase * 512 + h * VD;
    const unsigned lds0 = (unsigned)(uintptr_t)shm;
    float* wsf = (float*)(shm + LDS_WS) + wid * 64;
    const bf16* ksrc0 = Kh + (long)lane * 768 + wid * 8;
    const bf16* ksrc1 = Kh + (long)lane * 768 + (8 + (wid & 3)) * 8;
    const bf16* vsrc = Vh + (long)(16 * (wid & 3) + (lane >> 2)) * 512 + (wid >> 2) * 32 + (lane & 3) * 8;
    const unsigned kdst0 = lds0 + LDS_K + wid * 1024, kdst1 = lds0 + LDS_K + (8 + (wid & 3)) * 1024, vdst = lds0 + LDS_V + wid * 1024;
#define DMA_KV(t, s) do { glds16(ksrc0 + (long)(t) * 64 * 768, (unsigned)__builtin_amdgcn_readfirstlane(kdst0 + (s) * KSLOT)); \
        if (wid < 4) glds16(ksrc1 + (long)(t) * 64 * 768, (unsigned)__builtin_amdgcn_readfirstlane(kdst1 + (s) * KSLOT)); \
        glds16(vsrc + (long)(t) * 64 * 512, (unsigned)__builtin_amdgcn_readfirstlane(vdst + (s) * VSLOT)); } while (0)
    const int vb0 = (int)(lds0 + LDS_V) + ((lane >> 4) & 1) * 32 + (lane & 3) * 8 + (4 * hi + ((lane & 15) >> 2)) * 64;
    const int NT = (q0 + 256) / 64;
    DMA_KV(0, 0); DMA_KV(1, 1);
    bf16x8 qr[6];
#pragma unroll
    for (int d0 = 0; d0 < 6; ++d0) qr[d0] = *reinterpret_cast<const bf16x8*>(&Qw[(long)r32 * 768 + d0 * 16 + hi * 8]);
    float mhat = 0.f, l_reg = 0.f; f32x16 o[2]; o[0] = f32x16{}; o[1] = f32x16{};
    f32x16 negm = f32x16{};
    const int qrel = wid * 32 + r32;
    typedef short v4i16_t __attribute__((ext_vector_type(4)));
    typedef __attribute__((address_space(3))) v4i16_t* lds_v4p;
    int sl_cur = 0, sl_nn = 2, sl_prev = 0;
    const bool late = wid >= 4;
    u32x4 pwp[4]; pwp[0] = pwp[1] = pwp[2] = pwp[3] = (u32x4){0u, 0u, 0u, 0u};
#define ATT_PV(slot, PW) do { s16x4 vlo_[8], vhi_[8]; const int vb_ = vb0 + (slot) * VSLOT; \
        _Pragma("unroll") for (int i = 0; i < 8; ++i) { const int off = (i >> 2) * 4096 + (i & 3) * 1024; \
            vlo_[i] = __builtin_bit_cast(s16x4, __builtin_amdgcn_ds_read_tr16_b64_v4i16((lds_v4p)(vb_ + off))); vhi_[i] = __builtin_bit_cast(s16x4, __builtin_amdgcn_ds_read_tr16_b64_v4i16((lds_v4p)(vb_ + off + 512))); } \
        _Pragma("unroll") for (int i = 0; i < 8; ++i) { const bf16x8 vf = (bf16x8){vlo_[i][0], vlo_[i][1], vlo_[i][2], vlo_[i][3], vhi_[i][0], vhi_[i][1], vhi_[i][2], vhi_[i][3]}; \
            o[i >> 2] = __builtin_amdgcn_mfma_f32_32x32x16_bf16(__builtin_bit_cast(bf16x8, PW[i & 3]), vf, o[i >> 2], 0, 0, 0); } } while (0)
    for (int t = 0; t < NT; ++t) {
        if (t + 1 < NT && t > 0) { if (wid < 4) asm volatile("s_waitcnt vmcnt(3) lgkmcnt(0)\n\ts_barrier" ::: "memory"); else asm volatile("s_waitcnt vmcnt(2) lgkmcnt(0)\n\ts_barrier" ::: "memory"); }
        else ATT_WAIT_BAR();
        if (t + 2 < NT) DMA_KV(t + 2, sl_nn);
        if (late && t > 0) ATT_PV(sl_prev, pwp);
        const char* Kslot = shm + LDS_K + sl_cur * KSLOT;
        f32x16 p0 = negm, p1 = negm;
        { const char* kb = Kslot + hi * 1024 + r32 * 16;
#pragma unroll
          for (int d0 = 0; d0 < 6; ++d0) { const bf16x8 b0 = *reinterpret_cast<const bf16x8*>(kb + d0 * 2048); const bf16x8 b1 = *reinterpret_cast<const bf16x8*>(kb + d0 * 2048 + 512);
              p0 = __builtin_amdgcn_mfma_f32_32x32x16_bf16(b0, qr[d0], p0, 0, 0, 0); p1 = __builtin_amdgcn_mfma_f32_32x32x16_bf16(b1, qr[d0], p1, 0, 0, 0); } }
        const int jb = t - (NT - 4);
        if (jb >= 0) { const int kbase = 64 * jb + 4 * hi;
#pragma unroll
            for (int r = 0; r < 16; ++r) { const int kv = kbase + (r & 3) + 8 * (r >> 2); if (kv > qrel) p0[r] = -INFINITY; if (kv + 32 > qrel) p1[r] = -INFINITY; } }
        const float rm = rowmax(p0, p1);
        bool resc = false;
        if (t == 0 || __any(rm > 8.0f)) {
            const float dl = (t == 0) ? rm : fmaxf(rm, 0.f); mhat += dl;
#pragma unroll
            for (int r = 0; r < 16; ++r) { p0[r] -= dl; p1[r] -= dl; negm[r] = -mhat; }
            const float f = (t == 0) ? 1.0f : __builtin_amdgcn_exp2f(-dl); l_reg *= f; if (hi == 0) wsf[r32] = f; resc = true; }
        float sacc = 0.f;
#pragma unroll
        for (int r = 0; r < 16; ++r) { p0[r] = __builtin_amdgcn_exp2f(p0[r]); p1[r] = __builtin_amdgcn_exp2f(p1[r]); sacc += p0[r] + p1[r]; }
        l_reg += sacc;
        if (resc) { asm volatile("s_waitcnt lgkmcnt(0)" ::: "memory");
#pragma unroll
            for (int r = 0; r < 16; ++r) { const float fr_ = wsf[crow(r, hi)]; o[0][r] *= fr_; o[1][r] *= fr_; } }
        u32x4 pw[4];
        pw[0] = (u32x4){cvtpk_c(p0[0], p0[1]), cvtpk_c(p0[2], p0[3]), cvtpk_c(p0[4], p0[5]), cvtpk_c(p0[6], p0[7])};
        pw[1] = (u32x4){cvtpk_c(p0[8], p0[9]), cvtpk_c(p0[10], p0[11]), cvtpk_c(p0[12], p0[13]), cvtpk_c(p0[14], p0[15])};
        pw[2] = (u32x4){cvtpk_c(p1[0], p1[1]), cvtpk_c(p1[2], p1[3]), cvtpk_c(p1[4], p1[5]), cvtpk_c(p1[6], p1[7])};
        pw[3] = (u32x4){cvtpk_c(p1[8], p1[9]), cvtpk_c(p1[10], p1[11]), cvtpk_c(p1[12], p1[13]), cvtpk_c(p1[14], p1[15])};
        if (!late) ATT_PV(sl_cur, pw);
        else { pwp[0] = pw[0]; pwp[1] = pw[1]; pwp[2] = pw[2]; pwp[3] = pw[3]; }
        sl_prev = sl_cur; sl_cur = (sl_cur == NSLOT - 1) ? 0 : sl_cur + 1; sl_nn = (sl_nn == NSLOT - 1) ? 0 : sl_nn + 1;
    }
    if (late) ATT_PV(sl_prev, pwp);
#undef ATT_PV
    { auto rr = __builtin_amdgcn_permlane32_swap(__float_as_uint(l_reg), __float_as_uint(l_reg), false, false); l_reg = __uint_as_float(rr[0]) + __uint_as_float(rr[1]); }
    if (hi == 0) wsf[32 + r32] = l_reg; asm volatile("s_waitcnt lgkmcnt(0)" ::: "memory");
    float rli[16];
#pragma unroll
    for (int r = 0; r < 16; ++r) rli[r] = __builtin_amdgcn_rcpf(wsf[32 + crow(r, hi)]);
    bf16* Ow = O + (rowbase + q0 + wid * 32) * 512 + h * VD;
    { bf16* stg = (bf16*)(shm + LDS_OST) + wid * 2048;
#pragma unroll
      for (int r = 0; r < 16; ++r) { const int orow = crow(r, hi);
#pragma unroll
          for (int d0 = 0; d0 < 2; ++d0) stg[orow * 64 + d0 * 32 + r32] = (bf16)f2bf(o[d0][r] * rli[r]); }
      asm volatile("s_waitcnt lgkmcnt(0)" ::: "memory");
#pragma unroll
      for (int i = 0; i < 4; ++i) { const int row = i * 8 + (lane >> 3), ch = lane & 7; const u32x4 v = *(const u32x4*)(stg + row * 64 + ch * 8); *(u32x4*)(Ow + (long)row * 512 + ch * 8) = v; } }
    asm volatile("s_waitcnt vmcnt(0) lgkmcnt(0)\n\ts_barrier" ::: "memory");
#undef DMA_KV
}
}

__device__ __forceinline__ void phase_attn(const Params& p, const Frame& F, char* lds_generic, int l) {
    const bf16* Q = WSP(bf16, WS_Q); const bf16* KKp = WSP(bf16, WS_KK); const bf16* Vp = WSP(bf16, WS_V); bf16* O = WSP(bf16, WS_O);
    unsigned* head = (unsigned*)(F.ws + WS_CTL) + CW_ATTQ + l * 64;
    volatile LAS unsigned* MISC = (volatile LAS unsigned*)(F.lds + MISC_OFF);
    for (;;) {
        if (F.tid == 0) MISC[16] = __hip_atomic_fetch_add(head, 1u, RLX_AGENT);
        __syncthreads();
        const unsigned k = MISC[16];
        __syncthreads();
        if (k >= 1024u) break;
        const int qb = 15 - (int)(k >> 6), bh = (int)(k & 63u);
        att::attn_unit(bh >> 3, bh & 7, qb, Q, KKp, Vp, O, lds_generic);
    }
}

namespace rw {
constexpr int RS = 144;
constexpr int SLOT = 64 * RS;
constexpr int S_KT = 0, S_RT = 1, S_BC = 2, S_KC = 3, S_V = 4, S_BH = 5, S_KH = 6, S_GT = 7, S_ABK = 8, S_AKK = 9, S_AKR = 10, S_ABR = 11, S_ABKF = 12;
constexpr int S_TT = S_BC, S_ZT = S_KC, S_NW1T = S_AKK, S_NW2T = S_ABK;
constexpr int TOT_OFF = 13 * SLOT, PL_OFF = TOT_OFF + 8 * 64 * 4;
typedef short v4i16_t __attribute__((ext_vector_type(4)));
__device__ __forceinline__ int crow(int r, int hi) { return (r & 3) + 8 * (r >> 2) + 4 * hi; }
__device__ __forceinline__ bf16x8 frag_d(const LAS unsigned char* M, int row0, int k0, int r, int h) { return *(const LAS bf16x8*)(M + (row0 + r) * RS + (k0 + 8 * h) * 2); }
__device__ __forceinline__ bf16x8 frag_t(const LAS unsigned char* M, int k0, int col0, int lane) {
    const int h = lane >> 5, blk = (lane >> 4) & 1, q = (lane & 15) >> 2, pp = lane & 3;
    const LAS unsigned char* a = M + (k0 + 8 * h + q) * RS + (col0 + 16 * blk + 4 * pp) * 2;
    const v4i16_t lo = __builtin_amdgcn_ds_read_tr16_b64_v4i16((LAS v4i16_t*)a), hi = __builtin_amdgcn_ds_read_tr16_b64_v4i16((LAS v4i16_t*)(a + 4 * RS));
    return (bf16x8){lo[0], lo[1], lo[2], lo[3], hi[0], hi[1], hi[2], hi[3]};
}
__device__ __forceinline__ void store_T(LAS unsigned char* D, int m0, int n0, const f32x16& acc, float sgn, int r, int h) {
#pragma unroll
    for (int g = 0; g < 4; ++g) { u32x2 w; w.x = cvtpk_c(acc[4 * g] * sgn, acc[4 * g + 1] * sgn); w.y = cvtpk_c(acc[4 * g + 2] * sgn, acc[4 * g + 3] * sgn);
        *(LAS u32x2*)(D + (n0 + r) * RS + (m0 + 8 * g + 4 * h) * 2) = w; }
}
#define RW_MMA(acc, A, B) acc = __builtin_amdgcn_mfma_f32_32x32x16_bf16((A), (B), acc, 0, 0, 0)
}

#define LBAR() asm volatile("s_waitcnt lgkmcnt(0)\n\ts_barrier" ::: "memory")
__device__ __forceinline__ void phase_rwkv_r1(const Params& p, const Frame& F, int l) {
    using namespace rw;
    LAS unsigned char* L0 = F.lds;
#define SL(i) (L0 + (i) * SLOT)
    const bf16* RK = WSP(bf16, WS_RK); const float* LWp = WSP(float, WS_LW); const bf16* AGp = WSP(bf16, WS_AG);
    const bf16* Vv = l == 0 ? WSP(bf16, WS_VS0) : WSP(bf16, WS_VR);
    float* CH = WSP(float, WS_CH);
    const float* kkw = INP(I_KK) + (size_t)l * C5; const float* kaw = INP(I_KA) + (size_t)l * C5;
    const int tid0 = F.tid, wave = F.wave;
    const int pt0 = (tid0 >> 6) * 8 + (tid0 & 7), j80 = (tid0 >> 3) & 7;
    LAS float* tot = (LAS float*)(L0 + TOT_OFF); LAS float* PLv = (LAS float*)(L0 + PL_OFF);
    u32x4 g_r, g_k, g_v, g_a; f32x4 g_l0, g_l1;
#define R1_FETCH(uu) do { const int bh_ = (uu) >> 6, cc_ = (uu) & 63; const size_t tok = (size_t)(bh_ >> 3) * SEQ + (size_t)cc_ * 64 + pt0; const int c_ = (bh_ & 7) * 64 + 8 * j80; \
        g_r = *(const u32x4*)(RK + tok * 1024 + c_); g_k = *(const u32x4*)(RK + tok * 1024 + 512 + c_); g_v = *(const u32x4*)(Vv + tok * C5 + c_); \
        g_l0 = *(const f32x4*)(LWp + tok * C5 + c_); g_l1 = *(const f32x4*)(LWp + tok * C5 + c_ + 4); g_a = *(const u32x4*)(AGp + tok * 1024 + c_); } while (0)
    int u = F.vcu;
    if (u < 4096) R1_FETCH(u);
    for (; u < 4096; u += F.G) {
        const int hh = (u >> 6) & 7;
        int tid = tid0; asm volatile("" : "+v"(tid)); const int lane = tid & 63, r = lane & 31, h = lane >> 5, pt = (tid >> 6) * 8 + (tid & 7), j8 = (tid >> 3) & 7;
        {
            const int c = hh * 64 + 8 * j8;
            const f32x4 kk0 = *(const f32x4*)(kkw + c), kk1 = *(const f32x4*)(kkw + c + 4), ka0 = *(const f32x4*)(kaw + c), ka1 = *(const f32x4*)(kaw + c + 4);
            float rr[8], k[8], a[8], x[8], lw[8], kap[8], be[8], kp[8]; float ss = 0.f;
#pragma unroll
            for (int j = 0; j < 4; ++j) { rr[2 * j] = bflo(g_r[j]); rr[2 * j + 1] = bfhi(g_r[j]); k[2 * j] = bflo(g_k[j]); k[2 * j + 1] = bfhi(g_k[j]); }
            *(LAS u32x4*)(SL(S_V) + pt * RS + j8 * 16) = g_v;
#pragma unroll
            for (int j = 0; j < 8; ++j) { a[j] = (j & 1) ? bfhi(g_a[j >> 1]) : bflo(g_a[j >> 1]); lw[j] = j < 4 ? g_l0[j & 3] : g_l1[j & 3]; x[j] = lw[j]; const float q = k[j] * (j < 4 ? kk0[j & 3] : kk1[j & 3]); kap[j] = q; ss += q * q; }
            ss += __shfl_xor(ss, 8); ss += __shfl_xor(ss, 16); ss += __shfl_xor(ss, 32);
            const float inv = 1.0f / fmaxf(sqrtf(ss), 1e-12f);
#pragma unroll
            for (int j = 0; j < 8; ++j) { kap[j] *= inv; be[j] = kap[j] * a[j]; kp[j] = k[j] * (1.0f + (a[j] - 1.0f) * (j < 4 ? ka0[j & 3] : ka1[j & 3])); }
            const int tl = lane & 7;
#pragma unroll
            for (int j = 0; j < 8; ++j) { float y;
                y = __builtin_bit_cast(float, __builtin_amdgcn_update_dpp(0, __builtin_bit_cast(int, x[j]), 0x111, 0xF, 0xF, true)); x[j] += (tl >= 1) ? y : 0.f;
                y = __builtin_bit_cast(float, __builtin_amdgcn_update_dpp(0, __builtin_bit_cast(int, x[j]), 0x112, 0xF, 0xF, true)); x[j] += (tl >= 2) ? y : 0.f;
                y = __builtin_bit_cast(float, __builtin_amdgcn_update_dpp(0, __builtin_bit_cast(int, x[j]), 0x114, 0xF, 0xF, true)); x[j] += (tl >= 4) ? y : 0.f; }
            if (tl == 7) { *(LAS f32x4*)(tot + wave * 64 + 8 * j8) = (f32x4){x[0], x[1], x[2], x[3]}; *(LAS f32x4*)(tot + wave * 64 + 8 * j8 + 4) = (f32x4){x[4], x[5], x[6], x[7]}; }
            LBAR();
            float csL[8];
#pragma unroll
            for (int j = 0; j < 8; ++j) csL[j] = 0.f;
#pragma unroll
            for (int w2 = 0; w2 < 8; ++w2) { const f32x4 t0 = *(const LAS f32x4*)(tot + w2 * 64 + 8 * j8), t1 = *(const LAS f32x4*)(tot + w2 * 64 + 8 * j8 + 4);
#pragma unroll
                for (int j = 0; j < 8; ++j) { const float tv = j < 4 ? t0[j & 3] : t1[j & 3]; csL[j] += tv; if (w2 < wave) x[j] += tv; } }
            if (pt == 0) {
#pragma unroll
                for (int j = 0; j < 8; ++j) PLv[8 * j8 + j] = __expf(csL[j]); }
            float kt[8], rt[8], bc[8], kc[8], bh[8], kh[8];
#pragma unroll
            for (int j = 0; j < 8; ++j) { const float eP = __expf(x[j]), ePm1 = __expf(x[j] - lw[j]), eInv = __expf(-x[j]), eL = __expf(csL[j] - x[j]);
                kt[j] = kap[j] * ePm1; rt[j] = rr[j] * eP; bc[j] = be[j] * eInv; kc[j] = kp[j] * eInv; bh[j] = be[j] * eL; kh[j] = kp[j] * eL; }
#define PK8(v) (u32x4){cvtpk_c(v[0], v[1]), cvtpk_c(v[2], v[3]), cvtpk_c(v[4], v[5]), cvtpk_c(v[6], v[7])}
            *(LAS u32x4*)(SL(S_KT) + pt * RS + j8 * 16) = PK8(kt); *(LAS u32x4*)(SL(S_RT) + pt * RS + j8 * 16) = PK8(rt);
            *(LAS u32x4*)(SL(S_BC) + pt * RS + j8 * 16) = PK8(bc); *(LAS u32x4*)(SL(S_KC) + pt * RS + j8 * 16) = PK8(kc);
            *(LAS u32x4*)(SL(S_BH) + pt * RS + j8 * 16) = PK8(bh); *(LAS u32x4*)(SL(S_KH) + pt * RS + j8 * 16) = PK8(kh);
#undef PK8
        }
        LBAR();
        {
            const int mat = wave >> 1, ti = wave & 1;
            const LAS unsigned char* X = (mat < 2) ? SL(S_KT) : SL(S_RT); const LAS unsigned char* Y = (mat == 0 || mat == 3) ? SL(S_BC) : SL(S_KC);
            LAS unsigned char* Dm = SL(S_ABK + mat);
            const int t = 32 * ti + r;
            bf16x8 xb[4];
#pragma unroll
            for (int kk = 0; kk < 4; ++kk) xb[kk] = frag_d(X, 32 * ti, 16 * kk, r, h);
#pragma unroll
            for (int si = 0; si < 2; ++si) {
                f32x16 acc = f32x16{};
                if (!(ti == 0 && si == 1)) {
#pragma unroll
                    for (int kk = 0; kk < 4; ++kk) RW_MMA(acc, frag_d(Y, 32 * si, 16 * kk, r, h), xb[kk]); }
#pragma unroll
                for (int g = 0; g < 4; ++g) { float v[4];
#pragma unroll
                    for (int e = 0; e < 4; ++e) { const int sidx = 32 * si + 8 * g + 4 * h + e; const bool keep = (mat < 2) ? (sidx < t) : (sidx <= t); v[e] = keep ? acc[4 * g + e] : 0.f; }
                    u32x2 w; w.x = cvtpk_c(v[0], v[1]); w.y = cvtpk_c(v[2], v[3]);
                    *(LAS u32x2*)(Dm + t * RS + (32 * si + 8 * g + 4 * h) * 2) = w;
                    if (mat == 0 && ti == si) *(LAS f32x4*)(SL(S_ABKF) + ti * 4608 + r * 144 + (8 * g + 4 * h) * 4) = (f32x4){v[0], v[1], v[2], v[3]}; }
            }
        }
        LBAR();
        if (wave == 0) {
            const int hb = lane >> 5, c = lane & 31; const LAS unsigned char* Ab = SL(S_ABKF) + hb * 4608;
            float Tc[32];
#pragma unroll
            for (int t = 0; t < 32; ++t) Tc[t] = 0.f;
            f32x4 an[8];
#pragma unroll
            for (int s4 = 0; s4 < 8; ++s4) an[s4] = (f32x4){0.f, 0.f, 0.f, 0.f};
#pragma unroll
            for (int t = 0; t < 32; ++t) { float acc0 = (t == c) ? 1.0f : 0.0f, acc1 = 0.f;
                f32x4 ac[8];
#pragma unroll
                for (int s4 = 0; s4 < 8; ++s4) ac[s4] = an[s4];
                if (t + 1 < 32) {
#pragma unroll
                    for (int s4 = 0; s4 < (t + 4) / 4; ++s4) an[s4] = *(const LAS f32x4*)(Ab + (t + 1) * 144 + s4 * 16); }
#pragma unroll
                for (int s4 = 0; s4 < (t + 3) / 4; ++s4) { const f32x4 a4 = ac[s4];
                    acc0 -= a4.x * Tc[4 * s4]; acc1 -= a4.y * Tc[4 * s4 + 1]; acc0 -= a4.z * Tc[4 * s4 + 2]; acc1 -= a4.w * Tc[4 * s4 + 3]; }
                float acc = acc0 + acc1;
                asm volatile("" : "+v"(acc) :: "memory");
                Tc[t] = acc; }
#pragma unroll
            for (int q = 0; q < 4; ++q) *(LAS u32x4*)(SL(S_TT) + (32 * hb + c) * RS + (32 * hb) * 2 + q * 16) =
                (u32x4){cvtpk_c(Tc[8 * q], Tc[8 * q + 1]), cvtpk_c(Tc[8 * q + 2], Tc[8 * q + 3]), cvtpk_c(Tc[8 * q + 4], Tc[8 * q + 5]), cvtpk_c(Tc[8 * q + 6], Tc[8 * q + 7])};
            { f32x16 acc = f32x16{};
#pragma unroll
              for (int kk = 0; kk < 2; ++kk) RW_MMA(acc, frag_d(SL(S_ABK), 32, 16 * kk, r, h), frag_d(SL(S_TT), 0, 16 * kk, r, h));
              store_T(SL(S_ZT), 0, 0, acc, 1.0f, r, h); }
            { f32x16 acc = f32x16{};
#pragma unroll
              for (int kk = 0; kk < 2; ++kk) RW_MMA(acc, frag_t(SL(S_TT), 32 + 16 * kk, 32, lane), frag_d(SL(S_ZT), 0, 16 * kk, r, h));
              store_T(SL(S_TT), 32, 0, acc, -1.0f, r, h); }
        } else if (wave == 1) {
            const int row = 32 + (lane >> 1), hf = lane & 1;
            *(LAS u32x4*)(SL(S_TT) + row * RS + hf * 32) = (u32x4){0u, 0u, 0u, 0u}; *(LAS u32x4*)(SL(S_TT) + row * RS + hf * 32 + 16) = (u32x4){0u, 0u, 0u, 0u};
        } else if (wave >= 4) {
            const int ti = (wave - 4) >> 1, ii = (wave - 4) & 1; f32x16 acc = f32x16{};
#pragma unroll
            for (int kk = 0; kk < 4; ++kk) RW_MMA(acc, frag_d(SL(S_AKK), 32 * ti, 16 * kk, r, h), frag_t(SL(S_V), 16 * kk, 32 * ii, lane));
            store_T(SL(S_GT), 32 * ti, 32 * ii, acc, 1.0f, r, h);
        }
        LBAR();
        if (u + F.G < 4096) R1_FETCH(u + F.G);
        { const int w4 = wave & 3, ti = w4 >> 1, ci = w4 & 1; f32x16 acc = f32x16{};
          if (wave < 4) {
#pragma unroll
              for (int kk = 0; kk < 4; ++kk) RW_MMA(acc, frag_t(SL(S_TT), 16 * kk, 32 * ti, lane), frag_t(SL(S_KT), 16 * kk, 32 * ci, lane));
              store_T(SL(S_NW1T), 32 * ti, 32 * ci, acc, -1.0f, r, h); }
          else {
#pragma unroll
              for (int kk = 0; kk < 4; ++kk) RW_MMA(acc, frag_t(SL(S_TT), 16 * kk, 32 * ti, lane), frag_d(SL(S_GT), 32 * ci, 16 * kk, r, h));
              store_T(SL(S_NW2T), 32 * ti, 32 * ci, acc, -1.0f, r, h); } }
        LBAR();
        { const int which = wave >> 1, mi = wave & 1; float* dst = CH + ((size_t)u * 4 + which) * 4096;
#pragma unroll
          for (int ni = 0; ni < 2; ++ni) { f32x16 acc = f32x16{};
#pragma unroll
              for (int kk = 0; kk < 4; ++kk) {
                  if (which == 0) RW_MMA(acc, frag_d(SL(S_ABR), 32 * mi, 16 * kk, r, h), frag_d(SL(S_NW1T), 32 * ni, 16 * kk, r, h));
                  else if (which == 1) { RW_MMA(acc, frag_d(SL(S_AKR), 32 * mi, 16 * kk, r, h), frag_t(SL(S_V), 16 * kk, 32 * ni, lane)); RW_MMA(acc, frag_d(SL(S_ABR), 32 * mi, 16 * kk, r, h), frag_d(SL(S_NW2T), 32 * ni, 16 * kk, r, h)); }
                  else if (which == 2) RW_MMA(acc, frag_t(SL(S_BH), 16 * kk, 32 * mi, lane), frag_d(SL(S_NW1T), 32 * ni, 16 * kk, r, h));
                  else { RW_MMA(acc, frag_t(SL(S_KH), 16 * kk, 32 * mi, lane), frag_t(SL(S_V), 16 * kk, 32 * ni, lane)); RW_MMA(acc, frag_t(SL(S_BH), 16 * kk, 32 * mi, lane), frag_d(SL(S_NW2T), 32 * ni, 16 * kk, r, h)); } }
              const int n = 32 * ni + r;
#pragma unroll
              for (int rg = 0; rg < 16; ++rg) { const int m = 32 * mi + crow(rg, h); float v = acc[rg];
                  if (which == 0) v += bf2f(*(const LAS bf16*)(SL(S_RT) + m * RS + n * 2));
                  if (which == 2 && m == n) v += PLv[n];
                  dst[m * 64 + n] = v; } } }
        LBAR();
    }
#undef R1_FETCH
#undef SL
}

__device__ __forceinline__ void phase_rwkv_r2(const Params& p, const Frame& F) {
    const float* CH = WSP(float, WS_CH); float* RO = WSP(float, WS_RO);
    LAS float* stb = (LAS float*)(F.lds);
    constexpr int STB = 4 * 1280;
    const int lane = F.lane, wave = F.wave, q = lane >> 4, li = lane & 15, w4 = wave & 3;
    const int nr2 = F.G >= 4 ? F.G / 4 : 1;
    if (F.vcu >= nr2) return;
    for (int bh = F.vcu; bh < 64; bh += nr2) {
        const int b = bh >> 3, hh = bh & 7;
        __syncthreads();
        for (int i = F.tid; i < 2 * STB; i += NTHREADS) stb[i] = 0.f;
        __syncthreads();
        const int mA = (wave < 4) ? 2 : 0, mC = (wave < 4) ? 3 : 1;
        const float* basec = CH + (size_t)bh * 64 * 4 * 4096;
        f32x4 fa[2][4], fc[2][4];
#define R2_FETCH(cc, st) do { const float* pa = basec + ((size_t)(cc) * 4 + mA) * 4096 + (16 * w4 + li) * 64 + 16 * q; fa[st][0] = *(const f32x4*)(pa); fa[st][1] = *(const f32x4*)(pa + 4); fa[st][2] = *(const f32x4*)(pa + 8); fa[st][3] = *(const f32x4*)(pa + 12); \
            const float* pc = basec + ((size_t)(cc) * 4 + mC) * 4096 + (16 * w4 + 4 * q) * 64 + li; \
            _Pragma("unroll") for (int ct = 0; ct < 4; ++ct) fc[st][ct] = (f32x4){pc[16 * ct], pc[64 + 16 * ct], pc[128 + 16 * ct], pc[192 + 16 * ct]}; } while (0)
        R2_FETCH(0, 0); R2_FETCH(1, 1);
#pragma unroll 1
        for (int c0 = 0; c0 < 64; c0 += 2) {
#pragma unroll
            for (int st = 0; st < 2; ++st) { const int c = c0 + st;
                const f32x4 A0 = fa[st][0], A1 = fa[st][1], A2 = fa[st][2], A3 = fa[st][3];
                f32x4 acc[4];
#pragma unroll
                for (int ct = 0; ct < 4; ++ct) acc[ct] = fc[st][ct];
                if (c + 2 < 64) R2_FETCH(c + 2, st);
#pragma unroll
                for (int ct = 0; ct < 4; ++ct) { const LAS float* sb = stb + (c & 1) * STB + ct * 1280 + lane * 20;
                    const f32x4 b0 = *(const LAS f32x4*)(sb), b1 = *(const LAS f32x4*)(sb + 4), b2 = *(const LAS f32x4*)(sb + 8), b3 = *(const LAS f32x4*)(sb + 12);
#pragma unroll
                    for (int k = 0; k < 4; ++k) acc[ct] = __builtin_amdgcn_mfma_f32_16x16x4f32(A0[k], b0[k], acc[ct], 0, 0, 0);
#pragma unroll
                    for (int k = 0; k < 4; ++k) acc[ct] = __builtin_amdgcn_mfma_f32_16x16x4f32(A1[k], b1[k], acc[ct], 0, 0, 0);
#pragma unroll
                    for (int k = 0; k < 4; ++k) acc[ct] = __builtin_amdgcn_mfma_f32_16x16x4f32(A2[k], b2[k], acc[ct], 0, 0, 0);
#pragma unroll
                    for (int k = 0; k < 4; ++k) acc[ct] = __builtin_amdgcn_mfma_f32_16x16x4f32(A3[k], b3[k], acc[ct], 0, 0, 0); }
                if (wave < 4) {
#pragma unroll
                    for (int ct = 0; ct < 4; ++ct) *(LAS f32x4*)(stb + ((c + 1) & 1) * STB + ct * 1280 + (w4 * 16 + li) * 20 + 4 * q) = acc[ct]; }
                else { float* ro = RO + ((size_t)b * SEQ + (size_t)c * 64 + 16 * w4 + 4 * q) * C5 + hh * 64 + li;
#pragma unroll
                    for (int ct = 0; ct < 4; ++ct) { ro[16 * ct] = acc[ct][0]; ro[C5 + 16 * ct] = acc[ct][1]; ro[2 * C5 + 16 * ct] = acc[ct][2]; ro[3 * C5 + 16 * ct] = acc[ct][3]; } }
                LBAR();
            }
        }
#undef R2_FETCH
    }
    __syncthreads();
}
#undef LBAR

__device__ __forceinline__ void phase_mix(const Params& p, const Frame& F, int l) {
    const int gw = F.vcu * NWAVES + F.wave, NGW = F.G * NWAVES; const int lane = F.lane;
    const bf16* O = WSP(bf16, WS_O); const float* RO = WSP(float, WS_RO); const bf16* RK = WSP(bf16, WS_RK); const bf16* AGp = WSP(bf16, WS_AG);
    const bf16* Vv = l == 0 ? WSP(bf16, WS_VS0) : WSP(bf16, WS_VR); bf16* MIX = WSP(bf16, WS_MIX);
    const float* og = INP(I_MOUTG) + (size_t)l * C5; const float* gng = INP(I_GNG) + (size_t)l * C5; const float* gnb = INP(I_GNB) + (size_t)l * C5;
    const float* kaw = INP(I_KA) + (size_t)l * C5; const float* rkw = INP(I_RK) + (size_t)l * C5;
#pragma unroll 2
    for (int t = gw; t < T; t += NGW) {
        const int c = 8 * lane;
        { const u32x4 ow = *(const u32x4*)(O + (size_t)t * C5 + c); float o[8]; float ss = 0.f;
#pragma unroll
          for (int j = 0; j < 4; ++j) { o[2 * j] = bflo(ow[j]); o[2 * j + 1] = bfhi(ow[j]); ss += o[2 * j] * o[2 * j] + o[2 * j + 1] * o[2 * j + 1]; }
          const float rs = 1.f / sqrtf(wave_sum(ss) * (1.f / C5) + RMS_EPS);
          const f32x4 g0 = *(const f32x4*)(og + c), g1 = *(const f32x4*)(og + c + 4);
          u32x4 w; w.x = pk2(o[0] * rs * g0.x, o[1] * rs * g0.y); w.y = pk2(o[2] * rs * g0.z, o[3] * rs * g0.w); w.z = pk2(o[4] * rs * g1.x, o[5] * rs * g1.y); w.w = pk2(o[6] * rs * g1.z, o[7] * rs * g1.w);
          *(u32x4*)(MIX + (size_t)t * D + c) = w; }
        { const f32x4 r0 = *(const f32x4*)(RO + (size_t)t * C5 + c), r1 = *(const f32x4*)(RO + (size_t)t * C5 + c + 4);
          float o[8]; float s = 0.f;
#pragma unroll
          for (int j = 0; j < 8; ++j) { o[j] = j < 4 ? r0[j & 3] : r1[j & 3]; s += o[j]; }
          s += __shfl_xor(s, 1); s += __shfl_xor(s, 2); s += __shfl_xor(s, 4); const float mean = s * (1.f / 64.f); float q = 0.f;
#pragma unroll
          for (int j = 0; j < 8; ++j) { o[j] -= mean; q += o[j] * o[j]; }
          q += __shfl_xor(q, 1); q += __shfl_xor(q, 2); q += __shfl_xor(q, 4); const float rstd = 1.f / sqrtf(q * (1.f / 64.f) + GN_EPS);
          const u32x4 rw = *(const u32x4*)(RK + (size_t)t * 1024 + c), kw = *(const u32x4*)(RK + (size_t)t * 1024 + 512 + c), vw = *(const u32x4*)(Vv + (size_t)t * C5 + c);
          const u32x4 aw = *(const u32x4*)(AGp + (size_t)t * 1024 + c), gw = *(const u32x4*)(AGp + (size_t)t * 1024 + 512 + c);
          const f32x4 a0 = (f32x4){bflo(aw.x), bfhi(aw.x), bflo(aw.y), bfhi(aw.y)}, a1 = (f32x4){bflo(aw.z), bfhi(aw.z), bflo(aw.w), bfhi(aw.w)};
          const f32x4 g0 = (f32x4){bflo(gw.x), bfhi(gw.x), bflo(gw.y), bfhi(gw.y)}, g1 = (f32x4){bflo(gw.z), bfhi(gw.z), bflo(gw.w), bfhi(gw.w)};
          const f32x4 ka0 = *(const f32x4*)(kaw + c), ka1 = *(const f32x4*)(kaw + c + 4), rk0 = *(const f32x4*)(rkw + c), rk1 = *(const f32x4*)(rkw + c + 4);
          const f32x4 gg0 = *(const f32x4*)(gng + c), gg1 = *(const f32x4*)(gng + c + 4), gb0 = *(const f32x4*)(gnb + c), gb1 = *(const f32x4*)(gnb + c + 4);
          float r[8], k[8], v[8]; float bon = 0.f;
#pragma unroll
          for (int j = 0; j < 4; ++j) { r[2 * j] = bflo(rw[j]); r[2 * j + 1] = bfhi(rw[j]); k[2 * j] = bflo(kw[j]); k[2 * j + 1] = bfhi(kw[j]); v[2 * j] = bflo(vw[j]); v[2 * j + 1] = bfhi(vw[j]); }
#pragma unroll
          for (int j = 0; j < 8; ++j) { const float a = j < 4 ? a0[j & 3] : a1[j & 3]; const float kp = k[j] * (1.0f + (a - 1.0f) * (j < 4 ? ka0[j & 3] : ka1[j & 3])); bon += r[j] * kp * (j < 4 ? rk0[j & 3] : rk1[j & 3]); }
          bon += __shfl_xor(bon, 1); bon += __shfl_xor(bon, 2); bon += __shfl_xor(bon, 4);
          float y[8];
#pragma unroll
          for (int j = 0; j < 8; ++j) { const float gn = o[j] * rstd * (j < 4 ? gg0[j & 3] : gg1[j & 3]) + (j < 4 ? gb0[j & 3] : gb1[j & 3]); y[j] = (gn + bon * v[j]) * (j < 4 ? g0[j & 3] : g1[j & 3]); }
          u32x4 w; w.x = pk2(y[0], y[1]); w.y = pk2(y[2], y[3]); w.z = pk2(y[4], y[5]); w.w = pk2(y[6], y[7]);
          *(u32x4*)(MIX + (size_t)t * D + C5 + c) = w; }
    }
}

#define DPPI(x, ctrl) __builtin_amdgcn_update_dpp(0, (x), (ctrl), 0xF, 0xF, true)
__device__ __forceinline__ float row16_max(float x) {
    x = fmaxf(x, __builtin_bit_cast(float, DPPI(__builtin_bit_cast(int, x), 0xB1))); x = fmaxf(x, __builtin_bit_cast(float, DPPI(__builtin_bit_cast(int, x), 0x4E)));
    x = fmaxf(x, __builtin_bit_cast(float, DPPI(__builtin_bit_cast(int, x), 0x141))); x = fmaxf(x, __builtin_bit_cast(float, DPPI(__builtin_bit_cast(int, x), 0x140))); return x; }
__device__ __forceinline__ int row16_min(int x) {
    x = min(x, DPPI(x, 0xB1)); x = min(x, DPPI(x, 0x4E)); x = min(x, DPPI(x, 0x141)); x = min(x, DPPI(x, 0x140)); return x; }
__device__ __forceinline__ void phase_ln1_route(const Params& p, const Frame& F, int l) {
    LAS unsigned char* wl = F.lds;
    LAS int* hist = (LAS int*)(F.lds + LDSX_OFF + 4096);
    LAS int* basep = hist + 32;
    LAS int* rinfo = hist + 64;
    LAS float* rgate = (LAS float*)(rinfo + 512);
    const float* mod = WSP(float, WS_MOD) + (size_t)l * NBATCH * 6144;
    const float* g1 = INP(I_LN1G) + (size_t)l * D; const float* b1 = INP(I_LN1B) + (size_t)l * D;
    const float* rb = INP(I_RB) + (size_t)l * NE;
    unsigned* cnt = (unsigned*)(F.ws + WS_CTL) + CW_CNT + l * 64;
    int* LIST = WSP(int, WS_LIST); float* GATEL = WSP(float, WS_GATEL); int* TOKSLOT = WSP(int, WS_TOKSLOT);
    bf16* X = WSP(bf16, WS_X); unsigned char* H8 = WSP(unsigned char, WS_H8);
    const int lane = F.lane, li = lane & 15, g = lane >> 4;
    __syncthreads();
    for (int i = F.tid; i < 2 * 4096; i += NTHREADS) { const int part = i >> 12, rem = i & 4095, e = rem >> 7, ch = rem & 127;
        const u32x4 v = *(const u32x4*)(WSP(bf16, WS_RWT) + ((size_t)part * DEPTH + l) * NE * D + (size_t)e * D + ch * 8);
        *(LAS u32x4*)(wl + part * 65536 + e * 2048 + ((ch ^ (e & 15)) << 4)) = v; }
    __syncthreads();
    for (int chunk = F.vcu; chunk < T / 128; chunk += F.G) {
        __syncthreads();
        if (F.tid < 32) hist[F.tid] = 0;
        __syncthreads();
        const int row0 = chunk * 128 + F.wave * 16; const int b = row0 / SEQ;
        float mymean = 0.f, myrstd = 0.f;
#pragma unroll 1
        for (int rr = 0; rr < 16; ++rr) {
            const GAS u32x2* xr = (const GAS u32x2*)(X + (size_t)(row0 + rr) * D) + lane;
            f32x4 v[4]; float s = 0.f;
#pragma unroll
            for (int j = 0; j < 4; ++j) { const u32x2 w = xr[64 * j]; v[j] = (f32x4){bflo(w.x), bfhi(w.x), bflo(w.y), bfhi(w.y)}; s += (v[j].x + v[j].y) + (v[j].z + v[j].w); }
            const float mean = wave_sum(s) * (1.f / D); float s2 = 0.f;
#pragma unroll
            for (int j = 0; j < 4; ++j) { v[j] = v[j] - mean; s2 += (v[j].x * v[j].x + v[j].y * v[j].y) + (v[j].z * v[j].z + v[j].w * v[j].w); }
            const float rstd = __builtin_amdgcn_rsqf(wave_sum(s2) * (1.f / D) + LN_EPS);
            if (li == rr) { mymean = mean; myrstd = rstd; }
        }
        f32x4 acc0 = (f32x4){0.f, 0.f, 0.f, 0.f}, acc1 = acc0;
        bf16* xrow = X + (size_t)(row0 + li) * D + 8 * g; unsigned char* hrow = H8 + (size_t)(row0 + li) * D + 8 * g;
        const float* shp = mod + (size_t)b * 6144 + 3072 + 8 * g; const float* scp = mod + (size_t)b * 6144 + 4096 + 8 * g;
        const LAS unsigned char* w0 = wl + li * 2048; const LAS unsigned char* w1 = wl + (16 + li) * 2048;
#pragma unroll 2
        for (int s = 0; s < 32; ++s) {
            const int k = 32 * s;
            const u32x4 yw = *(const u32x4*)(xrow + k); const f32x4 y0 = (f32x4){bflo(yw.x), bfhi(yw.x), bflo(yw.y), bfhi(yw.y)}, y1 = (f32x4){bflo(yw.z), bfhi(yw.z), bflo(yw.w), bfhi(yw.w)};
            const f32x4 ga0 = *(const f32x4*)(g1 + k + 8 * g), ga1 = *(const f32x4*)(g1 + k + 8 * g + 4), be0 = *(const f32x4*)(b1 + k + 8 * g), be1 = *(const f32x4*)(b1 + k + 8 * g + 4);
            const f32x4 sc0 = *(const f32x4*)(scp + k), sc1 = *(const f32x4*)(scp + k + 4), sh0 = *(const f32x4*)(shp + k), sh1 = *(const f32x4*)(shp + k + 4);
            const f32x4 x0 = (y0 - mymean) * myrstd * ga0 + be0, x1 = (y1 - mymean) * myrstd * ga1 + be1;
            { u32x4 xw; xw.x = cvtpk_c(x0.x, x0.y); xw.y = cvtpk_c(x0.z, x0.w); xw.z = cvtpk_c(x1.x, x1.y); xw.w = cvtpk_c(x1.z, x1.w); *(u32x4*)(xrow + k) = xw; }
            const f32x4 h0 = x0 * (sc0 + 1.0f) + sh0, h1 = x1 * (sc1 + 1.0f) + sh1;
            u32x4 hi; hi.x = cvtpk_c(h0.x, h0.y); hi.y = cvtpk_c(h0.z, h0.w); hi.z = cvtpk_c(h1.x, h1.y); hi.w = cvtpk_c(h1.z, h1.w);
            { u32x2 h8; h8.x = q8x4(h0.x * QS_H, h0.y * QS_H, h0.z * QS_H, h0.w * QS_H); h8.y = q8x4(h1.x * QS_H, h1.y * QS_H, h1.z * QS_H, h1.w * QS_H); *(u32x2*)(hrow + k) = h8; }
            u32x4 lo; lo.x = cvtpk_c(h0.x - bflo(hi.x), h0.y - bfhi(hi.x)); lo.y = cvtpk_c(h0.z - bflo(hi.y), h0.w - bfhi(hi.y)); lo.z = cvtpk_c(h1.x - bflo(hi.z), h1.y - bfhi(hi.z)); lo.w = cvtpk_c(h1.z - bflo(hi.w), h1.w - bfhi(hi.w));
            const int cho = ((4 * s + g) ^ li) << 4;
            const bf16x8 bh0 = *(const LAS bf16x8*)(w0 + cho), bh1 = *(const LAS bf16x8*)(w1 + cho), bl0 = *(const LAS bf16x8*)(w0 + 65536 + cho), bl1 = *(const LAS bf16x8*)(w1 + 65536 + cho);
            const bf16x8 ahi = __builtin_bit_cast(bf16x8, hi), alo = __builtin_bit_cast(bf16x8, lo);
            acc0 = __builtin_amdgcn_mfma_f32_16x16x32_bf16(ahi, bh0, acc0, 0, 0, 0); acc1 = __builtin_amdgcn_mfma_f32_16x16x32_bf16(ahi, bh1, acc1, 0, 0, 0);
            acc0 = __builtin_amdgcn_mfma_f32_16x16x32_bf16(alo, bh0, acc0, 0, 0, 0); acc1 = __builtin_amdgcn_mfma_f32_16x16x32_bf16(alo, bh1, acc1, 0, 0, 0);
            acc0 = __builtin_amdgcn_mfma_f32_16x16x32_bf16(ahi, bl0, acc0, 0, 0, 0); acc1 = __builtin_amdgcn_mfma_f32_16x16x32_bf16(ahi, bl1, acc1, 0, 0, 0);
        }
        const float rb0 = rb[li], rb1 = rb[16 + li];
#pragma unroll
        for (int reg = 0; reg < 4; ++reg) {
            float v0 = acc0[reg] + rb0, v1 = acc1[reg] + rb1;
            float tv0 = 0.f, tv1 = 0.f, tv2 = 0.f, tv3 = 0.f; int te0 = 0, te1 = 0, te2 = 0, te3 = 0;
#pragma unroll
            for (int k = 0; k < 4; ++k) { const float mx = row16_max(fmaxf(v0, v1));
                const int id = (v0 == mx) ? li : ((v1 == mx) ? 16 + li : 99); const int ek = row16_min(id);
                if (k == 0) { tv0 = mx; te0 = ek; } else if (k == 1) { tv1 = mx; te1 = ek; } else if (k == 2) { tv2 = mx; te2 = ek; } else { tv3 = mx; te3 = ek; }
                if (ek == li) v0 = -INFINITY; if (ek == 16 + li) v1 = -INFINITY; }
            const float e1 = __expf(tv1 - tv0), e2 = __expf(tv2 - tv0), e3 = __expf(tv3 - tv0); const float inv = __builtin_amdgcn_rcpf(1.0f + e1 + e2 + e3);
            if (li < 4) { const int lr = F.wave * 16 + 4 * g + reg; const int ek = li == 0 ? te0 : li == 1 ? te1 : li == 2 ? te2 : te3; const float gk = (li == 0 ? 1.0f : li == 1 ? e1 : li == 2 ? e2 : e3) * inv;
                const int lp = __hip_atomic_fetch_add(&hist[ek], 1, __ATOMIC_RELAXED, __HIP_MEMORY_SCOPE_WORKGROUP); rinfo[lr * 4 + li] = (ek << 16) | lp; rgate[lr * 4 + li] = gk; }
        }
        __syncthreads();
        if (F.tid < 32) basep[F.tid] = (int)__hip_atomic_fetch_add(cnt + F.tid, (unsigned)hist[F.tid], RLX_AGENT);
        __syncthreads();
        { const int lr = F.tid >> 2, k = F.tid & 3; const int m = chunk * 128 + lr; const int info = rinfo[F.tid]; const int ek = info >> 16; const int pos = basep[ek] + (info & 0xffff);
          LIST[ek * CAP + pos] = m; GATEL[ek * CAP + pos] = rgate[F.tid]; TOKSLOT[m * 4 + k] = (ek << 16) | pos; }
    }
    __syncthreads();
}

__device__ __forceinline__ void moe_tables(const Frame& F, int l) {
    LAS int* tb = (LAS int*)(F.lds + TB_OFF); LAS int* cn = tb + 40;
    const unsigned* cnt = (const unsigned*)(F.ws + WS_CTL) + CW_CNT + l * 64;
    __syncthreads();
    if (F.tid == 0) { int acc = 0;
        for (int e = 0; e < NE; ++e) { const int c = (int)__hip_atomic_load(cnt + e, RLX_AGENT); cn[e] = c; tb[e] = acc; acc += (c + 255) >> 8; }
        tb[NE] = acc; }
    __syncthreads();
}

__device__ __forceinline__ void phase_combine(const Params& p, const Frame& F, int l) {
    const LAS int* tb = (const LAS int*)(F.lds + TB_OFF);
    const int gw = F.vcu * NWAVES + F.wave, NGW = F.G * NWAVES; const int lane = F.lane;
    const float* mod = WSP(float, WS_MOD) + (size_t)l * NBATCH * 6144; const float* modn = WSP(float, WS_MOD) + (size_t)(l + 1) * NBATCH * 6144;
    const float* g2 = INP(I_LN2G) + (size_t)l * D; const float* b2 = INP(I_LN2B) + (size_t)l * D;
    const bf16* Y = WSP(bf16, WS_Y); const int* TOKSLOT = WSP(int, WS_TOKSLOT);
    const bool lastl = (l == DEPTH - 1);
#pragma unroll 2
    for (int m = gw; m < T; m += NGW) {
        const int b = m / SEQ;
        int srow[4];
#pragma unroll
        for (int k = 0; k < 4; ++k) { const int ts = TOKSLOT[m * 4 + k]; const int e = ts >> 16, pos = ts & 0xffff; srow[k] = tb[e] * 256 + pos; }
        GAS u32x2* xr = (GAS u32x2*)(WSP(bf16, WS_X) + (size_t)m * D) + lane;
        f32x4 v[4]; float s = 0.f;
#pragma unroll
        for (int j = 0; j < 4; ++j) { const int c = 4 * lane + 256 * j; f32x4 y = (f32x4){0.f, 0.f, 0.f, 0.f};
#pragma unroll
            for (int k = 0; k < 4; ++k) { const u32x2 yw = *(const u32x2*)(Y + (size_t)srow[k] * D + c); y.x += bflo(yw.x); y.y += bfhi(yw.x); y.z += bflo(yw.y); y.w += bfhi(yw.y); }
            const f32x4 gt = *(const f32x4*)(mod + (size_t)b * 6144 + 5120 + c) + 1.0f;
            const u32x2 xw = xr[64 * j]; v[j] = (f32x4){bflo(xw.x), bfhi(xw.x), bflo(xw.y), bfhi(xw.y)} * DN_ALPHA + gt * y; s += (v[j].x + v[j].y) + (v[j].z + v[j].w); }
        const float mean = wave_sum(s) * (1.f / D); float s2 = 0.f;
#pragma unroll
        for (int j = 0; j < 4; ++j) { v[j] = v[j] - mean; s2 += (v[j].x * v[j].x + v[j].y * v[j].y) + (v[j].z * v[j].z + v[j].w * v[j].w); }
        const float rstd = 1.f / sqrtf(wave_sum(s2) * (1.f / D) + LN_EPS);
        GAS f32x4* oo = (GAS f32x4*)(p.out + (size_t)m * D) + lane;
        GAS unsigned* ho = (GAS unsigned*)(WSP(unsigned char, WS_H) + (size_t)m * D) + lane;
        f32x4 hq[4]; hq[0] = hq[1] = hq[2] = hq[3] = (f32x4){0.f, 0.f, 0.f, 0.f};
#pragma unroll
        for (int j = 0; j < 4; ++j) { const int c = 4 * lane + 256 * j;
            const f32x4 g = *(const f32x4*)(g2 + c), be = *(const f32x4*)(b2 + c);
            const f32x4 x2 = v[j] * rstd * g + be;
            if (lastl) oo[64 * j] = x2;
            else { { u32x2 xw; xw.x = pk2(x2.x, x2.y); xw.y = pk2(x2.z, x2.w); xr[64 * j] = xw; }
                const f32x4 sh = *(const f32x4*)(modn + (size_t)b * 6144 + c), sc = *(const f32x4*)(modn + (size_t)b * 6144 + 1024 + c);
                hq[j] = x2 * (sc + 1.0f) + sh; } }
        if (!lastl) { float mx = 0.f;
#pragma unroll
            for (int j = 0; j < 4; ++j) mx = fmaxf(mx, fmaxf(fmaxf(fabsf(hq[j].x), fabsf(hq[j].y)), fmaxf(fabsf(hq[j].z), fabsf(hq[j].w))));
#pragma unroll
            for (int o = 1; o < 64; o <<= 1) mx = fmaxf(mx, __shfl_xor(mx, o));
            mx = fmaxf(mx, 1e-20f); const float qsr = 127.0f / mx;
#pragma unroll
            for (int j = 0; j < 4; ++j) ho[64 * j] = q8x4(hq[j].x * qsr, hq[j].y * qsr, hq[j].z * qsr, hq[j].w * qsr);
            if (lane == 0) WSP(float, WS_HS)[m] = mx * (1.0f / 127.0f); }
    }
}

constexpr int PH_PER_LAYER = 11, N_PHASES = 2 + DEPTH * PH_PER_LAYER;
__global__ void __launch_bounds__(NTHREADS, 2) fwd(Params p) {
    extern __shared__ __attribute__((aligned(16))) unsigned char lds[];
    Frame F;
    F.lds = (LAS unsigned char*)lds; F.tid = threadIdx.x; F.lane = F.tid & 63; F.wave = __builtin_amdgcn_readfirstlane(F.tid >> 6);
    F.G = gridDim.x; { const int bx = blockIdx.x; F.vcu = (F.G % 8 == 0) ? (bx % 8) * (F.G / 8) + bx / 8 : bx; }
    F.ws = p.ws;
    volatile LAS unsigned* MISC = (volatile LAS unsigned*)(F.lds + MISC_OFF);
    if (F.tid < 64) MISC[F.tid] = 0u;
    __syncthreads();
    unsigned* ctl = (unsigned*)(p.ws + WS_CTL);
#if MK_ONE_LAUNCH
    XcdBarrier bar = xcd_barrier_post(ctl + CW_BAR, MISC + 8);
#define GRID_BAR() xcd_barrier(bar)
#else
#define GRID_BAR() do {} while (0)
#endif
    const int lo = p.ph_lo, hi = p.ph_hi;
#ifndef PH_MASK
#define PH_MASK 0xFFFFFFFFu
#endif
#define IN(k) (lo <= (k) && (k) < hi)
#define EN(j) ((PH_MASK >> (j)) & 1u)
#define SEAM(k) do { if (IN(k) && IN((k) + 1)) GRID_BAR(); } while (0)
    LAS unsigned char* ring = F.lds;

    if (EN(0) && IN(0)) { for (int rep = 0; rep < REP_PRO; ++rep) phase_prologue(p, F); } SEAM(0);
    if (EN(1) && IN(1)) { phase_ln0(p, F); } SEAM(1);
#define LAYER_BODY \
        constexpr int pb = 2 + l * PH_PER_LAYER; \
        const float* mod = WSP(float, WS_MOD) + (size_t)l * NBATCH * 6144; \
        if (EN(2) && IN(pb + 0)) { \
            pg8::Gemm g{WSP(bf16, WS_H), (const bf16*)(WSP(unsigned char, WS_WINT) + (size_t)l * N_INP * D), T, N_INP, D / 2}; pg8::DenseOrder S; S.init(T, N_INP, F.G, (int)blockIdx.x); \
            pg8::EpiPlainI8 E{WSP(bf16, WS_P), N_INP, 1.0f / QS_WIN, 1440, 1952, WSP(float, WS_HS)}; \
            pg8::gemm_phase<pg8::EpiPlainI8, pg8::DenseOrder, true, true>(ring, g, S, E); \
        } SEAM(pb + 0); \
        if (EN(3) && IN(pb + 1)) { phase_pgemm(p, F, l); } SEAM(pb + 1); \
        if (EN(5) && IN(pb + 3)) { phase_rwkv_r1(p, F, l); } SEAM(pb + 3); \
        if (EN(6) && IN(pb + 4)) { phase_rwkv_r2(p, F); if (l == 0) { const int c0 = F.G / 4, nc = (F.G * 3) / 8; if (F.vcu >= c0 && F.vcu < c0 + nc) phase_convert_experts(p, F, c0, nc); } phase_attn(p, F, (char*)lds, l); } SEAM(pb + 4); \
        if (EN(7) && IN(pb + 5)) { for (int rep = 0; rep < REP_MIX; ++rep) phase_mix(p, F, l); } SEAM(pb + 5); \
        if (EN(8) && IN(pb + 6)) { \
            pg8::Gemm g{WSP(bf16, WS_MIX), WSP(bf16, WS_WOT) + (size_t)l * D * D, T, D, D}; pg8::DenseOrder S; S.init(T, D, F.G, (int)blockIdx.x); \
            pg8::EpiWo E{WSP(bf16, WS_X), mod + 2048}; \
            pg8::gemm_phase<pg8::EpiWo, pg8::DenseOrder, true>(ring, g, S, E); \
        } SEAM(pb + 6); \
        if (EN(9) && IN(pb + 7)) { phase_ln1_route(p, F, l); } SEAM(pb + 7); \
        if (EN(10) && IN(pb + 8)) { \
            moe_tables(F, l); \
            const LAS int* tb = (const LAS int*)(F.lds + TB_OFF); \
            pg8::Gemm g{WSP(bf16, WS_H8), (const bf16*)(WSP(unsigned char, WS_W1T) + (size_t)l * NE * 2048 * D), T, 2048, D / 2};        \
            pg8::MoeOrder<true> S{tb, tb + 40, WSP(int, WS_LIST), 8, F.G, F.vcu, (LAS unsigned*)(F.lds + GT_OFF)}; \
            pg8::EpiSwiglu E{WSP(unsigned char, WS_H1), WSP(float, WS_B1P) + (size_t)l * NE * 2048}; \
            for (int rep = 0; rep < REP_MOE1; ++rep) pg8::gemm_phase<pg8::EpiSwiglu, pg8::MoeOrder<true>, true, true>(ring, g, S, E); \
        } SEAM(pb + 8); \
        if (EN(11) && IN(pb + 9)) { \
            moe_tables(F, l); \
            const LAS int* tb = (const LAS int*)(F.lds + TB_OFF); \
            pg8::Gemm g{WSP(bf16, WS_H1), (const bf16*)(WSP(unsigned char, WS_W2T) + (size_t)l * NE * D * FF), MAXSLOT, D, FF / 2}; \
            pg8::MoeOrder<false> S{tb, tb + 40, nullptr, 4, F.G, F.vcu, nullptr}; \
            pg8::EpiMoeOut E{WSP(bf16, WS_Y), INP(I_EB2) + (size_t)l * NE * D, WSP(float, WS_GATEL), tb}; \
            for (int rep = 0; rep < REP_MOE2; ++rep) pg8::gemm_phase<pg8::EpiMoeOut, pg8::MoeOrder<false>, true, true>(ring, g, S, E); \
        } SEAM(pb + 9); \
        if (EN(12) && IN(pb + 10)) { moe_tables(F, l); phase_combine(p, F, l); } SEAM(pb + 10);
    { constexpr int l = 0; LAYER_BODY }
    { constexpr int l = 1; LAYER_BODY }
#undef LAYER_BODY
#undef IN
#undef SEAM
}

extern "C" void kernel_launch(void* const* d_in, const int* in_sizes, int n_in, void* d_out, int out_size, void* d_ws, size_t ws_size, hipStream_t stream) {
    static int grid = 0;
    if (grid == 0) {
        if (n_in != N_INPUTS || out_size != T * D || ws_size < WS_END) { fprintf(stderr, "kernel_launch: unexpected problem: n_in %d out %d ws %zu\n", n_in, out_size, ws_size); grid = -1; return; }
        int dev = 0, cus = 0, per_cu = 0;
        if (hipGetDevice(&dev) != hipSuccess || hipDeviceGetAttribute(&cus, hipDeviceAttributeMultiprocessorCount, dev) != hipSuccess) { grid = -1; return; }
        if (hipFuncSetAttribute((const void*)fwd, hipFuncAttributeMaxDynamicSharedMemorySize, LDS_BYTES) != hipSuccess) { fprintf(stderr, "kernel_launch: hipFuncSetAttribute failed\n"); grid = -1; return; }
        if (hipOccupancyMaxActiveBlocksPerMultiprocessor(&per_cu, (const void*)fwd, NTHREADS, LDS_BYTES) != hipSuccess || per_cu < 1) fprintf(stderr, "kernel_launch: occupancy query reports %d\n", per_cu);
        (void)hipGetLastError();
        grid = cus;
    }
    if (grid < 0) return;
    if (hipMemsetAsync((char*)d_ws + WS_CTL, 0, CTL_ZERO_BYTES, stream) != hipSuccess) return;
    Params p{};
    for (int i = 0; i < N_INPUTS; ++i) p.in[i] = d_in[i];
    p.out = (float*)d_out; p.ws = (unsigned char*)d_ws;
#if MK_ONE_LAUNCH
    p.ph_lo = 0; p.ph_hi = N_PHASES;
    hipLaunchKernelGGL(fwd, dim3(grid), dim3(NTHREADS), LDS_BYTES, stream, p);
#else
    for (int ph = 0; ph < N_PHASES; ++ph) { p.ph_lo = ph; p.ph_hi = ph + 1; hipLaunchKernelGGL(fwd, dim3(grid), dim3(NTHREADS), LDS_BYTES, stream, p); }
#endif
}
```

```cpp
#include <hip/hip_runtime.h>
#include <cstdio>
#include <cstdint>

#define REP_PRO 1
#define REP_ATTN 1
#define REP_RWKV 1
#define REP_MOE1 1
#define REP_MOE2 1
#define REP_WIN 1
#define REP_PREP 1
#define REP_MIX 1
#ifndef MK_ONE_LAUNCH
#define MK_ONE_LAUNCH 1
#endif

#define GAS __attribute__((address_space(1)))
#define LAS __attribute__((address_space(3)))
typedef unsigned short bf16;
typedef short bf16x8 __attribute__((ext_vector_type(8)));
typedef short s16x4 __attribute__((ext_vector_type(4)));
typedef float f32x2 __attribute__((ext_vector_type(2)));
typedef float f32x4 __attribute__((ext_vector_type(4)));
typedef float f32x16 __attribute__((ext_vector_type(16)));
typedef unsigned u32x2 __attribute__((ext_vector_type(2)));
typedef unsigned u32x4 __attribute__((ext_vector_type(4)));
typedef int i32x4 __attribute__((ext_vector_type(4)));

constexpr int D = 1024, NBATCH = 8, SEQ = 4096, T = NBATCH * SEQ, DEPTH = 2;
constexpr int MLA_IN = 416, RWKV_IN = 1792, N_IN = 2208, N_INP = 2304;
constexpr int QLR = 256, KVLR = 128, ROPE = 32, NOPE = 64, QKD = 96, VD = 64, NH = 8;
constexpr int C5 = 512;
constexpr int NE = 32, TOPK = 4, FF = 1024, CAP = 32768;
constexpr int N_UP = 1792, K_UP = 384, N_SM = 1536, K_SM = 256;
constexpr int MAXSLOT = 139264;
constexpr float DN_ALPHA = 1.4142135623730951f;
constexpr float C2Q = 0.14724444602590306f;
constexpr float LN_EPS = 1e-5f, RMS_EPS = 1e-6f, GN_EPS = 64e-5f;
constexpr int NWAVES = 8, NTHREADS = 512;
constexpr float QS_H = 16.f, QS_W1 = 640.f, QS_U = 16.f, QS_W2 = 1280.f, QS_WIN = 640.f;
constexpr int PGW_Q = 0, PGW_KN = 384, PGW_V = 512, PGW_W = 640, PGW_A = 704, PGW_G = 768, PGW_VR = 896, PGW_NFRAG = 1408;

enum { I_X = 0, I_C, I_POS, I_ELNG, I_ELNB, I_ADAW, I_ADAB, I_WIN, I_QNG, I_WUQ, I_KVNG, I_WUK, I_WUV, I_MOUTG, I_MU, I_W0, I_W2, I_A0, I_A2, I_G2,
       I_KK, I_KA, I_RK, I_GNG, I_GNB, I_V0, I_V1, I_V2, I_WO, I_LN1G, I_LN1B, I_RW, I_RB, I_EW1, I_EB1, I_EW2, I_EB2, I_LN2G, I_LN2B, N_INPUTS };

constexpr size_t MiB = 1u << 20;
constexpr size_t WS_CTL = 0, CTL_ZERO_BYTES = 4 * MiB;
constexpr size_t WS_MOD = 4 * MiB, WS_B1P = 5 * MiB, WS_CS = 6 * MiB, WS_LIST = 10 * MiB, WS_GATEL = 14 * MiB, WS_TOKSLOT = 18 * MiB;
constexpr size_t WS_HS = 18 * MiB + 512 * 1024;
constexpr size_t WS_RWT = 19 * MiB;
constexpr size_t WS_WINT = 20 * MiB, WS_WUPT = 30 * MiB, WS_WSMT = 33 * MiB, WS_WV12T = 35 * MiB, WS_WOT = 36 * MiB, WS_W1T = 40 * MiB, WS_W2T = 296 * MiB;
constexpr size_t WS_X = 424 * MiB, WS_H = 552 * MiB, WS_VS0 = 616 * MiB, WS_VS1 = 648 * MiB;
constexpr size_t WS_P = 680 * MiB, WS_AN = 824 * MiB, WS_A2 = 848 * MiB, WS_RK = 864 * MiB, WS_Q = 928 * MiB, WS_KK = 976 * MiB, WS_V = 1024 * MiB, WS_O = 1056 * MiB;
constexpr size_t WS_WAG = 1088 * MiB, WS_RO = 1280 * MiB, WS_MIX = 1344 * MiB, WS_VR = 1408 * MiB;
constexpr size_t WS_LW = WS_WAG, WS_AG = WS_WAG + 64 * MiB;
constexpr size_t WS_H8 = WS_MIX;
constexpr size_t WS_H1 = 680 * MiB, WS_Y = 952 * MiB;
constexpr size_t WS_CH = 1440 * MiB;
constexpr size_t WS_PGW = 1696 * MiB;
constexpr size_t WS_END = 1700 * MiB;
constexpr int CW_TMO = 0, CW_CODE = 1, CW_BAR = 4096, CW_CNT = 8192, CW_ATTQ = 8448;

constexpr int RING_BYTES = 131072;
constexpr int LDSX_OFF = RING_BYTES;
constexpr int MISC_OFF = LDSX_OFF;
constexpr int TB_OFF = LDSX_OFF + 256;
constexpr int GT_OFF = LDSX_OFF + 1024;
constexpr int LDS_BYTES = 147456;

#define RLX_AGENT __ATOMIC_RELAXED, __HIP_MEMORY_SCOPE_AGENT
#define LDS_WAIT() asm volatile("s_waitcnt lgkmcnt(0)" ::: "memory")
#define VM_WAIT() asm volatile("s_waitcnt vmcnt(0)" ::: "memory")

__device__ __forceinline__ unsigned f2bf(float f) { unsigned u = __builtin_bit_cast(unsigned, f); return (u + 0x7fffu + ((u >> 16) & 1u)) >> 16; }
__device__ __forceinline__ unsigned pk2(float lo, float hi) { return f2bf(lo) | (f2bf(hi) << 16); }
__device__ __forceinline__ float bf2f(unsigned b) { return __builtin_bit_cast(float, b << 16); }
__device__ __forceinline__ float bflo(unsigned w) { return __builtin_bit_cast(float, w << 16); }
__device__ __forceinline__ float bfhi(unsigned w) { return __builtin_bit_cast(float, w & 0xffff0000u); }
__device__ __forceinline__ unsigned cvt_pk_bf16(float lo, float hi) { unsigned r; asm volatile("v_cvt_pk_bf16_f32 %0, %1, %2" : "=v"(r) : "v"(lo), "v"(hi)); return r; }
typedef __bf16 bf16x2_t __attribute__((ext_vector_type(2)));
__device__ __forceinline__ unsigned cvtpk_c(float lo, float hi) { f32x2 v = {lo, hi}; bf16x2_t b = __builtin_convertvector(v, bf16x2_t); return __builtin_bit_cast(unsigned, b); }
__device__ __forceinline__ unsigned q8r(float x) { return __builtin_bit_cast(unsigned, __builtin_amdgcn_fmed3f(x, -127.f, 127.f) + 12582912.f); }
__device__ __forceinline__ unsigned q8x4(float a, float b, float c, float d) { return (q8r(a) & 0xffu) | ((q8r(b) & 0xffu) << 8) | ((q8r(c) & 0xffu) << 16) | (q8r(d) << 24); }
__device__ __forceinline__ float wave_sum(float v) {
#pragma unroll
    for (int o = 1; o < 64; o <<= 1) v += __shfl_xor(v, o);
    return v;
}
__device__ __forceinline__ float sigmoidf_(float x) { return __builtin_amdgcn_rcpf(1.0f + __expf(-x)); }
__device__ __forceinline__ float tanhf_(float x) { return 1.0f - 2.0f * __builtin_amdgcn_rcpf(1.0f + __expf(2.0f * x)); }

#define XB_TMO      128
#define XB_XCNT(j)  (256  + 64 * (j))
#define XB_XSUB(j)  (1280 + 64 * (j))
#define XB_XGEN(j)  (2304 + 64 * (j))
#define XB_TOP      3328
#define XB_TOPGEN   3392
#define XCD_BAR_WORDS 3456
#define XB_SPIN_CAP (1u << 18)
__device__ __forceinline__ unsigned xb_ld(unsigned* p)              { return __hip_atomic_load(p, __ATOMIC_RELAXED, __HIP_MEMORY_SCOPE_AGENT); }
__device__ __forceinline__ unsigned xb_add(unsigned* p, unsigned v) { return __hip_atomic_fetch_add(p, v, __ATOMIC_RELAXED, __HIP_MEMORY_SCOPE_AGENT); }
__device__ __forceinline__ unsigned xb_xcc_id() { return (unsigned)__builtin_amdgcn_s_getreg((3 << 11) | 20) & 0xFu; }
#define XB_SPIN(cond, bar) do { unsigned _sp = 0; while (cond) { __builtin_amdgcn_s_sleep(1); \
    if ((++_sp & 255u) == 0u) { if (xb_ld(&(bar)[XB_TMO])) break; if (_sp > XB_SPIN_CAP) { atomicAdd(&(bar)[XB_TMO], 1u); break; } } } } while (0)
struct XcdBarrier { unsigned* bar; unsigned x; volatile LAS unsigned* st; };
__device__ __forceinline__ XcdBarrier xcd_barrier_post(unsigned* bar, volatile LAS unsigned* st) {
    XcdBarrier b; b.bar = bar; b.x = xb_xcc_id(); b.st = st;
    if (threadIdx.x == 0) (void)xb_add(&bar[XB_XCNT(b.x)], 1u);
    return b;
}
__device__ __forceinline__ void xcd_barrier_complete(unsigned* bar, unsigned x, unsigned& nloc, unsigned& nx) {
    const unsigned G = gridDim.x * gridDim.y * gridDim.z;
    unsigned sum, cnt, mine, sp = 0u;
    for (;;) {
        sum = 0u; cnt = 0u; mine = 0u;
#pragma unroll
        for (unsigned j = 0; j < 16; ++j) { const unsigned c = xb_ld(&bar[XB_XCNT(j)]); sum += c; cnt += (c > 0u) ? 1u : 0u; mine = (j == x) ? c : mine; }
        if (sum == G) break;
        __builtin_amdgcn_s_sleep(1);
        if ((++sp & 255u) == 0u) { if (xb_ld(&bar[XB_TMO])) break; if (sp > XB_SPIN_CAP) { atomicAdd(&bar[XB_TMO], 1u); break; } }
    }
    nloc = mine > 0u ? mine : 1u; nx = cnt > 0u ? cnt : 1u;
}
__device__ __forceinline__ void xcd_barrier(const XcdBarrier& b) {
    asm volatile("s_waitcnt vmcnt(0)" ::: "memory");
    __syncthreads();
    if (threadIdx.x == 0) {
        unsigned* bar = b.bar;
        __builtin_amdgcn_s_waitcnt(0);
        unsigned nloc = b.st[0], nx = b.st[1];
        if (nloc == 0u) { xcd_barrier_complete(bar, b.x, nloc, nx); b.st[0] = nloc; b.st[1] = nx; }
        const unsigned old = xb_add(&bar[XB_XSUB(b.x)], 1u);
        const unsigned gen = old / nloc;
        if (old + 1u == (gen + 1u) * nloc) {
            __builtin_amdgcn_fence(__ATOMIC_RELEASE, "agent");
            asm volatile("s_waitcnt vmcnt(0)" ::: "memory");
            const unsigned og = xb_add(&bar[XB_TOP], 1u);
            const unsigned tg = og / nx;
            if (og + 1u == (tg + 1u) * nx) xb_add(&bar[XB_TOPGEN], 1u);
            else XB_SPIN(xb_ld(&bar[XB_TOPGEN]) == tg, bar);
            __builtin_amdgcn_fence(__ATOMIC_ACQUIRE, "agent");
            xb_add(&bar[XB_XGEN(b.x)], 1u);
            asm volatile("s_waitcnt vmcnt(0)" ::: "memory");
        } else {
            XB_SPIN(xb_ld(&bar[XB_XGEN(b.x)]) == gen, bar);
            __builtin_amdgcn_fence(__ATOMIC_ACQUIRE, "agent");
            asm volatile("s_waitcnt vmcnt(0)" ::: "memory");
        }
    }
    __syncthreads();
}

namespace pg8 {
constexpr int BM = 256, BK = 64, HALF = 128, HTB = HALF * BK * 2, STAGE_BYTES = 8 * HTB, NXCD = 8, WGM = 8;
__device__ __forceinline__ int lds_byte(int r, int c) { const int st = (r >> 4) * 2 + (c >> 5), rr = r & 15, cc = c & 31, ob = rr * 64 + cc * 2; return st * 1024 + (ob ^ (((ob >> 9) & 1) << 5)); }
__device__ __forceinline__ void stage_rc(int b, int& R, int& C) { const int st = b / 1024, sb = b % 1024, swz = sb ^ (((sb >> 9) & 1) << 5); R = (st >> 1) * 16 + swz / 64; C = (st & 1) * 32 + (swz % 64) / 2; }
__device__ __forceinline__ int perm32(int rho) { const int n = rho >> 4, i = rho & 15; return 8 * (i >> 2) + 4 * n + (i & 3); }

struct Unit { int pm, pn, e; };
struct Gemm { const bf16* A; const bf16* Bt; int M, N, K; };

struct DenseOrder {
    int nM, nN, nwg, G, c;
    __device__ __forceinline__ void init(int M, int N, int G_, int c_) { nM = M / BM; nN = N / BM; nwg = nM * nN; G = G_; c = c_; }
    __device__ __forceinline__ bool next(int i, Unit& u) const {
        const long L = (long)i * G + c; if (L >= nwg) return false;
        int wgid = (int)L; { const int q = nwg / NXCD, r = nwg % NXCD, xcd = wgid % NXCD, off = wgid / NXCD; wgid = (xcd < r ? xcd * (q + 1) : r * (q + 1) + (xcd - r) * q) + off; }
        const int nig = WGM * nN, gid = wgid / nig, fm = gid * WGM, gsz = (nM - fm) < WGM ? (nM - fm) : WGM;
        u.pm = fm + ((wgid % nig) % gsz); u.pn = (wgid % nig) / gsz; u.e = 0; return true;
    }
    static constexpr bool GATHER = false;
    __device__ __forceinline__ size_t b_off(const Unit& u, int N, int K) const { return (size_t)u.pn * BM * K * 2; }
    __device__ __forceinline__ unsigned a_row_off(const Unit& u, int row, int K) const { return 0u; }
    __device__ __forceinline__ LAS unsigned* gtab() const { return nullptr; }
};
template <bool GATHER_> struct MoeOrder {
    static constexpr bool GATHER = GATHER_;
    const LAS int* tb; const LAS int* cnt; const int* list; int nN, G, c; LAS unsigned* gt_;
    __device__ __forceinline__ LAS unsigned* gtab() const { return gt_; }
    __device__ __forceinline__ bool next(int i, Unit& u) const {
        const int L = i * G + c; const int total = tb[NE] * nN; if (L >= total) return false;
        int e = 0;
#pragma unroll 1
        for (int j = 1; j < NE; ++j) if (tb[j] * nN <= L) e = j;
        const int Lr = L - tb[e] * nN, nte = tb[e + 1] - tb[e];
        const int mblk = Lr / (4 * nN), m0 = mblk * 4, gsz = (nte - m0) < 4 ? (nte - m0) : 4, rem = Lr - mblk * 4 * nN;
        u.e = e; u.pn = rem / gsz; u.pm = tb[e] + m0 + (rem % gsz); return true;
    }
    __device__ __forceinline__ size_t b_off(const Unit& u, int N, int K) const { return ((size_t)u.e * N + (size_t)u.pn * BM) * K * 2; }
    __device__ __forceinline__ unsigned a_row_off(const Unit& u, int row, int K) const {
        const int pos = (u.pm - tb[u.e]) * BM + row; const int tok = pos < cnt[u.e] ? list[u.e * CAP + pos] : 0; return (unsigned)tok * (unsigned)(K * 2);
    }
};

template <class Epi, class Sched, bool ALIGN_EPI, bool I8 = false>
__device__ __forceinline__ void gemm_phase(LAS unsigned char* lds, const Gemm g, const Sched& S, const Epi& E) {
    const int tid = threadIdx.x, wid = __builtin_amdgcn_readfirstlane(tid >> 6), lane = tid & 63, wr = wid >> 2, wc = wid & 3, fr = lane & 15, fq = lane >> 4;
    const int K = g.K, nt = K / BK;
    int RA[2]; unsigned CA[2], voffA[2], voffB[2];
#pragma unroll
    for (int i = 0; i < 2; ++i) { int R, C; stage_rc(tid * 16 + i * 8192, R, C); const int Rb = Epi::PERM ? ((R & ~31) + perm32(R & 31)) : R;
        RA[i] = R; CA[i] = (unsigned)C * 2u; voffA[i] = (unsigned)(R * K + C) * 2u; voffB[i] = (unsigned)(Rb * K + C) * 2u; }
    const size_t kstep = (size_t)(BK * 2);
    const size_t hstep = (size_t)HALF * K * 2;
    const size_t tstep = 2 * hstep;
    const unsigned ldsw = (unsigned)wid * 1024u;
    const int aoff = lds_byte(wr * 64 + fr, fq * 8), boff = lds_byte(wc * 32 + fr, fq * 8);
    const char* Abase = (const char*)g.A;
    LAS unsigned* gtb = S.gtab();
#define PG8_SA(b, h) (((b) * 2 + (h)) * HTB)
#define PG8_SB(b, h) ((4 + (b) * 2 + (h)) * HTB)
#define PG8_STAGE(bufoff, gbase, voff) do { _Pragma("unroll") for (int _i = 0; _i < 2; ++_i) \
        __builtin_amdgcn_global_load_lds((const unsigned*)((const char*)(gbase) + (voff)[_i]), (LAS unsigned*)(lds + (bufoff) + ldsw + _i * 8192), 16, 0, 0); } while (0)
#define PG8_STAGEA(bufoff, h, kb, nx) do { \
        if constexpr (Sched::GATHER) { const LAS unsigned* tp_ = gtb + ((nx) ? tnx : tcu) + (h) * HALF; const unsigned o0_ = tp_[RA[0]] + CA[0], o1_ = tp_[RA[1]] + CA[1]; \
            __builtin_amdgcn_global_load_lds((const unsigned*)(Abase + (size_t)(kb) + o0_), (LAS unsigned*)(lds + (bufoff) + ldsw), 16, 0, 0); \
            __builtin_amdgcn_global_load_lds((const unsigned*)(Abase + (size_t)(kb) + o1_), (LAS unsigned*)(lds + (bufoff) + ldsw + 8192), 16, 0, 0); } \
        else { const char* gb_ = ((nx) ? nA : cA) + (size_t)(h) * hstep + (size_t)(kb); PG8_STAGE(bufoff, gb_, voffA); } } while (0)
#define PG8_LDA(dst, b, h) do { _Pragma("unroll") for (int m = 0; m < 4; ++m) _Pragma("unroll") for (int k = 0; k < 2; ++k) dst[m][k] = *(const LAS bf16x8*)(lds + PG8_SA(b, h) + aoff + m * 2048 + k * 1024); } while (0)
#define PG8_LDB(dst, b, h) do { _Pragma("unroll") for (int n = 0; n < 2; ++n) _Pragma("unroll") for (int k = 0; k < 2; ++k) dst[n][k] = *(const LAS bf16x8*)(lds + PG8_SB(b, h) + boff + n * 2048 + k * 1024); } while (0)
#define PG8_MMA(ai, bj, At, Bt) do { __builtin_amdgcn_s_setprio(1); _Pragma("unroll") for (int m = 0; m < 4; ++m) _Pragma("unroll") for (int n = 0; n < 2; ++n) _Pragma("unroll") for (int k = 0; k < 2; ++k) { \
        if constexpr (I8) acc[ai][bj][m][n] = __builtin_bit_cast(f32x4, __builtin_amdgcn_mfma_i32_16x16x64_i8(__builtin_bit_cast(i32x4, Bt[n][k]), __builtin_bit_cast(i32x4, At[m][k]), __builtin_bit_cast(i32x4, acc[ai][bj][m][n]), 0, 0, 0)); \
        else acc[ai][bj][m][n] = __builtin_amdgcn_mfma_f32_16x16x32_bf16(Bt[n][k], At[m][k], acc[ai][bj][m][n], 0, 0, 0); } __builtin_amdgcn_s_setprio(0); } while (0)
#define PG8_WAIT_V(n) asm volatile("s_waitcnt vmcnt(" #n ")" ::: "memory")
#define PG8_WAIT_L(n) asm volatile("s_waitcnt lgkmcnt(" #n ")" ::: "memory")
#define PG8_BAR __builtin_amdgcn_s_barrier()
#define PG8_SCHED __builtin_amdgcn_sched_barrier(0)
    Unit cur, nxt; int ui = 0;
    if (!S.next(0, cur)) return;
    f32x4 acc[2][2][4][2];
#pragma unroll
    for (int a = 0; a < 2; ++a)
#pragma unroll
        for (int b = 0; b < 2; ++b)
#pragma unroll
            for (int m = 0; m < 4; ++m)
#pragma unroll
                for (int n = 0; n < 2; ++n) acc[a][b][m][n] = (f32x4){0.f, 0.f, 0.f, 0.f};
    bf16x8 At[4][2], B0[2][2], B1[2][2];
    const char* cA = Abase + (size_t)cur.pm * tstep; const char* cB = (const char*)g.Bt + S.b_off(cur, g.N, K);
    const char* nA = cA; const char* nB = cB;
    int tcu = 0, tnx = 0; unsigned nxt_off = 0u;
    if constexpr (Sched::GATHER) {
        if (tid < BM) gtb[tid] = S.a_row_off(cur, tid, K);
        asm volatile("s_waitcnt vmcnt(0) lgkmcnt(0)" ::: "memory"); PG8_BAR; asm volatile("" ::: "memory");
    }
    PG8_STAGE(PG8_SB(0, 0), cB, voffB); PG8_STAGE(PG8_SB(0, 1), cB + hstep, voffB); PG8_STAGEA(PG8_SA(0, 0), 0, 0, false); PG8_STAGEA(PG8_SA(0, 1), 1, 0, false);
    if (wr == 1) PG8_BAR;
    PG8_WAIT_V(2); PG8_BAR;
    PG8_STAGE(PG8_SB(1, 0), cB + kstep, voffB); PG8_STAGEA(PG8_SA(1, 0), 0, kstep, false); PG8_STAGE(PG8_SB(1, 1), cB + hstep + kstep, voffB);
    PG8_WAIT_V(6); PG8_BAR;
    for (;;) {
        const bool has_next = S.next(ui + 1, nxt);
        nA = cA; nB = cB; tnx = tcu;
        if (has_next) { nA = Abase + (size_t)nxt.pm * tstep; nB = (const char*)g.Bt + S.b_off(nxt, g.N, K);
            if constexpr (Sched::GATHER) { tnx = tcu ^ BM; if (tid < BM) nxt_off = S.a_row_off(nxt, tid, K); } }
#pragma unroll 1
        for (int t = 0; t < nt; t += 2) {
            const bool last = (t == nt - 2);
            if constexpr (Sched::GATHER) { if (t == 2 && has_next && tid < BM) gtb[tnx + tid] = nxt_off; }
            const size_t k1 = (size_t)(t + 1) * kstep;
            const size_t k2 = last ? 0 : (size_t)(t + 2) * kstep, k3 = k2 + kstep;
            const char* b2 = last ? nB : cB + (size_t)(t + 2) * kstep; const char* b3 = b2 + kstep;
            PG8_LDB(B0, 0, 0); PG8_LDB(B1, 0, 1); PG8_SCHED; PG8_LDA(At, 0, 0); PG8_STAGEA(PG8_SA(1, 1), 1, k1, false);
            PG8_WAIT_V(8); PG8_WAIT_L(0); PG8_BAR; PG8_MMA(0, 0, At, B0); PG8_MMA(0, 1, At, B1); PG8_BAR; PG8_SCHED;
            PG8_LDA(At, 0, 1); PG8_STAGE(PG8_SB(0, 0), b2, voffB); PG8_STAGE(PG8_SB(0, 1), b2 + hstep, voffB); PG8_STAGEA(PG8_SA(0, 0), 0, k2, last);
            PG8_WAIT_V(8); PG8_WAIT_L(0); PG8_BAR; PG8_MMA(1, 0, At, B0); PG8_MMA(1, 1, At, B1); PG8_BAR; PG8_SCHED;
            PG8_LDB(B0, 1, 0); PG8_LDB(B1, 1, 1); PG8_SCHED; PG8_LDA(At, 1, 0); PG8_STAGEA(PG8_SA(0, 1), 1, k2, last);
            PG8_WAIT_V(8); PG8_WAIT_L(0); PG8_BAR; PG8_MMA(0, 0, At, B0); PG8_MMA(0, 1, At, B1); PG8_BAR; PG8_SCHED;
            PG8_LDA(At, 1, 1); PG8_STAGE(PG8_SB(1, 0), b3, voffB); PG8_STAGE(PG8_SB(1, 1), b3 + hstep, voffB); PG8_STAGEA(PG8_SA(1, 0), 0, k3, last);
            PG8_WAIT_V(8); PG8_WAIT_L(0); PG8_BAR; PG8_MMA(1, 0, At, B0); PG8_MMA(1, 1, At, B1); PG8_BAR; PG8_SCHED;
        }
        if constexpr (ALIGN_EPI) { if (wr == 0) PG8_BAR; }
        E(acc, cur, wr, wc, fr, fq);
        if (!has_next) break;
#pragma unroll
        for (int a = 0; a < 2; ++a)
#pragma unroll
            for (int b = 0; b < 2; ++b)
#pragma unroll
                for (int m = 0; m < 4; ++m)
#pragma unroll
                    for (int n = 0; n < 2; ++n) acc[a][b][m][n] = (f32x4){0.f, 0.f, 0.f, 0.f};
        cur = nxt; cA = nA; cB = nB; tcu = tnx; ++ui;
        if constexpr (ALIGN_EPI) { if (wr == 1) PG8_BAR; }
    }
    PG8_WAIT_V(0);
    if constexpr (!ALIGN_EPI) { if (wr == 0) PG8_BAR; }
    PG8_BAR;
#undef PG8_SA
#undef PG8_SB
#undef PG8_STAGE
#undef PG8_STAGEA
#undef PG8_LDA
#undef PG8_LDB
#undef PG8_MMA
#undef PG8_WAIT_V
#undef PG8_WAIT_L
#undef PG8_BAR
#undef PG8_SCHED
}

struct EpiBf16Plain {
    static constexpr bool PERM = true;
    bf16* O; int ldc;
    __device__ __forceinline__ void operator()(const f32x4 (&acc)[2][2][4][2], const Unit& u, int wr, int wc, int fr, int fq) const {
        const int row0 = u.pm * BM + wr * 64 + fr, col0 = u.pn * BM + wc * 32 + 8 * fq;
#pragma unroll
        for (int ai = 0; ai < 2; ++ai)
#pragma unroll
            for (int m = 0; m < 4; ++m) { bf16* rowp = O + (size_t)(row0 + ai * HALF + m * 16) * ldc + col0;
#pragma unroll
                for (int bj = 0; bj < 2; ++bj) { const f32x4 v0 = acc[ai][bj][m][0], v1 = acc[ai][bj][m][1];
                    u32x4 w; w.x = cvt_pk_bf16(v0[0], v0[1]); w.y = cvt_pk_bf16(v0[2], v0[3]); w.z = cvt_pk_bf16(v1[0], v1[1]); w.w = cvt_pk_bf16(v1[2], v1[3]);
                    *(u32x4*)(rowp + bj * HALF) = w; } }
    }
};
struct EpiPlainI8 {
    static constexpr bool PERM = true;
    bf16* O; int ldc; float inv; int v0, v1; const float* rs;
    __device__ __forceinline__ void operator()(const f32x4 (&acc)[2][2][4][2], const Unit& u, int wr, int wc, int fr, int fq) const {
        const int row0 = u.pm * BM + wr * 64 + fr, col0 = u.pn * BM + wc * 32 + 8 * fq;
        float rsc[2][4];
#pragma unroll
        for (int ai = 0; ai < 2; ++ai)
#pragma unroll
            for (int m = 0; m < 4; ++m) rsc[ai][m] = rs[row0 + ai * HALF + m * 16];
#pragma unroll
        for (int bj = 0; bj < 2; ++bj) { const int c = col0 + bj * HALF; const float scc = (c >= v0 && c < v1) ? inv * 0.5f : inv;
#pragma unroll
            for (int ai = 0; ai < 2; ++ai)
#pragma unroll
                for (int m = 0; m < 4; ++m) { const i32x4 i0 = __builtin_bit_cast(i32x4, acc[ai][bj][m][0]), i1 = __builtin_bit_cast(i32x4, acc[ai][bj][m][1]); const float sc = scc * rsc[ai][m];
                    u32x4 w; w.x = cvt_pk_bf16((float)i0[0] * sc, (float)i0[1] * sc); w.y = cvt_pk_bf16((float)i0[2] * sc, (float)i0[3] * sc); w.z = cvt_pk_bf16((float)i1[0] * sc, (float)i1[1] * sc); w.w = cvt_pk_bf16((float)i1[2] * sc, (float)i1[3] * sc);
                    *(u32x4*)(O + (size_t)(row0 + ai * HALF + m * 16) * ldc + c) = w; } }
    }
};
struct EpiMlaUp {
    static constexpr bool PERM = true;
    bf16* Q; bf16* KK; bf16* V; const float* cs;
    __device__ __forceinline__ void operator()(const f32x4 (&acc)[2][2][4][2], const Unit& u, int wr, int wc, int fr, int fq) const {
        const int row0 = u.pm * BM + wr * 64 + fr;
#pragma unroll
        for (int bj = 0; bj < 2; ++bj) {
            const int c0 = u.pn * BM + bj * HALF + wc * 32 + 8 * fq;
            if (u.pn < 3) {
                const int h = c0 / QKD, d = c0 - h * QKD;
                const bool rope = d >= NOPE; const int i0 = rope ? (d - NOPE) >> 1 : 0;
#pragma unroll
                for (int ai = 0; ai < 2; ++ai)
#pragma unroll
                    for (int m = 0; m < 4; ++m) { const int row = row0 + ai * HALF + m * 16;
                        f32x4 v0 = acc[ai][bj][m][0], v1 = acc[ai][bj][m][1];
                        if (rope) { const f32x4 cA = *(const f32x4*)(cs + (size_t)row * 32 + i0 * 2), cB = *(const f32x4*)(cs + (size_t)row * 32 + i0 * 2 + 4);
                            const f32x4 a = v0, b = v1;
                            v0[0] = a[0] * cA[0] - a[1] * cA[1]; v0[1] = a[0] * cA[1] + a[1] * cA[0]; v0[2] = a[2] * cA[2] - a[3] * cA[3]; v0[3] = a[2] * cA[3] + a[3] * cA[2];
                            v1[0] = b[0] * cB[0] - b[1] * cB[1]; v1[1] = b[0] * cB[1] + b[1] * cB[0]; v1[2] = b[2] * cB[2] - b[3] * cB[3]; v1[3] = b[2] * cB[3] + b[3] * cB[2]; }
                        v0 = v0 * C2Q; v1 = v1 * C2Q;
                        u32x4 w; w.x = cvt_pk_bf16(v0[0], v0[1]); w.y = cvt_pk_bf16(v0[2], v0[3]); w.z = cvt_pk_bf16(v1[0], v1[1]); w.w = cvt_pk_bf16(v1[2], v1[3]);
                        *(u32x4*)(Q + (size_t)row * 768 + c0) = w; asm volatile("" ::: "memory"); }
            } else {
                bf16* base; int ld, cc;
                if (u.pn < 5) { const int c1 = c0 - 768; const int h = c1 >> 6, d = c1 & 63; base = KK; ld = 768; cc = h * QKD + d; }
                else { base = V; ld = 512; cc = c0 - 1280; }
#pragma unroll
                for (int ai = 0; ai < 2; ++ai)
#pragma unroll
                    for (int m = 0; m < 4; ++m) { const int row = row0 + ai * HALF + m * 16; const f32x4 v0 = acc[ai][bj][m][0], v1 = acc[ai][bj][m][1];
                        u32x4 w; w.x = cvt_pk_bf16(v0[0], v0[1]); w.y = cvt_pk_bf16(v0[2], v0[3]); w.z = cvt_pk_bf16(v1[0], v1[1]); w.w = cvt_pk_bf16(v1[2], v1[3]);
                        *(u32x4*)(base + (size_t)row * ld + cc) = w; asm volatile("" ::: "memory"); }
            }
        }
    }
};
struct EpiRwkvSmall {
    static constexpr bool PERM = false;
    float* O; const float* w0; const float* a0;
    __device__ __forceinline__ void operator()(const f32x4 (&acc)[2][2][4][2], const Unit& u, int wr, int wc, int fr, int fq) const {
        const int row0 = u.pm * BM + wr * 64 + fr, col0 = u.pn * BM + wc * 32 + 4 * fq;
        const int kind = u.pn >> 1;
#pragma unroll
        for (int bj = 0; bj < 2; ++bj)
#pragma unroll
            for (int n = 0; n < 2; ++n) { const int c = col0 + bj * HALF + n * 16;
                f32x4 bv = (f32x4){0.f, 0.f, 0.f, 0.f};
                if (kind == 0) bv = *(const f32x4*)(w0 + c); else if (kind == 1) bv = *(const f32x4*)(a0 + (c - 512));
#pragma unroll
                for (int ai = 0; ai < 2; ++ai)
#pragma unroll
                    for (int m = 0; m < 4; ++m) { f32x4 v = acc[ai][bj][m][n] + bv;
                        if (kind == 0) {
#pragma unroll
                            for (int j = 0; j < 4; ++j) { const float z = -v[j]; const float sp = fmaxf(z, 0.f) + __logf(1.0f + __expf(-fabsf(z))); const float w = -sp - 0.5f; v[j] = -__expf(w); }
                        } else if (kind == 1) {
#pragma unroll
                            for (int j = 0; j < 4; ++j) v[j] = sigmoidf_(v[j]);
                        }
                        *(f32x4*)(O + (size_t)(row0 + ai * HALF + m * 16) * N_SM + c) = v; asm volatile("" ::: "memory"); } }
    }
};
struct EpiVres {
    static constexpr bool PERM = true;
    const bf16* vs; const bf16* vf; bf16* vr; const float* v0;
    __device__ __forceinline__ void operator()(const f32x4 (&acc)[2][2][4][2], const Unit& u, int wr, int wc, int fr, int fq) const {
        const int row0 = u.pm * BM + wr * 64 + fr, col0 = u.pn * BM + wc * 32 + 8 * fq;
#pragma unroll
        for (int bj = 0; bj < 2; ++bj) { const int c = col0 + bj * HALF;
            const f32x4 b0 = *(const f32x4*)(v0 + c), b1 = *(const f32x4*)(v0 + c + 4);
#pragma unroll
            for (int ai = 0; ai < 2; ++ai)
#pragma unroll
                for (int m = 0; m < 4; ++m) { const size_t off = (size_t)(row0 + ai * HALF + m * 16) * C5 + c;
                    const u32x4 s = *(const u32x4*)(vs + off), f = *(const u32x4*)(vf + off);
                    const f32x4 g0 = acc[ai][bj][m][0] + b0, g1 = acc[ai][bj][m][1] + b1;
                    float o[8];
#pragma unroll
                    for (int j = 0; j < 4; ++j) { const float sl = bflo(s[j]), sh = bfhi(s[j]), fl = bflo(f[j]), fh = bfhi(f[j]);
                        const float ga = (j < 2) ? g0[2 * j] : g1[2 * j - 4], gb = (j < 2) ? g0[2 * j + 1] : g1[2 * j - 3];
                        o[2 * j] = sl + (fl - sl) * sigmoidf_(ga); o[2 * j + 1] = sh + (fh - sh) * sigmoidf_(gb); }
                    u32x4 w; w.x = cvt_pk_bf16(o[0], o[1]); w.y = cvt_pk_bf16(o[2], o[3]); w.z = cvt_pk_bf16(o[4], o[5]); w.w = cvt_pk_bf16(o[6], o[7]);
                    *(u32x4*)(vr + off) = w; } }
    }
};
struct EpiWo {
    static constexpr bool PERM = true;
    bf16* X; const float* gt;
    __device__ __forceinline__ void operator()(const f32x4 (&acc)[2][2][4][2], const Unit& u, int wr, int wc, int fr, int fq) const {
        const int row0 = u.pm * BM + wr * 64 + fr, col0 = u.pn * BM + wc * 32 + 8 * fq;
        const int b = (u.pm * BM) / SEQ;
#pragma unroll
        for (int bj = 0; bj < 2; ++bj) { const int c = col0 + bj * HALF;
            const f32x4 g0 = *(const f32x4*)(gt + (size_t)b * 6144 + c) + 1.0f, g1 = *(const f32x4*)(gt + (size_t)b * 6144 + c + 4) + 1.0f;
#pragma unroll
            for (int ai = 0; ai < 2; ++ai)
#pragma unroll
                for (int m = 0; m < 4; ++m) { bf16* px = X + (size_t)(row0 + ai * HALF + m * 16) * D + c; const u32x4 xw = *(const u32x4*)px;
                    const f32x4 a0 = acc[ai][bj][m][0], a1 = acc[ai][bj][m][1];
                    u32x4 w; w.x = cvt_pk_bf16(bflo(xw.x) * DN_ALPHA + g0[0] * a0[0], bfhi(xw.x) * DN_ALPHA + g0[1] * a0[1]); w.y = cvt_pk_bf16(bflo(xw.y) * DN_ALPHA + g0[2] * a0[2], bfhi(xw.y) * DN_ALPHA + g0[3] * a0[3]);
                    w.z = cvt_pk_bf16(bflo(xw.z) * DN_ALPHA + g1[0] * a1[0], bfhi(xw.z) * DN_ALPHA + g1[1] * a1[1]); w.w = cvt_pk_bf16(bflo(xw.w) * DN_ALPHA + g1[2] * a1[2], bfhi(xw.w) * DN_ALPHA + g1[3] * a1[3]);
                    *(u32x4*)px = w; } }
    }
};
struct EpiSwiglu {
    static constexpr bool PERM = true;
    unsigned char* O; const float* b1p;
    __device__ __forceinline__ void operator()(const f32x4 (&acc)[2][2][4][2], const Unit& u, int wr, int wc, int fr, int fq) const {
        const int row0 = u.pm * BM + wr * 64 + fr; const int cin = u.pn * BM + wc * 32 + 8 * fq, cout = u.pn * HALF + wc * 32 + 8 * fq;
        const float* bp = b1p + (size_t)u.e * 2048 + cin;
        const f32x4 bg0 = *(const f32x4*)(bp), bg1 = *(const f32x4*)(bp + 4), bl0 = *(const f32x4*)(bp + HALF), bl1 = *(const f32x4*)(bp + HALF + 4);
        constexpr float inv = 1.0f / (QS_H * QS_W1);
#pragma unroll
        for (int ai = 0; ai < 2; ++ai)
#pragma unroll
            for (int m = 0; m < 4; ++m) {
                const i32x4 ig0 = __builtin_bit_cast(i32x4, acc[ai][0][m][0]), ig1 = __builtin_bit_cast(i32x4, acc[ai][0][m][1]), il0 = __builtin_bit_cast(i32x4, acc[ai][1][m][0]), il1 = __builtin_bit_cast(i32x4, acc[ai][1][m][1]);
                float o[8];
#pragma unroll
                for (int j = 0; j < 8; ++j) { const float gv = fminf((float)(j < 4 ? ig0[j & 3] : ig1[j & 3]) * inv + (j < 4 ? bg0[j & 3] : bg1[j & 3]), 7.0f);
                    const float lv = __builtin_amdgcn_fmed3f((float)(j < 4 ? il0[j & 3] : il1[j & 3]) * inv + (j < 4 ? bl0[j & 3] : bl1[j & 3]), -7.0f, 7.0f);
                    const float sg = __builtin_amdgcn_rcpf(1.0f + __builtin_amdgcn_exp2f(gv * (-1.702f * 1.4426950408889634f)));
                    o[j] = (gv * sg) * (lv * QS_U + QS_U); }
                u32x2 w; w.x = q8x4(o[0], o[1], o[2], o[3]); w.y = q8x4(o[4], o[5], o[6], o[7]);
                *(u32x2*)(O + (size_t)(row0 + ai * HALF + m * 16) * FF + cout) = w; }
    }
};
struct EpiMoeOut {
    static constexpr bool PERM = true;
    bf16* O; const float* b2; const float* gatel; const LAS int* tb;
    __device__ __forceinline__ void operator()(const f32x4 (&acc)[2][2][4][2], const Unit& u, int wr, int wc, int fr, int fq) const {
        const int row0 = u.pm * BM + wr * 64 + fr, col0 = u.pn * BM + wc * 32 + 8 * fq;
        const int pos0 = (u.pm - tb[u.e]) * BM + wr * 64 + fr;
        const float* bp = b2 + (size_t)u.e * D + col0;
        constexpr float inv = 1.0f / (QS_U * QS_W2);
        f32x4 bv[2][2];
#pragma unroll
        for (int bj = 0; bj < 2; ++bj) { bv[bj][0] = *(const f32x4*)(bp + bj * HALF); bv[bj][1] = *(const f32x4*)(bp + bj * HALF + 4); }
#pragma unroll
        for (int ai = 0; ai < 2; ++ai)
#pragma unroll
            for (int m = 0; m < 4; ++m) { const float gt = gatel[(size_t)u.e * CAP + pos0 + ai * HALF + m * 16];
                bf16* rowp = O + (size_t)(row0 + ai * HALF + m * 16) * D + col0;
#pragma unroll
                for (int bj = 0; bj < 2; ++bj) { const i32x4 i0 = __builtin_bit_cast(i32x4, acc[ai][bj][m][0]), i1 = __builtin_bit_cast(i32x4, acc[ai][bj][m][1]);
                    f32x4 v0, v1;
#pragma unroll
                    for (int j = 0; j < 4; ++j) { v0[j] = ((float)i0[j] * inv + bv[bj][0][j]) * gt; v1[j] = ((float)i1[j] * inv + bv[bj][1][j]) * gt; }
                    u32x4 w; w.x = cvt_pk_bf16(v0[0], v0[1]); w.y = cvt_pk_bf16(v0[2], v0[3]); w.z = cvt_pk_bf16(v1[0], v1[1]); w.w = cvt_pk_bf16(v1[2], v1[3]);
                    *(u32x4*)(rowp + bj * HALF) = w; } }
    }
};
}

struct Params { const void* in[N_INPUTS]; float* out; unsigned char* ws; int ph_lo, ph_hi; };

struct Frame {
    LAS unsigned char* lds;
    int tid, lane, wave, G, vcu;
    unsigned char* ws;
};
#define WSP(type, off) ((type*)(F.ws + (off)))
#define INP(i) ((const float*)p.in[i])

__device__ const double INV_FREQ[16] = {1.00000000000000000e+00, 5.62341325190349073e-01, 3.16227766016837941e-01, 1.77827941003892293e-01, 1.00000000000000006e-01, 5.62341325190349114e-02,
    3.16227766016837913e-02, 1.77827941003892293e-02, 1.00000000000000002e-02, 5.62341325190349097e-03, 3.16227766016837939e-03, 1.77827941003892275e-03, 1.00000000000000002e-03,
    5.62341325190349097e-04, 3.16227766016837939e-04, 1.77827941003892270e-04};

template <int MODE>
__device__ __forceinline__ void tr_item(const float* W, int ldn, bf16* WT, int ldk, int kofs, int rofs, int k0, int n0, LAS float* scr, int lane) {
    f32x4 ld[8];
#pragma unroll
    for (int i = 0; i < 8; ++i) ld[i] = *(const f32x4*)(W + (size_t)(k0 + 8 * i + (lane >> 3)) * ldn + n0 + 4 * (lane & 7));
#pragma unroll
    for (int i = 0; i < 8; ++i) { LAS float* d = scr + (8 * i + (lane >> 3)) * 33 + 4 * (lane & 7); d[0] = ld[i].x; d[1] = ld[i].y; d[2] = ld[i].z; d[3] = ld[i].w; }
    LDS_WAIT(); asm volatile("" ::: "memory");
    const int c = lane & 7;
#pragma unroll
    for (int j = 0; j < 4; ++j) { const int n = (lane >> 3) + 8 * j; const LAS float* s = scr + (8 * c) * 33 + n;
        u32x4 o; o.x = pk2(s[0 * 33], s[1 * 33]); o.y = pk2(s[2 * 33], s[3 * 33]); o.z = pk2(s[4 * 33], s[5 * 33]); o.w = pk2(s[6 * 33], s[7 * 33]);
        const int ng = n0 + n; int row;
        if (MODE == 0) row = rofs + ng; else { const int jo = ng >> 1, bj = ng & 1; row = rofs + (jo >> 7) * 256 + bj * 128 + (jo & 127); }
        *(GAS u32x4*)(WT + (size_t)row * ldk + kofs + k0 + 8 * c) = o; }
    LDS_WAIT(); asm volatile("" ::: "memory");
}
__device__ __forceinline__ void tr_item_i8(const float* W, int ldn, unsigned char* WT, int ldk, int k0, int n0, LAS float* scr, int lane) {
    f32x4 ld[8];
#pragma unroll
    for (int i = 0; i < 8; ++i) ld[i] = *(const f32x4*)(W + (size_t)(k0 + 8 * i + (lane >> 3)) * ldn + n0 + 4 * (lane & 7));
#pragma unroll
    for (int i = 0; i < 8; ++i) { LAS float* d = scr + (8 * i + (lane >> 3)) * 33 + 4 * (lane & 7); d[0] = ld[i].x; d[1] = ld[i].y; d[2] = ld[i].z; d[3] = ld[i].w; }
    LDS_WAIT(); asm volatile("" ::: "memory");
    { const int n = lane >> 1, hf = lane & 1; const LAS float* sp = scr + (32 * hf) * 33 + n; const int ng = n0 + n;
      const float qs = (ng >= 1440 && ng < 1952) ? 2.0f * QS_WIN : QS_WIN;
      u32x4 o0, o1;
      o0.x = q8x4(sp[0 * 33] * qs, sp[1 * 33] * qs, sp[2 * 33] * qs, sp[3 * 33] * qs); o0.y = q8x4(sp[4 * 33] * qs, sp[5 * 33] * qs, sp[6 * 33] * qs, sp[7 * 33] * qs);
      o0.z = q8x4(sp[8 * 33] * qs, sp[9 * 33] * qs, sp[10 * 33] * qs, sp[11 * 33] * qs); o0.w = q8x4(sp[12 * 33] * qs, sp[13 * 33] * qs, sp[14 * 33] * qs, sp[15 * 33] * qs);
      o1.x = q8x4(sp[16 * 33] * qs, sp[17 * 33] * qs, sp[18 * 33] * qs, sp[19 * 33] * qs); o1.y = q8x4(sp[20 * 33] * qs, sp[21 * 33] * qs, sp[22 * 33] * qs, sp[23 * 33] * qs);
      o1.z = q8x4(sp[24 * 33] * qs, sp[25 * 33] * qs, sp[26 * 33] * qs, sp[27 * 33] * qs); o1.w = q8x4(sp[28 * 33] * qs, sp[29 * 33] * qs, sp[30 * 33] * qs, sp[31 * 33] * qs);
      unsigned char* dp = WT + (size_t)ng * ldk + k0 + 32 * hf;
      *(GAS u32x4*)dp = o0; *(GAS u32x4*)(dp + 16) = o1; }
    LDS_WAIT(); asm volatile("" ::: "memory");
}
__device__ __forceinline__ void zero_rect(const Frame& F, bf16* M, int ld, int r0, int nrows, int c0, int ncols) {
    const int gw = F.vcu * NWAVES + F.wave, NGW = F.G * NWAVES; const int nch = ncols / 8;
    for (int r = gw; r < nrows; r += NGW)
        for (int ch = F.lane; ch < nch; ch += 64) *(GAS u32x4*)(M + (size_t)(r0 + r) * ld + c0 + ch * 8) = (u32x4){0u, 0u, 0u, 0u};
}
__device__ __forceinline__ void phase_prologue(const Params& p, const Frame& F) {
    LAS float* scr = (LAS float*)(F.lds + F.wave * 16384);
    const int gw = F.vcu * NWAVES + F.wave, NGW = F.G * NWAVES;
    constexpr int I_IN = 16 * 69, I_UQ = 4 * 24, I_UK = 2 * 16, I_W2s = 16, I_G2s = 2 * 16, I_WO_ = 16 * 32, I_E1 = 16 * 64, I_E2 = 16 * 32;
    constexpr int PER_L = I_IN + I_UQ + 2 * I_UK + 2 * I_W2s + I_G2s + I_WO_;
    constexpr int NSMALL = DEPTH * PER_L;
    for (int it = gw; it < NSMALL; it += NGW) {
        int r = it;
        {
            const int l = r / PER_L; r -= l * PER_L;
            if (r < I_IN) { tr_item_i8(INP(I_WIN) + (size_t)l * D * N_IN, N_IN, WSP(unsigned char, WS_WINT) + (size_t)l * N_INP * D, D, 64 * (r / 69), 32 * (r % 69), scr, F.lane); continue; } r -= I_IN;
            bf16* up = WSP(bf16, WS_WUPT) + (size_t)l * N_UP * K_UP;
            if (r < I_UQ) { tr_item<0>(INP(I_WUQ) + (size_t)l * QLR * 768, 768, up, K_UP, 0, 0, 64 * (r / 24), 32 * (r % 24), scr, F.lane); continue; } r -= I_UQ;
            if (r < I_UK) { tr_item<0>(INP(I_WUK) + (size_t)l * KVLR * 512, 512, up, K_UP, 256, 768, 64 * (r / 16), 32 * (r % 16), scr, F.lane); continue; } r -= I_UK;
            if (r < I_UK) { tr_item<0>(INP(I_WUV) + (size_t)l * KVLR * 512, 512, up, K_UP, 256, 1280, 64 * (r / 16), 32 * (r % 16), scr, F.lane); continue; } r -= I_UK;
            bf16* sm = WSP(bf16, WS_WSMT) + (size_t)l * N_SM * K_SM;
            if (r < I_W2s) { tr_item<0>(INP(I_W2) + (size_t)l * 64 * 512, 512, sm, K_SM, 0, 0, 0, 32 * r, scr, F.lane); continue; } r -= I_W2s;
            if (r < I_W2s) { tr_item<0>(INP(I_A2) + (size_t)l * 64 * 512, 512, sm, K_SM, 64, 512, 0, 32 * r, scr, F.lane); continue; } r -= I_W2s;
            if (r < I_G2s) { tr_item<0>(INP(I_G2) + (size_t)l * 128 * 512, 512, sm, K_SM, 128, 1024, 64 * (r / 16), 32 * (r % 16), scr, F.lane); continue; } r -= I_G2s;
            tr_item<0>(INP(I_WO) + (size_t)l * D * D, D, WSP(bf16, WS_WOT) + (size_t)l * D * D, D, 0, 0, 64 * (r / 32), 32 * (r % 32), scr, F.lane); continue;
        }
    }
    for (int l = 0; l < DEPTH; ++l) {
        zero_rect(F, (bf16*)(WSP(unsigned char, WS_WINT) + (size_t)l * N_INP * D), D / 2, N_IN, N_INP - N_IN, 0, D / 2);
        bf16* up = WSP(bf16, WS_WUPT) + (size_t)l * N_UP * K_UP;
        zero_rect(F, up, K_UP, 0, 768, 256, 128); zero_rect(F, up, K_UP, 768, 1024, 0, 256);
        bf16* sm = WSP(bf16, WS_WSMT) + (size_t)l * N_SM * K_SM;
        zero_rect(F, sm, K_SM, 0, 512, 64, 192); zero_rect(F, sm, K_SM, 512, 512, 0, 64); zero_rect(F, sm, K_SM, 512, 512, 128, 128); zero_rect(F, sm, K_SM, 1024, 512, 0, 128);
    }
    const int gt = (F.vcu * NTHREADS) + F.tid, NGT = F.G * NTHREADS;
    { const float* v1 = INP(I_V1); const float* v2 = INP(I_V2); bf16* o = WSP(bf16, WS_WV12T);
      for (int i = gt; i < 512 * 512; i += NGT) { const int n = i >> 9, k = i & 511; float s = 0.f;
#pragma unroll 8
          for (int j = 0; j < 32; ++j) s += v1[k * 32 + j] * v2[j * 512 + n];
          o[i] = (bf16)f2bf(s); } }
    { const float* b1 = INP(I_EB1); float* o = WSP(float, WS_B1P);
      for (int i = gt; i < DEPTH * NE * 2048; i += NGT) { const int q = i & 2047, le = i >> 11; const int pn = q >> 8, bj = (q >> 7) & 1, jj = q & 127; o[i] = b1[(size_t)le * 2048 + 2 * (pn * 128 + jj) + bj]; } }
    { bf16* pg = WSP(bf16, WS_PGW);
      for (int i = gt; i < DEPTH * PGW_NFRAG * 64; i += NGT) { const int ln = i & 63, fi = (i >> 6) % PGW_NFRAG, l2 = (i >> 6) / PGW_NFRAG; const int rr = ln & 31, hh = ln >> 5;
          const float* W; int ldw, KS, f0; bool v12 = false;
          if (fi < PGW_KN) { W = INP(I_WUQ) + (size_t)l2 * QLR * 768; ldw = 768; KS = 16; f0 = PGW_Q; }
          else if (fi < PGW_V) { W = INP(I_WUK) + (size_t)l2 * KVLR * 512; ldw = 512; KS = 8; f0 = PGW_KN; }
          else if (fi < PGW_W) { W = INP(I_WUV) + (size_t)l2 * KVLR * 512; ldw = 512; KS = 8; f0 = PGW_V; }
          else if (fi < PGW_A) { W = INP(I_W2) + (size_t)l2 * 64 * 512; ldw = 512; KS = 4; f0 = PGW_W; }
          else if (fi < PGW_G) { W = INP(I_A2) + (size_t)l2 * 64 * 512; ldw = 512; KS = 4; f0 = PGW_A; }
          else if (fi < PGW_VR) { W = INP(I_G2) + (size_t)l2 * 128 * 512; ldw = 512; KS = 8; f0 = PGW_G; }
          else { W = nullptr; ldw = 512; KS = 32; f0 = PGW_VR; v12 = true; }
          const int nb = (fi - f0) / KS, ks = (fi - f0) % KS, n = 32 * nb + rr, k0 = 16 * ks + 8 * hh;
          float v[8];
          if (!v12) {
#pragma unroll
              for (int j = 0; j < 8; ++j) v[j] = W[(size_t)(k0 + j) * ldw + n]; }
          else { const float* v1 = INP(I_V1); const float* v2 = INP(I_V2);
#pragma unroll
              for (int j = 0; j < 8; ++j) { float sacc = 0.f;
#pragma unroll 8
                  for (int q = 0; q < 32; ++q) sacc += v1[(k0 + j) * 32 + q] * v2[q * 512 + n];
                  v[j] = (l2 == 0) ? 0.f : sacc; } }
          u32x4 o; o.x = pk2(v[0], v[1]); o.y = pk2(v[2], v[3]); o.z = pk2(v[4], v[5]); o.w = pk2(v[6], v[7]);
          *(u32x4*)(pg + (size_t)i * 8) = o; } }
    { const float* rw = INP(I_RW); bf16* o = WSP(bf16, WS_RWT);
      for (int i = gt; i < DEPTH * NE * D; i += NGT) { const int k = i & 1023, e = (i >> 10) & 31, l2 = i >> 15; const float v = rw[((size_t)l2 * D + k) * NE + e]; const unsigned hi = f2bf(v); const float lo = v - bf2f(hi);
          o[i] = (bf16)hi; o[DEPTH * NE * D + i] = (bf16)f2bf(lo); } }
    { const int* pos = (const int*)p.in[I_POS]; float* cs = WSP(float, WS_CS);
      for (int i = gt; i < T * 16; i += NGT) { const int t = i >> 4, k = i & 15; const double a = (double)pos[t] * INV_FREQ[k];
          const double q = __builtin_rint(a * 0.63661977236758134308); const int qi = (int)((long long)q & 3);
          double r = __builtin_fma(-q, 1.57079632679489655800e+00, a); r = __builtin_fma(-q, 6.12323399573676603587e-17, r);
          const double r2 = r * r;
          double sn = -2.50521083854417187751e-08; sn = sn * r2 + 2.75573192239858906526e-06; sn = sn * r2 - 1.98412698412698412698e-04; sn = sn * r2 + 8.33333333333333333333e-03; sn = sn * r2 - 1.66666666666666666667e-01; sn = r + r * r2 * sn;
          double cn = 2.08767569878680989792e-09; cn = cn * r2 - 2.75573192239858906526e-07; cn = cn * r2 + 2.48015873015873015873e-05; cn = cn * r2 - 1.38888888888888888889e-03; cn = cn * r2 + 4.16666666666666666667e-02; cn = cn * r2 - 0.5; cn = 1.0 + r2 * cn;
          double sv, cv;
          if (qi == 0) { sv = sn; cv = cn; } else if (qi == 1) { sv = cn; cv = -sn; } else if (qi == 2) { sv = -sn; cv = -cn; } else { sv = -cn; cv = sn; }
          cs[2 * i] = (float)cv; cs[2 * i + 1] = (float)sv; } }
    { LAS float* cact = (LAS float*)(F.lds);
      LAS float* part = (LAS float*)(F.lds + 32768);
      __syncthreads();
      const float* c = INP(I_C);
      for (int i = F.tid; i < NBATCH * D; i += NTHREADS) { const float v = c[i]; cact[i] = v / (1.0f + __expf(-v)); }
      __syncthreads();
      for (int item = F.vcu; item < DEPTH * 96; item += F.G) { const int l = item / 96, n0 = (item % 96) * 64;
          const float* aw = INP(I_ADAW) + (size_t)l * D * 6144 + n0 + F.lane;
          float a8[8];
#pragma unroll
          for (int b = 0; b < 8; ++b) a8[b] = 0.f;
          const int kb = F.wave * 128;
#pragma unroll 4
          for (int k = 0; k < 128; ++k) { const float wv = aw[(size_t)(kb + k) * 6144];
#pragma unroll
              for (int b = 0; b < 8; ++b) a8[b] += cact[b * D + kb + k] * wv; }
#pragma unroll
          for (int b = 0; b < 8; ++b) part[(F.wave * 8 + b) * 64 + F.lane] = a8[b];
          __syncthreads();
          { const int b = F.wave; float s = 0.f;
#pragma unroll
            for (int w = 0; w < 8; ++w) s += part[(w * 8 + b) * 64 + F.lane];
            WSP(float, WS_MOD)[((size_t)l * NBATCH + b) * 6144 + n0 + F.lane] = s + INP(I_ADAB)[(size_t)l * 6144 + n0 + F.lane]; }
          __syncthreads(); }
    }
}

__device__ __forceinline__ void phase_convert_experts(const Params& p, const Frame& F, int c0, int nc) {
    LAS float* scr = (LAS float*)(F.lds + F.wave * 16384);
    constexpr int I_E1 = 16 * 64, I_E2 = 16 * 32, NE1 = DEPTH * NE * I_E1, NE2 = DEPTH * NE * I_E2;
    const int gw = (F.vcu - c0) * NWAVES + F.wave, NGW = nc * NWAVES; const int lane = F.lane;
    __syncthreads();
    f32x4 ld[8];
#define CV_SRC(it, W_, ldn_, k0_, n0_) do { int r_ = (it); if (r_ < NE1) { const int le_ = r_ / I_E1; r_ -= le_ * I_E1; W_ = INP(I_EW1) + (size_t)le_ * D * 2048; ldn_ = 2048; k0_ = 64 * (r_ / 64); n0_ = 32 * (r_ % 64); } \
        else { r_ -= NE1; const int le_ = r_ / I_E2; r_ -= le_ * I_E2; W_ = INP(I_EW2) + (size_t)le_ * FF * D; ldn_ = D; k0_ = 64 * (r_ / 32); n0_ = 32 * (r_ % 32); } } while (0)
#define CV_LOAD(it) do { const float* W_; int ldn_, k0_, n0_; CV_SRC(it, W_, ldn_, k0_, n0_); \
        _Pragma("unroll") for (int i = 0; i < 8; ++i) ld[i] = *(const f32x4*)(W_ + (size_t)(k0_ + 8 * i + (lane >> 3)) * ldn_ + n0_ + 4 * (lane & 7)); } while (0)
    int it = gw;
    if (it < NE1 + NE2) CV_LOAD(it);
    for (; it < NE1 + NE2; it += NGW) {
#pragma unroll
        for (int i = 0; i < 8; ++i) { LAS float* d = scr + (8 * i + (lane >> 3)) * 33 + 4 * (lane & 7); d[0] = ld[i].x; d[1] = ld[i].y; d[2] = ld[i].z; d[3] = ld[i].w; }
        if (it + NGW < NE1 + NE2) CV_LOAD(it + NGW);
        LDS_WAIT(); asm volatile("" ::: "memory");
        int r = it; unsigned char* WT; int ldk, k0, n0; bool perm; float qs;
        if (r < NE1) { const int le = r / I_E1; r -= le * I_E1; WT = WSP(unsigned char, WS_W1T) + (size_t)le * 2048 * D; ldk = D; k0 = 64 * (r / 64); n0 = 32 * (r % 64); perm = true; qs = QS_W1; }
        else { r -= NE1; const int le = r / I_E2; r -= le * I_E2; WT = WSP(unsigned char, WS_W2T) + (size_t)le * D * FF; ldk = FF; k0 = 64 * (r / 32); n0 = 32 * (r % 32); perm = false; qs = QS_W2; }
        { const int n = lane >> 1, hf = lane & 1; const LAS float* sp = scr + (32 * hf) * 33 + n;
          u32x4 o0, o1;
          o0.x = q8x4(sp[0 * 33] * qs, sp[1 * 33] * qs, sp[2 * 33] * qs, sp[3 * 33] * qs); o0.y = q8x4(sp[4 * 33] * qs, sp[5 * 33] * qs, sp[6 * 33] * qs, sp[7 * 33] * qs);
          o0.z = q8x4(sp[8 * 33] * qs, sp[9 * 33] * qs, sp[10 * 33] * qs, sp[11 * 33] * qs); o0.w = q8x4(sp[12 * 33] * qs, sp[13 * 33] * qs, sp[14 * 33] * qs, sp[15 * 33] * qs);
          o1.x = q8x4(sp[16 * 33] * qs, sp[17 * 33] * qs, sp[18 * 33] * qs, sp[19 * 33] * qs); o1.y = q8x4(sp[20 * 33] * qs, sp[21 * 33] * qs, sp[22 * 33] * qs, sp[23 * 33] * qs);
          o1.z = q8x4(sp[24 * 33] * qs, sp[25 * 33] * qs, sp[26 * 33] * qs, sp[27 * 33] * qs); o1.w = q8x4(sp[28 * 33] * qs, sp[29 * 33] * qs, sp[30 * 33] * qs, sp[31 * 33] * qs);
          const int ng = n0 + n; int row = ng;
          if (perm) { const int jo = ng >> 1, bj = ng & 1; row = (jo >> 7) * 256 + bj * 128 + (jo & 127); }
          unsigned char* dp = WT + (size_t)row * ldk + k0 + 32 * hf;
          *(GAS u32x4*)dp = o0; *(GAS u32x4*)(dp + 16) = o1; }
        LDS_WAIT(); asm volatile("" ::: "memory");
    }
#undef CV_LOAD
#undef CV_SRC
    __syncthreads();
}

__device__ __forceinline__ void phase_ln0(const Params& p, const Frame& F) {
    const int gw = F.vcu * NWAVES + F.wave, NGW = F.G * NWAVES;
    const float* mod = WSP(float, WS_MOD);
#pragma unroll 4
    for (int m = gw; m < T; m += NGW) {
        const int b = m / SEQ;
        const GAS f32x4* xr = (const GAS f32x4*)(INP(I_X) + (size_t)m * D) + F.lane;
        f32x4 v[4]; float s = 0.f;
#pragma unroll
        for (int j = 0; j < 4; ++j) { v[j] = xr[64 * j]; s += (v[j].x + v[j].y) + (v[j].z + v[j].w); }
        const float mean = wave_sum(s) * (1.f / D); float s2 = 0.f;
#pragma unroll
        for (int j = 0; j < 4; ++j) { v[j] = v[j] - mean; s2 += (v[j].x * v[j].x + v[j].y * v[j].y) + (v[j].z * v[j].z + v[j].w * v[j].w); }
        const float rstd = 1.f / sqrtf(wave_sum(s2) * (1.f / D) + LN_EPS);
        GAS u32x2* xo = (GAS u32x2*)(WSP(bf16, WS_X) + (size_t)m * D) + F.lane;
        GAS unsigned* ho = (GAS unsigned*)(WSP(unsigned char, WS_H) + (size_t)m * D) + F.lane;
        f32x4 hq[4];
#pragma unroll
        for (int j = 0; j < 4; ++j) { const int c = 4 * F.lane + 256 * j;
            const f32x4 g = *(const f32x4*)(INP(I_ELNG) + c), be = *(const f32x4*)(INP(I_ELNB) + c);
            const f32x4 x0 = v[j] * rstd * g + be; { u32x2 xw; xw.x = pk2(x0.x, x0.y); xw.y = pk2(x0.z, x0.w); xo[64 * j] = xw; }
            const f32x4 sh = *(const f32x4*)(mod + (size_t)b * 6144 + c), sc = *(const f32x4*)(mod + (size_t)b * 6144 + 1024 + c);
            hq[j] = x0 * (sc + 1.0f) + sh; }
        float mx = 0.f;
#pragma unroll
        for (int j = 0; j < 4; ++j) mx = fmaxf(mx, fmaxf(fmaxf(fabsf(hq[j].x), fabsf(hq[j].y)), fmaxf(fabsf(hq[j].z), fabsf(hq[j].w))));
#pragma unroll
        for (int o = 1; o < 64; o <<= 1) mx = fmaxf(mx, __shfl_xor(mx, o));
        mx = fmaxf(mx, 1e-20f); const float qsr = 127.0f / mx;
#pragma unroll
        for (int j = 0; j < 4; ++j) ho[64 * j] = q8x4(hq[j].x * qsr, hq[j].y * qsr, hq[j].z * qsr, hq[j].w * qsr);
        if (F.lane == 0) WSP(float, WS_HS)[m] = mx * (1.0f / 127.0f);
    }
}

__device__ __forceinline__ void phase_prep(const Params& p, const Frame& F, int l) {
    const int gw = F.vcu * NWAVES + F.wave, NGW = F.G * NWAVES; const int lane = F.lane;
    const bf16* P = WSP(bf16, WS_P); const float* mu = INP(I_MU) + (size_t)l * RWKV_IN;
    const float* qg = INP(I_QNG) + (size_t)l * QLR; const float* kvg = INP(I_KVNG) + (size_t)l * KVLR;
    bf16* AN = WSP(bf16, WS_AN); bf16* A2 = WSP(bf16, WS_A2); bf16* RK = WSP(bf16, WS_RK); bf16* KKb = WSP(bf16, WS_KK);
    bf16* VS = l == 0 ? WSP(bf16, WS_VS0) : WSP(bf16, WS_VS1);
    const float* cs = WSP(float, WS_CS);
    const int RPW = (T + NGW - 1) / NGW; const int t0 = gw * RPW; const int t1 = (t0 + RPW < T) ? t0 + RPW : T;
    f32x4 mu0[3], mu1[3];
#pragma unroll
    for (int part = 0; part < 3; ++part) { mu0[part] = *(const f32x4*)(mu + part * 512 + 8 * lane); mu1[part] = *(const f32x4*)(mu + part * 512 + 8 * lane + 4); }
    const float mu_wd = mu[1536 + lane], mu_ad = mu[1600 + lane]; const f32x2 mu_gd = *(const f32x2*)(mu + 1664 + 2 * lane);
    const f32x4 gq = *(const f32x4*)(qg + 4 * lane); const f32x2 gkv = *(const f32x2*)(kvg + 2 * lane);
    u32x4 pw[3]; pw[0] = pw[1] = pw[2] = (u32x4){0u, 0u, 0u, 0u}; float p_wd = 0.f, p_ad = 0.f; unsigned p_gd = 0u;
    if (t0 < t1 && (t0 % SEQ) != 0) { const bf16* rp = P + (size_t)(t0 - 1) * N_INP + MLA_IN;
#pragma unroll
        for (int part = 0; part < 3; ++part) pw[part] = *(const u32x4*)(rp + part * 512 + 8 * lane);
        p_wd = bf2f(rp[1536 + lane]); p_ad = bf2f(rp[1600 + lane]); p_gd = *(const unsigned*)(rp + 1664 + 2 * lane); }
#pragma unroll 2
    for (int t = t0; t < t1; ++t) {
        const bf16* pr = P + (size_t)t * N_INP;
        if ((t % SEQ) == 0) { pw[0] = pw[1] = pw[2] = (u32x4){0u, 0u, 0u, 0u}; p_wd = 0.f; p_ad = 0.f; p_gd = 0u; }
        { const u32x2 qw = *(const u32x2*)(pr + 4 * lane); float q0 = bflo(qw.x), q1 = bfhi(qw.x), q2 = bflo(qw.y), q3 = bfhi(qw.y);
          const float rq = __builtin_amdgcn_rsqf(wave_sum(q0 * q0 + q1 * q1 + q2 * q2 + q3 * q3) * (1.f / QLR) + RMS_EPS);
          u32x2 w; w.x = pk2(q0 * rq * gq.x, q1 * rq * gq.y); w.y = pk2(q2 * rq * gq.z, q3 * rq * gq.w); *(u32x2*)(AN + (size_t)t * K_UP + 4 * lane) = w;
          const unsigned kw = *(const unsigned*)(pr + QLR + 2 * lane); const float k0 = bflo(kw), k1 = bfhi(kw);
          const float rk = __builtin_amdgcn_rsqf(wave_sum(k0 * k0 + k1 * k1) * (1.f / KVLR) + RMS_EPS);
          *(unsigned*)(AN + (size_t)t * K_UP + QLR + 2 * lane) = pk2(k0 * rk * gkv.x, k1 * rk * gkv.y);
          const int i = lane & 15; const unsigned rw = *(const unsigned*)(pr + QLR + KVLR + 2 * i); const float x0 = bflo(rw), x1 = bfhi(rw);
          const f32x2 csv = *(const f32x2*)(cs + (size_t)t * 32 + 2 * i); const unsigned ro = pk2(x0 * csv.x - x1 * csv.y, x0 * csv.y + x1 * csv.x);
          const int h0 = (lane >> 4) * 2;
          *(unsigned*)(KKb + (size_t)t * 768 + h0 * QKD + NOPE + 2 * i) = ro; *(unsigned*)(KKb + (size_t)t * 768 + (h0 + 1) * QKD + NOPE + 2 * i) = ro; }
        const bf16* rr = pr + MLA_IN;
#pragma unroll
        for (int part = 0; part < 3; ++part) {
            const u32x4 cw = *(const u32x4*)(rr + part * 512 + 8 * lane); const u32x4 pv_ = pw[part]; pw[part] = cw;
            float o[8];
#pragma unroll
            for (int j = 0; j < 4; ++j) { const float a = bflo(cw[j]), b = bfhi(cw[j]), pa = bflo(pv_[j]), pb = bfhi(pv_[j]); const float ma = j < 2 ? mu0[part][2 * j] : mu1[part][2 * j - 4], mb = j < 2 ? mu0[part][2 * j + 1] : mu1[part][2 * j - 3];
                o[2 * j] = a + ma * (pa - a); o[2 * j + 1] = b + mb * (pb - b); }
            u32x4 w; w.x = pk2(o[0], o[1]); w.y = pk2(o[2], o[3]); w.z = pk2(o[4], o[5]); w.w = pk2(o[6], o[7]);
            if (part < 2) *(u32x4*)(RK + (size_t)t * 1024 + part * 512 + 8 * lane) = w; else *(u32x4*)(VS + (size_t)t * C5 + 8 * lane) = w;
        }
        { const float a = bf2f(rr[1536 + lane]); const float v = a + mu_wd * (p_wd - a); p_wd = a; A2[(size_t)t * K_SM + lane] = (bf16)f2bf(tanhf_(v)); }
        { const float a = bf2f(rr[1600 + lane]); const float v = a + mu_ad * (p_ad - a); p_ad = a; A2[(size_t)t * K_SM + 64 + lane] = (bf16)f2bf(v); }
        { const unsigned cw = *(const unsigned*)(rr + 1664 + 2 * lane); const float a = bflo(cw), b = bfhi(cw); const float va = a + mu_gd.x * (bflo(p_gd) - a), vb = b + mu_gd.y * (bfhi(p_gd) - b); p_gd = cw;
          *(unsigned*)(A2 + (size_t)t * K_SM + 128 + 2 * lane) = pk2(sigmoidf_(va), sigmoidf_(vb)); }
    }
}

namespace pgm {
constexpr int RP = 64, LDA_AN = 784, LDA_A2 = 528, LDA_VS = 1040, OFF_A2 = RP * LDA_AN, OFF_VS = 0;
__device__ __forceinline__ int crow(int r, int hi) { return (r & 3) + 8 * (r >> 2) + 4 * hi; }
template <int KSTEPS>
__device__ __forceinline__ void block_mma(f32x16 (&acc)[2], const LAS unsigned char* A, int lda, const bf16* Bt, int ldb, int nrow0, int kofs, int r, int h) {
    const bf16* bp = Bt + (size_t)(nrow0 + r) * ldb + kofs + 8 * h;
    const LAS unsigned char* a0 = A + r * lda + (kofs + 8 * h) * 2; const LAS unsigned char* a1 = a0 + 32 * lda;
    bf16x8 cur[4], nxt[4];
#pragma unroll
    for (int j = 0; j < 4; ++j) cur[j] = *(const bf16x8*)(bp + 16 * j);
#pragma unroll
    for (int g = 0; g < KSTEPS / 4; ++g) {
        if (g + 1 < KSTEPS / 4) {
#pragma unroll
            for (int j = 0; j < 4; ++j) nxt[j] = *(const bf16x8*)(bp + 16 * (4 * g + 4 + j)); }
#pragma unroll
        for (int j = 0; j < 4; ++j) { const int ks = 4 * g + j; const bf16x8 x0 = *(const LAS bf16x8*)(a0 + ks * 32), x1 = *(const LAS bf16x8*)(a1 + ks * 32);
            acc[0] = __builtin_amdgcn_mfma_f32_32x32x16_bf16(cur[j], x0, acc[0], 0, 0, 0); acc[1] = __builtin_amdgcn_mfma_f32_32x32x16_bf16(cur[j], x1, acc[1], 0, 0, 0); }
        asm volatile("" ::: "memory");
#pragma unroll
        for (int j = 0; j < 4; ++j) cur[j] = nxt[j];
    }
}
template <int KSTEPS>
__device__ __forceinline__ void load_frags(bf16x8 (&fr)[KSTEPS], const bf16* pg, int frag0, int lane) {
    const bf16* bp = pg + ((size_t)frag0 * 64 + lane) * 8;
#pragma unroll
    for (int ks = 0; ks < KSTEPS; ++ks) fr[ks] = *(const bf16x8*)(bp + (size_t)ks * 512);
}
template <int KSTEPS>
__device__ __forceinline__ void mma_frags(f32x16 (&acc)[2], const LAS unsigned char* A, int lda, int kofs, const bf16x8 (&fr)[KSTEPS], int r, int h) {
    const LAS unsigned char* a0 = A + r * lda + (kofs + 8 * h) * 2; const LAS unsigned char* a1 = a0 + 32 * lda;
#pragma unroll
    for (int ks = 0; ks < KSTEPS; ++ks) { const bf16x8 x0 = *(const LAS bf16x8*)(a0 + ks * 32), x1 = *(const LAS bf16x8*)(a1 + ks * 32);
        acc[0] = __builtin_amdgcn_mfma_f32_32x32x16_bf16(fr[ks], x0, acc[0], 0, 0, 0); acc[1] = __builtin_amdgcn_mfma_f32_32x32x16_bf16(fr[ks], x1, acc[1], 0, 0, 0); }
}
constexpr int STG_LD = 80, STG_BYTES = RP * STG_LD, OFF_STG = RP * LDA_AN + RP * LDA_A2, OFF_ROPE = OFF_STG + 8 * STG_BYTES;
__device__ __forceinline__ void stage_put4(LAS unsigned char* stg, int mt, int g, int r, int h, float v0, float v1, float v2, float v3) {
    u32x2 w; w.x = cvtpk_c(v0, v1); w.y = cvtpk_c(v2, v3); *(LAS u32x2*)(stg + (32 * mt + r) * STG_LD + (8 * g + 4 * h) * 2) = w; }
__device__ __forceinline__ void stage_flush(const LAS unsigned char* stg, bf16* dst, int ldd, int lane) {
#pragma unroll
    for (int j = 0; j < 4; ++j) { const int row = 16 * j + (lane >> 2), ch = lane & 3; const u32x4 v = *(const LAS u32x4*)(stg + row * STG_LD + ch * 16); *(u32x4*)(dst + (size_t)row * ldd + 8 * ch) = v; }
}
__device__ __forceinline__ void stage_flush_kt(const LAS unsigned char* stg, bf16* dst, int lane) {
#pragma unroll
    for (int j = 0; j < 4; ++j) { const int row = 16 * j + (lane & 15), ch = lane >> 4; const u32x4 v = *(const LAS u32x4*)(stg + row * STG_LD + ch * 16); *(u32x4*)(dst + ch * 512 + row * 8) = v; }
}
}

__device__ __forceinline__ void phase_pgemm(const Params& p, const Frame& F, int l) {
    using namespace pgm;
    const int lane0 = F.lane, wave = F.wave;
    const bf16* P = WSP(bf16, WS_P); const float* mu = INP(I_MU) + (size_t)l * RWKV_IN;
    const float* qg = INP(I_QNG) + (size_t)l * QLR; const float* kvg = INP(I_KVNG) + (size_t)l * KVLR;
    bf16* RK = WSP(bf16, WS_RK); bf16* KKb = WSP(bf16, WS_KK); bf16* Qb = WSP(bf16, WS_Q); bf16* Vb = WSP(bf16, WS_V);
    bf16* VS = l == 0 ? WSP(bf16, WS_VS0) : WSP(bf16, WS_VS1);
    float* LWb = WSP(float, WS_LW); bf16* AGb = WSP(bf16, WS_AG);
    const float* cs = WSP(float, WS_CS);
    const bf16* PGW = WSP(bf16, WS_PGW) + (size_t)l * PGW_NFRAG * 512;
    const float* w0 = INP(I_W0) + (size_t)l * C5; const float* a0p = INP(I_A0) + (size_t)l * C5;
    LAS unsigned char* AN = F.lds; LAS unsigned char* A2 = F.lds + OFF_A2; LAS unsigned char* VSl = F.lds + OFF_VS;
    for (int panel = F.vcu; panel < T / RP; panel += F.G) {
        const int row0 = panel * RP;
        int lane = lane0; asm volatile("" : "+v"(lane)); const int r = lane & 31, h = lane >> 5;
        __syncthreads();
        {
            f32x4 mu0[3], mu1[3];
#pragma unroll
            for (int part = 0; part < 3; ++part) { mu0[part] = *(const f32x4*)(mu + part * 512 + 8 * lane); mu1[part] = *(const f32x4*)(mu + part * 512 + 8 * lane + 4); }
            const float mu_wd = mu[1536 + lane], mu_ad = mu[1600 + lane]; const f32x2 mu_gd = *(const f32x2*)(mu + 1664 + 2 * lane);
            const f32x4 gq = *(const f32x4*)(qg + 4 * lane); const f32x2 gkv = *(const f32x2*)(kvg + 2 * lane);
            const int t0 = row0 + 8 * wave;
            u32x4 pw[3]; pw[0] = pw[1] = pw[2] = (u32x4){0u, 0u, 0u, 0u}; float p_wd = 0.f, p_ad = 0.f; unsigned p_gd = 0u;
            if ((t0 % SEQ) != 0) { const bf16* rp = P + (size_t)(t0 - 1) * N_INP + MLA_IN;
#pragma unroll
                for (int part = 0; part < 3; ++part) pw[part] = *(const u32x4*)(rp + part * 512 + 8 * lane);
                p_wd = bf2f(rp[1536 + lane]); p_ad = bf2f(rp[1600 + lane]); p_gd = *(const unsigned*)(rp + 1664 + 2 * lane); }
#pragma unroll 2
            for (int i8 = 0; i8 < 8; ++i8) { const int t = t0 + i8, rl = 8 * wave + i8;
                const bf16* pr = P + (size_t)t * N_INP;
                { const u32x2 qw = *(const u32x2*)(pr + 4 * lane); float q0 = bflo(qw.x), q1 = bfhi(qw.x), q2 = bflo(qw.y), q3 = bfhi(qw.y);
                  const float rq = __builtin_amdgcn_rsqf(wave_sum(q0 * q0 + q1 * q1 + q2 * q2 + q3 * q3) * (1.f / QLR) + RMS_EPS);
                  u32x2 w; w.x = pk2(q0 * rq * gq.x, q1 * rq * gq.y); w.y = pk2(q2 * rq * gq.z, q3 * rq * gq.w); *(LAS u32x2*)(AN + rl * LDA_AN + lane * 8) = w;
                  const unsigned kw = *(const unsigned*)(pr + QLR + 2 * lane); const float k0 = bflo(kw), k1 = bfhi(kw);
                  const float rk = __builtin_amdgcn_rsqf(wave_sum(k0 * k0 + k1 * k1) * (1.f / KVLR) + RMS_EPS);
                  *(LAS unsigned*)(AN + rl * LDA_AN + (QLR + 2 * lane) * 2) = pk2(k0 * rk * gkv.x, k1 * rk * gkv.y);
                  const int i = lane & 15; const unsigned rw = *(const unsigned*)(pr + QLR + KVLR + 2 * i); const float x0 = bflo(rw), x1 = bfhi(rw);
                  const f32x2 csv = *(const f32x2*)(cs + (size_t)t * 32 + 2 * i); const unsigned ro = pk2(x0 * csv.x - x1 * csv.y, x0 * csv.y + x1 * csv.x);
                  if (lane < 16) *(LAS unsigned*)(F.lds + OFF_ROPE + rl * 64 + 4 * i) = ro; }
                const bf16* rr = pr + MLA_IN;
#pragma unroll
                for (int part = 0; part < 3; ++part) {
                    const u32x4 cw = *(const u32x4*)(rr + part * 512 + 8 * lane); const u32x4 pv_ = pw[part]; pw[part] = cw;
                    float o[8];
#pragma unroll
                    for (int j = 0; j < 4; ++j) { const float a = bflo(cw[j]), b = bfhi(cw[j]), pa = bflo(pv_[j]), pb = bfhi(pv_[j]); const float ma = j < 2 ? mu0[part][2 * j] : mu1[part][2 * j - 4], mb = j < 2 ? mu0[part][2 * j + 1] : mu1[part][2 * j - 3];
                        o[2 * j] = a + ma * (pa - a); o[2 * j + 1] = b + mb * (pb - b); }
                    u32x4 w; w.x = pk2(o[0], o[1]); w.y = pk2(o[2], o[3]); w.z = pk2(o[4], o[5]); w.w = pk2(o[6], o[7]);
                    if (part < 2) *(u32x4*)(RK + (size_t)t * 1024 + part * 512 + 8 * lane) = w; else *(u32x4*)(VS + (size_t)t * C5 + 8 * lane) = w;
                }
                { const float a = bf2f(rr[1536 + lane]); const float v = a + mu_wd * (p_wd - a); p_wd = a; *(LAS bf16*)(A2 + rl * LDA_A2 + lane * 2) = (bf16)f2bf(tanhf_(v)); }
                { const float a = bf2f(rr[1600 + lane]); const float v = a + mu_ad * (p_ad - a); p_ad = a; *(LAS bf16*)(A2 + rl * LDA_A2 + (64 + lane) * 2) = (bf16)f2bf(v); }
                { const unsigned cw = *(const unsigned*)(rr + 1664 + 2 * lane); const float a = bflo(cw), b = bfhi(cw); const float va = a + mu_gd.x * (bflo(p_gd) - a), vb = b + mu_gd.y * (bfhi(p_gd) - b); p_gd = cw;
                  *(LAS unsigned*)(A2 + rl * LDA_A2 + (128 + 2 * lane) * 2) = pk2(sigmoidf_(va), sigmoidf_(vb)); }
            }
        }
        __syncthreads();
#pragma unroll 1
        for (int j = 0; j < 4; ++j) { int tid2 = F.tid; asm volatile("" : "+v"(tid2)); const int pc = tid2 + 512 * j, key = pc & 63, c4 = (pc >> 6) & 3, hh = pc >> 8;
            const u32x4 v = *(const LAS u32x4*)(F.lds + OFF_ROPE + key * 64 + c4 * 16); *(u32x4*)(KKb + (size_t)panel * 49152 + hh * 6144 + (8 + c4) * 512 + key * 8) = v; }
        LAS unsigned char* stg = F.lds + OFF_STG + wave * STG_BYTES;
        const int wrot = (wave + F.vcu) & 7, rq = (F.vcu >> 3) % 3, rk = (F.vcu >> 3) & 3, rs6 = (F.vcu >> 3) % 6;
        bf16x8 fq[16], fqn[16];
        load_frags<16>(fqn, PGW, PGW_Q + 16 * (wrot + 8 * rq), lane);
#pragma unroll 1
        for (int it = 0; it < 3; ++it) { const int nb = wrot + 8 * ((it + rq) % 3); f32x16 acc[2]; acc[0] = f32x16{}; acc[1] = f32x16{};
#pragma unroll
            for (int ks = 0; ks < 16; ++ks) fq[ks] = fqn[ks];
            if (it + 1 < 3) load_frags<16>(fqn, PGW, PGW_Q + 16 * (wrot + 8 * ((it + 1 + rq) % 3)), lane);
            const bool rope = (nb % 3) == 2;
            f32x4 c48[2][4];
#pragma unroll
            for (int mt = 0; mt < 2; ++mt)
#pragma unroll
                for (int g = 0; g < 4; ++g) c48[mt][g] = rope ? *(const f32x4*)(cs + (size_t)(row0 + 32 * mt + r) * 32 + 8 * g + 4 * h) : (f32x4){1.f, 0.f, 1.f, 0.f};
            __builtin_amdgcn_sched_barrier(0);
            mma_frags<16>(acc, AN, LDA_AN, 0, fq, r, h);
#pragma unroll
            for (int mt = 0; mt < 2; ++mt) {
#pragma unroll
                for (int g = 0; g < 4; ++g) { float v0 = acc[mt][4 * g], v1 = acc[mt][4 * g + 1], v2 = acc[mt][4 * g + 2], v3 = acc[mt][4 * g + 3];
                    if (rope) { const f32x4 c4 = c48[mt][g];
                        const float a0 = v0, a1 = v1, a2 = v2, a3 = v3; v0 = a0 * c4.x - a1 * c4.y; v1 = a0 * c4.y + a1 * c4.x; v2 = a2 * c4.z - a3 * c4.w; v3 = a2 * c4.w + a3 * c4.z; }
                    stage_put4(stg, mt, g, r, h, v0 * C2Q, v1 * C2Q, v2 * C2Q, v3 * C2Q); } }
            stage_flush(stg, Qb + (size_t)row0 * 768 + 32 * nb, 768, lane); }
        bf16x8 fk[8], fkn[8];
        load_frags<8>(fkn, PGW, PGW_KN + 8 * (wrot + 8 * rk), lane);
#pragma unroll 1
        for (int it = 0; it < 4; ++it) { const int nb = wrot + 8 * ((it + rk) & 3); f32x16 acc[2]; acc[0] = f32x16{}; acc[1] = f32x16{};
            const bool isv = nb >= 16; const int n0 = 32 * (nb & 15);
#pragma unroll
            for (int ks = 0; ks < 8; ++ks) fk[ks] = fkn[ks];
            if (it + 1 < 4) load_frags<8>(fkn, PGW, PGW_KN + 8 * (wrot + 8 * ((it + 1 + rk) & 3)), lane);
            __builtin_amdgcn_sched_barrier(0);
            mma_frags<8>(acc, AN, LDA_AN, 256, fk, r, h);
#pragma unroll
            for (int mt = 0; mt < 2; ++mt)
#pragma unroll
                for (int g = 0; g < 4; ++g) stage_put4(stg, mt, g, r, h, acc[mt][4 * g], acc[mt][4 * g + 1], acc[mt][4 * g + 2], acc[mt][4 * g + 3]);
            if (isv) stage_flush(stg, Vb + (size_t)row0 * C5 + n0, C5, lane);
            else stage_flush_kt(stg, KKb + (size_t)panel * 49152 + (n0 >> 6) * 6144 + ((n0 & 63) >> 3) * 512, lane); }
        bf16x8 fs[8], fsn[8];
#pragma unroll
        for (int ks = 0; ks < 8; ++ks) fsn[ks] = (bf16x8){0, 0, 0, 0, 0, 0, 0, 0};
        { const int nn = wrot + 8 * rs6, kn = nn >> 4;
          if (kn == 2) load_frags<8>(fsn, PGW, PGW_G + 8 * (nn & 15), lane);
          else { bf16x8 t4[4]; load_frags<4>(t4, PGW, (kn == 0 ? PGW_W : PGW_A) + 4 * (nn & 15), lane); fsn[0] = t4[0]; fsn[1] = t4[1]; fsn[2] = t4[2]; fsn[3] = t4[3]; } }
#pragma unroll 1
        for (int it = 0; it < 6; ++it) { const int nb = wrot + 8 * ((it + rs6) % 6); f32x16 acc[2]; acc[0] = f32x16{}; acc[1] = f32x16{};
            const int kind = nb >> 4, n0 = 32 * (nb & 15);
#pragma unroll
            for (int ks = 0; ks < 8; ++ks) fs[ks] = fsn[ks];
            if (it + 1 < 6) { const int nn = wrot + 8 * ((it + 1 + rs6) % 6), kn = nn >> 4;
                if (kn == 2) load_frags<8>(fsn, PGW, PGW_G + 8 * (nn & 15), lane);
                else { bf16x8 t4[4]; load_frags<4>(t4, PGW, (kn == 0 ? PGW_W : PGW_A) + 4 * (nn & 15), lane); fsn[0] = t4[0]; fsn[1] = t4[1]; fsn[2] = t4[2]; fsn[3] = t4[3]; } }
            f32x4 bz4[4];
#pragma unroll
            for (int g = 0; g < 4; ++g) bz4[g] = kind == 2 ? (f32x4){0.f, 0.f, 0.f, 0.f} : *(const f32x4*)((kind == 0 ? w0 : a0p) + n0 + 8 * g + 4 * h);
            __builtin_amdgcn_sched_barrier(0);
            if (kind == 2) mma_frags<8>(acc, A2, LDA_A2, 128, fs, r, h);
            else { bf16x8 t4[4]; t4[0] = fs[0]; t4[1] = fs[1]; t4[2] = fs[2]; t4[3] = fs[3]; mma_frags<4>(acc, A2, LDA_A2, kind == 0 ? 0 : 64, t4, r, h); }
            if (kind == 0) {
#pragma unroll
                for (int mt = 0; mt < 2; ++mt) { float* lrow = LWb + (size_t)(row0 + 32 * mt + r) * C5 + n0;
#pragma unroll
                    for (int g = 0; g < 4; ++g) { const f32x4 bz = bz4[g]; f32x4 o;
#pragma unroll
                        for (int e = 0; e < 4; ++e) { const float z = -(acc[mt][4 * g + e] + bz[e]); const float sp = fmaxf(z, 0.f) + __logf(1.0f + __expf(-fabsf(z))); o[e] = -__expf(-sp - 0.5f); }
                        *(f32x4*)(lrow + 8 * g + 4 * h) = o; } }
            } else {
#pragma unroll
                for (int mt = 0; mt < 2; ++mt)
#pragma unroll
                    for (int g = 0; g < 4; ++g) { float v0 = acc[mt][4 * g], v1 = acc[mt][4 * g + 1], v2 = acc[mt][4 * g + 2], v3 = acc[mt][4 * g + 3];
                        if (kind == 1) { const f32x4 bz = bz4[g]; v0 = sigmoidf_(v0 + bz.x); v1 = sigmoidf_(v1 + bz.y); v2 = sigmoidf_(v2 + bz.z); v3 = sigmoidf_(v3 + bz.w); }
                        stage_put4(stg, mt, g, r, h, v0, v1, v2, v3); }
                stage_flush(stg, AGb + (size_t)row0 * 1024 + (kind - 1) * 512 + n0, 1024, lane); } }
        if (l > 0) {
            int tid2 = F.tid; asm volatile("" : "+v"(tid2)); const int lane2 = tid2 & 63, r2 = tid2 & 31, h2 = (tid2 >> 5) & 1;
            __syncthreads();
            const bf16* VS1 = WSP(bf16, WS_VS1); const bf16* VS0 = WSP(bf16, WS_VS0); bf16* VR = WSP(bf16, WS_VR); const float* v0 = INP(I_V0);
            asm volatile("s_waitcnt vmcnt(0)" ::: "memory");
            __builtin_amdgcn_fence(__ATOMIC_ACQUIRE, "agent"); asm volatile("s_waitcnt vmcnt(0)" ::: "memory");
            for (int i = tid2; i < RP * 64; i += NTHREADS) { const int rl = i >> 6, ch = i & 63; *(LAS u32x4*)(VSl + rl * LDA_VS + ch * 16) = *(const u32x4*)(VS1 + (size_t)(row0 + rl) * C5 + ch * 8); }
            __syncthreads();
#pragma unroll 1
            for (int it = 0; it < 2; ++it) { const int nb = wrot + 8 * ((it + (F.vcu >> 3)) & 1); f32x16 acc[2]; acc[0] = f32x16{}; acc[1] = f32x16{};
                { bf16x8 fv[16]; load_frags<16>(fv, PGW, PGW_VR + 32 * nb, lane2); mma_frags<16>(acc, VSl, LDA_VS, 0, fv, r2, h2); load_frags<16>(fv, PGW, PGW_VR + 32 * nb + 16, lane2); mma_frags<16>(acc, VSl, LDA_VS, 256, fv, r2, h2); }
#pragma unroll
                for (int mt = 0; mt < 2; ++mt) { const int rl = 32 * mt + r2; const size_t row = (size_t)(row0 + rl);
#pragma unroll
                    for (int g = 0; g < 4; ++g) { const int n = 32 * nb + 8 * g + 4 * h2; const f32x4 bz = *(const f32x4*)(v0 + n);
                        const u32x2 sw = *(const LAS u32x2*)(VSl + rl * LDA_VS + n * 2); const u32x2 fw = *(const u32x2*)(VS0 + row * C5 + n);
                        const float s0 = bflo(sw.x), s1 = bfhi(sw.x), s2 = bflo(sw.y), s3 = bfhi(sw.y), f0 = bflo(fw.x), f1 = bfhi(fw.x), f2 = bflo(fw.y), f3 = bfhi(fw.y);
                        stage_put4(stg, mt, g, r2, h2, s0 + (f0 - s0) * sigmoidf_(acc[mt][4 * g] + bz.x), s1 + (f1 - s1) * sigmoidf_(acc[mt][4 * g + 1] + bz.y),
                                   s2 + (f2 - s2) * sigmoidf_(acc[mt][4 * g + 2] + bz.z), s3 + (f3 - s3) * sigmoidf_(acc[mt][4 * g + 3] + bz.w)); } }
                stage_flush(stg, VR + (size_t)row0 * C5 + 32 * nb, C5, lane2); }
        }
    }
    __syncthreads();
}

namespace att {
__device__ __forceinline__ int crow(int r, int hi) { return (r & 3) + 8 * (r >> 2) + 4 * hi; }
constexpr int KSLOT = 12288, VSLOT = 8192;
constexpr int NSLOT = 4;
constexpr int LDS_K = 0, LDS_V = NSLOT * KSLOT, LDS_WS = LDS_V + NSLOT * VSLOT, LDS_OST = LDS_WS + NWAVES * 64 * 4, LDS_TOTAL = LDS_OST + NWAVES * 4096;
__device__ __forceinline__ void glds16(const void* gsrc, unsigned lds_dst) { unsigned keep;
    asm volatile("s_mov_b32 %0, m0\n\ts_mov_b32 m0, %2\n\ts_nop 0\n\tglobal_load_lds_dwordx4 %1, off\n\ts_mov_b32 m0, %0" : "=&s"(keep) : "v"(gsrc), "s"(lds_dst) : "memory"); }
__device__ __forceinline__ float max3f(float a, float b, float c) { return fmaxf(fmaxf(a, b), c); }
#define ATT_WAIT_BAR() asm volatile("s_waitcnt vmcnt(0) lgkmcnt(0)\n\ts_barrier" ::: "memory")
__device__ __forceinline__ float rowmax(const f32x16& p0, const f32x16& p1) {
    float a = max3f(p0[0], p0[1], p1[0]), b = max3f(p0[2], p0[3], p1[1]); a = max3f(a, p1[2], p1[3]);
#pragma unroll
    for (int r = 4; r < 16; r += 4) { a = max3f(a, p0[r], p0[r + 1]); b = max3f(b, p0[r + 2], p0[r + 3]); a = max3f(a, p1[r], p1[r + 1]); b = max3f(b, p1[r + 2], p1[r + 3]); }
    const float m = fmaxf(a, b);
    auto rr = __builtin_amdgcn_permlane32_swap(__float_as_uint(m), __float_as_uint(m), false, false);
    return fmaxf(__uint_as_float(rr[0]), __uint_as_float(rr[1]));
}
__device__ __forceinline__ void pv(f32x16* o, int vb, bf16x8 pa0, bf16x8 pa1, bf16x8 pa2, bf16x8 pa3) {
#pragma unroll
    for (int d0 = 0; d0 < 2; ++d0) { s16x4 lo[4], hi[4];
#pragma unroll
        for (int ks = 0; ks < 4; ++ks) {
            asm volatile("ds_read_b64_tr_b16 %0,%1 offset:%c2" : "=&v"(lo[ks]) : "v"(vb), "i"(d0 * 4096 + ks * 1024) : "memory");
            asm volatile("ds_read_b64_tr_b16 %0,%1 offset:%c2" : "=&v"(hi[ks]) : "v"(vb), "i"(d0 * 4096 + ks * 1024 + 512) : "memory"); }
        asm volatile("s_waitcnt lgkmcnt(0)" ::: "memory"); __builtin_amdgcn_sched_barrier(0);
#define PK(k) (bf16x8){lo[k][0], lo[k][1], lo[k][2], lo[k][3], hi[k][0], hi[k][1], hi[k][2], hi[k][3]}
        o[d0] = __builtin_amdgcn_mfma_f32_32x32x16_bf16(pa0, PK(0), o[d0], 0, 0, 0);
        o[d0] = __builtin_amdgcn_mfma_f32_32x32x16_bf16(pa1, PK(1), o[d0], 0, 0, 0);
        o[d0] = __builtin_amdgcn_mfma_f32_32x32x16_bf16(pa2, PK(2), o[d0], 0, 0, 0);
        o[d0] = __builtin_amdgcn_mfma_f32_32x32x16_bf16(pa3, PK(3), o[d0], 0, 0, 0);
#undef PK
    }
}
__device__ __forceinline__ void attn_unit(int b, int h, int qb, const bf16* Q, const bf16* __restrict__ KKp, const bf16* __restrict__ Vp, bf16* O, char* shm) {
    const int tid = threadIdx.x, lane = tid & 63, r32 = lane & 31, hi = lane >> 5; const int wid = __builtin_amdgcn_readfirstlane(tid >> 6);
    const long rowbase = (long)b * SEQ; const int q0 = qb * 256;
    const bf16* Qw = Q + (rowbase + q0 + wid * 32) * 768 + h * QKD;
    const bf16* Kh = KKp + (size_t)(b * (SEQ / 64)) * 49152 + h * 6144; const bf16* Vh = Vp + rowbase * 512 + h * VD;
    const unsigned lds0 = (unsigned)(uintptr_t)shm;
    float* wsf = (float*)(shm + LDS_WS) + wid * 64;
    const bf16* ksrc0 = Kh + wid * 512 + lane * 8;
    const bf16* ksrc1 = Kh + (8 + (wid & 3)) * 512 + lane * 8;
    const bf16* vsrc = Vh + (long)(16 * (wid & 3) + (lane >> 2)) * 512 + (wid >> 2) * 32 + (lane & 3) * 8;
    const unsigned kdst0 = lds0 + LDS_K + wid * 1024, kdst1 = lds0 + LDS_K + (8 + (wid & 3)) * 1024, vdst = lds0 + LDS_V + wid * 1024;
#define DMA_KV(t, s) do { glds16(ksrc0 + (long)(t) * 49152, (unsigned)__builtin_amdgcn_readfirstlane(kdst0 + (s) * KSLOT)); \
        if (wid < 4) glds16(ksrc1 + (long)(t) * 49152, (unsigned)__builtin_amdgcn_readfirstlane(kdst1 + (s) * KSLOT)); \
        glds16(vsrc + (long)(t) * 64 * 512, (unsigned)__builtin_amdgcn_readfirstlane(vdst + (s) * VSLOT)); } while (0)
    const int vb0 = (int)(lds0 + LDS_V) + ((lane >> 4) & 1) * 32 + (lane & 3) * 8 + (4 * hi + ((lane & 15) >> 2)) * 64;
    const int NT = (q0 + 256) / 64;
    DMA_KV(0, 0); DMA_KV(1, 1);
    bf16x8 qr[6];
#pragma unroll
    for (int d0 = 0; d0 < 6; ++d0) qr[d0] = *reinterpret_cast<const bf16x8*>(&Qw[(long)r32 * 768 + d0 * 16 + hi * 8]);
    float mhat = 0.f, l_reg = 0.f; f32x16 o[2]; o[0] = f32x16{}; o[1] = f32x16{};
    f32x16 negm = f32x16{};
    const int qrel = wid * 32 + r32;
    typedef short v4i16_t __attribute__((ext_vector_type(4)));
    typedef __attribute__((address_space(3))) v4i16_t* lds_v4p;
    u32x4 pw[4]; pw[0] = pw[1] = pw[2] = pw[3] = (u32x4){0u, 0u, 0u, 0u};
    f32x16 pc0, pc1;
    ATT_WAIT_BAR();
    { const char* kb = shm + LDS_K + hi * 1024 + r32 * 16; bf16x8 kf0[6], kf1[6];
#pragma unroll
      for (int d0 = 0; d0 < 6; ++d0) { kf0[d0] = *reinterpret_cast<const bf16x8*>(kb + d0 * 2048); kf1[d0] = *reinterpret_cast<const bf16x8*>(kb + d0 * 2048 + 512); }
      pc0 = __builtin_amdgcn_mfma_f32_32x32x16_bf16(kf0[0], qr[0], negm, 0, 0, 0); pc1 = __builtin_amdgcn_mfma_f32_32x32x16_bf16(kf1[0], qr[0], negm, 0, 0, 0);
#pragma unroll
      for (int d0 = 1; d0 < 6; ++d0) { pc0 = __builtin_amdgcn_mfma_f32_32x32x16_bf16(kf0[d0], qr[d0], pc0, 0, 0, 0); pc1 = __builtin_amdgcn_mfma_f32_32x32x16_bf16(kf1[d0], qr[d0], pc1, 0, 0, 0); } }
    for (int t = 0; t < NT; ++t) {
        if (t > 0) ATT_WAIT_BAR();
        if (t + 2 < NT) DMA_KV(t + 2, (t + 2) & (NSLOT - 1));
        const int vsl = ((t > 0) ? t - 1 : 0) & (NSLOT - 1);
        const int ksl = ((t + 1 < NT) ? t + 1 : t) & (NSLOT - 1);
        const int jb = t - (NT - 4);
        if (jb >= 0) { const int kbase = 64 * jb + 4 * hi;
#pragma unroll
            for (int r = 0; r < 16; ++r) { const int kv = kbase + (r & 3) + 8 * (r >> 2); if (kv > qrel) pc0[r] = -INFINITY; if (kv + 32 > qrel) pc1[r] = -INFINITY; } }
        float rm;
        { s16x4 vlo_[8], vhi_[8]; const lds_v4p vbp_ = (lds_v4p)(vb0 + vsl * VSLOT);
#pragma unroll
          for (int i = 0; i < 8; ++i) { const int off = (i >> 2) * 4096 + (i & 3) * 1024;
              vlo_[i] = __builtin_bit_cast(s16x4, __builtin_amdgcn_ds_read_tr16_b64_v4i16(vbp_ + off / 8)); vhi_[i] = __builtin_bit_cast(s16x4, __builtin_amdgcn_ds_read_tr16_b64_v4i16(vbp_ + (off + 512) / 8)); }
          __builtin_amdgcn_sched_barrier(0);
#pragma unroll
          for (int i = 0; i < 8; ++i) { const bf16x8 vf = (bf16x8){vlo_[i][0], vlo_[i][1], vlo_[i][2], vlo_[i][3], vhi_[i][0], vhi_[i][1], vhi_[i][2], vhi_[i][3]};
              o[i >> 2] = __builtin_amdgcn_mfma_f32_32x32x16_bf16(__builtin_bit_cast(bf16x8, pw[i & 3]), vf, o[i >> 2], 0, 0, 0); }
          rm = rowmax(pc0, pc1);
#pragma unroll
          for (int i = 0; i < 8; ++i) { __builtin_amdgcn_sched_group_barrier(0x8, 1, 0); __builtin_amdgcn_sched_group_barrier(0x2, 3, 0); }
          __builtin_amdgcn_sched_barrier(0); }
        if (t == 0 || __any(rm > 8.0f)) {
            const float dl = (t == 0) ? rm : fmaxf(rm, 0.f); mhat += dl;
#pragma unroll
            for (int r = 0; r < 16; ++r) { pc0[r] -= dl; pc1[r] -= dl; negm[r] = -mhat; }
            const float f = (t == 0) ? 1.0f : __builtin_amdgcn_exp2f(-dl); l_reg *= f; if (hi == 0) wsf[r32] = f;
            asm volatile("s_waitcnt lgkmcnt(0)" ::: "memory");
#pragma unroll
            for (int r = 0; r < 16; ++r) { const float fr_ = wsf[crow(r, hi)]; o[0][r] *= fr_; o[1][r] *= fr_; } }
        f32x16 pn0, pn1;
        { const char* kb = shm + LDS_K + ksl * KSLOT + hi * 1024 + r32 * 16; bf16x8 kf0[6], kf1[6];
#pragma unroll
          for (int d0 = 0; d0 < 6; ++d0) { kf0[d0] = *reinterpret_cast<const bf16x8*>(kb + d0 * 2048); kf1[d0] = *reinterpret_cast<const bf16x8*>(kb + d0 * 2048 + 512); }
          __builtin_amdgcn_sched_barrier(0);
          pn0 = __builtin_amdgcn_mfma_f32_32x32x16_bf16(kf0[0], qr[0], negm, 0, 0, 0); pn1 = __builtin_amdgcn_mfma_f32_32x32x16_bf16(kf1[0], qr[0], negm, 0, 0, 0);
#pragma unroll
          for (int d0 = 1; d0 < 6; ++d0) { pn0 = __builtin_amdgcn_mfma_f32_32x32x16_bf16(kf0[d0], qr[d0], pn0, 0, 0, 0); pn1 = __builtin_amdgcn_mfma_f32_32x32x16_bf16(kf1[d0], qr[d0], pn1, 0, 0, 0); }
          float sa0 = 0.f, sa1 = 0.f, sa2 = 0.f, sa3 = 0.f;
#pragma unroll
          for (int r = 0; r < 16; r += 2) { pc0[r] = __builtin_amdgcn_exp2f(pc0[r]); pc1[r] = __builtin_amdgcn_exp2f(pc1[r]); pc0[r + 1] = __builtin_amdgcn_exp2f(pc0[r + 1]); pc1[r + 1] = __builtin_amdgcn_exp2f(pc1[r + 1]);
              sa0 += pc0[r]; sa1 += pc1[r]; sa2 += pc0[r + 1]; sa3 += pc1[r + 1]; }
          l_reg += (sa0 + sa1) + (sa2 + sa3);
          pw[0] = (u32x4){cvtpk_c(pc0[0], pc0[1]), cvtpk_c(pc0[2], pc0[3]), cvtpk_c(pc0[4], pc0[5]), cvtpk_c(pc0[6], pc0[7])};
          pw[1] = (u32x4){cvtpk_c(pc0[8], pc0[9]), cvtpk_c(pc0[10], pc0[11]), cvtpk_c(pc0[12], pc0[13]), cvtpk_c(pc0[14], pc0[15])};
          pw[2] = (u32x4){cvtpk_c(pc1[0], pc1[1]), cvtpk_c(pc1[2], pc1[3]), cvtpk_c(pc1[4], pc1[5]), cvtpk_c(pc1[6], pc1[7])};
          pw[3] = (u32x4){cvtpk_c(pc1[8], pc1[9]), cvtpk_c(pc1[10], pc1[11]), cvtpk_c(pc1[12], pc1[13]), cvtpk_c(pc1[14], pc1[15])};
#pragma unroll
          for (int i = 0; i < 12; ++i) { __builtin_amdgcn_sched_group_barrier(0x8, 1, 0); __builtin_amdgcn_sched_group_barrier(0x400, 3, 0); __builtin_amdgcn_sched_group_barrier(0x2, 5, 0); }
          __builtin_amdgcn_sched_barrier(0); }
        pc0 = pn0; pc1 = pn1;
    }
    { s16x4 vlo_[8], vhi_[8]; const lds_v4p vbp_ = (lds_v4p)(vb0 + ((NT - 1) & (NSLOT - 1)) * VSLOT);
#pragma unroll
      for (int i = 0; i < 8; ++i) { const int off = (i >> 2) * 4096 + (i & 3) * 1024;
          vlo_[i] = __builtin_bit_cast(s16x4, __builtin_amdgcn_ds_read_tr16_b64_v4i16(vbp_ + off / 8)); vhi_[i] = __builtin_bit_cast(s16x4, __builtin_amdgcn_ds_read_tr16_b64_v4i16(vbp_ + (off + 512) / 8)); }
#pragma unroll
      for (int i = 0; i < 8; ++i) { const bf16x8 vf = (bf16x8){vlo_[i][0], vlo_[i][1], vlo_[i][2], vlo_[i][3], vhi_[i][0], vhi_[i][1], vhi_[i][2], vhi_[i][3]};
          o[i >> 2] = __builtin_amdgcn_mfma_f32_32x32x16_bf16(__builtin_bit_cast(bf16x8, pw[i & 3]), vf, o[i >> 2], 0, 0, 0); } }
    { auto rr = __builtin_amdgcn_permlane32_swap(__float_as_uint(l_reg), __float_as_uint(l_reg), false, false); l_reg = __uint_as_float(rr[0]) + __uint_as_float(rr[1]); }
    if (hi == 0) wsf[32 + r32] = l_reg; asm volatile("s_waitcnt lgkmcnt(0)" ::: "memory");
    float rli[16];
#pragma unroll
    for (int r = 0; r < 16; ++r) rli[r] = __builtin_amdgcn_rcpf(wsf[32 + crow(r, hi)]);
    bf16* Ow = O + (rowbase + q0 + wid * 32) * 512 + h * VD;
    { bf16* stg = (bf16*)(shm + LDS_OST) + wid * 2048;
#pragma unroll
      for (int r = 0; r < 16; ++r) { const int orow = crow(r, hi);
#pragma unroll
          for (int d0 = 0; d0 < 2; ++d0) stg[orow * 64 + d0 * 32 + r32] = (bf16)f2bf(o[d0][r] * rli[r]); }
      asm volatile("s_waitcnt lgkmcnt(0)" ::: "memory");
#pragma unroll
      for (int i = 0; i < 4; ++i) { const int row = i * 8 + (lane >> 3), ch = lane & 7; const u32x4 v = *(const u32x4*)(stg + row * 64 + ch * 8); *(u32x4*)(Ow + (long)row * 512 + ch * 8) = v; } }
    asm volatile("s_waitcnt vmcnt(0) lgkmcnt(0)\n\ts_barrier" ::: "memory");
#undef DMA_KV
}
}

__device__ __forceinline__ void phase_attn(const Params& p, const Frame& F, char* lds_generic, int l) {
    const bf16* Q = WSP(bf16, WS_Q); const bf16* KKp = WSP(bf16, WS_KK); const bf16* Vp = WSP(bf16, WS_V); bf16* O = WSP(bf16, WS_O);
    unsigned* head = (unsigned*)(F.ws + WS_CTL) + CW_ATTQ + l * 64;
    volatile LAS unsigned* MISC = (volatile LAS unsigned*)(F.lds + MISC_OFF);
    for (;;) {
        if (F.tid == 0) MISC[16] = __hip_atomic_fetch_add(head, 1u, RLX_AGENT);
        __syncthreads();
        const unsigned k = MISC[16];
        __syncthreads();
        if (k >= 1024u) break;
        const int qb = 15 - (int)(k >> 6), bh = (int)(k & 63u);
        att::attn_unit(bh >> 3, bh & 7, qb, Q, KKp, Vp, O, lds_generic);
    }
}

namespace rw {
constexpr int RS = 144;
constexpr int SLOT = 64 * RS;
constexpr int S_KT = 0, S_RT = 1, S_BC = 2, S_KC = 3, S_V = 4, S_BH = 5, S_KH = 6, S_GT = 7, S_ABK = 8, S_AKK = 9, S_AKR = 10, S_ABR = 11, S_ABKF = 12;
constexpr int S_TT = S_BC, S_ZT = S_KC, S_NW1T = S_AKK, S_NW2T = S_ABK;
constexpr int TOT_OFF = 13 * SLOT, PL_OFF = TOT_OFF + 8 * 64 * 4;
typedef short v4i16_t __attribute__((ext_vector_type(4)));
__device__ __forceinline__ int crow(int r, int hi) { return (r & 3) + 8 * (r >> 2) + 4 * hi; }
__device__ __forceinline__ bf16x8 frag_d(const LAS unsigned char* M, int row0, int k0, int r, int h) { return *(const LAS bf16x8*)(M + (row0 + r) * RS + (k0 + 8 * h) * 2); }
__device__ __forceinline__ bf16x8 frag_t(const LAS unsigned char* M, int k0, int col0, int lane) {
    const int h = lane >> 5, blk = (lane >> 4) & 1, q = (lane & 15) >> 2, pp = lane & 3;
    const LAS unsigned char* a = M + (k0 + 8 * h + q) * RS + (col0 + 16 * blk + 4 * pp) * 2;
    const v4i16_t lo = __builtin_amdgcn_ds_read_tr16_b64_v4i16((LAS v4i16_t*)a), hi = __builtin_amdgcn_ds_read_tr16_b64_v4i16((LAS v4i16_t*)(a + 4 * RS));
    return (bf16x8){lo[0], lo[1], lo[2], lo[3], hi[0], hi[1], hi[2], hi[3]};
}
__device__ __forceinline__ void store_T(LAS unsigned char* D, int m0, int n0, const f32x16& acc, float sgn, int r, int h) {
#pragma unroll
    for (int g = 0; g < 4; ++g) { u32x2 w; w.x = cvtpk_c(acc[4 * g] * sgn, acc[4 * g + 1] * sgn); w.y = cvtpk_c(acc[4 * g + 2] * sgn, acc[4 * g + 3] * sgn);
        *(LAS u32x2*)(D + (n0 + r) * RS + (m0 + 8 * g + 4 * h) * 2) = w; }
}
#define RW_MMA(acc, A, B) acc = __builtin_amdgcn_mfma_f32_32x32x16_bf16((A), (B), acc, 0, 0, 0)
}

#define LBAR() asm volatile("s_waitcnt lgkmcnt(0)\n\ts_barrier" ::: "memory")
__device__ __forceinline__ void phase_rwkv_r1(const Params& p, const Frame& F, int l) {
    using namespace rw;
    LAS unsigned char* L0 = F.lds;
#define SL(i) (L0 + (i) * SLOT)
    const bf16* RK = WSP(bf16, WS_RK); const float* LWp = WSP(float, WS_LW); const bf16* AGp = WSP(bf16, WS_AG);
    const bf16* Vv = l == 0 ? WSP(bf16, WS_VS0) : WSP(bf16, WS_VR);
    float* CH = WSP(float, WS_CH); float* BON = WSP(float, WS_AN);
    const float* kkw = INP(I_KK) + (size_t)l * C5; const float* kaw = INP(I_KA) + (size_t)l * C5; const float* rkw = INP(I_RK) + (size_t)l * C5;
    const int tid0 = F.tid, wave = F.wave;
    const int pt0 = (tid0 >> 6) * 8 + (tid0 & 7), j80 = (tid0 >> 3) & 7;
    LAS float* tot = (LAS float*)(L0 + TOT_OFF); LAS float* PLv = (LAS float*)(L0 + PL_OFF);
    u32x4 g_r, g_k, g_v, g_a; f32x4 g_l0, g_l1;
#define R1_FETCH(uu) do { const int bh_ = (uu) >> 6, cc_ = (uu) & 63; const size_t tok = (size_t)(bh_ >> 3) * SEQ + (size_t)cc_ * 64 + pt0; const int c_ = (bh_ & 7) * 64 + 8 * j80; \
        g_r = *(const u32x4*)(RK + tok * 1024 + c_); g_k = *(const u32x4*)(RK + tok * 1024 + 512 + c_); g_v = *(const u32x4*)(Vv + tok * C5 + c_); \
        g_l0 = *(const f32x4*)(LWp + tok * C5 + c_); g_l1 = *(const f32x4*)(LWp + tok * C5 + c_ + 4); g_a = *(const u32x4*)(AGp + tok * 1024 + c_); } while (0)
    int u = F.vcu;
    if (u < 4096) R1_FETCH(u);
    for (; u < 4096; u += F.G) {
        const int hh = (u >> 6) & 7;
        int tid = tid0; asm volatile("" : "+v"(tid)); const int lane = tid & 63, r = lane & 31, h = lane >> 5, pt = (tid >> 6) * 8 + (tid & 7), j8 = (tid >> 3) & 7;
        {
            const int c = hh * 64 + 8 * j8;
            const f32x4 kk0 = *(const f32x4*)(kkw + c), kk1 = *(const f32x4*)(kkw + c + 4), ka0 = *(const f32x4*)(kaw + c), ka1 = *(const f32x4*)(kaw + c + 4);
            float rr[8], k[8], a[8], x[8], lw[8], kap[8], be[8], kp[8]; float ss = 0.f;
#pragma unroll
            for (int j = 0; j < 4; ++j) { rr[2 * j] = bflo(g_r[j]); rr[2 * j + 1] = bfhi(g_r[j]); k[2 * j] = bflo(g_k[j]); k[2 * j + 1] = bfhi(g_k[j]); }
            *(LAS u32x4*)(SL(S_V) + pt * RS + j8 * 16) = g_v;
#pragma unroll
            for (int j = 0; j < 8; ++j) { a[j] = (j & 1) ? bfhi(g_a[j >> 1]) : bflo(g_a[j >> 1]); lw[j] = j < 4 ? g_l0[j & 3] : g_l1[j & 3]; x[j] = lw[j]; const float q = k[j] * (j < 4 ? kk0[j & 3] : kk1[j & 3]); kap[j] = q; ss += q * q; }
            ss += __shfl_xor(ss, 8); ss += __shfl_xor(ss, 16); ss += __shfl_xor(ss, 32);
            const float inv = 1.0f / fmaxf(sqrtf(ss), 1e-12f);
#pragma unroll
            for (int j = 0; j < 8; ++j) { kap[j] *= inv; be[j] = kap[j] * a[j]; kp[j] = k[j] * (1.0f + (a[j] - 1.0f) * (j < 4 ? ka0[j & 3] : ka1[j & 3])); }
            { const f32x4 rk0 = *(const f32x4*)(rkw + c), rk1 = *(const f32x4*)(rkw + c + 4); float bon = 0.f;
#pragma unroll
              for (int j = 0; j < 8; ++j) bon += rr[j] * kp[j] * (j < 4 ? rk0[j & 3] : rk1[j & 3]);
              bon += __shfl_xor(bon, 8); bon += __shfl_xor(bon, 16); bon += __shfl_xor(bon, 32);
              if (j8 == 0) BON[((size_t)(u >> 9) * SEQ + (size_t)(u & 63) * 64 + pt) * 8 + hh] = bon; }
            const int tl = lane & 7;
#pragma unroll
            for (int j = 0; j < 8; ++j) { float y;
                y = __builtin_bit_cast(float, __builtin_amdgcn_update_dpp(0, __builtin_bit_cast(int, x[j]), 0x111, 0xF, 0xF, true)); x[j] += (tl >= 1) ? y : 0.f;
                y = __builtin_bit_cast(float, __builtin_amdgcn_update_dpp(0, __builtin_bit_cast(int, x[j]), 0x112, 0xF, 0xF, true)); x[j] += (tl >= 2) ? y : 0.f;
                y = __builtin_bit_cast(float, __builtin_amdgcn_update_dpp(0, __builtin_bit_cast(int, x[j]), 0x114, 0xF, 0xF, true)); x[j] += (tl >= 4) ? y : 0.f; }
            if (tl == 7) { *(LAS f32x4*)(tot + wave * 64 + 8 * j8) = (f32x4){x[0], x[1], x[2], x[3]}; *(LAS f32x4*)(tot + wave * 64 + 8 * j8 + 4) = (f32x4){x[4], x[5], x[6], x[7]}; }
            LBAR();
            float csL[8];
#pragma unroll
            for (int j = 0; j < 8; ++j) csL[j] = 0.f;
#pragma unroll
            for (int w2 = 0; w2 < 8; ++w2) { const f32x4 t0 = *(const LAS f32x4*)(tot + w2 * 64 + 8 * j8), t1 = *(const LAS f32x4*)(tot + w2 * 64 + 8 * j8 + 4);
#pragma unroll
                for (int j = 0; j < 8; ++j) { const float tv = j < 4 ? t0[j & 3] : t1[j & 3]; csL[j] += tv; if (w2 < wave) x[j] += tv; } }
            if (pt == 0) {
#pragma unroll
                for (int j = 0; j < 8; ++j) PLv[8 * j8 + j] = __expf(csL[j]); }
            float kt[8], rt[8], bc[8], kc[8], bh[8], kh[8];
#pragma unroll
            for (int j = 0; j < 8; ++j) { const float eP = __expf(x[j]), ePm1 = __expf(x[j] - lw[j]), eInv = __expf(-x[j]), eL = __expf(csL[j] - x[j]);
                kt[j] = kap[j] * ePm1; rt[j] = rr[j] * eP; bc[j] = be[j] * eInv; kc[j] = kp[j] * eInv; bh[j] = be[j] * eL; kh[j] = kp[j] * eL; }
#define PK8(v) (u32x4){cvtpk_c(v[0], v[1]), cvtpk_c(v[2], v[3]), cvtpk_c(v[4], v[5]), cvtpk_c(v[6], v[7])}
            *(LAS u32x4*)(SL(S_KT) + pt * RS + j8 * 16) = PK8(kt); *(LAS u32x4*)(SL(S_RT) + pt * RS + j8 * 16) = PK8(rt);
            *(LAS u32x4*)(SL(S_BC) + pt * RS + j8 * 16) = PK8(bc); *(LAS u32x4*)(SL(S_KC) + pt * RS + j8 * 16) = PK8(kc);
            *(LAS u32x4*)(SL(S_BH) + pt * RS + j8 * 16) = PK8(bh); *(LAS u32x4*)(SL(S_KH) + pt * RS + j8 * 16) = PK8(kh);
#undef PK8
        }
        LBAR();
        {
            const int mat = wave >> 1, ti = wave & 1;
            const LAS unsigned char* X = (mat < 2) ? SL(S_KT) : SL(S_RT); const LAS unsigned char* Y = (mat == 0 || mat == 3) ? SL(S_BC) : SL(S_KC);
            LAS unsigned char* Dm = SL(S_ABK + mat);
            const int t = 32 * ti + r;
            bf16x8 xb[4];
#pragma unroll
            for (int kk = 0; kk < 4; ++kk) xb[kk] = frag_d(X, 32 * ti, 16 * kk, r, h);
#pragma unroll
            for (int si = 0; si < 2; ++si) {
                f32x16 acc = f32x16{};
                if (!(ti == 0 && si == 1)) {
#pragma unroll
                    for (int kk = 0; kk < 4; ++kk) RW_MMA(acc, frag_d(Y, 32 * si, 16 * kk, r, h), xb[kk]); }
#pragma unroll
                for (int g = 0; g < 4; ++g) { float v[4];
#pragma unroll
                    for (int e = 0; e < 4; ++e) { const int sidx = 32 * si + 8 * g + 4 * h + e; const bool keep = (mat < 2) ? (sidx < t) : (sidx <= t); v[e] = keep ? acc[4 * g + e] : 0.f; }
                    u32x2 w; w.x = cvtpk_c(v[0], v[1]); w.y = cvtpk_c(v[2], v[3]);
                    *(LAS u32x2*)(Dm + t * RS + (32 * si + 8 * g + 4 * h) * 2) = w;
                    if (mat == 0 && ti == si) *(LAS f32x4*)(SL(S_ABKF) + ti * 4608 + r * 144 + (8 * g + 4 * h) * 4) = (f32x4){v[0], v[1], v[2], v[3]}; }
            }
        }
        LBAR();
        if (wave == 0) {
            const int hb = lane >> 5, c = lane & 31; const LAS unsigned char* Ab = SL(S_ABKF) + hb * 4608;
            float Tc[32];
#pragma unroll
            for (int t = 0; t < 32; ++t) Tc[t] = 0.f;
            f32x4 an[8];
#pragma unroll
            for (int s4 = 0; s4 < 8; ++s4) an[s4] = (f32x4){0.f, 0.f, 0.f, 0.f};
#pragma unroll
            for (int t = 0; t < 32; ++t) { float acc0 = (t == c) ? 1.0f : 0.0f, acc1 = 0.f;
                f32x4 ac[8];
#pragma unroll
                for (int s4 = 0; s4 < 8; ++s4) ac[s4] = an[s4];
                if (t + 1 < 32) {
#pragma unroll
                    for (int s4 = 0; s4 < (t + 4) / 4; ++s4) an[s4] = *(const LAS f32x4*)(Ab + (t + 1) * 144 + s4 * 16); }
#pragma unroll
                for (int s4 = 0; s4 < (t + 3) / 4; ++s4) { const f32x4 a4 = ac[s4];
                    acc0 -= a4.x * Tc[4 * s4]; acc1 -= a4.y * Tc[4 * s4 + 1]; acc0 -= a4.z * Tc[4 * s4 + 2]; acc1 -= a4.w * Tc[4 * s4 + 3]; }
                float acc = acc0 + acc1;
                asm volatile("" : "+v"(acc) :: "memory");
                Tc[t] = acc; }
#pragma unroll
            for (int q = 0; q < 4; ++q) *(LAS u32x4*)(SL(S_TT) + (32 * hb + c) * RS + (32 * hb) * 2 + q * 16) =
                (u32x4){cvtpk_c(Tc[8 * q], Tc[8 * q + 1]), cvtpk_c(Tc[8 * q + 2], Tc[8 * q + 3]), cvtpk_c(Tc[8 * q + 4], Tc[8 * q + 5]), cvtpk_c(Tc[8 * q + 6], Tc[8 * q + 7])};
            { f32x16 acc = f32x16{};
#pragma unroll
              for (int kk = 0; kk < 2; ++kk) RW_MMA(acc, frag_d(SL(S_ABK), 32, 16 * kk, r, h), frag_d(SL(S_TT), 0, 16 * kk, r, h));
              store_T(SL(S_ZT), 0, 0, acc, 1.0f, r, h); }
            { f32x16 acc = f32x16{};
#pragma unroll
              for (int kk = 0; kk < 2; ++kk) RW_MMA(acc, frag_t(SL(S_TT), 32 + 16 * kk, 32, lane), frag_d(SL(S_ZT), 0, 16 * kk, r, h));
              store_T(SL(S_TT), 32, 0, acc, -1.0f, r, h); }
        } else if (wave == 1) {
            const int row = 32 + (lane >> 1), hf = lane & 1;
            *(LAS u32x4*)(SL(S_TT) + row * RS + hf * 32) = (u32x4){0u, 0u, 0u, 0u}; *(LAS u32x4*)(SL(S_TT) + row * RS + hf * 32 + 16) = (u32x4){0u, 0u, 0u, 0u};
        } else if (wave >= 4) {
            const int ti = (wave - 4) >> 1, ii = (wave - 4) & 1; f32x16 acc = f32x16{};
#pragma unroll
            for (int kk = 0; kk < 4; ++kk) RW_MMA(acc, frag_d(SL(S_AKK), 32 * ti, 16 * kk, r, h), frag_t(SL(S_V), 16 * kk, 32 * ii, lane));
            store_T(SL(S_GT), 32 * ti, 32 * ii, acc, 1.0f, r, h);
        }
        LBAR();
        if (u + F.G < 4096) R1_FETCH(u + F.G);
        { const int w4 = wave & 3, ti = w4 >> 1, ci = w4 & 1; f32x16 acc = f32x16{};
          if (wave < 4) {
#pragma unroll
              for (int kk = 0; kk < 4; ++kk) RW_MMA(acc, frag_t(SL(S_TT), 16 * kk, 32 * ti, lane), frag_t(SL(S_KT), 16 * kk, 32 * ci, lane));
              store_T(SL(S_NW1T), 32 * ti, 32 * ci, acc, -1.0f, r, h); }
          else {
#pragma unroll
              for (int kk = 0; kk < 4; ++kk) RW_MMA(acc, frag_t(SL(S_TT), 16 * kk, 32 * ti, lane), frag_d(SL(S_GT), 32 * ci, 16 * kk, r, h));
              store_T(SL(S_NW2T), 32 * ti, 32 * ci, acc, -1.0f, r, h); } }
        LBAR();
        { const int which = wave >> 1, mi = wave & 1; float* dst = CH + ((size_t)u * 4 + which) * 4096;
#pragma unroll
          for (int ni = 0; ni < 2; ++ni) { f32x16 acc = f32x16{};
#pragma unroll
              for (int kk = 0; kk < 4; ++kk) {
                  if (which == 0) RW_MMA(acc, frag_d(SL(S_ABR), 32 * mi, 16 * kk, r, h), frag_d(SL(S_NW1T), 32 * ni, 16 * kk, r, h));
                  else if (which == 1) { RW_MMA(acc, frag_d(SL(S_AKR), 32 * mi, 16 * kk, r, h), frag_t(SL(S_V), 16 * kk, 32 * ni, lane)); RW_MMA(acc, frag_d(SL(S_ABR), 32 * mi, 16 * kk, r, h), frag_d(SL(S_NW2T), 32 * ni, 16 * kk, r, h)); }
                  else if (which == 2) RW_MMA(acc, frag_t(SL(S_BH), 16 * kk, 32 * mi, lane), frag_d(SL(S_NW1T), 32 * ni, 16 * kk, r, h));
                  else { RW_MMA(acc, frag_t(SL(S_KH), 16 * kk, 32 * mi, lane), frag_t(SL(S_V), 16 * kk, 32 * ni, lane)); RW_MMA(acc, frag_t(SL(S_BH), 16 * kk, 32 * mi, lane), frag_d(SL(S_NW2T), 32 * ni, 16 * kk, r, h)); } }
              const int n = 32 * ni + r;
              if (which != 2) {
                  bf16* d16 = (bf16*)dst;
#pragma unroll
                  for (int rg = 0; rg < 16; rg += 2) { const int m = 32 * mi + crow(rg, h); float va = acc[rg], vb = acc[rg + 1];
                      if (which == 0) { va += bf2f(*(const LAS bf16*)(SL(S_RT) + m * RS + n * 2)); vb += bf2f(*(const LAS bf16*)(SL(S_RT) + (m + 1) * RS + n * 2)); }
                      const float send = (lane & 1) ? va : vb;
                      const float recv = __uint_as_float((unsigned)__builtin_amdgcn_update_dpp(0, (int)__float_as_uint(send), 0xB1, 0xF, 0xF, false));
                      const unsigned w = (lane & 1) ? cvtpk_c(recv, vb) : cvtpk_c(va, recv);
                      *(unsigned*)(d16 + (m + (lane & 1)) * 64 + (n & ~1)) = w; } }
              else {
#pragma unroll
                  for (int rg = 0; rg < 16; ++rg) { const int m = 32 * mi + crow(rg, h); float v = acc[rg];
                      if (which == 2 && m == n) v += PLv[n];
                      dst[m * 64 + n] = v; } } } }
        LBAR();
    }
#undef R1_FETCH
#undef SL
}

__device__ __forceinline__ void phase_rwkv_r2(const Params& p, const Frame& F) {
    const float* CH = WSP(float, WS_CH); float* RO = WSP(float, WS_RO);
    LAS float* stb = (LAS float*)(F.lds);
    constexpr int STB = 4 * 1280;
    const int lane = F.lane, wave = F.wave, q = lane >> 4, li = lane & 15, w4 = wave & 3;
    const int nr2 = F.G >= 4 ? F.G / 4 : 1;
    if (F.vcu >= nr2) return;
    for (int bh = F.vcu; bh < 64; bh += nr2) {
        const int b = bh >> 3, hh = bh & 7;
        __syncthreads();
        for (int i = F.tid; i < 2 * STB; i += NTHREADS) stb[i] = 0.f;
        __syncthreads();
        const float* basec = CH + (size_t)bh * 64 * 4 * 4096;
        if (wave < 4) {
            f32x4 fa[2][4]; u32x4 fc[2][4];
#define R2_FETCH_S(cc, st) do { const float* pa = basec + ((size_t)(cc) * 4 + 2) * 4096 + (16 * w4 + li) * 64 + 16 * q; fa[st][0] = *(const f32x4*)(pa); fa[st][1] = *(const f32x4*)(pa + 4); fa[st][2] = *(const f32x4*)(pa + 8); fa[st][3] = *(const f32x4*)(pa + 12); \
                const bf16* pc = (const bf16*)(basec + ((size_t)(cc) * 4 + 3) * 4096) + (16 * w4 + 4 * q) * 64 + li; \
                _Pragma("unroll") for (int ct = 0; ct < 4; ++ct) fc[st][ct] = (u32x4){(unsigned)pc[16 * ct], (unsigned)pc[64 + 16 * ct], (unsigned)pc[128 + 16 * ct], (unsigned)pc[192 + 16 * ct]}; } while (0)
            R2_FETCH_S(0, 0); R2_FETCH_S(1, 1);
#pragma unroll 1
            for (int c0 = 0; c0 < 64; c0 += 2) {
#pragma unroll
                for (int st = 0; st < 2; ++st) { const int c = c0 + st;
                    const f32x4 A0 = fa[st][0], A1 = fa[st][1], A2 = fa[st][2], A3 = fa[st][3];
                    f32x4 acc[4];
#pragma unroll
                    for (int ct = 0; ct < 4; ++ct)
#pragma unroll
                        for (int j = 0; j < 4; ++j) acc[ct][j] = __uint_as_float(fc[st][ct][j] << 16);
                    { const int cn = (c + 2 < 64) ? c + 2 : 63; R2_FETCH_S(cn, st); }
#pragma unroll
                    for (int ct = 0; ct < 4; ++ct) { const LAS float* sb = stb + (c & 1) * STB + ct * 1280 + lane * 20;
                        const f32x4 b0 = *(const LAS f32x4*)(sb), b1 = *(const LAS f32x4*)(sb + 4), b2 = *(const LAS f32x4*)(sb + 8), b3 = *(const LAS f32x4*)(sb + 12);
#pragma unroll
                        for (int k = 0; k < 4; ++k) acc[ct] = __builtin_amdgcn_mfma_f32_16x16x4f32(A0[k], b0[k], acc[ct], 0, 0, 0);
#pragma unroll
                        for (int k = 0; k < 4; ++k) acc[ct] = __builtin_amdgcn_mfma_f32_16x16x4f32(A1[k], b1[k], acc[ct], 0, 0, 0);
#pragma unroll
                        for (int k = 0; k < 4; ++k) acc[ct] = __builtin_amdgcn_mfma_f32_16x16x4f32(A2[k], b2[k], acc[ct], 0, 0, 0);
#pragma unroll
                        for (int k = 0; k < 4; ++k) acc[ct] = __builtin_amdgcn_mfma_f32_16x16x4f32(A3[k], b3[k], acc[ct], 0, 0, 0); }
#pragma unroll
                    for (int ct = 0; ct < 4; ++ct) *(LAS f32x4*)(stb + ((c + 1) & 1) * STB + ct * 1280 + (w4 * 16 + li) * 20 + 4 * q) = acc[ct];
                    LBAR();
                }
            }
#undef R2_FETCH_S
        } else {
            u32x4 fa[2][2], fc[2][4];
#define R2_FETCH_O(cc, st) do { const bf16* pa = (const bf16*)(basec + ((size_t)(cc) * 4 + 0) * 4096) + (16 * w4 + li) * 64 + 8 * q;        \
                fa[st][0] = *(const u32x4*)(pa); fa[st][1] = *(const u32x4*)(pa + 32); \
                const bf16* pc = (const bf16*)(basec + ((size_t)(cc) * 4 + 1) * 4096) + (16 * w4 + 4 * q) * 64 + li; \
                _Pragma("unroll") for (int ct = 0; ct < 4; ++ct) fc[st][ct] = (u32x4){(unsigned)pc[16 * ct], (unsigned)pc[64 + 16 * ct], (unsigned)pc[128 + 16 * ct], (unsigned)pc[192 + 16 * ct]}; } while (0)
            R2_FETCH_O(0, 0); R2_FETCH_O(1, 1);
#pragma unroll 1
            for (int c0 = 0; c0 < 64; c0 += 2) {
#pragma unroll
                for (int st = 0; st < 2; ++st) { const int c = c0 + st;
                    const bf16x8 a0 = __builtin_bit_cast(bf16x8, fa[st][0]), a1 = __builtin_bit_cast(bf16x8, fa[st][1]);
                    f32x4 acc[4];
#pragma unroll
                    for (int ct = 0; ct < 4; ++ct)
#pragma unroll
                        for (int j = 0; j < 4; ++j) acc[ct][j] = __uint_as_float(fc[st][ct][j] << 16);
                    { const int cn = (c + 2 < 64) ? c + 2 : 63; R2_FETCH_O(cn, st); }
#pragma unroll
                    for (int ct = 0; ct < 4; ++ct) { const LAS float* sb = stb + (c & 1) * STB + ct * 1280 + ((q >> 1) * 16 + li) * 20 + 8 * (q & 1);
                        const f32x4 x0 = *(const LAS f32x4*)(sb), x1 = *(const LAS f32x4*)(sb + 4), y0 = *(const LAS f32x4*)(sb + 640), y1 = *(const LAS f32x4*)(sb + 644);
                        const u32x4 p0 = (u32x4){cvtpk_c(x0.x, x0.y), cvtpk_c(x0.z, x0.w), cvtpk_c(x1.x, x1.y), cvtpk_c(x1.z, x1.w)}, p1 = (u32x4){cvtpk_c(y0.x, y0.y), cvtpk_c(y0.z, y0.w), cvtpk_c(y1.x, y1.y), cvtpk_c(y1.z, y1.w)};
                        acc[ct] = __builtin_amdgcn_mfma_f32_16x16x32_bf16(a0, __builtin_bit_cast(bf16x8, p0), acc[ct], 0, 0, 0);
                        acc[ct] = __builtin_amdgcn_mfma_f32_16x16x32_bf16(a1, __builtin_bit_cast(bf16x8, p1), acc[ct], 0, 0, 0); }
                    float* ro = RO + ((size_t)b * SEQ + (size_t)c * 64 + 16 * w4 + 4 * q) * C5 + hh * 64 + li;
#pragma unroll
                    for (int ct = 0; ct < 4; ++ct) { ro[16 * ct] = acc[ct][0]; ro[C5 + 16 * ct] = acc[ct][1]; ro[2 * C5 + 16 * ct] = acc[ct][2]; ro[3 * C5 + 16 * ct] = acc[ct][3]; }
                    LBAR();
                }
            }
#undef R2_FETCH_O
        }
    }
    __syncthreads();
}
#undef LBAR

__device__ __forceinline__ void phase_mix(const Params& p, const Frame& F, int l) {
    const int gw = F.vcu * NWAVES + F.wave, NGW = F.G * NWAVES; const int lane = F.lane;
    const bf16* O = WSP(bf16, WS_O); const float* RO = WSP(float, WS_RO); const float* BON = WSP(float, WS_AN); const bf16* AGp = WSP(bf16, WS_AG);
    const bf16* Vv = l == 0 ? WSP(bf16, WS_VS0) : WSP(bf16, WS_VR); bf16* MIX = WSP(bf16, WS_MIX);
    const float* og = INP(I_MOUTG) + (size_t)l * C5; const float* gng = INP(I_GNG) + (size_t)l * C5; const float* gnb = INP(I_GNB) + (size_t)l * C5;
#pragma unroll 4
    for (int t = gw; t < T; t += NGW) {
        const int c = 8 * lane;
        { const u32x4 ow = *(const u32x4*)(O + (size_t)t * C5 + c); float o[8]; float ss = 0.f;
#pragma unroll
          for (int j = 0; j < 4; ++j) { o[2 * j] = bflo(ow[j]); o[2 * j + 1] = bfhi(ow[j]); ss += o[2 * j] * o[2 * j] + o[2 * j + 1] * o[2 * j + 1]; }
          const float rs = 1.f / sqrtf(wave_sum(ss) * (1.f / C5) + RMS_EPS);
          const f32x4 g0 = *(const f32x4*)(og + c), g1 = *(const f32x4*)(og + c + 4);
          u32x4 w; w.x = pk2(o[0] * rs * g0.x, o[1] * rs * g0.y); w.y = pk2(o[2] * rs * g0.z, o[3] * rs * g0.w); w.z = pk2(o[4] * rs * g1.x, o[5] * rs * g1.y); w.w = pk2(o[6] * rs * g1.z, o[7] * rs * g1.w);
          *(u32x4*)(MIX + (size_t)t * D + c) = w; }
        { const f32x4 r0 = *(const f32x4*)(RO + (size_t)t * C5 + c), r1 = *(const f32x4*)(RO + (size_t)t * C5 + c + 4);
          float o[8]; float s = 0.f;
#pragma unroll
          for (int j = 0; j < 8; ++j) { o[j] = j < 4 ? r0[j & 3] : r1[j & 3]; s += o[j]; }
          s += __shfl_xor(s, 1); s += __shfl_xor(s, 2); s += __shfl_xor(s, 4); const float mean = s * (1.f / 64.f); float q = 0.f;
#pragma unroll
          for (int j = 0; j < 8; ++j) { o[j] -= mean; q += o[j] * o[j]; }
          q += __shfl_xor(q, 1); q += __shfl_xor(q, 2); q += __shfl_xor(q, 4); const float rstd = 1.f / sqrtf(q * (1.f / 64.f) + GN_EPS);
          const u32x4 vw = *(const u32x4*)(Vv + (size_t)t * C5 + c);
          const u32x4 gw = *(const u32x4*)(AGp + (size_t)t * 1024 + 512 + c);
          const float bon = BON[(size_t)t * 8 + (lane >> 3)];
          const f32x4 g0 = (f32x4){bflo(gw.x), bfhi(gw.x), bflo(gw.y), bfhi(gw.y)}, g1 = (f32x4){bflo(gw.z), bfhi(gw.z), bflo(gw.w), bfhi(gw.w)};
          const f32x4 gg0 = *(const f32x4*)(gng + c), gg1 = *(const f32x4*)(gng + c + 4), gb0 = *(const f32x4*)(gnb + c), gb1 = *(const f32x4*)(gnb + c + 4);
          float v[8];
#pragma unroll
          for (int j = 0; j < 4; ++j) { v[2 * j] = bflo(vw[j]); v[2 * j + 1] = bfhi(vw[j]); }
          float y[8];
#pragma unroll
          for (int j = 0; j < 8; ++j) { const float gn = o[j] * rstd * (j < 4 ? gg0[j & 3] : gg1[j & 3]) + (j < 4 ? gb0[j & 3] : gb1[j & 3]); y[j] = (gn + bon * v[j]) * (j < 4 ? g0[j & 3] : g1[j & 3]); }
          u32x4 w; w.x = pk2(y[0], y[1]); w.y = pk2(y[2], y[3]); w.z = pk2(y[4], y[5]); w.w = pk2(y[6], y[7]);
          *(u32x4*)(MIX + (size_t)t * D + C5 + c) = w; }
    }
}

#define DPPI(x, ctrl) __builtin_amdgcn_update_dpp(0, (x), (ctrl), 0xF, 0xF, true)
__device__ __forceinline__ float row16_max(float x) {
    x = fmaxf(x, __builtin_bit_cast(float, DPPI(__builtin_bit_cast(int, x), 0xB1))); x = fmaxf(x, __builtin_bit_cast(float, DPPI(__builtin_bit_cast(int, x), 0x4E)));
    x = fmaxf(x, __builtin_bit_cast(float, DPPI(__builtin_bit_cast(int, x), 0x141))); x = fmaxf(x, __builtin_bit_cast(float, DPPI(__builtin_bit_cast(int, x), 0x140))); return x; }
__device__ __forceinline__ int row16_min(int x) {
    x = min(x, DPPI(x, 0xB1)); x = min(x, DPPI(x, 0x4E)); x = min(x, DPPI(x, 0x141)); x = min(x, DPPI(x, 0x140)); return x; }
__device__ __forceinline__ void phase_ln1_route(const Params& p, const Frame& F, int l) {
    LAS unsigned char* wl = F.lds;
    LAS int* hist = (LAS int*)(F.lds + LDSX_OFF + 4096);
    LAS int* basep = hist + 32;
    LAS int* rinfo = hist + 64;
    LAS float* rgate = (LAS float*)(rinfo + 512);
    const float* mod = WSP(float, WS_MOD) + (size_t)l * NBATCH * 6144;
    const float* g1 = INP(I_LN1G) + (size_t)l * D; const float* b1 = INP(I_LN1B) + (size_t)l * D;
    const float* rb = INP(I_RB) + (size_t)l * NE;
    unsigned* cnt = (unsigned*)(F.ws + WS_CTL) + CW_CNT + l * 64;
    int* LIST = WSP(int, WS_LIST); float* GATEL = WSP(float, WS_GATEL); int* TOKSLOT = WSP(int, WS_TOKSLOT);
    bf16* X = WSP(bf16, WS_X); unsigned char* H8 = WSP(unsigned char, WS_H8);
    const int lane = F.lane, li = lane & 15, g = lane >> 4;
    __syncthreads();
    for (int i = F.tid; i < 2 * 4096; i += NTHREADS) { const int part = i >> 12, rem = i & 4095, e = rem >> 7, ch = rem & 127;
        const u32x4 v = *(const u32x4*)(WSP(bf16, WS_RWT) + ((size_t)part * DEPTH + l) * NE * D + (size_t)e * D + ch * 8);
        *(LAS u32x4*)(wl + part * 65536 + e * 2048 + ((ch ^ (e & 15)) << 4)) = v; }
    __syncthreads();
    for (int chunk = F.vcu; chunk < T / 128; chunk += F.G) {
        __syncthreads();
        if (F.tid < 32) hist[F.tid] = 0;
        __syncthreads();
        const int row0 = chunk * 128 + F.wave * 16; const int b = row0 / SEQ;
        float mymean = 0.f, myrstd = 0.f;
#pragma unroll 1
        for (int rr = 0; rr < 16; ++rr) {
            const GAS u32x2* xr = (const GAS u32x2*)(X + (size_t)(row0 + rr) * D) + lane;
            f32x4 v[4]; float s = 0.f;
#pragma unroll
            for (int j = 0; j < 4; ++j) { const u32x2 w = xr[64 * j]; v[j] = (f32x4){bflo(w.x), bfhi(w.x), bflo(w.y), bfhi(w.y)}; s += (v[j].x + v[j].y) + (v[j].z + v[j].w); }
            const float mean = wave_sum(s) * (1.f / D); float s2 = 0.f;
#pragma unroll
            for (int j = 0; j < 4; ++j) { v[j] = v[j] - mean; s2 += (v[j].x * v[j].x + v[j].y * v[j].y) + (v[j].z * v[j].z + v[j].w * v[j].w); }
            const float rstd = __builtin_amdgcn_rsqf(wave_sum(s2) * (1.f / D) + LN_EPS);
            if (li == rr) { mymean = mean; myrstd = rstd; }
        }
        f32x4 acc0 = (f32x4){0.f, 0.f, 0.f, 0.f}, acc1 = acc0;
        bf16* xrow = X + (size_t)(row0 + li) * D + 8 * g; unsigned char* hrow = H8 + (size_t)(row0 + li) * D + 8 * g;
        const float* shp = mod + (size_t)b * 6144 + 3072 + 8 * g; const float* scp = mod + (size_t)b * 6144 + 4096 + 8 * g;
        const LAS unsigned char* w0 = wl + li * 2048; const LAS unsigned char* w1 = wl + (16 + li) * 2048;
#pragma unroll 2
        for (int s = 0; s < 32; ++s) {
            const int k = 32 * s;
            const u32x4 yw = *(const u32x4*)(xrow + k); const f32x4 y0 = (f32x4){bflo(yw.x), bfhi(yw.x), bflo(yw.y), bfhi(yw.y)}, y1 = (f32x4){bflo(yw.z), bfhi(yw.z), bflo(yw.w), bfhi(yw.w)};
            const f32x4 ga0 = *(const f32x4*)(g1 + k + 8 * g), ga1 = *(const f32x4*)(g1 + k + 8 * g + 4), be0 = *(const f32x4*)(b1 + k + 8 * g), be1 = *(const f32x4*)(b1 + k + 8 * g + 4);
            const f32x4 sc0 = *(const f32x4*)(scp + k), sc1 = *(const f32x4*)(scp + k + 4), sh0 = *(const f32x4*)(shp + k), sh1 = *(const f32x4*)(shp + k + 4);
            const f32x4 x0 = (y0 - mymean) * myrstd * ga0 + be0, x1 = (y1 - mymean) * myrstd * ga1 + be1;
            { u32x4 xw; xw.x = cvtpk_c(x0.x, x0.y); xw.y = cvtpk_c(x0.z, x0.w); xw.z = cvtpk_c(x1.x, x1.y); xw.w = cvtpk_c(x1.z, x1.w); *(u32x4*)(xrow + k) = xw; }
            const f32x4 h0 = x0 * (sc0 + 1.0f) + sh0, h1 = x1 * (sc1 + 1.0f) + sh1;
            u32x4 hi; hi.x = cvtpk_c(h0.x, h0.y); hi.y = cvtpk_c(h0.z, h0.w); hi.z = cvtpk_c(h1.x, h1.y); hi.w = cvtpk_c(h1.z, h1.w);
            { u32x2 h8; h8.x = q8x4(h0.x * QS_H, h0.y * QS_H, h0.z * QS_H, h0.w * QS_H); h8.y = q8x4(h1.x * QS_H, h1.y * QS_H, h1.z * QS_H, h1.w * QS_H); *(u32x2*)(hrow + k) = h8; }
            u32x4 lo; lo.x = cvtpk_c(h0.x - bflo(hi.x), h0.y - bfhi(hi.x)); lo.y = cvtpk_c(h0.z - bflo(hi.y), h0.w - bfhi(hi.y)); lo.z = cvtpk_c(h1.x - bflo(hi.z), h1.y - bfhi(hi.z)); lo.w = cvtpk_c(h1.z - bflo(hi.w), h1.w - bfhi(hi.w));
            const int cho = ((4 * s + g) ^ li) << 4;
            const bf16x8 bh0 = *(const LAS bf16x8*)(w0 + cho), bh1 = *(const LAS bf16x8*)(w1 + cho), bl0 = *(const LAS bf16x8*)(w0 + 65536 + cho), bl1 = *(const LAS bf16x8*)(w1 + 65536 + cho);
            const bf16x8 ahi = __builtin_bit_cast(bf16x8, hi), alo = __builtin_bit_cast(bf16x8, lo);
            acc0 = __builtin_amdgcn_mfma_f32_16x16x32_bf16(ahi, bh0, acc0, 0, 0, 0); acc1 = __builtin_amdgcn_mfma_f32_16x16x32_bf16(ahi, bh1, acc1, 0, 0, 0);
            acc0 = __builtin_amdgcn_mfma_f32_16x16x32_bf16(alo, bh0, acc0, 0, 0, 0); acc1 = __builtin_amdgcn_mfma_f32_16x16x32_bf16(alo, bh1, acc1, 0, 0, 0);
            acc0 = __builtin_amdgcn_mfma_f32_16x16x32_bf16(ahi, bl0, acc0, 0, 0, 0); acc1 = __builtin_amdgcn_mfma_f32_16x16x32_bf16(ahi, bl1, acc1, 0, 0, 0);
        }
        const float rb0 = rb[li], rb1 = rb[16 + li];
#pragma unroll
        for (int reg = 0; reg < 4; ++reg) {
            float v0 = acc0[reg] + rb0, v1 = acc1[reg] + rb1;
            float tv0 = 0.f, tv1 = 0.f, tv2 = 0.f, tv3 = 0.f; int te0 = 0, te1 = 0, te2 = 0, te3 = 0;
#pragma unroll
            for (int k = 0; k < 4; ++k) { const float mx = row16_max(fmaxf(v0, v1));
                const int id = (v0 == mx) ? li : ((v1 == mx) ? 16 + li : 99); const int ek = row16_min(id);
                if (k == 0) { tv0 = mx; te0 = ek; } else if (k == 1) { tv1 = mx; te1 = ek; } else if (k == 2) { tv2 = mx; te2 = ek; } else { tv3 = mx; te3 = ek; }
                if (ek == li) v0 = -INFINITY; if (ek == 16 + li) v1 = -INFINITY; }
            const float e1 = __expf(tv1 - tv0), e2 = __expf(tv2 - tv0), e3 = __expf(tv3 - tv0); const float inv = __builtin_amdgcn_rcpf(1.0f + e1 + e2 + e3);
            if (li < 4) { const int lr = F.wave * 16 + 4 * g + reg; const int ek = li == 0 ? te0 : li == 1 ? te1 : li == 2 ? te2 : te3; const float gk = (li == 0 ? 1.0f : li == 1 ? e1 : li == 2 ? e2 : e3) * inv;
                const int lp = __hip_atomic_fetch_add(&hist[ek], 1, __ATOMIC_RELAXED, __HIP_MEMORY_SCOPE_WORKGROUP); rinfo[lr * 4 + li] = (ek << 16) | lp; rgate[lr * 4 + li] = gk; }
        }
        __syncthreads();
        if (F.tid < 32) basep[F.tid] = (int)__hip_atomic_fetch_add(cnt + F.tid, (unsigned)hist[F.tid], RLX_AGENT);
        __syncthreads();
        { const int lr = F.tid >> 2, k = F.tid & 3; const int m = chunk * 128 + lr; const int info = rinfo[F.tid]; const int ek = info >> 16; const int pos = basep[ek] + (info & 0xffff);
          LIST[ek * CAP + pos] = m; GATEL[ek * CAP + pos] = rgate[F.tid]; TOKSLOT[m * 4 + k] = (ek << 16) | pos; }
    }
    __syncthreads();
}

__device__ __forceinline__ void moe_tables(const Frame& F, int l) {
    LAS int* tb = (LAS int*)(F.lds + TB_OFF); LAS int* cn = tb + 40;
    const unsigned* cnt = (const unsigned*)(F.ws + WS_CTL) + CW_CNT + l * 64;
    __syncthreads();
    if (F.tid == 0) { int acc = 0;
        for (int e = 0; e < NE; ++e) { const int c = (int)__hip_atomic_load(cnt + e, RLX_AGENT); cn[e] = c; tb[e] = acc; acc += (c + 255) >> 8; }
        tb[NE] = acc; }
    __syncthreads();
}

__device__ __forceinline__ void phase_combine(const Params& p, const Frame& F, int l) {
    const LAS int* tb = (const LAS int*)(F.lds + TB_OFF);
    const int gw = F.vcu * NWAVES + F.wave, NGW = F.G * NWAVES; const int lane = F.lane;
    const float* mod = WSP(float, WS_MOD) + (size_t)l * NBATCH * 6144; const float* modn = WSP(float, WS_MOD) + (size_t)(l + 1) * NBATCH * 6144;
    const float* g2 = INP(I_LN2G) + (size_t)l * D; const float* b2 = INP(I_LN2B) + (size_t)l * D;
    const bf16* Y = WSP(bf16, WS_Y); const int* TOKSLOT = WSP(int, WS_TOKSLOT);
    const bool lastl = (l == DEPTH - 1);
#pragma unroll 4
    for (int m = gw; m < T; m += NGW) {
        const int b = m / SEQ;
        int srow[4];
#pragma unroll
        for (int k = 0; k < 4; ++k) { const int ts = TOKSLOT[m * 4 + k]; const int e = ts >> 16, pos = ts & 0xffff; srow[k] = tb[e] * 256 + pos; }
        GAS u32x2* xr = (GAS u32x2*)(WSP(bf16, WS_X) + (size_t)m * D) + lane;
        f32x4 v[4]; float s = 0.f;
#pragma unroll
        for (int j = 0; j < 4; ++j) { const int c = 4 * lane + 256 * j; f32x4 y = (f32x4){0.f, 0.f, 0.f, 0.f};
#pragma unroll
            for (int k = 0; k < 4; ++k) { const u32x2 yw = *(const u32x2*)(Y + (size_t)srow[k] * D + c); y.x += bflo(yw.x); y.y += bfhi(yw.x); y.z += bflo(yw.y); y.w += bfhi(yw.y); }
            const f32x4 gt = *(const f32x4*)(mod + (size_t)b * 6144 + 5120 + c) + 1.0f;
            const u32x2 xw = xr[64 * j]; v[j] = (f32x4){bflo(xw.x), bfhi(xw.x), bflo(xw.y), bfhi(xw.y)} * DN_ALPHA + gt * y; s += (v[j].x + v[j].y) + (v[j].z + v[j].w); }
        const float mean = wave_sum(s) * (1.f / D); float s2 = 0.f;
#pragma unroll
        for (int j = 0; j < 4; ++j) { v[j] = v[j] - mean; s2 += (v[j].x * v[j].x + v[j].y * v[j].y) + (v[j].z * v[j].z + v[j].w * v[j].w); }
        const float rstd = 1.f / sqrtf(wave_sum(s2) * (1.f / D) + LN_EPS);
        GAS f32x4* oo = (GAS f32x4*)(p.out + (size_t)m * D) + lane;
        GAS unsigned* ho = (GAS unsigned*)(WSP(unsigned char, WS_H) + (size_t)m * D) + lane;
        f32x4 hq[4]; hq[0] = hq[1] = hq[2] = hq[3] = (f32x4){0.f, 0.f, 0.f, 0.f};
#pragma unroll
        for (int j = 0; j < 4; ++j) { const int c = 4 * lane + 256 * j;
            const f32x4 g = *(const f32x4*)(g2 + c), be = *(const f32x4*)(b2 + c);
            const f32x4 x2 = v[j] * rstd * g + be;
            if (lastl) oo[64 * j] = x2;
            else { { u32x2 xw; xw.x = pk2(x2.x, x2.y); xw.y = pk2(x2.z, x2.w); xr[64 * j] = xw; }
                const f32x4 sh = *(const f32x4*)(modn + (size_t)b * 6144 + c), sc = *(const f32x4*)(modn + (size_t)b * 6144 + 1024 + c);
                hq[j] = x2 * (sc + 1.0f) + sh; } }
        if (!lastl) { float mx = 0.f;
#pragma unroll
            for (int j = 0; j < 4; ++j) mx = fmaxf(mx, fmaxf(fmaxf(fabsf(hq[j].x), fabsf(hq[j].y)), fmaxf(fabsf(hq[j].z), fabsf(hq[j].w))));
#pragma unroll
            for (int o = 1; o < 64; o <<= 1) mx = fmaxf(mx, __shfl_xor(mx, o));
            mx = fmaxf(mx, 1e-20f); const float qsr = 127.0f / mx;
#pragma unroll
            for (int j = 0; j < 4; ++j) ho[64 * j] = q8x4(hq[j].x * qsr, hq[j].y * qsr, hq[j].z * qsr, hq[j].w * qsr);
            if (lane == 0) WSP(float, WS_HS)[m] = mx * (1.0f / 127.0f); }
    }
}

constexpr int PH_PER_LAYER = 11, N_PHASES = 2 + DEPTH * PH_PER_LAYER;
__global__ void __launch_bounds__(NTHREADS, 2) fwd(Params p) {
    extern __shared__ __attribute__((aligned(16))) unsigned char lds[];
    Frame F;
    F.lds = (LAS unsigned char*)lds; F.tid = threadIdx.x; F.lane = F.tid & 63; F.wave = __builtin_amdgcn_readfirstlane(F.tid >> 6);
    F.G = gridDim.x; { const int bx = blockIdx.x; F.vcu = (F.G % 8 == 0) ? (bx % 8) * (F.G / 8) + bx / 8 : bx; }
    F.ws = p.ws;
    volatile LAS unsigned* MISC = (volatile LAS unsigned*)(F.lds + MISC_OFF);
    if (F.tid < 64) MISC[F.tid] = 0u;
    __syncthreads();
    unsigned* ctl = (unsigned*)(p.ws + WS_CTL);
#if MK_ONE_LAUNCH
    XcdBarrier bar = xcd_barrier_post(ctl + CW_BAR, MISC + 8);
#define GRID_BAR() xcd_barrier(bar)
#else
#define GRID_BAR() do {} while (0)
#endif
    const int lo = p.ph_lo, hi = p.ph_hi;
#ifndef PH_MASK
#define PH_MASK 0xFFFFFFFFu
#endif
#define IN(k) (lo <= (k) && (k) < hi)
#define EN(j) ((PH_MASK >> (j)) & 1u)
#define SEAM(k) do { if (IN(k) && IN((k) + 1)) GRID_BAR(); } while (0)
    LAS unsigned char* ring = F.lds;

    if (EN(0) && IN(0)) { for (int rep = 0; rep < REP_PRO; ++rep) phase_prologue(p, F); } SEAM(0);
    if (EN(1) && IN(1)) { phase_ln0(p, F); } SEAM(1);
#define LAYER_BODY \
        constexpr int pb = 2 + l * PH_PER_LAYER; \
        const float* mod = WSP(float, WS_MOD) + (size_t)l * NBATCH * 6144; \
        if (EN(2) && IN(pb + 0)) { \
            pg8::Gemm g{WSP(bf16, WS_H), (const bf16*)(WSP(unsigned char, WS_WINT) + (size_t)l * N_INP * D), T, N_INP, D / 2}; pg8::DenseOrder S; S.init(T, N_INP, F.G, (int)blockIdx.x); \
            pg8::EpiPlainI8 E{WSP(bf16, WS_P), N_INP, 1.0f / QS_WIN, 1440, 1952, WSP(float, WS_HS)}; \
            pg8::gemm_phase<pg8::EpiPlainI8, pg8::DenseOrder, true, true>(ring, g, S, E); \
        } SEAM(pb + 0); \
        if (EN(3) && IN(pb + 1)) { phase_pgemm(p, F, l); } SEAM(pb + 1); \
        if (EN(5) && IN(pb + 3)) { phase_rwkv_r1(p, F, l); } SEAM(pb + 3); \
        if (EN(6) && IN(pb + 4)) { phase_rwkv_r2(p, F); if (l == 0) { const int c0 = F.G / 4, nc = (F.G * 3) / 8; if (F.vcu >= c0 && F.vcu < c0 + nc) phase_convert_experts(p, F, c0, nc); } phase_attn(p, F, (char*)lds, l); } SEAM(pb + 4); \
        if (EN(7) && IN(pb + 5)) { for (int rep = 0; rep < REP_MIX; ++rep) phase_mix(p, F, l); } SEAM(pb + 5); \
        if (EN(8) && IN(pb + 6)) { \
            pg8::Gemm g{WSP(bf16, WS_MIX), WSP(bf16, WS_WOT) + (size_t)l * D * D, T, D, D}; pg8::DenseOrder S; S.init(T, D, F.G, (int)blockIdx.x); \
            pg8::EpiWo E{WSP(bf16, WS_X), mod + 2048}; \
            pg8::gemm_phase<pg8::EpiWo, pg8::DenseOrder, true>(ring, g, S, E); \
        } SEAM(pb + 6); \
        if (EN(9) && IN(pb + 7)) { phase_ln1_route(p, F, l); } SEAM(pb + 7); \
        if (EN(10) && IN(pb + 8)) { \
            moe_tables(F, l); \
            const LAS int* tb = (const LAS int*)(F.lds + TB_OFF); \
            pg8::Gemm g{WSP(bf16, WS_H8), (const bf16*)(WSP(unsigned char, WS_W1T) + (size_t)l * NE * 2048 * D), T, 2048, D / 2};        \
            pg8::MoeOrder<true> S{tb, tb + 40, WSP(int, WS_LIST), 8, F.G, F.vcu, (LAS unsigned*)(F.lds + GT_OFF)}; \
            pg8::EpiSwiglu E{WSP(unsigned char, WS_H1), WSP(float, WS_B1P) + (size_t)l * NE * 2048}; \
            for (int rep = 0; rep < REP_MOE1; ++rep) pg8::gemm_phase<pg8::EpiSwiglu, pg8::MoeOrder<true>, true, true>(ring, g, S, E); \
        } SEAM(pb + 8); \
        if (EN(11) && IN(pb + 9)) { \
            moe_tables(F, l); \
            const LAS int* tb = (const LAS int*)(F.lds + TB_OFF); \
            pg8::Gemm g{WSP(bf16, WS_H1), (const bf16*)(WSP(unsigned char, WS_W2T) + (size_t)l * NE * D * FF), MAXSLOT, D, FF / 2}; \
            pg8::MoeOrder<false> S{tb, tb + 40, nullptr, 4, F.G, F.vcu, nullptr}; \
            pg8::EpiMoeOut E{WSP(bf16, WS_Y), INP(I_EB2) + (size_t)l * NE * D, WSP(float, WS_GATEL), tb}; \
            for (int rep = 0; rep < REP_MOE2; ++rep) pg8::gemm_phase<pg8::EpiMoeOut, pg8::MoeOrder<false>, true, true>(ring, g, S, E); \
        } SEAM(pb + 9); \
        if (EN(12) && IN(pb + 10)) { moe_tables(F, l); phase_combine(p, F, l); } SEAM(pb + 10);
    { constexpr int l = 0; LAYER_BODY }
    { constexpr int l = 1; LAYER_BODY }
#undef LAYER_BODY
#undef IN
#undef SEAM
}

extern "C" void kernel_launch(void* const* d_in, const int* in_sizes, int n_in, void* d_out, int out_size, void* d_ws, size_t ws_size, hipStream_t stream) {
    static int grid = 0;
    if (grid == 0) {
        if (n_in != N_INPUTS || out_size != T * D || ws_size < WS_END) { fprintf(stderr, "kernel_launch: unexpected problem: n_in %d out %d ws %zu\n", n_in, out_size, ws_size); grid = -1; return; }
        int dev = 0, cus = 0, per_cu = 0;
        if (hipGetDevice(&dev) != hipSuccess || hipDeviceGetAttribute(&cus, hipDeviceAttributeMultiprocessorCount, dev) != hipSuccess) { grid = -1; return; }
        if (hipFuncSetAttribute((const void*)fwd, hipFuncAttributeMaxDynamicSharedMemorySize, LDS_BYTES) != hipSuccess) { fprintf(stderr, "kernel_launch: hipFuncSetAttribute failed\n"); grid = -1; return; }
        if (hipOccupancyMaxActiveBlocksPerMultiprocessor(&per_cu, (const void*)fwd, NTHREADS, LDS_BYTES) != hipSuccess || per_cu < 1) fprintf(stderr, "kernel_launch: occupancy query reports %d\n", per_cu);
        (void)hipGetLastError();
        grid = cus;
    }
    if (grid < 0) return;
    if (hipMemsetAsync((char*)d_ws + WS_CTL, 0, CTL_ZERO_BYTES, stream) != hipSuccess) return;
    Params p{};
    for (int i = 0; i < N_INPUTS; ++i) p.in[i] = d_in[i];
    p.out = (float*)d_out; p.ws = (unsigned char*)d_ws;
#if MK_ONE_LAUNCH
    p.ph_lo = 0; p.ph_hi = N_PHASES;
    hipLaunchKernelGGL(fwd, dim3(grid), dim3(NTHREADS), LDS_BYTES, stream, p);
#else
    for (int ph = 0; ph < N_PHASES; ++ph) { p.ph_lo = ph; p.ph_hi = ph + 1; hipLaunchKernelGGL(fwd, dim3(grid), dim3(NTHREADS), LDS_BYTES, stream, p); }
#endif
}
```

```cpp
#include <hip/hip_runtime.h>
#include <cstdio>
#include <cstdint>

#define REP_PRO 1
#define REP_ATTN 1
#define REP_RWKV 1
#define REP_MOE1 1
#define REP_MOE2 1
#define REP_WIN 1
#define REP_PREP 1
#define REP_MIX 1
#ifndef MK_ONE_LAUNCH
#define MK_ONE_LAUNCH 1
#endif

#define GAS __attribute__((address_space(1)))
#define LAS __attribute__((address_space(3)))
typedef unsigned short bf16;
typedef short bf16x8 __attribute__((ext_vector_type(8)));
typedef short s16x4 __attribute__((ext_vector_type(4)));
typedef float f32x2 __attribute__((ext_vector_type(2)));
typedef float f32x4 __attribute__((ext_vector_type(4)));
typedef float f32x16 __attribute__((ext_vector_type(16)));
typedef unsigned u32x2 __attribute__((ext_vector_type(2)));
typedef unsigned u32x4 __attribute__((ext_vector_type(4)));
typedef int i32x4 __attribute__((ext_vector_type(4)));

constexpr int D = 1024, NBATCH = 8, SEQ = 4096, T = NBATCH * SEQ, DEPTH = 2;
constexpr int MLA_IN = 416, RWKV_IN = 1792, N_IN = 2208, N_INP = 2304;
constexpr int QLR = 256, KVLR = 128, ROPE = 32, NOPE = 64, QKD = 96, VD = 64, NH = 8;
constexpr int C5 = 512;
constexpr int NE = 32, TOPK = 4, FF = 1024, CAP = 32768;
constexpr int N_UP = 1792, K_UP = 384, N_SM = 1536, K_SM = 256;
constexpr int MAXSLOT = 139264;
constexpr float DN_ALPHA = 1.4142135623730951f;
constexpr float C2Q = 0.14724444602590306f;
constexpr float LN_EPS = 1e-5f, RMS_EPS = 1e-6f, GN_EPS = 64e-5f;
constexpr int NWAVES = 8, NTHREADS = 512;
constexpr float QS_H = 16.f, QS_W1 = 640.f, QS_U = 16.f, QS_W2 = 1280.f, QS_WIN = 640.f;
constexpr int PGW_Q = 0, PGW_KN = 384, PGW_V = 512, PGW_W = 640, PGW_A = 704, PGW_G = 768, PGW_VR = 896, PGW_NFRAG = 1408;

enum { I_X = 0, I_C, I_POS, I_ELNG, I_ELNB, I_ADAW, I_ADAB, I_WIN, I_QNG, I_WUQ, I_KVNG, I_WUK, I_WUV, I_MOUTG, I_MU, I_W0, I_W2, I_A0, I_A2, I_G2,
       I_KK, I_KA, I_RK, I_GNG, I_GNB, I_V0, I_V1, I_V2, I_WO, I_LN1G, I_LN1B, I_RW, I_RB, I_EW1, I_EB1, I_EW2, I_EB2, I_LN2G, I_LN2B, N_INPUTS };

constexpr size_t MiB = 1u << 20;
constexpr size_t WS_CTL = 0, CTL_ZERO_BYTES = 4 * MiB;
constexpr size_t WS_MOD = 4 * MiB, WS_B1P = 5 * MiB, WS_CS = 6 * MiB, WS_LIST = 10 * MiB, WS_GATEL = 14 * MiB, WS_TOKSLOT = 18 * MiB;
constexpr size_t WS_HS = 18 * MiB + 512 * 1024;
constexpr size_t WS_RWT = 19 * MiB;
constexpr size_t WS_WINT = 20 * MiB, WS_WUPT = 30 * MiB, WS_WSMT = 33 * MiB, WS_WV12T = 35 * MiB, WS_WOT = 36 * MiB, WS_W1T = 40 * MiB, WS_W2T = 296 * MiB;
constexpr size_t WS_X = 424 * MiB, WS_H = 552 * MiB, WS_VS0 = 616 * MiB, WS_VS1 = 648 * MiB;
constexpr size_t WS_P = 680 * MiB, WS_AN = 824 * MiB, WS_A2 = 848 * MiB, WS_RK = 864 * MiB, WS_Q = 928 * MiB, WS_KK = 976 * MiB, WS_V = 1024 * MiB, WS_O = 1056 * MiB;
constexpr size_t WS_WAG = 1088 * MiB, WS_RO = 1280 * MiB, WS_MIX = 1344 * MiB, WS_VR = 1408 * MiB;
constexpr size_t WS_LW = WS_WAG, WS_AG = WS_WAG + 64 * MiB;
constexpr size_t WS_H8 = WS_MIX;
constexpr size_t WS_H1 = 680 * MiB, WS_Y = 952 * MiB;
constexpr size_t WS_CH = 1440 * MiB;
constexpr size_t WS_PGW = 1696 * MiB;
constexpr size_t WS_END = 1700 * MiB;
constexpr int CW_TMO = 0, CW_CODE = 1, CW_BAR = 4096, CW_CNT = 8192, CW_ATTQ = 8448;

constexpr int RING_BYTES = 131072;
constexpr int LDSX_OFF = RING_BYTES;
constexpr int MISC_OFF = LDSX_OFF;
constexpr int TB_OFF = LDSX_OFF + 256;
constexpr int GT_OFF = LDSX_OFF + 1024;
constexpr int LDS_BYTES = 147456;

#define RLX_AGENT __ATOMIC_RELAXED, __HIP_MEMORY_SCOPE_AGENT
#define LDS_WAIT() asm volatile("s_waitcnt lgkmcnt(0)" ::: "memory")
#define VM_WAIT() asm volatile("s_waitcnt vmcnt(0)" ::: "memory")

__device__ __forceinline__ unsigned f2bf(float f) { unsigned u = __builtin_bit_cast(unsigned, f); return (u + 0x7fffu + ((u >> 16) & 1u)) >> 16; }
__device__ __forceinline__ unsigned pk2(float lo, float hi) { return f2bf(lo) | (f2bf(hi) << 16); }
__device__ __forceinline__ float bf2f(unsigned b) { return __builtin_bit_cast(float, b << 16); }
__device__ __forceinline__ float bflo(unsigned w) { return __builtin_bit_cast(float, w << 16); }
__device__ __forceinline__ float bfhi(unsigned w) { return __builtin_bit_cast(float, w & 0xffff0000u); }
__device__ __forceinline__ unsigned cvt_pk_bf16(float lo, float hi) { unsigned r; asm volatile("v_cvt_pk_bf16_f32 %0, %1, %2" : "=v"(r) : "v"(lo), "v"(hi)); return r; }
typedef __bf16 bf16x2_t __attribute__((ext_vector_type(2)));
__device__ __forceinline__ unsigned cvtpk_c(float lo, float hi) { f32x2 v = {lo, hi}; bf16x2_t b = __builtin_convertvector(v, bf16x2_t); return __builtin_bit_cast(unsigned, b); }
__device__ __forceinline__ unsigned q8r(float x) { return __builtin_bit_cast(unsigned, __builtin_amdgcn_fmed3f(x, -127.f, 127.f) + 12582912.f); }
__device__ __forceinline__ unsigned q8x4(float a, float b, float c, float d) { return (q8r(a) & 0xffu) | ((q8r(b) & 0xffu) << 8) | ((q8r(c) & 0xffu) << 16) | (q8r(d) << 24); }
__device__ __forceinline__ float wave_sum(float v) {
#pragma unroll
    for (int o = 1; o < 64; o <<= 1) v += __shfl_xor(v, o);
    return v;
}
__device__ __forceinline__ float sigmoidf_(float x) { return __builtin_amdgcn_rcpf(1.0f + __expf(-x)); }
__device__ __forceinline__ float tanhf_(float x) { return 1.0f - 2.0f * __builtin_amdgcn_rcpf(1.0f + __expf(2.0f * x)); }

#define XB_TMO      128
#define XB_XCNT(j)  (256  + 64 * (j))
#define XB_XSUB(j)  (1280 + 64 * (j))
#define XB_XGEN(j)  (2304 + 64 * (j))
#define XB_TOP      3328
#define XB_TOPGEN   3392
#define XCD_BAR_WORDS 3456
#define XB_SPIN_CAP (1u << 18)
__device__ __forceinline__ unsigned xb_ld(unsigned* p)              { return __hip_atomic_load(p, __ATOMIC_RELAXED, __HIP_MEMORY_SCOPE_AGENT); }
__device__ __forceinline__ unsigned xb_add(unsigned* p, unsigned v) { return __hip_atomic_fetch_add(p, v, __ATOMIC_RELAXED, __HIP_MEMORY_SCOPE_AGENT); }
__device__ __forceinline__ unsigned xb_xcc_id() { return (unsigned)__builtin_amdgcn_s_getreg((3 << 11) | 20) & 0xFu; }
#define XB_SPIN(cond, bar) do { unsigned _sp = 0; while (cond) { __builtin_amdgcn_s_sleep(1); \
    if ((++_sp & 255u) == 0u) { if (xb_ld(&(bar)[XB_TMO])) break; if (_sp > XB_SPIN_CAP) { atomicAdd(&(bar)[XB_TMO], 1u); break; } } } } while (0)
struct XcdBarrier { unsigned* bar; unsigned x; volatile LAS unsigned* st; };
__device__ __forceinline__ XcdBarrier xcd_barrier_post(unsigned* bar, volatile LAS unsigned* st) {
    XcdBarrier b; b.bar = bar; b.x = xb_xcc_id(); b.st = st;
    if (threadIdx.x == 0) (void)xb_add(&bar[XB_XCNT(b.x)], 1u);
    return b;
}
__device__ __forceinline__ void xcd_barrier_complete(unsigned* bar, unsigned x, unsigned& nloc, unsigned& nx) {
    const unsigned G = gridDim.x * gridDim.y * gridDim.z;
    unsigned sum, cnt, mine, sp = 0u;
    for (;;) {
        sum = 0u; cnt = 0u; mine = 0u;
#pragma unroll
        for (unsigned j = 0; j < 16; ++j) { const unsigned c = xb_ld(&bar[XB_XCNT(j)]); sum += c; cnt += (c > 0u) ? 1u : 0u; mine = (j == x) ? c : mine; }
        if (sum == G) break;
        __builtin_amdgcn_s_sleep(1);
        if ((++sp & 255u) == 0u) { if (xb_ld(&bar[XB_TMO])) break; if (sp > XB_SPIN_CAP) { atomicAdd(&bar[XB_TMO], 1u); break; } }
    }
    nloc = mine > 0u ? mine : 1u; nx = cnt > 0u ? cnt : 1u;
}
__device__ __forceinline__ void xcd_barrier(const XcdBarrier& b) {
    asm volatile("s_waitcnt vmcnt(0)" ::: "memory");
    __syncthreads();
    if (threadIdx.x == 0) {
        unsigned* bar = b.bar;
        __builtin_amdgcn_s_waitcnt(0);
        unsigned nloc = b.st[0], nx = b.st[1];
        if (nloc == 0u) { xcd_barrier_complete(bar, b.x, nloc, nx); b.st[0] = nloc; b.st[1] = nx; }
        const unsigned old = xb_add(&bar[XB_XSUB(b.x)], 1u);
        const unsigned gen = old / nloc;
        if (old + 1u == (gen + 1u) * nloc) {
            __builtin_amdgcn_fence(__ATOMIC_RELEASE, "agent");
            asm volatile("s_waitcnt vmcnt(0)" ::: "memory");
            const unsigned og = xb_add(&bar[XB_TOP], 1u);
            const unsigned tg = og / nx;
            if (og + 1u == (tg + 1u) * nx) xb_add(&bar[XB_TOPGEN], 1u);
            else XB_SPIN(xb_ld(&bar[XB_TOPGEN]) == tg, bar);
            __builtin_amdgcn_fence(__ATOMIC_ACQUIRE, "agent");
            xb_add(&bar[XB_XGEN(b.x)], 1u);
            asm volatile("s_waitcnt vmcnt(0)" ::: "memory");
        } else {
            XB_SPIN(xb_ld(&bar[XB_XGEN(b.x)]) == gen, bar);
            __builtin_amdgcn_fence(__ATOMIC_ACQUIRE, "agent");
            asm volatile("s_waitcnt vmcnt(0)" ::: "memory");
        }
    }
    __syncthreads();
}

namespace pg8 {
constexpr int BM = 256, BK = 64, HALF = 128, HTB = HALF * BK * 2, STAGE_BYTES = 8 * HTB, NXCD = 8, WGM = 8;
__device__ __forceinline__ int lds_byte(int r, int c) { const int st = (r >> 4) * 2 + (c >> 5), rr = r & 15, cc = c & 31, ob = rr * 64 + cc * 2; return st * 1024 + (ob ^ (((ob >> 9) & 1) << 5)); }
__device__ __forceinline__ void stage_rc(int b, int& R, int& C) { const int st = b / 1024, sb = b % 1024, swz = sb ^ (((sb >> 9) & 1) << 5); R = (st >> 1) * 16 + swz / 64; C = (st & 1) * 32 + (swz % 64) / 2; }
__device__ __forceinline__ int perm32(int rho) { const int n = rho >> 4, i = rho & 15; return 8 * (i >> 2) + 4 * n + (i & 3); }

struct Unit { int pm, pn, e; };
struct Gemm { const bf16* A; const bf16* Bt; int M, N, K; };

struct DenseOrder {
    int nM, nN, nwg, G, c;
    __device__ __forceinline__ void init(int M, int N, int G_, int c_) { nM = M / BM; nN = N / BM; nwg = nM * nN; G = G_; c = c_; }
    __device__ __forceinline__ bool next(int i, Unit& u) const {
        const long L = (long)i * G + c; if (L >= nwg) return false;
        int wgid = (int)L; { const int q = nwg / NXCD, r = nwg % NXCD, xcd = wgid % NXCD, off = wgid / NXCD; wgid = (xcd < r ? xcd * (q + 1) : r * (q + 1) + (xcd - r) * q) + off; }
        const int nig = WGM * nN, gid = wgid / nig, fm = gid * WGM, gsz = (nM - fm) < WGM ? (nM - fm) : WGM;
        u.pm = fm + ((wgid % nig) % gsz); u.pn = (wgid % nig) / gsz; u.e = 0; return true;
    }
    static constexpr bool GATHER = false;
    __device__ __forceinline__ size_t b_off(const Unit& u, int N, int K) const { return (size_t)u.pn * BM * K * 2; }
    __device__ __forceinline__ unsigned a_row_off(const Unit& u, int row, int K) const { return 0u; }
    __device__ __forceinline__ LAS unsigned* gtab() const { return nullptr; }
};
template <bool GATHER_> struct MoeOrder {
    static constexpr bool GATHER = GATHER_;
    const LAS int* tb; const LAS int* cnt; const int* list; int nN, G, c; LAS unsigned* gt_;
    __device__ __forceinline__ LAS unsigned* gtab() const { return gt_; }
    __device__ __forceinline__ bool next(int i, Unit& u) const {
        const int L = i * G + c; const int total = tb[NE] * nN; if (L >= total) return false;
        int e = 0;
#pragma unroll 1
        for (int j = 1; j < NE; ++j) if (tb[j] * nN <= L) e = j;
        const int Lr = L - tb[e] * nN, nte = tb[e + 1] - tb[e];
        const int mblk = Lr / (4 * nN), m0 = mblk * 4, gsz = (nte - m0) < 4 ? (nte - m0) : 4, rem = Lr - mblk * 4 * nN;
        u.e = e; u.pn = rem / gsz; u.pm = tb[e] + m0 + (rem % gsz); return true;
    }
    __device__ __forceinline__ size_t b_off(const Unit& u, int N, int K) const { return ((size_t)u.e * N + (size_t)u.pn * BM) * K * 2; }
    __device__ __forceinline__ unsigned a_row_off(const Unit& u, int row, int K) const {
        const int pos = (u.pm - tb[u.e]) * BM + row; const int tok = pos < cnt[u.e] ? list[u.e * CAP + pos] : 0; return (unsigned)tok * (unsigned)(K * 2);
    }
};

template <class Epi, class Sched, bool ALIGN_EPI, bool I8 = false>
__device__ __forceinline__ void gemm_phase(LAS unsigned char* lds, const Gemm g, const Sched& S, const Epi& E) {
    const int tid = threadIdx.x, wid = __builtin_amdgcn_readfirstlane(tid >> 6), lane = tid & 63, wr = wid >> 2, wc = wid & 3, fr = lane & 15, fq = lane >> 4;
    const int K = g.K, nt = K / BK;
    int RA[2]; unsigned CA[2], voffA[2], voffB[2];
#pragma unroll
    for (int i = 0; i < 2; ++i) { int R, C; stage_rc(tid * 16 + i * 8192, R, C); const int Rb = Epi::PERM ? ((R & ~31) + perm32(R & 31)) : R;
        RA[i] = R; CA[i] = (unsigned)C * 2u; voffA[i] = (unsigned)(R * K + C) * 2u; voffB[i] = (unsigned)(Rb * K + C) * 2u; }
    const size_t kstep = (size_t)(BK * 2);
    const size_t hstep = (size_t)HALF * K * 2;
    const size_t tstep = 2 * hstep;
    const unsigned ldsw = (unsigned)wid * 1024u;
    const int aoff = lds_byte(wr * 64 + fr, fq * 8), boff = lds_byte(wc * 32 + fr, fq * 8);
    const char* Abase = (const char*)g.A;
    LAS unsigned* gtb = S.gtab();
#define PG8_SA(b, h) (((b) * 2 + (h)) * HTB)
#define PG8_SB(b, h) ((4 + (b) * 2 + (h)) * HTB)
#define PG8_STAGE(bufoff, gbase, voff) do { _Pragma("unroll") for (int _i = 0; _i < 2; ++_i) \
        __builtin_amdgcn_global_load_lds((const unsigned*)((const char*)(gbase) + (voff)[_i]), (LAS unsigned*)(lds + (bufoff) + ldsw + _i * 8192), 16, 0, 0); } while (0)
#define PG8_STAGEA(bufoff, h, kb, nx) do { \
        if constexpr (Sched::GATHER) { const LAS unsigned* tp_ = gtb + ((nx) ? tnx : tcu) + (h) * HALF; const unsigned o0_ = tp_[RA[0]] + CA[0], o1_ = tp_[RA[1]] + CA[1]; \
            __builtin_amdgcn_global_load_lds((const unsigned*)(Abase + (size_t)(kb) + o0_), (LAS unsigned*)(lds + (bufoff) + ldsw), 16, 0, 0); \
            __builtin_amdgcn_global_load_lds((const unsigned*)(Abase + (size_t)(kb) + o1_), (LAS unsigned*)(lds + (bufoff) + ldsw + 8192), 16, 0, 0); } \
        else { const char* gb_ = ((nx) ? nA : cA) + (size_t)(h) * hstep + (size_t)(kb); PG8_STAGE(bufoff, gb_, voffA); } } while (0)
#define PG8_LDA(dst, b, h) do { _Pragma("unroll") for (int m = 0; m < 4; ++m) _Pragma("unroll") for (int k = 0; k < 2; ++k) dst[m][k] = *(const LAS bf16x8*)(lds + PG8_SA(b, h) + aoff + m * 2048 + k * 1024); } while (0)
#define PG8_LDB(dst, b, h) do { _Pragma("unroll") for (int n = 0; n < 2; ++n) _Pragma("unroll") for (int k = 0; k < 2; ++k) dst[n][k] = *(const LAS bf16x8*)(lds + PG8_SB(b, h) + boff + n * 2048 + k * 1024); } while (0)
#define PG8_MMA(ai, bj, At, Bt) do { __builtin_amdgcn_s_setprio(1); _Pragma("unroll") for (int m = 0; m < 4; ++m) _Pragma("unroll") for (int n = 0; n < 2; ++n) _Pragma("unroll") for (int k = 0; k < 2; ++k) { \
        if constexpr (I8) acc[ai][bj][m][n] = __builtin_bit_cast(f32x4, __builtin_amdgcn_mfma_i32_16x16x64_i8(__builtin_bit_cast(i32x4, Bt[n][k]), __builtin_bit_cast(i32x4, At[m][k]), __builtin_bit_cast(i32x4, acc[ai][bj][m][n]), 0, 0, 0)); \
        else acc[ai][bj][m][n] = __builtin_amdgcn_mfma_f32_16x16x32_bf16(Bt[n][k], At[m][k], acc[ai][bj][m][n], 0, 0, 0); } __builtin_amdgcn_s_setprio(0); } while (0)
#define PG8_WAIT_V(n) asm volatile("s_waitcnt vmcnt(" #n ")" ::: "memory")
#define PG8_WAIT_L(n) asm volatile("s_waitcnt lgkmcnt(" #n ")" ::: "memory")
#define PG8_BAR __builtin_amdgcn_s_barrier()
#define PG8_SCHED __builtin_amdgcn_sched_barrier(0)
    Unit cur, nxt; int ui = 0;
    if (!S.next(0, cur)) return;
    f32x4 acc[2][2][4][2];
#pragma unroll
    for (int a = 0; a < 2; ++a)
#pragma unroll
        for (int b = 0; b < 2; ++b)
#pragma unroll
            for (int m = 0; m < 4; ++m)
#pragma unroll
                for (int n = 0; n < 2; ++n) acc[a][b][m][n] = (f32x4){0.f, 0.f, 0.f, 0.f};
    bf16x8 At[4][2], B0[2][2], B1[2][2];
    const char* cA = Abase + (size_t)cur.pm * tstep; const char* cB = (const char*)g.Bt + S.b_off(cur, g.N, K);
    const char* nA = cA; const char* nB = cB;
    int tcu = 0, tnx = 0; unsigned nxt_off = 0u;
    if constexpr (Sched::GATHER) {
        if (tid < BM) gtb[tid] = S.a_row_off(cur, tid, K);
        asm volatile("s_waitcnt vmcnt(0) lgkmcnt(0)" ::: "memory"); PG8_BAR; asm volatile("" ::: "memory");
    }
    PG8_STAGE(PG8_SB(0, 0), cB, voffB); PG8_STAGE(PG8_SB(0, 1), cB + hstep, voffB); PG8_STAGEA(PG8_SA(0, 0), 0, 0, false); PG8_STAGEA(PG8_SA(0, 1), 1, 0, false);
    if (wr == 1) PG8_BAR;
    PG8_WAIT_V(2); PG8_BAR;
    PG8_STAGE(PG8_SB(1, 0), cB + kstep, voffB); PG8_STAGEA(PG8_SA(1, 0), 0, kstep, false); PG8_STAGE(PG8_SB(1, 1), cB + hstep + kstep, voffB);
    PG8_WAIT_V(6); PG8_BAR;
    for (;;) {
        const bool has_next = S.next(ui + 1, nxt);
        nA = cA; nB = cB; tnx = tcu;
        if (has_next) { nA = Abase + (size_t)nxt.pm * tstep; nB = (const char*)g.Bt + S.b_off(nxt, g.N, K);
            if constexpr (Sched::GATHER) { tnx = tcu ^ BM; if (tid < BM) nxt_off = S.a_row_off(nxt, tid, K); } }
#pragma unroll 1
        for (int t = 0; t < nt; t += 2) {
            const bool last = (t == nt - 2);
            if constexpr (Sched::GATHER) { if (t == 2 && has_next && tid < BM) gtb[tnx + tid] = nxt_off; }
            const size_t k1 = (size_t)(t + 1) * kstep;
            const size_t k2 = last ? 0 : (size_t)(t + 2) * kstep, k3 = k2 + kstep;
            const char* b2 = last ? nB : cB + (size_t)(t + 2) * kstep; const char* b3 = b2 + kstep;
            PG8_LDB(B0, 0, 0); PG8_LDB(B1, 0, 1); PG8_SCHED; PG8_LDA(At, 0, 0); PG8_STAGEA(PG8_SA(1, 1), 1, k1, false);
            PG8_WAIT_V(8); PG8_WAIT_L(0); PG8_BAR; PG8_MMA(0, 0, At, B0); PG8_MMA(0, 1, At, B1); PG8_BAR; PG8_SCHED;
            PG8_LDA(At, 0, 1); PG8_STAGE(PG8_SB(0, 0), b2, voffB); PG8_STAGE(PG8_SB(0, 1), b2 + hstep, voffB); PG8_STAGEA(PG8_SA(0, 0), 0, k2, last);
            PG8_WAIT_V(8); PG8_WAIT_L(0); PG8_BAR; PG8_MMA(1, 0, At, B0); PG8_MMA(1, 1, At, B1); PG8_BAR; PG8_SCHED;
            PG8_LDB(B0, 1, 0); PG8_LDB(B1, 1, 1); PG8_SCHED; PG8_LDA(At, 1, 0); PG8_STAGEA(PG8_SA(0, 1), 1, k2, last);
            PG8_WAIT_V(8); PG8_WAIT_L(0); PG8_BAR; PG8_MMA(0, 0, At, B0); PG8_MMA(0, 1, At, B1); PG8_BAR; PG8_SCHED;
            PG8_LDA(At, 1, 1); PG8_STAGE(PG8_SB(1, 0), b3, voffB); PG8_STAGE(PG8_SB(1, 1), b3 + hstep, voffB); PG8_STAGEA(PG8_SA(1, 0), 0, k3, last);
            PG8_WAIT_V(8); PG8_WAIT_L(0); PG8_BAR; PG8_MMA(1, 0, At, B0); PG8_MMA(1, 1, At, B1); PG8_BAR; PG8_SCHED;
        }
        if constexpr (ALIGN_EPI) { if (wr == 0) PG8_BAR; }
        E(acc, cur, wr, wc, fr, fq);
        if (!has_next) break;
#pragma unroll
        for (int a = 0; a < 2; ++a)
#pragma unroll
            for (int b = 0; b < 2; ++b)
#pragma unroll
                for (int m = 0; m < 4; ++m)
#pragma unroll
                    for (int n = 0; n < 2; ++n) acc[a][b][m][n] = (f32x4){0.f, 0.f, 0.f, 0.f};
        cur = nxt; cA = nA; cB = nB; tcu = tnx; ++ui;
        if constexpr (ALIGN_EPI) { if (wr == 1) PG8_BAR; }
    }
    PG8_WAIT_V(0);
    if constexpr (!ALIGN_EPI) { if (wr == 0) PG8_BAR; }
    PG8_BAR;
#undef PG8_SA
#undef PG8_SB
#undef PG8_STAGE
#undef PG8_STAGEA
#undef PG8_LDA
#undef PG8_LDB
#undef PG8_MMA
#undef PG8_WAIT_V
#undef PG8_WAIT_L
#undef PG8_BAR
#undef PG8_SCHED
}

struct EpiBf16Plain {
    static constexpr bool PERM = true;
    bf16* O; int ldc;
    __device__ __forceinline__ void operator()(const f32x4 (&acc)[2][2][4][2], const Unit& u, int wr, int wc, int fr, int fq) const {
        const int row0 = u.pm * BM + wr * 64 + fr, col0 = u.pn * BM + wc * 32 + 8 * fq;
#pragma unroll
        for (int ai = 0; ai < 2; ++ai)
#pragma unroll
            for (int m = 0; m < 4; ++m) { bf16* rowp = O + (size_t)(row0 + ai * HALF + m * 16) * ldc + col0;
#pragma unroll
                for (int bj = 0; bj < 2; ++bj) { const f32x4 v0 = acc[ai][bj][m][0], v1 = acc[ai][bj][m][1];
                    u32x4 w; w.x = cvt_pk_bf16(v0[0], v0[1]); w.y = cvt_pk_bf16(v0[2], v0[3]); w.z = cvt_pk_bf16(v1[0], v1[1]); w.w = cvt_pk_bf16(v1[2], v1[3]);
                    *(u32x4*)(rowp + bj * HALF) = w; } }
    }
};
struct EpiPlainI8 {
    static constexpr bool PERM = true;
    bf16* O; int ldc; float inv; int v0, v1; const float* rs;
    __device__ __forceinline__ void operator()(const f32x4 (&acc)[2][2][4][2], const Unit& u, int wr, int wc, int fr, int fq) const {
        const int row0 = u.pm * BM + wr * 64 + fr, col0 = u.pn * BM + wc * 32 + 8 * fq;
        float rsc[2][4];
#pragma unroll
        for (int ai = 0; ai < 2; ++ai)
#pragma unroll
            for (int m = 0; m < 4; ++m) rsc[ai][m] = rs[row0 + ai * HALF + m * 16];
#pragma unroll
        for (int bj = 0; bj < 2; ++bj) { const int c = col0 + bj * HALF; const float scc = (c >= v0 && c < v1) ? inv * 0.5f : inv;
#pragma unroll
            for (int ai = 0; ai < 2; ++ai)
#pragma unroll
                for (int m = 0; m < 4; ++m) { const i32x4 i0 = __builtin_bit_cast(i32x4, acc[ai][bj][m][0]), i1 = __builtin_bit_cast(i32x4, acc[ai][bj][m][1]); const float sc = scc * rsc[ai][m];
                    u32x4 w; w.x = cvt_pk_bf16((float)i0[0] * sc, (float)i0[1] * sc); w.y = cvt_pk_bf16((float)i0[2] * sc, (float)i0[3] * sc); w.z = cvt_pk_bf16((float)i1[0] * sc, (float)i1[1] * sc); w.w = cvt_pk_bf16((float)i1[2] * sc, (float)i1[3] * sc);
                    *(u32x4*)(O + (size_t)(row0 + ai * HALF + m * 16) * ldc + c) = w; } }
    }
};
struct EpiMlaUp {
    static constexpr bool PERM = true;
    bf16* Q; bf16* KK; bf16* V; const float* cs;
    __device__ __forceinline__ void operator()(const f32x4 (&acc)[2][2][4][2], const Unit& u, int wr, int wc, int fr, int fq) const {
        const int row0 = u.pm * BM + wr * 64 + fr;
#pragma unroll
        for (int bj = 0; bj < 2; ++bj) {
            const int c0 = u.pn * BM + bj * HALF + wc * 32 + 8 * fq;
            if (u.pn < 3) {
                const int h = c0 / QKD, d = c0 - h * QKD;
                const bool rope = d >= NOPE; const int i0 = rope ? (d - NOPE) >> 1 : 0;
#pragma unroll
                for (int ai = 0; ai < 2; ++ai)
#pragma unroll
                    for (int m = 0; m < 4; ++m) { const int row = row0 + ai * HALF + m * 16;
                        f32x4 v0 = acc[ai][bj][m][0], v1 = acc[ai][bj][m][1];
                        if (rope) { const f32x4 cA = *(const f32x4*)(cs + (size_t)row * 32 + i0 * 2), cB = *(const f32x4*)(cs + (size_t)row * 32 + i0 * 2 + 4);
                            const f32x4 a = v0, b = v1;
                            v0[0] = a[0] * cA[0] - a[1] * cA[1]; v0[1] = a[0] * cA[1] + a[1] * cA[0]; v0[2] = a[2] * cA[2] - a[3] * cA[3]; v0[3] = a[2] * cA[3] + a[3] * cA[2];
                            v1[0] = b[0] * cB[0] - b[1] * cB[1]; v1[1] = b[0] * cB[1] + b[1] * cB[0]; v1[2] = b[2] * cB[2] - b[3] * cB[3]; v1[3] = b[2] * cB[3] + b[3] * cB[2]; }
                        v0 = v0 * C2Q; v1 = v1 * C2Q;
                        u32x4 w; w.x = cvt_pk_bf16(v0[0], v0[1]); w.y = cvt_pk_bf16(v0[2], v0[3]); w.z = cvt_pk_bf16(v1[0], v1[1]); w.w = cvt_pk_bf16(v1[2], v1[3]);
                        *(u32x4*)(Q + (size_t)row * 768 + c0) = w; asm volatile("" ::: "memory"); }
            } else {
                bf16* base; int ld, cc;
                if (u.pn < 5) { const int c1 = c0 - 768; const int h = c1 >> 6, d = c1 & 63; base = KK; ld = 768; cc = h * QKD + d; }
                else { base = V; ld = 512; cc = c0 - 1280; }
#pragma unroll
                for (int ai = 0; ai < 2; ++ai)
#pragma unroll
                    for (int m = 0; m < 4; ++m) { const int row = row0 + ai * HALF + m * 16; const f32x4 v0 = acc[ai][bj][m][0], v1 = acc[ai][bj][m][1];
                        u32x4 w; w.x = cvt_pk_bf16(v0[0], v0[1]); w.y = cvt_pk_bf16(v0[2], v0[3]); w.z = cvt_pk_bf16(v1[0], v1[1]); w.w = cvt_pk_bf16(v1[2], v1[3]);
                        *(u32x4*)(base + (size_t)row * ld + cc) = w; asm volatile("" ::: "memory"); }
            }
        }
    }
};
struct EpiRwkvSmall {
    static constexpr bool PERM = false;
    float* O; const float* w0; const float* a0;
    __device__ __forceinline__ void operator()(const f32x4 (&acc)[2][2][4][2], const Unit& u, int wr, int wc, int fr, int fq) const {
        const int row0 = u.pm * BM + wr * 64 + fr, col0 = u.pn * BM + wc * 32 + 4 * fq;
        const int kind = u.pn >> 1;
#pragma unroll
        for (int bj = 0; bj < 2; ++bj)
#pragma unroll
            for (int n = 0; n < 2; ++n) { const int c = col0 + bj * HALF + n * 16;
                f32x4 bv = (f32x4){0.f, 0.f, 0.f, 0.f};
                if (kind == 0) bv = *(const f32x4*)(w0 + c); else if (kind == 1) bv = *(const f32x4*)(a0 + (c - 512));
#pragma unroll
                for (int ai = 0; ai < 2; ++ai)
#pragma unroll
                    for (int m = 0; m < 4; ++m) { f32x4 v = acc[ai][bj][m][n] + bv;
                        if (kind == 0) {
#pragma unroll
                            for (int j = 0; j < 4; ++j) { const float z = -v[j]; const float sp = fmaxf(z, 0.f) + __logf(1.0f + __expf(-fabsf(z))); const float w = -sp - 0.5f; v[j] = -__expf(w); }
                        } else if (kind == 1) {
#pragma unroll
                            for (int j = 0; j < 4; ++j) v[j] = sigmoidf_(v[j]);
                        }
                        *(f32x4*)(O + (size_t)(row0 + ai * HALF + m * 16) * N_SM + c) = v; asm volatile("" ::: "memory"); } }
    }
};
struct EpiVres {
    static constexpr bool PERM = true;
    const bf16* vs; const bf16* vf; bf16* vr; const float* v0;
    __device__ __forceinline__ void operator()(const f32x4 (&acc)[2][2][4][2], const Unit& u, int wr, int wc, int fr, int fq) const {
        const int row0 = u.pm * BM + wr * 64 + fr, col0 = u.pn * BM + wc * 32 + 8 * fq;
#pragma unroll
        for (int bj = 0; bj < 2; ++bj) { const int c = col0 + bj * HALF;
            const f32x4 b0 = *(const f32x4*)(v0 + c), b1 = *(const f32x4*)(v0 + c + 4);
#pragma unroll
            for (int ai = 0; ai < 2; ++ai)
#pragma unroll
                for (int m = 0; m < 4; ++m) { const size_t off = (size_t)(row0 + ai * HALF + m * 16) * C5 + c;
                    const u32x4 s = *(const u32x4*)(vs + off), f = *(const u32x4*)(vf + off);
                    const f32x4 g0 = acc[ai][bj][m][0] + b0, g1 = acc[ai][bj][m][1] + b1;
                    float o[8];
#pragma unroll
                    for (int j = 0; j < 4; ++j) { const float sl = bflo(s[j]), sh = bfhi(s[j]), fl = bflo(f[j]), fh = bfhi(f[j]);
                        const float ga = (j < 2) ? g0[2 * j] : g1[2 * j - 4], gb = (j < 2) ? g0[2 * j + 1] : g1[2 * j - 3];
                        o[2 * j] = sl + (fl - sl) * sigmoidf_(ga); o[2 * j + 1] = sh + (fh - sh) * sigmoidf_(gb); }
                    u32x4 w; w.x = cvt_pk_bf16(o[0], o[1]); w.y = cvt_pk_bf16(o[2], o[3]); w.z = cvt_pk_bf16(o[4], o[5]); w.w = cvt_pk_bf16(o[6], o[7]);
                    *(u32x4*)(vr + off) = w; } }
    }
};
struct EpiWo {
    static constexpr bool PERM = true;
    bf16* X; const float* gt;
    __device__ __forceinline__ void operator()(const f32x4 (&acc)[2][2][4][2], const Unit& u, int wr, int wc, int fr, int fq) const {
        const int row0 = u.pm * BM + wr * 64 + fr, col0 = u.pn * BM + wc * 32 + 8 * fq;
        const int b = (u.pm * BM) / SEQ;
#pragma unroll
        for (int bj = 0; bj < 2; ++bj) { const int c = col0 + bj * HALF;
            const f32x4 g0 = *(const f32x4*)(gt + (size_t)b * 6144 + c) + 1.0f, g1 = *(const f32x4*)(gt + (size_t)b * 6144 + c + 4) + 1.0f;
#pragma unroll
            for (int ai = 0; ai < 2; ++ai)
#pragma unroll
                for (int m = 0; m < 4; ++m) { bf16* px = X + (size_t)(row0 + ai * HALF + m * 16) * D + c; const u32x4 xw = *(const u32x4*)px;
                    const f32x4 a0 = acc[ai][bj][m][0], a1 = acc[ai][bj][m][1];
                    u32x4 w; w.x = cvt_pk_bf16(bflo(xw.x) * DN_ALPHA + g0[0] * a0[0], bfhi(xw.x) * DN_ALPHA + g0[1] * a0[1]); w.y = cvt_pk_bf16(bflo(xw.y) * DN_ALPHA + g0[2] * a0[2], bfhi(xw.y) * DN_ALPHA + g0[3] * a0[3]);
                    w.z = cvt_pk_bf16(bflo(xw.z) * DN_ALPHA + g1[0] * a1[0], bfhi(xw.z) * DN_ALPHA + g1[1] * a1[1]); w.w = cvt_pk_bf16(bflo(xw.w) * DN_ALPHA + g1[2] * a1[2], bfhi(xw.w) * DN_ALPHA + g1[3] * a1[3]);
                    *(u32x4*)px = w; } }
    }
};
struct EpiSwiglu {
    static constexpr bool PERM = true;
    unsigned char* O; const float* b1p;
    __device__ __forceinline__ void operator()(const f32x4 (&acc)[2][2][4][2], const Unit& u, int wr, int wc, int fr, int fq) const {
        const int row0 = u.pm * BM + wr * 64 + fr; const int cin = u.pn * BM + wc * 32 + 8 * fq, cout = u.pn * HALF + wc * 32 + 8 * fq;
        const float* bp = b1p + (size_t)u.e * 2048 + cin;
        const f32x4 bg0 = *(const f32x4*)(bp), bg1 = *(const f32x4*)(bp + 4), bl0 = *(const f32x4*)(bp + HALF), bl1 = *(const f32x4*)(bp + HALF + 4);
        constexpr float inv = 1.0f / (QS_H * QS_W1);
#pragma unroll
        for (int ai = 0; ai < 2; ++ai)
#pragma unroll
            for (int m = 0; m < 4; ++m) {
                const i32x4 ig0 = __builtin_bit_cast(i32x4, acc[ai][0][m][0]), ig1 = __builtin_bit_cast(i32x4, acc[ai][0][m][1]), il0 = __builtin_bit_cast(i32x4, acc[ai][1][m][0]), il1 = __builtin_bit_cast(i32x4, acc[ai][1][m][1]);
                float o[8];
#pragma unroll
                for (int j = 0; j < 8; ++j) { const float gv = fminf((float)(j < 4 ? ig0[j & 3] : ig1[j & 3]) * inv + (j < 4 ? bg0[j & 3] : bg1[j & 3]), 7.0f);
                    const float lv = __builtin_amdgcn_fmed3f((float)(j < 4 ? il0[j & 3] : il1[j & 3]) * inv + (j < 4 ? bl0[j & 3] : bl1[j & 3]), -7.0f, 7.0f);
                    const float sg = __builtin_amdgcn_rcpf(1.0f + __builtin_amdgcn_exp2f(gv * (-1.702f * 1.4426950408889634f)));
                    o[j] = (gv * sg) * (lv * QS_U + QS_U); }
                u32x2 w; w.x = q8x4(o[0], o[1], o[2], o[3]); w.y = q8x4(o[4], o[5], o[6], o[7]);
                *(u32x2*)(O + (size_t)(row0 + ai * HALF + m * 16) * FF + cout) = w; }
    }
};
struct EpiMoeOut {
    static constexpr bool PERM = true;
    bf16* O; const float* b2; const float* gatel; const LAS int* tb;
    __device__ __forceinline__ void operator()(const f32x4 (&acc)[2][2][4][2], const Unit& u, int wr, int wc, int fr, int fq) const {
        const int row0 = u.pm * BM + wr * 64 + fr, col0 = u.pn * BM + wc * 32 + 8 * fq;
        const int pos0 = (u.pm - tb[u.e]) * BM + wr * 64 + fr;
        const float* bp = b2 + (size_t)u.e * D + col0;
        constexpr float inv = 1.0f / (QS_U * QS_W2);
        f32x4 bv[2][2];
#pragma unroll
        for (int bj = 0; bj < 2; ++bj) { bv[bj][0] = *(const f32x4*)(bp + bj * HALF); bv[bj][1] = *(const f32x4*)(bp + bj * HALF + 4); }
#pragma unroll
        for (int ai = 0; ai < 2; ++ai)
#pragma unroll
            for (int m = 0; m < 4; ++m) { const float gt = gatel[(size_t)u.e * CAP + pos0 + ai * HALF + m * 16];
                bf16* rowp = O + (size_t)(row0 + ai * HALF + m * 16) * D + col0;
#pragma unroll
                for (int bj = 0; bj < 2; ++bj) { const i32x4 i0 = __builtin_bit_cast(i32x4, acc[ai][bj][m][0]), i1 = __builtin_bit_cast(i32x4, acc[ai][bj][m][1]);
                    f32x4 v0, v1;
#pragma unroll
                    for (int j = 0; j < 4; ++j) { v0[j] = ((float)i0[j] * inv + bv[bj][0][j]) * gt; v1[j] = ((float)i1[j] * inv + bv[bj][1][j]) * gt; }
                    u32x4 w; w.x = cvt_pk_bf16(v0[0], v0[1]); w.y = cvt_pk_bf16(v0[2], v0[3]); w.z = cvt_pk_bf16(v1[0], v1[1]); w.w = cvt_pk_bf16(v1[2], v1[3]);
                    *(u32x4*)(rowp + bj * HALF) = w; } }
    }
};
}

struct Params { const void* in[N_INPUTS]; float* out; unsigned char* ws; int ph_lo, ph_hi; };

struct Frame {
    LAS unsigned char* lds;
    int tid, lane, wave, G, vcu;
    unsigned char* ws;
};
#define WSP(type, off) ((type*)(F.ws + (off)))
#define INP(i) ((const float*)p.in[i])

__device__ const double INV_FREQ[16] = {1.00000000000000000e+00, 5.62341325190349073e-01, 3.16227766016837941e-01, 1.77827941003892293e-01, 1.00000000000000006e-01, 5.62341325190349114e-02,
    3.16227766016837913e-02, 1.77827941003892293e-02, 1.00000000000000002e-02, 5.62341325190349097e-03, 3.16227766016837939e-03, 1.77827941003892275e-03, 1.00000000000000002e-03,
    5.62341325190349097e-04, 3.16227766016837939e-04, 1.77827941003892270e-04};

template <int MODE>
__device__ __forceinline__ void tr_item(const float* W, int ldn, bf16* WT, int ldk, int kofs, int rofs, int k0, int n0, LAS float* scr, int lane) {
    f32x4 ld[8];
#pragma unroll
    for (int i = 0; i < 8; ++i) ld[i] = *(const f32x4*)(W + (size_t)(k0 + 8 * i + (lane >> 3)) * ldn + n0 + 4 * (lane & 7));
#pragma unroll
    for (int i = 0; i < 8; ++i) { LAS float* d = scr + (8 * i + (lane >> 3)) * 33 + 4 * (lane & 7); d[0] = ld[i].x; d[1] = ld[i].y; d[2] = ld[i].z; d[3] = ld[i].w; }
    LDS_WAIT(); asm volatile("" ::: "memory");
    const int c = lane & 7;
#pragma unroll
    for (int j = 0; j < 4; ++j) { const int n = (lane >> 3) + 8 * j; const LAS float* s = scr + (8 * c) * 33 + n;
        u32x4 o; o.x = pk2(s[0 * 33], s[1 * 33]); o.y = pk2(s[2 * 33], s[3 * 33]); o.z = pk2(s[4 * 33], s[5 * 33]); o.w = pk2(s[6 * 33], s[7 * 33]);
        const int ng = n0 + n; int row;
        if (MODE == 0) row = rofs + ng; else { const int jo = ng >> 1, bj = ng & 1; row = rofs + (jo >> 7) * 256 + bj * 128 + (jo & 127); }
        *(GAS u32x4*)(WT + (size_t)row * ldk + kofs + k0 + 8 * c) = o; }
    LDS_WAIT(); asm volatile("" ::: "memory");
}
__device__ __forceinline__ void tr_item_i8(const float* W, int ldn, unsigned char* WT, int ldk, int k0, int n0, LAS float* scr, int lane) {
    f32x4 ld[8];
#pragma unroll
    for (int i = 0; i < 8; ++i) ld[i] = *(const f32x4*)(W + (size_t)(k0 + 8 * i + (lane >> 3)) * ldn + n0 + 4 * (lane & 7));
#pragma unroll
    for (int i = 0; i < 8; ++i) { LAS float* d = scr + (8 * i + (lane >> 3)) * 33 + 4 * (lane & 7); d[0] = ld[i].x; d[1] = ld[i].y; d[2] = ld[i].z; d[3] = ld[i].w; }
    LDS_WAIT(); asm volatile("" ::: "memory");
    { const int n = lane >> 1, hf = lane & 1; const LAS float* sp = scr + (32 * hf) * 33 + n; const int ng = n0 + n;
      const float qs = (ng >= 1440 && ng < 1952) ? 2.0f * QS_WIN : QS_WIN;
      u32x4 o0, o1;
      o0.x = q8x4(sp[0 * 33] * qs, sp[1 * 33] * qs, sp[2 * 33] * qs, sp[3 * 33] * qs); o0.y = q8x4(sp[4 * 33] * qs, sp[5 * 33] * qs, sp[6 * 33] * qs, sp[7 * 33] * qs);
      o0.z = q8x4(sp[8 * 33] * qs, sp[9 * 33] * qs, sp[10 * 33] * qs, sp[11 * 33] * qs); o0.w = q8x4(sp[12 * 33] * qs, sp[13 * 33] * qs, sp[14 * 33] * qs, sp[15 * 33] * qs);
      o1.x = q8x4(sp[16 * 33] * qs, sp[17 * 33] * qs, sp[18 * 33] * qs, sp[19 * 33] * qs); o1.y = q8x4(sp[20 * 33] * qs, sp[21 * 33] * qs, sp[22 * 33] * qs, sp[23 * 33] * qs);
      o1.z = q8x4(sp[24 * 33] * qs, sp[25 * 33] * qs, sp[26 * 33] * qs, sp[27 * 33] * qs); o1.w = q8x4(sp[28 * 33] * qs, sp[29 * 33] * qs, sp[30 * 33] * qs, sp[31 * 33] * qs);
      unsigned char* dp = WT + (size_t)ng * ldk + k0 + 32 * hf;
      *(GAS u32x4*)dp = o0; *(GAS u32x4*)(dp + 16) = o1; }
    LDS_WAIT(); asm volatile("" ::: "memory");
}
__device__ __forceinline__ void zero_rect(const Frame& F, bf16* M, int ld, int r0, int nrows, int c0, int ncols) {
    const int gw = F.vcu * NWAVES + F.wave, NGW = F.G * NWAVES; const int nch = ncols / 8;
    for (int r = gw; r < nrows; r += NGW)
        for (int ch = F.lane; ch < nch; ch += 64) *(GAS u32x4*)(M + (size_t)(r0 + r) * ld + c0 + ch * 8) = (u32x4){0u, 0u, 0u, 0u};
}
__device__ __forceinline__ void phase_prologue(const Params& p, const Frame& F) {
    LAS float* scr = (LAS float*)(F.lds + F.wave * 16384);
    const int gw = F.vcu * NWAVES + F.wave, NGW = F.G * NWAVES;
    constexpr int I_IN = 16 * 69, I_UQ = 4 * 24, I_UK = 2 * 16, I_W2s = 16, I_G2s = 2 * 16, I_WO_ = 16 * 32, I_E1 = 16 * 64, I_E2 = 16 * 32;
    constexpr int PER_L = I_IN + I_UQ + 2 * I_UK + 2 * I_W2s + I_G2s + I_WO_;
    constexpr int NSMALL = DEPTH * PER_L;
    for (int it = gw; it < NSMALL; it += NGW) {
        int r = it;
        {
            const int l = r / PER_L; r -= l * PER_L;
            if (r < I_IN) { tr_item_i8(INP(I_WIN) + (size_t)l * D * N_IN, N_IN, WSP(unsigned char, WS_WINT) + (size_t)l * N_INP * D, D, 64 * (r / 69), 32 * (r % 69), scr, F.lane); continue; } r -= I_IN;
            bf16* up = WSP(bf16, WS_WUPT) + (size_t)l * N_UP * K_UP;
            if (r < I_UQ) { tr_item<0>(INP(I_WUQ) + (size_t)l * QLR * 768, 768, up, K_UP, 0, 0, 64 * (r / 24), 32 * (r % 24), scr, F.lane); continue; } r -= I_UQ;
            if (r < I_UK) { tr_item<0>(INP(I_WUK) + (size_t)l * KVLR * 512, 512, up, K_UP, 256, 768, 64 * (r / 16), 32 * (r % 16), scr, F.lane); continue; } r -= I_UK;
            if (r < I_UK) { tr_item<0>(INP(I_WUV) + (size_t)l * KVLR * 512, 512, up, K_UP, 256, 1280, 64 * (r / 16), 32 * (r % 16), scr, F.lane); continue; } r -= I_UK;
            bf16* sm = WSP(bf16, WS_WSMT) + (size_t)l * N_SM * K_SM;
            if (r < I_W2s) { tr_item<0>(INP(I_W2) + (size_t)l * 64 * 512, 512, sm, K_SM, 0, 0, 0, 32 * r, scr, F.lane); continue; } r -= I_W2s;
            if (r < I_W2s) { tr_item<0>(INP(I_A2) + (size_t)l * 64 * 512, 512, sm, K_SM, 64, 512, 0, 32 * r, scr, F.lane); continue; } r -= I_W2s;
            if (r < I_G2s) { tr_item<0>(INP(I_G2) + (size_t)l * 128 * 512, 512, sm, K_SM, 128, 1024, 64 * (r / 16), 32 * (r % 16), scr, F.lane); continue; } r -= I_G2s;
            tr_item<0>(INP(I_WO) + (size_t)l * D * D, D, WSP(bf16, WS_WOT) + (size_t)l * D * D, D, 0, 0, 64 * (r / 32), 32 * (r % 32), scr, F.lane); continue;
        }
    }
    for (int l = 0; l < DEPTH; ++l) {
        zero_rect(F, (bf16*)(WSP(unsigned char, WS_WINT) + (size_t)l * N_INP * D), D / 2, N_IN, N_INP - N_IN, 0, D / 2);
        bf16* up = WSP(bf16, WS_WUPT) + (size_t)l * N_UP * K_UP;
        zero_rect(F, up, K_UP, 0, 768, 256, 128); zero_rect(F, up, K_UP, 768, 1024, 0, 256);
        bf16* sm = WSP(bf16, WS_WSMT) + (size_t)l * N_SM * K_SM;
        zero_rect(F, sm, K_SM, 0, 512, 64, 192); zero_rect(F, sm, K_SM, 512, 512, 0, 64); zero_rect(F, sm, K_SM, 512, 512, 128, 128); zero_rect(F, sm, K_SM, 1024, 512, 0, 128);
    }
    const int gt = (F.vcu * NTHREADS) + F.tid, NGT = F.G * NTHREADS;
    { const float* v1 = INP(I_V1); const float* v2 = INP(I_V2); bf16* o = WSP(bf16, WS_WV12T);
      for (int i = gt; i < 512 * 512; i += NGT) { const int n = i >> 9, k = i & 511; float s = 0.f;
#pragma unroll 8
          for (int j = 0; j < 32; ++j) s += v1[k * 32 + j] * v2[j * 512 + n];
          o[i] = (bf16)f2bf(s); } }
    { const float* b1 = INP(I_EB1); float* o = WSP(float, WS_B1P);
      for (int i = gt; i < DEPTH * NE * 2048; i += NGT) { const int q = i & 2047, le = i >> 11; const int pn = q >> 8, bj = (q >> 7) & 1, jj = q & 127; o[i] = b1[(size_t)le * 2048 + 2 * (pn * 128 + jj) + bj]; } }
    { bf16* pg = WSP(bf16, WS_PGW);
      for (int i = gt; i < DEPTH * PGW_NFRAG * 64; i += NGT) { const int ln = i & 63, fi = (i >> 6) % PGW_NFRAG, l2 = (i >> 6) / PGW_NFRAG; const int rr = ln & 31, hh = ln >> 5;
          const float* W; int ldw, KS, f0; bool v12 = false;
          if (fi < PGW_KN) { W = INP(I_WUQ) + (size_t)l2 * QLR * 768; ldw = 768; KS = 16; f0 = PGW_Q; }
          else if (fi < PGW_V) { W = INP(I_WUK) + (size_t)l2 * KVLR * 512; ldw = 512; KS = 8; f0 = PGW_KN; }
          else if (fi < PGW_W) { W = INP(I_WUV) + (size_t)l2 * KVLR * 512; ldw = 512; KS = 8; f0 = PGW_V; }
          else if (fi < PGW_A) { W = INP(I_W2) + (size_t)l2 * 64 * 512; ldw = 512; KS = 4; f0 = PGW_W; }
          else if (fi < PGW_G) { W = INP(I_A2) + (size_t)l2 * 64 * 512; ldw = 512; KS = 4; f0 = PGW_A; }
          else if (fi < PGW_VR) { W = INP(I_G2) + (size_t)l2 * 128 * 512; ldw = 512; KS = 8; f0 = PGW_G; }
          else { W = nullptr; ldw = 512; KS = 32; f0 = PGW_VR; v12 = true; }
          const int nb = (fi - f0) / KS, ks = (fi - f0) % KS, n = 32 * nb + rr, k0 = 16 * ks + 8 * hh;
          float v[8];
          if (!v12) {
#pragma unroll
              for (int j = 0; j < 8; ++j) v[j] = W[(size_t)(k0 + j) * ldw + n]; }
          else { const float* v1 = INP(I_V1); const float* v2 = INP(I_V2);
#pragma unroll
              for (int j = 0; j < 8; ++j) { float sacc = 0.f;
#pragma unroll 8
                  for (int q = 0; q < 32; ++q) sacc += v1[(k0 + j) * 32 + q] * v2[q * 512 + n];
                  v[j] = (l2 == 0) ? 0.f : sacc; } }
          u32x4 o; o.x = pk2(v[0], v[1]); o.y = pk2(v[2], v[3]); o.z = pk2(v[4], v[5]); o.w = pk2(v[6], v[7]);
          *(u32x4*)(pg + (size_t)i * 8) = o; } }
    { const float* rw = INP(I_RW); bf16* o = WSP(bf16, WS_RWT);
      for (int i = gt; i < DEPTH * NE * D; i += NGT) { const int k = i & 1023, e = (i >> 10) & 31, l2 = i >> 15; const float v = rw[((size_t)l2 * D + k) * NE + e]; const unsigned hi = f2bf(v); const float lo = v - bf2f(hi);
          o[i] = (bf16)hi; o[DEPTH * NE * D + i] = (bf16)f2bf(lo); } }
    { const int* pos = (const int*)p.in[I_POS]; float* cs = WSP(float, WS_CS);
      for (int i = gt; i < T * 16; i += NGT) { const int t = i >> 4, k = i & 15; const double a = (double)pos[t] * INV_FREQ[k];
          const double q = __builtin_rint(a * 0.63661977236758134308); const int qi = (int)((long long)q & 3);
          double r = __builtin_fma(-q, 1.57079632679489655800e+00, a); r = __builtin_fma(-q, 6.12323399573676603587e-17, r);
          const double r2 = r * r;
          double sn = -2.50521083854417187751e-08; sn = sn * r2 + 2.75573192239858906526e-06; sn = sn * r2 - 1.98412698412698412698e-04; sn = sn * r2 + 8.33333333333333333333e-03; sn = sn * r2 - 1.66666666666666666667e-01; sn = r + r * r2 * sn;
          double cn = 2.08767569878680989792e-09; cn = cn * r2 - 2.75573192239858906526e-07; cn = cn * r2 + 2.48015873015873015873e-05; cn = cn * r2 - 1.38888888888888888889e-03; cn = cn * r2 + 4.16666666666666666667e-02; cn = cn * r2 - 0.5; cn = 1.0 + r2 * cn;
          double sv, cv;
          if (qi == 0) { sv = sn; cv = cn; } else if (qi == 1) { sv = cn; cv = -sn; } else if (qi == 2) { sv = -sn; cv = -cn; } else { sv = -cn; cv = sn; }
          cs[2 * i] = (float)cv; cs[2 * i + 1] = (float)sv; } }
    { LAS float* cact = (LAS float*)(F.lds);
      LAS float* part = (LAS float*)(F.lds + 32768);
      __syncthreads();
      const float* c = INP(I_C);
      for (int i = F.tid; i < NBATCH * D; i += NTHREADS) { const float v = c[i]; cact[i] = v / (1.0f + __expf(-v)); }
      __syncthreads();
      for (int item = F.vcu; item < DEPTH * 96; item += F.G) { const int l = item / 96, n0 = (item % 96) * 64;
          const float* aw = INP(I_ADAW) + (size_t)l * D * 6144 + n0 + F.lane;
          float a8[8];
#pragma unroll
          for (int b = 0; b < 8; ++b) a8[b] = 0.f;
          const int kb = F.wave * 128;
#pragma unroll 4
          for (int k = 0; k < 128; ++k) { const float wv = aw[(size_t)(kb + k) * 6144];
#pragma unroll
              for (int b = 0; b < 8; ++b) a8[b] += cact[b * D + kb + k] * wv; }
#pragma unroll
          for (int b = 0; b < 8; ++b) part[(F.wave * 8 + b) * 64 + F.lane] = a8[b];
          __syncthreads();
          { const int b = F.wave; float s = 0.f;
#pragma unroll
            for (int w = 0; w < 8; ++w) s += part[(w * 8 + b) * 64 + F.lane];
            WSP(float, WS_MOD)[((size_t)l * NBATCH + b) * 6144 + n0 + F.lane] = s + INP(I_ADAB)[(size_t)l * 6144 + n0 + F.lane]; }
          __syncthreads(); }
    }
}

__device__ __forceinline__ void phase_convert_experts(const Params& p, const Frame& F, int c0, int nc) {
    LAS float* scr = (LAS float*)(F.lds + F.wave * 16384);
    constexpr int I_E1 = 16 * 64, I_E2 = 16 * 32, NE1 = DEPTH * NE * I_E1, NE2 = DEPTH * NE * I_E2;
    const int gw = (F.vcu - c0) * NWAVES + F.wave, NGW = nc * NWAVES; const int lane = F.lane;
    __syncthreads();
    f32x4 ld[8];
#define CV_SRC(it, W_, ldn_, k0_, n0_) do { int r_ = (it); if (r_ < NE1) { const int le_ = r_ / I_E1; r_ -= le_ * I_E1; W_ = INP(I_EW1) + (size_t)le_ * D * 2048; ldn_ = 2048; k0_ = 64 * (r_ / 64); n0_ = 32 * (r_ % 64); } \
        else { r_ -= NE1; const int le_ = r_ / I_E2; r_ -= le_ * I_E2; W_ = INP(I_EW2) + (size_t)le_ * FF * D; ldn_ = D; k0_ = 64 * (r_ / 32); n0_ = 32 * (r_ % 32); } } while (0)
#define CV_LOAD(it) do { const float* W_; int ldn_, k0_, n0_; CV_SRC(it, W_, ldn_, k0_, n0_); \
        _Pragma("unroll") for (int i = 0; i < 8; ++i) ld[i] = *(const f32x4*)(W_ + (size_t)(k0_ + 8 * i + (lane >> 3)) * ldn_ + n0_ + 4 * (lane & 7)); } while (0)
    int it = gw;
    if (it < NE1 + NE2) CV_LOAD(it);
    for (; it < NE1 + NE2; it += NGW) {
#pragma unroll
        for (int i = 0; i < 8; ++i) { LAS float* d = scr + (8 * i + (lane >> 3)) * 33 + 4 * (lane & 7); d[0] = ld[i].x; d[1] = ld[i].y; d[2] = ld[i].z; d[3] = ld[i].w; }
        if (it + NGW < NE1 + NE2) CV_LOAD(it + NGW);
        LDS_WAIT(); asm volatile("" ::: "memory");
        int r = it; unsigned char* WT; int ldk, k0, n0; bool perm; float qs;
        if (r < NE1) { const int le = r / I_E1; r -= le * I_E1; WT = WSP(unsigned char, WS_W1T) + (size_t)le * 2048 * D; ldk = D; k0 = 64 * (r / 64); n0 = 32 * (r % 64); perm = true; qs = QS_W1; }
        else { r -= NE1; const int le = r / I_E2; r -= le * I_E2; WT = WSP(unsigned char, WS_W2T) + (size_t)le * D * FF; ldk = FF; k0 = 64 * (r / 32); n0 = 32 * (r % 32); perm = false; qs = QS_W2; }
        { const int n = lane >> 1, hf = lane & 1; const LAS float* sp = scr + (32 * hf) * 33 + n;
          u32x4 o0, o1;
          o0.x = q8x4(sp[0 * 33] * qs, sp[1 * 33] * qs, sp[2 * 33] * qs, sp[3 * 33] * qs); o0.y = q8x4(sp[4 * 33] * qs, sp[5 * 33] * qs, sp[6 * 33] * qs, sp[7 * 33] * qs);
          o0.z = q8x4(sp[8 * 33] * qs, sp[9 * 33] * qs, sp[10 * 33] * qs, sp[11 * 33] * qs); o0.w = q8x4(sp[12 * 33] * qs, sp[13 * 33] * qs, sp[14 * 33] * qs, sp[15 * 33] * qs);
          o1.x = q8x4(sp[16 * 33] * qs, sp[17 * 33] * qs, sp[18 * 33] * qs, sp[19 * 33] * qs); o1.y = q8x4(sp[20 * 33] * qs, sp[21 * 33] * qs, sp[22 * 33] * qs, sp[23 * 33] * qs);
          o1.z = q8x4(sp[24 * 33] * qs, sp[25 * 33] * qs, sp[26 * 33] * qs, sp[27 * 33] * qs); o1.w = q8x4(sp[28 * 33] * qs, sp[29 * 33] * qs, sp[30 * 33] * qs, sp[31 * 33] * qs);
          const int ng = n0 + n; int row = ng;
          if (perm) { const int jo = ng >> 1, bj = ng & 1; row = (jo >> 7) * 256 + bj * 128 + (jo & 127); }
          unsigned char* dp = WT + (size_t)row * ldk + k0 + 32 * hf;
          *(GAS u32x4*)dp = o0; *(GAS u32x4*)(dp + 16) = o1; }
        LDS_WAIT(); asm volatile("" ::: "memory");
    }
#undef CV_LOAD
#undef CV_SRC
    __syncthreads();
}

__device__ __forceinline__ void phase_ln0(const Params& p, const Frame& F) {
    const int gw = F.vcu * NWAVES + F.wave, NGW = F.G * NWAVES;
    const float* mod = WSP(float, WS_MOD);
#pragma unroll 4
    for (int m = gw; m < T; m += NGW) {
        const int b = m / SEQ;
        const GAS f32x4* xr = (const GAS f32x4*)(INP(I_X) + (size_t)m * D) + F.lane;
        f32x4 v[4]; float s = 0.f;
#pragma unroll
        for (int j = 0; j < 4; ++j) { v[j] = xr[64 * j]; s += (v[j].x + v[j].y) + (v[j].z + v[j].w); }
        const float mean = wave_sum(s) * (1.f / D); float s2 = 0.f;
#pragma unroll
        for (int j = 0; j < 4; ++j) { v[j] = v[j] - mean; s2 += (v[j].x * v[j].x + v[j].y * v[j].y) + (v[j].z * v[j].z + v[j].w * v[j].w); }
        const float rstd = 1.f / sqrtf(wave_sum(s2) * (1.f / D) + LN_EPS);
        GAS u32x2* xo = (GAS u32x2*)(WSP(bf16, WS_X) + (size_t)m * D) + F.lane;
        GAS unsigned* ho = (GAS unsigned*)(WSP(unsigned char, WS_H) + (size_t)m * D) + F.lane;
        f32x4 hq[4];
#pragma unroll
        for (int j = 0; j < 4; ++j) { const int c = 4 * F.lane + 256 * j;
            const f32x4 g = *(const f32x4*)(INP(I_ELNG) + c), be = *(const f32x4*)(INP(I_ELNB) + c);
            const f32x4 x0 = v[j] * rstd * g + be; { u32x2 xw; xw.x = pk2(x0.x, x0.y); xw.y = pk2(x0.z, x0.w); xo[64 * j] = xw; }
            const f32x4 sh = *(const f32x4*)(mod + (size_t)b * 6144 + c), sc = *(const f32x4*)(mod + (size_t)b * 6144 + 1024 + c);
            hq[j] = x0 * (sc + 1.0f) + sh; }
        float mx = 0.f;
#pragma unroll
        for (int j = 0; j < 4; ++j) mx = fmaxf(mx, fmaxf(fmaxf(fabsf(hq[j].x), fabsf(hq[j].y)), fmaxf(fabsf(hq[j].z), fabsf(hq[j].w))));
#pragma unroll
        for (int o = 1; o < 64; o <<= 1) mx = fmaxf(mx, __shfl_xor(mx, o));
        mx = fmaxf(mx, 1e-20f); const float qsr = 127.0f / mx;
#pragma unroll
        for (int j = 0; j < 4; ++j) ho[64 * j] = q8x4(hq[j].x * qsr, hq[j].y * qsr, hq[j].z * qsr, hq[j].w * qsr);
        if (F.lane == 0) WSP(float, WS_HS)[m] = mx * (1.0f / 127.0f);
    }
}

__device__ __forceinline__ void phase_prep(const Params& p, const Frame& F, int l) {
    const int gw = F.vcu * NWAVES + F.wave, NGW = F.G * NWAVES; const int lane = F.lane;
    const bf16* P = WSP(bf16, WS_P); const float* mu = INP(I_MU) + (size_t)l * RWKV_IN;
    const float* qg = INP(I_QNG) + (size_t)l * QLR; const float* kvg = INP(I_KVNG) + (size_t)l * KVLR;
    bf16* AN = WSP(bf16, WS_AN); bf16* A2 = WSP(bf16, WS_A2); bf16* RK = WSP(bf16, WS_RK); bf16* KKb = WSP(bf16, WS_KK);
    bf16* VS = l == 0 ? WSP(bf16, WS_VS0) : WSP(bf16, WS_VS1);
    const float* cs = WSP(float, WS_CS);
    const int RPW = (T + NGW - 1) / NGW; const int t0 = gw * RPW; const int t1 = (t0 + RPW < T) ? t0 + RPW : T;
    f32x4 mu0[3], mu1[3];
#pragma unroll
    for (int part = 0; part < 3; ++part) { mu0[part] = *(const f32x4*)(mu + part * 512 + 8 * lane); mu1[part] = *(const f32x4*)(mu + part * 512 + 8 * lane + 4); }
    const float mu_wd = mu[1536 + lane], mu_ad = mu[1600 + lane]; const f32x2 mu_gd = *(const f32x2*)(mu + 1664 + 2 * lane);
    const f32x4 gq = *(const f32x4*)(qg + 4 * lane); const f32x2 gkv = *(const f32x2*)(kvg + 2 * lane);
    u32x4 pw[3]; pw[0] = pw[1] = pw[2] = (u32x4){0u, 0u, 0u, 0u}; float p_wd = 0.f, p_ad = 0.f; unsigned p_gd = 0u;
    if (t0 < t1 && (t0 % SEQ) != 0) { const bf16* rp = P + (size_t)(t0 - 1) * N_INP + MLA_IN;
#pragma unroll
        for (int part = 0; part < 3; ++part) pw[part] = *(const u32x4*)(rp + part * 512 + 8 * lane);
        p_wd = bf2f(rp[1536 + lane]); p_ad = bf2f(rp[1600 + lane]); p_gd = *(const unsigned*)(rp + 1664 + 2 * lane); }
#pragma unroll 2
    for (int t = t0; t < t1; ++t) {
        const bf16* pr = P + (size_t)t * N_INP;
        if ((t % SEQ) == 0) { pw[0] = pw[1] = pw[2] = (u32x4){0u, 0u, 0u, 0u}; p_wd = 0.f; p_ad = 0.f; p_gd = 0u; }
        { const u32x2 qw = *(const u32x2*)(pr + 4 * lane); float q0 = bflo(qw.x), q1 = bfhi(qw.x), q2 = bflo(qw.y), q3 = bfhi(qw.y);
          const float rq = __builtin_amdgcn_rsqf(wave_sum(q0 * q0 + q1 * q1 + q2 * q2 + q3 * q3) * (1.f / QLR) + RMS_EPS);
          u32x2 w; w.x = pk2(q0 * rq * gq.x, q1 * rq * gq.y); w.y = pk2(q2 * rq * gq.z, q3 * rq * gq.w); *(u32x2*)(AN + (size_t)t * K_UP + 4 * lane) = w;
          const unsigned kw = *(const unsigned*)(pr + QLR + 2 * lane); const float k0 = bflo(kw), k1 = bfhi(kw);
          const float rk = __builtin_amdgcn_rsqf(wave_sum(k0 * k0 + k1 * k1) * (1.f / KVLR) + RMS_EPS);
          *(unsigned*)(AN + (size_t)t * K_UP + QLR + 2 * lane) = pk2(k0 * rk * gkv.x, k1 * rk * gkv.y);
          const int i = lane & 15; const unsigned rw = *(const unsigned*)(pr + QLR + KVLR + 2 * i); const float x0 = bflo(rw), x1 = bfhi(rw);
          const f32x2 csv = *(const f32x2*)(cs + (size_t)t * 32 + 2 * i); const unsigned ro = pk2(x0 * csv.x - x1 * csv.y, x0 * csv.y + x1 * csv.x);
          const int h0 = (lane >> 4) * 2;
          *(unsigned*)(KKb + (size_t)t * 768 + h0 * QKD + NOPE + 2 * i) = ro; *(unsigned*)(KKb + (size_t)t * 768 + (h0 + 1) * QKD + NOPE + 2 * i) = ro; }
        const bf16* rr = pr + MLA_IN;
#pragma unroll
        for (int part = 0; part < 3; ++part) {
            const u32x4 cw = *(const u32x4*)(rr + part * 512 + 8 * lane); const u32x4 pv_ = pw[part]; pw[part] = cw;
            float o[8];
#pragma unroll
            for (int j = 0; j < 4; ++j) { const float a = bflo(cw[j]), b = bfhi(cw[j]), pa = bflo(pv_[j]), pb = bfhi(pv_[j]); const float ma = j < 2 ? mu0[part][2 * j] : mu1[part][2 * j - 4], mb = j < 2 ? mu0[part][2 * j + 1] : mu1[part][2 * j - 3];
                o[2 * j] = a + ma * (pa - a); o[2 * j + 1] = b + mb * (pb - b); }
            u32x4 w; w.x = pk2(o[0], o[1]); w.y = pk2(o[2], o[3]); w.z = pk2(o[4], o[5]); w.w = pk2(o[6], o[7]);
            if (part < 2) *(u32x4*)(RK + (size_t)t * 1024 + part * 512 + 8 * lane) = w; else *(u32x4*)(VS + (size_t)t * C5 + 8 * lane) = w;
        }
        { const float a = bf2f(rr[1536 + lane]); const float v = a + mu_wd * (p_wd - a); p_wd = a; A2[(size_t)t * K_SM + lane] = (bf16)f2bf(tanhf_(v)); }
        { const float a = bf2f(rr[1600 + lane]); const float v = a + mu_ad * (p_ad - a); p_ad = a; A2[(size_t)t * K_SM + 64 + lane] = (bf16)f2bf(v); }
        { const unsigned cw = *(const unsigned*)(rr + 1664 + 2 * lane); const float a = bflo(cw), b = bfhi(cw); const float va = a + mu_gd.x * (bflo(p_gd) - a), vb = b + mu_gd.y * (bfhi(p_gd) - b); p_gd = cw;
          *(unsigned*)(A2 + (size_t)t * K_SM + 128 + 2 * lane) = pk2(sigmoidf_(va), sigmoidf_(vb)); }
    }
}

namespace pgm {
constexpr int RP = 64, LDA_AN = 784, LDA_A2 = 528, LDA_VS = 1040, OFF_A2 = RP * LDA_AN, OFF_VS = 0;
__device__ __forceinline__ int crow(int r, int hi) { return (r & 3) + 8 * (r >> 2) + 4 * hi; }
template <int KSTEPS>
__device__ __forceinline__ void block_mma(f32x16 (&acc)[2], const LAS unsigned char* A, int lda, const bf16* Bt, int ldb, int nrow0, int kofs, int r, int h) {
    const bf16* bp = Bt + (size_t)(nrow0 + r) * ldb + kofs + 8 * h;
    const LAS unsigned char* a0 = A + r * lda + (kofs + 8 * h) * 2; const LAS unsigned char* a1 = a0 + 32 * lda;
    bf16x8 cur[4], nxt[4];
#pragma unroll
    for (int j = 0; j < 4; ++j) cur[j] = *(const bf16x8*)(bp + 16 * j);
#pragma unroll
    for (int g = 0; g < KSTEPS / 4; ++g) {
        if (g + 1 < KSTEPS / 4) {
#pragma unroll
            for (int j = 0; j < 4; ++j) nxt[j] = *(const bf16x8*)(bp + 16 * (4 * g + 4 + j)); }
#pragma unroll
        for (int j = 0; j < 4; ++j) { const int ks = 4 * g + j; const bf16x8 x0 = *(const LAS bf16x8*)(a0 + ks * 32), x1 = *(const LAS bf16x8*)(a1 + ks * 32);
            acc[0] = __builtin_amdgcn_mfma_f32_32x32x16_bf16(cur[j], x0, acc[0], 0, 0, 0); acc[1] = __builtin_amdgcn_mfma_f32_32x32x16_bf16(cur[j], x1, acc[1], 0, 0, 0); }
        asm volatile("" ::: "memory");
#pragma unroll
        for (int j = 0; j < 4; ++j) cur[j] = nxt[j];
    }
}
template <int KSTEPS>
__device__ __forceinline__ void load_frags(bf16x8 (&fr)[KSTEPS], const bf16* pg, int frag0, int lane) {
    const bf16* bp = pg + ((size_t)frag0 * 64 + lane) * 8;
#pragma unroll
    for (int ks = 0; ks < KSTEPS; ++ks) fr[ks] = *(const bf16x8*)(bp + (size_t)ks * 512);
}
template <int KSTEPS>
__device__ __forceinline__ void mma_frags(f32x16 (&acc)[2], const LAS unsigned char* A, int lda, int kofs, const bf16x8 (&fr)[KSTEPS], int r, int h) {
    const LAS unsigned char* a0 = A + r * lda + (kofs + 8 * h) * 2; const LAS unsigned char* a1 = a0 + 32 * lda;
#pragma unroll
    for (int ks = 0; ks < KSTEPS; ++ks) { const bf16x8 x0 = *(const LAS bf16x8*)(a0 + ks * 32), x1 = *(const LAS bf16x8*)(a1 + ks * 32);
        acc[0] = __builtin_amdgcn_mfma_f32_32x32x16_bf16(fr[ks], x0, acc[0], 0, 0, 0); acc[1] = __builtin_amdgcn_mfma_f32_32x32x16_bf16(fr[ks], x1, acc[1], 0, 0, 0); }
}
constexpr int STG_LD = 80, STG_BYTES = RP * STG_LD, OFF_STG = RP * LDA_AN + RP * LDA_A2, OFF_ROPE = OFF_STG + 8 * STG_BYTES;
__device__ __forceinline__ void stage_put4(LAS unsigned char* stg, int mt, int g, int r, int h, float v0, float v1, float v2, float v3) {
    u32x2 w; w.x = cvtpk_c(v0, v1); w.y = cvtpk_c(v2, v3); *(LAS u32x2*)(stg + (32 * mt + r) * STG_LD + (8 * g + 4 * h) * 2) = w; }
__device__ __forceinline__ void stage_flush(const LAS unsigned char* stg, bf16* dst, int ldd, int lane) {
#pragma unroll
    for (int j = 0; j < 4; ++j) { const int row = 16 * j + (lane >> 2), ch = lane & 3; const u32x4 v = *(const LAS u32x4*)(stg + row * STG_LD + ch * 16); *(u32x4*)(dst + (size_t)row * ldd + 8 * ch) = v; }
}
__device__ __forceinline__ void stage_flush_kt(const LAS unsigned char* stg, bf16* dst, int lane) {
#pragma unroll
    for (int j = 0; j < 4; ++j) { const int row = 16 * j + (lane & 15), ch = lane >> 4; const u32x4 v = *(const LAS u32x4*)(stg + row * STG_LD + ch * 16); *(u32x4*)(dst + ch * 512 + row * 8) = v; }
}
}

__device__ __forceinline__ void phase_pgemm(const Params& p, const Frame& F, int l) {
    using namespace pgm;
    const int lane0 = F.lane, wave = F.wave;
    const bf16* P = WSP(bf16, WS_P); const float* mu = INP(I_MU) + (size_t)l * RWKV_IN;
    const float* qg = INP(I_QNG) + (size_t)l * QLR; const float* kvg = INP(I_KVNG) + (size_t)l * KVLR;
    bf16* RK = WSP(bf16, WS_RK); bf16* KKb = WSP(bf16, WS_KK); bf16* Qb = WSP(bf16, WS_Q); bf16* Vb = WSP(bf16, WS_V);
    bf16* VS = l == 0 ? WSP(bf16, WS_VS0) : WSP(bf16, WS_VS1);
    float* LWb = WSP(float, WS_LW); bf16* AGb = WSP(bf16, WS_AG);
    const float* cs = WSP(float, WS_CS);
    const bf16* PGW = WSP(bf16, WS_PGW) + (size_t)l * PGW_NFRAG * 512;
    const float* w0 = INP(I_W0) + (size_t)l * C5; const float* a0p = INP(I_A0) + (size_t)l * C5;
    LAS unsigned char* AN = F.lds; LAS unsigned char* A2 = F.lds + OFF_A2; LAS unsigned char* VSl = F.lds + OFF_VS;
    for (int panel = F.vcu; panel < T / RP; panel += F.G) {
        const int row0 = panel * RP;
        int lane = lane0; asm volatile("" : "+v"(lane)); const int r = lane & 31, h = lane >> 5;
        __syncthreads();
        {
            f32x4 mu0[3], mu1[3];
#pragma unroll
            for (int part = 0; part < 3; ++part) { mu0[part] = *(const f32x4*)(mu + part * 512 + 8 * lane); mu1[part] = *(const f32x4*)(mu + part * 512 + 8 * lane + 4); }
            const float mu_wd = mu[1536 + lane], mu_ad = mu[1600 + lane]; const f32x2 mu_gd = *(const f32x2*)(mu + 1664 + 2 * lane);
            const f32x4 gq = *(const f32x4*)(qg + 4 * lane); const f32x2 gkv = *(const f32x2*)(kvg + 2 * lane);
            const int t0 = row0 + 8 * wave;
            u32x4 pw[3]; pw[0] = pw[1] = pw[2] = (u32x4){0u, 0u, 0u, 0u}; float p_wd = 0.f, p_ad = 0.f; unsigned p_gd = 0u;
            if ((t0 % SEQ) != 0) { const bf16* rp = P + (size_t)(t0 - 1) * N_INP + MLA_IN;
#pragma unroll
                for (int part = 0; part < 3; ++part) pw[part] = *(const u32x4*)(rp + part * 512 + 8 * lane);
                p_wd = bf2f(rp[1536 + lane]); p_ad = bf2f(rp[1600 + lane]); p_gd = *(const unsigned*)(rp + 1664 + 2 * lane); }
#pragma unroll 2
            for (int i8 = 0; i8 < 8; ++i8) { const int t = t0 + i8, rl = 8 * wave + i8;
                const bf16* pr = P + (size_t)t * N_INP;
                { const u32x2 qw = *(const u32x2*)(pr + 4 * lane); float q0 = bflo(qw.x), q1 = bfhi(qw.x), q2 = bflo(qw.y), q3 = bfhi(qw.y);
                  const float rq = __builtin_amdgcn_rsqf(wave_sum(q0 * q0 + q1 * q1 + q2 * q2 + q3 * q3) * (1.f / QLR) + RMS_EPS);
                  u32x2 w; w.x = pk2(q0 * rq * gq.x, q1 * rq * gq.y); w.y = pk2(q2 * rq * gq.z, q3 * rq * gq.w); *(LAS u32x2*)(AN + rl * LDA_AN + lane * 8) = w;
                  const unsigned kw = *(const unsigned*)(pr + QLR + 2 * lane); const float k0 = bflo(kw), k1 = bfhi(kw);
                  const float rk = __builtin_amdgcn_rsqf(wave_sum(k0 * k0 + k1 * k1) * (1.f / KVLR) + RMS_EPS);
                  *(LAS unsigned*)(AN + rl * LDA_AN + (QLR + 2 * lane) * 2) = pk2(k0 * rk * gkv.x, k1 * rk * gkv.y);
                  const int i = lane & 15; const unsigned rw = *(const unsigned*)(pr + QLR + KVLR + 2 * i); const float x0 = bflo(rw), x1 = bfhi(rw);
                  const f32x2 csv = *(const f32x2*)(cs + (size_t)t * 32 + 2 * i); const unsigned ro = pk2(x0 * csv.x - x1 * csv.y, x0 * csv.y + x1 * csv.x);
                  if (lane < 16) *(LAS unsigned*)(F.lds + OFF_ROPE + rl * 64 + 4 * i) = ro; }
                const bf16* rr = pr + MLA_IN;
#pragma unroll
                for (int part = 0; part < 3; ++part) {
                    const u32x4 cw = *(const u32x4*)(rr + part * 512 + 8 * lane); const u32x4 pv_ = pw[part]; pw[part] = cw;
                    float o[8];
#pragma unroll
                    for (int j = 0; j < 4; ++j) { const float a = bflo(cw[j]), b = bfhi(cw[j]), pa = bflo(pv_[j]), pb = bfhi(pv_[j]); const float ma = j < 2 ? mu0[part][2 * j] : mu1[part][2 * j - 4], mb = j < 2 ? mu0[part][2 * j + 1] : mu1[part][2 * j - 3];
                        o[2 * j] = a + ma * (pa - a); o[2 * j + 1] = b + mb * (pb - b); }
                    u32x4 w; w.x = pk2(o[0], o[1]); w.y = pk2(o[2], o[3]); w.z = pk2(o[4], o[5]); w.w = pk2(o[6], o[7]);
                    if (part < 2) *(u32x4*)(RK + (size_t)t * 1024 + part * 512 + 8 * lane) = w; else *(u32x4*)(VS + (size_t)t * C5 + 8 * lane) = w;
                }
                { const float a = bf2f(rr[1536 + lane]); const float v = a + mu_wd * (p_wd - a); p_wd = a; *(LAS bf16*)(A2 + rl * LDA_A2 + lane * 2) = (bf16)f2bf(tanhf_(v)); }
                { const float a = bf2f(rr[1600 + lane]); const float v = a + mu_ad * (p_ad - a); p_ad = a; *(LAS bf16*)(A2 + rl * LDA_A2 + (64 + lane) * 2) = (bf16)f2bf(v); }
                { const unsigned cw = *(const unsigned*)(rr + 1664 + 2 * lane); const float a = bflo(cw), b = bfhi(cw); const float va = a + mu_gd.x * (bflo(p_gd) - a), vb = b + mu_gd.y * (bfhi(p_gd) - b); p_gd = cw;
                  *(LAS unsigned*)(A2 + rl * LDA_A2 + (128 + 2 * lane) * 2) = pk2(sigmoidf_(va), sigmoidf_(vb)); }
            }
        }
        __syncthreads();
#pragma unroll 1
        for (int j = 0; j < 4; ++j) { int tid2 = F.tid; asm volatile("" : "+v"(tid2)); const int pc = tid2 + 512 * j, key = pc & 63, c4 = (pc >> 6) & 3, hh = pc >> 8;
            const u32x4 v = *(const LAS u32x4*)(F.lds + OFF_ROPE + key * 64 + c4 * 16); *(u32x4*)(KKb + (size_t)panel * 49152 + hh * 6144 + (8 + c4) * 512 + key * 8) = v; }
        LAS unsigned char* stg = F.lds + OFF_STG + wave * STG_BYTES;
        const int wrot = (wave + F.vcu) & 7, rq = (F.vcu >> 3) % 3, rk = (F.vcu >> 3) & 3, rs6 = (F.vcu >> 3) % 6;
        bf16x8 fq[16], fqn[16];
        load_frags<16>(fqn, PGW, PGW_Q + 16 * (wrot + 8 * rq), lane);
#pragma unroll 1
        for (int it = 0; it < 3; ++it) { const int nb = wrot + 8 * ((it + rq) % 3); f32x16 acc[2]; acc[0] = f32x16{}; acc[1] = f32x16{};
#pragma unroll
            for (int ks = 0; ks < 16; ++ks) fq[ks] = fqn[ks];
            if (it + 1 < 3) load_frags<16>(fqn, PGW, PGW_Q + 16 * (wrot + 8 * ((it + 1 + rq) % 3)), lane);
            const bool rope = (nb % 3) == 2;
            f32x4 c48[2][4];
#pragma unroll
            for (int mt = 0; mt < 2; ++mt)
#pragma unroll
                for (int g = 0; g < 4; ++g) c48[mt][g] = rope ? *(const f32x4*)(cs + (size_t)(row0 + 32 * mt + r) * 32 + 8 * g + 4 * h) : (f32x4){1.f, 0.f, 1.f, 0.f};
            __builtin_amdgcn_sched_barrier(0);
            mma_frags<16>(acc, AN, LDA_AN, 0, fq, r, h);
#pragma unroll
            for (int mt = 0; mt < 2; ++mt) {
#pragma unroll
                for (int g = 0; g < 4; ++g) { float v0 = acc[mt][4 * g], v1 = acc[mt][4 * g + 1], v2 = acc[mt][4 * g + 2], v3 = acc[mt][4 * g + 3];
                    if (rope) { const f32x4 c4 = c48[mt][g];
                        const float a0 = v0, a1 = v1, a2 = v2, a3 = v3; v0 = a0 * c4.x - a1 * c4.y; v1 = a0 * c4.y + a1 * c4.x; v2 = a2 * c4.z - a3 * c4.w; v3 = a2 * c4.w + a3 * c4.z; }
                    stage_put4(stg, mt, g, r, h, v0 * C2Q, v1 * C2Q, v2 * C2Q, v3 * C2Q); } }
            stage_flush(stg, Qb + (size_t)row0 * 768 + 32 * nb, 768, lane); }
        bf16x8 fk[8], fkn[8];
        load_frags<8>(fkn, PGW, PGW_KN + 8 * (wrot + 8 * rk), lane);
#pragma unroll 1
        for (int it = 0; it < 4; ++it) { const int nb = wrot + 8 * ((it + rk) & 3); f32x16 acc[2]; acc[0] = f32x16{}; acc[1] = f32x16{};
            const bool isv = nb >= 16; const int n0 = 32 * (nb & 15);
#pragma unroll
            for (int ks = 0; ks < 8; ++ks) fk[ks] = fkn[ks];
            if (it + 1 < 4) load_frags<8>(fkn, PGW, PGW_KN + 8 * (wrot + 8 * ((it + 1 + rk) & 3)), lane);
            __builtin_amdgcn_sched_barrier(0);
            mma_frags<8>(acc, AN, LDA_AN, 256, fk, r, h);
#pragma unroll
            for (int mt = 0; mt < 2; ++mt)
#pragma unroll
                for (int g = 0; g < 4; ++g) stage_put4(stg, mt, g, r, h, acc[mt][4 * g], acc[mt][4 * g + 1], acc[mt][4 * g + 2], acc[mt][4 * g + 3]);
            if (isv) stage_flush(stg, Vb + (size_t)row0 * C5 + n0, C5, lane);
            else stage_flush_kt(stg, KKb + (size_t)panel * 49152 + (n0 >> 6) * 6144 + ((n0 & 63) >> 3) * 512, lane); }
        bf16x8 fs[8], fsn[8];
#pragma unroll
        for (int ks = 0; ks < 8; ++ks) fsn[ks] = (bf16x8){0, 0, 0, 0, 0, 0, 0, 0};
        { const int nn = wrot + 8 * rs6, kn = nn >> 4;
          if (kn == 2) load_frags<8>(fsn, PGW, PGW_G + 8 * (nn & 15), lane);
          else { bf16x8 t4[4]; load_frags<4>(t4, PGW, (kn == 0 ? PGW_W : PGW_A) + 4 * (nn & 15), lane); fsn[0] = t4[0]; fsn[1] = t4[1]; fsn[2] = t4[2]; fsn[3] = t4[3]; } }
#pragma unroll 1
        for (int it = 0; it < 6; ++it) { const int nb = wrot + 8 * ((it + rs6) % 6); f32x16 acc[2]; acc[0] = f32x16{}; acc[1] = f32x16{};
            const int kind = nb >> 4, n0 = 32 * (nb & 15);
#pragma unroll
            for (int ks = 0; ks < 8; ++ks) fs[ks] = fsn[ks];
            if (it + 1 < 6) { const int nn = wrot + 8 * ((it + 1 + rs6) % 6), kn = nn >> 4;
                if (kn == 2) load_frags<8>(fsn, PGW, PGW_G + 8 * (nn & 15), lane);
                else { bf16x8 t4[4]; load_frags<4>(t4, PGW, (kn == 0 ? PGW_W : PGW_A) + 4 * (nn & 15), lane); fsn[0] = t4[0]; fsn[1] = t4[1]; fsn[2] = t4[2]; fsn[3] = t4[3]; } }
            f32x4 bz4[4];
#pragma unroll
            for (int g = 0; g < 4; ++g) bz4[g] = kind == 2 ? (f32x4){0.f, 0.f, 0.f, 0.f} : *(const f32x4*)((kind == 0 ? w0 : a0p) + n0 + 8 * g + 4 * h);
            __builtin_amdgcn_sched_barrier(0);
            if (kind == 2) mma_frags<8>(acc, A2, LDA_A2, 128, fs, r, h);
            else { bf16x8 t4[4]; t4[0] = fs[0]; t4[1] = fs[1]; t4[2] = fs[2]; t4[3] = fs[3]; mma_frags<4>(acc, A2, LDA_A2, kind == 0 ? 0 : 64, t4, r, h); }
            if (kind == 0) {
#pragma unroll
                for (int mt = 0; mt < 2; ++mt) { float* lrow = LWb + (size_t)(row0 + 32 * mt + r) * C5 + n0;
#pragma unroll
                    for (int g = 0; g < 4; ++g) { const f32x4 bz = bz4[g]; f32x4 o;
#pragma unroll
                        for (int e = 0; e < 4; ++e) { const float z = -(acc[mt][4 * g + e] + bz[e]); const float sp = fmaxf(z, 0.f) + __logf(1.0f + __expf(-fabsf(z))); o[e] = -__expf(-sp - 0.5f); }
                        *(f32x4*)(lrow + 8 * g + 4 * h) = o; } }
            } else {
#pragma unroll
                for (int mt = 0; mt < 2; ++mt)
#pragma unroll
                    for (int g = 0; g < 4; ++g) { float v0 = acc[mt][4 * g], v1 = acc[mt][4 * g + 1], v2 = acc[mt][4 * g + 2], v3 = acc[mt][4 * g + 3];
                        if (kind == 1) { const f32x4 bz = bz4[g]; v0 = sigmoidf_(v0 + bz.x); v1 = sigmoidf_(v1 + bz.y); v2 = sigmoidf_(v2 + bz.z); v3 = sigmoidf_(v3 + bz.w); }
                        stage_put4(stg, mt, g, r, h, v0, v1, v2, v3); }
                stage_flush(stg, AGb + (size_t)row0 * 1024 + (kind - 1) * 512 + n0, 1024, lane); } }
        if (l > 0) {
            int tid2 = F.tid; asm volatile("" : "+v"(tid2)); const int lane2 = tid2 & 63, r2 = tid2 & 31, h2 = (tid2 >> 5) & 1;
            __syncthreads();
            const bf16* VS1 = WSP(bf16, WS_VS1); const bf16* VS0 = WSP(bf16, WS_VS0); bf16* VR = WSP(bf16, WS_VR); const float* v0 = INP(I_V0);
            asm volatile("s_waitcnt vmcnt(0)" ::: "memory");
            __builtin_amdgcn_fence(__ATOMIC_ACQUIRE, "agent"); asm volatile("s_waitcnt vmcnt(0)" ::: "memory");
            for (int i = tid2; i < RP * 64; i += NTHREADS) { const int rl = i >> 6, ch = i & 63; *(LAS u32x4*)(VSl + rl * LDA_VS + ch * 16) = *(const u32x4*)(VS1 + (size_t)(row0 + rl) * C5 + ch * 8); }
            __syncthreads();
#pragma unroll 1
            for (int it = 0; it < 2; ++it) { const int nb = wrot + 8 * ((it + (F.vcu >> 3)) & 1); f32x16 acc[2]; acc[0] = f32x16{}; acc[1] = f32x16{};
                { bf16x8 fv[16]; load_frags<16>(fv, PGW, PGW_VR + 32 * nb, lane2); mma_frags<16>(acc, VSl, LDA_VS, 0, fv, r2, h2); load_frags<16>(fv, PGW, PGW_VR + 32 * nb + 16, lane2); mma_frags<16>(acc, VSl, LDA_VS, 256, fv, r2, h2); }
#pragma unroll
                for (int mt = 0; mt < 2; ++mt) { const int rl = 32 * mt + r2; const size_t row = (size_t)(row0 + rl);
#pragma unroll
                    for (int g = 0; g < 4; ++g) { const int n = 32 * nb + 8 * g + 4 * h2; const f32x4 bz = *(const f32x4*)(v0 + n);
                        const u32x2 sw = *(const LAS u32x2*)(VSl + rl * LDA_VS + n * 2); const u32x2 fw = *(const u32x2*)(VS0 + row * C5 + n);
                        const float s0 = bflo(sw.x), s1 = bfhi(sw.x), s2 = bflo(sw.y), s3 = bfhi(sw.y), f0 = bflo(fw.x), f1 = bfhi(fw.x), f2 = bflo(fw.y), f3 = bfhi(fw.y);
                        stage_put4(stg, mt, g, r2, h2, s0 + (f0 - s0) * sigmoidf_(acc[mt][4 * g] + bz.x), s1 + (f1 - s1) * sigmoidf_(acc[mt][4 * g + 1] + bz.y),
                                   s2 + (f2 - s2) * sigmoidf_(acc[mt][4 * g + 2] + bz.z), s3 + (f3 - s3) * sigmoidf_(acc[mt][4 * g + 3] + bz.w)); } }
                stage_flush(stg, VR + (size_t)row0 * C5 + 32 * nb, C5, lane2); }
        }
    }
    __syncthreads();
}

namespace att {
__device__ __forceinline__ int crow(int r, int hi) { return (r & 3) + 8 * (r >> 2) + 4 * hi; }
constexpr int KSLOT = 12288, VSLOT = 8192;
constexpr int NSLOT = 4;
constexpr int LDS_K = 0, LDS_V = NSLOT * KSLOT, LDS_WS = LDS_V + NSLOT * VSLOT, LDS_OST = LDS_WS + NWAVES * 64 * 4, LDS_TOTAL = LDS_OST + NWAVES * 4096;
__device__ __forceinline__ void glds16(const void* gsrc, unsigned lds_dst) { unsigned keep;
    asm volatile("s_mov_b32 %0, m0\n\ts_mov_b32 m0, %2\n\ts_nop 0\n\tglobal_load_lds_dwordx4 %1, off\n\ts_mov_b32 m0, %0" : "=&s"(keep) : "v"(gsrc), "s"(lds_dst) : "memory"); }
__device__ __forceinline__ float max3f(float a, float b, float c) { return fmaxf(fmaxf(a, b), c); }
#define ATT_WAIT_BAR() asm volatile("s_waitcnt vmcnt(0) lgkmcnt(0)\n\ts_barrier" ::: "memory")
__device__ __forceinline__ float rowmax(const f32x16& p0, const f32x16& p1) {
    float a = max3f(p0[0], p0[1], p1[0]), b = max3f(p0[2], p0[3], p1[1]); a = max3f(a, p1[2], p1[3]);
#pragma unroll
    for (int r = 4; r < 16; r += 4) { a = max3f(a, p0[r], p0[r + 1]); b = max3f(b, p0[r + 2], p0[r + 3]); a = max3f(a, p1[r], p1[r + 1]); b = max3f(b, p1[r + 2], p1[r + 3]); }
    const float m = fmaxf(a, b);
    auto rr = __builtin_amdgcn_permlane32_swap(__float_as_uint(m), __float_as_uint(m), false, false);
    return fmaxf(__uint_as_float(rr[0]), __uint_as_float(rr[1]));
}
__device__ __forceinline__ void pv(f32x16* o, int vb, bf16x8 pa0, bf16x8 pa1, bf16x8 pa2, bf16x8 pa3) {
#pragma unroll
    for (int d0 = 0; d0 < 2; ++d0) { s16x4 lo[4], hi[4];
#pragma unroll
        for (int ks = 0; ks < 4; ++ks) {
            asm volatile("ds_read_b64_tr_b16 %0,%1 offset:%c2" : "=&v"(lo[ks]) : "v"(vb), "i"(d0 * 4096 + ks * 1024) : "memory");
            asm volatile("ds_read_b64_tr_b16 %0,%1 offset:%c2" : "=&v"(hi[ks]) : "v"(vb), "i"(d0 * 4096 + ks * 1024 + 512) : "memory"); }
        asm volatile("s_waitcnt lgkmcnt(0)" ::: "memory"); __builtin_amdgcn_sched_barrier(0);
#define PK(k) (bf16x8){lo[k][0], lo[k][1], lo[k][2], lo[k][3], hi[k][0], hi[k][1], hi[k][2], hi[k][3]}
        o[d0] = __builtin_amdgcn_mfma_f32_32x32x16_bf16(pa0, PK(0), o[d0], 0, 0, 0);
        o[d0] = __builtin_amdgcn_mfma_f32_32x32x16_bf16(pa1, PK(1), o[d0], 0, 0, 0);
        o[d0] = __builtin_amdgcn_mfma_f32_32x32x16_bf16(pa2, PK(2), o[d0], 0, 0, 0);
        o[d0] = __builtin_amdgcn_mfma_f32_32x32x16_bf16(pa3, PK(3), o[d0], 0, 0, 0);
#undef PK
    }
}
__device__ __forceinline__ void attn_unit(int b, int h, int qb, const bf16* Q, const bf16* __restrict__ KKp, const bf16* __restrict__ Vp, bf16* O, char* shm) {
    const int tid = threadIdx.x, lane = tid & 63, r32 = lane & 31, hi = lane >> 5; const int wid = __builtin_amdgcn_readfirstlane(tid >> 6);
    const long rowbase = (long)b * SEQ; const int q0 = qb * 256;
    const bf16* Qw = Q + (rowbase + q0 + wid * 32) * 768 + h * QKD;
    const bf16* Kh = KKp + (size_t)(b * (SEQ / 64)) * 49152 + h * 6144; const bf16* Vh = Vp + rowbase * 512 + h * VD;
    const unsigned lds0 = (unsigned)(uintptr_t)shm;
    float* wsf = (float*)(shm + LDS_WS) + wid * 64;
    const bf16* ksrc0 = Kh + wid * 512 + lane * 8;
    const bf16* ksrc1 = Kh + (8 + (wid & 3)) * 512 + lane * 8;
    const bf16* vsrc = Vh + (long)(16 * (wid & 3) + (lane >> 2)) * 512 + (wid >> 2) * 32 + (lane & 3) * 8;
    const unsigned kdst0 = lds0 + LDS_K + wid * 1024, kdst1 = lds0 + LDS_K + (8 + (wid & 3)) * 1024, vdst = lds0 + LDS_V + wid * 1024;
#define DMA_KV(t, s) do { glds16(ksrc0 + (long)(t) * 49152, (unsigned)__builtin_amdgcn_readfirstlane(kdst0 + (s) * KSLOT)); \
        if (wid < 4) glds16(ksrc1 + (long)(t) * 49152, (unsigned)__builtin_amdgcn_readfirstlane(kdst1 + (s) * KSLOT)); \
        glds16(vsrc + (long)(t) * 64 * 512, (unsigned)__builtin_amdgcn_readfirstlane(vdst + (s) * VSLOT)); } while (0)
    const int vb0 = (int)(lds0 + LDS_V) + ((lane >> 4) & 1) * 32 + (lane & 3) * 8 + (4 * hi + ((lane & 15) >> 2)) * 64;
    const int NT = (q0 + 256) / 64;
    DMA_KV(0, 0); DMA_KV(1, 1);
    bf16x8 qr[6];
#pragma unroll
    for (int d0 = 0; d0 < 6; ++d0) qr[d0] = *reinterpret_cast<const bf16x8*>(&Qw[(long)r32 * 768 + d0 * 16 + hi * 8]);
    float mhat = 0.f, l_reg = 0.f; f32x16 o[2]; o[0] = f32x16{}; o[1] = f32x16{};
    f32x16 negm = f32x16{};
    const int qrel = wid * 32 + r32;
    typedef short v4i16_t __attribute__((ext_vector_type(4)));
    typedef __attribute__((address_space(3))) v4i16_t* lds_v4p;
    u32x4 pw[4]; pw[0] = pw[1] = pw[2] = pw[3] = (u32x4){0u, 0u, 0u, 0u};
    f32x16 pc0, pc1;
    ATT_WAIT_BAR();
    { const char* kb = shm + LDS_K + hi * 1024 + r32 * 16; bf16x8 kf0[6], kf1[6];
#pragma unroll
      for (int d0 = 0; d0 < 6; ++d0) { kf0[d0] = *reinterpret_cast<const bf16x8*>(kb + d0 * 2048); kf1[d0] = *reinterpret_cast<const bf16x8*>(kb + d0 * 2048 + 512); }
      pc0 = __builtin_amdgcn_mfma_f32_32x32x16_bf16(kf0[0], qr[0], negm, 0, 0, 0); pc1 = __builtin_amdgcn_mfma_f32_32x32x16_bf16(kf1[0], qr[0], negm, 0, 0, 0);
#pragma unroll
      for (int d0 = 1; d0 < 6; ++d0) { pc0 = __builtin_amdgcn_mfma_f32_32x32x16_bf16(kf0[d0], qr[d0], pc0, 0, 0, 0); pc1 = __builtin_amdgcn_mfma_f32_32x32x16_bf16(kf1[d0], qr[d0], pc1, 0, 0, 0); } }
    for (int t = 0; t < NT; ++t) {
        if (t > 0) ATT_WAIT_BAR();
        if (t + 2 < NT) DMA_KV(t + 2, (t + 2) & (NSLOT - 1));
        const int vsl = ((t > 0) ? t - 1 : 0) & (NSLOT - 1);
        const int ksl = ((t + 1 < NT) ? t + 1 : t) & (NSLOT - 1);
        const int jb = t - (NT - 4);
        if (jb >= 0) { const int kbase = 64 * jb + 4 * hi;
#pragma unroll
            for (int r = 0; r < 16; ++r) { const int kv = kbase + (r & 3) + 8 * (r >> 2); if (kv > qrel) pc0[r] = -INFINITY; if (kv + 32 > qrel) pc1[r] = -INFINITY; } }
        float rm;
        { s16x4 vlo_[8], vhi_[8]; const lds_v4p vbp_ = (lds_v4p)(vb0 + vsl * VSLOT);
#pragma unroll
          for (int i = 0; i < 8; ++i) { const int off = (i >> 2) * 4096 + (i & 3) * 1024;
              vlo_[i] = __builtin_bit_cast(s16x4, __builtin_amdgcn_ds_read_tr16_b64_v4i16(vbp_ + off / 8)); vhi_[i] = __builtin_bit_cast(s16x4, __builtin_amdgcn_ds_read_tr16_b64_v4i16(vbp_ + (off + 512) / 8)); }
          __builtin_amdgcn_sched_barrier(0);
#pragma unroll
          for (int i = 0; i < 8; ++i) { const bf16x8 vf = (bf16x8){vlo_[i][0], vlo_[i][1], vlo_[i][2], vlo_[i][3], vhi_[i][0], vhi_[i][1], vhi_[i][2], vhi_[i][3]};
              o[i >> 2] = __builtin_amdgcn_mfma_f32_32x32x16_bf16(__builtin_bit_cast(bf16x8, pw[i & 3]), vf, o[i >> 2], 0, 0, 0); }
          rm = rowmax(pc0, pc1);
#pragma unroll
          for (int i = 0; i < 8; ++i) { __builtin_amdgcn_sched_group_barrier(0x8, 1, 0); __builtin_amdgcn_sched_group_barrier(0x2, 3, 0); }
          __builtin_amdgcn_sched_barrier(0); }
        if (t == 0 || __any(rm > 8.0f)) {
            const float dl = (t == 0) ? rm : fmaxf(rm, 0.f); mhat += dl;
#pragma unroll
            for (int r = 0; r < 16; ++r) { pc0[r] -= dl; pc1[r] -= dl; negm[r] = -mhat; }
            const float f = (t == 0) ? 1.0f : __builtin_amdgcn_exp2f(-dl); l_reg *= f; if (hi == 0) wsf[r32] = f;
            asm volatile("s_waitcnt lgkmcnt(0)" ::: "memory");
#pragma unroll
            for (int r = 0; r < 16; ++r) { const float fr_ = wsf[crow(r, hi)]; o[0][r] *= fr_; o[1][r] *= fr_; } }
        f32x16 pn0, pn1;
        { const char* kb = shm + LDS_K + ksl * KSLOT + hi * 1024 + r32 * 16; bf16x8 kf0[6], kf1[6];
#pragma unroll
          for (int d0 = 0; d0 < 6; ++d0) { kf0[d0] = *reinterpret_cast<const bf16x8*>(kb + d0 * 2048); kf1[d0] = *reinterpret_cast<const bf16x8*>(kb + d0 * 2048 + 512); }
          __builtin_amdgcn_sched_barrier(0);
          pn0 = __builtin_amdgcn_mfma_f32_32x32x16_bf16(kf0[0], qr[0], negm, 0, 0, 0); pn1 = __builtin_amdgcn_mfma_f32_32x32x16_bf16(kf1[0], qr[0], negm, 0, 0, 0);
#pragma unroll
          for (int d0 = 1; d0 < 6; ++d0) { pn0 = __builtin_amdgcn_mfma_f32_32x32x16_bf16(kf0[d0], qr[d0], pn0, 0, 0, 0); pn1 = __builtin_amdgcn_mfma_f32_32x32x16_bf16(kf1[d0], qr[d0], pn1, 0, 0, 0); }
          float sa0 = 0.f, sa1 = 0.f, sa2 = 0.f, sa3 = 0.f;
#pragma unroll
          for (int r = 0; r < 16; r += 2) { pc0[r] = __builtin_amdgcn_exp2f(pc0[r]); pc1[r] = __builtin_amdgcn_exp2f(pc1[r]); pc0[r + 1] = __builtin_amdgcn_exp2f(pc0[r + 1]); pc1[r + 1] = __builtin_amdgcn_exp2f(pc1[r + 1]);
              sa0 += pc0[r]; sa1 += pc1[r]; sa2 += pc0[r + 1]; sa3 += pc1[r + 1]; }
          l_reg += (sa0 + sa1) + (sa2 + sa3);
          pw[0] = (u32x4){cvtpk_c(pc0[0], pc0[1]), cvtpk_c(pc0[2], pc0[3]), cvtpk_c(pc0[4], pc0[5]), cvtpk_c(pc0[6], pc0[7])};
          pw[1] = (u32x4){cvtpk_c(pc0[8], pc0[9]), cvtpk_c(pc0[10], pc0[11]), cvtpk_c(pc0[12], pc0[13]), cvtpk_c(pc0[14], pc0[15])};
          pw[2] = (u32x4){cvtpk_c(pc1[0], pc1[1]), cvtpk_c(pc1[2], pc1[3]), cvtpk_c(pc1[4], pc1[5]), cvtpk_c(pc1[6], pc1[7])};
          pw[3] = (u32x4){cvtpk_c(pc1[8], pc1[9]), cvtpk_c(pc1[10], pc1[11]), cvtpk_c(pc1[12], pc1[13]), cvtpk_c(pc1[14], pc1[15])};
#pragma unroll
          for (int i = 0; i < 12; ++i) { __builtin_amdgcn_sched_group_barrier(0x8, 1, 0); __builtin_amdgcn_sched_group_barrier(0x400, 3, 0); __builtin_amdgcn_sched_group_barrier(0x2, 5, 0); }
          __builtin_amdgcn_sched_barrier(0); }
        pc0 = pn0; pc1 = pn1;
    }
    { s16x4 vlo_[8], vhi_[8]; const lds_v4p vbp_ = (lds_v4p)(vb0 + ((NT - 1) & (NSLOT - 1)) * VSLOT);
#pragma unroll
      for (int i = 0; i < 8; ++i) { const int off = (i >> 2) * 4096 + (i & 3) * 1024;
          vlo_[i] = __builtin_bit_cast(s16x4, __builtin_amdgcn_ds_read_tr16_b64_v4i16(vbp_ + off / 8)); vhi_[i] = __builtin_bit_cast(s16x4, __builtin_amdgcn_ds_read_tr16_b64_v4i16(vbp_ + (off + 512) / 8)); }
#pragma unroll
      for (int i = 0; i < 8; ++i) { const bf16x8 vf = (bf16x8){vlo_[i][0], vlo_[i][1], vlo_[i][2], vlo_[i][3], vhi_[i][0], vhi_[i][1], vhi_[i][2], vhi_[i][3]};
          o[i >> 2] = __builtin_amdgcn_mfma_f32_32x32x16_bf16(__builtin_bit_cast(bf16x8, pw[i & 3]), vf, o[i >> 2], 0, 0, 0); } }
    { auto rr = __builtin_amdgcn_permlane32_swap(__float_as_uint(l_reg), __float_as_uint(l_reg), false, false); l_reg = __uint_as_float(rr[0]) + __uint_as_float(rr[1]); }
    if (hi == 0) wsf[32 + r32] = l_reg; asm volatile("s_waitcnt lgkmcnt(0)" ::: "memory");
    float rli[16];
#pragma unroll
    for (int r = 0; r < 16; ++r) rli[r] = __builtin_amdgcn_rcpf(wsf[32 + crow(r, hi)]);
    bf16* Ow = O + (rowbase + q0 + wid * 32) * 512 + h * VD;
    { bf16* stg = (bf16*)(shm + LDS_OST) + wid * 2048;
#pragma unroll
      for (int r = 0; r < 16; ++r) { const int orow = crow(r, hi);
#pragma unroll
          for (int d0 = 0; d0 < 2; ++d0) stg[orow * 64 + d0 * 32 + r32] = (bf16)f2bf(o[d0][r] * rli[r]); }
      asm volatile("s_waitcnt lgkmcnt(0)" ::: "memory");
#pragma unroll
      for (int i = 0; i < 4; ++i) { const int row = i * 8 + (lane >> 3), ch = lane & 7; const u32x4 v = *(const u32x4*)(stg + row * 64 + ch * 8); *(u32x4*)(Ow + (long)row * 512 + ch * 8) = v; } }
    asm volatile("s_waitcnt vmcnt(0) lgkmcnt(0)\n\ts_barrier" ::: "memory");
#undef DMA_KV
}
}

__device__ __forceinline__ void phase_attn(const Params& p, const Frame& F, char* lds_generic, int l) {
    const bf16* Q = WSP(bf16, WS_Q); const bf16* KKp = WSP(bf16, WS_KK); const bf16* Vp = WSP(bf16, WS_V); bf16* O = WSP(bf16, WS_O);
    unsigned* head = (unsigned*)(F.ws + WS_CTL) + CW_ATTQ + l * 64;
    volatile LAS unsigned* MISC = (volatile LAS unsigned*)(F.lds + MISC_OFF);
    for (;;) {
        if (F.tid == 0) MISC[16] = __hip_atomic_fetch_add(head, 1u, RLX_AGENT);
        __syncthreads();
        const unsigned k = MISC[16];
        __syncthreads();
        if (k >= 1024u) break;
        const int qb = 15 - (int)(k >> 6), bh = (int)(k & 63u);
        att::attn_unit(bh >> 3, bh & 7, qb, Q, KKp, Vp, O, lds_generic);
    }
}

namespace rw {
constexpr int RS = 144;
constexpr int SLOT = 64 * RS;
constexpr int S_KT = 0, S_RT = 1, S_BC = 2, S_KC = 3, S_V = 4, S_BH = 5, S_KH = 6, S_GT = 7, S_ABK = 8, S_AKK = 9, S_AKR = 10, S_ABR = 11, S_ABKF = 12;
constexpr int S_TT = S_BC, S_ZT = S_KC, S_NW1T = S_AKK, S_NW2T = S_ABK;
constexpr int TOT_OFF = 13 * SLOT, PL_OFF = TOT_OFF + 8 * 64 * 4;
typedef short v4i16_t __attribute__((ext_vector_type(4)));
__device__ __forceinline__ int crow(int r, int hi) { return (r & 3) + 8 * (r >> 2) + 4 * hi; }
__device__ __forceinline__ bf16x8 frag_d(const LAS unsigned char* M, int row0, int k0, int r, int h) { return *(const LAS bf16x8*)(M + (row0 + r) * RS + (k0 + 8 * h) * 2); }
__device__ __forceinline__ bf16x8 frag_t(const LAS unsigned char* M, int k0, int col0, int lane) {
    const int h = lane >> 5, blk = (lane >> 4) & 1, q = (lane & 15) >> 2, pp = lane & 3;
    const LAS unsigned char* a = M + (k0 + 8 * h + q) * RS + (col0 + 16 * blk + 4 * pp) * 2;
    const v4i16_t lo = __builtin_amdgcn_ds_read_tr16_b64_v4i16((LAS v4i16_t*)a), hi = __builtin_amdgcn_ds_read_tr16_b64_v4i16((LAS v4i16_t*)(a + 4 * RS));
    return (bf16x8){lo[0], lo[1], lo[2], lo[3], hi[0], hi[1], hi[2], hi[3]};
}
__device__ __forceinline__ void store_T(LAS unsigned char* D, int m0, int n0, const f32x16& acc, float sgn, int r, int h) {
#pragma unroll
    for (int g = 0; g < 4; ++g) { u32x2 w; w.x = cvtpk_c(acc[4 * g] * sgn, acc[4 * g + 1] * sgn); w.y = cvtpk_c(acc[4 * g + 2] * sgn, acc[4 * g + 3] * sgn);
        *(LAS u32x2*)(D + (n0 + r) * RS + (m0 + 8 * g + 4 * h) * 2) = w; }
}
#define RW_MMA(acc, A, B) acc = __builtin_amdgcn_mfma_f32_32x32x16_bf16((A), (B), acc, 0, 0, 0)
}

#define LBAR() asm volatile("s_waitcnt lgkmcnt(0)\n\ts_barrier" ::: "memory")
__device__ __forceinline__ void phase_rwkv_r1(const Params& p, const Frame& F, int l) {
    using namespace rw;
    LAS unsigned char* L0 = F.lds;
#define SL(i) (L0 + (i) * SLOT)
    const bf16* RK = WSP(bf16, WS_RK); const float* LWp = WSP(float, WS_LW); const bf16* AGp = WSP(bf16, WS_AG);
    const bf16* Vv = l == 0 ? WSP(bf16, WS_VS0) : WSP(bf16, WS_VR);
    float* CH = WSP(float, WS_CH); float* BON = WSP(float, WS_AN);
    const float* kkw = INP(I_KK) + (size_t)l * C5; const float* kaw = INP(I_KA) + (size_t)l * C5; const float* rkw = INP(I_RK) + (size_t)l * C5;
    const int tid0 = F.tid, wave = F.wave;
    const int pt0 = (tid0 >> 6) * 8 + (tid0 & 7), j80 = (tid0 >> 3) & 7;
    LAS float* tot = (LAS float*)(L0 + TOT_OFF); LAS float* PLv = (LAS float*)(L0 + PL_OFF);
    u32x4 g_r, g_k, g_v, g_a; f32x4 g_l0, g_l1;
#define R1_FETCH(uu) do { const int bh_ = (uu) >> 6, cc_ = (uu) & 63; const size_t tok = (size_t)(bh_ >> 3) * SEQ + (size_t)cc_ * 64 + pt0; const int c_ = (bh_ & 7) * 64 + 8 * j80; \
        g_r = *(const u32x4*)(RK + tok * 1024 + c_); g_k = *(const u32x4*)(RK + tok * 1024 + 512 + c_); g_v = *(const u32x4*)(Vv + tok * C5 + c_); \
        g_l0 = *(const f32x4*)(LWp + tok * C5 + c_); g_l1 = *(const f32x4*)(LWp + tok * C5 + c_ + 4); g_a = *(const u32x4*)(AGp + tok * 1024 + c_); } while (0)
    int u = F.vcu;
    if (u < 4096) R1_FETCH(u);
    for (; u < 4096; u += F.G) {
        const int hh = (u >> 6) & 7;
        int tid = tid0; asm volatile("" : "+v"(tid)); const int lane = tid & 63, r = lane & 31, h = lane >> 5, pt = (tid >> 6) * 8 + (tid & 7), j8 = (tid >> 3) & 7;
        {
            const int c = hh * 64 + 8 * j8;
            const f32x4 kk0 = *(const f32x4*)(kkw + c), kk1 = *(const f32x4*)(kkw + c + 4), ka0 = *(const f32x4*)(kaw + c), ka1 = *(const f32x4*)(kaw + c + 4);
            float rr[8], k[8], a[8], x[8], lw[8], kap[8], be[8], kp[8]; float ss = 0.f;
#pragma unroll
            for (int j = 0; j < 4; ++j) { rr[2 * j] = bflo(g_r[j]); rr[2 * j + 1] = bfhi(g_r[j]); k[2 * j] = bflo(g_k[j]); k[2 * j + 1] = bfhi(g_k[j]); }
            *(LAS u32x4*)(SL(S_V) + pt * RS + j8 * 16) = g_v;
#pragma unroll
            for (int j = 0; j < 8; ++j) { a[j] = (j & 1) ? bfhi(g_a[j >> 1]) : bflo(g_a[j >> 1]); lw[j] = j < 4 ? g_l0[j & 3] : g_l1[j & 3]; x[j] = lw[j]; const float q = k[j] * (j < 4 ? kk0[j & 3] : kk1[j & 3]); kap[j] = q; ss += q * q; }
            ss += __shfl_xor(ss, 8); ss += __shfl_xor(ss, 16); ss += __shfl_xor(ss, 32);
            const float inv = 1.0f / fmaxf(sqrtf(ss), 1e-12f);
#pragma unroll
            for (int j = 0; j < 8; ++j) { kap[j] *= inv; be[j] = kap[j] * a[j]; kp[j] = k[j] * (1.0f + (a[j] - 1.0f) * (j < 4 ? ka0[j & 3] : ka1[j & 3])); }
            { const f32x4 rk0 = *(const f32x4*)(rkw + c), rk1 = *(const f32x4*)(rkw + c + 4); float bon = 0.f;
#pragma unroll
              for (int j = 0; j < 8; ++j) bon += rr[j] * kp[j] * (j < 4 ? rk0[j & 3] : rk1[j & 3]);
              bon += __shfl_xor(bon, 8); bon += __shfl_xor(bon, 16); bon += __shfl_xor(bon, 32);
              if (j8 == 0) BON[((size_t)(u >> 9) * SEQ + (size_t)(u & 63) * 64 + pt) * 8 + hh] = bon; }
            const int tl = lane & 7;
#pragma unroll
            for (int j = 0; j < 8; ++j) { float y;
                y = __builtin_bit_cast(float, __builtin_amdgcn_update_dpp(0, __builtin_bit_cast(int, x[j]), 0x111, 0xF, 0xF, true)); x[j] += (tl >= 1) ? y : 0.f;
                y = __builtin_bit_cast(float, __builtin_amdgcn_update_dpp(0, __builtin_bit_cast(int, x[j]), 0x112, 0xF, 0xF, true)); x[j] += (tl >= 2) ? y : 0.f;
                y = __builtin_bit_cast(float, __builtin_amdgcn_update_dpp(0, __builtin_bit_cast(int, x[j]), 0x114, 0xF, 0xF, true)); x[j] += (tl >= 4) ? y : 0.f; }
            if (tl == 7) { *(LAS f32x4*)(tot + wave * 64 + 8 * j8) = (f32x4){x[0], x[1], x[2], x[3]}; *(LAS f32x4*)(tot + wave * 64 + 8 * j8 + 4) = (f32x4){x[4], x[5], x[6], x[7]}; }
            LBAR();
            float csL[8];
#pragma unroll
            for (int j = 0; j < 8; ++j) csL[j] = 0.f;
#pragma unroll
            for (int w2 = 0; w2 < 8; ++w2) { const f32x4 t0 = *(const LAS f32x4*)(tot + w2 * 64 + 8 * j8), t1 = *(const LAS f32x4*)(tot + w2 * 64 + 8 * j8 + 4);
#pragma unroll
                for (int j = 0; j < 8; ++j) { const float tv = j < 4 ? t0[j & 3] : t1[j & 3]; csL[j] += tv; if (w2 < wave) x[j] += tv; } }
            if (pt == 0) {
#pragma unroll
                for (int j = 0; j < 8; ++j) PLv[8 * j8 + j] = __expf(csL[j]); }
            float kt[8], rt[8], bc[8], kc[8], bh[8], kh[8];
#pragma unroll
            for (int j = 0; j < 8; ++j) { const float eP = __expf(x[j]), ePm1 = __expf(x[j] - lw[j]), eInv = __expf(-x[j]), eL = __expf(csL[j] - x[j]);
                kt[j] = kap[j] * ePm1; rt[j] = rr[j] * eP; bc[j] = be[j] * eInv; kc[j] = kp[j] * eInv; bh[j] = be[j] * eL; kh[j] = kp[j] * eL; }
#define PK8(v) (u32x4){cvtpk_c(v[0], v[1]), cvtpk_c(v[2], v[3]), cvtpk_c(v[4], v[5]), cvtpk_c(v[6], v[7])}
            *(LAS u32x4*)(SL(S_KT) + pt * RS + j8 * 16) = PK8(kt); *(LAS u32x4*)(SL(S_RT) + pt * RS + j8 * 16) = PK8(rt);
            *(LAS u32x4*)(SL(S_BC) + pt * RS + j8 * 16) = PK8(bc); *(LAS u32x4*)(SL(S_KC) + pt * RS + j8 * 16) = PK8(kc);
            *(LAS u32x4*)(SL(S_BH) + pt * RS + j8 * 16) = PK8(bh); *(LAS u32x4*)(SL(S_KH) + pt * RS + j8 * 16) = PK8(kh);
#undef PK8
        }
        LBAR();
        {
            const int mat = wave >> 1, ti = wave & 1;
            const LAS unsigned char* X = (mat < 2) ? SL(S_KT) : SL(S_RT); const LAS unsigned char* Y = (mat == 0 || mat == 3) ? SL(S_BC) : SL(S_KC);
            LAS unsigned char* Dm = SL(S_ABK + mat);
            const int t = 32 * ti + r;
            bf16x8 xb[4];
#pragma unroll
            for (int kk = 0; kk < 4; ++kk) xb[kk] = frag_d(X, 32 * ti, 16 * kk, r, h);
#pragma unroll
            for (int si = 0; si < 2; ++si) {
                f32x16 acc = f32x16{};
                if (!(ti == 0 && si == 1)) {
#pragma unroll
                    for (int kk = 0; kk < 4; ++kk) RW_MMA(acc, frag_d(Y, 32 * si, 16 * kk, r, h), xb[kk]); }
#pragma unroll
                for (int g = 0; g < 4; ++g) { float v[4];
#pragma unroll
                    for (int e = 0; e < 4; ++e) { const int sidx = 32 * si + 8 * g + 4 * h + e; const bool keep = (mat < 2) ? (sidx < t) : (sidx <= t); v[e] = keep ? acc[4 * g + e] : 0.f; }
                    u32x2 w; w.x = cvtpk_c(v[0], v[1]); w.y = cvtpk_c(v[2], v[3]);
                    *(LAS u32x2*)(Dm + t * RS + (32 * si + 8 * g + 4 * h) * 2) = w;
                    if (mat == 0 && ti == si) *(LAS f32x4*)(SL(S_ABKF) + ti * 4608 + r * 144 + (8 * g + 4 * h) * 4) = (f32x4){v[0], v[1], v[2], v[3]}; }
            }
        }
        LBAR();
        if (wave == 0) {
            const int hb = lane >> 5, c = lane & 31; const LAS unsigned char* Ab = SL(S_ABKF) + hb * 4608;
            float Tc[32];
#pragma unroll
            for (int t = 0; t < 32; ++t) Tc[t] = 0.f;
            f32x4 an[8];
#pragma unroll
            for (int s4 = 0; s4 < 8; ++s4) an[s4] = (f32x4){0.f, 0.f, 0.f, 0.f};
#pragma unroll
            for (int t = 0; t < 32; ++t) { float acc0 = (t == c) ? 1.0f : 0.0f, acc1 = 0.f;
                f32x4 ac[8];
#pragma unroll
                for (int s4 = 0; s4 < 8; ++s4) ac[s4] = an[s4];
                if (t + 1 < 32) {
#pragma unroll
                    for (int s4 = 0; s4 < (t + 4) / 4; ++s4) an[s4] = *(const LAS f32x4*)(Ab + (t + 1) * 144 + s4 * 16); }
#pragma unroll
                for (int s4 = 0; s4 < (t + 3) / 4; ++s4) { const f32x4 a4 = ac[s4];
                    acc0 -= a4.x * Tc[4 * s4]; acc1 -= a4.y * Tc[4 * s4 + 1]; acc0 -= a4.z * Tc[4 * s4 + 2]; acc1 -= a4.w * Tc[4 * s4 + 3]; }
                float acc = acc0 + acc1;
                asm volatile("" : "+v"(acc) :: "memory");
                Tc[t] = acc; }
#pragma unroll
            for (int q = 0; q < 4; ++q) *(LAS u32x4*)(SL(S_TT) + (32 * hb + c) * RS + (32 * hb) * 2 + q * 16) =
                (u32x4){cvtpk_c(Tc[8 * q], Tc[8 * q + 1]), cvtpk_c(Tc[8 * q + 2], Tc[8 * q + 3]), cvtpk_c(Tc[8 * q + 4], Tc[8 * q + 5]), cvtpk_c(Tc[8 * q + 6], Tc[8 * q + 7])};
            { f32x16 acc = f32x16{};
#pragma unroll
              for (int kk = 0; kk < 2; ++kk) RW_MMA(acc, frag_d(SL(S_ABK), 32, 16 * kk, r, h), frag_d(SL(S_TT), 0, 16 * kk, r, h));
              store_T(SL(S_ZT), 0, 0, acc, 1.0f, r, h); }
            { f32x16 acc = f32x16{};
#pragma unroll
              for (int kk = 0; kk < 2; ++kk) RW_MMA(acc, frag_t(SL(S_TT), 32 + 16 * kk, 32, lane), frag_d(SL(S_ZT), 0, 16 * kk, r, h));
              store_T(SL(S_TT), 32, 0, acc, -1.0f, r, h); }
        } else if (wave == 1) {
            const int row = 32 + (lane >> 1), hf = lane & 1;
            *(LAS u32x4*)(SL(S_TT) + row * RS + hf * 32) = (u32x4){0u, 0u, 0u, 0u}; *(LAS u32x4*)(SL(S_TT) + row * RS + hf * 32 + 16) = (u32x4){0u, 0u, 0u, 0u};
        } else if (wave >= 4) {
            const int ti = (wave - 4) >> 1, ii = (wave - 4) & 1; f32x16 acc = f32x16{};
#pragma unroll
            for (int kk = 0; kk < 4; ++kk) RW_MMA(acc, frag_d(SL(S_AKK), 32 * ti, 16 * kk, r, h), frag_t(SL(S_V), 16 * kk, 32 * ii, lane));
            store_T(SL(S_GT), 32 * ti, 32 * ii, acc, 1.0f, r, h);
        }
        LBAR();
        if (u + F.G < 4096) R1_FETCH(u + F.G);
        { const int w4 = wave & 3, ti = w4 >> 1, ci = w4 & 1; f32x16 acc = f32x16{};
          if (wave < 4) {
#pragma unroll
              for (int kk = 0; kk < 4; ++kk) RW_MMA(acc, frag_t(SL(S_TT), 16 * kk, 32 * ti, lane), frag_t(SL(S_KT), 16 * kk, 32 * ci, lane));
              store_T(SL(S_NW1T), 32 * ti, 32 * ci, acc, -1.0f, r, h); }
          else {
#pragma unroll
              for (int kk = 0; kk < 4; ++kk) RW_MMA(acc, frag_t(SL(S_TT), 16 * kk, 32 * ti, lane), frag_d(SL(S_GT), 32 * ci, 16 * kk, r, h));
              store_T(SL(S_NW2T), 32 * ti, 32 * ci, acc, -1.0f, r, h); } }
        LBAR();
        { const int which = wave >> 1, mi = wave & 1; float* dst = CH + ((size_t)u * 4 + which) * 4096;
#pragma unroll
          for (int ni = 0; ni < 2; ++ni) { f32x16 acc = f32x16{};
#pragma unroll
              for (int kk = 0; kk < 4; ++kk) {
                  if (which == 0) RW_MMA(acc, frag_d(SL(S_ABR), 32 * mi, 16 * kk, r, h), frag_d(SL(S_NW1T), 32 * ni, 16 * kk, r, h));
                  else if (which == 1) { RW_MMA(acc, frag_d(SL(S_AKR), 32 * mi, 16 * kk, r, h), frag_t(SL(S_V), 16 * kk, 32 * ni, lane)); RW_MMA(acc, frag_d(SL(S_ABR), 32 * mi, 16 * kk, r, h), frag_d(SL(S_NW2T), 32 * ni, 16 * kk, r, h)); }
                  else if (which == 2) RW_MMA(acc, frag_t(SL(S_BH), 16 * kk, 32 * mi, lane), frag_d(SL(S_NW1T), 32 * ni, 16 * kk, r, h));
                  else { RW_MMA(acc, frag_t(SL(S_KH), 16 * kk, 32 * mi, lane), frag_t(SL(S_V), 16 * kk, 32 * ni, lane)); RW_MMA(acc, frag_t(SL(S_BH), 16 * kk, 32 * mi, lane), frag_d(SL(S_NW2T), 32 * ni, 16 * kk, r, h)); } }
              const int n = 32 * ni + r;
              if (which != 2) {
                  bf16* d16 = (bf16*)dst;
#pragma unroll
                  for (int rg = 0; rg < 16; rg += 2) { const int m = 32 * mi + crow(rg, h); float va = acc[rg], vb = acc[rg + 1];
                      if (which == 0) { va += bf2f(*(const LAS bf16*)(SL(S_RT) + m * RS + n * 2)); vb += bf2f(*(const LAS bf16*)(SL(S_RT) + (m + 1) * RS + n * 2)); }
                      const float send = (lane & 1) ? va : vb;
                      const float recv = __uint_as_float((unsigned)__builtin_amdgcn_update_dpp(0, (int)__float_as_uint(send), 0xB1, 0xF, 0xF, false));
                      const unsigned w = (lane & 1) ? cvtpk_c(recv, vb) : cvtpk_c(va, recv);
                      *(unsigned*)(d16 + (m + (lane & 1)) * 64 + (n & ~1)) = w; } }
              else {
#pragma unroll
                  for (int rg = 0; rg < 16; ++rg) { const int m = 32 * mi + crow(rg, h); float v = acc[rg];
                      if (which == 2 && m == n) v += PLv[n];
                      dst[m * 64 + n] = v; } } } }
        LBAR();
    }
#undef R1_FETCH
#undef SL
}

__device__ __forceinline__ void phase_rwkv_r2(const Params& p, const Frame& F) {
    const float* CH = WSP(float, WS_CH); float* RO = WSP(float, WS_RO);
    LAS float* stb = (LAS float*)(F.lds);
    constexpr int STB = 4 * 1280;
    const int lane = F.lane, wave = F.wave, q = lane >> 4, li = lane & 15, w4 = wave & 3;
    const int nr2 = F.G >= 4 ? F.G / 4 : 1;
    if (F.vcu >= nr2) return;
    for (int bh = F.vcu; bh < 64; bh += nr2) {
        const int b = bh >> 3, hh = bh & 7;
        __syncthreads();
        for (int i = F.tid; i < 2 * STB; i += NTHREADS) stb[i] = 0.f;
        __syncthreads();
        const float* basec = CH + (size_t)bh * 64 * 4 * 4096;
        if (wave < 4) {
            f32x4 fa[2][4]; u32x4 fc[2][4];
#define R2_FETCH_S(cc, st) do { const float* pa = basec + ((size_t)(cc) * 4 + 2) * 4096 + (16 * w4 + li) * 64 + 16 * q; fa[st][0] = *(const f32x4*)(pa); fa[st][1] = *(const f32x4*)(pa + 4); fa[st][2] = *(const f32x4*)(pa + 8); fa[st][3] = *(const f32x4*)(pa + 12); \
                const bf16* pc = (const bf16*)(basec + ((size_t)(cc) * 4 + 3) * 4096) + (16 * w4 + 4 * q) * 64 + li; \
                _Pragma("unroll") for (int ct = 0; ct < 4; ++ct) fc[st][ct] = (u32x4){(unsigned)pc[16 * ct], (unsigned)pc[64 + 16 * ct], (unsigned)pc[128 + 16 * ct], (unsigned)pc[192 + 16 * ct]}; } while (0)
            R2_FETCH_S(0, 0); R2_FETCH_S(1, 1);
#pragma unroll 1
            for (int c0 = 0; c0 < 64; c0 += 2) {
#pragma unroll
                for (int st = 0; st < 2; ++st) { const int c = c0 + st;
                    const f32x4 A0 = fa[st][0], A1 = fa[st][1], A2 = fa[st][2], A3 = fa[st][3];
                    f32x4 acc[4];
#pragma unroll
                    for (int ct = 0; ct < 4; ++ct)
#pragma unroll
                        for (int j = 0; j < 4; ++j) acc[ct][j] = __uint_as_float(fc[st][ct][j] << 16);
                    { const int cn = (c + 2 < 64) ? c + 2 : 63; R2_FETCH_S(cn, st); }
#pragma unroll
                    for (int ct = 0; ct < 4; ++ct) { const LAS float* sb = stb + (c & 1) * STB + ct * 1280 + lane * 20;
                        const f32x4 b0 = *(const LAS f32x4*)(sb), b1 = *(const LAS f32x4*)(sb + 4), b2 = *(const LAS f32x4*)(sb + 8), b3 = *(const LAS f32x4*)(sb + 12);
#pragma unroll
                        for (int k = 0; k < 4; ++k) acc[ct] = __builtin_amdgcn_mfma_f32_16x16x4f32(A0[k], b0[k], acc[ct], 0, 0, 0);
#pragma unroll
                        for (int k = 0; k < 4; ++k) acc[ct] = __builtin_amdgcn_mfma_f32_16x16x4f32(A1[k], b1[k], acc[ct], 0, 0, 0);
#pragma unroll
                        for (int k = 0; k < 4; ++k) acc[ct] = __builtin_amdgcn_mfma_f32_16x16x4f32(A2[k], b2[k], acc[ct], 0, 0, 0);
#pragma unroll
                        for (int k = 0; k < 4; ++k) acc[ct] = __builtin_amdgcn_mfma_f32_16x16x4f32(A3[k], b3[k], acc[ct], 0, 0, 0); }
#pragma unroll
                    for (int ct = 0; ct < 4; ++ct) *(LAS f32x4*)(stb + ((c + 1) & 1) * STB + ct * 1280 + (w4 * 16 + li) * 20 + 4 * q) = acc[ct];
                    LBAR();
                }
            }
#undef R2_FETCH_S
        } else {
            u32x4 fa[2][2], fc[2][4];
#define R2_FETCH_O(cc, st) do { const bf16* pa = (const bf16*)(basec + ((size_t)(cc) * 4 + 0) * 4096) + (16 * w4 + li) * 64 + 8 * q;        \
                fa[st][0] = *(const u32x4*)(pa); fa[st][1] = *(const u32x4*)(pa + 32); \
                const bf16* pc = (const bf16*)(basec + ((size_t)(cc) * 4 + 1) * 4096) + (16 * w4 + 4 * q) * 64 + li; \
                _Pragma("unroll") for (int ct = 0; ct < 4; ++ct) fc[st][ct] = (u32x4){(unsigned)pc[16 * ct], (unsigned)pc[64 + 16 * ct], (unsigned)pc[128 + 16 * ct], (unsigned)pc[192 + 16 * ct]}; } while (0)
            R2_FETCH_O(0, 0); R2_FETCH_O(1, 1);
#pragma unroll 1
            for (int c0 = 0; c0 < 64; c0 += 2) {
#pragma unroll
                for (int st = 0; st < 2; ++st) { const int c = c0 + st;
                    const bf16x8 a0 = __builtin_bit_cast(bf16x8, fa[st][0]), a1 = __builtin_bit_cast(bf16x8, fa[st][1]);
                    f32x4 acc[4];
#pragma unroll
                    for (int ct = 0; ct < 4; ++ct)
#pragma unroll
                        for (int j = 0; j < 4; ++j) acc[ct][j] = __uint_as_float(fc[st][ct][j] << 16);
                    { const int cn = (c + 2 < 64) ? c + 2 : 63; R2_FETCH_O(cn, st); }
#pragma unroll
                    for (int ct = 0; ct < 4; ++ct) { const LAS float* sb = stb + (c & 1) * STB + ct * 1280 + ((q >> 1) * 16 + li) * 20 + 8 * (q & 1);
                        const f32x4 x0 = *(const LAS f32x4*)(sb), x1 = *(const LAS f32x4*)(sb + 4), y0 = *(const LAS f32x4*)(sb + 640), y1 = *(const LAS f32x4*)(sb + 644);
                        const u32x4 p0 = (u32x4){cvtpk_c(x0.x, x0.y), cvtpk_c(x0.z, x0.w), cvtpk_c(x1.x, x1.y), cvtpk_c(x1.z, x1.w)}, p1 = (u32x4){cvtpk_c(y0.x, y0.y), cvtpk_c(y0.z, y0.w), cvtpk_c(y1.x, y1.y), cvtpk_c(y1.z, y1.w)};
                        acc[ct] = __builtin_amdgcn_mfma_f32_16x16x32_bf16(a0, __builtin_bit_cast(bf16x8, p0), acc[ct], 0, 0, 0);
                        acc[ct] = __builtin_amdgcn_mfma_f32_16x16x32_bf16(a1, __builtin_bit_cast(bf16x8, p1), acc[ct], 0, 0, 0); }
                    float* ro = RO + ((size_t)b * SEQ + (size_t)c * 64 + 16 * w4 + 4 * q) * C5 + hh * 64 + li;
#pragma unroll
                    for (int ct = 0; ct < 4; ++ct) { ro[16 * ct] = acc[ct][0]; ro[C5 + 16 * ct] = acc[ct][1]; ro[2 * C5 + 16 * ct] = acc[ct][2]; ro[3 * C5 + 16 * ct] = acc[ct][3]; }
                    LBAR();
                }
            }
#undef R2_FETCH_O
        }
    }
    __syncthreads();
}
#undef LBAR

__device__ __forceinline__ void phase_mix(const Params& p, const Frame& F, int l) {
    const int gw = F.vcu * NWAVES + F.wave, NGW = F.G * NWAVES; const int lane = F.lane;
    const bf16* O = WSP(bf16, WS_O); const float* RO = WSP(float, WS_RO); const float* BON = WSP(float, WS_AN); const bf16* AGp = WSP(bf16, WS_AG);
    const bf16* Vv = l == 0 ? WSP(bf16, WS_VS0) : WSP(bf16, WS_VR); bf16* MIX = WSP(bf16, WS_MIX);
    const float* og = INP(I_MOUTG) + (size_t)l * C5; const float* gng = INP(I_GNG) + (size_t)l * C5; const float* gnb = INP(I_GNB) + (size_t)l * C5;
    const int c = 8 * lane;
    const f32x4 og0 = *(const f32x4*)(og + c), og1 = *(const f32x4*)(og + c + 4);
    const f32x4 gg0 = *(const f32x4*)(gng + c), gg1 = *(const f32x4*)(gng + c + 4), gb0 = *(const f32x4*)(gnb + c), gb1 = *(const f32x4*)(gnb + c + 4);
    constexpr int U = 4;
#pragma unroll 1
    for (int t0 = gw; t0 < T; t0 += U * NGW) {
        u32x4 ow[U], vw[U], gw4[U]; f32x4 r0[U], r1[U]; float bonv[U];
#pragma unroll
        for (int u = 0; u < U; ++u) { const int tt = t0 + u * NGW; const size_t t = (size_t)(tt < T ? tt : T - 1);
            ow[u] = *(const u32x4*)(O + t * C5 + c); r0[u] = *(const f32x4*)(RO + t * C5 + c); r1[u] = *(const f32x4*)(RO + t * C5 + c + 4);
            vw[u] = *(const u32x4*)(Vv + t * C5 + c); gw4[u] = *(const u32x4*)(AGp + t * 1024 + 512 + c); bonv[u] = BON[t * 8 + (lane >> 3)]; }
#pragma unroll
        for (int u = 0; u < U; ++u) { const int t = t0 + u * NGW; if (t >= T) break;
            u32x4 wa;
            { float o[8]; float ss = 0.f;
#pragma unroll
              for (int j = 0; j < 4; ++j) { o[2 * j] = bflo(ow[u][j]); o[2 * j + 1] = bfhi(ow[u][j]); ss += o[2 * j] * o[2 * j] + o[2 * j + 1] * o[2 * j + 1]; }
              const float rs = 1.f / sqrtf(wave_sum(ss) * (1.f / C5) + RMS_EPS);
              wa.x = pk2(o[0] * rs * og0.x, o[1] * rs * og0.y); wa.y = pk2(o[2] * rs * og0.z, o[3] * rs * og0.w); wa.z = pk2(o[4] * rs * og1.x, o[5] * rs * og1.y); wa.w = pk2(o[6] * rs * og1.z, o[7] * rs * og1.w); }
            u32x4 wb;
            { float o[8]; float s = 0.f;
#pragma unroll
              for (int j = 0; j < 8; ++j) { o[j] = j < 4 ? r0[u][j & 3] : r1[u][j & 3]; s += o[j]; }
              s += __shfl_xor(s, 1); s += __shfl_xor(s, 2); s += __shfl_xor(s, 4); const float mean = s * (1.f / 64.f); float q = 0.f;
#pragma unroll
              for (int j = 0; j < 8; ++j) { o[j] -= mean; q += o[j] * o[j]; }
              q += __shfl_xor(q, 1); q += __shfl_xor(q, 2); q += __shfl_xor(q, 4); const float rstd = 1.f / sqrtf(q * (1.f / 64.f) + GN_EPS);
              const u32x4 gq = gw4[u]; const float bon = bonv[u];
              const f32x4 g0 = (f32x4){bflo(gq.x), bfhi(gq.x), bflo(gq.y), bfhi(gq.y)}, g1 = (f32x4){bflo(gq.z), bfhi(gq.z), bflo(gq.w), bfhi(gq.w)};
              float v[8];
#pragma unroll
              for (int j = 0; j < 4; ++j) { v[2 * j] = bflo(vw[u][j]); v[2 * j + 1] = bfhi(vw[u][j]); }
              float y[8];
#pragma unroll
              for (int j = 0; j < 8; ++j) { const float gn = o[j] * rstd * (j < 4 ? gg0[j & 3] : gg1[j & 3]) + (j < 4 ? gb0[j & 3] : gb1[j & 3]); y[j] = (gn + bon * v[j]) * (j < 4 ? g0[j & 3] : g1[j & 3]); }
              wb.x = pk2(y[0], y[1]); wb.y = pk2(y[2], y[3]); wb.z = pk2(y[4], y[5]); wb.w = pk2(y[6], y[7]); }
            *(u32x4*)(MIX + (size_t)t * D + c) = wa; *(u32x4*)(MIX + (size_t)t * D + C5 + c) = wb; }
    }
}

#define DPPI(x, ctrl) __builtin_amdgcn_update_dpp(0, (x), (ctrl), 0xF, 0xF, true)
__device__ __forceinline__ float row16_max(float x) {
    x = fmaxf(x, __builtin_bit_cast(float, DPPI(__builtin_bit_cast(int, x), 0xB1))); x = fmaxf(x, __builtin_bit_cast(float, DPPI(__builtin_bit_cast(int, x), 0x4E)));
    x = fmaxf(x, __builtin_bit_cast(float, DPPI(__builtin_bit_cast(int, x), 0x141))); x = fmaxf(x, __builtin_bit_cast(float, DPPI(__builtin_bit_cast(int, x), 0x140))); return x; }
__device__ __forceinline__ int row16_min(int x) {
    x = min(x, DPPI(x, 0xB1)); x = min(x, DPPI(x, 0x4E)); x = min(x, DPPI(x, 0x141)); x = min(x, DPPI(x, 0x140)); return x; }
__device__ __forceinline__ void phase_ln1_route(const Params& p, const Frame& F, int l) {
    LAS unsigned char* wl = F.lds;
    LAS int* hist = (LAS int*)(F.lds + LDSX_OFF + 4096);
    LAS int* basep = hist + 32;
    LAS int* rinfo = hist + 64;
    LAS float* rgate = (LAS float*)(rinfo + 512);
    const float* mod = WSP(float, WS_MOD) + (size_t)l * NBATCH * 6144;
    const float* g1 = INP(I_LN1G) + (size_t)l * D; const float* b1 = INP(I_LN1B) + (size_t)l * D;
    const float* rb = INP(I_RB) + (size_t)l * NE;
    unsigned* cnt = (unsigned*)(F.ws + WS_CTL) + CW_CNT + l * 64;
    int* LIST = WSP(int, WS_LIST); float* GATEL = WSP(float, WS_GATEL); int* TOKSLOT = WSP(int, WS_TOKSLOT);
    bf16* X = WSP(bf16, WS_X); unsigned char* H8 = WSP(unsigned char, WS_H8);
    const int lane = F.lane, li = lane & 15, g = lane >> 4;
    __syncthreads();
    for (int i = F.tid; i < 2 * 4096; i += NTHREADS) { const int part = i >> 12, rem = i & 4095, e = rem >> 7, ch = rem & 127;
        const u32x4 v = *(const u32x4*)(WSP(bf16, WS_RWT) + ((size_t)part * DEPTH + l) * NE * D + (size_t)e * D + ch * 8);
        *(LAS u32x4*)(wl + part * 65536 + e * 2048 + ((ch ^ (e & 15)) << 4)) = v; }
    __syncthreads();
    for (int chunk = F.vcu; chunk < T / 128; chunk += F.G) {
        __syncthreads();
        if (F.tid < 32) hist[F.tid] = 0;
        __syncthreads();
        const int row0 = chunk * 128 + F.wave * 16; const int b = row0 / SEQ;
        float mymean = 0.f, myrstd = 0.f;
#pragma unroll 1
        for (int rr = 0; rr < 16; ++rr) {
            const GAS u32x2* xr = (const GAS u32x2*)(X + (size_t)(row0 + rr) * D) + lane;
            f32x4 v[4]; float s = 0.f;
#pragma unroll
            for (int j = 0; j < 4; ++j) { const u32x2 w = xr[64 * j]; v[j] = (f32x4){bflo(w.x), bfhi(w.x), bflo(w.y), bfhi(w.y)}; s += (v[j].x + v[j].y) + (v[j].z + v[j].w); }
            const float mean = wave_sum(s) * (1.f / D); float s2 = 0.f;
#pragma unroll
            for (int j = 0; j < 4; ++j) { v[j] = v[j] - mean; s2 += (v[j].x * v[j].x + v[j].y * v[j].y) + (v[j].z * v[j].z + v[j].w * v[j].w); }
            const float rstd = __builtin_amdgcn_rsqf(wave_sum(s2) * (1.f / D) + LN_EPS);
            if (li == rr) { mymean = mean; myrstd = rstd; }
        }
        f32x4 acc0 = (f32x4){0.f, 0.f, 0.f, 0.f}, acc1 = acc0;
        bf16* xrow = X + (size_t)(row0 + li) * D + 8 * g; unsigned char* hrow = H8 + (size_t)(row0 + li) * D + 8 * g;
        const float* shp = mod + (size_t)b * 6144 + 3072 + 8 * g; const float* scp = mod + (size_t)b * 6144 + 4096 + 8 * g;
        const LAS unsigned char* w0 = wl + li * 2048; const LAS unsigned char* w1 = wl + (16 + li) * 2048;
#pragma unroll 2
        for (int s = 0; s < 32; ++s) {
            const int k = 32 * s;
            const u32x4 yw = *(const u32x4*)(xrow + k); const f32x4 y0 = (f32x4){bflo(yw.x), bfhi(yw.x), bflo(yw.y), bfhi(yw.y)}, y1 = (f32x4){bflo(yw.z), bfhi(yw.z), bflo(yw.w), bfhi(yw.w)};
            const f32x4 ga0 = *(const f32x4*)(g1 + k + 8 * g), ga1 = *(const f32x4*)(g1 + k + 8 * g + 4), be0 = *(const f32x4*)(b1 + k + 8 * g), be1 = *(const f32x4*)(b1 + k + 8 * g + 4);
            const f32x4 sc0 = *(const f32x4*)(scp + k), sc1 = *(const f32x4*)(scp + k + 4), sh0 = *(const f32x4*)(shp + k), sh1 = *(const f32x4*)(shp + k + 4);
            const f32x4 x0 = (y0 - mymean) * myrstd * ga0 + be0, x1 = (y1 - mymean) * myrstd * ga1 + be1;
            { u32x4 xw; xw.x = cvtpk_c(x0.x, x0.y); xw.y = cvtpk_c(x0.z, x0.w); xw.z = cvtpk_c(x1.x, x1.y); xw.w = cvtpk_c(x1.z, x1.w); *(u32x4*)(xrow + k) = xw; }
            const f32x4 h0 = x0 * (sc0 + 1.0f) + sh0, h1 = x1 * (sc1 + 1.0f) + sh1;
            u32x4 hi; hi.x = cvtpk_c(h0.x, h0.y); hi.y = cvtpk_c(h0.z, h0.w); hi.z = cvtpk_c(h1.x, h1.y); hi.w = cvtpk_c(h1.z, h1.w);
            { u32x2 h8; h8.x = q8x4(h0.x * QS_H, h0.y * QS_H, h0.z * QS_H, h0.w * QS_H); h8.y = q8x4(h1.x * QS_H, h1.y * QS_H, h1.z * QS_H, h1.w * QS_H); *(u32x2*)(hrow + k) = h8; }
            u32x4 lo; lo.x = cvtpk_c(h0.x - bflo(hi.x), h0.y - bfhi(hi.x)); lo.y = cvtpk_c(h0.z - bflo(hi.y), h0.w - bfhi(hi.y)); lo.z = cvtpk_c(h1.x - bflo(hi.z), h1.y - bfhi(hi.z)); lo.w = cvtpk_c(h1.z - bflo(hi.w), h1.w - bfhi(hi.w));
            const int cho = ((4 * s + g) ^ li) << 4;
            const bf16x8 bh0 = *(const LAS bf16x8*)(w0 + cho), bh1 = *(const LAS bf16x8*)(w1 + cho), bl0 = *(const LAS bf16x8*)(w0 + 65536 + cho), bl1 = *(const LAS bf16x8*)(w1 + 65536 + cho);
            const bf16x8 ahi = __builtin_bit_cast(bf16x8, hi), alo = __builtin_bit_cast(bf16x8, lo);
            acc0 = __builtin_amdgcn_mfma_f32_16x16x32_bf16(ahi, bh0, acc0, 0, 0, 0); acc1 = __builtin_amdgcn_mfma_f32_16x16x32_bf16(ahi, bh1, acc1, 0, 0, 0);
            acc0 = __builtin_amdgcn_mfma_f32_16x16x32_bf16(alo, bh0, acc0, 0, 0, 0); acc1 = __builtin_amdgcn_mfma_f32_16x16x32_bf16(alo, bh1, acc1, 0, 0, 0);
            acc0 = __builtin_amdgcn_mfma_f32_16x16x32_bf16(ahi, bl0, acc0, 0, 0, 0); acc1 = __builtin_amdgcn_mfma_f32_16x16x32_bf16(ahi, bl1, acc1, 0, 0, 0);
        }
        const float rb0 = rb[li], rb1 = rb[16 + li];
#pragma unroll
        for (int reg = 0; reg < 4; ++reg) {
            float v0 = acc0[reg] + rb0, v1 = acc1[reg] + rb1;
            float tv0 = 0.f, tv1 = 0.f, tv2 = 0.f, tv3 = 0.f; int te0 = 0, te1 = 0, te2 = 0, te3 = 0;
#pragma unroll
            for (int k = 0; k < 4; ++k) { const float mx = row16_max(fmaxf(v0, v1));
                const int id = (v0 == mx) ? li : ((v1 == mx) ? 16 + li : 99); const int ek = row16_min(id);
                if (k == 0) { tv0 = mx; te0 = ek; } else if (k == 1) { tv1 = mx; te1 = ek; } else if (k == 2) { tv2 = mx; te2 = ek; } else { tv3 = mx; te3 = ek; }
                if (ek == li) v0 = -INFINITY; if (ek == 16 + li) v1 = -INFINITY; }
            const float e1 = __expf(tv1 - tv0), e2 = __expf(tv2 - tv0), e3 = __expf(tv3 - tv0); const float inv = __builtin_amdgcn_rcpf(1.0f + e1 + e2 + e3);
            if (li < 4) { const int lr = F.wave * 16 + 4 * g + reg; const int ek = li == 0 ? te0 : li == 1 ? te1 : li == 2 ? te2 : te3; const float gk = (li == 0 ? 1.0f : li == 1 ? e1 : li == 2 ? e2 : e3) * inv;
                const int lp = __hip_atomic_fetch_add(&hist[ek], 1, __ATOMIC_RELAXED, __HIP_MEMORY_SCOPE_WORKGROUP); rinfo[lr * 4 + li] = (ek << 16) | lp; rgate[lr * 4 + li] = gk; }
        }
        __syncthreads();
        if (F.tid < 32) basep[F.tid] = (int)__hip_atomic_fetch_add(cnt + F.tid, (unsigned)hist[F.tid], RLX_AGENT);
        __syncthreads();
        { const int lr = F.tid >> 2, k = F.tid & 3; const int m = chunk * 128 + lr; const int info = rinfo[F.tid]; const int ek = info >> 16; const int pos = basep[ek] + (info & 0xffff);
          LIST[ek * CAP + pos] = m; GATEL[ek * CAP + pos] = rgate[F.tid]; TOKSLOT[m * 4 + k] = (ek << 16) | pos; }
    }
    __syncthreads();
}

__device__ __forceinline__ void moe_tables(const Frame& F, int l) {
    LAS int* tb = (LAS int*)(F.lds + TB_OFF); LAS int* cn = tb + 40;
    const unsigned* cnt = (const unsigned*)(F.ws + WS_CTL) + CW_CNT + l * 64;
    __syncthreads();
    if (F.tid == 0) { int acc = 0;
        for (int e = 0; e < NE; ++e) { const int c = (int)__hip_atomic_load(cnt + e, RLX_AGENT); cn[e] = c; tb[e] = acc; acc += (c + 255) >> 8; }
        tb[NE] = acc; }
    __syncthreads();
}

__device__ __forceinline__ void phase_combine(const Params& p, const Frame& F, int l) {
    const LAS int* tb = (const LAS int*)(F.lds + TB_OFF);
    const int gw = F.vcu * NWAVES + F.wave, NGW = F.G * NWAVES; const int lane = F.lane;
    const float* mod = WSP(float, WS_MOD) + (size_t)l * NBATCH * 6144; const float* modn = WSP(float, WS_MOD) + (size_t)(l + 1) * NBATCH * 6144;
    const float* g2 = INP(I_LN2G) + (size_t)l * D; const float* b2 = INP(I_LN2B) + (size_t)l * D;
    const bf16* Y = WSP(bf16, WS_Y); const int* TOKSLOT = WSP(int, WS_TOKSLOT);
    const bool lastl = (l == DEPTH - 1);
#pragma unroll 4
    for (int m = gw; m < T; m += NGW) {
        const int b = m / SEQ;
        int srow[4];
#pragma unroll
        for (int k = 0; k < 4; ++k) { const int ts = TOKSLOT[m * 4 + k]; const int e = ts >> 16, pos = ts & 0xffff; srow[k] = tb[e] * 256 + pos; }
        GAS u32x2* xr = (GAS u32x2*)(WSP(bf16, WS_X) + (size_t)m * D) + lane;
        f32x4 v[4]; float s = 0.f;
#pragma unroll
        for (int j = 0; j < 4; ++j) { const int c = 4 * lane + 256 * j; f32x4 y = (f32x4){0.f, 0.f, 0.f, 0.f};
#pragma unroll
            for (int k = 0; k < 4; ++k) { const u32x2 yw = *(const u32x2*)(Y + (size_t)srow[k] * D + c); y.x += bflo(yw.x); y.y += bfhi(yw.x); y.z += bflo(yw.y); y.w += bfhi(yw.y); }
            const f32x4 gt = *(const f32x4*)(mod + (size_t)b * 6144 + 5120 + c) + 1.0f;
            const u32x2 xw = xr[64 * j]; v[j] = (f32x4){bflo(xw.x), bfhi(xw.x), bflo(xw.y), bfhi(xw.y)} * DN_ALPHA + gt * y; s += (v[j].x + v[j].y) + (v[j].z + v[j].w); }
        const float mean = wave_sum(s) * (1.f / D); float s2 = 0.f;
#pragma unroll
        for (int j = 0; j < 4; ++j) { v[j] = v[j] - mean; s2 += (v[j].x * v[j].x + v[j].y * v[j].y) + (v[j].z * v[j].z + v[j].w * v[j].w); }
        const float rstd = 1.f / sqrtf(wave_sum(s2) * (1.f / D) + LN_EPS);
        GAS f32x4* oo = (GAS f32x4*)(p.out + (size_t)m * D) + lane;
        GAS unsigned* ho = (GAS unsigned*)(WSP(unsigned char, WS_H) + (size_t)m * D) + lane;
        f32x4 hq[4]; hq[0] = hq[1] = hq[2] = hq[3] = (f32x4){0.f, 0.f, 0.f, 0.f};
#pragma unroll
        for (int j = 0; j < 4; ++j) { const int c = 4 * lane + 256 * j;
            const f32x4 g = *(const f32x4*)(g2 + c), be = *(const f32x4*)(b2 + c);
            const f32x4 x2 = v[j] * rstd * g + be;
            if (lastl) oo[64 * j] = x2;
            else { { u32x2 xw; xw.x = pk2(x2.x, x2.y); xw.y = pk2(x2.z, x2.w); xr[64 * j] = xw; }
                const f32x4 sh = *(const f32x4*)(modn + (size_t)b * 6144 + c), sc = *(const f32x4*)(modn + (size_t)b * 6144 + 1024 + c);
                hq[j] = x2 * (sc + 1.0f) + sh; } }
        if (!lastl) { float mx = 0.f;
#pragma unroll
            for (int j = 0; j < 4; ++j) mx = fmaxf(mx, fmaxf(fmaxf(fabsf(hq[j].x), fabsf(hq[j].y)), fmaxf(fabsf(hq[j].z), fabsf(hq[j].w))));
#pragma unroll
            for (int o = 1; o < 64; o <<= 1) mx = fmaxf(mx, __shfl_xor(mx, o));
            mx = fmaxf(mx, 1e-20f); const float qsr = 127.0f / mx;
#pragma unroll
            for (int j = 0; j < 4; ++j) ho[64 * j] = q8x4(hq[j].x * qsr, hq[j].y * qsr, hq[j].z * qsr, hq[j].w * qsr);
            if (lane == 0) WSP(float, WS_HS)[m] = mx * (1.0f / 127.0f); }
    }
}

constexpr int PH_PER_LAYER = 11, N_PHASES = 2 + DEPTH * PH_PER_LAYER;
__global__ void __launch_bounds__(NTHREADS, 2) fwd(Params p) {
    extern __shared__ __attribute__((aligned(16))) unsigned char lds[];
    Frame F;
    F.lds = (LAS unsigned char*)lds; F.tid = threadIdx.x; F.lane = F.tid & 63; F.wave = __builtin_amdgcn_readfirstlane(F.tid >> 6);
    F.G = gridDim.x; { const int bx = blockIdx.x; F.vcu = (F.G % 8 == 0) ? (bx % 8) * (F.G / 8) + bx / 8 : bx; }
    F.ws = p.ws;
    volatile LAS unsigned* MISC = (volatile LAS unsigned*)(F.lds + MISC_OFF);
    if (F.tid < 64) MISC[F.tid] = 0u;
    __syncthreads();
    unsigned* ctl = (unsigned*)(p.ws + WS_CTL);
#if MK_ONE_LAUNCH
    XcdBarrier bar = xcd_barrier_post(ctl + CW_BAR, MISC + 8);
#define GRID_BAR() xcd_barrier(bar)
#else
#define GRID_BAR() do {} while (0)
#endif
    const int lo = p.ph_lo, hi = p.ph_hi;
#ifndef PH_MASK
#define PH_MASK 0xFFFFFFFFu
#endif
#define IN(k) (lo <= (k) && (k) < hi)
#define EN(j) ((PH_MASK >> (j)) & 1u)
#define SEAM(k) do { if (IN(k) && IN((k) + 1)) GRID_BAR(); } while (0)
    LAS unsigned char* ring = F.lds;

    if (EN(0) && IN(0)) { for (int rep = 0; rep < REP_PRO; ++rep) phase_prologue(p, F); } SEAM(0);
    if (EN(1) && IN(1)) { phase_ln0(p, F); } SEAM(1);
#define LAYER_BODY \
        constexpr int pb = 2 + l * PH_PER_LAYER; \
        const float* mod = WSP(float, WS_MOD) + (size_t)l * NBATCH * 6144; \
        if (EN(2) && IN(pb + 0)) { \
            pg8::Gemm g{WSP(bf16, WS_H), (const bf16*)(WSP(unsigned char, WS_WINT) + (size_t)l * N_INP * D), T, N_INP, D / 2}; pg8::DenseOrder S; S.init(T, N_INP, F.G, (int)blockIdx.x); \
            pg8::EpiPlainI8 E{WSP(bf16, WS_P), N_INP, 1.0f / QS_WIN, 1440, 1952, WSP(float, WS_HS)}; \
            pg8::gemm_phase<pg8::EpiPlainI8, pg8::DenseOrder, true, true>(ring, g, S, E); \
        } SEAM(pb + 0); \
        if (EN(3) && IN(pb + 1)) { phase_pgemm(p, F, l); } SEAM(pb + 1); \
        if (EN(5) && IN(pb + 3)) { phase_rwkv_r1(p, F, l); } SEAM(pb + 3); \
        if (EN(6) && IN(pb + 4)) { phase_rwkv_r2(p, F); if (l == 0) { const int c0 = F.G / 4, nc = (F.G * 3) / 8; if (F.vcu >= c0 && F.vcu < c0 + nc) phase_convert_experts(p, F, c0, nc); } phase_attn(p, F, (char*)lds, l); } SEAM(pb + 4); \
        if (EN(7) && IN(pb + 5)) { for (int rep = 0; rep < REP_MIX; ++rep) phase_mix(p, F, l); } SEAM(pb + 5); \
        if (EN(8) && IN(pb + 6)) { \
            pg8::Gemm g{WSP(bf16, WS_MIX), WSP(bf16, WS_WOT) + (size_t)l * D * D, T, D, D}; pg8::DenseOrder S; S.init(T, D, F.G, (int)blockIdx.x); \
            pg8::EpiWo E{WSP(bf16, WS_X), mod + 2048}; \
            pg8::gemm_phase<pg8::EpiWo, pg8::DenseOrder, true>(ring, g, S, E); \
        } SEAM(pb + 6); \
        if (EN(9) && IN(pb + 7)) { phase_ln1_route(p, F, l); } SEAM(pb + 7); \
        if (EN(10) && IN(pb + 8)) { \
            moe_tables(F, l); \
            const LAS int* tb = (const LAS int*)(F.lds + TB_OFF); \
            pg8::Gemm g{WSP(bf16, WS_H8), (const bf16*)(WSP(unsigned char, WS_W1T) + (size_t)l * NE * 2048 * D), T, 2048, D / 2};        \
            pg8::MoeOrder<true> S{tb, tb + 40, WSP(int, WS_LIST), 8, F.G, F.vcu, (LAS unsigned*)(F.lds + GT_OFF)}; \
            pg8::EpiSwiglu E{WSP(unsigned char, WS_H1), WSP(float, WS_B1P) + (size_t)l * NE * 2048}; \
            for (int rep = 0; rep < REP_MOE1; ++rep) pg8::gemm_phase<pg8::EpiSwiglu, pg8::MoeOrder<true>, true, true>(ring, g, S, E); \
        } SEAM(pb + 8); \
        if (EN(11) && IN(pb + 9)) { \
            moe_tables(F, l); \
            const LAS int* tb = (const LAS int*)(F.lds + TB_OFF); \
            pg8::Gemm g{WSP(bf16, WS_H1), (const bf16*)(WSP(unsigned char, WS_W2T) + (size_t)l * NE * D * FF), MAXSLOT, D, FF / 2}; \
            pg8::MoeOrder<false> S{tb, tb + 40, nullptr, 4, F.G, F.vcu, nullptr}; \
            pg8::EpiMoeOut E{WSP(bf16, WS_Y), INP(I_EB2) + (size_t)l * NE * D, WSP(float, WS_GATEL), tb}; \
            for (int rep = 0; rep < REP_MOE2; ++rep) pg8::gemm_phase<pg8::EpiMoeOut, pg8::MoeOrder<false>, true, true>(ring, g, S, E); \
        } SEAM(pb + 9); \
        if (EN(12) && IN(pb + 10)) { moe_tables(F, l); phase_combine(p, F, l); } SEAM(pb + 10);
    { constexpr int l = 0; LAYER_BODY }
    { constexpr int l = 1; LAYER_BODY }
#undef LAYER_BODY
#undef IN
#undef SEAM
}

extern "C" void kernel_launch(void* const* d_in, const int* in_sizes, int n_in, void* d_out, int out_size, void* d_ws, size_t ws_size, hipStream_t stream) {
    static int grid = 0;
    if (grid == 0) {
        if (n_in != N_INPUTS || out_size != T * D || ws_size < WS_END) { fprintf(stderr, "kernel_launch: unexpected problem: n_in %d out %d ws %zu\n", n_in, out_size, ws_size); grid = -1; return; }
        int dev = 0, cus = 0, per_cu = 0;
        if (hipGetDevice(&dev) != hipSuccess || hipDeviceGetAttribute(&cus, hipDeviceAttributeMultiprocessorCount, dev) != hipSuccess) { grid = -1; return; }
        if (hipFuncSetAttribute((const void*)fwd, hipFuncAttributeMaxDynamicSharedMemorySize, LDS_BYTES) != hipSuccess) { fprintf(stderr, "kernel_launch: hipFuncSetAttribute failed\n"); grid = -1; return; }
        if (hipOccupancyMaxActiveBlocksPerMultiprocessor(&per_cu, (const void*)fwd, NTHREADS, LDS_BYTES) != hipSuccess || per_cu < 1) fprintf(stderr, "kernel_launch: occupancy query reports %d\n", per_cu);
        (void)hipGetLastError();
        grid = cus;
    }
    if (grid < 0) return;
    if (hipMemsetAsync((char*)d_ws + WS_CTL, 0, CTL_ZERO_BYTES, stream) != hipSuccess) return;
    Params p{};
    for (int i = 0; i < N_INPUTS; ++i) p.in[i] = d_in[i];
    p.out = (float*)d_out; p.ws = (unsigned char*)d_ws;
#if MK_ONE_LAUNCH
    p.ph_lo = 0; p.ph_hi = N_PHASES;
    hipLaunchKernelGGL(fwd, dim3(grid), dim3(NTHREADS), LDS_BYTES, stream, p);
#else
    for (int ph = 0; ph < N_PHASES; ++ph) { p.ph_lo = ph; p.ph_hi = ph + 1; hipLaunchKernelGGL(fwd, dim3(grid), dim3(NTHREADS), LDS_BYTES, stream, p); }
#endif
}
```
